# Optimizing an MI355X kernel written in HIP

```python
import math
import jax, jax.numpy as jnp
from jax import lax
import numpy as np

D_MODEL = 1024
BATCH = 8
SEQ = 4096
DEPTH = 1

CONV_CH = 512
CONV_WIDTH = 31
ATTN_HEADS = 8
HEAD_DIM = 64
ATTN_W = ATTN_HEADS * HEAD_DIM
MOBA_BLOCK = 256
MOBA_TOPK = 3
Q_CHUNK = 128
PEER_HEADS = 8
PEER_NKEYS = 128
PEER_EXPERTS = PEER_NKEYS * PEER_NKEYS
PEER_QDIM = 256
PEER_TOPK = 16
PEER_TOK_CHUNK = 128
NORM_EPS = 1e-6
IN_SPLITS = (2 * CONV_CH, 2 * CONV_CH + ATTN_W, 2 * CONV_CH + 2 * ATTN_W,
             2 * CONV_CH + 3 * ATTN_W, 2 * CONV_CH + 3 * ATTN_W + D_MODEL)
IN_COLS = 2 * CONV_CH + 3 * ATTN_W + 2 * D_MODEL

kernel_name = 'hybrid_conformer_moba_peer_block'


def rms_norm(x, g):
    xf = x.astype(jnp.float32)
    y = xf * lax.rsqrt(jnp.mean(xf * xf, axis=-1, keepdims=True) + NORM_EPS)
    return (y * g.astype(jnp.float32)).astype(x.dtype)


def layer_norm(x, g, b):
    xf = x.astype(jnp.float32)
    mu = jnp.mean(xf, axis=-1, keepdims=True)
    xc = xf - mu
    var = jnp.mean(xc * xc, axis=-1, keepdims=True)
    y = xc * lax.rsqrt(var + NORM_EPS) * g.astype(jnp.float32) + b.astype(jnp.float32)
    return y.astype(x.dtype)


def alibi_slopes(n_heads):
    return jnp.asarray([2.0 ** (-8.0 * (i + 1) / n_heads) for i in range(n_heads)], dtype=jnp.float32)


def conformer_conv(u, conv_w, conv_b, ln_g, ln_b, w_pw, b_pw):
    a, gte = jnp.split(u, 2, axis=-1)
    z = a * jax.nn.sigmoid(gte)
    z = jnp.pad(z, ((0, 0), (CONV_WIDTH - 1, 0), (0, 0)))
    z = lax.conv_general_dilated(z, conv_w[:, None, :].astype(z.dtype), window_strides=(1,),
                                 padding='VALID', dimension_numbers=('NWC', 'WIO', 'NWC'),
                                 feature_group_count=CONV_CH) + conv_b
    z = jax.nn.silu(layer_norm(z, ln_g, ln_b))
    return z @ w_pw + b_pw


def moba_attention(q, k, v):
    B, H, S, dh = q.shape
    nb = -(-S // MOBA_BLOCK)
    s_pad = nb * MOBA_BLOCK
    pad = ((0, 0), (0, 0), (0, s_pad - S), (0, 0))
    kb = jnp.pad(k, pad).reshape(B, H, nb, MOBA_BLOCK, dh)
    vb = jnp.pad(v, pad).reshape(B, H, nb, MOBA_BLOCK, dh)
    kmean = jnp.mean(kb.astype(jnp.float32), axis=3)
    n_sel = min(MOBA_TOPK, nb)
    nc = S // Q_CHUNK
    slopes = alibi_slopes(H)
    scale = dh ** -0.5
    offs = jnp.arange(MOBA_BLOCK)
    qloc = jnp.arange(Q_CHUNK)
    hidx = jnp.arange(H)[:, None, None]

    def chunk(n):
        b = n // nc
        c = n % nc
        t0 = c * Q_CHUNK
        blk = t0 // MOBA_BLOCK
        qc = lax.dynamic_slice_in_dim(lax.dynamic_index_in_dim(q, b, 0, keepdims=False), t0, Q_CHUNK, axis=1)
        qf = qc.astype(jnp.float32) * scale
        kb_b = lax.dynamic_index_in_dim(kb, b, 0, keepdims=False)
        vb_b = lax.dynamic_index_in_dim(vb, b, 0, keepdims=False)
        km_b = lax.dynamic_index_in_dim(kmean, b, 0, keepdims=False)
        tpos = t0 + qloc
        bscore = jnp.einsum('hqd,hnd->hqn', qf, km_b)
        bscore = jnp.where(jnp.arange(nb) < blk, bscore, -jnp.inf)
        _, sel = lax.top_k(bscore, n_sel)
        sel_ok = sel < blk
        ksel = kb_b[hidx, sel]
        vsel = vb_b[hidx, sel]
        spos = sel[..., None] * MOBA_BLOCK + offs
        dist = (tpos[None, :, None, None] - spos).astype(jnp.float32)
        lsel = jnp.einsum('hqd,hqnkd->hqnk', qf, ksel.astype(jnp.float32)) - slopes[:, None, None, None] * dist
        lsel = jnp.where(sel_ok[..., None], lsel, -jnp.inf).reshape(H, Q_CHUNK, n_sel * MOBA_BLOCK)
        kown = lax.dynamic_index_in_dim(kb_b, blk, 1, keepdims=False)
        vown = lax.dynamic_index_in_dim(vb_b, blk, 1, keepdims=False)
        opos = blk * MOBA_BLOCK + offs
        odist = (tpos[:, None] - opos[None, :]).astype(jnp.float32)
        lown = jnp.einsum('hqd,hkd->hqk', qf, kown.astype(jnp.float32)) - slopes[:, None, None] * odist
        lown = jnp.where((opos[None, :] <= tpos[:, None])[None], lown, -jnp.inf)
        p = jax.nn.softmax(jnp.concatenate([lsel, lown], axis=-1), axis=-1)
        p_sel = p[..., :n_sel * MOBA_BLOCK]
        p_own = p[..., n_sel * MOBA_BLOCK:]
        out = (jnp.einsum('hqk,hqkd->hqd', p_sel, vsel.reshape(H, Q_CHUNK, n_sel * MOBA_BLOCK, dh).astype(jnp.float32))
               + jnp.einsum('hqk,hkd->hqd', p_own, vown.astype(jnp.float32)))
        return out.astype(q.dtype)

    o = lax.map(chunk, jnp.arange(B * nc))
    o = o.reshape(B, nc, H, Q_CHUNK, dh).transpose(0, 1, 3, 2, 4)
    return o.reshape(B, S, H * dh)


def peer_ffn(h, w_q, keys1, keys2, u_tab, v_tab):
    B, S, D = h.shape
    T = B * S
    ht = h.reshape(T, D)
    q = (ht @ w_q).reshape(T, PEER_HEADS, 2, PEER_QDIM // 2).astype(jnp.float32)
    s1 = jnp.einsum('thc,nc->thn', q[:, :, 0], keys1.astype(jnp.float32))
    s2 = jnp.einsum('thc,nc->thn', q[:, :, 1], keys2.astype(jnp.float32))
    v1, i1 = lax.top_k(s1, PEER_TOPK)
    v2, i2 = lax.top_k(s2, PEER_TOPK)
    cand = (v1[..., :, None] + v2[..., None, :]).reshape(T, PEER_HEADS, PEER_TOPK * PEER_TOPK)
    cidx = (i1[..., :, None] * PEER_NKEYS + i2[..., None, :]).reshape(T, PEER_HEADS, PEER_TOPK * PEER_TOPK)
    sc, pos = lax.top_k(cand, PEER_TOPK)
    eidx = jnp.take_along_axis(cidx, pos, axis=-1)
    g = jax.nn.softmax(sc, axis=-1)
    n_ch = T // PEER_TOK_CHUNK
    E = PEER_HEADS * PEER_TOPK
    xs = (ht.reshape(n_ch, PEER_TOK_CHUNK, D),
          eidx.reshape(n_ch, PEER_TOK_CHUNK, E),
          g.reshape(n_ch, PEER_TOK_CHUNK, E))

    def body(args):
        xc, ec, gc = args
        uc = u_tab[ec]
        a = jax.nn.gelu(jnp.einsum('td,ted->te', xc, uc, preferred_element_type=jnp.float32), approximate=False)
        vc = v_tab[ec]
        y = jnp.einsum('te,ted->td', (gc * a).astype(vc.dtype), vc, preferred_element_type=jnp.float32)
        return y.astype(h.dtype)

    return lax.map(body, xs).reshape(B, S, D)


def setup_inputs(seed: int = 0) -> dict:
    key = jax.random.key(seed)
    ks = jax.random.split(key, 20)
    f32 = jnp.float32
    L = DEPTH
    nrm = lambda k, shape, s: jax.random.normal(k, shape, f32) * s
    return {
        'x': jax.random.normal(ks[0], (BATCH, SEQ, D_MODEL), f32),
        'g_norm1': 1.0 + nrm(ks[1], (L, D_MODEL), 0.02),
        'w_in': nrm(ks[2], (L, D_MODEL, IN_COLS), D_MODEL ** -0.5),
        'conv_w': nrm(ks[3], (L, CONV_WIDTH, CONV_CH), CONV_WIDTH ** -0.5),
        'conv_b': nrm(ks[4], (L, CONV_CH), 0.02),
        'conv_ln_g': 1.0 + nrm(ks[5], (L, CONV_CH), 0.02),
        'conv_ln_b': nrm(ks[6], (L, CONV_CH), 0.02),
        'w_conv_pw': nrm(ks[7], (L, CONV_CH, D_MODEL), CONV_CH ** -0.5),
        'b_conv_pw': nrm(ks[8], (L, D_MODEL), 0.02),
        'w_attn_out': nrm(ks[9], (L, ATTN_W, D_MODEL), ATTN_W ** -0.5),
        'w_out': nrm(ks[10], (L, D_MODEL, D_MODEL), D_MODEL ** -0.5),
        'g_norm2': 1.0 + nrm(ks[11], (L, D_MODEL), 0.02),
        'w_peer_q': nrm(ks[12], (L, D_MODEL, PEER_HEADS * PEER_QDIM), D_MODEL ** -0.5),
        'peer_keys1': nrm(ks[13], (L, PEER_NKEYS, PEER_QDIM // 2), (PEER_QDIM // 2) ** -0.5),
        'peer_keys2': nrm(ks[14], (L, PEER_NKEYS, PEER_QDIM // 2), (PEER_QDIM // 2) ** -0.5),
        'peer_u': nrm(ks[15], (L, PEER_EXPERTS, D_MODEL), D_MODEL ** -0.5),
        'peer_v': nrm(ks[16], (L, PEER_EXPERTS, D_MODEL), 0.25),
        'g_final': 1.0 + nrm(ks[17], (D_MODEL,), 0.02),
    }


def reference(x, g_norm1, w_in, conv_w, conv_b, conv_ln_g, conv_ln_b, w_conv_pw, b_conv_pw,
              w_attn_out, w_out, g_norm2, w_peer_q, peer_keys1, peer_keys2, peer_u, peer_v, g_final):
    B, S, D = x.shape
    for l in range(DEPTH):
        h = rms_norm(x, g_norm1[l])
        z = h @ w_in[l]
        u_conv, q, k, v, gate_c, gate_a = jnp.split(z, IN_SPLITS, axis=-1)
        y_conv = conformer_conv(u_conv, conv_w[l], conv_b[l], conv_ln_g[l], conv_ln_b[l], w_conv_pw[l], b_conv_pw[l])
        to_heads = lambda t: t.reshape(B, S, ATTN_HEADS, HEAD_DIM).transpose(0, 2, 1, 3)
        y_attn = moba_attention(to_heads(q), to_heads(k), to_heads(v)) @ w_attn_out[l]
        mix = jax.nn.sigmoid(gate_c) * y_conv + jax.nn.sigmoid(gate_a) * y_attn
        x = x + mix @ w_out[l]
        x = x + peer_ffn(rms_norm(x, g_norm2[l]), w_peer_q[l], peer_keys1[l], peer_keys2[l], peer_u[l], peer_v[l])
    return rms_norm(x, g_final)
```

```cpp
#define MK_N_LAUNCHES 8
#ifndef PG8_EPI_DRAIN
#define PG8_EPI_DRAIN 0
#endif
#include <hip/hip_runtime.h>
#include <hip/hip_bf16.h>
#include <cstdio>
#include <cstdint>
#include <cmath>
namespace pg8 {
#define PG8_LAS __attribute__((address_space(3)))
typedef unsigned short bf16_t;
typedef short bf16x8 __attribute__((ext_vector_type(8)));
typedef float f32x4 __attribute__((ext_vector_type(4)));
typedef unsigned u32x4 __attribute__((ext_vector_type(4)));
constexpr int BM = 256, BK = 64, HALF = 128, HTB = HALF * BK * 2  , STAGE_BYTES = 8 * HTB, NXCD = 8, WGM = 8;

__host__ __device__ __forceinline__ int lds_byte(int r, int c) { const int st = (r >> 4) * 2 + (c >> 5), rr = r & 15, cc = c & 31, ob = rr * 64 + cc * 2; return st * 1024 + (ob ^ (((ob >> 9) & 1) << 5)); }
__host__ __device__ __forceinline__ void stage_rc(int b, int& R, int& C) { const int st = b / 1024, sb = b % 1024, swz = sb ^ (((sb >> 9) & 1) << 5); R = (st >> 1) * 16 + swz / 64; C = (st & 1) * 32 + (swz % 64) / 2; }
__host__ __device__ __forceinline__ int perm32(int rho) { const int n = rho >> 4, i = rho & 15; return 8 * (i >> 2) + 4 * n + (i & 3); }

struct Unit { int pm, pn; };
struct Gemm { const bf16_t* A; const bf16_t* Bt; int M, N, K; };

struct StaticOrder {
    int nM, nN, nwg, G, c;
    __host__ __device__ void init(int M, int N, int G_, int c_) { nM = M / BM; nN = N / BM; nwg = nM * nN; G = G_; c = c_; }
    __host__ __device__ bool next(int i, Unit& u) const {
        const long L = (long)i * G + c; if (L >= nwg) return false;
        int wgid = (int)L; { const int q = nwg / NXCD, r = nwg % NXCD, xcd = wgid % NXCD, off = wgid / NXCD; wgid = (xcd < r ? xcd * (q + 1) : r * (q + 1) + (xcd - r) * q) + off; }
        const int nig = WGM * nN, gid = wgid / nig, fm = gid * WGM, gsz = (nM - fm) < WGM ? (nM - fm) : WGM;
        u.pm = fm + ((wgid % nig) % gsz); u.pn = (wgid % nig) / gsz; return true;
    }
    __device__ __forceinline__ void a_ready(const Unit&) const {}
    __device__ __forceinline__ void done(const Unit&) const {}
};

typedef float f32x2c_t __attribute__((ext_vector_type(2))); typedef __bf16 bf16x2c_t __attribute__((ext_vector_type(2)));
__device__ __forceinline__ unsigned cvt_pk_bf16(float lo, float hi) { const f32x2c_t v = {lo, hi}; const bf16x2c_t b = __builtin_convertvector(v, bf16x2c_t); return __builtin_bit_cast(unsigned, b); }
typedef float f32x2 __attribute__((ext_vector_type(2)));
__device__ __forceinline__ float sigm(float v) { return __builtin_amdgcn_rcpf(1.0f + __builtin_amdgcn_exp2f(-1.4426950408889634f * v)); }
__device__ __forceinline__ float bf_lo(unsigned u) { return __uint_as_float(u << 16); }
__device__ __forceinline__ float bf_hi(unsigned u) { return __uint_as_float(u & 0xffff0000u); }
__device__ __forceinline__ u32x4 pack8(const f32x4 a, const f32x4 b) { u32x4 w; w.x = cvt_pk_bf16(a[0], a[1]); w.y = cvt_pk_bf16(a[2], a[3]); w.z = cvt_pk_bf16(b[0], b[1]); w.w = cvt_pk_bf16(b[2], b[3]); return w; }
__device__ __forceinline__ void unpack8(const u32x4 w, f32x4& a, f32x4& b) { a = (f32x4){bf_lo(w.x), bf_hi(w.x), bf_lo(w.y), bf_hi(w.y)}; b = (f32x4){bf_lo(w.z), bf_hi(w.z), bf_lo(w.w), bf_hi(w.w)}; }

struct EpiIn {
    static constexpr bool PERM = true, AFTER_DRAIN = false;
    bf16_t *zglu, *Q, *gc; float* kmean; float qscale; size_t qkv_stride, gate_stride;
    __device__ __forceinline__ void operator()(const f32x4 (&acc)[2][2][4][2], const Unit& u, int wr, int wc, int fr, int fq) const {
        const int row0 = u.pm * BM + wr * 64 + fr, cw = wc * 32 + 8 * fq, pn = u.pn;
        if (pn < 4) {
#pragma unroll
            for (int ai = 0; ai < 2; ++ai)
#pragma unroll
                for (int m = 0; m < 4; ++m) { const size_t row = (size_t)(row0 + ai * HALF + m * 16);
                    f32x4 z0, z1;
#pragma unroll
                    for (int j = 0; j < 4; ++j) { z0[j] = acc[ai][0][m][0][j] * sigm(acc[ai][1][m][0][j]); z1[j] = acc[ai][0][m][1][j] * sigm(acc[ai][1][m][1][j]); }
                    *(u32x4*)(zglu + row * 512 + pn * 128 + cw) = pack8(z0, z1); }
        } else if (pn < 10) {
            bf16_t* base = Q + (size_t)((pn - 4) >> 1) * qkv_stride; const int ct = (pn & 1) * 256; const float sc = pn < 6 ? qscale : 1.0f;
#pragma unroll
            for (int ai = 0; ai < 2; ++ai)
#pragma unroll
                for (int m = 0; m < 4; ++m) { const size_t row = (size_t)(row0 + ai * HALF + m * 16);
#pragma unroll
                    for (int bj = 0; bj < 2; ++bj) *(u32x4*)(base + row * 512 + ct + bj * HALF + cw) = pack8(acc[ai][bj][m][0] * sc, acc[ai][bj][m][1] * sc); }
            if (pn == 6 || pn == 7) {
#pragma unroll
                for (int bj = 0; bj < 2; ++bj)
#pragma unroll
                    for (int n = 0; n < 2; ++n)
#pragma unroll
                        for (int j = 0; j < 4; ++j) { float s = 0.f;
#pragma unroll
                            for (int ai = 0; ai < 2; ++ai)
#pragma unroll
                                for (int m = 0; m < 4; ++m) s += acc[ai][bj][m][n][j];
                            s += __shfl_xor(s, 1); s += __shfl_xor(s, 2); s += __shfl_xor(s, 4); s += __shfl_xor(s, 8);
                            if (fr == 0) kmean[((size_t)u.pm * 2 + wr) * 512 + ct + bj * HALF + cw + 4 * n + j] = s * (1.0f / 256.0f); }
            }
        } else {
            bf16_t* base = gc + (size_t)((pn - 10) >> 2) * gate_stride; const int ct = ((pn - 10) & 3) * 256;
#pragma unroll
            for (int ai = 0; ai < 2; ++ai)
#pragma unroll
                for (int m = 0; m < 4; ++m) { const size_t row = (size_t)(row0 + ai * HALF + m * 16);
#pragma unroll
                    for (int bj = 0; bj < 2; ++bj) { f32x4 s0, s1;
#pragma unroll
                        for (int j = 0; j < 4; ++j) { s0[j] = sigm(acc[ai][bj][m][0][j]); s1[j] = sigm(acc[ai][bj][m][1][j]); }
                        *(u32x4*)(base + row * 1024 + ct + bj * HALF + cw) = pack8(s0, s1); } }
        }
    }
};
template <bool ADD> struct EpiMix {
    static constexpr bool PERM = true, AFTER_DRAIN = false;
    const bf16_t* gate; const float* bias; bf16_t* mix;
    __device__ __forceinline__ void operator()(const f32x4 (&acc)[2][2][4][2], const Unit& u, int wr, int wc, int fr, int fq) const {
        const int row0 = u.pm * BM + wr * 64 + fr, col0 = u.pn * BM + wc * 32 + 8 * fq;
#pragma unroll
        for (int ai = 0; ai < 2; ++ai)
#pragma unroll
            for (int m = 0; m < 4; ++m) { const size_t row = (size_t)(row0 + ai * HALF + m * 16);
#pragma unroll
                for (int bj = 0; bj < 2; ++bj) { const size_t off = row * 1024 + col0 + bj * HALF;
                    f32x4 g0, g1; unpack8(*(const u32x4*)(gate + off), g0, g1);
                    f32x4 v0 = acc[ai][bj][m][0], v1 = acc[ai][bj][m][1];
                    if (!ADD) { v0 = (v0 + *(const f32x4*)(bias + col0 + bj * HALF)) * g0; v1 = (v1 + *(const f32x4*)(bias + col0 + bj * HALF + 4)) * g1; }
                    else { f32x4 p0, p1; unpack8(*(const u32x4*)(mix + off), p0, p1); v0 = p0 + v0 * g0; v1 = p1 + v1 * g1; }
                    *(u32x4*)(mix + off) = pack8(v0, v1); } }
    }
};
struct EpiX1 {
    static constexpr bool PERM = true, AFTER_DRAIN = false;
    const float* x; float* x1; bf16_t* x1b; float* ss;
    __device__ __forceinline__ void operator()(const f32x4 (&acc)[2][2][4][2], const Unit& u, int wr, int wc, int fr, int fq) const {
        const int row0 = u.pm * BM + wr * 64 + fr, col0 = u.pn * BM + wc * 32 + 8 * fq;
#pragma unroll
        for (int ai = 0; ai < 2; ++ai)
#pragma unroll
            for (int m = 0; m < 4; ++m) { const size_t row = (size_t)(row0 + ai * HALF + m * 16); float sq = 0.f;
#pragma unroll
                for (int bj = 0; bj < 2; ++bj) { const size_t off = row * 1024 + col0 + bj * HALF;
                    const f32x4 r0 = *(const f32x4*)(x + off) + acc[ai][bj][m][0], r1 = *(const f32x4*)(x + off + 4) + acc[ai][bj][m][1];
                    *(f32x4*)(x1 + off) = r0; *(f32x4*)(x1 + off + 4) = r1; *(u32x4*)(x1b + off) = pack8(r0, r1);
                    sq += (r0[0] * r0[0] + r0[1] * r0[1]) + (r0[2] * r0[2] + r0[3] * r0[3]) + (r1[0] * r1[0] + r1[1] * r1[1]) + (r1[2] * r1[2] + r1[3] * r1[3]); }
                sq += __shfl_xor(sq, 16); sq += __shfl_xor(sq, 32);
                if (fq == 0) ss[row * 16 + u.pn * 4 + wc] = sq; }
    }
};
struct EpiStore {
    static constexpr bool PERM = true, AFTER_DRAIN = false;
    bf16_t* O; int ldc;
    __device__ __forceinline__ void operator()(const f32x4 (&acc)[2][2][4][2], const Unit& u, int wr, int wc, int fr, int fq) const {
        const int row0 = u.pm * BM + wr * 64 + fr, col0 = u.pn * BM + wc * 32 + 8 * fq;
#pragma unroll
        for (int ai = 0; ai < 2; ++ai)
#pragma unroll
            for (int m = 0; m < 4; ++m) { const size_t row = (size_t)(row0 + ai * HALF + m * 16);
#pragma unroll
                for (int bj = 0; bj < 2; ++bj) *(u32x4*)(O + row * ldc + col0 + bj * HALF) = pack8(acc[ai][bj][m][0], acc[ai][bj][m][1]); }
    }
};


template <class Epi, class Sched, bool ALIGN_EPI = false, bool SP2 = false>
__device__ __forceinline__ void gemm_phase(PG8_LAS unsigned char* lds, const Gemm g, const Sched& S, const Epi& E) {
    const int tid = threadIdx.x, wid = __builtin_amdgcn_readfirstlane(tid >> 6), lane = tid & 63, wr = wid >> 2, wc = wid & 3, fr = lane & 15, fq = lane >> 4;
    const int K = g.K, nt = K / BK;
    unsigned voffA[2], voffB[2];
#pragma unroll
    for (int i = 0; i < 2; ++i) { int R, C; stage_rc(tid * 16 + i * 8192, R, C); const int Rb = Epi::PERM ? ((R & ~31) + perm32(R & 31)) : R;
        voffA[i] = (unsigned)(R * K + C) * 2u; voffB[i] = (unsigned)(Rb * K + C) * 2u; }
    const size_t kstep = (size_t)(BK * 2);
    const size_t hstep = (size_t)HALF * K * 2;
    const size_t tstep = 2 * hstep;
    const unsigned ldsw = (unsigned)wid * 1024u;
    const int aoff = lds_byte(wr * 64 + fr, fq * 8), boff = lds_byte(wc * 32 + fr, fq * 8);
#define PG8_SA(b, h) (((b) * 2 + (h)) * HTB)
#define PG8_SB(b, h) ((4 + (b) * 2 + (h)) * HTB)
#define PG8_STAGE(bufoff, gbase, voff) do { _Pragma("unroll") for (int _i = 0; _i < 2; ++_i) \
        __builtin_amdgcn_global_load_lds((const unsigned*)((const char*)(gbase) + (voff)[_i]), (PG8_LAS unsigned*)(lds + (bufoff) + ldsw + _i * 8192), 16, 0, 0); } while (0)
#define PG8_LDA(dst, b, h) do { _Pragma("unroll") for (int m = 0; m < 4; ++m) _Pragma("unroll") for (int k = 0; k < 2; ++k) dst[m][k] = *(const PG8_LAS bf16x8*)(lds + PG8_SA(b, h) + aoff + m * 2048 + k * 1024); } while (0)
#define PG8_LDB(dst, b, h) do { _Pragma("unroll") for (int n = 0; n < 2; ++n) _Pragma("unroll") for (int k = 0; k < 2; ++k) dst[n][k] = *(const PG8_LAS bf16x8*)(lds + PG8_SB(b, h) + boff + n * 2048 + k * 1024); } while (0)
#define PG8_MMA(ai, bj, At, Bt) do { __builtin_amdgcn_s_setprio(1); _Pragma("unroll") for (int m = 0; m < 4; ++m) _Pragma("unroll") for (int n = 0; n < 2; ++n) _Pragma("unroll") for (int k = 0; k < 2; ++k) \
        acc[ai][bj][m][n] = __builtin_amdgcn_mfma_f32_16x16x32_bf16(Bt[n][k], At[m][k], acc[ai][bj][m][n], 0, 0, 0); __builtin_amdgcn_s_setprio(0); } while (0)
#define PG8_WAIT_V(n) asm volatile("s_waitcnt vmcnt(" #n ")" ::: "memory")
#define PG8_WAIT_L(n) asm volatile("s_waitcnt lgkmcnt(" #n ")" ::: "memory")
#define PG8_BAR __builtin_amdgcn_s_barrier()
#define PG8_SCHED __builtin_amdgcn_sched_barrier(0)
    Unit cur, nxt; int ui = 0;
    if (!S.next(0, cur)) return;
    f32x4 acc[2][2][4][2];
#pragma unroll
    for (int a = 0; a < 2; ++a)
#pragma unroll
        for (int b = 0; b < 2; ++b)
#pragma unroll
            for (int m = 0; m < 4; ++m)
#pragma unroll
                for (int n = 0; n < 2; ++n) acc[a][b][m][n] = (f32x4){0.f, 0.f, 0.f, 0.f};
    bf16x8 At[4][2], B0[2][2], B1[2][2];
    const char* cA = (const char*)g.A + (size_t)cur.pm * tstep; const char* cB = (const char*)g.Bt + (size_t)cur.pn * tstep;
    S.a_ready(cur);
    if constexpr (SP2) {
        PG8_STAGE(PG8_SB(0, 0), cB, voffB); PG8_STAGE(PG8_SB(0, 1), cB + hstep, voffB); PG8_STAGE(PG8_SA(0, 0), cA, voffA); PG8_STAGE(PG8_SA(0, 1), cA + hstep, voffA);
        if (wr == 1) PG8_BAR;
        PG8_WAIT_V(2); PG8_BAR;
        PG8_STAGE(PG8_SB(1, 0), cB + kstep, voffB); PG8_STAGE(PG8_SA(1, 0), cA + kstep, voffA); PG8_STAGE(PG8_SB(1, 1), cB + hstep + kstep, voffB);
        PG8_WAIT_V(6); PG8_BAR;
    } else {
        PG8_STAGE(PG8_SB(0, 0), cB, voffB); PG8_STAGE(PG8_SA(0, 0), cA, voffA); PG8_STAGE(PG8_SB(0, 1), cB + hstep, voffB); PG8_STAGE(PG8_SA(0, 1), cA + hstep, voffA);
        if (wr == 1) PG8_BAR;
        PG8_WAIT_V(4); PG8_BAR;
        PG8_STAGE(PG8_SB(1, 0), cB + kstep, voffB); PG8_STAGE(PG8_SA(1, 0), cA + kstep, voffA); PG8_STAGE(PG8_SB(1, 1), cB + hstep + kstep, voffB);
        PG8_WAIT_V(6); PG8_BAR;
    }
    for (;;) {
        const bool has_next = S.next(ui + 1, nxt);
        const char* nA = has_next ? (const char*)g.A + (size_t)nxt.pm * tstep : cA; const char* nB = has_next ? (const char*)g.Bt + (size_t)nxt.pn * tstep : cB;
        for (int t = 0; t < nt; t += 2) {
            const bool last = (t == nt - 2);
            const char* a1 = cA + (size_t)(t + 1) * kstep;
            const char* a2 = last ? nA : cA + (size_t)(t + 2) * kstep; const char* b2 = last ? nB : cB + (size_t)(t + 2) * kstep;
            const char* a3 = a2 + kstep; const char* b3 = b2 + kstep;
            if (last && has_next) S.a_ready(nxt);
            if constexpr (SP2) {
            PG8_LDB(B0, 0, 0); PG8_LDB(B1, 0, 1); PG8_SCHED; PG8_LDA(At, 0, 0); PG8_STAGE(PG8_SA(1, 1), a1 + hstep, voffA);
            PG8_WAIT_V(8); PG8_WAIT_L(0); PG8_BAR; PG8_MMA(0, 0, At, B0); PG8_MMA(0, 1, At, B1); PG8_BAR; PG8_SCHED;
            PG8_LDA(At, 0, 1); PG8_STAGE(PG8_SB(0, 0), b2, voffB); PG8_STAGE(PG8_SB(0, 1), b2 + hstep, voffB); PG8_STAGE(PG8_SA(0, 0), a2, voffA);
            PG8_WAIT_V(8); PG8_WAIT_L(0); PG8_BAR; PG8_MMA(1, 0, At, B0); PG8_MMA(1, 1, At, B1); PG8_BAR; PG8_SCHED;
            PG8_LDB(B0, 1, 0); PG8_LDB(B1, 1, 1); PG8_SCHED; PG8_LDA(At, 1, 0); PG8_STAGE(PG8_SA(0, 1), a2 + hstep, voffA);
            PG8_WAIT_V(8); PG8_WAIT_L(0); PG8_BAR; PG8_MMA(0, 0, At, B0); PG8_MMA(0, 1, At, B1); PG8_BAR; PG8_SCHED;
            PG8_LDA(At, 1, 1); PG8_STAGE(PG8_SB(1, 0), b3, voffB); PG8_STAGE(PG8_SB(1, 1), b3 + hstep, voffB); PG8_STAGE(PG8_SA(1, 0), a3, voffA);
            PG8_WAIT_V(8); PG8_WAIT_L(0); PG8_BAR; PG8_MMA(1, 0, At, B0); PG8_MMA(1, 1, At, B1); PG8_BAR; PG8_SCHED;
            } else {
            PG8_LDB(B0, 0, 0); PG8_SCHED; PG8_LDA(At, 0, 0); PG8_STAGE(PG8_SA(1, 1), a1 + hstep, voffA);
            PG8_WAIT_L(8); PG8_BAR; PG8_WAIT_L(0); PG8_MMA(0, 0, At, B0); PG8_BAR; PG8_SCHED;
            PG8_LDB(B1, 0, 1); PG8_STAGE(PG8_SB(0, 0), b2, voffB);
            PG8_BAR; PG8_WAIT_L(0); PG8_MMA(0, 1, At, B1); PG8_BAR;
            PG8_LDA(At, 0, 1); PG8_STAGE(PG8_SA(0, 0), a2, voffA);
            PG8_BAR; PG8_WAIT_L(0); PG8_MMA(1, 0, At, B0); PG8_BAR; PG8_SCHED;
            PG8_STAGE(PG8_SB(0, 1), b2 + hstep, voffB);
            PG8_WAIT_V(6); PG8_BAR; PG8_MMA(1, 1, At, B1); PG8_BAR;
            PG8_LDB(B0, 1, 0); PG8_SCHED; PG8_LDA(At, 1, 0); PG8_STAGE(PG8_SA(0, 1), a2 + hstep, voffA);
            PG8_WAIT_L(8); PG8_BAR; PG8_WAIT_L(0); PG8_MMA(0, 0, At, B0); PG8_BAR; PG8_SCHED;
            PG8_LDB(B1, 1, 1); PG8_STAGE(PG8_SB(1, 0), b3, voffB);
            PG8_BAR; PG8_WAIT_L(0); PG8_MMA(0, 1, At, B1); PG8_BAR;
            PG8_LDA(At, 1, 1); PG8_STAGE(PG8_SA(1, 0), a3, voffA);
            PG8_BAR; PG8_WAIT_L(0); PG8_MMA(1, 0, At, B0); PG8_BAR; PG8_SCHED;
            PG8_STAGE(PG8_SB(1, 1), b3 + hstep, voffB);
            PG8_WAIT_V(6); PG8_BAR; PG8_MMA(1, 1, At, B1); PG8_BAR;
            }
        }
        if constexpr (ALIGN_EPI) { if (wr == 0) PG8_BAR; }
        if constexpr (!Epi::AFTER_DRAIN) { E(acc, cur, wr, wc, fr, fq); S.done(cur);
#if PG8_EPI_DRAIN
            PG8_WAIT_V(0);
#endif
        }
        if (!has_next) break;
#pragma unroll
        for (int a = 0; a < 2; ++a)
#pragma unroll
            for (int b = 0; b < 2; ++b)
#pragma unroll
                for (int m = 0; m < 4; ++m)
#pragma unroll
                    for (int n = 0; n < 2; ++n) acc[a][b][m][n] = (f32x4){0.f, 0.f, 0.f, 0.f};
        cur = nxt; cA = nA; cB = nB; ++ui;
        if constexpr (ALIGN_EPI) { if (wr == 1) PG8_BAR; }
    }
    PG8_WAIT_V(0);
    if constexpr (!ALIGN_EPI) { if (wr == 0) PG8_BAR; }
    PG8_BAR;
    if constexpr (Epi::AFTER_DRAIN) { E.fused(acc, cur, wr, wc, fr, fq, lds, wid, lane); S.done(cur); }
#undef PG8_SA
#undef PG8_SB
#undef PG8_STAGE
#undef PG8_LDA
#undef PG8_LDB
#undef PG8_MMA
#undef PG8_WAIT_V
#undef PG8_WAIT_L
#undef PG8_BAR
#undef PG8_SCHED
}
}

#include <hip/hip_bf16.h>
#include <cmath>
namespace attn_body {
using bf16=__hip_bfloat16;
using bf16x8=__attribute__((ext_vector_type(8)))short;
using s16x4=__attribute__((ext_vector_type(4)))short;
using f32x16=__attribute__((ext_vector_type(16)))float;
using u32x4=__attribute__((ext_vector_type(4)))unsigned;
typedef float f32x4_t __attribute__((ext_vector_type(4)));
constexpr int BATCH=8,NHEAD=8,SEQ=4096,D=64,DM=NHEAD*D;
constexpr int NW=8,QBLK=32,QB=QBLK*NW,KVBLK=64,NQB=SEQ/QB;
constexpr int ATTN_PITCH=DM, ATTN_UNIT_ROWS=QB;
__device__ __forceinline__ int crow(int r,int hi){return (r&3)+8*(r>>2)+4*hi;}
#define SBAR() __builtin_amdgcn_sched_barrier(0)
__device__ __forceinline__ void cmask(f32x16&p0,f32x16&p1,int jb,int qrel,int hi){
  const float NEG=-INFINITY; int kb=64*jb+4*hi;
  #pragma unroll
  for(int r=0;r<16;++r){int kv=kb+(r&3)+8*(r>>2); if(kv>qrel)p0[r]=NEG; if(kv+32>qrel)p1[r]=NEG;}
}

constexpr int NSLOT=3, SLOTB=8192;
constexpr int LDS_K=0, LDS_V=NSLOT*SLOTB, LDS_WS=2*NSLOT*SLOTB, LDS_OST=LDS_WS+NW*64*4, LDS_KM=LDS_OST+NW*4096, LDS_BYTES=LDS_KM+4096;
constexpr float C2=0.125f*1.4426950408889634f;
__device__ __forceinline__ void glds16(const void*gsrc,unsigned lds_dst){unsigned keep;
  asm volatile("s_mov_b32 %0, m0\n\ts_mov_b32 m0, %2\n\ts_nop 0\n\tglobal_load_lds_dwordx4 %1, off\n\ts_mov_b32 m0, %0":"=&s"(keep):"v"(gsrc),"s"(lds_dst):"memory");}
__device__ __forceinline__ float max3f(float a,float b,float c){float r;asm("v_max3_f32 %0, %1, %2, %3":"=v"(r):"v"(a),"v"(b),"v"(c));return r;}
__device__ __forceinline__ float max2f(float a,float b){float r;asm("v_max_f32_e32 %0, %1, %2":"=v"(r):"v"(a),"v"(b));return r;}
__device__ __forceinline__ float fadd_s(float a,float b){float r;asm("v_add_f32_e32 %0, %1, %2":"=v"(r):"v"(a),"v"(b));return r;}
__device__ __forceinline__ float fsub_s(float a,float b){float r;asm("v_sub_f32_e32 %0, %1, %2":"=v"(r):"v"(a),"v"(b));return r;}
typedef float f32x2_t __attribute__((ext_vector_type(2))); typedef __bf16 bf16x2_t __attribute__((ext_vector_type(2)));
__device__ __forceinline__ unsigned cvtpk_s(float lo,float hi){f32x2_t v={lo,hi};bf16x2_t b=__builtin_convertvector(v,bf16x2_t);return __builtin_bit_cast(unsigned,b);}
#define WAIT_BAR(N) asm volatile("s_waitcnt vmcnt(" #N ") lgkmcnt(0)\n\ts_barrier":::"memory")

__device__ __forceinline__ void qkt(f32x16&p0,f32x16&p1,const char*Kslot,const bf16x8*qr,int r32,int hi){
  const char*kb=Kslot+hi*1024+r32*16;
  #pragma unroll
  for(int d0=0;d0<4;++d0){
    const bf16x8 b0=*reinterpret_cast<const bf16x8*>(kb+d0*2048);
    const bf16x8 b1=*reinterpret_cast<const bf16x8*>(kb+d0*2048+512);
    p0=__builtin_amdgcn_mfma_f32_32x32x16_bf16(b0,qr[d0],p0,0,0,0);p1=__builtin_amdgcn_mfma_f32_32x32x16_bf16(b1,qr[d0],p1,0,0,0);}
}
typedef __attribute__((address_space(3))) const char* lds_cptr;
typedef short v4i16_t __attribute__((ext_vector_type(4)));
__device__ __forceinline__ void kload8(bf16x8*kf,lds_cptr kp){
  kf[0]=*(const __attribute__((address_space(3))) bf16x8*)(kp);      kf[1]=*(const __attribute__((address_space(3))) bf16x8*)(kp+512);
  kf[2]=*(const __attribute__((address_space(3))) bf16x8*)(kp+2048); kf[3]=*(const __attribute__((address_space(3))) bf16x8*)(kp+2560);
  kf[4]=*(const __attribute__((address_space(3))) bf16x8*)(kp+4096); kf[5]=*(const __attribute__((address_space(3))) bf16x8*)(kp+4608);
  kf[6]=*(const __attribute__((address_space(3))) bf16x8*)(kp+6144); kf[7]=*(const __attribute__((address_space(3))) bf16x8*)(kp+6656);
}
__device__ __forceinline__ void kload2(bf16x8*kf,lds_cptr kp,int j){ kf[2*j]=*(const __attribute__((address_space(3))) bf16x8*)(kp+j*2048); kf[2*j+1]=*(const __attribute__((address_space(3))) bf16x8*)(kp+j*2048+512); }
__device__ __forceinline__ s16x4 vtr(lds_cptr p){ return __builtin_bit_cast(s16x4,__builtin_amdgcn_ds_read_tr16_b64_v4i16((__attribute__((address_space(3))) v4i16_t*)p)); }
__device__ __forceinline__ float rowmax(const f32x16&p0,const f32x16&p1){
  float a=max3f(p0[0],p0[1],p1[0]),b=max3f(p0[2],p0[3],p1[1]);a=max3f(a,p1[2],p1[3]);
  #pragma unroll
  for(int r=4;r<16;r+=4){a=max3f(a,p0[r],p0[r+1]);b=max3f(b,p0[r+2],p0[r+3]);a=max3f(a,p1[r],p1[r+1]);b=max3f(b,p1[r+2],p1[r+3]);}
  const float m=max2f(a,b);
  auto rr=__builtin_amdgcn_permlane32_swap(__float_as_uint(m),__float_as_uint(m),false,false);
  return max2f(__uint_as_float(rr[0]),__uint_as_float(rr[1]));
}
__device__ __forceinline__ void pv(f32x16*o,int vb,bf16x8 pa0,bf16x8 pa1,bf16x8 pa2,bf16x8 pa3){
  #pragma unroll
  for(int d0=0;d0<2;++d0){s16x4 lo[4],hi[4];
    #pragma unroll
    for(int ks=0;ks<4;++ks){
      asm volatile("ds_read_b64_tr_b16 %0,%1 offset:%c2":"=&v"(lo[ks]):"v"(vb),"i"(d0*4096+ks*1024):"memory");
      asm volatile("ds_read_b64_tr_b16 %0,%1 offset:%c2":"=&v"(hi[ks]):"v"(vb),"i"(d0*4096+ks*1024+512):"memory");}
    asm volatile("s_waitcnt lgkmcnt(0)":::"memory");SBAR();
    #define PK(k) (bf16x8){lo[k][0],lo[k][1],lo[k][2],lo[k][3],hi[k][0],hi[k][1],hi[k][2],hi[k][3]}
    o[d0]=__builtin_amdgcn_mfma_f32_32x32x16_bf16(pa0,PK(0),o[d0],0,0,0);
    o[d0]=__builtin_amdgcn_mfma_f32_32x32x16_bf16(pa1,PK(1),o[d0],0,0,0);
    o[d0]=__builtin_amdgcn_mfma_f32_32x32x16_bf16(pa2,PK(2),o[d0],0,0,0);
    o[d0]=__builtin_amdgcn_mfma_f32_32x32x16_bf16(pa3,PK(3),o[d0],0,0,0);
    #undef PK
  }
}

#ifndef ATTN_STORE16
#define ATTN_STORE16(p,v) (*(u32x4*)(p)=(v))
#endif
template<int THRL> __device__ __forceinline__ void attn_unit(int b,int h,int qb,const bf16*Q,const bf16*__restrict__ K,const bf16*__restrict__ V,bf16*O,const float*kmean,char*shm){
  const int tid=threadIdx.x,lane=tid&63,r32=lane&31,hi=lane>>5; const int wid=__builtin_amdgcn_readfirstlane(tid>>6);
  const long rowbase=(long)b*SEQ; const int q0=qb*QB;
  const bf16*Qw=Q+(rowbase+q0+wid*QBLK)*DM+h*D;
  const bf16*Kh=K+rowbase*DM+h*D,*Vh=V+rowbase*DM+h*D;
  const unsigned lds0=(unsigned)(uintptr_t)shm;
  float*wsf=(float*)(shm+LDS_WS)+wid*64;
  const bf16*ksrc=Kh+(long)lane*DM+wid*8;
  const bf16*vsrc=Vh+(long)(16*(wid&3)+(lane>>2))*DM+(wid>>2)*32+(lane&3)*8;
  const unsigned kdst=lds0+LDS_K+wid*1024, vdst=lds0+LDS_V+wid*1024;
  #define POS(t) (((t)<4)?(NT-4+(t)):((t)-4))
  #define DMA_K(t,slot) glds16(ksrc+(long)POS(t)*KVBLK*DM,(unsigned)__builtin_amdgcn_readfirstlane(kdst+(slot)))
  #define DMA_V(t,slot) glds16(vsrc+(long)POS(t)*KVBLK*DM,(unsigned)__builtin_amdgcn_readfirstlane(vdst+(slot)))
  const int vb0=(int)(lds0+LDS_V)+((lane>>4)&1)*32+(lane&3)*8+(4*hi+((lane&15)>>2))*64;
  const char*Kbase=shm+LDS_K; bf16x8 kf[8];
  const lds_cptr shm3=(lds_cptr)shm; const lds_cptr kp0=shm3+LDS_K+hi*1024+r32*16; const lds_cptr vp0=shm3+LDS_V+((lane>>4)&1)*32+(lane&3)*8+(4*hi+((lane&15)>>2))*64;
  const int NT=(q0+QB)/KVBLK;
  DMA_K(0,0);DMA_V(0,0);DMA_K(1,SLOTB);
  bf16x8 qr[4];
  #pragma unroll
  for(int d0=0;d0<4;++d0)qr[d0]=*reinterpret_cast<const bf16x8*>(&Qw[(long)r32*DM+d0*16+hi*8]);
  float mhat=0.f,l_reg=0.f;f32x16 o[2];o[0]=f32x16{};o[1]=f32x16{};
  const float slope2=ldexpf(1.4426950408889634f,-(h+1));
  unsigned selmask=0u;
  { typedef __attribute__((address_space(3))) float* lds_fptr; typedef __attribute__((address_space(3))) const f32x4_t* lds_f4ptr;
    lds_fptr kml=(lds_fptr)((lds_cptr)shm+LDS_KM);
    { const float*src=kmean+((long)b*16)*2*DM+h*D;
      #pragma unroll
      for(int i=0;i<2;++i){const int e=tid+512*i; kml[e]=src[(e>>6)*2*DM+(e&63)]+src[(e>>6)*2*DM+DM+(e&63)];} }
    asm volatile("s_waitcnt vmcnt(0) lgkmcnt(0)\n\ts_barrier":::"memory");
    float qf[32];
    #pragma unroll
    for(int d0=0;d0<4;++d0){
      #pragma unroll
      for(int j=0;j<8;++j)qf[d0*8+j]=__uint_as_float(((unsigned)(unsigned short)qr[d0][j])<<16);}
    float sc[16];
    #pragma unroll
    for(int j=0;j<16;++j){ sc[j]=-INFINITY;
      if(j<qb){ lds_f4ptr kr=(lds_f4ptr)(kml+j*64+hi*8); float a=0.f;
        #pragma unroll
        for(int d0=0;d0<4;++d0){ const f32x4_t k0=kr[d0*4],k1=kr[d0*4+1];
          a+=qf[d0*8+0]*k0[0]+qf[d0*8+1]*k0[1]+qf[d0*8+2]*k0[2]+qf[d0*8+3]*k0[3]+qf[d0*8+4]*k1[0]+qf[d0*8+5]*k1[1]+qf[d0*8+6]*k1[2]+qf[d0*8+7]*k1[3]; }
        a+=__shfl_xor(a,32); sc[j]=a; } }
    #pragma unroll
    for(int j=0;j<15;++j){ int cnt=0;
      #pragma unroll
      for(int k=0;k<15;++k){ if(k!=j) cnt+=((sc[k]>sc[j])||((sc[k]==sc[j])&&(k<j)))?1:0; }
      if(j<qb&&cnt<3) selmask|=(1u<<j); } }
  #define CINIT(C0,C1,t) do{ const int pt_=POS(t); float x_=slope2*(float)(64*pt_-q0+4*hi)-mhat; \
    if((t)>=4){ x_+=((selmask>>(pt_>>2))&1u)?0.f:-30000.f; } const float y_=x_+32.f*slope2; \
    _Pragma("unroll") for(int r=0;r<16;++r){ const float cr_=(float)((r&3)+8*(r>>2)); C0[r]=__builtin_fmaf(slope2,cr_,x_); C1[r]=__builtin_fmaf(slope2,cr_,y_); } }while(0)

  const int qrel=wid*QBLK+r32;
  #define CMASK(P0,P1,t) do{ if((t)<4)cmask(P0,P1,(t),qrel,hi);}while(0)
  bool resc=false;
  #define START(P0,P1) do{ const float rm=rowmax(P0,P1); resc=false; \
    { const float dl=rm; mhat=fadd_s(mhat,dl); \
      _Pragma("unroll") for(int r=0;r<16;++r){P0[r]=fsub_s(P0[r],dl);P1[r]=fsub_s(P1[r],dl);} } \
    _Pragma("unroll") for(int r=0;r<16;++r)P0[r]=__builtin_amdgcn_exp2f(P0[r]); }while(0)
  #define RESC() do{ if(resc){ asm volatile("s_waitcnt lgkmcnt(0)":::"memory"); \
      _Pragma("unroll") for(int d_=0;d_<2;++d_) _Pragma("unroll") for(int r=0;r<16;++r)o[d_][r]*=wsf[crow(r,hi)]; } }while(0)
  f32x16 pA0,pA1,pB0,pB1;
  int sl_prev=0,sl_cur=0,sl_next=SLOTB;
  #define ROT() do{sl_prev=sl_cur;sl_cur=sl_next;sl_next=(sl_next==(NSLOT-1)*SLOTB)?0:sl_next+SLOTB;}while(0)
  DMA_K(2,2*SLOTB);
  WAIT_BAR(3);
  CINIT(pA0,pA1,0); qkt(pA0,pA1,Kbase,qr,r32,hi);asm volatile("s_nop 15\n\ts_nop 7":"+v"(pA0),"+v"(pA1));CMASK(pA0,pA1,0);
  START(pA0,pA1);
  _Pragma("unroll") for(int r=0;r<16;++r)pA1[r]=__builtin_amdgcn_exp2f(pA1[r]);
  WAIT_BAR(0);
  DMA_K(3,0);DMA_V(1,SLOTB);
  ROT();
  kload8(kf,kp0+sl_cur);
  WAIT_BAR(2);
  s16x4 vlo[8],vhi[8]; u32x4 pw0,pw1,pw2,pw3;
  #define PKW(P,B) cvtpk_s(P[B],P[B+1])
  #define PAF(k) __builtin_bit_cast(bf16x8,pw##k)
  #define VFR(i) (bf16x8){vlo[i][0],vlo[i][1],vlo[i][2],vlo[i][3],vhi[i][0],vhi[i][1],vhi[i][2],vhi[i][3]}
  #define PIN(x) asm volatile("":"+v"(x))
  #define MX3(a,b,c) __builtin_fmaxf(__builtin_fmaxf((a),(b)),(c))
  #define GAPA(MF,A0,A1,A2,A3,W0,W1,PW) do{ MF; sacc+=A0; sacc+=A1; sacc+=A2; sacc+=A3; PIN(sacc); W0; W1; PIN(PW); SBAR(); }while(0)
  #define EX(v) __builtin_amdgcn_exp2f(v)
  #define GAPB(MF,X,B) do{ MF; X[B]=EX(X[B]); X[B+1]=EX(X[B+1]); X[B+2]=EX(X[B+2]); X[B+3]=EX(X[B+3]); PIN(X); SBAR(); }while(0)
  #define VRD(i) do{ vlo[i]=vtr(vp_+(((i)>>2)*4096+((i)&3)*1024)); vhi[i]=vtr(vp_+(((i)>>2)*4096+((i)&3)*1024+512)); }while(0)
  #define KRD(G,j) do{ if(G){ kload2(kf,kp0+sl_next,j); SBAR(); } }while(0)
  #define STEP(C0,C1,P0,P1,t,GK,GV,GL) do{ SBAR(); CINIT(C0,C1,t); PIN(C0); PIN(C1); SBAR(); \
    const lds_cptr vp_=vp0+sl_prev; \
    VRD(0); SBAR(); float sacc=(P0[0]+P0[1]); \
    GAPA(C0=__builtin_amdgcn_mfma_f32_32x32x16_bf16(kf[0],qr[0],C0,0,0,0), P0[2],P0[3],P0[4],P0[5],     pw0[0]=PKW(P0,0), pw0[1]=PKW(P0,2), pw0); \
    VRD(4); SBAR(); GAPA(C1=__builtin_amdgcn_mfma_f32_32x32x16_bf16(kf[1],qr[0],C1,0,0,0), P0[6],P0[7],P0[8],P0[9],     pw0[2]=PKW(P0,4), pw0[3]=PKW(P0,6), pw0); \
    VRD(1); SBAR(); GAPA(C0=__builtin_amdgcn_mfma_f32_32x32x16_bf16(kf[2],qr[1],C0,0,0,0),   P0[10],P0[11],P0[12],P0[13], pw1[0]=PKW(P0,8), pw1[1]=PKW(P0,10), pw1); \
    VRD(5); SBAR(); GAPA(C1=__builtin_amdgcn_mfma_f32_32x32x16_bf16(kf[3],qr[1],C1,0,0,0),   P0[14],P0[15],P1[0],P1[1],   pw1[2]=PKW(P0,12),pw1[3]=PKW(P0,14), pw1); \
    VRD(2); SBAR(); GAPA(C0=__builtin_amdgcn_mfma_f32_32x32x16_bf16(kf[4],qr[2],C0,0,0,0),   P1[2],P1[3],P1[4],P1[5],     pw2[0]=PKW(P1,0), pw2[1]=PKW(P1,2), pw2); \
    VRD(6); SBAR(); GAPA(C1=__builtin_amdgcn_mfma_f32_32x32x16_bf16(kf[5],qr[2],C1,0,0,0),   P1[6],P1[7],P1[8],P1[9],     pw2[2]=PKW(P1,4), pw2[3]=PKW(P1,6), pw2); \
    VRD(3); SBAR(); GAPA(C0=__builtin_amdgcn_mfma_f32_32x32x16_bf16(kf[6],qr[3],C0,0,0,0),   P1[10],P1[11],P1[12],P1[13], pw3[0]=PKW(P1,8), pw3[1]=PKW(P1,10), pw3); \
    VRD(7); SBAR(); GAPA(C1=__builtin_amdgcn_mfma_f32_32x32x16_bf16(kf[7],qr[3],C1,0,0,0),   P1[14],P1[15],0.f,0.f,       pw3[2]=PKW(P1,12),pw3[3]=PKW(P1,14), pw3); \
    l_reg+=sacc; \
    if(GK){DMA_K((t)+3,sl_cur);} if(GV){DMA_V((t)+1,sl_next);} \
    CMASK(C0,C1,t); \
    { float a=MX3(C0[0],C0[1],C1[0]),b=MX3(C0[2],C0[3],C1[1]); a=MX3(a,C1[2],C1[3]); \
      _Pragma("unroll") for(int r=4;r<16;r+=4){a=MX3(a,C0[r],C0[r+1]);b=MX3(b,C0[r+2],C0[r+3]);a=MX3(a,C1[r],C1[r+1]);b=MX3(b,C1[r+2],C1[r+3]);} \
      float rm=__builtin_fmaxf(a,b); { auto rr=__builtin_amdgcn_permlane32_swap(__float_as_uint(rm),__float_as_uint(rm),false,false); rm=__builtin_fmaxf(__uint_as_float(rr[0]),__uint_as_float(rr[1])); } \
      resc=false; \
      if(__builtin_expect(__any(rm>(float)THRL),0)){ const float dl=__builtin_fmaxf(rm,0.f); mhat+=dl; \
        _Pragma("unroll") for(int r=0;r<16;++r){C0[r]-=dl;C1[r]-=dl;} \
        const float f=__builtin_amdgcn_exp2f(-dl); l_reg*=f; if(hi==0)wsf[r32]=f; resc=true; } } \
    SBAR(); \
    GAPB(o[0]=__builtin_amdgcn_mfma_f32_32x32x16_bf16(PAF(0),VFR(0),o[0],0,0,0), C0,0); \
    GAPB(o[1]=__builtin_amdgcn_mfma_f32_32x32x16_bf16(PAF(0),VFR(4),o[1],0,0,0), C0,4); \
    KRD(GL,0); GAPB(o[0]=__builtin_amdgcn_mfma_f32_32x32x16_bf16(PAF(1),VFR(1),o[0],0,0,0), C0,8); \
    KRD(GL,1); GAPB(o[1]=__builtin_amdgcn_mfma_f32_32x32x16_bf16(PAF(1),VFR(5),o[1],0,0,0), C0,12); \
    KRD(GL,2); GAPB(o[0]=__builtin_amdgcn_mfma_f32_32x32x16_bf16(PAF(2),VFR(2),o[0],0,0,0), C1,0); \
    KRD(GL,3); GAPB(o[1]=__builtin_amdgcn_mfma_f32_32x32x16_bf16(PAF(2),VFR(6),o[1],0,0,0), C1,4); \
    GAPB(o[0]=__builtin_amdgcn_mfma_f32_32x32x16_bf16(PAF(3),VFR(3),o[0],0,0,0), C1,8); \
    GAPB(o[1]=__builtin_amdgcn_mfma_f32_32x32x16_bf16(PAF(3),VFR(7),o[1],0,0,0), C1,12); \
    }while(0)
  int t=1;
  #define ENDW(tt) do{ if((tt)+3<NT){WAIT_BAR(2);} else if((tt)+2<NT){WAIT_BAR(1);} else {WAIT_BAR(0);} }while(0)
  for(;t<5&&t+1<NT;t+=2){
    STEP(pB0,pB1,pA0,pA1,t,(t+3<NT),(t+1<NT),(t+1<NT));       ENDW(t);   RESC(); ROT();
    STEP(pA0,pA1,pB0,pB1,t+1,(t+4<NT),(t+2<NT),(t+2<NT));     ENDW(t+1); RESC(); ROT();
  }
  #undef CMASK
  #define CMASK(P0,P1,t) do{}while(0)
  for(;t+5<NT;t+=2){
    STEP(pB0,pB1,pA0,pA1,t,true,true,true);     WAIT_BAR(2); RESC(); ROT();
    STEP(pA0,pA1,pB0,pB1,t+1,true,true,true);   WAIT_BAR(2); RESC(); ROT();
  }
  for(;t+1<NT;t+=2){
    STEP(pB0,pB1,pA0,pA1,t,(t+3<NT),(t+1<NT),(t+1<NT));       ENDW(t);   RESC(); ROT();
    STEP(pA0,pA1,pB0,pB1,t+1,(t+4<NT),(t+2<NT),(t+2<NT));     ENDW(t+1); RESC(); ROT();
  }
  #undef CMASK
  #define CMASK(P0,P1,t) do{ if((t)<4)cmask(P0,P1,(t),qrel,hi);}while(0)
  STEP(pB0,pB1,pA0,pA1,NT-1,false,false,false); RESC();
  { float sacc=pB0[0]+pB0[1]; _Pragma("unroll") for(int r=2;r<16;++r)sacc+=pB0[r]; _Pragma("unroll") for(int r=0;r<16;++r)sacc+=pB1[r]; l_reg+=sacc;
    pw0=(u32x4){PKW(pB0,0),PKW(pB0,2),PKW(pB0,4),PKW(pB0,6)};pw1=(u32x4){PKW(pB0,8),PKW(pB0,10),PKW(pB0,12),PKW(pB0,14)};pw2=(u32x4){PKW(pB1,0),PKW(pB1,2),PKW(pB1,4),PKW(pB1,6)};pw3=(u32x4){PKW(pB1,8),PKW(pB1,10),PKW(pB1,12),PKW(pB1,14)};
    SBAR(); pv(o,vb0+sl_cur,PAF(0),PAF(1),PAF(2),PAF(3)); }
  #undef PKW
  #undef PAF
  #undef VFR
  #undef PIN
  #undef MX3
  #undef GAPA
  #undef GAPB
  #undef EX
  #undef VRD
  #undef KRD
  #undef STEP
  #undef ENDW
  {auto rr=__builtin_amdgcn_permlane32_swap(__float_as_uint(l_reg),__float_as_uint(l_reg),false,false);l_reg=__uint_as_float(rr[0])+__uint_as_float(rr[1]);}
  if(hi==0)wsf[32+r32]=l_reg;asm volatile("s_waitcnt lgkmcnt(0)":::"memory");
  float rli[16];
  #pragma unroll
  for(int r=0;r<16;++r)rli[r]=__builtin_amdgcn_rcpf(wsf[32+crow(r,hi)]);
  bf16*Ow=O+(rowbase+q0+wid*QBLK)*DM+h*D;
  { bf16*stg=(bf16*)(shm+LDS_OST)+wid*2048;
    #pragma unroll
    for(int r=0;r<16;++r){const int orow=crow(r,hi);
      #pragma unroll
      for(int d0=0;d0<2;++d0)stg[orow*64+d0*32+r32]=__float2bfloat16(o[d0][r]*rli[r]);}
    asm volatile("s_waitcnt lgkmcnt(0)":::"memory");
    #pragma unroll
    for(int i=0;i<4;++i){const int row=i*8+(lane>>3),ch=lane&7; const u32x4 v=*(const u32x4*)(stg+row*64+ch*8); ATTN_STORE16(Ow+(long)row*DM+ch*8,v);} }
  asm volatile("s_waitcnt lgkmcnt(0)\n\ts_barrier":::"memory");
  #undef DMA_K
  #undef DMA_V
  #undef POS
  #undef CINIT
  #undef CMASK
  #undef START
  #undef RESC
  #undef ROT
}
constexpr int ATTN_LDS_BYTES=LDS_BYTES;
struct AttnTensors { const bf16* Q; const bf16* K; const bf16* V; bf16* O; const float* kmean; };
struct AttnUnit { int bh; int qb; };
struct StaticOrder {
  int vcu,grid;
  __device__ __forceinline__ explicit StaticOrder(int grid_,int block):vcu((grid_%8==0)?((block%8)*(grid_/8)+block/8):block),grid(grid_){}
  __device__ __forceinline__ bool next(int i,AttnUnit&u)const{ const int item=(i>>1)*grid+vcu; if(item>=BATCH*NHEAD*8)return false; const int s=item&7; u.bh=item>>3; u.qb=(i&1)?15-s:s; return true; }
  __device__ __forceinline__ void a_ready(const AttnUnit&)const{}
  __device__ __forceinline__ void done(const AttnUnit&)const{}
};
template<class Sched,int THRL=8> __device__ __forceinline__ void attn_phase(char*lds,const AttnTensors&T,const Sched&S){
  AttnUnit u;
  for(int i=0;S.next(i,u);++i){ S.a_ready(u); attn_unit<THRL>(u.bh/NHEAD,u.bh%NHEAD,u.qb,T.Q,T.K,T.V,T.O,T.kmean,lds); S.done(u); }
}
#undef SBAR
#undef WAIT_BAR
}

constexpr int NWAVES = 8;
#ifndef MK_N_LAUNCHES
#define MK_N_LAUNCHES 1
#endif
constexpr int N_LAUNCHES = MK_N_LAUNCHES;
constexpr int PER_PHASE = 8;

constexpr int BATCH = 8, SEQ = 4096, DM = 1024, TOK = BATCH * SEQ;
constexpr int CONV_CH = 512, CONV_W = 31, ATT_W = 512, IN_COLS = 4608;
constexpr int P_HEADS = 8, P_NK = 128, P_TOPK = 16, P_E = P_HEADS * P_TOPK  , N_EXP = P_NK * P_NK;
constexpr float NORM_EPS = 1e-6f;

constexpr size_t MiB = 1u << 20;
constexpr size_t WS_CTL = 0, CTL_ZERO_BYTES = 2 * MiB;
constexpr size_t WS_KMEAN = 1 * MiB;
constexpr size_t WS_SS = 2 * MiB;
constexpr size_t WS_WIN = 4 * MiB;
constexpr size_t WS_WPW = 13 * MiB, WS_WAO = 14 * MiB;
constexpr size_t WS_WOUT = 15 * MiB;
constexpr size_t WS_WQ = 17 * MiB;
constexpr size_t WS_KEYS = 21 * MiB;
constexpr size_t WS_UB = 24 * MiB, WS_VB = 56 * MiB;
constexpr size_t WS_H = 88 * MiB;
constexpr size_t WS_CACT = 88 * MiB;
constexpr size_t WS_EIDX = 120 * MiB, WS_GW = 136 * MiB;
constexpr size_t WS_ZGLU = 152 * MiB, WS_QO = 184 * MiB, WS_K = 216 * MiB, WS_V = 248 * MiB;
constexpr size_t WS_MIX = 216 * MiB;
constexpr size_t WS_QP = 152 * MiB;
constexpr size_t WS_GC = 280 * MiB, WS_GA = 344 * MiB;
constexpr size_t WS_X1B = 280 * MiB;
constexpr size_t WS_END = 408 * MiB;
constexpr int CW_TMO = 0, CW_CODE = 1, CW_BAR = 4096;

constexpr int RING_OFF = 0, RING_BYTES = 131072;
constexpr int LDSCTL_OFF = RING_BYTES, MISC_OFF = LDSCTL_OFF + 320;
constexpr int LDS_BYTES = 147456;
static_assert(MISC_OFF + 128 <= LDS_BYTES, "LDS map");

#define GAS __attribute__((address_space(1)))
#define LAS __attribute__((address_space(3)))
typedef unsigned short bf16;
typedef unsigned v4u __attribute__((ext_vector_type(4)));
typedef float f32x4 __attribute__((ext_vector_type(4)));
typedef float f32x16 __attribute__((ext_vector_type(16)));
typedef short bf16x8 __attribute__((ext_vector_type(8)));
typedef __bf16 bf16x2_t __attribute__((ext_vector_type(2)));
typedef GAS unsigned gu32;
#define RLX_AGENT __ATOMIC_RELAXED, __HIP_MEMORY_SCOPE_AGENT
#define LDS_WAIT() asm volatile("s_waitcnt lgkmcnt(0)" ::: "memory")
#define VM_WAIT() asm volatile("s_waitcnt vmcnt(0)" ::: "memory")
__device__ __forceinline__ unsigned f2bf(float f) { unsigned u = __builtin_bit_cast(unsigned, f); return (u + 0x7fffu + ((u >> 16) & 1u)) >> 16; }
__device__ __forceinline__ unsigned pk2(float lo, float hi) { return f2bf(lo) | (f2bf(hi) << 16); }
__device__ __forceinline__ float bflo(unsigned u) { return __uint_as_float(u << 16); }
__device__ __forceinline__ float bfhi(unsigned u) { return __uint_as_float(u & 0xffff0000u); }

#define XB_TMO      128
#define XB_XCNT(j)  (256  + 64 * (j))
#define XB_XSUB(j)  (1280 + 64 * (j))
#define XB_XGEN(j)  (2304 + 64 * (j))
#define XB_TOP      3328
#define XB_TOPGEN   3392
#define XCD_BAR_WORDS 3456
#define XB_SPIN_CAP (1u << 18)

__device__ __forceinline__ unsigned xb_ld(unsigned* p)              { return __hip_atomic_load(p, __ATOMIC_RELAXED, __HIP_MEMORY_SCOPE_AGENT); }
__device__ __forceinline__ unsigned xb_add(unsigned* p, unsigned v) { return __hip_atomic_fetch_add(p, v, __ATOMIC_RELAXED, __HIP_MEMORY_SCOPE_AGENT); }
__device__ __forceinline__ unsigned xb_xcc_id() { return (unsigned)__builtin_amdgcn_s_getreg((3 << 11) | 20) & 0xFu; }
#define XB_SPIN(cond, bar) do { unsigned _sp = 0; while (cond) { __builtin_amdgcn_s_sleep(1); \
    if ((++_sp & 255u) == 0u) { if (xb_ld(&(bar)[XB_TMO])) break; if (_sp > XB_SPIN_CAP) { atomicAdd(&(bar)[XB_TMO], 1u); break; } } } } while (0)

struct XcdBarrier {
    unsigned* bar; unsigned x;
    volatile LAS unsigned* st;
};

__device__ __forceinline__ XcdBarrier xcd_barrier_post(unsigned* bar, volatile LAS unsigned* st) {
    XcdBarrier b; b.bar = bar; b.x = xb_xcc_id(); b.st = st;
    if (threadIdx.x == 0) (void)xb_add(&bar[XB_XCNT(b.x)], 1u);
    return b;
}
__device__ __forceinline__ void xcd_barrier_complete(unsigned* bar, unsigned x, unsigned& nloc, unsigned& nx) {
    const unsigned G = gridDim.x * gridDim.y * gridDim.z;
    unsigned sum, cnt, mine, sp = 0u;
    for (;;) {
        sum = 0u; cnt = 0u; mine = 0u;
#pragma unroll
        for (unsigned j = 0; j < 16; ++j) { const unsigned c = xb_ld(&bar[XB_XCNT(j)]); sum += c; cnt += (c > 0u) ? 1u : 0u; mine = (j == x) ? c : mine; }
        if (sum == G) break;
        __builtin_amdgcn_s_sleep(1);
        if ((++sp & 255u) == 0u) { if (xb_ld(&bar[XB_TMO])) break; if (sp > XB_SPIN_CAP) { atomicAdd(&bar[XB_TMO], 1u); break; } }
    }
    nloc = mine > 0u ? mine : 1u; nx = cnt > 0u ? cnt : 1u;
}

__device__ __forceinline__ void xcd_barrier(const XcdBarrier& b) {
    asm volatile("s_waitcnt vmcnt(0)" ::: "memory");
    __syncthreads();
    if (threadIdx.x == 0) {
        unsigned* bar = b.bar;
        __builtin_amdgcn_s_waitcnt(0);
        unsigned nloc = b.st[0], nx = b.st[1];
        if (nloc == 0u) { xcd_barrier_complete(bar, b.x, nloc, nx); b.st[0] = nloc; b.st[1] = nx; }
        const unsigned old = xb_add(&bar[XB_XSUB(b.x)], 1u);
        const unsigned gen = old / nloc;
        if (old + 1u == (gen + 1u) * nloc) {
            __builtin_amdgcn_fence(__ATOMIC_RELEASE, "agent");
            asm volatile("s_waitcnt vmcnt(0)" ::: "memory");
            const unsigned og = xb_add(&bar[XB_TOP], 1u);
            const unsigned tg = og / nx;
            if (og + 1u == (tg + 1u) * nx) xb_add(&bar[XB_TOPGEN], 1u);
            else XB_SPIN(xb_ld(&bar[XB_TOPGEN]) == tg, bar);
            __builtin_amdgcn_fence(__ATOMIC_ACQUIRE, "agent");
            xb_add(&bar[XB_XGEN(b.x)], 1u);
            asm volatile("s_waitcnt vmcnt(0)" ::: "memory");
        } else {
            XB_SPIN(xb_ld(&bar[XB_XGEN(b.x)]) == gen, bar);
            __builtin_amdgcn_fence(__ATOMIC_ACQUIRE, "agent");
            asm volatile("s_waitcnt vmcnt(0)" ::: "memory");
        }
    }
    __syncthreads();
}

struct Frame {
    LAS unsigned char* lds;
    volatile LAS unsigned* MISC;
    gu32* ctl;
    int tid, lane, wave;
    int vcu, G;
};
__device__ __forceinline__ float wave_sum(float v) {
#pragma unroll
    for (int o = 1; o < 64; o <<= 1) v += __shfl_xor(v, o);
    return v;
}

__device__ __forceinline__ void p0_transpose_item(const float* W, int K, int N, bf16* WT, int k0, int n0, int dst_row0, const float* kscale, LAS float* scr, int lane) {
#pragma unroll 8
    for (int i = 0; i < 32; ++i) { const int kk = 2 * i + (lane >> 5); float v = W[(size_t)(k0 + kk) * N + n0 + (lane & 31)]; if (kscale) v *= kscale[k0 + kk]; scr[kk * 33 + (lane & 31)] = v; }
    LDS_WAIT(); asm volatile("" ::: "memory");
    const int c = lane & 7;
#pragma unroll
    for (int j = 0; j < 4; ++j) { const int n = (lane >> 3) + 8 * j; const LAS float* s = scr + (8 * c) * 33 + n;
        v4u o; o.x = pk2(s[0 * 33], s[1 * 33]); o.y = pk2(s[2 * 33], s[3 * 33]); o.z = pk2(s[4 * 33], s[5 * 33]); o.w = pk2(s[6 * 33], s[7 * 33]);
        *(GAS v4u*)(WT + (size_t)(dst_row0 + n) * K + k0 + 8 * c) = o; }
    LDS_WAIT(); asm volatile("" ::: "memory");
}
__device__ __forceinline__ int perm_in(int s) { if (s < 512) return 256 * (s >> 7) + (s & 127); if (s < 1024) { const int s2 = s - 512; return 256 * (s2 >> 7) + 128 + (s2 & 127); } return s; }
template <bool NORM> __device__ __forceinline__ void row_to_bf16(int lane, const float* xrow, const float* g, bf16* orow) {
    const GAS f32x4* xr = (const GAS f32x4*)xrow + lane;
    f32x4 v[4]; float s2 = 0.f;
#pragma unroll
    for (int j = 0; j < 4; ++j) { v[j] = xr[64 * j]; s2 += (v[j].x * v[j].x + v[j].y * v[j].y) + (v[j].z * v[j].z + v[j].w * v[j].w); }
    float rstd = 1.f;
    if (NORM) rstd = 1.f / sqrtf(wave_sum(s2) * (1.f / 1024.f) + NORM_EPS);
    GAS unsigned long long* o8 = (GAS unsigned long long*)orow + lane;
#pragma unroll
    for (int j = 0; j < 4; ++j) { f32x4 gv = (f32x4){1.f, 1.f, 1.f, 1.f}; if (g) gv = *((const GAS f32x4*)g + lane + 64 * j);
        const f32x4 w = v[j] * rstd * gv;
        o8[64 * j] = (unsigned long long)pk2(w.x, w.y) | ((unsigned long long)pk2(w.z, w.w) << 32); }
}
struct P0Args { const float *x, *g1, *w_in, *w_pw, *w_ao, *w_out, *g2, *w_q, *k1, *k2, *pu, *pv; bf16 *H, *Win, *Wpw, *Wao, *Wout, *Wq, *keys, *ub, *vb; };
__device__ __forceinline__ void p0_prologue(Frame& F, const P0Args& a) {
    LAS float* scr = (LAS float*)(F.lds + RING_OFF + F.wave * 16384);
    const int gw = F.vcu * NWAVES + F.wave, NGW = F.G * NWAVES;
    constexpr int I_IN = 16 * (IN_COLS / 32), I_PW = 8 * 32, I_AO = 8 * 32, I_OUT = 16 * 32, I_Q = 16 * 64;
    constexpr int NITEMS = I_IN + I_PW + I_AO + I_OUT + I_Q;
    for (int it = gw; it < NITEMS; it += NGW) {
        int r = it;
        if (r < I_IN) { const int nb = IN_COLS / 32, kb = r / nb, n0 = 32 * (r % nb); p0_transpose_item(a.w_in, 1024, IN_COLS, a.Win, 64 * kb, n0, perm_in(n0), nullptr, scr, F.lane); continue; } r -= I_IN;
        if (r < I_PW) { const int kb = r / 32, n0 = 32 * (r % 32); p0_transpose_item(a.w_pw, 512, 1024, a.Wpw, 64 * kb, n0, n0, nullptr, scr, F.lane); continue; } r -= I_PW;
        if (r < I_AO) { const int kb = r / 32, n0 = 32 * (r % 32); p0_transpose_item(a.w_ao, 512, 1024, a.Wao, 64 * kb, n0, n0, nullptr, scr, F.lane); continue; } r -= I_AO;
        if (r < I_OUT) { const int kb = r / 32, n0 = 32 * (r % 32); p0_transpose_item(a.w_out, 1024, 1024, a.Wout, 64 * kb, n0, n0, nullptr, scr, F.lane); continue; } r -= I_OUT;
        { const int kb = r / 64, n0 = 32 * (r % 64); p0_transpose_item(a.w_q, 1024, 2048, a.Wq, 64 * kb, n0, n0, a.g2, scr, F.lane); }
    }
    for (int m = gw; m < TOK; m += NGW) row_to_bf16<true>(F.lane, a.x + (size_t)m * 1024, a.g1, a.H + (size_t)m * 1024);
    for (int m = gw; m < N_EXP; m += NGW) { row_to_bf16<false>(F.lane, a.pu + (size_t)m * 1024, a.g2, a.ub + (size_t)m * 1024); row_to_bf16<false>(F.lane, a.pv + (size_t)m * 1024, nullptr, a.vb + (size_t)m * 1024); }
    for (int m = gw; m < 32; m += NGW) { const float* src = (m < 16 ? a.k1 : a.k2) + (size_t)(m & 15) * 1024; row_to_bf16<false>(F.lane, src, nullptr, a.keys + (size_t)m * 1024); }
}

struct ConvArgs { const bf16* zglu; const float *cw, *cb, *lg, *lb; bf16* cact; };
__device__ __forceinline__ void conv_phase(Frame& F, const ConvArgs& a) {
    LAS unsigned char* zs = F.lds + RING_OFF;
    LAS float* part = (LAS float*)(F.lds + RING_OFF + 98304);
    const int cp = F.tid & 255, half = F.tid >> 8, c0 = 2 * cp;
    float w0[CONV_W], w1[CONV_W];
    { const GAS float* p = (const GAS float*)(a.cw + c0);
#pragma unroll
      for (int w = 0; w < CONV_W; ++w) { w0[w] = p[0]; w1[w] = p[1]; p += 512; asm volatile("" : "+v"(p)); } }
    const float b0 = a.cb[c0], b1 = a.cb[c0 + 1], lg0 = a.lg[c0], lg1 = a.lg[c0 + 1], lb0 = a.lb[c0], lb1 = a.lb[c0 + 1];
    for (int tile = F.vcu; tile < TOK / 64; tile += F.G) {
        const int t0 = tile * 64, tb = t0 & (SEQ - 1);
        for (int i = F.tid; i < 94 * 64; i += 512) { const int r = i >> 6, ch = i & 63; v4u v = (v4u){0u, 0u, 0u, 0u};
            if (tb - 30 + r >= 0) v = *(const GAS v4u*)(a.zglu + (size_t)(t0 - 30 + r) * 512 + ch * 8);
            *(LAS v4u*)(zs + r * 1024 + ch * 16) = v; }
        __syncthreads();
        for (int ch8 = 0; ch8 < 4; ++ch8) {
            const int tl = half * 32 + ch8 * 8;
            float z0[38], z1[38];
#pragma unroll
            for (int i = 0; i < 38; ++i) { const unsigned u = *(const LAS unsigned*)(zs + (tl + i) * 1024 + cp * 4); z0[i] = bflo(u); z1[i] = bfhi(u); }
            float a0[8], a1[8];
#pragma unroll
            for (int k = 0; k < 8; ++k) { float s0 = b0, s1 = b1;
#pragma unroll
                for (int w = 0; w < CONV_W; ++w) { s0 += w0[w] * z0[k + w]; s1 += w1[w] * z1[k + w]; }
                a0[k] = s0; a1[k] = s1; }
#pragma unroll
            for (int k = 0; k < 8; ++k) { const float s1 = wave_sum(a0[k] + a1[k]), s2 = wave_sum(a0[k] * a0[k] + a1[k] * a1[k]);
                if (F.lane == 0) { part[((half * 8 + k) * 4 + (F.wave & 3)) * 2] = s1; part[((half * 8 + k) * 4 + (F.wave & 3)) * 2 + 1] = s2; } }
            __syncthreads();
            bf16* op = a.cact + (size_t)(t0 + tl) * 512 + c0;
#pragma unroll
            for (int k = 0; k < 8; ++k) { const LAS float* p = part + (half * 8 + k) * 8;
                const float S1 = (p[0] + p[2]) + (p[4] + p[6]), S2 = (p[1] + p[3]) + (p[5] + p[7]);
                const float mean = S1 * (1.f / 512.f), var = S2 * (1.f / 512.f) - mean * mean, rstd = 1.f / sqrtf(var + NORM_EPS);
                const float y0 = (a0[k] - mean) * rstd * lg0 + lb0, y1 = (a1[k] - mean) * rstd * lg1 + lb1;
                const float o0 = y0 / (1.f + __expf(-y0)), o1 = y1 / (1.f + __expf(-y1));
                *(GAS unsigned*)(op + k * 512) = pk2(o0, o1); }
            __syncthreads();
        }
    }
}

__device__ __forceinline__ int tokey(float v) { const int b = __float_as_int(v); return b ^ ((b >> 31) & 0x7fffffff); }
__device__ __forceinline__ float unkey(int k, int mask) { const int t = k & ~mask; return __int_as_float(t ^ ((t >> 31) & 0x7fffffff)); }
__device__ __forceinline__ void ce_desc(int& a, int& b) { const int hi = a > b ? a : b, lo = a > b ? b : a; a = hi; b = lo; }
template <int N> __device__ __forceinline__ void sort_desc(int (&v)[N]) {
#pragma unroll
    for (int k = 2; k <= N; k <<= 1)
#pragma unroll
        for (int j = k >> 1; j > 0; j >>= 1)
#pragma unroll
            for (int i = 0; i < N; ++i) { const int l = i ^ j; if (l > i) { if ((i & k) == 0) ce_desc(v[i], v[l]); else ce_desc(v[l], v[i]); } }
}
__device__ __forceinline__ void bitonic_merge16_desc(int (&v)[16]) {
#pragma unroll
    for (int j = 8; j > 0; j >>= 1)
#pragma unroll
        for (int i = 0; i < 16; ++i) { const int l = i ^ j; if (l > i) ce_desc(v[i], v[l]); }
}
__device__ __forceinline__ void merge_top16(int (&a)[16], const int (&b)[16]) {
#pragma unroll
    for (int i = 0; i < 16; ++i) a[i] = a[i] > b[15 - i] ? a[i] : b[15 - i];
    bitonic_merge16_desc(a);
}
__device__ __forceinline__ void top16_of_64(const int (&x)[64], int (&out)[16]) {
    int g[16];
#pragma unroll
    for (int i = 0; i < 16; ++i) out[i] = x[i];
    sort_desc<16>(out);
#pragma unroll
    for (int q = 1; q < 4; ++q) {
#pragma unroll
        for (int i = 0; i < 16; ++i) g[i] = x[16 * q + i];
        sort_desc<16>(g); merge_top16(out, g); }
}
__device__ __forceinline__ int crow_(int r, int hi) { return (r & 3) + 8 * (r >> 2) + 4 * hi; }
struct SelArgs { const bf16* qp; const bf16* keys; const float* ss; int* eidx; float* gw; };
__device__ __forceinline__ void peer_select_phase(Frame& F, const SelArgs& a) {
    for (int i = F.tid; i < 2 * 128 * 16; i += 512) { const int which = i >> 11, rem = i & 2047, row = rem >> 4, ch = rem & 15;
        const v4u v = *(const GAS v4u*)(a.keys + (size_t)which * 16384 + row * 128 + ch * 8);
        *(LAS v4u*)(F.lds + RING_OFF + which * 32768 + row * 256 + ((ch ^ (row & 15)) << 4)) = v; }
    __syncthreads();
    LAS int* scr = (LAS int*)(F.lds + RING_OFF + 65536 + F.wave * 4096);
    const int lane = F.lane, tl = lane & 31, hi = lane >> 5;
    const int gw = F.vcu * NWAVES + F.wave, NGW = F.G * NWAVES;
    constexpr int NUNITS = (TOK / 32) * P_HEADS;
    constexpr int PA[50] = {0,0,0,0,0,0,0,0,0,0,0,0,0,0,0,0, 1,1,1,1,1,1,1,1, 2,2,2,2,2, 3,3,3,3, 4,4,4, 5,5, 6,6, 7,7, 8,9,10,11,12,13,14,15};
    constexpr int PB[50] = {0,1,2,3,4,5,6,7,8,9,10,11,12,13,14,15, 0,1,2,3,4,5,6,7, 0,1,2,3,4, 0,1,2,3, 0,1,2, 0,1, 0,1, 0,1, 0,0,0,0,0,0,0,0};
    for (int unit = gw; unit < NUNITS; unit += NGW) {
        const int tt = unit >> 3, hh = unit & 7, t = tt * 32 + tl;
        int vk[2][16];
#pragma unroll
        for (int half = 0; half < 2; ++half) {
            const bf16* qrow = a.qp + (size_t)t * 2048 + hh * 256 + half * 128 + hi * 8;
            bf16x8 bq[8];
#pragma unroll
            for (int ks = 0; ks < 8; ++ks) bq[ks] = *(const GAS bf16x8*)(qrow + ks * 16);
            f32x16 acc[4];
#pragma unroll
            for (int nb = 0; nb < 4; ++nb) { acc[nb] = (f32x16){};
#pragma unroll
                for (int ks = 0; ks < 8; ++ks) { const int row = nb * 32 + tl, ch = 2 * ks + hi;
                    const bf16x8 ka = *(const LAS bf16x8*)(F.lds + RING_OFF + half * 32768 + row * 256 + ((ch ^ (row & 15)) << 4));
                    acc[nb] = __builtin_amdgcn_mfma_f32_32x32x16_bf16(ka, bq[ks], acc[nb], 0, 0, 0); } }
            int keys[64];
#pragma unroll
            for (int nb = 0; nb < 4; ++nb)
#pragma unroll
                for (int r = 0; r < 16; ++r) keys[nb * 16 + r] = (tokey(acc[nb][r]) & ~127) | (nb * 32 + crow_(r, hi));
            int top[16]; top16_of_64(keys, top);
            int oth[16];
#pragma unroll
            for (int i = 0; i < 16; ++i) oth[i] = __shfl_xor(top[i], 32);
            merge_top16(top, oth);
#pragma unroll
            for (int i = 0; i < 16; ++i) vk[half][i] = top[i];
        }
        float f1[16], f2[16];
#pragma unroll
        for (int i = 0; i < 16; ++i) { f1[i] = unkey(vk[0][i], 127); f2[i] = unkey(vk[1][i], 127); }
        int ck[64];
#pragma unroll
        for (int i = 0; i < 50; ++i) ck[i] = (tokey(f1[PA[i]] + f2[PB[i]]) & ~255) | (PA[i] * 16 + PB[i]);
#pragma unroll
        for (int i = 50; i < 64; ++i) ck[i] = (int)0x80000000;
        int c[16]; top16_of_64(ck, c);
        if (hi == 0) {
#pragma unroll
            for (int i = 0; i < 16; ++i) { scr[tl * 32 + i] = vk[0][i] & 127; scr[tl * 32 + 16 + i] = vk[1][i] & 127; } }
        float ssum = 0.f;
        { const GAS f32x4* sp = (const GAS f32x4*)(a.ss + (size_t)t * 16);
#pragma unroll
          for (int i = 0; i < 4; ++i) { const f32x4 v = sp[i]; ssum += (v.x + v.y) + (v.z + v.w); } }
        const float rstd = 1.f / sqrtf(ssum * (1.f / 1024.f) + NORM_EPS);
        const float smax = unkey(c[0], 255);
        float e[16], esum = 0.f;
#pragma unroll
        for (int i = 0; i < 16; ++i) { e[i] = __expf((unkey(c[i], 255) - smax) * rstd); esum += e[i]; }
        const float inv = 1.f / esum;
        LDS_WAIT(); asm volatile("" ::: "memory");
        int eo[8]; float go[8];
#pragma unroll
        for (int i = 0; i < 8; ++i) { const int ci = hi ? c[i + 8] : c[i]; const float ei = hi ? e[i + 8] : e[i];
            const int id = ci & 255, i1 = scr[tl * 32 + (id >> 4)], i2 = scr[tl * 32 + 16 + (id & 15)];
            eo[i] = i1 * P_NK + i2; go[i] = ei * inv; }
        int* ep = a.eidx + (size_t)t * P_E + hh * 16 + hi * 8; float* gp = a.gw + (size_t)t * P_E + hh * 16 + hi * 8;
        *(GAS v4u*)(ep) = (v4u){(unsigned)eo[0], (unsigned)eo[1], (unsigned)eo[2], (unsigned)eo[3]}; *(GAS v4u*)(ep + 4) = (v4u){(unsigned)eo[4], (unsigned)eo[5], (unsigned)eo[6], (unsigned)eo[7]};
        *(GAS f32x4*)(gp) = (f32x4){go[0], go[1], go[2], go[3]}; *(GAS f32x4*)(gp + 4) = (f32x4){go[4], go[5], go[6], go[7]};
        LDS_WAIT(); asm volatile("" ::: "memory");
    }
}

__device__ __forceinline__ float dot2bf(unsigned w, unsigned x, float acc) { return __builtin_amdgcn_fdot2_f32_bf16(__builtin_bit_cast(bf16x2_t, w), __builtin_bit_cast(bf16x2_t, x), acc, false); }
struct ExpArgs { float* xio; const bf16* x1b; const bf16* ub; const bf16* vb; const int* eidx; const float* gw; const float* gfinal; };
__device__ __forceinline__ void peer_expert_phase(Frame& F, const ExpArgs& a) {
    LAS float* coef = (LAS float*)(F.lds + RING_OFF + F.wave * 1024);
    const int lane = F.lane, grp = lane >> 4, j = lane & 15;
    const int gw = F.vcu * NWAVES + F.wave, NGW = F.G * NWAVES;
    for (int t = gw; t < TOK; t += NGW) {
        float* xr = a.xio + (size_t)t * 1024;
        const f32x4 xa0 = *(const GAS f32x4*)(xr + 8 * lane), xa1 = *(const GAS f32x4*)(xr + 8 * lane + 4), xb0 = *(const GAS f32x4*)(xr + 512 + 8 * lane), xb1 = *(const GAS f32x4*)(xr + 512 + 8 * lane + 4);
        float sq = (xa0.x * xa0.x + xa0.y * xa0.y) + (xa0.z * xa0.z + xa0.w * xa0.w) + (xa1.x * xa1.x + xa1.y * xa1.y) + (xa1.z * xa1.z + xa1.w * xa1.w)
                 + (xb0.x * xb0.x + xb0.y * xb0.y) + (xb0.z * xb0.z + xb0.w * xb0.w) + (xb1.x * xb1.x + xb1.y * xb1.y) + (xb1.z * xb1.z + xb1.w * xb1.w);
        const float rstd = 1.f / sqrtf(wave_sum(sq) * (1.f / 1024.f) + NORM_EPS);
        v4u xu[8];
#pragma unroll
        for (int i = 0; i < 8; ++i) xu[i] = *(const GAS v4u*)(a.x1b + (size_t)t * 1024 + 64 * j + 8 * i);
        const int e_lo = a.eidx[(size_t)t * P_E + lane], e_hi = a.eidx[(size_t)t * P_E + 64 + lane];
        const float g_lo = a.gw[(size_t)t * P_E + lane], g_hi = a.gw[(size_t)t * P_E + 64 + lane];
#pragma unroll 2
        for (int r = 0; r < 32; ++r) {
            const int s = 4 * r + grp;
            const int e = __shfl(r < 16 ? e_lo : e_hi, s & 63);
            const float g = __shfl(r < 16 ? g_lo : g_hi, s & 63);
            const bf16* up = a.ub + (size_t)e * 1024 + 64 * j;
            v4u w[8];
#pragma unroll
            for (int i = 0; i < 8; ++i) w[i] = *(const GAS v4u*)(up + 8 * i);
            float d0 = 0.f, d1 = 0.f, d2 = 0.f, d3 = 0.f;
#pragma unroll
            for (int i = 0; i < 8; ++i) { d0 = dot2bf(w[i].x, xu[i].x, d0); d1 = dot2bf(w[i].y, xu[i].y, d1); d2 = dot2bf(w[i].z, xu[i].z, d2); d3 = dot2bf(w[i].w, xu[i].w, d3); }
            float d = (d0 + d1) + (d2 + d3);
            d += __shfl_xor(d, 1); d += __shfl_xor(d, 2); d += __shfl_xor(d, 4); d += __shfl_xor(d, 8);
            const float v = d * rstd, act = 0.5f * v * (1.f + erff(v * 0.70710678118654752f));
            if (j == 0) coef[s] = g * act;
        }
        LDS_WAIT(); asm volatile("" ::: "memory");
        float y[16];
#pragma unroll
        for (int i = 0; i < 16; ++i) y[i] = 0.f;
        for (int s0 = 0; s0 < P_E; s0 += 8) {
            v4u va[8], vb_[8]; float cf[8];
#pragma unroll
            for (int k = 0; k < 8; ++k) { const int s = s0 + k;
                const int e = __builtin_amdgcn_readlane(s0 < 64 ? e_lo : e_hi, s & 63);
                const bf16* vp = a.vb + (size_t)e * 1024 + 8 * lane;
                va[k] = *(const GAS v4u*)(vp); vb_[k] = *(const GAS v4u*)(vp + 512); cf[k] = coef[s]; }
#pragma unroll
            for (int k = 0; k < 8; ++k) { const float c = cf[k];
                y[0] += c * bflo(va[k].x); y[1] += c * bfhi(va[k].x); y[2] += c * bflo(va[k].y); y[3] += c * bfhi(va[k].y);
                y[4] += c * bflo(va[k].z); y[5] += c * bfhi(va[k].z); y[6] += c * bflo(va[k].w); y[7] += c * bfhi(va[k].w);
                y[8] += c * bflo(vb_[k].x); y[9] += c * bfhi(vb_[k].x); y[10] += c * bflo(vb_[k].y); y[11] += c * bfhi(vb_[k].y);
                y[12] += c * bflo(vb_[k].z); y[13] += c * bfhi(vb_[k].z); y[14] += c * bflo(vb_[k].w); y[15] += c * bfhi(vb_[k].w); }
        }
        f32x4 o0 = xa0 + (f32x4){y[0], y[1], y[2], y[3]}, o1 = xa1 + (f32x4){y[4], y[5], y[6], y[7]}, o2 = xb0 + (f32x4){y[8], y[9], y[10], y[11]}, o3 = xb1 + (f32x4){y[12], y[13], y[14], y[15]};
        float sq2 = (o0.x * o0.x + o0.y * o0.y) + (o0.z * o0.z + o0.w * o0.w) + (o1.x * o1.x + o1.y * o1.y) + (o1.z * o1.z + o1.w * o1.w)
                  + (o2.x * o2.x + o2.y * o2.y) + (o2.z * o2.z + o2.w * o2.w) + (o3.x * o3.x + o3.y * o3.y) + (o3.z * o3.z + o3.w * o3.w);
        const float rstd2 = 1.f / sqrtf(wave_sum(sq2) * (1.f / 1024.f) + NORM_EPS);
        const GAS f32x4* gf = (const GAS f32x4*)(a.gfinal + 8 * lane);
        *(GAS f32x4*)(xr + 8 * lane) = o0 * rstd2 * gf[0]; *(GAS f32x4*)(xr + 8 * lane + 4) = o1 * rstd2 * gf[1];
        *(GAS f32x4*)(xr + 512 + 8 * lane) = o2 * rstd2 * gf[128]; *(GAS f32x4*)(xr + 512 + 8 * lane + 4) = o3 * rstd2 * gf[129];
        LDS_WAIT(); asm volatile("" ::: "memory");
    }
}

struct Args { const float* in[18]; float* out; unsigned char* ws; int ph_lo, ph_hi, li, pad; };
__global__ void __launch_bounds__(NWAVES * 64, 2) fwd_kernel(Args args) {
    extern __shared__ __attribute__((aligned(16))) unsigned char lds[];
    Frame F;
    F.lds = (LAS unsigned char*)lds;
    F.MISC = (volatile LAS unsigned*)(F.lds + MISC_OFF);
    F.tid = threadIdx.x; F.lane = F.tid & 63; F.wave = __builtin_amdgcn_readfirstlane(F.tid >> 6);
    F.G = gridDim.x; { const int bx = blockIdx.x; F.vcu = (F.G % 8 == 0) ? (bx % 8) * (F.G / 8) + bx / 8 : bx; }
    unsigned char* ws = args.ws;
    F.ctl = (gu32*)(ws + WS_CTL);
#define GRID_BAR(seam) do { if (N_LAUNCHES == PER_PHASE) { if (F.tid == 0) __hip_atomic_store(F.ctl + CW_TMO, 0xBADBA0u | (unsigned)(seam), RLX_AGENT); } else { xcd_barrier(bar); } } while (0)
    const float* x = args.in[0];
    bf16* H = (bf16*)(ws + WS_H); bf16* Win = (bf16*)(ws + WS_WIN); bf16* Wpw = (bf16*)(ws + WS_WPW); bf16* Wao = (bf16*)(ws + WS_WAO); bf16* Wout = (bf16*)(ws + WS_WOUT); bf16* Wq = (bf16*)(ws + WS_WQ);
    bf16* KEYS = (bf16*)(ws + WS_KEYS); bf16* UB = (bf16*)(ws + WS_UB); bf16* VB = (bf16*)(ws + WS_VB);
    bf16* ZGLU = (bf16*)(ws + WS_ZGLU); bf16* QO = (bf16*)(ws + WS_QO); bf16* KB = (bf16*)(ws + WS_K); bf16* VBUF = (bf16*)(ws + WS_V); bf16* GC = (bf16*)(ws + WS_GC); bf16* GA = (bf16*)(ws + WS_GA);
    bf16* CACT = (bf16*)(ws + WS_CACT); bf16* MIX = (bf16*)(ws + WS_MIX); bf16* X1B = (bf16*)(ws + WS_X1B); bf16* QP = (bf16*)(ws + WS_QP);
    float* KMEAN = (float*)(ws + WS_KMEAN); float* SS = (float*)(ws + WS_SS); int* EIDX = (int*)(ws + WS_EIDX); float* GW = (float*)(ws + WS_GW);
    for (int u = F.tid; u < (LDS_BYTES - LDSCTL_OFF) / 4; u += NWAVES * 64) ((LAS unsigned*)(F.lds + LDSCTL_OFF))[u] = 0u;
    __syncthreads();
    XcdBarrier bar; bar.bar = (unsigned*)(F.ctl + CW_BAR); bar.x = 0; bar.st = nullptr;
    if (N_LAUNCHES != PER_PHASE) bar = xcd_barrier_post((unsigned*)(F.ctl + CW_BAR), F.MISC + 8);
    const int lo = args.ph_lo, hi = args.ph_hi;
#ifndef PHASE_MASK
#define PHASE_MASK 0xff
#endif
#define IN(k) (((PHASE_MASK >> (k)) & 1) && lo <= (k) && (k) < hi)
#define BOTH(k) (IN(k) && IN((k) + 1))

    if (IN(0)) {
        P0Args a{x, args.in[1], args.in[2], args.in[7], args.in[9], args.in[10], args.in[11], args.in[12], args.in[13], args.in[14], args.in[15], args.in[16], H, Win, Wpw, Wao, Wout, Wq, KEYS, UB, VB};
        p0_prologue(F, a);
        if (BOTH(0)) GRID_BAR(0);
    }
#ifdef DEBUG_P1_PLAIN
    if (IN(1)) {
        pg8::Gemm g{H, Wq, TOK, 2048, 1024}; pg8::StaticOrder S; S.init(TOK, 2048, F.G, (int)blockIdx.x);
        pg8::EpiStore E{QP, 2048};
        pg8::gemm_phase<pg8::EpiStore, pg8::StaticOrder, true, true>(F.lds + RING_OFF, g, S, E);
    }
#else
    if (IN(1)) {
        pg8::Gemm g{H, Win, TOK, IN_COLS, 1024}; pg8::StaticOrder S; S.init(TOK, IN_COLS, F.G, (int)blockIdx.x);
        pg8::EpiIn E{ZGLU, QO, GC, KMEAN, attn_body::C2, (size_t)(WS_K - WS_QO) / 2, (size_t)(WS_GA - WS_GC) / 2};
        static_assert(WS_V - WS_K == WS_K - WS_QO, "Q|K|V equally spaced");
        pg8::gemm_phase<pg8::EpiIn, pg8::StaticOrder, true, true>(F.lds + RING_OFF, g, S, E);
        if (BOTH(1)) GRID_BAR(1);
    }
#endif
    if (IN(2)) {
        static_assert(attn_body::ATTN_LDS_BYTES <= RING_BYTES && attn_body::ATTN_PITCH == ATT_W, "attention body geometry vs frame");
        const attn_body::AttnTensors AT{(const attn_body::bf16*)QO, (const attn_body::bf16*)KB, (const attn_body::bf16*)VBUF, (attn_body::bf16*)QO, KMEAN};
        const attn_body::StaticOrder S((int)F.G, (int)blockIdx.x);
        attn_body::attn_phase<attn_body::StaticOrder>((char*)lds + RING_OFF, AT, S);
        __syncthreads();
        const ConvArgs ca{ZGLU, args.in[3], args.in[4], args.in[5], args.in[6], CACT};
        conv_phase(F, ca);
        if (BOTH(2)) GRID_BAR(2);
    }
    if (IN(3)) {
        { pg8::Gemm g{CACT, Wpw, TOK, 1024, 512}; pg8::StaticOrder S; S.init(TOK, 1024, F.G, (int)blockIdx.x);
          pg8::EpiMix<false> E{GC, args.in[8], MIX};
          pg8::gemm_phase<pg8::EpiMix<false>, pg8::StaticOrder, true, true>(F.lds + RING_OFF, g, S, E); }
        { pg8::Gemm g{QO, Wao, TOK, 1024, 512}; pg8::StaticOrder S; S.init(TOK, 1024, F.G, (int)blockIdx.x);
          pg8::EpiMix<true> E{GA, nullptr, MIX};
          pg8::gemm_phase<pg8::EpiMix<true>, pg8::StaticOrder, true, true>(F.lds + RING_OFF, g, S, E); }
        if (BOTH(3)) GRID_BAR(3);
    }
    if (IN(4)) {
        pg8::Gemm g{MIX, Wout, TOK, 1024, 1024}; pg8::StaticOrder S; S.init(TOK, 1024, F.G, (int)blockIdx.x);
        pg8::EpiX1 E{x, args.out, X1B, SS};
        pg8::gemm_phase<pg8::EpiX1, pg8::StaticOrder, true, true>(F.lds + RING_OFF, g, S, E);
        if (BOTH(4)) GRID_BAR(4);
    }
    if (IN(5)) {
        pg8::Gemm g{X1B, Wq, TOK, 2048, 1024}; pg8::StaticOrder S; S.init(TOK, 2048, F.G, (int)blockIdx.x);
        pg8::EpiStore E{QP, 2048};
        pg8::gemm_phase<pg8::EpiStore, pg8::StaticOrder, true, true>(F.lds + RING_OFF, g, S, E);
        if (BOTH(5)) GRID_BAR(5);
    }
    if (IN(6)) {
        const SelArgs sa{QP, KEYS, SS, EIDX, GW};
        peer_select_phase(F, sa);
        if (BOTH(6)) GRID_BAR(6);
    }
    if (IN(7)) {
        const ExpArgs ea{args.out, X1B, UB, VB, EIDX, GW, args.in[17]};
        peer_expert_phase(F, ea);
    }
#undef IN
#undef BOTH
}

#ifdef DEBUG_DUMP
__global__ void dump_kernel(const unsigned char* ws, float* out, float wsmib) {
    const size_t i = (size_t)blockIdx.x * 256 + threadIdx.x; if (i >= (size_t)TOK * 1024) return;
    const size_t t = i >> 10, c = i & 1023; float v = 0.f;
    auto B = [&](size_t off, size_t idx) { return bflo((unsigned)((const bf16*)(ws + off))[idx]); };
#if DEBUG_DUMP == 0
    v = B(WS_H, i) + B(WS_WIN, i % (4608u * 1024u)) + B(WS_WPW, i % (512u * 1024u)) + B(WS_WAO, i % (512u * 1024u)) + B(WS_WOUT, i % (1024u * 1024u)) + B(WS_WQ, i % (2048u * 1024u)) + B(WS_KEYS, i % 32768u) + B(WS_UB, i % (16384u * 1024u)) + B(WS_VB, i % (16384u * 1024u));
#elif DEBUG_DUMP == 1
    v = B(WS_ZGLU, t * 512 + (c & 511)) + 2.f * B(WS_QO, t * 512 + (c & 511)) + 3.f * B(WS_K, t * 512 + (c & 511)) + 4.f * B(WS_V, t * 512 + (c & 511)) + 5.f * B(WS_GC, i) + 6.f * B(WS_GA, i) + ((const float*)(ws + WS_KMEAN))[(t >> 8) * 1024 + (c & 1023)];
#elif DEBUG_DUMP == 2
    v = B(WS_QO, t * 512 + (c & 511)) + 2.f * B(WS_CACT, t * 512 + (c & 511));
#elif DEBUG_DUMP == 20
    v = B(WS_QO, t * 512 + (c & 511));
#elif DEBUG_DUMP == 21
    v = B(WS_CACT, t * 512 + (c & 511));
#elif DEBUG_DUMP == 3
    v = B(WS_MIX, i);
#elif DEBUG_DUMP == 5
    v = B(WS_QP, t * 2048 + c) + 2.f * B(WS_QP, t * 2048 + 1024 + c);
#elif DEBUG_DUMP == 10
    v = B(WS_ZGLU, t * 512 + (c & 511));
#elif DEBUG_DUMP == 11
    v = 2.f * B(WS_QO, t * 512 + (c & 511)) + 3.f * B(WS_K, t * 512 + (c & 511)) + 4.f * B(WS_V, t * 512 + (c & 511));
#elif DEBUG_DUMP == 12
    v = 5.f * B(WS_GC, i) + 6.f * B(WS_GA, i);
#elif DEBUG_DUMP == 13
    v = ((const float*)(ws + WS_KMEAN))[(t >> 8) * 1024 + (c & 1023)];
#elif DEBUG_DUMP == 98
    v = wsmib;
#elif DEBUG_DUMP == 99
    v = 1.0f + (float)(c & 7);
#endif
    out[i] = v;
}
#endif
extern "C" void kernel_launch(void* const* d_in, const int* in_sizes, int n_in, void* d_out, int out_size, void* d_ws, size_t ws_size, hipStream_t stream) {
    static int grid = 0;
    if (grid == 0) {
        if (n_in != 18 || in_sizes[0] != TOK * DM || out_size != TOK * DM || ws_size < WS_END) { fprintf(stderr, "kernel_launch: unexpected shapes (n_in %d, in0 %d, out %d, ws %zu); nothing launched\n", n_in, n_in > 0 ? in_sizes[0] : -1, out_size, ws_size); grid = -1; return; }
        int dev = 0, cus = 0, per_cu = 0;
        if (hipGetDevice(&dev) != hipSuccess || hipDeviceGetAttribute(&cus, hipDeviceAttributeMultiprocessorCount, dev) != hipSuccess) { grid = -1; return; }
        if (hipFuncSetAttribute((const void*)fwd_kernel, hipFuncAttributeMaxDynamicSharedMemorySize, LDS_BYTES) != hipSuccess) { fprintf(stderr, "kernel_launch: hipFuncSetAttribute failed\n"); grid = -1; return; }
        if (hipOccupancyMaxActiveBlocksPerMultiprocessor(&per_cu, (const void*)fwd_kernel, NWAVES * 64, LDS_BYTES) != hipSuccess || per_cu < 1) fprintf(stderr, "kernel_launch: occupancy query reports %d\n", per_cu);
        (void)hipGetLastError();
        grid = cus;
    }
    if (grid < 0) return;
    (void)hipMemsetAsync((char*)d_ws + WS_CTL, 0, CTL_ZERO_BYTES, stream);
    Args a{};
    for (int i = 0; i < 18; ++i) a.in[i] = (const float*)d_in[i];
    a.out = (float*)d_out; a.ws = (unsigned char*)d_ws;
#ifndef NPH_RUN
#define NPH_RUN N_LAUNCHES
#endif
    for (int li = 0; li < NPH_RUN; ++li) {
        a.ph_lo = (N_LAUNCHES == PER_PHASE) ? li : 0; a.ph_hi = (N_LAUNCHES == PER_PHASE) ? li + 1 : PER_PHASE; a.li = li;
        hipLaunchKernelGGL(fwd_kernel, dim3(grid), dim3(NWAVES * 64), LDS_BYTES, stream, a);
    }
#ifdef DEBUG_DUMP
    hipLaunchKernelGGL(dump_kernel, dim3(TOK * 1024 / 256), dim3(256), 0, stream, (const unsigned char*)d_ws, (float*)d_out, (float)(ws_size >> 20));
#endif
}
```

```cpp
#define MK_N_LAUNCHES 1
#ifndef PG8_EPI_DRAIN
#define PG8_EPI_DRAIN 0
#endif
#include <hip/hip_runtime.h>
#include <hip/hip_bf16.h>
#include <cstdio>
#include <cstdint>
#include <cmath>
namespace pg8 {
#define PG8_LAS __attribute__((address_space(3)))
typedef unsigned short bf16_t;
typedef short bf16x8 __attribute__((ext_vector_type(8)));
typedef float f32x4 __attribute__((ext_vector_type(4)));
typedef unsigned u32x4 __attribute__((ext_vector_type(4)));
constexpr int BM = 256, BK = 64, HALF = 128, HTB = HALF * BK * 2  , STAGE_BYTES = 8 * HTB, NXCD = 8, WGM = 8;

__host__ __device__ __forceinline__ int lds_byte(int r, int c) { const int st = (r >> 4) * 2 + (c >> 5), rr = r & 15, cc = c & 31, ob = rr * 64 + cc * 2; return st * 1024 + (ob ^ (((ob >> 9) & 1) << 5)); }
__host__ __device__ __forceinline__ void stage_rc(int b, int& R, int& C) { const int st = b / 1024, sb = b % 1024, swz = sb ^ (((sb >> 9) & 1) << 5); R = (st >> 1) * 16 + swz / 64; C = (st & 1) * 32 + (swz % 64) / 2; }
__host__ __device__ __forceinline__ int perm32(int rho) { const int n = rho >> 4, i = rho & 15; return 8 * (i >> 2) + 4 * n + (i & 3); }

struct Unit { int pm, pn; };
struct Gemm { const bf16_t* A; const bf16_t* Bt; int M, N, K; };

struct StaticOrder {
    int nM, nN, nwg, G, c;
    __host__ __device__ void init(int M, int N, int G_, int c_) { nM = M / BM; nN = N / BM; nwg = nM * nN; G = G_; c = c_; }
    __host__ __device__ bool next(int i, Unit& u) const {
        const long L = (long)i * G + c; if (L >= nwg) return false;
        int wgid = (int)L; { const int q = nwg / NXCD, r = nwg % NXCD, xcd = wgid % NXCD, off = wgid / NXCD; wgid = (xcd < r ? xcd * (q + 1) : r * (q + 1) + (xcd - r) * q) + off; }
        const int nig = WGM * nN, gid = wgid / nig, fm = gid * WGM, gsz = (nM - fm) < WGM ? (nM - fm) : WGM;
        u.pm = fm + ((wgid % nig) % gsz); u.pn = (wgid % nig) / gsz; return true;
    }
    __device__ __forceinline__ void a_ready(const Unit&) const {}
    __device__ __forceinline__ void done(const Unit&) const {}
};

typedef float f32x2c_t __attribute__((ext_vector_type(2))); typedef __bf16 bf16x2c_t __attribute__((ext_vector_type(2)));
__device__ __forceinline__ unsigned cvt_pk_bf16(float lo, float hi) { const f32x2c_t v = {lo, hi}; const bf16x2c_t b = __builtin_convertvector(v, bf16x2c_t); return __builtin_bit_cast(unsigned, b); }
typedef float f32x2 __attribute__((ext_vector_type(2)));
__device__ __forceinline__ float sigm(float v) { return __builtin_amdgcn_rcpf(1.0f + __builtin_amdgcn_exp2f(-1.4426950408889634f * v)); }
__device__ __forceinline__ float bf_lo(unsigned u) { return __uint_as_float(u << 16); }
__device__ __forceinline__ float bf_hi(unsigned u) { return __uint_as_float(u & 0xffff0000u); }
__device__ __forceinline__ u32x4 pack8(const f32x4 a, const f32x4 b) { u32x4 w; w.x = cvt_pk_bf16(a[0], a[1]); w.y = cvt_pk_bf16(a[2], a[3]); w.z = cvt_pk_bf16(b[0], b[1]); w.w = cvt_pk_bf16(b[2], b[3]); return w; }
__device__ __forceinline__ void unpack8(const u32x4 w, f32x4& a, f32x4& b) { a = (f32x4){bf_lo(w.x), bf_hi(w.x), bf_lo(w.y), bf_hi(w.y)}; b = (f32x4){bf_lo(w.z), bf_hi(w.z), bf_lo(w.w), bf_hi(w.w)}; }

struct EpiIn {
    static constexpr bool PERM = true, AFTER_DRAIN = false;
    bf16_t *zglu, *Q, *gc; float* kmean; float qscale; size_t qkv_stride, gate_stride;
    __device__ __forceinline__ void operator()(const f32x4 (&acc)[2][2][4][2], const Unit& u, int wr, int wc, int fr, int fq) const {
        const int row0 = u.pm * BM + wr * 64 + fr, cw = wc * 32 + 8 * fq, pn = u.pn;
        if (pn < 4) {
#pragma unroll
            for (int ai = 0; ai < 2; ++ai)
#pragma unroll
                for (int m = 0; m < 4; ++m) { const size_t row = (size_t)(row0 + ai * HALF + m * 16);
                    f32x4 z0, z1;
#pragma unroll
                    for (int j = 0; j < 4; ++j) { z0[j] = acc[ai][0][m][0][j] * sigm(acc[ai][1][m][0][j]); z1[j] = acc[ai][0][m][1][j] * sigm(acc[ai][1][m][1][j]); }
                    *(u32x4*)(zglu + row * 512 + pn * 128 + cw) = pack8(z0, z1); }
        } else if (pn < 10) {
            bf16_t* base = Q + (size_t)((pn - 4) >> 1) * qkv_stride; const int ct = (pn & 1) * 256; const float sc = pn < 6 ? qscale : 1.0f;
#pragma unroll
            for (int ai = 0; ai < 2; ++ai)
#pragma unroll
                for (int m = 0; m < 4; ++m) { const size_t row = (size_t)(row0 + ai * HALF + m * 16);
#pragma unroll
                    for (int bj = 0; bj < 2; ++bj) *(u32x4*)(base + row * 512 + ct + bj * HALF + cw) = pack8(acc[ai][bj][m][0] * sc, acc[ai][bj][m][1] * sc); }
            if (pn == 6 || pn == 7) {
#pragma unroll
                for (int bj = 0; bj < 2; ++bj)
#pragma unroll
                    for (int n = 0; n < 2; ++n)
#pragma unroll
                        for (int j = 0; j < 4; ++j) { float s = 0.f;
#pragma unroll
                            for (int ai = 0; ai < 2; ++ai)
#pragma unroll
                                for (int m = 0; m < 4; ++m) s += acc[ai][bj][m][n][j];
                            s += __shfl_xor(s, 1); s += __shfl_xor(s, 2); s += __shfl_xor(s, 4); s += __shfl_xor(s, 8);
                            if (fr == 0) kmean[((size_t)u.pm * 2 + wr) * 512 + ct + bj * HALF + cw + 4 * n + j] = s * (1.0f / 256.0f); }
            }
        } else {
            bf16_t* base = gc + (size_t)((pn - 10) >> 2) * gate_stride; const int ct = ((pn - 10) & 3) * 256;
#pragma unroll
            for (int ai = 0; ai < 2; ++ai)
#pragma unroll
                for (int m = 0; m < 4; ++m) { const size_t row = (size_t)(row0 + ai * HALF + m * 16);
#pragma unroll
                    for (int bj = 0; bj < 2; ++bj) { f32x4 s0, s1;
#pragma unroll
                        for (int j = 0; j < 4; ++j) { s0[j] = sigm(acc[ai][bj][m][0][j]); s1[j] = sigm(acc[ai][bj][m][1][j]); }
                        *(u32x4*)(base + row * 1024 + ct + bj * HALF + cw) = pack8(s0, s1); } }
        }
    }
};
template <bool ADD> struct EpiMix {
    static constexpr bool PERM = true, AFTER_DRAIN = false;
    const bf16_t* gate; const float* bias; bf16_t* mix;
    __device__ __forceinline__ void operator()(const f32x4 (&acc)[2][2][4][2], const Unit& u, int wr, int wc, int fr, int fq) const {
        const int row0 = u.pm * BM + wr * 64 + fr, col0 = u.pn * BM + wc * 32 + 8 * fq;
#pragma unroll
        for (int ai = 0; ai < 2; ++ai)
#pragma unroll
            for (int m = 0; m < 4; ++m) { const size_t row = (size_t)(row0 + ai * HALF + m * 16);
#pragma unroll
                for (int bj = 0; bj < 2; ++bj) { const size_t off = row * 1024 + col0 + bj * HALF;
                    f32x4 g0, g1; unpack8(*(const u32x4*)(gate + off), g0, g1);
                    f32x4 v0 = acc[ai][bj][m][0], v1 = acc[ai][bj][m][1];
                    if (!ADD) { v0 = (v0 + *(const f32x4*)(bias + col0 + bj * HALF)) * g0; v1 = (v1 + *(const f32x4*)(bias + col0 + bj * HALF + 4)) * g1; }
                    else { f32x4 p0, p1; unpack8(*(const u32x4*)(mix + off), p0, p1); v0 = p0 + v0 * g0; v1 = p1 + v1 * g1; }
                    *(u32x4*)(mix + off) = pack8(v0, v1); } }
    }
};
struct EpiX1 {
    static constexpr bool PERM = true, AFTER_DRAIN = false;
    const float* x; float* x1; bf16_t* x1b; float* ss;
    __device__ __forceinline__ void operator()(const f32x4 (&acc)[2][2][4][2], const Unit& u, int wr, int wc, int fr, int fq) const {
        const int row0 = u.pm * BM + wr * 64 + fr, col0 = u.pn * BM + wc * 32 + 8 * fq;
#pragma unroll
        for (int ai = 0; ai < 2; ++ai)
#pragma unroll
            for (int m = 0; m < 4; ++m) { const size_t row = (size_t)(row0 + ai * HALF + m * 16); float sq = 0.f;
#pragma unroll
                for (int bj = 0; bj < 2; ++bj) { const size_t off = row * 1024 + col0 + bj * HALF;
                    const f32x4 r0 = *(const f32x4*)(x + off) + acc[ai][bj][m][0], r1 = *(const f32x4*)(x + off + 4) + acc[ai][bj][m][1];
                    *(f32x4*)(x1 + off) = r0; *(f32x4*)(x1 + off + 4) = r1; *(u32x4*)(x1b + off) = pack8(r0, r1);
                    sq += (r0[0] * r0[0] + r0[1] * r0[1]) + (r0[2] * r0[2] + r0[3] * r0[3]) + (r1[0] * r1[0] + r1[1] * r1[1]) + (r1[2] * r1[2] + r1[3] * r1[3]); }
                sq += __shfl_xor(sq, 16); sq += __shfl_xor(sq, 32);
                if (fq == 0) ss[row * 16 + u.pn * 4 + wc] = sq; }
    }
};
struct EpiStore {
    static constexpr bool PERM = true, AFTER_DRAIN = false;
    bf16_t* O; int ldc;
    __device__ __forceinline__ void operator()(const f32x4 (&acc)[2][2][4][2], const Unit& u, int wr, int wc, int fr, int fq) const {
        const int row0 = u.pm * BM + wr * 64 + fr, col0 = u.pn * BM + wc * 32 + 8 * fq;
#pragma unroll
        for (int ai = 0; ai < 2; ++ai)
#pragma unroll
            for (int m = 0; m < 4; ++m) { const size_t row = (size_t)(row0 + ai * HALF + m * 16);
#pragma unroll
                for (int bj = 0; bj < 2; ++bj) *(u32x4*)(O + row * ldc + col0 + bj * HALF) = pack8(acc[ai][bj][m][0], acc[ai][bj][m][1]); }
    }
};


template <class Epi, class Sched, bool ALIGN_EPI = false, bool SP2 = false>
__device__ __forceinline__ void gemm_phase(PG8_LAS unsigned char* lds, const Gemm g, const Sched& S, const Epi& E) {
    const int tid = threadIdx.x, wid = __builtin_amdgcn_readfirstlane(tid >> 6), lane = tid & 63, wr = wid >> 2, wc = wid & 3, fr = lane & 15, fq = lane >> 4;
    const int K = g.K, nt = K / BK;
    unsigned voffA[2], voffB[2];
#pragma unroll
    for (int i = 0; i < 2; ++i) { int R, C; stage_rc(tid * 16 + i * 8192, R, C); const int Rb = Epi::PERM ? ((R & ~31) + perm32(R & 31)) : R;
        voffA[i] = (unsigned)(R * K + C) * 2u; voffB[i] = (unsigned)(Rb * K + C) * 2u; }
    const size_t kstep = (size_t)(BK * 2);
    const size_t hstep = (size_t)HALF * K * 2;
    const size_t tstep = 2 * hstep;
    const unsigned ldsw = (unsigned)wid * 1024u;
    const int aoff = lds_byte(wr * 64 + fr, fq * 8), boff = lds_byte(wc * 32 + fr, fq * 8);
#define PG8_SA(b, h) (((b) * 2 + (h)) * HTB)
#define PG8_SB(b, h) ((4 + (b) * 2 + (h)) * HTB)
#define PG8_STAGE(bufoff, gbase, voff) do { _Pragma("unroll") for (int _i = 0; _i < 2; ++_i) \
        __builtin_amdgcn_global_load_lds((const unsigned*)((const char*)(gbase) + (voff)[_i]), (PG8_LAS unsigned*)(lds + (bufoff) + ldsw + _i * 8192), 16, 0, 0); } while (0)
#define PG8_LDA(dst, b, h) do { _Pragma("unroll") for (int m = 0; m < 4; ++m) _Pragma("unroll") for (int k = 0; k < 2; ++k) dst[m][k] = *(const PG8_LAS bf16x8*)(lds + PG8_SA(b, h) + aoff + m * 2048 + k * 1024); } while (0)
#define PG8_LDB(dst, b, h) do { _Pragma("unroll") for (int n = 0; n < 2; ++n) _Pragma("unroll") for (int k = 0; k < 2; ++k) dst[n][k] = *(const PG8_LAS bf16x8*)(lds + PG8_SB(b, h) + boff + n * 2048 + k * 1024); } while (0)
#define PG8_MMA(ai, bj, At, Bt) do { __builtin_amdgcn_s_setprio(1); _Pragma("unroll") for (int m = 0; m < 4; ++m) _Pragma("unroll") for (int n = 0; n < 2; ++n) _Pragma("unroll") for (int k = 0; k < 2; ++k) \
        acc[ai][bj][m][n] = __builtin_amdgcn_mfma_f32_16x16x32_bf16(Bt[n][k], At[m][k], acc[ai][bj][m][n], 0, 0, 0); __builtin_amdgcn_s_setprio(0); } while (0)
#define PG8_WAIT_V(n) asm volatile("s_waitcnt vmcnt(" #n ")" ::: "memory")
#define PG8_WAIT_L(n) asm volatile("s_waitcnt lgkmcnt(" #n ")" ::: "memory")
#define PG8_BAR __builtin_amdgcn_s_barrier()
#define PG8_SCHED __builtin_amdgcn_sched_barrier(0)
    Unit cur, nxt; int ui = 0;
    if (!S.next(0, cur)) return;
    f32x4 acc[2][2][4][2];
#pragma unroll
    for (int a = 0; a < 2; ++a)
#pragma unroll
        for (int b = 0; b < 2; ++b)
#pragma unroll
            for (int m = 0; m < 4; ++m)
#pragma unroll
                for (int n = 0; n < 2; ++n) acc[a][b][m][n] = (f32x4){0.f, 0.f, 0.f, 0.f};
    bf16x8 At[4][2], B0[2][2], B1[2][2];
    const char* cA = (const char*)g.A + (size_t)cur.pm * tstep; const char* cB = (const char*)g.Bt + (size_t)cur.pn * tstep;
    S.a_ready(cur);
    if constexpr (SP2) {
        PG8_STAGE(PG8_SB(0, 0), cB, voffB); PG8_STAGE(PG8_SB(0, 1), cB + hstep, voffB); PG8_STAGE(PG8_SA(0, 0), cA, voffA); PG8_STAGE(PG8_SA(0, 1), cA + hstep, voffA);
        if (wr == 1) PG8_BAR;
        PG8_WAIT_V(2); PG8_BAR;
        PG8_STAGE(PG8_SB(1, 0), cB + kstep, voffB); PG8_STAGE(PG8_SA(1, 0), cA + kstep, voffA); PG8_STAGE(PG8_SB(1, 1), cB + hstep + kstep, voffB);
        PG8_WAIT_V(6); PG8_BAR;
    } else {
        PG8_STAGE(PG8_SB(0, 0), cB, voffB); PG8_STAGE(PG8_SA(0, 0), cA, voffA); PG8_STAGE(PG8_SB(0, 1), cB + hstep, voffB); PG8_STAGE(PG8_SA(0, 1), cA + hstep, voffA);
        if (wr == 1) PG8_BAR;
        PG8_WAIT_V(4); PG8_BAR;
        PG8_STAGE(PG8_SB(1, 0), cB + kstep, voffB); PG8_STAGE(PG8_SA(1, 0), cA + kstep, voffA); PG8_STAGE(PG8_SB(1, 1), cB + hstep + kstep, voffB);
        PG8_WAIT_V(6); PG8_BAR;
    }
    for (;;) {
        const bool has_next = S.next(ui + 1, nxt);
        const char* nA = has_next ? (const char*)g.A + (size_t)nxt.pm * tstep : cA; const char* nB = has_next ? (const char*)g.Bt + (size_t)nxt.pn * tstep : cB;
        for (int t = 0; t < nt; t += 2) {
            const bool last = (t == nt - 2);
            const char* a1 = cA + (size_t)(t + 1) * kstep;
            const char* a2 = last ? nA : cA + (size_t)(t + 2) * kstep; const char* b2 = last ? nB : cB + (size_t)(t + 2) * kstep;
            const char* a3 = a2 + kstep; const char* b3 = b2 + kstep;
            if (last && has_next) S.a_ready(nxt);
            if constexpr (SP2) {
            PG8_LDB(B0, 0, 0); PG8_LDB(B1, 0, 1); PG8_SCHED; PG8_LDA(At, 0, 0); PG8_STAGE(PG8_SA(1, 1), a1 + hstep, voffA);
            PG8_WAIT_V(8); PG8_WAIT_L(0); PG8_BAR; PG8_MMA(0, 0, At, B0); PG8_MMA(0, 1, At, B1); PG8_BAR; PG8_SCHED;
            PG8_LDA(At, 0, 1); PG8_STAGE(PG8_SB(0, 0), b2, voffB); PG8_STAGE(PG8_SB(0, 1), b2 + hstep, voffB); PG8_STAGE(PG8_SA(0, 0), a2, voffA);
            PG8_WAIT_V(8); PG8_WAIT_L(0); PG8_BAR; PG8_MMA(1, 0, At, B0); PG8_MMA(1, 1, At, B1); PG8_BAR; PG8_SCHED;
            PG8_LDB(B0, 1, 0); PG8_LDB(B1, 1, 1); PG8_SCHED; PG8_LDA(At, 1, 0); PG8_STAGE(PG8_SA(0, 1), a2 + hstep, voffA);
            PG8_WAIT_V(8); PG8_WAIT_L(0); PG8_BAR; PG8_MMA(0, 0, At, B0); PG8_MMA(0, 1, At, B1); PG8_BAR; PG8_SCHED;
            PG8_LDA(At, 1, 1); PG8_STAGE(PG8_SB(1, 0), b3, voffB); PG8_STAGE(PG8_SB(1, 1), b3 + hstep, voffB); PG8_STAGE(PG8_SA(1, 0), a3, voffA);
            PG8_WAIT_V(8); PG8_WAIT_L(0); PG8_BAR; PG8_MMA(1, 0, At, B0); PG8_MMA(1, 1, At, B1); PG8_BAR; PG8_SCHED;
            } else {
            PG8_LDB(B0, 0, 0); PG8_SCHED; PG8_LDA(At, 0, 0); PG8_STAGE(PG8_SA(1, 1), a1 + hstep, voffA);
            PG8_WAIT_L(8); PG8_BAR; PG8_WAIT_L(0); PG8_MMA(0, 0, At, B0); PG8_BAR; PG8_SCHED;
            PG8_LDB(B1, 0, 1); PG8_STAGE(PG8_SB(0, 0), b2, voffB);
            PG8_BAR; PG8_WAIT_L(0); PG8_MMA(0, 1, At, B1); PG8_BAR;
            PG8_LDA(At, 0, 1); PG8_STAGE(PG8_SA(0, 0), a2, voffA);
            PG8_BAR; PG8_WAIT_L(0); PG8_MMA(1, 0, At, B0); PG8_BAR; PG8_SCHED;
            PG8_STAGE(PG8_SB(0, 1), b2 + hstep, voffB);
            PG8_WAIT_V(6); PG8_BAR; PG8_MMA(1, 1, At, B1); PG8_BAR;
            PG8_LDB(B0, 1, 0); PG8_SCHED; PG8_LDA(At, 1, 0); PG8_STAGE(PG8_SA(0, 1), a2 + hstep, voffA);
            PG8_WAIT_L(8); PG8_BAR; PG8_WAIT_L(0); PG8_MMA(0, 0, At, B0); PG8_BAR; PG8_SCHED;
            PG8_LDB(B1, 1, 1); PG8_STAGE(PG8_SB(1, 0), b3, voffB);
            PG8_BAR; PG8_WAIT_L(0); PG8_MMA(0, 1, At, B1); PG8_BAR;
            PG8_LDA(At, 1, 1); PG8_STAGE(PG8_SA(1, 0), a3, voffA);
            PG8_BAR; PG8_WAIT_L(0); PG8_MMA(1, 0, At, B0); PG8_BAR; PG8_SCHED;
            PG8_STAGE(PG8_SB(1, 1), b3 + hstep, voffB);
            PG8_WAIT_V(6); PG8_BAR; PG8_MMA(1, 1, At, B1); PG8_BAR;
            }
        }
        if constexpr (ALIGN_EPI) { if (wr == 0) PG8_BAR; }
        if constexpr (!Epi::AFTER_DRAIN) { E(acc, cur, wr, wc, fr, fq); S.done(cur);
#if PG8_EPI_DRAIN
            PG8_WAIT_V(0);
#endif
        }
        if (!has_next) break;
#pragma unroll
        for (int a = 0; a < 2; ++a)
#pragma unroll
            for (int b = 0; b < 2; ++b)
#pragma unroll
                for (int m = 0; m < 4; ++m)
#pragma unroll
                    for (int n = 0; n < 2; ++n) acc[a][b][m][n] = (f32x4){0.f, 0.f, 0.f, 0.f};
        cur = nxt; cA = nA; cB = nB; ++ui;
        if constexpr (ALIGN_EPI) { if (wr == 1) PG8_BAR; }
    }
    PG8_WAIT_V(0);
    if constexpr (!ALIGN_EPI) { if (wr == 0) PG8_BAR; }
    PG8_BAR;
    if constexpr (Epi::AFTER_DRAIN) { E.fused(acc, cur, wr, wc, fr, fq, lds, wid, lane); S.done(cur); }
#undef PG8_SA
#undef PG8_SB
#undef PG8_STAGE
#undef PG8_LDA
#undef PG8_LDB
#undef PG8_MMA
#undef PG8_WAIT_V
#undef PG8_WAIT_L
#undef PG8_BAR
#undef PG8_SCHED
}
}

#include <hip/hip_bf16.h>
#include <cmath>
namespace attn_body {
using bf16=__hip_bfloat16;
using bf16x8=__attribute__((ext_vector_type(8)))short;
using s16x4=__attribute__((ext_vector_type(4)))short;
using f32x16=__attribute__((ext_vector_type(16)))float;
using u32x4=__attribute__((ext_vector_type(4)))unsigned;
typedef float f32x4_t __attribute__((ext_vector_type(4)));
constexpr int BATCH=8,NHEAD=8,SEQ=4096,D=64,DM=NHEAD*D;
constexpr int NW=8,QBLK=32,QB=QBLK*NW,KVBLK=64,NQB=SEQ/QB;
constexpr int ATTN_PITCH=DM, ATTN_UNIT_ROWS=QB;
__device__ __forceinline__ int crow(int r,int hi){return (r&3)+8*(r>>2)+4*hi;}
#define SBAR() __builtin_amdgcn_sched_barrier(0)
__device__ __forceinline__ void cmask(f32x16&p0,f32x16&p1,int jb,int qrel,int hi){
  const float NEG=-INFINITY; int kb=64*jb+4*hi;
  #pragma unroll
  for(int r=0;r<16;++r){int kv=kb+(r&3)+8*(r>>2); if(kv>qrel)p0[r]=NEG; if(kv+32>qrel)p1[r]=NEG;}
}

constexpr int NSLOT=3, SLOTB=8192;
constexpr int LDS_K=0, LDS_V=NSLOT*SLOTB, LDS_WS=2*NSLOT*SLOTB, LDS_OST=LDS_WS+NW*64*4, LDS_KM=LDS_OST+NW*4096, LDS_BYTES=LDS_KM+4096;
constexpr float C2=0.125f*1.4426950408889634f;
__device__ __forceinline__ void glds16(const void*gsrc,unsigned lds_dst){unsigned keep;
  asm volatile("s_mov_b32 %0, m0\n\ts_mov_b32 m0, %2\n\ts_nop 0\n\tglobal_load_lds_dwordx4 %1, off\n\ts_mov_b32 m0, %0":"=&s"(keep):"v"(gsrc),"s"(lds_dst):"memory");}
__device__ __forceinline__ float max3f(float a,float b,float c){float r;asm("v_max3_f32 %0, %1, %2, %3":"=v"(r):"v"(a),"v"(b),"v"(c));return r;}
__device__ __forceinline__ float max2f(float a,float b){float r;asm("v_max_f32_e32 %0, %1, %2":"=v"(r):"v"(a),"v"(b));return r;}
__device__ __forceinline__ float fadd_s(float a,float b){float r;asm("v_add_f32_e32 %0, %1, %2":"=v"(r):"v"(a),"v"(b));return r;}
__device__ __forceinline__ float fsub_s(float a,float b){float r;asm("v_sub_f32_e32 %0, %1, %2":"=v"(r):"v"(a),"v"(b));return r;}
typedef float f32x2_t __attribute__((ext_vector_type(2))); typedef __bf16 bf16x2_t __attribute__((ext_vector_type(2)));
__device__ __forceinline__ unsigned cvtpk_s(float lo,float hi){f32x2_t v={lo,hi};bf16x2_t b=__builtin_convertvector(v,bf16x2_t);return __builtin_bit_cast(unsigned,b);}
#define WAIT_BAR(N) asm volatile("s_waitcnt vmcnt(" #N ") lgkmcnt(0)\n\ts_barrier":::"memory")

__device__ __forceinline__ void qkt(f32x16&p0,f32x16&p1,const char*Kslot,const bf16x8*qr,int r32,int hi){
  const char*kb=Kslot+hi*1024+r32*16;
  #pragma unroll
  for(int d0=0;d0<4;++d0){
    const bf16x8 b0=*reinterpret_cast<const bf16x8*>(kb+d0*2048);
    const bf16x8 b1=*reinterpret_cast<const bf16x8*>(kb+d0*2048+512);
    p0=__builtin_amdgcn_mfma_f32_32x32x16_bf16(b0,qr[d0],p0,0,0,0);p1=__builtin_amdgcn_mfma_f32_32x32x16_bf16(b1,qr[d0],p1,0,0,0);}
}
typedef __attribute__((address_space(3))) const char* lds_cptr;
typedef short v4i16_t __attribute__((ext_vector_type(4)));
__device__ __forceinline__ void kload8(bf16x8*kf,lds_cptr kp){
  kf[0]=*(const __attribute__((address_space(3))) bf16x8*)(kp);      kf[1]=*(const __attribute__((address_space(3))) bf16x8*)(kp+512);
  kf[2]=*(const __attribute__((address_space(3))) bf16x8*)(kp+2048); kf[3]=*(const __attribute__((address_space(3))) bf16x8*)(kp+2560);
  kf[4]=*(const __attribute__((address_space(3))) bf16x8*)(kp+4096); kf[5]=*(const __attribute__((address_space(3))) bf16x8*)(kp+4608);
  kf[6]=*(const __attribute__((address_space(3))) bf16x8*)(kp+6144); kf[7]=*(const __attribute__((address_space(3))) bf16x8*)(kp+6656);
}
__device__ __forceinline__ void kload2(bf16x8*kf,lds_cptr kp,int j){ kf[2*j]=*(const __attribute__((address_space(3))) bf16x8*)(kp+j*2048); kf[2*j+1]=*(const __attribute__((address_space(3))) bf16x8*)(kp+j*2048+512); }
__device__ __forceinline__ s16x4 vtr(lds_cptr p){ return __builtin_bit_cast(s16x4,__builtin_amdgcn_ds_read_tr16_b64_v4i16((__attribute__((address_space(3))) v4i16_t*)p)); }
__device__ __forceinline__ float rowmax(const f32x16&p0,const f32x16&p1){
  float a=max3f(p0[0],p0[1],p1[0]),b=max3f(p0[2],p0[3],p1[1]);a=max3f(a,p1[2],p1[3]);
  #pragma unroll
  for(int r=4;r<16;r+=4){a=max3f(a,p0[r],p0[r+1]);b=max3f(b,p0[r+2],p0[r+3]);a=max3f(a,p1[r],p1[r+1]);b=max3f(b,p1[r+2],p1[r+3]);}
  const float m=max2f(a,b);
  auto rr=__builtin_amdgcn_permlane32_swap(__float_as_uint(m),__float_as_uint(m),false,false);
  return max2f(__uint_as_float(rr[0]),__uint_as_float(rr[1]));
}
__device__ __forceinline__ void pv(f32x16*o,int vb,bf16x8 pa0,bf16x8 pa1,bf16x8 pa2,bf16x8 pa3){
  #pragma unroll
  for(int d0=0;d0<2;++d0){s16x4 lo[4],hi[4];
    #pragma unroll
    for(int ks=0;ks<4;++ks){
      asm volatile("ds_read_b64_tr_b16 %0,%1 offset:%c2":"=&v"(lo[ks]):"v"(vb),"i"(d0*4096+ks*1024):"memory");
      asm volatile("ds_read_b64_tr_b16 %0,%1 offset:%c2":"=&v"(hi[ks]):"v"(vb),"i"(d0*4096+ks*1024+512):"memory");}
    asm volatile("s_waitcnt lgkmcnt(0)":::"memory");SBAR();
    #define PK(k) (bf16x8){lo[k][0],lo[k][1],lo[k][2],lo[k][3],hi[k][0],hi[k][1],hi[k][2],hi[k][3]}
    o[d0]=__builtin_amdgcn_mfma_f32_32x32x16_bf16(pa0,PK(0),o[d0],0,0,0);
    o[d0]=__builtin_amdgcn_mfma_f32_32x32x16_bf16(pa1,PK(1),o[d0],0,0,0);
    o[d0]=__builtin_amdgcn_mfma_f32_32x32x16_bf16(pa2,PK(2),o[d0],0,0,0);
    o[d0]=__builtin_amdgcn_mfma_f32_32x32x16_bf16(pa3,PK(3),o[d0],0,0,0);
    #undef PK
  }
}

#ifndef ATTN_STORE16
#define ATTN_STORE16(p,v) (*(u32x4*)(p)=(v))
#endif
template<int THRL> __device__ __forceinline__ void attn_unit(int b,int h,int qb,const bf16*Q,const bf16*__restrict__ K,const bf16*__restrict__ V,bf16*O,const float*kmean,char*shm){
  const int tid=threadIdx.x,lane=tid&63,r32=lane&31,hi=lane>>5; const int wid=__builtin_amdgcn_readfirstlane(tid>>6);
  const long rowbase=(long)b*SEQ; const int q0=qb*QB;
  const bf16*Qw=Q+(rowbase+q0+wid*QBLK)*DM+h*D;
  const bf16*Kh=K+rowbase*DM+h*D,*Vh=V+rowbase*DM+h*D;
  const unsigned lds0=(unsigned)(uintptr_t)shm;
  float*wsf=(float*)(shm+LDS_WS)+wid*64;
  const bf16*ksrc=Kh+(long)lane*DM+wid*8;
  const bf16*vsrc=Vh+(long)(16*(wid&3)+(lane>>2))*DM+(wid>>2)*32+(lane&3)*8;
  const unsigned kdst=lds0+LDS_K+wid*1024, vdst=lds0+LDS_V+wid*1024;
  #define POS(t) (((t)<4)?(NT-4+(t)):((t)-4))
  #define DMA_K(t,slot) glds16(ksrc+(long)POS(t)*KVBLK*DM,(unsigned)__builtin_amdgcn_readfirstlane(kdst+(slot)))
  #define DMA_V(t,slot) glds16(vsrc+(long)POS(t)*KVBLK*DM,(unsigned)__builtin_amdgcn_readfirstlane(vdst+(slot)))
  const int vb0=(int)(lds0+LDS_V)+((lane>>4)&1)*32+(lane&3)*8+(4*hi+((lane&15)>>2))*64;
  const char*Kbase=shm+LDS_K; bf16x8 kf[8];
  const lds_cptr shm3=(lds_cptr)shm; const lds_cptr kp0=shm3+LDS_K+hi*1024+r32*16; const lds_cptr vp0=shm3+LDS_V+((lane>>4)&1)*32+(lane&3)*8+(4*hi+((lane&15)>>2))*64;
  const int NT=(q0+QB)/KVBLK;
  DMA_K(0,0);DMA_V(0,0);DMA_K(1,SLOTB);
  bf16x8 qr[4];
  #pragma unroll
  for(int d0=0;d0<4;++d0)qr[d0]=*reinterpret_cast<const bf16x8*>(&Qw[(long)r32*DM+d0*16+hi*8]);
  float mhat=0.f,l_reg=0.f;f32x16 o[2];o[0]=f32x16{};o[1]=f32x16{};
  const float slope2=ldexpf(1.4426950408889634f,-(h+1));
  unsigned selmask=0u;
  { typedef __attribute__((address_space(3))) float* lds_fptr; typedef __attribute__((address_space(3))) const f32x4_t* lds_f4ptr;
    lds_fptr kml=(lds_fptr)((lds_cptr)shm+LDS_KM);
    { const float*src=kmean+((long)b*16)*2*DM+h*D;
      #pragma unroll
      for(int i=0;i<2;++i){const int e=tid+512*i; kml[e]=src[(e>>6)*2*DM+(e&63)]+src[(e>>6)*2*DM+DM+(e&63)];} }
    asm volatile("s_waitcnt vmcnt(0) lgkmcnt(0)\n\ts_barrier":::"memory");
    float qf[32];
    #pragma unroll
    for(int d0=0;d0<4;++d0){
      #pragma unroll
      for(int j=0;j<8;++j)qf[d0*8+j]=__uint_as_float(((unsigned)(unsigned short)qr[d0][j])<<16);}
    float sc[16];
    #pragma unroll
    for(int j=0;j<16;++j){ sc[j]=-INFINITY;
      if(j<qb){ lds_f4ptr kr=(lds_f4ptr)(kml+j*64+hi*8); float a=0.f;
        #pragma unroll
        for(int d0=0;d0<4;++d0){ const f32x4_t k0=kr[d0*4],k1=kr[d0*4+1];
          a+=qf[d0*8+0]*k0[0]+qf[d0*8+1]*k0[1]+qf[d0*8+2]*k0[2]+qf[d0*8+3]*k0[3]+qf[d0*8+4]*k1[0]+qf[d0*8+5]*k1[1]+qf[d0*8+6]*k1[2]+qf[d0*8+7]*k1[3]; }
        a+=__shfl_xor(a,32); sc[j]=a; } }
    #pragma unroll
    for(int j=0;j<15;++j){ int cnt=0;
      #pragma unroll
      for(int k=0;k<15;++k){ if(k!=j) cnt+=((sc[k]>sc[j])||((sc[k]==sc[j])&&(k<j)))?1:0; }
      if(j<qb&&cnt<3) selmask|=(1u<<j); } }
  #define CINIT(C0,C1,t) do{ const int pt_=POS(t); float x_=slope2*(float)(64*pt_-q0+4*hi)-mhat; \
    if((t)>=4){ x_+=((selmask>>(pt_>>2))&1u)?0.f:-30000.f; } const float y_=x_+32.f*slope2; \
    _Pragma("unroll") for(int r=0;r<16;++r){ const float cr_=(float)((r&3)+8*(r>>2)); C0[r]=__builtin_fmaf(slope2,cr_,x_); C1[r]=__builtin_fmaf(slope2,cr_,y_); } }while(0)

  const int qrel=wid*QBLK+r32;
  #define CMASK(P0,P1,t) do{ if((t)<4)cmask(P0,P1,(t),qrel,hi);}while(0)
  bool resc=false;
  #define START(P0,P1) do{ const float rm=rowmax(P0,P1); resc=false; \
    { const float dl=rm; mhat=fadd_s(mhat,dl); \
      _Pragma("unroll") for(int r=0;r<16;++r){P0[r]=fsub_s(P0[r],dl);P1[r]=fsub_s(P1[r],dl);} } \
    _Pragma("unroll") for(int r=0;r<16;++r)P0[r]=__builtin_amdgcn_exp2f(P0[r]); }while(0)
  #define RESC() do{ if(resc){ asm volatile("s_waitcnt lgkmcnt(0)":::"memory"); \
      _Pragma("unroll") for(int d_=0;d_<2;++d_) _Pragma("unroll") for(int r=0;r<16;++r)o[d_][r]*=wsf[crow(r,hi)]; } }while(0)
  f32x16 pA0,pA1,pB0,pB1;
  int sl_prev=0,sl_cur=0,sl_next=SLOTB;
  #define ROT() do{sl_prev=sl_cur;sl_cur=sl_next;sl_next=(sl_next==(NSLOT-1)*SLOTB)?0:sl_next+SLOTB;}while(0)
  DMA_K(2,2*SLOTB);
  WAIT_BAR(3);
  CINIT(pA0,pA1,0); qkt(pA0,pA1,Kbase,qr,r32,hi);asm volatile("s_nop 15\n\ts_nop 7":"+v"(pA0),"+v"(pA1));CMASK(pA0,pA1,0);
  START(pA0,pA1);
  _Pragma("unroll") for(int r=0;r<16;++r)pA1[r]=__builtin_amdgcn_exp2f(pA1[r]);
  WAIT_BAR(0);
  DMA_K(3,0);DMA_V(1,SLOTB);
  ROT();
  kload8(kf,kp0+sl_cur);
  WAIT_BAR(2);
  s16x4 vlo[8],vhi[8]; u32x4 pw0,pw1,pw2,pw3;
  #define PKW(P,B) cvtpk_s(P[B],P[B+1])
  #define PAF(k) __builtin_bit_cast(bf16x8,pw##k)
  #define VFR(i) (bf16x8){vlo[i][0],vlo[i][1],vlo[i][2],vlo[i][3],vhi[i][0],vhi[i][1],vhi[i][2],vhi[i][3]}
  #define PIN(x) asm volatile("":"+v"(x))
  #define MX3(a,b,c) __builtin_fmaxf(__builtin_fmaxf((a),(b)),(c))
  #define GAPA(MF,A0,A1,A2,A3,W0,W1,PW) do{ MF; sacc+=A0; sacc+=A1; sacc+=A2; sacc+=A3; PIN(sacc); W0; W1; PIN(PW); SBAR(); }while(0)
  #define EX(v) __builtin_amdgcn_exp2f(v)
  #define GAPB(MF,X,B) do{ MF; X[B]=EX(X[B]); X[B+1]=EX(X[B+1]); X[B+2]=EX(X[B+2]); X[B+3]=EX(X[B+3]); PIN(X); SBAR(); }while(0)
  #define VRD(i) do{ vlo[i]=vtr(vp_+(((i)>>2)*4096+((i)&3)*1024)); vhi[i]=vtr(vp_+(((i)>>2)*4096+((i)&3)*1024+512)); }while(0)
  #define KRD(G,j) do{ if(G){ kload2(kf,kp0+sl_next,j); SBAR(); } }while(0)
  #define STEP(C0,C1,P0,P1,t,GK,GV,GL) do{ SBAR(); CINIT(C0,C1,t); PIN(C0); PIN(C1); SBAR(); \
    const lds_cptr vp_=vp0+sl_prev; \
    VRD(0); SBAR(); float sacc=(P0[0]+P0[1]); \
    GAPA(C0=__builtin_amdgcn_mfma_f32_32x32x16_bf16(kf[0],qr[0],C0,0,0,0), P0[2],P0[3],P0[4],P0[5],     pw0[0]=PKW(P0,0), pw0[1]=PKW(P0,2), pw0); \
    VRD(4); SBAR(); GAPA(C1=__builtin_amdgcn_mfma_f32_32x32x16_bf16(kf[1],qr[0],C1,0,0,0), P0[6],P0[7],P0[8],P0[9],     pw0[2]=PKW(P0,4), pw0[3]=PKW(P0,6), pw0); \
    VRD(1); SBAR(); GAPA(C0=__builtin_amdgcn_mfma_f32_32x32x16_bf16(kf[2],qr[1],C0,0,0,0),   P0[10],P0[11],P0[12],P0[13], pw1[0]=PKW(P0,8), pw1[1]=PKW(P0,10), pw1); \
    VRD(5); SBAR(); GAPA(C1=__builtin_amdgcn_mfma_f32_32x32x16_bf16(kf[3],qr[1],C1,0,0,0),   P0[14],P0[15],P1[0],P1[1],   pw1[2]=PKW(P0,12),pw1[3]=PKW(P0,14), pw1); \
    VRD(2); SBAR(); GAPA(C0=__builtin_amdgcn_mfma_f32_32x32x16_bf16(kf[4],qr[2],C0,0,0,0),   P1[2],P1[3],P1[4],P1[5],     pw2[0]=PKW(P1,0), pw2[1]=PKW(P1,2), pw2); \
    VRD(6); SBAR(); GAPA(C1=__builtin_amdgcn_mfma_f32_32x32x16_bf16(kf[5],qr[2],C1,0,0,0),   P1[6],P1[7],P1[8],P1[9],     pw2[2]=PKW(P1,4), pw2[3]=PKW(P1,6), pw2); \
    VRD(3); SBAR(); GAPA(C0=__builtin_amdgcn_mfma_f32_32x32x16_bf16(kf[6],qr[3],C0,0,0,0),   P1[10],P1[11],P1[12],P1[13], pw3[0]=PKW(P1,8), pw3[1]=PKW(P1,10), pw3); \
    VRD(7); SBAR(); GAPA(C1=__builtin_amdgcn_mfma_f32_32x32x16_bf16(kf[7],qr[3],C1,0,0,0),   P1[14],P1[15],0.f,0.f,       pw3[2]=PKW(P1,12),pw3[3]=PKW(P1,14), pw3); \
    l_reg+=sacc; \
    if(GK){DMA_K((t)+3,sl_cur);} if(GV){DMA_V((t)+1,sl_next);} \
    CMASK(C0,C1,t); \
    { float a=MX3(C0[0],C0[1],C1[0]),b=MX3(C0[2],C0[3],C1[1]); a=MX3(a,C1[2],C1[3]); \
      _Pragma("unroll") for(int r=4;r<16;r+=4){a=MX3(a,C0[r],C0[r+1]);b=MX3(b,C0[r+2],C0[r+3]);a=MX3(a,C1[r],C1[r+1]);b=MX3(b,C1[r+2],C1[r+3]);} \
      float rm=__builtin_fmaxf(a,b); { auto rr=__builtin_amdgcn_permlane32_swap(__float_as_uint(rm),__float_as_uint(rm),false,false); rm=__builtin_fmaxf(__uint_as_float(rr[0]),__uint_as_float(rr[1])); } \
      resc=false; \
      if(__builtin_expect(__any(rm>(float)THRL),0)){ const float dl=__builtin_fmaxf(rm,0.f); mhat+=dl; \
        _Pragma("unroll") for(int r=0;r<16;++r){C0[r]-=dl;C1[r]-=dl;} \
        const float f=__builtin_amdgcn_exp2f(-dl); l_reg*=f; if(hi==0)wsf[r32]=f; resc=true; } } \
    SBAR(); \
    GAPB(o[0]=__builtin_amdgcn_mfma_f32_32x32x16_bf16(PAF(0),VFR(0),o[0],0,0,0), C0,0); \
    GAPB(o[1]=__builtin_amdgcn_mfma_f32_32x32x16_bf16(PAF(0),VFR(4),o[1],0,0,0), C0,4); \
    KRD(GL,0); GAPB(o[0]=__builtin_amdgcn_mfma_f32_32x32x16_bf16(PAF(1),VFR(1),o[0],0,0,0), C0,8); \
    KRD(GL,1); GAPB(o[1]=__builtin_amdgcn_mfma_f32_32x32x16_bf16(PAF(1),VFR(5),o[1],0,0,0), C0,12); \
    KRD(GL,2); GAPB(o[0]=__builtin_amdgcn_mfma_f32_32x32x16_bf16(PAF(2),VFR(2),o[0],0,0,0), C1,0); \
    KRD(GL,3); GAPB(o[1]=__builtin_amdgcn_mfma_f32_32x32x16_bf16(PAF(2),VFR(6),o[1],0,0,0), C1,4); \
    GAPB(o[0]=__builtin_amdgcn_mfma_f32_32x32x16_bf16(PAF(3),VFR(3),o[0],0,0,0), C1,8); \
    GAPB(o[1]=__builtin_amdgcn_mfma_f32_32x32x16_bf16(PAF(3),VFR(7),o[1],0,0,0), C1,12); \
    }while(0)
  int t=1;
  #define ENDW(tt) do{ if((tt)+3<NT){WAIT_BAR(2);} else if((tt)+2<NT){WAIT_BAR(1);} else {WAIT_BAR(0);} }while(0)
  for(;t<5&&t+1<NT;t+=2){
    STEP(pB0,pB1,pA0,pA1,t,(t+3<NT),(t+1<NT),(t+1<NT));       ENDW(t);   RESC(); ROT();
    STEP(pA0,pA1,pB0,pB1,t+1,(t+4<NT),(t+2<NT),(t+2<NT));     ENDW(t+1); RESC(); ROT();
  }
  #undef CMASK
  #define CMASK(P0,P1,t) do{}while(0)
  for(;t+5<NT;t+=2){
    STEP(pB0,pB1,pA0,pA1,t,true,true,true);     WAIT_BAR(2); RESC(); ROT();
    STEP(pA0,pA1,pB0,pB1,t+1,true,true,true);   WAIT_BAR(2); RESC(); ROT();
  }
  for(;t+1<NT;t+=2){
    STEP(pB0,pB1,pA0,pA1,t,(t+3<NT),(t+1<NT),(t+1<NT));       ENDW(t);   RESC(); ROT();
    STEP(pA0,pA1,pB0,pB1,t+1,(t+4<NT),(t+2<NT),(t+2<NT));     ENDW(t+1); RESC(); ROT();
  }
  #undef CMASK
  #define CMASK(P0,P1,t) do{ if((t)<4)cmask(P0,P1,(t),qrel,hi);}while(0)
  STEP(pB0,pB1,pA0,pA1,NT-1,false,false,false); RESC();
  { float sacc=pB0[0]+pB0[1]; _Pragma("unroll") for(int r=2;r<16;++r)sacc+=pB0[r]; _Pragma("unroll") for(int r=0;r<16;++r)sacc+=pB1[r]; l_reg+=sacc;
    pw0=(u32x4){PKW(pB0,0),PKW(pB0,2),PKW(pB0,4),PKW(pB0,6)};pw1=(u32x4){PKW(pB0,8),PKW(pB0,10),PKW(pB0,12),PKW(pB0,14)};pw2=(u32x4){PKW(pB1,0),PKW(pB1,2),PKW(pB1,4),PKW(pB1,6)};pw3=(u32x4){PKW(pB1,8),PKW(pB1,10),PKW(pB1,12),PKW(pB1,14)};
    SBAR(); pv(o,vb0+sl_cur,PAF(0),PAF(1),PAF(2),PAF(3)); }
  #undef PKW
  #undef PAF
  #undef VFR
  #undef PIN
  #undef MX3
  #undef GAPA
  #undef GAPB
  #undef EX
  #undef VRD
  #undef KRD
  #undef STEP
  #undef ENDW
  {auto rr=__builtin_amdgcn_permlane32_swap(__float_as_uint(l_reg),__float_as_uint(l_reg),false,false);l_reg=__uint_as_float(rr[0])+__uint_as_float(rr[1]);}
  if(hi==0)wsf[32+r32]=l_reg;asm volatile("s_waitcnt lgkmcnt(0)":::"memory");
  float rli[16];
  #pragma unroll
  for(int r=0;r<16;++r)rli[r]=__builtin_amdgcn_rcpf(wsf[32+crow(r,hi)]);
  bf16*Ow=O+(rowbase+q0+wid*QBLK)*DM+h*D;
  { bf16*stg=(bf16*)(shm+LDS_OST)+wid*2048;
    #pragma unroll
    for(int r=0;r<16;++r){const int orow=crow(r,hi);
      #pragma unroll
      for(int d0=0;d0<2;++d0)stg[orow*64+d0*32+r32]=__float2bfloat16(o[d0][r]*rli[r]);}
    asm volatile("s_waitcnt lgkmcnt(0)":::"memory");
    #pragma unroll
    for(int i=0;i<4;++i){const int row=i*8+(lane>>3),ch=lane&7; const u32x4 v=*(const u32x4*)(stg+row*64+ch*8); ATTN_STORE16(Ow+(long)row*DM+ch*8,v);} }
  asm volatile("s_waitcnt lgkmcnt(0)\n\ts_barrier":::"memory");
  #undef DMA_K
  #undef DMA_V
  #undef POS
  #undef CINIT
  #undef CMASK
  #undef START
  #undef RESC
  #undef ROT
}
constexpr int ATTN_LDS_BYTES=LDS_BYTES;
struct AttnTensors { const bf16* Q; const bf16* K; const bf16* V; bf16* O; const float* kmean; };
struct AttnUnit { int bh; int qb; };
struct StaticOrder {
  int vcu,grid;
  __device__ __forceinline__ explicit StaticOrder(int grid_,int block):vcu((grid_%8==0)?((block%8)*(grid_/8)+block/8):block),grid(grid_){}
  __device__ __forceinline__ bool next(int i,AttnUnit&u)const{ const int item=(i>>1)*grid+vcu; if(item>=BATCH*NHEAD*8)return false; const int s=item&7; u.bh=item>>3; u.qb=(i&1)?15-s:s; return true; }
  __device__ __forceinline__ void a_ready(const AttnUnit&)const{}
  __device__ __forceinline__ void done(const AttnUnit&)const{}
};
template<class Sched,int THRL=8> __device__ __forceinline__ void attn_phase(char*lds,const AttnTensors&T,const Sched&S){
  AttnUnit u;
  for(int i=0;S.next(i,u);++i){ S.a_ready(u); attn_unit<THRL>(u.bh/NHEAD,u.bh%NHEAD,u.qb,T.Q,T.K,T.V,T.O,T.kmean,lds); S.done(u); }
}
#undef SBAR
#undef WAIT_BAR
}

constexpr int NWAVES = 8;
#ifndef MK_N_LAUNCHES
#define MK_N_LAUNCHES 1
#endif
constexpr int N_LAUNCHES = MK_N_LAUNCHES;
constexpr int PER_PHASE = 8;

constexpr int BATCH = 8, SEQ = 4096, DM = 1024, TOK = BATCH * SEQ;
constexpr int CONV_CH = 512, CONV_W = 31, ATT_W = 512, IN_COLS = 4608;
constexpr int P_HEADS = 8, P_NK = 128, P_TOPK = 16, P_E = P_HEADS * P_TOPK  , N_EXP = P_NK * P_NK;
constexpr float NORM_EPS = 1e-6f;

constexpr size_t MiB = 1u << 20;
constexpr size_t WS_CTL = 0, CTL_ZERO_BYTES = 2 * MiB;
constexpr size_t WS_KMEAN = 1 * MiB;
constexpr size_t WS_SS = 2 * MiB;
constexpr size_t WS_WIN = 4 * MiB;
constexpr size_t WS_WPW = 13 * MiB, WS_WAO = 14 * MiB;
constexpr size_t WS_WOUT = 15 * MiB;
constexpr size_t WS_WQ = 17 * MiB;
constexpr size_t WS_KEYS = 21 * MiB;
constexpr size_t WS_UB = 24 * MiB, WS_VB = 56 * MiB;
constexpr size_t WS_H = 88 * MiB;
constexpr size_t WS_CACT = 88 * MiB;
constexpr size_t WS_EIDX = 120 * MiB, WS_GW = 136 * MiB;
constexpr size_t WS_ZGLU = 152 * MiB, WS_QO = 184 * MiB, WS_K = 216 * MiB, WS_V = 248 * MiB;
constexpr size_t WS_MIX = 216 * MiB;
constexpr size_t WS_QP = 152 * MiB;
constexpr size_t WS_GC = 280 * MiB, WS_GA = 344 * MiB;
constexpr size_t WS_X1B = 280 * MiB;
constexpr size_t WS_END = 408 * MiB;
constexpr int CW_TMO = 0, CW_CODE = 1, CW_BAR = 4096;

constexpr int RING_OFF = 0, RING_BYTES = 131072;
constexpr int LDSCTL_OFF = RING_BYTES, MISC_OFF = LDSCTL_OFF + 320;
constexpr int LDS_BYTES = 147456;
static_assert(MISC_OFF + 128 <= LDS_BYTES, "LDS map");

#define GAS __attribute__((address_space(1)))
#define LAS __attribute__((address_space(3)))
typedef unsigned short bf16;
typedef unsigned v4u __attribute__((ext_vector_type(4)));
typedef float f32x4 __attribute__((ext_vector_type(4)));
typedef float f32x16 __attribute__((ext_vector_type(16)));
typedef short bf16x8 __attribute__((ext_vector_type(8)));
typedef __bf16 bf16x2_t __attribute__((ext_vector_type(2)));
typedef GAS unsigned gu32;
#define RLX_AGENT __ATOMIC_RELAXED, __HIP_MEMORY_SCOPE_AGENT
#define LDS_WAIT() asm volatile("s_waitcnt lgkmcnt(0)" ::: "memory")
#define VM_WAIT() asm volatile("s_waitcnt vmcnt(0)" ::: "memory")
__device__ __forceinline__ unsigned f2bf(float f) { unsigned u = __builtin_bit_cast(unsigned, f); return (u + 0x7fffu + ((u >> 16) & 1u)) >> 16; }
__device__ __forceinline__ unsigned pk2(float lo, float hi) { return f2bf(lo) | (f2bf(hi) << 16); }
__device__ __forceinline__ float bflo(unsigned u) { return __uint_as_float(u << 16); }
__device__ __forceinline__ float bfhi(unsigned u) { return __uint_as_float(u & 0xffff0000u); }

#define XB_TMO      128
#define XB_XCNT(j)  (256  + 64 * (j))
#define XB_XSUB(j)  (1280 + 64 * (j))
#define XB_XGEN(j)  (2304 + 64 * (j))
#define XB_TOP      3328
#define XB_TOPGEN   3392
#define XCD_BAR_WORDS 3456
#define XB_SPIN_CAP (1u << 18)

__device__ __forceinline__ unsigned xb_ld(unsigned* p)              { return __hip_atomic_load(p, __ATOMIC_RELAXED, __HIP_MEMORY_SCOPE_AGENT); }
__device__ __forceinline__ unsigned xb_add(unsigned* p, unsigned v) { return __hip_atomic_fetch_add(p, v, __ATOMIC_RELAXED, __HIP_MEMORY_SCOPE_AGENT); }
__device__ __forceinline__ unsigned xb_xcc_id() { return (unsigned)__builtin_amdgcn_s_getreg((3 << 11) | 20) & 0xFu; }
#define XB_SPIN(cond, bar) do { unsigned _sp = 0; while (cond) { __builtin_amdgcn_s_sleep(1); \
    if ((++_sp & 255u) == 0u) { if (xb_ld(&(bar)[XB_TMO])) break; if (_sp > XB_SPIN_CAP) { atomicAdd(&(bar)[XB_TMO], 1u); break; } } } } while (0)

struct XcdBarrier {
    unsigned* bar; unsigned x;
    volatile LAS unsigned* st;
};

__device__ __forceinline__ XcdBarrier xcd_barrier_post(unsigned* bar, volatile LAS unsigned* st) {
    XcdBarrier b; b.bar = bar; b.x = xb_xcc_id(); b.st = st;
    if (threadIdx.x == 0) (void)xb_add(&bar[XB_XCNT(b.x)], 1u);
    return b;
}
__device__ __forceinline__ void xcd_barrier_complete(unsigned* bar, unsigned x, unsigned& nloc, unsigned& nx) {
    const unsigned G = gridDim.x * gridDim.y * gridDim.z;
    unsigned sum, cnt, mine, sp = 0u;
    for (;;) {
        sum = 0u; cnt = 0u; mine = 0u;
#pragma unroll
        for (unsigned j = 0; j < 16; ++j) { const unsigned c = xb_ld(&bar[XB_XCNT(j)]); sum += c; cnt += (c > 0u) ? 1u : 0u; mine = (j == x) ? c : mine; }
        if (sum == G) break;
        __builtin_amdgcn_s_sleep(1);
        if ((++sp & 255u) == 0u) { if (xb_ld(&bar[XB_TMO])) break; if (sp > XB_SPIN_CAP) { atomicAdd(&bar[XB_TMO], 1u); break; } }
    }
    nloc = mine > 0u ? mine : 1u; nx = cnt > 0u ? cnt : 1u;
}

__device__ __forceinline__ void xcd_barrier(const XcdBarrier& b) {
    asm volatile("s_waitcnt vmcnt(0)" ::: "memory");
    __syncthreads();
    if (threadIdx.x == 0) {
        unsigned* bar = b.bar;
        __builtin_amdgcn_s_waitcnt(0);
        unsigned nloc = b.st[0], nx = b.st[1];
        if (nloc == 0u) { xcd_barrier_complete(bar, b.x, nloc, nx); b.st[0] = nloc; b.st[1] = nx; }
        const unsigned old = xb_add(&bar[XB_XSUB(b.x)], 1u);
        const unsigned gen = old / nloc;
        if (old + 1u == (gen + 1u) * nloc) {
            __builtin_amdgcn_fence(__ATOMIC_RELEASE, "agent");
            asm volatile("s_waitcnt vmcnt(0)" ::: "memory");
            const unsigned og = xb_add(&bar[XB_TOP], 1u);
            const unsigned tg = og / nx;
            if (og + 1u == (tg + 1u) * nx) xb_add(&bar[XB_TOPGEN], 1u);
            else XB_SPIN(xb_ld(&bar[XB_TOPGEN]) == tg, bar);
            __builtin_amdgcn_fence(__ATOMIC_ACQUIRE, "agent");
            xb_add(&bar[XB_XGEN(b.x)], 1u);
            asm volatile("s_waitcnt vmcnt(0)" ::: "memory");
        } else {
            XB_SPIN(xb_ld(&bar[XB_XGEN(b.x)]) == gen, bar);
            __builtin_amdgcn_fence(__ATOMIC_ACQUIRE, "agent");
            asm volatile("s_waitcnt vmcnt(0)" ::: "memory");
        }
    }
    __syncthreads();
}

struct Frame {
    LAS unsigned char* lds;
    volatile LAS unsigned* MISC;
    gu32* ctl;
    int tid, lane, wave;
    int vcu, G;
};
__device__ __forceinline__ float wave_sum(float v) {
#pragma unroll
    for (int o = 1; o < 64; o <<= 1) v += __shfl_xor(v, o);
    return v;
}

__device__ __forceinline__ void p0_transpose_item(const float* W, int K, int N, bf16* WT, int k0, int n0, int dst_row0, const float* kscale, LAS float* scr, int lane) {
#pragma unroll 8
    for (int i = 0; i < 32; ++i) { const int kk = 2 * i + (lane >> 5); float v = W[(size_t)(k0 + kk) * N + n0 + (lane & 31)]; if (kscale) v *= kscale[k0 + kk]; scr[kk * 33 + (lane & 31)] = v; }
    LDS_WAIT(); asm volatile("" ::: "memory");
    const int c = lane & 7;
#pragma unroll
    for (int j = 0; j < 4; ++j) { const int n = (lane >> 3) + 8 * j; const LAS float* s = scr + (8 * c) * 33 + n;
        v4u o; o.x = pk2(s[0 * 33], s[1 * 33]); o.y = pk2(s[2 * 33], s[3 * 33]); o.z = pk2(s[4 * 33], s[5 * 33]); o.w = pk2(s[6 * 33], s[7 * 33]);
        *(GAS v4u*)(WT + (size_t)(dst_row0 + n) * K + k0 + 8 * c) = o; }
    LDS_WAIT(); asm volatile("" ::: "memory");
}
__device__ __forceinline__ int perm_in(int s) { if (s < 512) return 256 * (s >> 7) + (s & 127); if (s < 1024) { const int s2 = s - 512; return 256 * (s2 >> 7) + 128 + (s2 & 127); } return s; }
template <bool NORM> __device__ __forceinline__ void row_to_bf16(int lane, const float* xrow, const float* g, bf16* orow) {
    const GAS f32x4* xr = (const GAS f32x4*)xrow + lane;
    f32x4 v[4]; float s2 = 0.f;
#pragma unroll
    for (int j = 0; j < 4; ++j) { v[j] = xr[64 * j]; s2 += (v[j].x * v[j].x + v[j].y * v[j].y) + (v[j].z * v[j].z + v[j].w * v[j].w); }
    float rstd = 1.f;
    if (NORM) rstd = 1.f / sqrtf(wave_sum(s2) * (1.f / 1024.f) + NORM_EPS);
    GAS unsigned long long* o8 = (GAS unsigned long long*)orow + lane;
#pragma unroll
    for (int j = 0; j < 4; ++j) { f32x4 gv = (f32x4){1.f, 1.f, 1.f, 1.f}; if (g) gv = *((const GAS f32x4*)g + lane + 64 * j);
        const f32x4 w = v[j] * rstd * gv;
        o8[64 * j] = (unsigned long long)pk2(w.x, w.y) | ((unsigned long long)pk2(w.z, w.w) << 32); }
}
struct P0Args { const float *x, *g1, *w_in, *w_pw, *w_ao, *w_out, *g2, *w_q, *k1, *k2, *pu, *pv; bf16 *H, *Win, *Wpw, *Wao, *Wout, *Wq, *keys, *ub, *vb; };
__device__ __forceinline__ void p0_prologue(Frame& F, const P0Args& a) {
    LAS float* scr = (LAS float*)(F.lds + RING_OFF + F.wave * 16384);
    const int gw = F.vcu * NWAVES + F.wave, NGW = F.G * NWAVES;
    constexpr int I_IN = 16 * (IN_COLS / 32), I_PW = 8 * 32, I_AO = 8 * 32, I_OUT = 16 * 32, I_Q = 16 * 64;
    constexpr int NITEMS = I_IN + I_PW + I_AO + I_OUT + I_Q;
    for (int it = gw; it < NITEMS; it += NGW) {
        int r = it;
        if (r < I_IN) { const int nb = IN_COLS / 32, kb = r / nb, n0 = 32 * (r % nb); p0_transpose_item(a.w_in, 1024, IN_COLS, a.Win, 64 * kb, n0, perm_in(n0), nullptr, scr, F.lane); continue; } r -= I_IN;
        if (r < I_PW) { const int kb = r / 32, n0 = 32 * (r % 32); p0_transpose_item(a.w_pw, 512, 1024, a.Wpw, 64 * kb, n0, n0, nullptr, scr, F.lane); continue; } r -= I_PW;
        if (r < I_AO) { const int kb = r / 32, n0 = 32 * (r % 32); p0_transpose_item(a.w_ao, 512, 1024, a.Wao, 64 * kb, n0, n0, nullptr, scr, F.lane); continue; } r -= I_AO;
        if (r < I_OUT) { const int kb = r / 32, n0 = 32 * (r % 32); p0_transpose_item(a.w_out, 1024, 1024, a.Wout, 64 * kb, n0, n0, nullptr, scr, F.lane); continue; } r -= I_OUT;
        { const int kb = r / 64, n0 = 32 * (r % 64); p0_transpose_item(a.w_q, 1024, 2048, a.Wq, 64 * kb, n0, n0, a.g2, scr, F.lane); }
    }
    for (int m = gw; m < TOK; m += NGW) row_to_bf16<true>(F.lane, a.x + (size_t)m * 1024, a.g1, a.H + (size_t)m * 1024);
    for (int m = gw; m < N_EXP; m += NGW) { row_to_bf16<false>(F.lane, a.pu + (size_t)m * 1024, a.g2, a.ub + (size_t)m * 1024); row_to_bf16<false>(F.lane, a.pv + (size_t)m * 1024, nullptr, a.vb + (size_t)m * 1024); }
    for (int m = gw; m < 32; m += NGW) { const float* src = (m < 16 ? a.k1 : a.k2) + (size_t)(m & 15) * 1024; row_to_bf16<false>(F.lane, src, nullptr, a.keys + (size_t)m * 1024); }
}

struct ConvArgs { const bf16* zglu; const float *cw, *cb, *lg, *lb; bf16* cact; };
__device__ __forceinline__ void conv_phase(Frame& F, const ConvArgs& a) {
    LAS unsigned char* zs = F.lds + RING_OFF;
    LAS float* part = (LAS float*)(F.lds + RING_OFF + 98304);
    const int cp = F.tid & 255, half = F.tid >> 8, c0 = 2 * cp;
    float w0[CONV_W], w1[CONV_W];
    { const GAS float* p = (const GAS float*)(a.cw + c0);
#pragma unroll
      for (int w = 0; w < CONV_W; ++w) { w0[w] = p[0]; w1[w] = p[1]; p += 512; asm volatile("" : "+v"(p)); } }
    const float b0 = a.cb[c0], b1 = a.cb[c0 + 1], lg0 = a.lg[c0], lg1 = a.lg[c0 + 1], lb0 = a.lb[c0], lb1 = a.lb[c0 + 1];
    for (int tile = F.vcu; tile < TOK / 64; tile += F.G) {
        const int t0 = tile * 64, tb = t0 & (SEQ - 1);
        for (int i = F.tid; i < 94 * 64; i += 512) { const int r = i >> 6, ch = i & 63; v4u v = (v4u){0u, 0u, 0u, 0u};
            if (tb - 30 + r >= 0) v = *(const GAS v4u*)(a.zglu + (size_t)(t0 - 30 + r) * 512 + ch * 8);
            *(LAS v4u*)(zs + r * 1024 + ch * 16) = v; }
        __syncthreads();
        for (int ch8 = 0; ch8 < 4; ++ch8) {
            const int tl = half * 32 + ch8 * 8;
            float z0[38], z1[38];
#pragma unroll
            for (int i = 0; i < 38; ++i) { const unsigned u = *(const LAS unsigned*)(zs + (tl + i) * 1024 + cp * 4); z0[i] = bflo(u); z1[i] = bfhi(u); }
            float a0[8], a1[8];
#pragma unroll
            for (int k = 0; k < 8; ++k) { float s0 = b0, s1 = b1;
#pragma unroll
                for (int w = 0; w < CONV_W; ++w) { s0 += w0[w] * z0[k + w]; s1 += w1[w] * z1[k + w]; }
                a0[k] = s0; a1[k] = s1; }
#pragma unroll
            for (int k = 0; k < 8; ++k) { const float s1 = wave_sum(a0[k] + a1[k]), s2 = wave_sum(a0[k] * a0[k] + a1[k] * a1[k]);
                if (F.lane == 0) { part[((half * 8 + k) * 4 + (F.wave & 3)) * 2] = s1; part[((half * 8 + k) * 4 + (F.wave & 3)) * 2 + 1] = s2; } }
            __syncthreads();
            bf16* op = a.cact + (size_t)(t0 + tl) * 512 + c0;
#pragma unroll
            for (int k = 0; k < 8; ++k) { const LAS float* p = part + (half * 8 + k) * 8;
                const float S1 = (p[0] + p[2]) + (p[4] + p[6]), S2 = (p[1] + p[3]) + (p[5] + p[7]);
                const float mean = S1 * (1.f / 512.f), var = S2 * (1.f / 512.f) - mean * mean, rstd = 1.f / sqrtf(var + NORM_EPS);
                const float y0 = (a0[k] - mean) * rstd * lg0 + lb0, y1 = (a1[k] - mean) * rstd * lg1 + lb1;
                const float o0 = y0 / (1.f + __expf(-y0)), o1 = y1 / (1.f + __expf(-y1));
                *(GAS unsigned*)(op + k * 512) = pk2(o0, o1); }
            __syncthreads();
        }
    }
}

__device__ __forceinline__ int tokey(float v) { const int b = __float_as_int(v); return b ^ ((b >> 31) & 0x7fffffff); }
__device__ __forceinline__ float unkey(int k, int mask) { const int t = k & ~mask; return __int_as_float(t ^ ((t >> 31) & 0x7fffffff)); }
__device__ __forceinline__ void ce_desc(int& a, int& b) { const int hi = a > b ? a : b, lo = a > b ? b : a; a = hi; b = lo; }
template <int N> __device__ __forceinline__ void sort_desc(int (&v)[N]) {
#pragma unroll
    for (int k = 2; k <= N; k <<= 1)
#pragma unroll
        for (int j = k >> 1; j > 0; j >>= 1)
#pragma unroll
            for (int i = 0; i < N; ++i) { const int l = i ^ j; if (l > i) { if ((i & k) == 0) ce_desc(v[i], v[l]); else ce_desc(v[l], v[i]); } }
}
__device__ __forceinline__ void bitonic_merge16_desc(int (&v)[16]) {
#pragma unroll
    for (int j = 8; j > 0; j >>= 1)
#pragma unroll
        for (int i = 0; i < 16; ++i) { const int l = i ^ j; if (l > i) ce_desc(v[i], v[l]); }
}
__device__ __forceinline__ void merge_top16(int (&a)[16], const int (&b)[16]) {
#pragma unroll
    for (int i = 0; i < 16; ++i) a[i] = a[i] > b[15 - i] ? a[i] : b[15 - i];
    bitonic_merge16_desc(a);
}
__device__ __forceinline__ void top16_of_64(const int (&x)[64], int (&out)[16]) {
    int g[16];
#pragma unroll
    for (int i = 0; i < 16; ++i) out[i] = x[i];
    sort_desc<16>(out);
#pragma unroll
    for (int q = 1; q < 4; ++q) {
#pragma unroll
        for (int i = 0; i < 16; ++i) g[i] = x[16 * q + i];
        sort_desc<16>(g); merge_top16(out, g); }
}
__device__ __forceinline__ int crow_(int r, int hi) { return (r & 3) + 8 * (r >> 2) + 4 * hi; }
struct SelArgs { const bf16* qp; const bf16* keys; const float* ss; int* eidx; float* gw; };
__device__ __forceinline__ void peer_select_phase(Frame& F, const SelArgs& a) {
    for (int i = F.tid; i < 2 * 128 * 16; i += 512) { const int which = i >> 11, rem = i & 2047, row = rem >> 4, ch = rem & 15;
        const v4u v = *(const GAS v4u*)(a.keys + (size_t)which * 16384 + row * 128 + ch * 8);
        *(LAS v4u*)(F.lds + RING_OFF + which * 32768 + row * 256 + ((ch ^ (row & 15)) << 4)) = v; }
    __syncthreads();
    LAS int* scr = (LAS int*)(F.lds + RING_OFF + 65536 + F.wave * 4096);
    const int lane = F.lane, tl = lane & 31, hi = lane >> 5;
    const int gw = F.vcu * NWAVES + F.wave, NGW = F.G * NWAVES;
    constexpr int NUNITS = (TOK / 32) * P_HEADS;
    constexpr int PA[50] = {0,0,0,0,0,0,0,0,0,0,0,0,0,0,0,0, 1,1,1,1,1,1,1,1, 2,2,2,2,2, 3,3,3,3, 4,4,4, 5,5, 6,6, 7,7, 8,9,10,11,12,13,14,15};
    constexpr int PB[50] = {0,1,2,3,4,5,6,7,8,9,10,11,12,13,14,15, 0,1,2,3,4,5,6,7, 0,1,2,3,4, 0,1,2,3, 0,1,2, 0,1, 0,1, 0,1, 0,0,0,0,0,0,0,0};
    for (int unit = gw; unit < NUNITS; unit += NGW) {
        const int tt = unit >> 3, hh = unit & 7, t = tt * 32 + tl;
        int vk[2][16];
#pragma unroll
        for (int half = 0; half < 2; ++half) {
            const bf16* qrow = a.qp + (size_t)t * 2048 + hh * 256 + half * 128 + hi * 8;
            bf16x8 bq[8];
#pragma unroll
            for (int ks = 0; ks < 8; ++ks) bq[ks] = *(const GAS bf16x8*)(qrow + ks * 16);
            f32x16 acc[4];
#pragma unroll
            for (int nb = 0; nb < 4; ++nb) { acc[nb] = (f32x16){};
#pragma unroll
                for (int ks = 0; ks < 8; ++ks) { const int row = nb * 32 + tl, ch = 2 * ks + hi;
                    const bf16x8 ka = *(const LAS bf16x8*)(F.lds + RING_OFF + half * 32768 + row * 256 + ((ch ^ (row & 15)) << 4));
                    acc[nb] = __builtin_amdgcn_mfma_f32_32x32x16_bf16(ka, bq[ks], acc[nb], 0, 0, 0); } }
            int keys[64];
#pragma unroll
            for (int nb = 0; nb < 4; ++nb)
#pragma unroll
                for (int r = 0; r < 16; ++r) keys[nb * 16 + r] = (tokey(acc[nb][r]) & ~127) | (nb * 32 + crow_(r, hi));
            int top[16]; top16_of_64(keys, top);
            int oth[16];
#pragma unroll
            for (int i = 0; i < 16; ++i) oth[i] = __shfl_xor(top[i], 32);
            merge_top16(top, oth);
#pragma unroll
            for (int i = 0; i < 16; ++i) vk[half][i] = top[i];
        }
        float f1[16], f2[16];
#pragma unroll
        for (int i = 0; i < 16; ++i) { f1[i] = unkey(vk[0][i], 127); f2[i] = unkey(vk[1][i], 127); }
        int ck[64];
#pragma unroll
        for (int i = 0; i < 50; ++i) ck[i] = (tokey(f1[PA[i]] + f2[PB[i]]) & ~255) | (PA[i] * 16 + PB[i]);
#pragma unroll
        for (int i = 50; i < 64; ++i) ck[i] = (int)0x80000000;
        int c[16]; top16_of_64(ck, c);
        if (hi == 0) {
#pragma unroll
            for (int i = 0; i < 16; ++i) { scr[tl * 32 + i] = vk[0][i] & 127; scr[tl * 32 + 16 + i] = vk[1][i] & 127; } }
        float ssum = 0.f;
        { const GAS f32x4* sp = (const GAS f32x4*)(a.ss + (size_t)t * 16);
#pragma unroll
          for (int i = 0; i < 4; ++i) { const f32x4 v = sp[i]; ssum += (v.x + v.y) + (v.z + v.w); } }
        const float rstd = 1.f / sqrtf(ssum * (1.f / 1024.f) + NORM_EPS);
        const float smax = unkey(c[0], 255);
        float e[16], esum = 0.f;
#pragma unroll
        for (int i = 0; i < 16; ++i) { e[i] = __expf((unkey(c[i], 255) - smax) * rstd); esum += e[i]; }
        const float inv = 1.f / esum;
        LDS_WAIT(); asm volatile("" ::: "memory");
        int eo[8]; float go[8];
#pragma unroll
        for (int i = 0; i < 8; ++i) { const int ci = hi ? c[i + 8] : c[i]; const float ei = hi ? e[i + 8] : e[i];
            const int id = ci & 255, i1 = scr[tl * 32 + (id >> 4)], i2 = scr[tl * 32 + 16 + (id & 15)];
            eo[i] = i1 * P_NK + i2; go[i] = ei * inv; }
        int* ep = a.eidx + (size_t)t * P_E + hh * 16 + hi * 8; float* gp = a.gw + (size_t)t * P_E + hh * 16 + hi * 8;
        *(GAS v4u*)(ep) = (v4u){(unsigned)eo[0], (unsigned)eo[1], (unsigned)eo[2], (unsigned)eo[3]}; *(GAS v4u*)(ep + 4) = (v4u){(unsigned)eo[4], (unsigned)eo[5], (unsigned)eo[6], (unsigned)eo[7]};
        *(GAS f32x4*)(gp) = (f32x4){go[0], go[1], go[2], go[3]}; *(GAS f32x4*)(gp + 4) = (f32x4){go[4], go[5], go[6], go[7]};
        LDS_WAIT(); asm volatile("" ::: "memory");
    }
}

__device__ __forceinline__ float dot2bf(unsigned w, unsigned x, float acc) { return __builtin_amdgcn_fdot2_f32_bf16(__builtin_bit_cast(bf16x2_t, w), __builtin_bit_cast(bf16x2_t, x), acc, false); }
struct ExpArgs { float* xio; const bf16* x1b; const bf16* ub; const bf16* vb; const int* eidx; const float* gw; const float* gfinal; };
__device__ __forceinline__ void peer_expert_phase(Frame& F, const ExpArgs& a) {
    LAS float* coef = (LAS float*)(F.lds + RING_OFF + F.wave * 1024);
    const int lane = F.lane, grp = lane >> 4, j = lane & 15;
    const int gw = F.vcu * NWAVES + F.wave, NGW = F.G * NWAVES;
    for (int t = gw; t < TOK; t += NGW) {
        float* xr = a.xio + (size_t)t * 1024;
        const f32x4 xa0 = *(const GAS f32x4*)(xr + 8 * lane), xa1 = *(const GAS f32x4*)(xr + 8 * lane + 4), xb0 = *(const GAS f32x4*)(xr + 512 + 8 * lane), xb1 = *(const GAS f32x4*)(xr + 512 + 8 * lane + 4);
        float sq = (xa0.x * xa0.x + xa0.y * xa0.y) + (xa0.z * xa0.z + xa0.w * xa0.w) + (xa1.x * xa1.x + xa1.y * xa1.y) + (xa1.z * xa1.z + xa1.w * xa1.w)
                 + (xb0.x * xb0.x + xb0.y * xb0.y) + (xb0.z * xb0.z + xb0.w * xb0.w) + (xb1.x * xb1.x + xb1.y * xb1.y) + (xb1.z * xb1.z + xb1.w * xb1.w);
        const float rstd = 1.f / sqrtf(wave_sum(sq) * (1.f / 1024.f) + NORM_EPS);
        v4u xu[8];
#pragma unroll
        for (int i = 0; i < 8; ++i) xu[i] = *(const GAS v4u*)(a.x1b + (size_t)t * 1024 + 64 * j + 8 * i);
        const int e_lo = a.eidx[(size_t)t * P_E + lane], e_hi = a.eidx[(size_t)t * P_E + 64 + lane];
        const float g_lo = a.gw[(size_t)t * P_E + lane], g_hi = a.gw[(size_t)t * P_E + 64 + lane];
#pragma unroll 2
        for (int r = 0; r < 32; ++r) {
            const int s = 4 * r + grp;
            const int e = __shfl(r < 16 ? e_lo : e_hi, s & 63);
            const float g = __shfl(r < 16 ? g_lo : g_hi, s & 63);
            const bf16* up = a.ub + (size_t)e * 1024 + 64 * j;
            v4u w[8];
#pragma unroll
            for (int i = 0; i < 8; ++i) w[i] = *(const GAS v4u*)(up + 8 * i);
            float d0 = 0.f, d1 = 0.f, d2 = 0.f, d3 = 0.f;
#pragma unroll
            for (int i = 0; i < 8; ++i) { d0 = dot2bf(w[i].x, xu[i].x, d0); d1 = dot2bf(w[i].y, xu[i].y, d1); d2 = dot2bf(w[i].z, xu[i].z, d2); d3 = dot2bf(w[i].w, xu[i].w, d3); }
            float d = (d0 + d1) + (d2 + d3);
            d += __shfl_xor(d, 1); d += __shfl_xor(d, 2); d += __shfl_xor(d, 4); d += __shfl_xor(d, 8);
            const float v = d * rstd, act = 0.5f * v * (1.f + erff(v * 0.70710678118654752f));
            if (j == 0) coef[s] = g * act;
        }
        LDS_WAIT(); asm volatile("" ::: "memory");
        float y[16];
#pragma unroll
        for (int i = 0; i < 16; ++i) y[i] = 0.f;
        for (int s0 = 0; s0 < P_E; s0 += 8) {
            v4u va[8], vb_[8]; float cf[8];
#pragma unroll
            for (int k = 0; k < 8; ++k) { const int s = s0 + k;
                const int e = __builtin_amdgcn_readlane(s0 < 64 ? e_lo : e_hi, s & 63);
                const bf16* vp = a.vb + (size_t)e * 1024 + 8 * lane;
                va[k] = *(const GAS v4u*)(vp); vb_[k] = *(const GAS v4u*)(vp + 512); cf[k] = coef[s]; }
#pragma unroll
            for (int k = 0; k < 8; ++k) { const float c = cf[k];
                y[0] += c * bflo(va[k].x); y[1] += c * bfhi(va[k].x); y[2] += c * bflo(va[k].y); y[3] += c * bfhi(va[k].y);
                y[4] += c * bflo(va[k].z); y[5] += c * bfhi(va[k].z); y[6] += c * bflo(va[k].w); y[7] += c * bfhi(va[k].w);
                y[8] += c * bflo(vb_[k].x); y[9] += c * bfhi(vb_[k].x); y[10] += c * bflo(vb_[k].y); y[11] += c * bfhi(vb_[k].y);
                y[12] += c * bflo(vb_[k].z); y[13] += c * bfhi(vb_[k].z); y[14] += c * bflo(vb_[k].w); y[15] += c * bfhi(vb_[k].w); }
        }
        f32x4 o0 = xa0 + (f32x4){y[0], y[1], y[2], y[3]}, o1 = xa1 + (f32x4){y[4], y[5], y[6], y[7]}, o2 = xb0 + (f32x4){y[8], y[9], y[10], y[11]}, o3 = xb1 + (f32x4){y[12], y[13], y[14], y[15]};
        float sq2 = (o0.x * o0.x + o0.y * o0.y) + (o0.z * o0.z + o0.w * o0.w) + (o1.x * o1.x + o1.y * o1.y) + (o1.z * o1.z + o1.w * o1.w)
                  + (o2.x * o2.x + o2.y * o2.y) + (o2.z * o2.z + o2.w * o2.w) + (o3.x * o3.x + o3.y * o3.y) + (o3.z * o3.z + o3.w * o3.w);
        const float rstd2 = 1.f / sqrtf(wave_sum(sq2) * (1.f / 1024.f) + NORM_EPS);
        const GAS f32x4* gf = (const GAS f32x4*)(a.gfinal + 8 * lane);
        *(GAS f32x4*)(xr + 8 * lane) = o0 * rstd2 * gf[0]; *(GAS f32x4*)(xr + 8 * lane + 4) = o1 * rstd2 * gf[1];
        *(GAS f32x4*)(xr + 512 + 8 * lane) = o2 * rstd2 * gf[128]; *(GAS f32x4*)(xr + 512 + 8 * lane + 4) = o3 * rstd2 * gf[129];
        LDS_WAIT(); asm volatile("" ::: "memory");
    }
}

struct Args { const float* in[18]; float* out; unsigned char* ws; int ph_lo, ph_hi, li, pad; };
__global__ void __launch_bounds__(NWAVES * 64, 2) fwd_kernel(Args args) {
    extern __shared__ __attribute__((aligned(16))) unsigned char lds[];
    Frame F;
    F.lds = (LAS unsigned char*)lds;
    F.MISC = (volatile LAS unsigned*)(F.lds + MISC_OFF);
    F.tid = threadIdx.x; F.lane = F.tid & 63; F.wave = __builtin_amdgcn_readfirstlane(F.tid >> 6);
    F.G = gridDim.x; { const int bx = blockIdx.x; F.vcu = (F.G % 8 == 0) ? (bx % 8) * (F.G / 8) + bx / 8 : bx; }
    unsigned char* ws = args.ws;
    F.ctl = (gu32*)(ws + WS_CTL);
#define GRID_BAR(seam) do { if (N_LAUNCHES == PER_PHASE) { if (F.tid == 0) __hip_atomic_store(F.ctl + CW_TMO, 0xBADBA0u | (unsigned)(seam), RLX_AGENT); } else { xcd_barrier(bar); } } while (0)
    const float* x = args.in[0];
    bf16* H = (bf16*)(ws + WS_H); bf16* Win = (bf16*)(ws + WS_WIN); bf16* Wpw = (bf16*)(ws + WS_WPW); bf16* Wao = (bf16*)(ws + WS_WAO); bf16* Wout = (bf16*)(ws + WS_WOUT); bf16* Wq = (bf16*)(ws + WS_WQ);
    bf16* KEYS = (bf16*)(ws + WS_KEYS); bf16* UB = (bf16*)(ws + WS_UB); bf16* VB = (bf16*)(ws + WS_VB);
    bf16* ZGLU = (bf16*)(ws + WS_ZGLU); bf16* QO = (bf16*)(ws + WS_QO); bf16* KB = (bf16*)(ws + WS_K); bf16* VBUF = (bf16*)(ws + WS_V); bf16* GC = (bf16*)(ws + WS_GC); bf16* GA = (bf16*)(ws + WS_GA);
    bf16* CACT = (bf16*)(ws + WS_CACT); bf16* MIX = (bf16*)(ws + WS_MIX); bf16* X1B = (bf16*)(ws + WS_X1B); bf16* QP = (bf16*)(ws + WS_QP);
    float* KMEAN = (float*)(ws + WS_KMEAN); float* SS = (float*)(ws + WS_SS); int* EIDX = (int*)(ws + WS_EIDX); float* GW = (float*)(ws + WS_GW);
    for (int u = F.tid; u < (LDS_BYTES - LDSCTL_OFF) / 4; u += NWAVES * 64) ((LAS unsigned*)(F.lds + LDSCTL_OFF))[u] = 0u;
    __syncthreads();
    XcdBarrier bar; bar.bar = (unsigned*)(F.ctl + CW_BAR); bar.x = 0; bar.st = nullptr;
    if (N_LAUNCHES != PER_PHASE) bar = xcd_barrier_post((unsigned*)(F.ctl + CW_BAR), F.MISC + 8);
    const int lo = args.ph_lo, hi = args.ph_hi;
#ifndef PHASE_MASK
#define PHASE_MASK 0xff
#endif
#define IN(k) (((PHASE_MASK >> (k)) & 1) && lo <= (k) && (k) < hi)
#define BOTH(k) (IN(k) && IN((k) + 1))

    if (IN(0)) {
        P0Args a{x, args.in[1], args.in[2], args.in[7], args.in[9], args.in[10], args.in[11], args.in[12], args.in[13], args.in[14], args.in[15], args.in[16], H, Win, Wpw, Wao, Wout, Wq, KEYS, UB, VB};
        p0_prologue(F, a);
        if (BOTH(0)) GRID_BAR(0);
    }
#ifdef DEBUG_P1_PLAIN
    if (IN(1)) {
        pg8::Gemm g{H, Wq, TOK, 2048, 1024}; pg8::StaticOrder S; S.init(TOK, 2048, F.G, (int)blockIdx.x);
        pg8::EpiStore E{QP, 2048};
        pg8::gemm_phase<pg8::EpiStore, pg8::StaticOrder, true, true>(F.lds + RING_OFF, g, S, E);
    }
#else
    if (IN(1)) {
        pg8::Gemm g{H, Win, TOK, IN_COLS, 1024}; pg8::StaticOrder S; S.init(TOK, IN_COLS, F.G, (int)blockIdx.x);
        pg8::EpiIn E{ZGLU, QO, GC, KMEAN, attn_body::C2, (size_t)(WS_K - WS_QO) / 2, (size_t)(WS_GA - WS_GC) / 2};
        static_assert(WS_V - WS_K == WS_K - WS_QO, "Q|K|V equally spaced");
        pg8::gemm_phase<pg8::EpiIn, pg8::StaticOrder, true, true>(F.lds + RING_OFF, g, S, E);
        if (BOTH(1)) GRID_BAR(1);
    }
#endif
    if (IN(2)) {
        static_assert(attn_body::ATTN_LDS_BYTES <= RING_BYTES && attn_body::ATTN_PITCH == ATT_W, "attention body geometry vs frame");
        const attn_body::AttnTensors AT{(const attn_body::bf16*)QO, (const attn_body::bf16*)KB, (const attn_body::bf16*)VBUF, (attn_body::bf16*)QO, KMEAN};
        const attn_body::StaticOrder S((int)F.G, (int)blockIdx.x);
        attn_body::attn_phase<attn_body::StaticOrder>((char*)lds + RING_OFF, AT, S);
        __syncthreads();
        const ConvArgs ca{ZGLU, args.in[3], args.in[4], args.in[5], args.in[6], CACT};
        conv_phase(F, ca);
        if (BOTH(2)) GRID_BAR(2);
    }
    if (IN(3)) {
        { pg8::Gemm g{CACT, Wpw, TOK, 1024, 512}; pg8::StaticOrder S; S.init(TOK, 1024, F.G, (int)blockIdx.x);
          pg8::EpiMix<false> E{GC, args.in[8], MIX};
          pg8::gemm_phase<pg8::EpiMix<false>, pg8::StaticOrder, true, true>(F.lds + RING_OFF, g, S, E); }
        { pg8::Gemm g{QO, Wao, TOK, 1024, 512}; pg8::StaticOrder S; S.init(TOK, 1024, F.G, (int)blockIdx.x);
          pg8::EpiMix<true> E{GA, nullptr, MIX};
          pg8::gemm_phase<pg8::EpiMix<true>, pg8::StaticOrder, true, true>(F.lds + RING_OFF, g, S, E); }
        if (BOTH(3)) GRID_BAR(3);
    }
    if (IN(4)) {
        pg8::Gemm g{MIX, Wout, TOK, 1024, 1024}; pg8::StaticOrder S; S.init(TOK, 1024, F.G, (int)blockIdx.x);
        pg8::EpiX1 E{x, args.out, X1B, SS};
        pg8::gemm_phase<pg8::EpiX1, pg8::StaticOrder, true, true>(F.lds + RING_OFF, g, S, E);
        if (BOTH(4)) GRID_BAR(4);
    }
    if (IN(5)) {
        pg8::Gemm g{X1B, Wq, TOK, 2048, 1024}; pg8::StaticOrder S; S.init(TOK, 2048, F.G, (int)blockIdx.x);
        pg8::EpiStore E{QP, 2048};
        pg8::gemm_phase<pg8::EpiStore, pg8::StaticOrder, true, true>(F.lds + RING_OFF, g, S, E);
        if (BOTH(5)) GRID_BAR(5);
    }
    if (IN(6)) {
        const SelArgs sa{QP, KEYS, SS, EIDX, GW};
        peer_select_phase(F, sa);
        if (BOTH(6)) GRID_BAR(6);
    }
    if (IN(7)) {
        const ExpArgs ea{args.out, X1B, UB, VB, EIDX, GW, args.in[17]};
        peer_expert_phase(F, ea);
    }
#undef IN
#undef BOTH
}

#ifdef DEBUG_DUMP
__global__ void dump_kernel(const unsigned char* ws, float* out, float wsmib) {
    const size_t i = (size_t)blockIdx.x * 256 + threadIdx.x; if (i >= (size_t)TOK * 1024) return;
    const size_t t = i >> 10, c = i & 1023; float v = 0.f;
    auto B = [&](size_t off, size_t idx) { return bflo((unsigned)((const bf16*)(ws + off))[idx]); };
#if DEBUG_DUMP == 0
    v = B(WS_H, i) + B(WS_WIN, i % (4608u * 1024u)) + B(WS_WPW, i % (512u * 1024u)) + B(WS_WAO, i % (512u * 1024u)) + B(WS_WOUT, i % (1024u * 1024u)) + B(WS_WQ, i % (2048u * 1024u)) + B(WS_KEYS, i % 32768u) + B(WS_UB, i % (16384u * 1024u)) + B(WS_VB, i % (16384u * 1024u));
#elif DEBUG_DUMP == 1
    v = B(WS_ZGLU, t * 512 + (c & 511)) + 2.f * B(WS_QO, t * 512 + (c & 511)) + 3.f * B(WS_K, t * 512 + (c & 511)) + 4.f * B(WS_V, t * 512 + (c & 511)) + 5.f * B(WS_GC, i) + 6.f * B(WS_GA, i) + ((const float*)(ws + WS_KMEAN))[(t >> 8) * 1024 + (c & 1023)];
#elif DEBUG_DUMP == 2
    v = B(WS_QO, t * 512 + (c & 511)) + 2.f * B(WS_CACT, t * 512 + (c & 511));
#elif DEBUG_DUMP == 20
    v = B(WS_QO, t * 512 + (c & 511));
#elif DEBUG_DUMP == 21
    v = B(WS_CACT, t * 512 + (c & 511));
#elif DEBUG_DUMP == 3
    v = B(WS_MIX, i);
#elif DEBUG_DUMP == 5
    v = B(WS_QP, t * 2048 + c) + 2.f * B(WS_QP, t * 2048 + 1024 + c);
#elif DEBUG_DUMP == 10
    v = B(WS_ZGLU, t * 512 + (c & 511));
#elif DEBUG_DUMP == 11
    v = 2.f * B(WS_QO, t * 512 + (c & 511)) + 3.f * B(WS_K, t * 512 + (c & 511)) + 4.f * B(WS_V, t * 512 + (c & 511));
#elif DEBUG_DUMP == 12
    v = 5.f * B(WS_GC, i) + 6.f * B(WS_GA, i);
#elif DEBUG_DUMP == 13
    v = ((const float*)(ws + WS_KMEAN))[(t >> 8) * 1024 + (c & 1023)];
#elif DEBUG_DUMP == 98
    v = wsmib;
#elif DEBUG_DUMP == 99
    v = 1.0f + (float)(c & 7);
#endif
    out[i] = v;
}
#endif
extern "C" void kernel_launch(void* const* d_in, const int* in_sizes, int n_in, void* d_out, int out_size, void* d_ws, size_t ws_size, hipStream_t stream) {
    static int grid = 0;
    if (grid == 0) {
        if (n_in != 18 || in_sizes[0] != TOK * DM || out_size != TOK * DM || ws_size < WS_END) { fprintf(stderr, "kernel_launch: unexpected shapes (n_in %d, in0 %d, out %d, ws %zu); nothing launched\n", n_in, n_in > 0 ? in_sizes[0] : -1, out_size, ws_size); grid = -1; return; }
        int dev = 0, cus = 0, per_cu = 0;
        if (hipGetDevice(&dev) != hipSuccess || hipDeviceGetAttribute(&cus, hipDeviceAttributeMultiprocessorCount, dev) != hipSuccess) { grid = -1; return; }
        if (hipFuncSetAttribute((const void*)fwd_kernel, hipFuncAttributeMaxDynamicSharedMemorySize, LDS_BYTES) != hipSuccess) { fprintf(stderr, "kernel_launch: hipFuncSetAttribute failed\n"); grid = -1; return; }
        if (hipOccupancyMaxActiveBlocksPerMultiprocessor(&per_cu, (const void*)fwd_kernel, NWAVES * 64, LDS_BYTES) != hipSuccess || per_cu < 1) fprintf(stderr, "kernel_launch: occupancy query reports %d\n", per_cu);
        (void)hipGetLastError();
        grid = cus;
    }
    if (grid < 0) return;
    (void)hipMemsetAsync((char*)d_ws + WS_CTL, 0, CTL_ZERO_BYTES, stream);
    Args a{};
    for (int i = 0; i < 18; ++i) a.in[i] = (const float*)d_in[i];
    a.out = (float*)d_out; a.ws = (unsigned char*)d_ws;
#ifndef NPH_RUN
#define NPH_RUN N_LAUNCHES
#endif
    for (int li = 0; li < NPH_RUN; ++li) {
        a.ph_lo = (N_LAUNCHES == PER_PHASE) ? li : 0; a.ph_hi = (N_LAUNCHES == PER_PHASE) ? li + 1 : PER_PHASE; a.li = li;
        hipLaunchKernelGGL(fwd_kernel, dim3(grid), dim3(NWAVES * 64), LDS_BYTES, stream, a);
    }
#ifdef DEBUG_DUMP
    hipLaunchKernelGGL(dump_kernel, dim3(TOK * 1024 / 256), dim3(256), 0, stream, (const unsigned char*)d_ws, (float*)d_out, (float)(ws_size >> 20));
#endif
}
```

```cpp
#define MK_N_LAUNCHES 1
#ifndef PG8_EPI_DRAIN
#define PG8_EPI_DRAIN 0
#endif
#include <hip/hip_runtime.h>
#include <hip/hip_bf16.h>
#include <cstdio>
#include <cstdint>
#include <cmath>
namespace pg8 {
#define PG8_LAS __attribute__((address_space(3)))
typedef unsigned short bf16_t;
typedef short bf16x8 __attribute__((ext_vector_type(8)));
typedef float f32x4 __attribute__((ext_vector_type(4)));
typedef unsigned u32x4 __attribute__((ext_vector_type(4)));
constexpr int BM = 256, BK = 64, HALF = 128, HTB = HALF * BK * 2  , STAGE_BYTES = 8 * HTB, NXCD = 8, WGM = 8;

__host__ __device__ __forceinline__ int lds_byte(int r, int c) { const int st = (r >> 4) * 2 + (c >> 5), rr = r & 15, cc = c & 31, ob = rr * 64 + cc * 2; return st * 1024 + (ob ^ (((ob >> 9) & 1) << 5)); }
__host__ __device__ __forceinline__ void stage_rc(int b, int& R, int& C) { const int st = b / 1024, sb = b % 1024, swz = sb ^ (((sb >> 9) & 1) << 5); R = (st >> 1) * 16 + swz / 64; C = (st & 1) * 32 + (swz % 64) / 2; }
__host__ __device__ __forceinline__ int perm32(int rho) { const int n = rho >> 4, i = rho & 15; return 8 * (i >> 2) + 4 * n + (i & 3); }

struct Unit { int pm, pn; };
struct Gemm { const bf16_t* A; const bf16_t* Bt; int M, N, K; };

struct StaticOrder {
    int nM, nN, nwg, G, c;
    __host__ __device__ void init(int M, int N, int G_, int c_) { nM = M / BM; nN = N / BM; nwg = nM * nN; G = G_; c = c_; }
    __host__ __device__ bool next(int i, Unit& u) const {
        const long L = (long)i * G + c; if (L >= nwg) return false;
        int wgid = (int)L; { const int q = nwg / NXCD, r = nwg % NXCD, xcd = wgid % NXCD, off = wgid / NXCD; wgid = (xcd < r ? xcd * (q + 1) : r * (q + 1) + (xcd - r) * q) + off; }
        const int nig = WGM * nN, gid = wgid / nig, fm = gid * WGM, gsz = (nM - fm) < WGM ? (nM - fm) : WGM;
        u.pm = fm + ((wgid % nig) % gsz); u.pn = (wgid % nig) / gsz; return true;
    }
    __device__ __forceinline__ void a_ready(const Unit&) const {}
    __device__ __forceinline__ void done(const Unit&) const {}
};
struct PairOrder {
    int pm, pn0, cnt;
    __device__ __forceinline__ bool next(int i, Unit& u) const { if (i >= cnt) return false; int m = pm, n = pn0 + i; asm volatile("" : "+s"(m), "+s"(n));
        u.pm = m; u.pn = n; return true; }
    __device__ __forceinline__ void a_ready(const Unit&) const {}
    __device__ __forceinline__ void done(const Unit&) const {}
};

typedef float f32x2c_t __attribute__((ext_vector_type(2))); typedef __bf16 bf16x2c_t __attribute__((ext_vector_type(2)));
__device__ __forceinline__ unsigned cvt_pk_bf16(float lo, float hi) { const f32x2c_t v = {lo, hi}; const bf16x2c_t b = __builtin_convertvector(v, bf16x2c_t); return __builtin_bit_cast(unsigned, b); }
typedef float f32x2 __attribute__((ext_vector_type(2)));
__device__ __forceinline__ float sigm(float v) { return __builtin_amdgcn_rcpf(1.0f + __builtin_amdgcn_exp2f(-1.4426950408889634f * v)); }
__device__ __forceinline__ float bf_lo(unsigned u) { return __uint_as_float(u << 16); }
__device__ __forceinline__ float bf_hi(unsigned u) { return __uint_as_float(u & 0xffff0000u); }
__device__ __forceinline__ u32x4 pack8(const f32x4 a, const f32x4 b) { u32x4 w; w.x = cvt_pk_bf16(a[0], a[1]); w.y = cvt_pk_bf16(a[2], a[3]); w.z = cvt_pk_bf16(b[0], b[1]); w.w = cvt_pk_bf16(b[2], b[3]); return w; }
__device__ __forceinline__ void unpack8(const u32x4 w, f32x4& a, f32x4& b) { a = (f32x4){bf_lo(w.x), bf_hi(w.x), bf_lo(w.y), bf_hi(w.y)}; b = (f32x4){bf_lo(w.z), bf_hi(w.z), bf_lo(w.w), bf_hi(w.w)}; }

#ifndef PG8_WT
#define PG8_WT 1
#endif
__device__ __forceinline__ __amdgpu_buffer_rsrc_t wt_rsrc(const void* p) { return __builtin_amdgcn_make_buffer_rsrc((void*)p, 0, 0x7fffffff, 0x00020000); }
__device__ __forceinline__ void st16(bf16_t* base, const __amdgpu_buffer_rsrc_t r, size_t elem_off, const u32x4 v) {
#if PG8_WT
    __builtin_amdgcn_raw_buffer_store_b128(v, r, (unsigned)(elem_off * 2), 0, 16);
#else
    *(u32x4*)(base + elem_off) = v;
#endif
}
struct EpiIn {
    static constexpr bool PERM = true, AFTER_DRAIN = false, HAS_MID = false;
    bf16_t *zglu, *Q, *gc; float* kmean; float qscale; size_t qkv_stride, gate_stride;
    __device__ __forceinline__ void operator()(const f32x4 (&acc)[2][2][4][2], const Unit& u, int wr, int wc, int fr, int fq) const {
        const int row0 = u.pm * BM + wr * 64 + fr, cw = wc * 32 + 8 * fq, pn = u.pn;
        const __amdgpu_buffer_rsrc_t rz = wt_rsrc(zglu), rq = wt_rsrc(Q), rg = wt_rsrc(gc);
        if (pn < 4) {
#pragma unroll
            for (int ai = 0; ai < 2; ++ai)
#pragma unroll
                for (int m = 0; m < 4; ++m) { const size_t row = (size_t)(row0 + ai * HALF + m * 16);
                    f32x4 z0, z1;
#pragma unroll
                    for (int j = 0; j < 4; ++j) { z0[j] = acc[ai][0][m][0][j] * sigm(acc[ai][1][m][0][j]); z1[j] = acc[ai][0][m][1][j] * sigm(acc[ai][1][m][1][j]); }
                    st16(zglu, rz, row * 512 + pn * 128 + cw, pack8(z0, z1)); }
        } else if (pn < 10) {
            const size_t boff = (size_t)((pn - 4) >> 1) * qkv_stride; const int ct = (pn & 1) * 256; const float sc = pn < 6 ? qscale : 1.0f;
#pragma unroll
            for (int ai = 0; ai < 2; ++ai)
#pragma unroll
                for (int m = 0; m < 4; ++m) { const size_t row = (size_t)(row0 + ai * HALF + m * 16);
#pragma unroll
                    for (int bj = 0; bj < 2; ++bj) st16(Q, rq, boff + row * 512 + ct + bj * HALF + cw, pack8(acc[ai][bj][m][0] * sc, acc[ai][bj][m][1] * sc)); }
            if (pn == 6 || pn == 7) {
#pragma unroll
                for (int bj = 0; bj < 2; ++bj)
#pragma unroll
                    for (int n = 0; n < 2; ++n)
#pragma unroll
                        for (int j = 0; j < 4; ++j) { float s = 0.f;
#pragma unroll
                            for (int ai = 0; ai < 2; ++ai)
#pragma unroll
                                for (int m = 0; m < 4; ++m) s += acc[ai][bj][m][n][j];
                            s += __shfl_xor(s, 1); s += __shfl_xor(s, 2); s += __shfl_xor(s, 4); s += __shfl_xor(s, 8);
                            if (fr == 0) kmean[((size_t)u.pm * 2 + wr) * 512 + ct + bj * HALF + cw + 4 * n + j] = s * (1.0f / 256.0f); }
            }
        } else {
            const size_t boff = (size_t)((pn - 10) >> 2) * gate_stride; const int ct = ((pn - 10) & 3) * 256;
#pragma unroll
            for (int ai = 0; ai < 2; ++ai)
#pragma unroll
                for (int m = 0; m < 4; ++m) { const size_t row = (size_t)(row0 + ai * HALF + m * 16);
#pragma unroll
                    for (int bj = 0; bj < 2; ++bj) { f32x4 s0, s1;
#pragma unroll
                        for (int j = 0; j < 4; ++j) { s0[j] = sigm(acc[ai][bj][m][0][j]); s1[j] = sigm(acc[ai][bj][m][1][j]); }
                        st16(gc, rg, boff + row * 1024 + ct + bj * HALF + cw, pack8(s0, s1)); } }
        }
    }
};
template <bool ADD> struct EpiMix {
    static constexpr bool PERM = true, AFTER_DRAIN = false, HAS_MID = false;
    const bf16_t* gate; const float* bias; bf16_t* mix;
    __device__ __forceinline__ void operator()(const f32x4 (&acc)[2][2][4][2], const Unit& u, int wr, int wc, int fr, int fq) const {
        const int row0 = u.pm * BM + wr * 64 + fr, col0 = u.pn * BM + wc * 32 + 8 * fq;
        f32x4 b0[2], b1[2];
#pragma unroll
        for (int bj = 0; bj < 2; ++bj) { b0[bj] = (f32x4){0.f, 0.f, 0.f, 0.f}; b1[bj] = b0[bj]; if (!ADD) { b0[bj] = *(const f32x4*)(bias + col0 + bj * HALF); b1[bj] = *(const f32x4*)(bias + col0 + bj * HALF + 4); } }
#pragma unroll
        for (int ai = 0; ai < 2; ++ai) {
            u32x4 gq[4][2], mq[4][2];
#pragma unroll
            for (int m = 0; m < 4; ++m)
#pragma unroll
                for (int bj = 0; bj < 2; ++bj) { const size_t off = (size_t)(row0 + ai * HALF + m * 16) * 1024 + col0 + bj * HALF; gq[m][bj] = *(const u32x4*)(gate + off); if (ADD) mq[m][bj] = *(const u32x4*)(mix + off); }
#pragma unroll
            for (int m = 0; m < 4; ++m)
#pragma unroll
                for (int bj = 0; bj < 2; ++bj) { const size_t off = (size_t)(row0 + ai * HALF + m * 16) * 1024 + col0 + bj * HALF;
                    f32x4 g0, g1; unpack8(gq[m][bj], g0, g1);
                    f32x4 v0 = acc[ai][bj][m][0], v1 = acc[ai][bj][m][1];
                    if (!ADD) { v0 = (v0 + b0[bj]) * g0; v1 = (v1 + b1[bj]) * g1; }
                    else { f32x4 p0, p1; unpack8(mq[m][bj], p0, p1); v0 = p0 + v0 * g0; v1 = p1 + v1 * g1; }
                    *(u32x4*)(mix + off) = pack8(v0, v1); }
        }
    }
};
struct EpiMixF {
    static constexpr bool PERM = true, AFTER_DRAIN = false, HAS_MID = true;
    const bf16_t* gc; const bf16_t* ga; const float* bias; bf16_t* mix;
    __device__ __forceinline__ void mid(f32x4 (&acc)[2][2][4][2], const Unit& u, int wr, int wc, int fr, int fq) const {
        const int row0 = u.pm * BM + wr * 64 + fr, col0 = u.pn * BM + wc * 32 + 8 * fq;
#pragma unroll
        for (int ai = 0; ai < 2; ++ai)
#pragma unroll
            for (int m = 0; m < 4; ++m) { u32x4 cq[2], aq[2];
#pragma unroll
                for (int bj = 0; bj < 2; ++bj) { const size_t off = (size_t)(row0 + ai * HALF + m * 16) * 1024 + col0 + bj * HALF; cq[bj] = *(const u32x4*)(gc + off); aq[bj] = *(const u32x4*)(ga + off); }
#pragma unroll
                for (int bj = 0; bj < 2; ++bj) { f32x4 c0, c1, a0, a1; unpack8(cq[bj], c0, c1); unpack8(aq[bj], a0, a1);
                    const f32x4 b0 = *(const f32x4*)(bias + col0 + bj * HALF), b1 = *(const f32x4*)(bias + col0 + bj * HALF + 4);
#pragma unroll
                    for (int j = 0; j < 4; ++j) { acc[ai][bj][m][0][j] = (acc[ai][bj][m][0][j] + b0[j]) * c0[j] * __builtin_amdgcn_rcpf(fmaxf(a0[j], 1e-30f));
                                                  acc[ai][bj][m][1][j] = (acc[ai][bj][m][1][j] + b1[j]) * c1[j] * __builtin_amdgcn_rcpf(fmaxf(a1[j], 1e-30f)); } }
                if (m & 1) asm volatile("" ::: "memory"); }
    }
    __device__ __forceinline__ void operator()(const f32x4 (&acc)[2][2][4][2], const Unit& u, int wr, int wc, int fr, int fq) const {
        const int row0 = u.pm * BM + wr * 64 + fr, col0 = u.pn * BM + wc * 32 + 8 * fq;
        const __amdgpu_buffer_rsrc_t rm = wt_rsrc(mix);
#pragma unroll
        for (int ai = 0; ai < 2; ++ai) { u32x4 aq[4][2];
#pragma unroll
            for (int m = 0; m < 4; ++m)
#pragma unroll
                for (int bj = 0; bj < 2; ++bj) aq[m][bj] = *(const u32x4*)(ga + (size_t)(row0 + ai * HALF + m * 16) * 1024 + col0 + bj * HALF);
#pragma unroll
            for (int m = 0; m < 4; ++m)
#pragma unroll
                for (int bj = 0; bj < 2; ++bj) { f32x4 a0, a1; unpack8(aq[m][bj], a0, a1); f32x4 v0 = acc[ai][bj][m][0], v1 = acc[ai][bj][m][1];
#pragma unroll
                    for (int j = 0; j < 4; ++j) { v0[j] *= fmaxf(a0[j], 1e-30f); v1[j] *= fmaxf(a1[j], 1e-30f); }
                    st16(mix, rm, (size_t)(row0 + ai * HALF + m * 16) * 1024 + col0 + bj * HALF, pack8(v0, v1)); } }
    }
};
struct EpiX1 {
    static constexpr bool PERM = true, AFTER_DRAIN = false, HAS_MID = false;
    const float* x; float* x1; bf16_t* x1b; float* ss;
    __device__ __forceinline__ void operator()(const f32x4 (&acc)[2][2][4][2], const Unit& u, int wr, int wc, int fr, int fq) const {
        const int row0 = u.pm * BM + wr * 64 + fr, col0 = u.pn * BM + wc * 32 + 8 * fq;
        const __amdgpu_buffer_rsrc_t rx = wt_rsrc(x1b);
#pragma unroll
        for (int ai = 0; ai < 2; ++ai) {
            f32x4 xq[4][2][2];
#pragma unroll
            for (int m = 0; m < 4; ++m)
#pragma unroll
                for (int bj = 0; bj < 2; ++bj) { const size_t off = (size_t)(row0 + ai * HALF + m * 16) * 1024 + col0 + bj * HALF; xq[m][bj][0] = *(const f32x4*)(x + off); xq[m][bj][1] = *(const f32x4*)(x + off + 4); }
#pragma unroll
            for (int m = 0; m < 4; ++m) { const size_t row = (size_t)(row0 + ai * HALF + m * 16); float sq = 0.f;
#pragma unroll
                for (int bj = 0; bj < 2; ++bj) { const size_t off = row * 1024 + col0 + bj * HALF;
                    const f32x4 r0 = xq[m][bj][0] + acc[ai][bj][m][0], r1 = xq[m][bj][1] + acc[ai][bj][m][1];
                    st16(x1b, rx, off, pack8(r0, r1));
                    sq += (r0[0] * r0[0] + r0[1] * r0[1]) + (r0[2] * r0[2] + r0[3] * r0[3]) + (r1[0] * r1[0] + r1[1] * r1[1]) + (r1[2] * r1[2] + r1[3] * r1[3]); }
                sq += __shfl_xor(sq, 16); sq += __shfl_xor(sq, 32);
                if (fq == 0) ss[row * 16 + u.pn * 4 + wc] = sq; }
        }
    }
};
struct EpiStore {
    static constexpr bool PERM = true, AFTER_DRAIN = false, HAS_MID = false;
    bf16_t* O; int ldc;
    __device__ __forceinline__ void operator()(const f32x4 (&acc)[2][2][4][2], const Unit& u, int wr, int wc, int fr, int fq) const {
        const int row0 = u.pm * BM + wr * 64 + fr, col0 = u.pn * BM + wc * 32 + 8 * fq;
        const __amdgpu_buffer_rsrc_t ro = wt_rsrc(O);
#pragma unroll
        for (int ai = 0; ai < 2; ++ai)
#pragma unroll
            for (int m = 0; m < 4; ++m) { const size_t row = (size_t)(row0 + ai * HALF + m * 16);
#pragma unroll
                for (int bj = 0; bj < 2; ++bj) st16(O, ro, row * ldc + col0 + bj * HALF, pack8(acc[ai][bj][m][0], acc[ai][bj][m][1])); }
    }
};


template <class Epi, class Sched, bool ALIGN_EPI = false, bool SP2 = false>
__device__ __forceinline__ void gemm_phase(PG8_LAS unsigned char* lds, const Gemm g, const Sched& S, const Epi& E) {
    int tid_ = threadIdx.x; asm volatile("" : "+v"(tid_));
    const int tid = tid_, wid = __builtin_amdgcn_readfirstlane(tid >> 6), lane = tid & 63, wr = wid >> 2, wc = wid & 3, fr = lane & 15, fq = lane >> 4;
    const int K = g.K, nt = K / BK;
    unsigned voffA[2], voffB[2];
#pragma unroll
    for (int i = 0; i < 2; ++i) { int R, C; stage_rc(tid * 16 + i * 8192, R, C); const int Rb = Epi::PERM ? ((R & ~31) + perm32(R & 31)) : R;
        voffA[i] = (unsigned)(R * K + C) * 2u; voffB[i] = (unsigned)(Rb * K + C) * 2u; }
    const size_t kstep = (size_t)(BK * 2);
    const size_t hstep = (size_t)HALF * K * 2;
    const size_t tstep = 2 * hstep;
    const unsigned ldsw = (unsigned)wid * 1024u;
    const int aoff = lds_byte(wr * 64 + fr, fq * 8), boff = lds_byte(wc * 32 + fr, fq * 8);
#define PG8_SA(b, h) (((b) * 2 + (h)) * HTB)
#define PG8_SB(b, h) ((4 + (b) * 2 + (h)) * HTB)
#define PG8_STAGE(bufoff, gbase, voff) do { _Pragma("unroll") for (int _i = 0; _i < 2; ++_i) \
        __builtin_amdgcn_global_load_lds((const unsigned*)((const char*)(gbase) + (voff)[_i]), (PG8_LAS unsigned*)(lds + (bufoff) + ldsw + _i * 8192), 16, 0, 0); } while (0)
#define PG8_LDA(dst, b, h) do { _Pragma("unroll") for (int m = 0; m < 4; ++m) _Pragma("unroll") for (int k = 0; k < 2; ++k) dst[m][k] = *(const PG8_LAS bf16x8*)(lds + PG8_SA(b, h) + aoff + m * 2048 + k * 1024); } while (0)
#define PG8_LDB(dst, b, h) do { _Pragma("unroll") for (int n = 0; n < 2; ++n) _Pragma("unroll") for (int k = 0; k < 2; ++k) dst[n][k] = *(const PG8_LAS bf16x8*)(lds + PG8_SB(b, h) + boff + n * 2048 + k * 1024); } while (0)
#define PG8_MMA(ai, bj, At, Bt) do { __builtin_amdgcn_s_setprio(1); _Pragma("unroll") for (int m = 0; m < 4; ++m) _Pragma("unroll") for (int n = 0; n < 2; ++n) _Pragma("unroll") for (int k = 0; k < 2; ++k) \
        acc[ai][bj][m][n] = __builtin_amdgcn_mfma_f32_16x16x32_bf16(Bt[n][k], At[m][k], acc[ai][bj][m][n], 0, 0, 0); __builtin_amdgcn_s_setprio(0); } while (0)
#define PG8_WAIT_V(n) asm volatile("s_waitcnt vmcnt(" #n ")" ::: "memory")
#define PG8_WAIT_L(n) asm volatile("s_waitcnt lgkmcnt(" #n ")" ::: "memory")
#define PG8_BAR __builtin_amdgcn_s_barrier()
#define PG8_SCHED __builtin_amdgcn_sched_barrier(0)
    Unit cur, nxt; int ui = 0;
    if (!S.next(0, cur)) return;
    f32x4 acc[2][2][4][2];
#pragma unroll
    for (int a = 0; a < 2; ++a)
#pragma unroll
        for (int b = 0; b < 2; ++b)
#pragma unroll
            for (int m = 0; m < 4; ++m)
#pragma unroll
                for (int n = 0; n < 2; ++n) acc[a][b][m][n] = (f32x4){0.f, 0.f, 0.f, 0.f};
    bf16x8 At[4][2], B0[2][2], B1[2][2];
    const char* cA = (const char*)g.A + (size_t)cur.pm * tstep; const char* cB = (const char*)g.Bt + (size_t)cur.pn * tstep;
    S.a_ready(cur);
    if constexpr (SP2) {
        PG8_STAGE(PG8_SB(0, 0), cB, voffB); PG8_STAGE(PG8_SB(0, 1), cB + hstep, voffB); PG8_STAGE(PG8_SA(0, 0), cA, voffA); PG8_STAGE(PG8_SA(0, 1), cA + hstep, voffA);
        if (wr == 1) PG8_BAR;
        PG8_WAIT_V(2); PG8_BAR;
        PG8_STAGE(PG8_SB(1, 0), cB + kstep, voffB); PG8_STAGE(PG8_SA(1, 0), cA + kstep, voffA); PG8_STAGE(PG8_SB(1, 1), cB + hstep + kstep, voffB);
        PG8_WAIT_V(6); PG8_BAR;
    } else {
        PG8_STAGE(PG8_SB(0, 0), cB, voffB); PG8_STAGE(PG8_SA(0, 0), cA, voffA); PG8_STAGE(PG8_SB(0, 1), cB + hstep, voffB); PG8_STAGE(PG8_SA(0, 1), cA + hstep, voffA);
        if (wr == 1) PG8_BAR;
        PG8_WAIT_V(4); PG8_BAR;
        PG8_STAGE(PG8_SB(1, 0), cB + kstep, voffB); PG8_STAGE(PG8_SA(1, 0), cA + kstep, voffA); PG8_STAGE(PG8_SB(1, 1), cB + hstep + kstep, voffB);
        PG8_WAIT_V(6); PG8_BAR;
    }
    for (;;) {
        const bool has_next = S.next(ui + 1, nxt);
        const char* nA = has_next ? (const char*)g.A + (size_t)nxt.pm * tstep : cA; const char* nB = has_next ? (const char*)g.Bt + (size_t)nxt.pn * tstep : cB;
        if constexpr (Epi::HAS_MID) {
        for (int t = 0; t < nt / 2; t += 2) {
            const bool last = (t == nt - 2);
            const char* a1 = cA + (size_t)(t + 1) * kstep;
            const char* a2 = last ? nA : cA + (size_t)(t + 2) * kstep; const char* b2 = last ? nB : cB + (size_t)(t + 2) * kstep;
            const char* a3 = a2 + kstep; const char* b3 = b2 + kstep;
            if (last && has_next) S.a_ready(nxt);
            if constexpr (SP2) {
            PG8_LDB(B0, 0, 0); PG8_LDB(B1, 0, 1); PG8_SCHED; PG8_LDA(At, 0, 0); PG8_STAGE(PG8_SA(1, 1), a1 + hstep, voffA);
            PG8_WAIT_V(8); PG8_WAIT_L(0); PG8_BAR; PG8_MMA(0, 0, At, B0); PG8_MMA(0, 1, At, B1); PG8_BAR; PG8_SCHED;
            PG8_LDA(At, 0, 1); PG8_STAGE(PG8_SB(0, 0), b2, voffB); PG8_STAGE(PG8_SB(0, 1), b2 + hstep, voffB); PG8_STAGE(PG8_SA(0, 0), a2, voffA);
            PG8_WAIT_V(8); PG8_WAIT_L(0); PG8_BAR; PG8_MMA(1, 0, At, B0); PG8_MMA(1, 1, At, B1); PG8_BAR; PG8_SCHED;
            PG8_LDB(B0, 1, 0); PG8_LDB(B1, 1, 1); PG8_SCHED; PG8_LDA(At, 1, 0); PG8_STAGE(PG8_SA(0, 1), a2 + hstep, voffA);
            PG8_WAIT_V(8); PG8_WAIT_L(0); PG8_BAR; PG8_MMA(0, 0, At, B0); PG8_MMA(0, 1, At, B1); PG8_BAR; PG8_SCHED;
            PG8_LDA(At, 1, 1); PG8_STAGE(PG8_SB(1, 0), b3, voffB); PG8_STAGE(PG8_SB(1, 1), b3 + hstep, voffB); PG8_STAGE(PG8_SA(1, 0), a3, voffA);
            PG8_WAIT_V(8); PG8_WAIT_L(0); PG8_BAR; PG8_MMA(1, 0, At, B0); PG8_MMA(1, 1, At, B1); PG8_BAR; PG8_SCHED;
            } else {
            PG8_LDB(B0, 0, 0); PG8_SCHED; PG8_LDA(At, 0, 0); PG8_STAGE(PG8_SA(1, 1), a1 + hstep, voffA);
            PG8_WAIT_L(8); PG8_BAR; PG8_WAIT_L(0); PG8_MMA(0, 0, At, B0); PG8_BAR; PG8_SCHED;
            PG8_LDB(B1, 0, 1); PG8_STAGE(PG8_SB(0, 0), b2, voffB);
            PG8_BAR; PG8_WAIT_L(0); PG8_MMA(0, 1, At, B1); PG8_BAR;
            PG8_LDA(At, 0, 1); PG8_STAGE(PG8_SA(0, 0), a2, voffA);
            PG8_BAR; PG8_WAIT_L(0); PG8_MMA(1, 0, At, B0); PG8_BAR; PG8_SCHED;
            PG8_STAGE(PG8_SB(0, 1), b2 + hstep, voffB);
            PG8_WAIT_V(6); PG8_BAR; PG8_MMA(1, 1, At, B1); PG8_BAR;
            PG8_LDB(B0, 1, 0); PG8_SCHED; PG8_LDA(At, 1, 0); PG8_STAGE(PG8_SA(0, 1), a2 + hstep, voffA);
            PG8_WAIT_L(8); PG8_BAR; PG8_WAIT_L(0); PG8_MMA(0, 0, At, B0); PG8_BAR; PG8_SCHED;
            PG8_LDB(B1, 1, 1); PG8_STAGE(PG8_SB(1, 0), b3, voffB);
            PG8_BAR; PG8_WAIT_L(0); PG8_MMA(0, 1, At, B1); PG8_BAR;
            PG8_LDA(At, 1, 1); PG8_STAGE(PG8_SA(1, 0), a3, voffA);
            PG8_BAR; PG8_WAIT_L(0); PG8_MMA(1, 0, At, B0); PG8_BAR; PG8_SCHED;
            PG8_STAGE(PG8_SB(1, 1), b3 + hstep, voffB);
            PG8_WAIT_V(6); PG8_BAR; PG8_MMA(1, 1, At, B1); PG8_BAR;
            }
        }
        E.mid(acc, cur, wr, wc, fr, fq);
        for (int t = nt / 2; t < nt; t += 2) {
            const bool last = (t == nt - 2);
            const char* a1 = cA + (size_t)(t + 1) * kstep;
            const char* a2 = last ? nA : cA + (size_t)(t + 2) * kstep; const char* b2 = last ? nB : cB + (size_t)(t + 2) * kstep;
            const char* a3 = a2 + kstep; const char* b3 = b2 + kstep;
            if (last && has_next) S.a_ready(nxt);
            if constexpr (SP2) {
            PG8_LDB(B0, 0, 0); PG8_LDB(B1, 0, 1); PG8_SCHED; PG8_LDA(At, 0, 0); PG8_STAGE(PG8_SA(1, 1), a1 + hstep, voffA);
            PG8_WAIT_V(8); PG8_WAIT_L(0); PG8_BAR; PG8_MMA(0, 0, At, B0); PG8_MMA(0, 1, At, B1); PG8_BAR; PG8_SCHED;
            PG8_LDA(At, 0, 1); PG8_STAGE(PG8_SB(0, 0), b2, voffB); PG8_STAGE(PG8_SB(0, 1), b2 + hstep, voffB); PG8_STAGE(PG8_SA(0, 0), a2, voffA);
            PG8_WAIT_V(8); PG8_WAIT_L(0); PG8_BAR; PG8_MMA(1, 0, At, B0); PG8_MMA(1, 1, At, B1); PG8_BAR; PG8_SCHED;
            PG8_LDB(B0, 1, 0); PG8_LDB(B1, 1, 1); PG8_SCHED; PG8_LDA(At, 1, 0); PG8_STAGE(PG8_SA(0, 1), a2 + hstep, voffA);
            PG8_WAIT_V(8); PG8_WAIT_L(0); PG8_BAR; PG8_MMA(0, 0, At, B0); PG8_MMA(0, 1, At, B1); PG8_BAR; PG8_SCHED;
            PG8_LDA(At, 1, 1); PG8_STAGE(PG8_SB(1, 0), b3, voffB); PG8_STAGE(PG8_SB(1, 1), b3 + hstep, voffB); PG8_STAGE(PG8_SA(1, 0), a3, voffA);
            PG8_WAIT_V(8); PG8_WAIT_L(0); PG8_BAR; PG8_MMA(1, 0, At, B0); PG8_MMA(1, 1, At, B1); PG8_BAR; PG8_SCHED;
            } else {
            PG8_LDB(B0, 0, 0); PG8_SCHED; PG8_LDA(At, 0, 0); PG8_STAGE(PG8_SA(1, 1), a1 + hstep, voffA);
            PG8_WAIT_L(8); PG8_BAR; PG8_WAIT_L(0); PG8_MMA(0, 0, At, B0); PG8_BAR; PG8_SCHED;
            PG8_LDB(B1, 0, 1); PG8_STAGE(PG8_SB(0, 0), b2, voffB);
            PG8_BAR; PG8_WAIT_L(0); PG8_MMA(0, 1, At, B1); PG8_BAR;
            PG8_LDA(At, 0, 1); PG8_STAGE(PG8_SA(0, 0), a2, voffA);
            PG8_BAR; PG8_WAIT_L(0); PG8_MMA(1, 0, At, B0); PG8_BAR; PG8_SCHED;
            PG8_STAGE(PG8_SB(0, 1), b2 + hstep, voffB);
            PG8_WAIT_V(6); PG8_BAR; PG8_MMA(1, 1, At, B1); PG8_BAR;
            PG8_LDB(B0, 1, 0); PG8_SCHED; PG8_LDA(At, 1, 0); PG8_STAGE(PG8_SA(0, 1), a2 + hstep, voffA);
            PG8_WAIT_L(8); PG8_BAR; PG8_WAIT_L(0); PG8_MMA(0, 0, At, B0); PG8_BAR; PG8_SCHED;
            PG8_LDB(B1, 1, 1); PG8_STAGE(PG8_SB(1, 0), b3, voffB);
            PG8_BAR; PG8_WAIT_L(0); PG8_MMA(0, 1, At, B1); PG8_BAR;
            PG8_LDA(At, 1, 1); PG8_STAGE(PG8_SA(1, 0), a3, voffA);
            PG8_BAR; PG8_WAIT_L(0); PG8_MMA(1, 0, At, B0); PG8_BAR; PG8_SCHED;
            PG8_STAGE(PG8_SB(1, 1), b3 + hstep, voffB);
            PG8_WAIT_V(6); PG8_BAR; PG8_MMA(1, 1, At, B1); PG8_BAR;
            }
        }
        } else {
        for (int t = 0; t < nt; t += 2) {
            const bool last = (t == nt - 2);
            const char* a1 = cA + (size_t)(t + 1) * kstep;
            const char* a2 = last ? nA : cA + (size_t)(t + 2) * kstep; const char* b2 = last ? nB : cB + (size_t)(t + 2) * kstep;
            const char* a3 = a2 + kstep; const char* b3 = b2 + kstep;
            if (last && has_next) S.a_ready(nxt);
            if constexpr (SP2) {
            PG8_LDB(B0, 0, 0); PG8_LDB(B1, 0, 1); PG8_SCHED; PG8_LDA(At, 0, 0); PG8_STAGE(PG8_SA(1, 1), a1 + hstep, voffA);
            PG8_WAIT_V(8); PG8_WAIT_L(0); PG8_BAR; PG8_MMA(0, 0, At, B0); PG8_MMA(0, 1, At, B1); PG8_BAR; PG8_SCHED;
            PG8_LDA(At, 0, 1); PG8_STAGE(PG8_SB(0, 0), b2, voffB); PG8_STAGE(PG8_SB(0, 1), b2 + hstep, voffB); PG8_STAGE(PG8_SA(0, 0), a2, voffA);
            PG8_WAIT_V(8); PG8_WAIT_L(0); PG8_BAR; PG8_MMA(1, 0, At, B0); PG8_MMA(1, 1, At, B1); PG8_BAR; PG8_SCHED;
            PG8_LDB(B0, 1, 0); PG8_LDB(B1, 1, 1); PG8_SCHED; PG8_LDA(At, 1, 0); PG8_STAGE(PG8_SA(0, 1), a2 + hstep, voffA);
            PG8_WAIT_V(8); PG8_WAIT_L(0); PG8_BAR; PG8_MMA(0, 0, At, B0); PG8_MMA(0, 1, At, B1); PG8_BAR; PG8_SCHED;
            PG8_LDA(At, 1, 1); PG8_STAGE(PG8_SB(1, 0), b3, voffB); PG8_STAGE(PG8_SB(1, 1), b3 + hstep, voffB); PG8_STAGE(PG8_SA(1, 0), a3, voffA);
            PG8_WAIT_V(8); PG8_WAIT_L(0); PG8_BAR; PG8_MMA(1, 0, At, B0); PG8_MMA(1, 1, At, B1); PG8_BAR; PG8_SCHED;
            } else {
            PG8_LDB(B0, 0, 0); PG8_SCHED; PG8_LDA(At, 0, 0); PG8_STAGE(PG8_SA(1, 1), a1 + hstep, voffA);
            PG8_WAIT_L(8); PG8_BAR; PG8_WAIT_L(0); PG8_MMA(0, 0, At, B0); PG8_BAR; PG8_SCHED;
            PG8_LDB(B1, 0, 1); PG8_STAGE(PG8_SB(0, 0), b2, voffB);
            PG8_BAR; PG8_WAIT_L(0); PG8_MMA(0, 1, At, B1); PG8_BAR;
            PG8_LDA(At, 0, 1); PG8_STAGE(PG8_SA(0, 0), a2, voffA);
            PG8_BAR; PG8_WAIT_L(0); PG8_MMA(1, 0, At, B0); PG8_BAR; PG8_SCHED;
            PG8_STAGE(PG8_SB(0, 1), b2 + hstep, voffB);
            PG8_WAIT_V(6); PG8_BAR; PG8_MMA(1, 1, At, B1); PG8_BAR;
            PG8_LDB(B0, 1, 0); PG8_SCHED; PG8_LDA(At, 1, 0); PG8_STAGE(PG8_SA(0, 1), a2 + hstep, voffA);
            PG8_WAIT_L(8); PG8_BAR; PG8_WAIT_L(0); PG8_MMA(0, 0, At, B0); PG8_BAR; PG8_SCHED;
            PG8_LDB(B1, 1, 1); PG8_STAGE(PG8_SB(1, 0), b3, voffB);
            PG8_BAR; PG8_WAIT_L(0); PG8_MMA(0, 1, At, B1); PG8_BAR;
            PG8_LDA(At, 1, 1); PG8_STAGE(PG8_SA(1, 0), a3, voffA);
            PG8_BAR; PG8_WAIT_L(0); PG8_MMA(1, 0, At, B0); PG8_BAR; PG8_SCHED;
            PG8_STAGE(PG8_SB(1, 1), b3 + hstep, voffB);
            PG8_WAIT_V(6); PG8_BAR; PG8_MMA(1, 1, At, B1); PG8_BAR;
            }
        }
        }
        if constexpr (ALIGN_EPI) { if (wr == 0) PG8_BAR; }
        if constexpr (!Epi::AFTER_DRAIN) { E(acc, cur, wr, wc, fr, fq); S.done(cur);
#if PG8_EPI_DRAIN
            PG8_WAIT_V(0);
#endif
        }
        if (!has_next) break;
#pragma unroll
        for (int a = 0; a < 2; ++a)
#pragma unroll
            for (int b = 0; b < 2; ++b)
#pragma unroll
                for (int m = 0; m < 4; ++m)
#pragma unroll
                    for (int n = 0; n < 2; ++n) acc[a][b][m][n] = (f32x4){0.f, 0.f, 0.f, 0.f};
        cur = nxt; cA = nA; cB = nB; ++ui;
        if constexpr (ALIGN_EPI) { if (wr == 1) PG8_BAR; }
    }
    PG8_WAIT_V(0);
    if constexpr (!ALIGN_EPI) { if (wr == 0) PG8_BAR; }
    PG8_BAR;
    if constexpr (Epi::AFTER_DRAIN) { E.fused(acc, cur, wr, wc, fr, fq, lds, wid, lane); S.done(cur); }
#undef PG8_SA
#undef PG8_SB
#undef PG8_STAGE
#undef PG8_LDA
#undef PG8_LDB
#undef PG8_MMA
#undef PG8_WAIT_V
#undef PG8_WAIT_L
#undef PG8_BAR
#undef PG8_SCHED
}
}

#include <hip/hip_bf16.h>
#include <cmath>
namespace attn_body {
using bf16=__hip_bfloat16;
using bf16x8=__attribute__((ext_vector_type(8)))short;
using s16x4=__attribute__((ext_vector_type(4)))short;
using f32x16=__attribute__((ext_vector_type(16)))float;
using u32x4=__attribute__((ext_vector_type(4)))unsigned;
typedef float f32x4_t __attribute__((ext_vector_type(4)));
constexpr int BATCH=8,NHEAD=8,SEQ=4096,D=64,DM=NHEAD*D;
constexpr int NW=8,QBLK=32,QB=QBLK*NW,KVBLK=64,NQB=SEQ/QB;
constexpr int ATTN_PITCH=DM, ATTN_UNIT_ROWS=QB, OPITCH=1024;
__device__ __forceinline__ int crow(int r,int hi){return (r&3)+8*(r>>2)+4*hi;}
#define SBAR() __builtin_amdgcn_sched_barrier(0)
__device__ __forceinline__ void cmask(f32x16&p0,f32x16&p1,int jb,int qrel,int hi){
  const float NEG=-INFINITY; int kb=64*jb+4*hi;
  #pragma unroll
  for(int r=0;r<16;++r){int kv=kb+(r&3)+8*(r>>2); if(kv>qrel)p0[r]=NEG; if(kv+32>qrel)p1[r]=NEG;}
}

constexpr int NSLOT=3, SLOTB=8192;
constexpr int LDS_K=0, LDS_V=NSLOT*SLOTB, LDS_WS=2*NSLOT*SLOTB, LDS_OST=LDS_WS+NW*64*4, LDS_KM=LDS_OST+NW*4096, LDS_BYTES=LDS_KM+4096;
constexpr float C2=0.125f*1.4426950408889634f;
__device__ __forceinline__ void glds16(const void*gsrc,unsigned lds_dst){unsigned keep;
  asm volatile("s_mov_b32 %0, m0\n\ts_mov_b32 m0, %2\n\ts_nop 0\n\tglobal_load_lds_dwordx4 %1, off\n\ts_mov_b32 m0, %0":"=&s"(keep):"v"(gsrc),"s"(lds_dst):"memory");}
__device__ __forceinline__ float max3f(float a,float b,float c){float r;asm("v_max3_f32 %0, %1, %2, %3":"=v"(r):"v"(a),"v"(b),"v"(c));return r;}
__device__ __forceinline__ float max2f(float a,float b){float r;asm("v_max_f32_e32 %0, %1, %2":"=v"(r):"v"(a),"v"(b));return r;}
__device__ __forceinline__ float fadd_s(float a,float b){float r;asm("v_add_f32_e32 %0, %1, %2":"=v"(r):"v"(a),"v"(b));return r;}
__device__ __forceinline__ float fsub_s(float a,float b){float r;asm("v_sub_f32_e32 %0, %1, %2":"=v"(r):"v"(a),"v"(b));return r;}
typedef float f32x2_t __attribute__((ext_vector_type(2))); typedef __bf16 bf16x2_t __attribute__((ext_vector_type(2)));
__device__ __forceinline__ unsigned cvtpk_s(float lo,float hi){f32x2_t v={lo,hi};bf16x2_t b=__builtin_convertvector(v,bf16x2_t);return __builtin_bit_cast(unsigned,b);}
#define WAIT_BAR(N) asm volatile("s_waitcnt vmcnt(" #N ") lgkmcnt(0)\n\ts_barrier":::"memory")

__device__ __forceinline__ void qkt(f32x16&p0,f32x16&p1,const char*Kslot,const bf16x8*qr,int r32,int hi){
  const char*kb=Kslot+hi*1024+r32*16;
  #pragma unroll
  for(int d0=0;d0<4;++d0){
    const bf16x8 b0=*reinterpret_cast<const bf16x8*>(kb+d0*2048);
    const bf16x8 b1=*reinterpret_cast<const bf16x8*>(kb+d0*2048+512);
    p0=__builtin_amdgcn_mfma_f32_32x32x16_bf16(b0,qr[d0],p0,0,0,0);p1=__builtin_amdgcn_mfma_f32_32x32x16_bf16(b1,qr[d0],p1,0,0,0);}
}
typedef __attribute__((address_space(3))) const char* lds_cptr;
typedef short v4i16_t __attribute__((ext_vector_type(4)));
__device__ __forceinline__ void kload8(bf16x8*kf,lds_cptr kp){
  kf[0]=*(const __attribute__((address_space(3))) bf16x8*)(kp);      kf[1]=*(const __attribute__((address_space(3))) bf16x8*)(kp+512);
  kf[2]=*(const __attribute__((address_space(3))) bf16x8*)(kp+2048); kf[3]=*(const __attribute__((address_space(3))) bf16x8*)(kp+2560);
  kf[4]=*(const __attribute__((address_space(3))) bf16x8*)(kp+4096); kf[5]=*(const __attribute__((address_space(3))) bf16x8*)(kp+4608);
  kf[6]=*(const __attribute__((address_space(3))) bf16x8*)(kp+6144); kf[7]=*(const __attribute__((address_space(3))) bf16x8*)(kp+6656);
}
__device__ __forceinline__ void kload2(bf16x8*kf,lds_cptr kp,int j){ kf[2*j]=*(const __attribute__((address_space(3))) bf16x8*)(kp+j*2048); kf[2*j+1]=*(const __attribute__((address_space(3))) bf16x8*)(kp+j*2048+512); }
__device__ __forceinline__ s16x4 vtr(lds_cptr p){ return __builtin_bit_cast(s16x4,__builtin_amdgcn_ds_read_tr16_b64_v4i16((__attribute__((address_space(3))) v4i16_t*)p)); }
__device__ __forceinline__ float rowmax(const f32x16&p0,const f32x16&p1){
  float a=max3f(p0[0],p0[1],p1[0]),b=max3f(p0[2],p0[3],p1[1]);a=max3f(a,p1[2],p1[3]);
  #pragma unroll
  for(int r=4;r<16;r+=4){a=max3f(a,p0[r],p0[r+1]);b=max3f(b,p0[r+2],p0[r+3]);a=max3f(a,p1[r],p1[r+1]);b=max3f(b,p1[r+2],p1[r+3]);}
  const float m=max2f(a,b);
  auto rr=__builtin_amdgcn_permlane32_swap(__float_as_uint(m),__float_as_uint(m),false,false);
  return max2f(__uint_as_float(rr[0]),__uint_as_float(rr[1]));
}
__device__ __forceinline__ void pv(f32x16*o,int vb,bf16x8 pa0,bf16x8 pa1,bf16x8 pa2,bf16x8 pa3){
  #pragma unroll
  for(int d0=0;d0<2;++d0){s16x4 lo[4],hi[4];
    #pragma unroll
    for(int ks=0;ks<4;++ks){
      asm volatile("ds_read_b64_tr_b16 %0,%1 offset:%c2":"=&v"(lo[ks]):"v"(vb),"i"(d0*4096+ks*1024):"memory");
      asm volatile("ds_read_b64_tr_b16 %0,%1 offset:%c2":"=&v"(hi[ks]):"v"(vb),"i"(d0*4096+ks*1024+512):"memory");}
    asm volatile("s_waitcnt lgkmcnt(0)":::"memory");SBAR();
    #define PK(k) (bf16x8){lo[k][0],lo[k][1],lo[k][2],lo[k][3],hi[k][0],hi[k][1],hi[k][2],hi[k][3]}
    o[d0]=__builtin_amdgcn_mfma_f32_32x32x16_bf16(pa0,PK(0),o[d0],0,0,0);
    o[d0]=__builtin_amdgcn_mfma_f32_32x32x16_bf16(pa1,PK(1),o[d0],0,0,0);
    o[d0]=__builtin_amdgcn_mfma_f32_32x32x16_bf16(pa2,PK(2),o[d0],0,0,0);
    o[d0]=__builtin_amdgcn_mfma_f32_32x32x16_bf16(pa3,PK(3),o[d0],0,0,0);
    #undef PK
  }
}

#ifndef ATTN_STORE16
#define ATTN_STORE16(p,v) __builtin_amdgcn_raw_buffer_store_b128((v),orsrc_,(unsigned)((const char*)(p)-(const char*)O),0,16)
#endif
template<int THRL> __device__ __forceinline__ void attn_unit(int b,int h,int qb,const bf16*Q,const bf16*__restrict__ K,const bf16*__restrict__ V,bf16*O,const float*kmean,char*shm){
  const int tid=threadIdx.x,lane=tid&63,r32=lane&31,hi=lane>>5; const int wid=__builtin_amdgcn_readfirstlane(tid>>6);
  const long rowbase=(long)b*SEQ; const int q0=qb*QB;
  const bf16*Qw=Q+(rowbase+q0+wid*QBLK)*DM+h*D;
  const bf16*Kh=K+rowbase*DM+h*D,*Vh=V+rowbase*DM+h*D;
  const unsigned lds0=(unsigned)(uintptr_t)shm;
  float*wsf=(float*)(shm+LDS_WS)+wid*64;
  const bf16*ksrc=Kh+(long)lane*DM+wid*8;
  const bf16*vsrc=Vh+(long)(16*(wid&3)+(lane>>2))*DM+(wid>>2)*32+(lane&3)*8;
  const unsigned kdst=lds0+LDS_K+wid*1024, vdst=lds0+LDS_V+wid*1024;
  #define POS(t) (((t)<4)?(NT-4+(t)):((t)-4))
  #define DMA_K(t,slot) glds16(ksrc+(long)POS(t)*KVBLK*DM,(unsigned)__builtin_amdgcn_readfirstlane(kdst+(slot)))
  #define DMA_V(t,slot) glds16(vsrc+(long)POS(t)*KVBLK*DM,(unsigned)__builtin_amdgcn_readfirstlane(vdst+(slot)))
  const int vb0=(int)(lds0+LDS_V)+((lane>>4)&1)*32+(lane&3)*8+(4*hi+((lane&15)>>2))*64;
  const char*Kbase=shm+LDS_K; bf16x8 kf[8];
  const lds_cptr shm3=(lds_cptr)shm; const lds_cptr kp0=shm3+LDS_K+hi*1024+r32*16; const lds_cptr vp0=shm3+LDS_V+((lane>>4)&1)*32+(lane&3)*8+(4*hi+((lane&15)>>2))*64;
  const int NT=(q0+QB)/KVBLK;
  DMA_K(0,0);DMA_V(0,0);DMA_K(1,SLOTB);
  bf16x8 qr[4];
  #pragma unroll
  for(int d0=0;d0<4;++d0)qr[d0]=*reinterpret_cast<const bf16x8*>(&Qw[(long)r32*DM+d0*16+hi*8]);
  float mhat=0.f,l_reg=0.f;f32x16 o[2];o[0]=f32x16{};o[1]=f32x16{};
  const float slope2=ldexpf(1.4426950408889634f,-(h+1));
  unsigned selmask=0u;
  { typedef __attribute__((address_space(3))) float* lds_fptr; typedef __attribute__((address_space(3))) const f32x4_t* lds_f4ptr;
    lds_fptr kml=(lds_fptr)((lds_cptr)shm+LDS_KM);
    { const float*src=kmean+((long)b*16)*2*DM+h*D;
      #pragma unroll
      for(int i=0;i<2;++i){const int e=tid+512*i; kml[e]=src[(e>>6)*2*DM+(e&63)]+src[(e>>6)*2*DM+DM+(e&63)];} }
    asm volatile("s_waitcnt vmcnt(0) lgkmcnt(0)\n\ts_barrier":::"memory");
    float qf[32];
    #pragma unroll
    for(int d0=0;d0<4;++d0){
      #pragma unroll
      for(int j=0;j<8;++j)qf[d0*8+j]=__uint_as_float(((unsigned)(unsigned short)qr[d0][j])<<16);}
    float sc[16];
    #pragma unroll
    for(int j=0;j<16;++j){ sc[j]=-INFINITY;
      if(j<qb){ lds_f4ptr kr=(lds_f4ptr)(kml+j*64+hi*8); float a=0.f;
        #pragma unroll
        for(int d0=0;d0<4;++d0){ const f32x4_t k0=kr[d0*4],k1=kr[d0*4+1];
          a+=qf[d0*8+0]*k0[0]+qf[d0*8+1]*k0[1]+qf[d0*8+2]*k0[2]+qf[d0*8+3]*k0[3]+qf[d0*8+4]*k1[0]+qf[d0*8+5]*k1[1]+qf[d0*8+6]*k1[2]+qf[d0*8+7]*k1[3]; }
        a+=__shfl_xor(a,32); sc[j]=a; } }
    #pragma unroll
    for(int j=0;j<15;++j){ int cnt=0;
      #pragma unroll
      for(int k=0;k<15;++k){ if(k!=j) cnt+=((sc[k]>sc[j])||((sc[k]==sc[j])&&(k<j)))?1:0; }
      if(j<qb&&cnt<3) selmask|=(1u<<j); } }
  #define CINIT(C0,C1,t) do{ const int pt_=POS(t); float x_=slope2*(float)(64*pt_-q0+4*hi)-mhat; \
    if((t)>=4){ x_+=((selmask>>(pt_>>2))&1u)?0.f:-30000.f; } const float y_=x_+32.f*slope2; \
    _Pragma("unroll") for(int r=0;r<16;++r){ const float cr_=(float)((r&3)+8*(r>>2)); C0[r]=__builtin_fmaf(slope2,cr_,x_); C1[r]=__builtin_fmaf(slope2,cr_,y_); } }while(0)

  const int qrel=wid*QBLK+r32;
  #define CMASK(P0,P1,t) do{ if((t)<4)cmask(P0,P1,(t),qrel,hi);}while(0)
  bool resc=false;
  #define START(P0,P1) do{ const float rm=rowmax(P0,P1); resc=false; \
    { const float dl=rm; mhat=fadd_s(mhat,dl); \
      _Pragma("unroll") for(int r=0;r<16;++r){P0[r]=fsub_s(P0[r],dl);P1[r]=fsub_s(P1[r],dl);} } \
    _Pragma("unroll") for(int r=0;r<16;++r)P0[r]=__builtin_amdgcn_exp2f(P0[r]); }while(0)
  #define RESC() do{ if(resc){ asm volatile("s_waitcnt lgkmcnt(0)":::"memory"); \
      _Pragma("unroll") for(int d_=0;d_<2;++d_) _Pragma("unroll") for(int r=0;r<16;++r)o[d_][r]*=wsf[crow(r,hi)]; } }while(0)
  f32x16 pA0,pA1,pB0,pB1;
  int sl_prev=0,sl_cur=0,sl_next=SLOTB;
  #define ROT() do{sl_prev=sl_cur;sl_cur=sl_next;sl_next=(sl_next==(NSLOT-1)*SLOTB)?0:sl_next+SLOTB;}while(0)
  DMA_K(2,2*SLOTB);
  WAIT_BAR(3);
  CINIT(pA0,pA1,0); qkt(pA0,pA1,Kbase,qr,r32,hi);asm volatile("s_nop 15\n\ts_nop 7":"+v"(pA0),"+v"(pA1));CMASK(pA0,pA1,0);
  START(pA0,pA1);
  _Pragma("unroll") for(int r=0;r<16;++r)pA1[r]=__builtin_amdgcn_exp2f(pA1[r]);
  WAIT_BAR(0);
  DMA_K(3,0);DMA_V(1,SLOTB);
  ROT();
  kload8(kf,kp0+sl_cur);
  WAIT_BAR(2);
  s16x4 vlo[8],vhi[8]; u32x4 pw0,pw1,pw2,pw3;
  #define PKW(P,B) cvtpk_s(P[B],P[B+1])
  #define PAF(k) __builtin_bit_cast(bf16x8,pw##k)
  #define VFR(i) (bf16x8){vlo[i][0],vlo[i][1],vlo[i][2],vlo[i][3],vhi[i][0],vhi[i][1],vhi[i][2],vhi[i][3]}
  #define PIN(x) asm volatile("":"+v"(x))
  #define MX3(a,b,c) __builtin_fmaxf(__builtin_fmaxf((a),(b)),(c))
  #define GAPA(MF,A0,A1,A2,A3,W0,W1,PW) do{ MF; sacc+=A0; sacc+=A1; sacc+=A2; sacc+=A3; PIN(sacc); W0; W1; PIN(PW); SBAR(); }while(0)
  #define EX(v) __builtin_amdgcn_exp2f(v)
  #define GAPB(MF,X,B) do{ MF; X[B]=EX(X[B]); X[B+1]=EX(X[B+1]); X[B+2]=EX(X[B+2]); X[B+3]=EX(X[B+3]); PIN(X); SBAR(); }while(0)
  #define VRD(i) do{ vlo[i]=vtr(vp_+(((i)>>2)*4096+((i)&3)*1024)); vhi[i]=vtr(vp_+(((i)>>2)*4096+((i)&3)*1024+512)); }while(0)
  #define KRD(G,j) do{ if(G){ kload2(kf,kp0+sl_next,j); SBAR(); } }while(0)
  #define STEP(C0,C1,P0,P1,t,GK,GV,GL) do{ SBAR(); CINIT(C0,C1,t); PIN(C0); PIN(C1); SBAR(); \
    const lds_cptr vp_=vp0+sl_prev; \
    VRD(0); SBAR(); float sacc=(P0[0]+P0[1]); \
    GAPA(C0=__builtin_amdgcn_mfma_f32_32x32x16_bf16(kf[0],qr[0],C0,0,0,0), P0[2],P0[3],P0[4],P0[5],     pw0[0]=PKW(P0,0), pw0[1]=PKW(P0,2), pw0); \
    VRD(4); SBAR(); GAPA(C1=__builtin_amdgcn_mfma_f32_32x32x16_bf16(kf[1],qr[0],C1,0,0,0), P0[6],P0[7],P0[8],P0[9],     pw0[2]=PKW(P0,4), pw0[3]=PKW(P0,6), pw0); \
    VRD(1); SBAR(); GAPA(C0=__builtin_amdgcn_mfma_f32_32x32x16_bf16(kf[2],qr[1],C0,0,0,0),   P0[10],P0[11],P0[12],P0[13], pw1[0]=PKW(P0,8), pw1[1]=PKW(P0,10), pw1); \
    VRD(5); SBAR(); GAPA(C1=__builtin_amdgcn_mfma_f32_32x32x16_bf16(kf[3],qr[1],C1,0,0,0),   P0[14],P0[15],P1[0],P1[1],   pw1[2]=PKW(P0,12),pw1[3]=PKW(P0,14), pw1); \
    VRD(2); SBAR(); GAPA(C0=__builtin_amdgcn_mfma_f32_32x32x16_bf16(kf[4],qr[2],C0,0,0,0),   P1[2],P1[3],P1[4],P1[5],     pw2[0]=PKW(P1,0), pw2[1]=PKW(P1,2), pw2); \
    VRD(6); SBAR(); GAPA(C1=__builtin_amdgcn_mfma_f32_32x32x16_bf16(kf[5],qr[2],C1,0,0,0),   P1[6],P1[7],P1[8],P1[9],     pw2[2]=PKW(P1,4), pw2[3]=PKW(P1,6), pw2); \
    VRD(3); SBAR(); GAPA(C0=__builtin_amdgcn_mfma_f32_32x32x16_bf16(kf[6],qr[3],C0,0,0,0),   P1[10],P1[11],P1[12],P1[13], pw3[0]=PKW(P1,8), pw3[1]=PKW(P1,10), pw3); \
    VRD(7); SBAR(); GAPA(C1=__builtin_amdgcn_mfma_f32_32x32x16_bf16(kf[7],qr[3],C1,0,0,0),   P1[14],P1[15],0.f,0.f,       pw3[2]=PKW(P1,12),pw3[3]=PKW(P1,14), pw3); \
    l_reg+=sacc; \
    if(GK){DMA_K((t)+3,sl_cur);} if(GV){DMA_V((t)+1,sl_next);} \
    CMASK(C0,C1,t); \
    { float a=MX3(C0[0],C0[1],C1[0]),b=MX3(C0[2],C0[3],C1[1]); a=MX3(a,C1[2],C1[3]); \
      _Pragma("unroll") for(int r=4;r<16;r+=4){a=MX3(a,C0[r],C0[r+1]);b=MX3(b,C0[r+2],C0[r+3]);a=MX3(a,C1[r],C1[r+1]);b=MX3(b,C1[r+2],C1[r+3]);} \
      float rm=__builtin_fmaxf(a,b); { auto rr=__builtin_amdgcn_permlane32_swap(__float_as_uint(rm),__float_as_uint(rm),false,false); rm=__builtin_fmaxf(__uint_as_float(rr[0]),__uint_as_float(rr[1])); } \
      resc=false; \
      if(__builtin_expect(__any(rm>(float)THRL),0)){ const float dl=__builtin_fmaxf(rm,0.f); mhat+=dl; \
        _Pragma("unroll") for(int r=0;r<16;++r){C0[r]-=dl;C1[r]-=dl;} \
        const float f=__builtin_amdgcn_exp2f(-dl); l_reg*=f; if(hi==0)wsf[r32]=f; resc=true; } } \
    SBAR(); \
    GAPB(o[0]=__builtin_amdgcn_mfma_f32_32x32x16_bf16(PAF(0),VFR(0),o[0],0,0,0), C0,0); \
    GAPB(o[1]=__builtin_amdgcn_mfma_f32_32x32x16_bf16(PAF(0),VFR(4),o[1],0,0,0), C0,4); \
    KRD(GL,0); GAPB(o[0]=__builtin_amdgcn_mfma_f32_32x32x16_bf16(PAF(1),VFR(1),o[0],0,0,0), C0,8); \
    KRD(GL,1); GAPB(o[1]=__builtin_amdgcn_mfma_f32_32x32x16_bf16(PAF(1),VFR(5),o[1],0,0,0), C0,12); \
    KRD(GL,2); GAPB(o[0]=__builtin_amdgcn_mfma_f32_32x32x16_bf16(PAF(2),VFR(2),o[0],0,0,0), C1,0); \
    KRD(GL,3); GAPB(o[1]=__builtin_amdgcn_mfma_f32_32x32x16_bf16(PAF(2),VFR(6),o[1],0,0,0), C1,4); \
    GAPB(o[0]=__builtin_amdgcn_mfma_f32_32x32x16_bf16(PAF(3),VFR(3),o[0],0,0,0), C1,8); \
    GAPB(o[1]=__builtin_amdgcn_mfma_f32_32x32x16_bf16(PAF(3),VFR(7),o[1],0,0,0), C1,12); \
    }while(0)
  int t=1;
  #define ENDW(tt) do{ if((tt)+3<NT){WAIT_BAR(2);} else if((tt)+2<NT){WAIT_BAR(1);} else {WAIT_BAR(0);} }while(0)
  for(;t<5&&t+1<NT;t+=2){
    STEP(pB0,pB1,pA0,pA1,t,(t+3<NT),(t+1<NT),(t+1<NT));       ENDW(t);   RESC(); ROT();
    STEP(pA0,pA1,pB0,pB1,t+1,(t+4<NT),(t+2<NT),(t+2<NT));     ENDW(t+1); RESC(); ROT();
  }
  #undef CMASK
  #define CMASK(P0,P1,t) do{}while(0)
  for(;t+5<NT;t+=2){
    STEP(pB0,pB1,pA0,pA1,t,true,true,true);     WAIT_BAR(2); RESC(); ROT();
    STEP(pA0,pA1,pB0,pB1,t+1,true,true,true);   WAIT_BAR(2); RESC(); ROT();
  }
  for(;t+1<NT;t+=2){
    STEP(pB0,pB1,pA0,pA1,t,(t+3<NT),(t+1<NT),(t+1<NT));       ENDW(t);   RESC(); ROT();
    STEP(pA0,pA1,pB0,pB1,t+1,(t+4<NT),(t+2<NT),(t+2<NT));     ENDW(t+1); RESC(); ROT();
  }
  #undef CMASK
  #define CMASK(P0,P1,t) do{ if((t)<4)cmask(P0,P1,(t),qrel,hi);}while(0)
  STEP(pB0,pB1,pA0,pA1,NT-1,false,false,false); RESC();
  { float sacc=pB0[0]+pB0[1]; _Pragma("unroll") for(int r=2;r<16;++r)sacc+=pB0[r]; _Pragma("unroll") for(int r=0;r<16;++r)sacc+=pB1[r]; l_reg+=sacc;
    pw0=(u32x4){PKW(pB0,0),PKW(pB0,2),PKW(pB0,4),PKW(pB0,6)};pw1=(u32x4){PKW(pB0,8),PKW(pB0,10),PKW(pB0,12),PKW(pB0,14)};pw2=(u32x4){PKW(pB1,0),PKW(pB1,2),PKW(pB1,4),PKW(pB1,6)};pw3=(u32x4){PKW(pB1,8),PKW(pB1,10),PKW(pB1,12),PKW(pB1,14)};
    SBAR(); pv(o,vb0+sl_cur,PAF(0),PAF(1),PAF(2),PAF(3)); }
  #undef PKW
  #undef PAF
  #undef VFR
  #undef PIN
  #undef MX3
  #undef GAPA
  #undef GAPB
  #undef EX
  #undef VRD
  #undef KRD
  #undef STEP
  #undef ENDW
  {auto rr=__builtin_amdgcn_permlane32_swap(__float_as_uint(l_reg),__float_as_uint(l_reg),false,false);l_reg=__uint_as_float(rr[0])+__uint_as_float(rr[1]);}
  if(hi==0)wsf[32+r32]=l_reg;asm volatile("s_waitcnt lgkmcnt(0)":::"memory");
  float rli[16];
  #pragma unroll
  for(int r=0;r<16;++r)rli[r]=__builtin_amdgcn_rcpf(wsf[32+crow(r,hi)]);
  bf16*Ow=O+(rowbase+q0+wid*QBLK)*OPITCH+h*D; const __amdgpu_buffer_rsrc_t orsrc_=__builtin_amdgcn_make_buffer_rsrc((void*)O,0,0x7fffffff,0x00020000);
  { bf16*stg=(bf16*)(shm+LDS_OST)+wid*2048;
    #pragma unroll
    for(int r=0;r<16;++r){const int orow=crow(r,hi);
      #pragma unroll
      for(int d0=0;d0<2;++d0)stg[orow*64+d0*32+r32]=__float2bfloat16(o[d0][r]*rli[r]);}
    asm volatile("s_waitcnt lgkmcnt(0)":::"memory");
    #pragma unroll
    for(int i=0;i<4;++i){const int row=i*8+(lane>>3),ch=lane&7; const u32x4 v=*(const u32x4*)(stg+row*64+ch*8); ATTN_STORE16(Ow+(long)row*OPITCH+ch*8,v);} }
  asm volatile("s_waitcnt lgkmcnt(0)\n\ts_barrier":::"memory");
  #undef DMA_K
  #undef DMA_V
  #undef POS
  #undef CINIT
  #undef CMASK
  #undef START
  #undef RESC
  #undef ROT
}
constexpr int ATTN_LDS_BYTES=LDS_BYTES;
struct AttnTensors { const bf16* Q; const bf16* K; const bf16* V; bf16* O; const float* kmean; };
struct AttnUnit { int bh; int qb; };
struct StaticOrder {
  int vcu,grid;
  __device__ __forceinline__ explicit StaticOrder(int grid_,int block):vcu((grid_%8==0)?((block%8)*(grid_/8)+block/8):block),grid(grid_){}
  __device__ __forceinline__ bool next(int i,AttnUnit&u)const{ const int item=(i>>1)*grid+vcu; if(item>=BATCH*NHEAD*8)return false; const int s=item&7; u.bh=item>>3; u.qb=(i&1)?15-s:s; return true; }
  __device__ __forceinline__ void a_ready(const AttnUnit&)const{}
  __device__ __forceinline__ void done(const AttnUnit&)const{}
};
template<class Sched,int THRL=8> __device__ __forceinline__ void attn_phase(char*lds,const AttnTensors&T,const Sched&S){
  AttnUnit u;
  for(int i=0;S.next(i,u);++i){ S.a_ready(u); attn_unit<THRL>(u.bh/NHEAD,u.bh%NHEAD,u.qb,T.Q,T.K,T.V,T.O,T.kmean,lds); S.done(u); }
}
#undef SBAR
#undef WAIT_BAR
}

constexpr int NWAVES = 8;
#ifndef MK_N_LAUNCHES
#define MK_N_LAUNCHES 1
#endif
constexpr int N_LAUNCHES = MK_N_LAUNCHES;
constexpr int PER_PHASE = 4;

constexpr int BATCH = 8, SEQ = 4096, DM = 1024, TOK = BATCH * SEQ;
constexpr int CONV_CH = 512, CONV_W = 31, ATT_W = 512, IN_COLS = 4608;
constexpr int P_HEADS = 8, P_NK = 128, P_TOPK = 16, P_E = P_HEADS * P_TOPK  , N_EXP = P_NK * P_NK;
constexpr float NORM_EPS = 1e-6f;

constexpr size_t MiB = 1u << 20;
constexpr size_t WS_CTL = 0, CTL_ZERO_BYTES = 65536;
constexpr size_t WS_KMEAN = 1 * MiB;
constexpr size_t WS_SS = 2 * MiB;
constexpr size_t WS_WIN = 4 * MiB;
constexpr size_t WS_WPW = 13 * MiB, WS_WAO = 14 * MiB;
constexpr size_t WS_WOUT = 15 * MiB;
constexpr size_t WS_WQ = 17 * MiB;
constexpr size_t WS_KEYS = 21 * MiB;
constexpr size_t WS_USC = 22 * MiB, WS_VSC = 22 * MiB + 65536;
constexpr size_t WS_UB = 24 * MiB, WS_VB = 56 * MiB;
constexpr size_t WS_H = 88 * MiB;
constexpr size_t WS_CACT = 88 * MiB;
constexpr size_t WS_EIDX = 472 * MiB, WS_GW = 488 * MiB, WS_GA = 40 * MiB;
constexpr size_t WS_ZGLU = 152 * MiB, WS_QO = 184 * MiB, WS_K = 216 * MiB, WS_V = 248 * MiB;
constexpr size_t WS_MIX = 408 * MiB;
constexpr size_t WS_QP = 152 * MiB;
constexpr size_t WS_COEF = 72 * MiB, WS_SS2 = 23 * MiB;
constexpr size_t WS_GC = 280 * MiB, WS_GATE_A = 344 * MiB;
constexpr size_t WS_X1B = 280 * MiB;
constexpr size_t WS_X8 = 344 * MiB, WS_XS = 22 * MiB + 524288;
constexpr int X8_PITCH = 2048;
constexpr size_t WS_END = 504 * MiB;
constexpr int CW_TMO = 0, CW_CODE = 1, CW_CONVQ = 64, CW_BAR = 4096, CW_PAIR = 8192;

constexpr int RING_OFF = 0, RING_BYTES = 131072;
constexpr int LDSCTL_OFF = RING_BYTES, MISC_OFF = LDSCTL_OFF + 320;
constexpr int LDS_BYTES = 147456;
static_assert(MISC_OFF + 128 <= LDS_BYTES, "LDS map");

#define GAS __attribute__((address_space(1)))
#define LAS __attribute__((address_space(3)))
typedef unsigned short bf16;
typedef unsigned v4u __attribute__((ext_vector_type(4)));
typedef float f32x4 __attribute__((ext_vector_type(4)));
typedef float f32x16 __attribute__((ext_vector_type(16)));
typedef short bf16x8 __attribute__((ext_vector_type(8)));
typedef __bf16 bf16x2_t __attribute__((ext_vector_type(2)));
typedef GAS unsigned gu32;
#define RLX_AGENT __ATOMIC_RELAXED, __HIP_MEMORY_SCOPE_AGENT
#define LDS_WAIT() asm volatile("s_waitcnt lgkmcnt(0)" ::: "memory")
#define VM_WAIT() asm volatile("s_waitcnt vmcnt(0)" ::: "memory")
__device__ __forceinline__ unsigned f2bf(float f) { unsigned u = __builtin_bit_cast(unsigned, f); return (u + 0x7fffu + ((u >> 16) & 1u)) >> 16; }
__device__ __forceinline__ unsigned pk2(float lo, float hi) { return f2bf(lo) | (f2bf(hi) << 16); }
__device__ __forceinline__ float bflo(unsigned u) { return __uint_as_float(u << 16); }
__device__ __forceinline__ float bfhi(unsigned u) { return __uint_as_float(u & 0xffff0000u); }

#define XB_TMO      128
#define XB_XCNT(j)  (256  + 64 * (j))
#define XB_XSUB(j)  (1280 + 64 * (j))
#define XB_XGEN(j)  (2304 + 64 * (j))
#define XB_TOP      3328
#define XB_TOPGEN   3392
#define XCD_BAR_WORDS 3456
#define XB_SPIN_CAP (1u << 18)

__device__ __forceinline__ unsigned xb_ld(unsigned* p)              { return __hip_atomic_load(p, __ATOMIC_RELAXED, __HIP_MEMORY_SCOPE_AGENT); }
__device__ __forceinline__ unsigned xb_add(unsigned* p, unsigned v) { return __hip_atomic_fetch_add(p, v, __ATOMIC_RELAXED, __HIP_MEMORY_SCOPE_AGENT); }
__device__ __forceinline__ unsigned xb_xcc_id() { return (unsigned)__builtin_amdgcn_s_getreg((3 << 11) | 20) & 0xFu; }
#define XB_SPIN(cond, bar) do { unsigned _sp = 0; while (cond) { __builtin_amdgcn_s_sleep(1); \
    if ((++_sp & 255u) == 0u) { if (xb_ld(&(bar)[XB_TMO])) break; if (_sp > XB_SPIN_CAP) { atomicAdd(&(bar)[XB_TMO], 1u); break; } } } } while (0)

struct XcdBarrier {
    unsigned* bar; unsigned x;
    volatile LAS unsigned* st;
};

__device__ __forceinline__ XcdBarrier xcd_barrier_post(unsigned* bar, volatile LAS unsigned* st) {
    XcdBarrier b; b.bar = bar; b.x = xb_xcc_id(); b.st = st;
    if (threadIdx.x == 0) (void)xb_add(&bar[XB_XCNT(b.x)], 1u);
    return b;
}
__device__ __forceinline__ void xcd_barrier_complete(unsigned* bar, unsigned x, unsigned& nloc, unsigned& nx) {
    const unsigned G = gridDim.x * gridDim.y * gridDim.z;
    unsigned sum, cnt, mine, sp = 0u;
    for (;;) {
        sum = 0u; cnt = 0u; mine = 0u;
#pragma unroll
        for (unsigned j = 0; j < 16; ++j) { const unsigned c = xb_ld(&bar[XB_XCNT(j)]); sum += c; cnt += (c > 0u) ? 1u : 0u; mine = (j == x) ? c : mine; }
        if (sum == G) break;
        __builtin_amdgcn_s_sleep(1);
        if ((++sp & 255u) == 0u) { if (xb_ld(&bar[XB_TMO])) break; if (sp > XB_SPIN_CAP) { atomicAdd(&bar[XB_TMO], 1u); break; } }
    }
    nloc = mine > 0u ? mine : 1u; nx = cnt > 0u ? cnt : 1u;
}

__device__ __forceinline__ void xcd_barrier(const XcdBarrier& b) {
    asm volatile("s_waitcnt vmcnt(0)" ::: "memory");
    __syncthreads();
    if (threadIdx.x == 0) {
        unsigned* bar = b.bar;
        __builtin_amdgcn_s_waitcnt(0);
        unsigned nloc = b.st[0], nx = b.st[1];
        if (nloc == 0u) { xcd_barrier_complete(bar, b.x, nloc, nx); b.st[0] = nloc; b.st[1] = nx; }
        const unsigned old = xb_add(&bar[XB_XSUB(b.x)], 1u);
        const unsigned gen = old / nloc;
        if (old + 1u == (gen + 1u) * nloc) {
            __builtin_amdgcn_fence(__ATOMIC_RELEASE, "agent");
            asm volatile("s_waitcnt vmcnt(0)" ::: "memory");
            const unsigned og = xb_add(&bar[XB_TOP], 1u);
            const unsigned tg = og / nx;
            if (og + 1u == (tg + 1u) * nx) xb_add(&bar[XB_TOPGEN], 1u);
            else XB_SPIN(xb_ld(&bar[XB_TOPGEN]) == tg, bar);
            __builtin_amdgcn_fence(__ATOMIC_ACQUIRE, "agent");
            xb_add(&bar[XB_XGEN(b.x)], 1u);
            asm volatile("s_waitcnt vmcnt(0)" ::: "memory");
        } else {
            XB_SPIN(xb_ld(&bar[XB_XGEN(b.x)]) == gen, bar);
            __builtin_amdgcn_fence(__ATOMIC_ACQUIRE, "agent");
            asm volatile("s_waitcnt vmcnt(0)" ::: "memory");
        }
    }
    __syncthreads();
}

struct Frame {
    LAS unsigned char* lds;
    volatile LAS unsigned* MISC;
    gu32* ctl;
    int tid, lane, wave;
    int vcu, G;
};
__device__ __forceinline__ float wave_sum(float v) {
#pragma unroll
    for (int o = 1; o < 64; o <<= 1) v += __shfl_xor(v, o);
    return v;
}

__device__ __forceinline__ float wave_sum_hi(float v) {
    v += __builtin_bit_cast(float, __builtin_amdgcn_update_dpp(0, __builtin_bit_cast(int, v), 0xB1, 0xf, 0xf, false));
    v += __builtin_bit_cast(float, __builtin_amdgcn_update_dpp(0, __builtin_bit_cast(int, v), 0x4E, 0xf, 0xf, false));
    v += __builtin_bit_cast(float, __builtin_amdgcn_update_dpp(0, __builtin_bit_cast(int, v), 0x141, 0xf, 0xf, false));
    v += __builtin_bit_cast(float, __builtin_amdgcn_update_dpp(0, __builtin_bit_cast(int, v), 0x140, 0xf, 0xf, false));
    v += __builtin_bit_cast(float, __builtin_amdgcn_update_dpp(0, __builtin_bit_cast(int, v), 0x142, 0xA, 0xF, false));
    v += __builtin_bit_cast(float, __builtin_amdgcn_update_dpp(0, __builtin_bit_cast(int, v), 0x143, 0xC, 0xF, false));
    return v;
}

__device__ __forceinline__ void p0_transpose_item(const float* W, int K, int N, bf16* WT, int k0, int n0, int dst_row0, const float* kscale, LAS float* scr, int lane, int dpitch = 0, int koff = 0) {
    if (dpitch == 0) dpitch = K;
#pragma unroll 8
    for (int i = 0; i < 32; ++i) { const int kk = 2 * i + (lane >> 5); float v = W[(size_t)(k0 + kk) * N + n0 + (lane & 31)]; if (kscale) v *= kscale[k0 + kk]; scr[kk * 33 + (lane & 31)] = v; }
    LDS_WAIT(); asm volatile("" ::: "memory");
    const int c = lane & 7;
#pragma unroll
    for (int j = 0; j < 4; ++j) { const int n = (lane >> 3) + 8 * j; const LAS float* s = scr + (8 * c) * 33 + n;
        v4u o; o.x = pk2(s[0 * 33], s[1 * 33]); o.y = pk2(s[2 * 33], s[3 * 33]); o.z = pk2(s[4 * 33], s[5 * 33]); o.w = pk2(s[6 * 33], s[7 * 33]);
        *(GAS v4u*)(WT + (size_t)(dst_row0 + n) * dpitch + koff + k0 + 8 * c) = o; }
    LDS_WAIT(); asm volatile("" ::: "memory");
}
__device__ __forceinline__ int perm_in(int s) { if (s < 512) return 256 * (s >> 7) + (s & 127); if (s < 1024) { const int s2 = s - 512; return 256 * (s2 >> 7) + 128 + (s2 & 127); } return s; }
__device__ __forceinline__ float wave_max(float v) {
#pragma unroll
    for (int o = 1; o < 64; o <<= 1) v = fmaxf(v, __shfl_xor(v, o));
    return v;
}
template <bool NORM, int NR> __device__ __forceinline__ void rows_to_bf16(int lane, const float* xrow, size_t rstride, const float* g, bf16* orow) {
    f32x4 v[NR][4]; float s2[NR];
#pragma unroll
    for (int q = 0; q < NR; ++q) { const GAS f32x4* xr = (const GAS f32x4*)(xrow + q * rstride) + lane;
#pragma unroll
        for (int j = 0; j < 4; ++j) v[q][j] = xr[64 * j]; }
#pragma unroll
    for (int q = 0; q < NR; ++q) { s2[q] = 0.f;
#pragma unroll
        for (int j = 0; j < 4; ++j) s2[q] += (v[q][j].x * v[q][j].x + v[q][j].y * v[q][j].y) + (v[q][j].z * v[q][j].z + v[q][j].w * v[q][j].w); }
    float rstd[NR];
#pragma unroll
    for (int q = 0; q < NR; ++q) rstd[q] = NORM ? 1.f / sqrtf(wave_sum(s2[q]) * (1.f / 1024.f) + NORM_EPS) : 1.f;
#pragma unroll
    for (int j = 0; j < 4; ++j) { f32x4 gv = (f32x4){1.f, 1.f, 1.f, 1.f}; if (g) gv = *((const GAS f32x4*)g + lane + 64 * j);
#pragma unroll
        for (int q = 0; q < NR; ++q) { const f32x4 w = v[q][j] * rstd[q] * gv;
            ((GAS unsigned long long*)(orow + q * rstride) + lane)[64 * j] = (unsigned long long)pk2(w.x, w.y) | ((unsigned long long)pk2(w.z, w.w) << 32); } }
}
template <bool NORM> __device__ __forceinline__ void row_to_bf16(int lane, const float* xrow, const float* g, bf16* orow) { rows_to_bf16<NORM, 1>(lane, xrow, 1024, g, orow); }
template <bool SLICED> __device__ __forceinline__ void row_to_fp8(int lane, const float* xrow, const float* g, unsigned char* base, int row, float* isc) {
    const GAS f32x4* xr = (const GAS f32x4*)xrow + lane;
    f32x4 v[4]; float am = 0.f;
#pragma unroll
    for (int j = 0; j < 4; ++j) { v[j] = xr[64 * j]; if (g) v[j] = v[j] * *((const GAS f32x4*)g + lane + 64 * j);
        am = fmaxf(am, fmaxf(fmaxf(fabsf(v[j].x), fabsf(v[j].y)), fmaxf(fabsf(v[j].z), fabsf(v[j].w)))); }
#pragma unroll
    for (int o = 1; o < 64; o <<= 1) am = fmaxf(am, __shfl_xor(am, o));
    const float sc = am > 0.f ? 240.f / am : 1.f;
    if (lane == 0) isc[row] = am > 0.f ? am * (1.f / 240.f) : 1.f;
#pragma unroll
    for (int j = 0; j < 4; ++j) { int w = 0; w = __builtin_amdgcn_cvt_pk_fp8_f32(v[j].x * sc, v[j].y * sc, w, false); w = __builtin_amdgcn_cvt_pk_fp8_f32(v[j].z * sc, v[j].w * sc, w, true);
        if (SLICED) *(GAS int*)(base + (size_t)(2 * j + (lane >> 5)) * ((size_t)N_EXP * 128) + (size_t)row * 128 + 4 * (lane & 31)) = w;
        else *(GAS int*)(base + (size_t)row * 1024 + 4 * (lane + 64 * j)) = w; }
}
__device__ __forceinline__ void rows_to_fp8_uv(int lane, const float* urow, const float* vrow, const float* g, unsigned char* ub8, unsigned char* vb8, int row, float* usc, float* vsc) {
    f32x4 u[4], v[4]; float au = 0.f, av = 0.f;
#pragma unroll
    for (int j = 0; j < 4; ++j) { u[j] = ((const GAS f32x4*)urow + lane)[64 * j]; v[j] = ((const GAS f32x4*)vrow + lane)[64 * j]; }
#pragma unroll
    for (int j = 0; j < 4; ++j) { u[j] = u[j] * *((const GAS f32x4*)g + lane + 64 * j);
        au = fmaxf(au, fmaxf(fmaxf(fabsf(u[j].x), fabsf(u[j].y)), fmaxf(fabsf(u[j].z), fabsf(u[j].w))));
        av = fmaxf(av, fmaxf(fmaxf(fabsf(v[j].x), fabsf(v[j].y)), fmaxf(fabsf(v[j].z), fabsf(v[j].w)))); }
#pragma unroll
    for (int o = 1; o < 64; o <<= 1) { au = fmaxf(au, __shfl_xor(au, o)); av = fmaxf(av, __shfl_xor(av, o)); }
    const float su = au > 0.f ? 240.f / au : 1.f, sv = av > 0.f ? 240.f / av : 1.f;
    if (lane == 0) { usc[row] = au > 0.f ? au * (1.f / 240.f) : 1.f; vsc[row] = av > 0.f ? av * (1.f / 240.f) : 1.f; }
#pragma unroll
    for (int j = 0; j < 4; ++j) { int w = 0; w = __builtin_amdgcn_cvt_pk_fp8_f32(u[j].x * su, u[j].y * su, w, false); w = __builtin_amdgcn_cvt_pk_fp8_f32(u[j].z * su, u[j].w * su, w, true);
        *(GAS int*)(ub8 + (size_t)row * 1024 + 4 * (lane + 64 * j)) = w;
        int x = 0; x = __builtin_amdgcn_cvt_pk_fp8_f32(v[j].x * sv, v[j].y * sv, x, false); x = __builtin_amdgcn_cvt_pk_fp8_f32(v[j].z * sv, v[j].w * sv, x, true);
        *(GAS int*)(vb8 + (size_t)(2 * j + (lane >> 5)) * ((size_t)N_EXP * 128) + (size_t)row * 128 + 4 * (lane & 31)) = x; }
}
struct P0Args { const float *x, *g1, *w_in, *w_pw, *w_ao, *w_out, *g2, *w_q, *k1, *k2, *pu, *pv; bf16 *H, *Win, *Wpw, *Wao, *Wout, *Wq, *keys; unsigned char *ub8, *vb8; float *usc, *vsc; };
__device__ __forceinline__ void p0_prologue(Frame& F, const P0Args& a) {
    LAS float* scr = (LAS float*)(F.lds + RING_OFF + F.wave * 16384);
    const int gw = F.vcu * NWAVES + F.wave, NGW = F.G * NWAVES;
    constexpr int I_IN = 16 * (IN_COLS / 32), I_PW = 8 * 32, I_AO = 8 * 32, I_OUT = 16 * 32, I_Q = 16 * 64;
    constexpr int NITEMS = I_IN + I_PW + I_AO + I_OUT + I_Q;
    for (int it = gw; it < NITEMS; it += NGW) {
        int r = it;
        if (r < I_IN) { const int nb = IN_COLS / 32, kb = r / nb, n0 = 32 * (r % nb); p0_transpose_item(a.w_in, 1024, IN_COLS, a.Win, 64 * kb, n0, perm_in(n0), nullptr, scr, F.lane); continue; } r -= I_IN;
        if (r < I_PW) { const int kb = r / 32, n0 = 32 * (r % 32); p0_transpose_item(a.w_pw, 512, 1024, a.Wpw, 64 * kb, n0, n0, nullptr, scr, F.lane, 1024, 0); continue; } r -= I_PW;
        if (r < I_AO) { const int kb = r / 32, n0 = 32 * (r % 32); p0_transpose_item(a.w_ao, 512, 1024, a.Wpw, 64 * kb, n0, n0, nullptr, scr, F.lane, 1024, 512); continue; }   r -= I_AO;
        if (r < I_OUT) { const int kb = r / 32, n0 = 32 * (r % 32); p0_transpose_item(a.w_out, 1024, 1024, a.Wout, 64 * kb, n0, n0, nullptr, scr, F.lane); continue; } r -= I_OUT;
        { const int kb = r / 64, n0 = 32 * (r % 64); p0_transpose_item(a.w_q, 1024, 2048, a.Wq, 64 * kb, n0, n0, a.g2, scr, F.lane); }
    }
    for (int m = 4 * gw; m < TOK; m += 4 * NGW) rows_to_bf16<true, 4>(F.lane, a.x + (size_t)m * 1024, 1024, a.g1, a.H + (size_t)m * 1024);
    for (int m = gw; m < N_EXP; m += NGW) rows_to_fp8_uv(F.lane, a.pu + (size_t)m * 1024, a.pv + (size_t)m * 1024, a.g2, a.ub8, a.vb8, m, a.usc, a.vsc);
    for (int m = gw; m < 32; m += NGW) { const float* src = (m < 16 ? a.k1 : a.k2) + (size_t)(m & 15) * 1024; row_to_bf16<false>(F.lane, src, nullptr, a.keys + (size_t)m * 1024); }
}

struct ConvArgs { const bf16* zglu; const float *cw, *cb, *lg, *lb; bf16* cact; };
__device__ __forceinline__ void conv_phase(Frame& F, const ConvArgs& a) {
    LAS unsigned char* zs = F.lds + RING_OFF;
    LAS float* part = (LAS float*)(F.lds + RING_OFF + 98304);
    int tid_ = F.tid; asm volatile("" : "+v"(tid_));
    const int cp = tid_ & 255, half = tid_ >> 8, c0 = 2 * cp;
    float w0[CONV_W], w1[CONV_W];
    { const GAS float* p = (const GAS float*)(a.cw + c0);
#pragma unroll
      for (int w = 0; w < CONV_W; ++w) { w0[w] = p[0]; w1[w] = p[1]; p += 512; asm volatile("" : "+v"(p)); } }
    const float b0 = a.cb[c0], b1 = a.cb[c0 + 1], lg0 = a.lg[c0], lg1 = a.lg[c0 + 1], lb0 = a.lb[c0], lb1 = a.lb[c0 + 1];
    for (int tile = F.vcu; tile < TOK / 64; tile += F.G) {
        const int t0 = tile * 64, tb = t0 & (SEQ - 1);
#pragma unroll
        for (int hb = 0; hb < 2; ++hb) { v4u zv[6];
#pragma unroll
          for (int q = 0; q < 6; ++q) { const int i = tid_ + 512 * (6 * hb + q), r = i >> 6, ch = i & 63; zv[q] = (v4u){0u, 0u, 0u, 0u};
              if (i < 94 * 64 && tb - 30 + r >= 0) zv[q] = *(const GAS v4u*)(a.zglu + (size_t)(t0 - 30 + r) * 512 + ch * 8); }
#pragma unroll
          for (int q = 0; q < 6; ++q) { const int i = tid_ + 512 * (6 * hb + q), r = i >> 6, ch = i & 63; if (i < 94 * 64) *(LAS v4u*)(zs + r * 1024 + ch * 16) = zv[q]; } }
        __syncthreads();
        for (int ch8 = 0; ch8 < 4; ++ch8) {
            const int tl = half * 32 + ch8 * 8;
            float z0[38], z1[38];
#pragma unroll
            for (int i = 0; i < 38; ++i) { const unsigned u = *(const LAS unsigned*)(zs + (tl + i) * 1024 + cp * 4); z0[i] = bflo(u); z1[i] = bfhi(u); }
            float a0[8], a1[8];
#pragma unroll
            for (int k = 0; k < 8; ++k) { float s0 = b0, s1 = b1;
#pragma unroll
                for (int w = 0; w < CONV_W; ++w) { s0 += w0[w] * z0[k + w]; s1 += w1[w] * z1[k + w]; }
                a0[k] = s0; a1[k] = s1; }
#pragma unroll
            for (int k = 0; k < 8; ++k) { const float s1 = wave_sum_hi(a0[k] + a1[k]), s2 = wave_sum_hi(a0[k] * a0[k] + a1[k] * a1[k]);
                if (F.lane == 63) { part[((half * 8 + k) * 4 + (F.wave & 3)) * 2] = s1; part[((half * 8 + k) * 4 + (F.wave & 3)) * 2 + 1] = s2; } }
            __syncthreads();
            bf16* op = a.cact + (size_t)(t0 + tl) * 1024 + c0;
#pragma unroll
            for (int k = 0; k < 8; ++k) { const LAS float* p = part + (half * 8 + k) * 8;
                const float S1 = (p[0] + p[2]) + (p[4] + p[6]), S2 = (p[1] + p[3]) + (p[5] + p[7]);
                const float mean = S1 * (1.f / 512.f), var = S2 * (1.f / 512.f) - mean * mean, rstd = __builtin_amdgcn_rsqf(var + NORM_EPS);
                const float y0 = (a0[k] - mean) * rstd * lg0 + lb0, y1 = (a1[k] - mean) * rstd * lg1 + lb1;
                const float o0 = y0 * __builtin_amdgcn_rcpf(1.f + __builtin_amdgcn_exp2f(-1.4426950408889634f * y0)), o1 = y1 * __builtin_amdgcn_rcpf(1.f + __builtin_amdgcn_exp2f(-1.4426950408889634f * y1));
                *(GAS unsigned*)(op + k * 1024) = pk2(o0, o1); }
            __syncthreads();
        }
    }
}

__device__ __forceinline__ int tokey(float v) { const int b = __float_as_int(v); return b ^ ((b >> 31) & 0x7fffffff); }
__device__ __forceinline__ float unkey(int k, int mask) { const int t = k & ~mask; return __int_as_float(t ^ ((t >> 31) & 0x7fffffff)); }
__device__ __forceinline__ void ce_desc(int& a, int& b) { const int hi = a > b ? a : b, lo = a > b ? b : a; a = hi; b = lo; }
template <int N> __device__ __forceinline__ void sort_desc(int (&v)[N]) {
#pragma unroll
    for (int k = 2; k <= N; k <<= 1)
#pragma unroll
        for (int j = k >> 1; j > 0; j >>= 1)
#pragma unroll
            for (int i = 0; i < N; ++i) { const int l = i ^ j; if (l > i) { if ((i & k) == 0) ce_desc(v[i], v[l]); else ce_desc(v[l], v[i]); } }
}
__device__ __forceinline__ void bitonic_merge16_desc(int (&v)[16]) {
#pragma unroll
    for (int j = 8; j > 0; j >>= 1)
#pragma unroll
        for (int i = 0; i < 16; ++i) { const int l = i ^ j; if (l > i) ce_desc(v[i], v[l]); }
}
__device__ __forceinline__ void merge_top16(int (&a)[16], const int (&b)[16]) {
#pragma unroll
    for (int i = 0; i < 16; ++i) a[i] = a[i] > b[15 - i] ? a[i] : b[15 - i];
    bitonic_merge16_desc(a);
}
__device__ __forceinline__ void top16_of_64(const int (&x)[64], int (&out)[16]) {
    int g[16];
#pragma unroll
    for (int i = 0; i < 16; ++i) out[i] = x[i];
    sort_desc<16>(out);
#pragma unroll
    for (int q = 1; q < 4; ++q) {
#pragma unroll
        for (int i = 0; i < 16; ++i) g[i] = x[16 * q + i];
        sort_desc<16>(g); merge_top16(out, g); }
}
__device__ __forceinline__ int crow_(int r, int hi) { return (r & 3) + 8 * (r >> 2) + 4 * hi; }
struct SelArgs { const bf16* qp; const bf16* keys; const float* ss; const float* usc; const float* vsc; int* eidx; float* ga; float* gb; const bf16* x1b; unsigned char* x8; float* xs; };
__device__ __forceinline__ void peer_select_phase(Frame& F, const SelArgs& a, const int rb, const int h0, const int nh) {
    for (int i = F.tid; i < 2 * 128 * 16; i += 512) { const int which = i >> 11, rem = i & 2047, row = rem >> 4, ch = rem & 15;
        const v4u v = *(const GAS v4u*)(a.keys + (size_t)which * 16384 + row * 128 + ch * 8);
        *(LAS v4u*)(F.lds + RING_OFF + which * 32768 + row * 256 + ((ch ^ (row & 15)) << 4)) = v; }
    __syncthreads();
    LAS int* scr = (LAS int*)(F.lds + RING_OFF + 65536 + F.wave * 4096);
    const int lane = F.lane, tl = lane & 31, hi = lane >> 5;
    constexpr int PA[50] = {0,0,0,0,0,0,0,0,0,0,0,0,0,0,0,0, 1,1,1,1,1,1,1,1, 2,2,2,2,2, 3,3,3,3, 4,4,4, 5,5, 6,6, 7,7, 8,9,10,11,12,13,14,15};
    constexpr int PB[50] = {0,1,2,3,4,5,6,7,8,9,10,11,12,13,14,15, 0,1,2,3,4,5,6,7, 0,1,2,3,4, 0,1,2,3, 0,1,2, 0,1, 0,1, 0,1, 0,0,0,0,0,0,0,0};
    for (int k = 0; k < nh; ++k) {
        const int tt = rb * 8 + F.wave, hh = h0 + k, t = tt * 32 + tl;
        int vk[2][16];
#pragma unroll
        for (int half = 0; half < 2; ++half) {
            const bf16* qrow = a.qp + (size_t)t * 2048 + hh * 256 + half * 128 + hi * 8;
            bf16x8 bq[8];
#pragma unroll
            for (int ks = 0; ks < 8; ++ks) bq[ks] = *(const GAS bf16x8*)(qrow + ks * 16);
            f32x16 acc[4];
#pragma unroll
            for (int nb = 0; nb < 4; ++nb) { acc[nb] = (f32x16){};
#pragma unroll
                for (int ks = 0; ks < 8; ++ks) { const int row = nb * 32 + tl, ch = 2 * ks + hi;
                    const bf16x8 ka = *(const LAS bf16x8*)(F.lds + RING_OFF + half * 32768 + row * 256 + ((ch ^ (row & 15)) << 4));
                    acc[nb] = __builtin_amdgcn_mfma_f32_32x32x16_bf16(ka, bq[ks], acc[nb], 0, 0, 0); } }
            int keys[64];
#pragma unroll
            for (int nb = 0; nb < 4; ++nb)
#pragma unroll
                for (int r = 0; r < 16; ++r) keys[nb * 16 + r] = (tokey(acc[nb][r]) & ~127) | (nb * 32 + crow_(r, hi));
            int top[16]; top16_of_64(keys, top);
            int oth[16];
#pragma unroll
            for (int i = 0; i < 16; ++i) oth[i] = __shfl_xor(top[i], 32);
            merge_top16(top, oth);
#pragma unroll
            for (int i = 0; i < 16; ++i) vk[half][i] = top[i];
        }
        float f1[16], f2[16];
#pragma unroll
        for (int i = 0; i < 16; ++i) { f1[i] = unkey(vk[0][i], 127); f2[i] = unkey(vk[1][i], 127); }
        int ck[64];
#pragma unroll
        for (int i = 0; i < 50; ++i) ck[i] = (tokey(f1[PA[i]] + f2[PB[i]]) & ~255) | (PA[i] * 16 + PB[i]);
#pragma unroll
        for (int i = 50; i < 64; ++i) ck[i] = (int)0x80000000;
        int c[16]; top16_of_64(ck, c);
        if (hi == 0) {
#pragma unroll
            for (int i = 0; i < 16; ++i) { scr[tl * 32 + i] = vk[0][i] & 127; scr[tl * 32 + 16 + i] = vk[1][i] & 127; } }
        float ssum = 0.f;
        { const GAS f32x4* sp = (const GAS f32x4*)(a.ss + (size_t)t * 16);
#pragma unroll
          for (int i = 0; i < 4; ++i) { const f32x4 v = sp[i]; ssum += (v.x + v.y) + (v.z + v.w); } }
        const float rstd = 1.f / sqrtf(ssum * (1.f / 1024.f) + NORM_EPS);
        const float smax = unkey(c[0], 255);
        float e[16], esum = 0.f;
#pragma unroll
        for (int i = 0; i < 16; ++i) { e[i] = __expf((unkey(c[i], 255) - smax) * rstd); esum += e[i]; }
        const float inv = 1.f / esum;
        LDS_WAIT(); asm volatile("" ::: "memory");
        int eo[8]; float go[8];
#pragma unroll
        for (int i = 0; i < 8; ++i) { const int ci = hi ? c[i + 8] : c[i]; const float ei = hi ? e[i + 8] : e[i];
            const int id = ci & 255, i1 = scr[tl * 32 + (id >> 4)], i2 = scr[tl * 32 + 16 + (id & 15)];
            eo[i] = i1 * P_NK + i2; go[i] = ei * inv; }
        float ua[8];
#pragma unroll
        for (int i = 0; i < 8; ++i) { ua[i] = a.usc[eo[i]]; go[i] *= a.vsc[eo[i]]; }
        int* ep = a.eidx + (size_t)t * P_E + hh * 16 + hi * 8; float* gp = a.gb + (size_t)t * P_E + hh * 16 + hi * 8; float* up_ = a.ga + (size_t)t * P_E + hh * 16 + hi * 8;
        *(GAS f32x4*)(up_) = (f32x4){ua[0], ua[1], ua[2], ua[3]}; *(GAS f32x4*)(up_ + 4) = (f32x4){ua[4], ua[5], ua[6], ua[7]};
        *(GAS v4u*)(ep) = (v4u){(unsigned)eo[0], (unsigned)eo[1], (unsigned)eo[2], (unsigned)eo[3]}; *(GAS v4u*)(ep + 4) = (v4u){(unsigned)eo[4], (unsigned)eo[5], (unsigned)eo[6], (unsigned)eo[7]};
        *(GAS f32x4*)(gp) = (f32x4){go[0], go[1], go[2], go[3]}; *(GAS f32x4*)(gp + 4) = (f32x4){go[4], go[5], go[6], go[7]};
        LDS_WAIT(); asm volatile("" ::: "memory");
    }
}

__device__ __forceinline__ void peer_rows_fp8(Frame& F, const SelArgs& a, const int t0, const int ntok) {
    const int lane = F.lane;
    for (int t = t0 + F.wave; t < t0 + ntok; t += NWAVES) {
        const GAS v4u* xp = (const GAS v4u*)(a.x1b + (size_t)t * 1024 + 16 * lane); const v4u xa = xp[0], xb = xp[1];
        const float xf[16] = {bflo(xa.x), bfhi(xa.x), bflo(xa.y), bfhi(xa.y), bflo(xa.z), bfhi(xa.z), bflo(xa.w), bfhi(xa.w), bflo(xb.x), bfhi(xb.x), bflo(xb.y), bfhi(xb.y), bflo(xb.z), bfhi(xb.z), bflo(xb.w), bfhi(xb.w)};
        float am = 0.f;
#pragma unroll
        for (int i = 0; i < 16; ++i) am = fmaxf(am, fabsf(xf[i]));
#pragma unroll
        for (int o = 1; o < 64; o <<= 1) am = fmaxf(am, __shfl_xor(am, o));
        const float xsc = am > 0.f ? 240.f / am : 1.f, xinv = am > 0.f ? am * (1.f / 240.f) : 1.f;
        v4u o;
        { int w = 0; w = __builtin_amdgcn_cvt_pk_fp8_f32(xf[0] * xsc, xf[1] * xsc, w, false); w = __builtin_amdgcn_cvt_pk_fp8_f32(xf[2] * xsc, xf[3] * xsc, w, true); o.x = (unsigned)w; }
        { int w = 0; w = __builtin_amdgcn_cvt_pk_fp8_f32(xf[4] * xsc, xf[5] * xsc, w, false); w = __builtin_amdgcn_cvt_pk_fp8_f32(xf[6] * xsc, xf[7] * xsc, w, true); o.y = (unsigned)w; }
        { int w = 0; w = __builtin_amdgcn_cvt_pk_fp8_f32(xf[8] * xsc, xf[9] * xsc, w, false); w = __builtin_amdgcn_cvt_pk_fp8_f32(xf[10] * xsc, xf[11] * xsc, w, true); o.z = (unsigned)w; }
        { int w = 0; w = __builtin_amdgcn_cvt_pk_fp8_f32(xf[12] * xsc, xf[13] * xsc, w, false); w = __builtin_amdgcn_cvt_pk_fp8_f32(xf[14] * xsc, xf[15] * xsc, w, true); o.w = (unsigned)w; }
        *(GAS v4u*)(a.x8 + (size_t)t * X8_PITCH + 16 * lane) = o;
        const float ssum = wave_sum(lane < 16 ? a.ss[(size_t)t * 16 + lane] : 0.f);
        if (lane == 0) a.xs[t] = xinv / sqrtf(ssum * (1.f / 1024.f) + NORM_EPS);
    }
}

typedef float f32x2_t __attribute__((ext_vector_type(2)));
struct ExpA { const unsigned char* x8; const float* xs; const unsigned char* ub8; const int* eidx; const float* ga; const float* gb; float* coef; };
__device__ __forceinline__ float row_sum16(float v) {
    v += __builtin_bit_cast(float, __builtin_amdgcn_update_dpp(0, __builtin_bit_cast(int, v), 0xB1, 0xf, 0xf, false));
    v += __builtin_bit_cast(float, __builtin_amdgcn_update_dpp(0, __builtin_bit_cast(int, v), 0x4E, 0xf, 0xf, false));
    v += __builtin_bit_cast(float, __builtin_amdgcn_update_dpp(0, __builtin_bit_cast(int, v), 0x141, 0xf, 0xf, false));
    v += __builtin_bit_cast(float, __builtin_amdgcn_update_dpp(0, __builtin_bit_cast(int, v), 0x140, 0xf, 0xf, false));
    return v;
}
__device__ __forceinline__ float gelu_as(float v) {
    const float av = fabsf(v), t = __builtin_amdgcn_rcpf(av * 0.2316418882f + 1.0f);
    float q = t * 0.5307027145f + (-0.7265760135f); q = q * t + 0.7107068705f; q = q * t + (-0.142248368f); q = q * t + 0.127414796f; q = q * t;
    const float m = v * (q * __builtin_amdgcn_exp2f((v * v) * (-0.72134752044f)));
    return v < 0.f ? m : v - m;
}
__device__ __forceinline__ float wave_sum_diag(float v) {
    v = row_sum16(v);
    v += __builtin_bit_cast(float, __builtin_amdgcn_update_dpp(0, __builtin_bit_cast(int, v), 0x142, 0xA, 0xF, false));
    v += __builtin_bit_cast(float, __builtin_amdgcn_update_dpp(0, __builtin_bit_cast(int, v), 0x143, 0xC, 0xF, false));
    return v;
}
__device__ __forceinline__ void pair_sync(Frame& F, gu32* pf, const unsigned epoch) {
    asm volatile("s_waitcnt vmcnt(0)" ::: "memory");
    __syncthreads();
    if (F.tid == 0) {
        unsigned* bar = (unsigned*)(F.ctl + CW_BAR);
        __builtin_amdgcn_fence(__ATOMIC_RELEASE, "agent");
        asm volatile("s_waitcnt vmcnt(0)" ::: "memory");
        __hip_atomic_store(pf + F.vcu * 16, epoch, RLX_AGENT);
        unsigned* other = (unsigned*)(pf + (F.vcu ^ 1) * 16);
        XB_SPIN(xb_ld(other) < epoch, bar);
        __builtin_amdgcn_fence(__ATOMIC_ACQUIRE, "agent");
        asm volatile("s_waitcnt vmcnt(0)" ::: "memory");
    }
    __syncthreads();
}
__device__ __forceinline__ int wg_grab(LAS int* c, const int lane) {
    int v = 0; if (lane == 0) v = __hip_atomic_fetch_add(c, 1, __ATOMIC_RELAXED, __HIP_MEMORY_SCOPE_WORKGROUP);
    return __builtin_amdgcn_readfirstlane(v);
}
__device__ __forceinline__ void peer_u_phase(Frame& F, const ExpA& a, const int s, const int tfirst, const int step, const int ntok, LAS int* cnt) {
    const int lane = F.lane;
    LAS int* lstA = (LAS int*)(F.lds + RING_OFF + F.wave * 4096); LAS int* lstB = lstA + 512;
    lstA[lane] = 0; lstA[64 + lane] = 0; lstB[lane] = 0; lstB[64 + lane] = 0;
    const bool diag = ((lane & 15) >> 2) == (lane >> 4); const int dsel = lane & 3;
    const bool b3 = (lane & 8) != 0; const int usel = ((lane >> 5) & 1) * 4 + ((lane >> 4) & 1) * 2 + ((lane >> 3) & 1);
    if (ntok <= 0) return;
    const GAS unsigned char* ubase = (const GAS unsigned char*)a.ub8; const unsigned lane16 = 16u * (unsigned)lane;
    struct Raw { v4u x; int e0, e1; float fa0, fa1, fb0, fb1, xs; };
#if defined(ABL_HOTROWS)
#define ABL_ROW(e) (((e) & ~2047) | ((e) & 63))
#else
#define ABL_ROW(e) (e)
#endif
#define PU_RAW(R, T) do { const int tt_ = (T) < TOK ? (T) : tfirst; R.x = *(const GAS v4u*)(a.x8 + (size_t)tt_ * X8_PITCH + 16 * lane); \
        R.e0 = a.eidx[(size_t)tt_ * P_E + lane]; R.e1 = a.eidx[(size_t)tt_ * P_E + 64 + lane]; R.fa0 = a.ga[(size_t)tt_ * P_E + lane]; R.fa1 = a.ga[(size_t)tt_ * P_E + 64 + lane]; \
        R.fb0 = a.gb[(size_t)tt_ * P_E + lane]; R.fb1 = a.gb[(size_t)tt_ * P_E + 64 + lane]; R.xs = a.xs[tt_]; } while (0)
#define PU_PREP(R, LST, XLO, XHI, N, VALID) do { \
        XLO = (long)(((unsigned long long)R.x.y << 32) | R.x.x); XHI = (long)(((unsigned long long)R.x.w << 32) | R.x.z); \
        const bool in0_ = (VALID) && (R.e0 >> 11) == s, in1_ = (VALID) && (R.e1 >> 11) == s; \
        const unsigned long long m0_ = __ballot(in0_), m1_ = __ballot(in1_), lt_ = (1ull << lane) - 1ull; \
        const int n0_ = __popcll(m0_); N = n0_ + __popcll(m1_); \
        LAS float* lsa_ = (LAS float*)(LST + 128); LAS float* lsb_ = (LAS float*)(LST + 256); \
        if (in0_) { const int p = __popcll(m0_ & lt_); LST[p] = lane | (R.e0 << 10); lsa_[p] = R.fa0 * R.xs; lsb_[p] = R.fb0; } \
        if (in1_) { const int p = n0_ + __popcll(m1_ & lt_); LST[p] = (64 + lane) | (R.e1 << 10); lsa_[p] = R.fa1 * R.xs; lsb_[p] = R.fb1; } } while (0)
#if defined(ABL_UNOLOAD)
#define PU_LOAD(W, LST, K0) do { _Pragma("unroll") for (int u = 0; u < 8; ++u) { const int ent_ = LST[((K0) + u) & 127]; const unsigned q_ = ((unsigned)ent_ & 0x07070707u) | 0x30303030u; W[u] = (v4u){q_, q_ ^ ((unsigned)lane & 7u), q_ ^ 0x01010101u, 0x31323334u}; } } while (0)
#elif defined(ABL_U768)
typedef unsigned v3u_ __attribute__((ext_vector_type(3)));
#define PU_LOAD(W, LST, K0) do { _Pragma("unroll") for (int u = 0; u < 8; ++u) { const int ent_ = LST[((K0) + u) & 127]; const v3u_ t_ = *(const GAS v3u_*)(a.ub8 + (size_t)ABL_ROW(ent_ >> 8) * 768 + 12 * lane); W[u] = (v4u){t_.x, t_.y, t_.z, 0u}; } } while (0)
#else
#define PU_LOAD(W, LST, K0) do { _Pragma("unroll") for (int u = 0; u < 8; ++u) { const unsigned off_ = ((unsigned)LST[((K0) + u) & 127] & ~1023u) | lane16; W[u] = *(const GAS v4u*)(ubase + off_); } } while (0)
#endif
#define PU_COMP(W, LST, XLO, XHI, N, T, K0) do { float d[8]; \
            _Pragma("unroll") for (int u = 0; u < 8; ++u) { f32x4 acc = {0.f, 0.f, 0.f, 0.f}; \
                acc = __builtin_amdgcn_mfma_f32_16x16x32_fp8_fp8((long)(((unsigned long long)W[u].y << 32) | W[u].x), XLO, acc, 0, 0, 0); \
                acc = __builtin_amdgcn_mfma_f32_16x16x32_fp8_fp8((long)(((unsigned long long)W[u].w << 32) | W[u].z), XHI, acc, 0, 0, 0); \
                const float v01 = (dsel & 1) ? acc[1] : acc[0], v23 = (dsel & 1) ? acc[3] : acc[2]; \
                d[u] = diag ? ((dsel & 2) ? v23 : v01) : 0.f; } \
            float z_[4], w_[2]; \
            _Pragma("unroll") for (int i = 0; i < 4; ++i) { const auto rr = __builtin_amdgcn_permlane32_swap(__float_as_uint(d[i]), __float_as_uint(d[i + 4]), false, false); z_[i] = __uint_as_float(rr[0]) + __uint_as_float(rr[1]); } \
            _Pragma("unroll") for (int i = 0; i < 2; ++i) { const auto rr = __builtin_amdgcn_permlane16_swap(__float_as_uint(z_[i]), __float_as_uint(z_[i + 2]), false, false); w_[i] = __uint_as_float(rr[0]) + __uint_as_float(rr[1]); } \
            float du = (b3 ? w_[1] : w_[0]) + __builtin_bit_cast(float, __builtin_amdgcn_update_dpp(0, __builtin_bit_cast(int, b3 ? w_[0] : w_[1]), 0x128, 0xf, 0xf, false)); \
            du += __builtin_bit_cast(float, __builtin_amdgcn_update_dpp(0, __builtin_bit_cast(int, du), 0xB1, 0xf, 0xf, false)); \
            du += __builtin_bit_cast(float, __builtin_amdgcn_update_dpp(0, __builtin_bit_cast(int, du), 0x4E, 0xf, 0xf, false)); \
            du += __builtin_bit_cast(float, __builtin_amdgcn_update_dpp(0, __builtin_bit_cast(int, du), 0x141, 0xf, 0xf, false)); \
            const int ku = (K0) + usel; \
            if ((lane & 7) == 0 && ku < N) { const int slot = LST[ku] & 255; a.coef[(size_t)(T) * P_E + slot] = ((LAS float*)(LST + 256))[ku] * gelu_as(du * ((LAS float*)(LST + 128))[ku]); } } while (0)
    Raw rA, rB;
    const int npair = (ntok + 1) >> 1;
#define PU_TOK(i) ((i) < ntok ? tfirst + (i) * step : TOK)
    int p = wg_grab(cnt, lane);
    if (p >= npair) return;
    PU_RAW(rA, PU_TOK(2 * p)); PU_RAW(rB, PU_TOK(2 * p + 1));
    while (p < npair) {
        const int pn = wg_grab(cnt, lane);
        const int tA = PU_TOK(2 * p), tB = PU_TOK(2 * p + 1); const bool vB = tB < TOK;
        long xloA, xhiA, xloB, xhiB; int nA, nB;
        PU_PREP(rA, lstA, xloA, xhiA, nA, true);
        PU_PREP(rB, lstB, xloB, xhiB, nB, vB);
        LDS_WAIT(); asm volatile("" ::: "memory");
        v4u wA0[8], wA1[8], wB0[8], wB1[8];
        PU_LOAD(wA0, lstA, 0); PU_LOAD(wB0, lstB, 0); PU_LOAD(wA1, lstA, 8); PU_LOAD(wB1, lstB, 8);
        PU_RAW(rA, PU_TOK(2 * pn)); PU_RAW(rB, PU_TOK(2 * pn + 1));
        PU_COMP(wA0, lstA, xloA, xhiA, nA, tA, 0);
        if (nA > 16) PU_LOAD(wA0, lstA, 16);
        PU_COMP(wB0, lstB, xloB, xhiB, nB, tB, 0);
        if (nB > 16) PU_LOAD(wB0, lstB, 16);
        PU_COMP(wA1, lstA, xloA, xhiA, nA, tA, 8);
        PU_COMP(wB1, lstB, xloB, xhiB, nB, tB, 8);
        if (nA > 16) PU_COMP(wA0, lstA, xloA, xhiA, nA, tA, 16);
        if (nB > 16) PU_COMP(wB0, lstB, xloB, xhiB, nB, tB, 16);
        for (int k0 = 24; k0 < nA; k0 += 8) { PU_LOAD(wA1, lstA, k0); PU_COMP(wA1, lstA, xloA, xhiA, nA, tA, k0); }
        for (int k0 = 24; k0 < nB; k0 += 8) { PU_LOAD(wB1, lstB, k0); PU_COMP(wB1, lstB, xloB, xhiB, nB, tB, k0); }
        LDS_WAIT(); asm volatile("" ::: "memory");
        p = pn;
    }
#undef PU_TOK
#undef PU_RAW
#undef PU_PREP
#undef PU_LOAD
#undef PU_COMP
}
struct ExpB { float* xio; const bf16* x1b; const unsigned char* vb8; const int* eidx; const float* coef; float* ss2; };
__device__ __forceinline__ void peer_v_phase(Frame& F, const ExpB& a, const int s, const int t0, const int step, const int ntok, LAS int* cnt) {
    const int lane = F.lane, g = lane >> 3, j = lane & 7;
    const GAS unsigned char* vs = (const GAS unsigned char*)a.vb8 + (size_t)s * ((size_t)N_EXP * 128); const unsigned j16 = 16u * (unsigned)j;
    if (ntok <= 0) return;
    typedef float f32x2h __attribute__((ext_vector_type(2)));
    const int xoff = 128 * s + 16 * j + ((lane >> 5) & 1) * 8 + ((lane >> 4) & 1) * 4 + ((lane >> 3) & 1) * 2;
#if defined(ABL_NOCVT)
#define PV_CVT(w, hi_) ((f32x2_t){__uint_as_float(((w) & 0x007fffffu) | 0x3c000000u), __uint_as_float((((w) >> 7) & 0x007fffffu) | ((hi_) ? 0x3b800000u : 0x3c000000u))})
#else
#define PV_CVT(w, hi_) __builtin_amdgcn_cvt_pk_f32_fp8((int)(w), hi_)
#endif
#if defined(ABL_HOTV)
#define ABL_VROW(e) ((e) & 63)
#else
#define ABL_VROW(e) (e)
#endif
#define PV_LDE(E, T) do { const int tt_ = (T) < TOK ? (T) : t0; const GAS v4u* ep_ = (const GAS v4u*)(a.eidx + (size_t)tt_ * P_E + 16 * g); \
        _Pragma("unroll") for (int k4 = 0; k4 < 4; ++k4) { const v4u ev = ep_[k4]; E[4 * k4] = (int)ev.x; E[4 * k4 + 1] = (int)ev.y; E[4 * k4 + 2] = (int)ev.z; E[4 * k4 + 3] = (int)ev.w; } } while (0)
#define PV_ROWS(W, E, C, XO, T) do { const int tt_ = (T) < TOK ? (T) : t0; _Pragma("unroll") for (int k = 0; k < 16; ++k) W[k] = *(const GAS v4u*)(vs + (((unsigned)ABL_VROW(E[k]) << 7) | j16)); \
        const GAS f32x4* cp_ = (const GAS f32x4*)(a.coef + (size_t)tt_ * P_E + 16 * g); \
        _Pragma("unroll") for (int k4 = 0; k4 < 4; ++k4) { const f32x4 cv = cp_[k4]; C[4 * k4] = cv.x; C[4 * k4 + 1] = cv.y; C[4 * k4 + 2] = cv.z; C[4 * k4 + 3] = cv.w; } \
        { const unsigned xu_ = *(const GAS unsigned*)(a.x1b + (size_t)tt_ * 1024 + xoff); XO = (f32x2h){bflo(xu_), bfhi(xu_)}; } } while (0)
#define PV_COMP(W, C, XO, T) do { float y[16]; f32x2_t y2[8]; \
        _Pragma("unroll") for (int i = 0; i < 8; ++i) y2[i] = (f32x2_t){0.f, 0.f}; \
        _Pragma("unroll") for (int k = 0; k < 16; ++k) { const unsigned ww[4] = {W[k].x, W[k].y, W[k].z, W[k].w}; const f32x2_t cc = {C[k], C[k]}; \
            _Pragma("unroll") for (int q = 0; q < 4; ++q) { const f32x2_t lo = PV_CVT(ww[q], false), hi = PV_CVT(ww[q], true); \
                y2[2 * q] = __builtin_elementwise_fma(cc, lo, y2[2 * q]); y2[2 * q + 1] = __builtin_elementwise_fma(cc, hi, y2[2 * q + 1]); } } \
        _Pragma("unroll") for (int i = 0; i < 8; ++i) { y[2 * i] = y2[i].x; y[2 * i + 1] = y2[i].y; } \
        float z[8], wv[4], f0, f1; \
        _Pragma("unroll") for (int i = 0; i < 8; ++i) { const auto rr = __builtin_amdgcn_permlane32_swap(__float_as_uint(y[i]), __float_as_uint(y[i + 8]), false, false); z[i] = __uint_as_float(rr[0]) + __uint_as_float(rr[1]); } \
        _Pragma("unroll") for (int i = 0; i < 4; ++i) { const auto rr = __builtin_amdgcn_permlane16_swap(__float_as_uint(z[i]), __float_as_uint(z[i + 4]), false, false); wv[i] = __uint_as_float(rr[0]) + __uint_as_float(rr[1]); } \
        { const bool b3 = (lane & 8) != 0; \
          const float k0_ = b3 ? wv[2] : wv[0], k1_ = b3 ? wv[3] : wv[1], s0_ = b3 ? wv[0] : wv[2], s1_ = b3 ? wv[1] : wv[3]; \
          f0 = k0_ + __builtin_bit_cast(float, __builtin_amdgcn_update_dpp(0, __builtin_bit_cast(int, s0_), 0x128, 0xf, 0xf, false)); \
          f1 = k1_ + __builtin_bit_cast(float, __builtin_amdgcn_update_dpp(0, __builtin_bit_cast(int, s1_), 0x128, 0xf, 0xf, false)); } \
        const f32x2h o = XO + (f32x2h){f0, f1}; \
        *(GAS f32x2h*)(a.xio + (size_t)(T) * 1024 + xoff) = o; \
        float sq = row_sum16(o.x * o.x + o.y * o.y); \
        sq += __shfl_xor(sq, 16); sq += __shfl_xor(sq, 32); \
        if (lane == 0) a.ss2[(size_t)(T) * 8 + s] = sq; } while (0)
    int e1[16], e2[16]; float cA[16], cB[16]; v4u wA[16], wB[16]; f32x2h xoA, xoB;
#define PV_TOK(i) ((i) < ntok ? t0 + (i) * step : TOK)
    int iA = wg_grab(cnt, lane), iB = wg_grab(cnt, lane);
    if (iA >= ntok) return;
    PV_LDE(e1, PV_TOK(iA));
    PV_LDE(e2, PV_TOK(iB));
    PV_ROWS(wA, e1, cA, xoA, PV_TOK(iA));
    for (;;) {
        const int iC = wg_grab(cnt, lane);
        PV_LDE(e1, PV_TOK(iC));
        PV_ROWS(wB, e2, cB, xoB, PV_TOK(iB));
        PV_COMP(wA, cA, xoA, PV_TOK(iA));
        if (iB >= ntok) break;
        const int iD = wg_grab(cnt, lane);
        PV_LDE(e2, PV_TOK(iD));
        PV_ROWS(wA, e1, cA, xoA, PV_TOK(iC));
        PV_COMP(wB, cB, xoB, PV_TOK(iB));
        if (iC >= ntok) break;
        iA = iC; iB = iD;
    }
#undef PV_TOK
#undef PV_LDE
#undef PV_ROWS
#undef PV_COMP
}
__device__ __forceinline__ void final_norm_phase(Frame& F, float* xio, const float* ss2, const float* gfinal, const int tfirst, const int tend, const int step) {
    const int lane = F.lane;
    for (int t = tfirst; t < tend; t += step) {
        const GAS f32x4* sp = (const GAS f32x4*)(ss2 + (size_t)t * 8); const f32x4 s0 = sp[0], s1 = sp[1];
        const float rstd = 1.f / sqrtf(((s0.x + s0.y) + (s0.z + s0.w) + (s1.x + s1.y) + (s1.z + s1.w)) * (1.f / 1024.f) + NORM_EPS);
        GAS f32x4* xr = (GAS f32x4*)(xio + (size_t)t * 1024) + lane; const GAS f32x4* gf = (const GAS f32x4*)gfinal + lane;
#pragma unroll
        for (int q = 0; q < 4; ++q) xr[64 * q] = xr[64 * q] * rstd * gf[64 * q];
    }
}

struct Args { const float* in[18]; float* out; unsigned char* ws; int ph_lo, ph_hi, li, pad; };
__global__ void __launch_bounds__(NWAVES * 64, 2) fwd_kernel(Args args) {
    extern __shared__ __attribute__((aligned(16))) unsigned char lds[];
    Frame F;
    F.lds = (LAS unsigned char*)lds;
    F.MISC = (volatile LAS unsigned*)(F.lds + MISC_OFF);
    F.tid = threadIdx.x; F.lane = F.tid & 63; F.wave = __builtin_amdgcn_readfirstlane(F.tid >> 6);
    F.G = gridDim.x; { const int bx = blockIdx.x; F.vcu = (F.G % 8 == 0) ? (bx % 8) * (F.G / 8) + bx / 8 : bx; }
    unsigned char* ws = args.ws;
    F.ctl = (gu32*)(ws + WS_CTL);
#define GRID_BAR(seam) do { if (N_LAUNCHES == PER_PHASE) { if (F.tid == 0) __hip_atomic_store(F.ctl + CW_TMO, 0xBADBA0u | (unsigned)(seam), RLX_AGENT); } else { xcd_barrier(bar); } } while (0)
    const float* x = args.in[0];
    bf16* H = (bf16*)(ws + WS_H); bf16* Win = (bf16*)(ws + WS_WIN); bf16* Wpw = (bf16*)(ws + WS_WPW); bf16* Wao = (bf16*)(ws + WS_WAO); bf16* Wout = (bf16*)(ws + WS_WOUT); bf16* Wq = (bf16*)(ws + WS_WQ);
    bf16* KEYS = (bf16*)(ws + WS_KEYS); unsigned char* UB = ws + WS_UB; unsigned char* VB = ws + WS_VB; float* USC = (float*)(ws + WS_USC); float* VSC = (float*)(ws + WS_VSC);
    bf16* ZGLU = (bf16*)(ws + WS_ZGLU); bf16* QO = (bf16*)(ws + WS_QO); bf16* KB = (bf16*)(ws + WS_K); bf16* VBUF = (bf16*)(ws + WS_V); bf16* GC = (bf16*)(ws + WS_GC); bf16* GA = (bf16*)(ws + WS_GATE_A);
    bf16* CACT = (bf16*)(ws + WS_CACT); bf16* MIX = (bf16*)(ws + WS_MIX); bf16* X1B = (bf16*)(ws + WS_X1B); bf16* QP = (bf16*)(ws + WS_QP);
    float* KMEAN = (float*)(ws + WS_KMEAN); float* SS = (float*)(ws + WS_SS); int* EIDX = (int*)(ws + WS_EIDX); float* GW = (float*)(ws + WS_GW);
    for (int u = F.tid; u < (LDS_BYTES - LDSCTL_OFF) / 4; u += NWAVES * 64) ((LAS unsigned*)(F.lds + LDSCTL_OFF))[u] = 0u;
    __syncthreads();
    XcdBarrier bar; bar.bar = (unsigned*)(F.ctl + CW_BAR); bar.x = 0; bar.st = nullptr;
    if (N_LAUNCHES != PER_PHASE) bar = xcd_barrier_post((unsigned*)(F.ctl + CW_BAR), F.MISC + 8);
    const int lo = args.ph_lo, hi = args.ph_hi;
#ifdef TIME_PHASE
    unsigned long long ts_[PER_PHASE + 1]; ts_[0] = __builtin_amdgcn_s_memrealtime();
#define STAMP(k) ts_[(k) + 1] = __builtin_amdgcn_s_memrealtime()
#else
#define STAMP(k) do {} while (0)
#endif
#ifndef PHASE_MASK
#define PHASE_MASK 0xf
#endif
#define IN(k) (((PHASE_MASK >> (k)) & 1) && lo <= (k) && (k) < hi)
#define BOTH(k) (IN(k) && IN((k) + 1))

    if (IN(0)) {
        P0Args a{x, args.in[1], args.in[2], args.in[7], args.in[9], args.in[10], args.in[11], args.in[12], args.in[13], args.in[14], args.in[15], args.in[16], H, Win, Wpw, Wao, Wout, Wq, KEYS, UB, VB, USC, VSC};
        p0_prologue(F, a);
        if (BOTH(0)) GRID_BAR(0);
        STAMP(0);
    }
#ifdef DEBUG_P1_PLAIN
    if (IN(1)) {
        pg8::Gemm g{H, Wq, TOK, 2048, 1024}; pg8::StaticOrder S; S.init(TOK, 2048, F.G, (int)blockIdx.x);
        pg8::EpiStore E{QP, 2048};
        pg8::gemm_phase<pg8::EpiStore, pg8::StaticOrder, true, true>(F.lds + RING_OFF, g, S, E);
    }
#else
    if (IN(1)) {
        pg8::Gemm g{H, Win, TOK, IN_COLS, 1024}; pg8::StaticOrder S; S.init(TOK, IN_COLS, F.G, (int)blockIdx.x);
        pg8::EpiIn E{ZGLU, QO, GC, KMEAN, attn_body::C2, (size_t)(WS_K - WS_QO) / 2, (size_t)(WS_GATE_A - WS_GC) / 2};
        static_assert(WS_V - WS_K == WS_K - WS_QO, "Q|K|V equally spaced");
        pg8::gemm_phase<pg8::EpiIn, pg8::StaticOrder, true, true>(F.lds + RING_OFF, g, S, E);
        if (BOTH(1)) GRID_BAR(1);
        STAMP(1);
    }
#endif
    if (IN(2)) {
        static_assert(attn_body::ATTN_LDS_BYTES <= RING_BYTES && attn_body::ATTN_PITCH == ATT_W, "attention body geometry vs frame");
#ifdef CONV_FIRST
        { const ConvArgs ca{ZGLU, args.in[3], args.in[4], args.in[5], args.in[6], CACT};
          conv_phase(F, ca); }
        __syncthreads();
#ifdef TIME_SPLIT2
        ts_[3] = __builtin_amdgcn_s_memrealtime();
#endif
#endif
        const attn_body::AttnTensors AT{(const attn_body::bf16*)QO, (const attn_body::bf16*)KB, (const attn_body::bf16*)VBUF, (attn_body::bf16*)(CACT + 512), KMEAN};
        const attn_body::StaticOrder S((int)F.G, (int)blockIdx.x);
        attn_body::attn_phase<attn_body::StaticOrder>((char*)lds + RING_OFF, AT, S);
        __syncthreads();
#ifndef CONV_FIRST
        { const ConvArgs ca{ZGLU, args.in[3], args.in[4], args.in[5], args.in[6], CACT};
          conv_phase(F, ca); }
#endif
        if (BOTH(2)) GRID_BAR(2);
#if !(defined(TIME_SPLIT2) && defined(CONV_FIRST))
        STAMP(2);
#endif
    }
    if (IN(3)) {
        const int npair = F.G >> 1, pair = F.vcu >> 1, j = F.vcu & 1;
        gu32* pf = F.ctl + CW_PAIR; unsigned epoch = 0;
        static_assert(TOK / 256 == 128, "one row block per workgroup pair");
        int rb = pair, jj = j;
#define OPAQUE_RB() asm volatile("" : "+s"(rb), "+s"(jj))
        if (npair == TOK / 256) {
#ifdef TIME_SEG
            unsigned long long sg_[8];
#define SEG(k) sg_[k] = __builtin_amdgcn_s_memrealtime()
#else
#define SEG(k) do {} while (0)
#endif
            SEG(0);
            OPAQUE_RB();
            { pg8::Gemm g{CACT, Wpw, TOK, 1024, 1024}; const pg8::PairOrder S{rb, 2 * jj, 2};
              pg8::EpiMixF E{GC, GA, args.in[8], MIX};
              pg8::gemm_phase<pg8::EpiMixF, pg8::PairOrder, true, true>(F.lds + RING_OFF, g, S, E); }
            pair_sync(F, pf, ++epoch);
            OPAQUE_RB();
            { pg8::Gemm g{MIX, Wout, TOK, 1024, 1024}; const pg8::PairOrder S{rb, 2 * jj, 2};
              pg8::EpiX1 E{x, args.out, X1B, SS};
              pg8::gemm_phase<pg8::EpiX1, pg8::PairOrder, true, true>(F.lds + RING_OFF, g, S, E); }
            pair_sync(F, pf, ++epoch);
            SEG(1);
            OPAQUE_RB();
            { pg8::Gemm g{X1B, Wq, TOK, 2048, 1024}; const pg8::PairOrder S{rb, 4 * jj, 4};
              pg8::EpiStore E{QP, 2048};
              pg8::gemm_phase<pg8::EpiStore, pg8::PairOrder, true, true>(F.lds + RING_OFF, g, S, E); }
            VM_WAIT(); __syncthreads();
            OPAQUE_RB();
            const int t0 = rb * 256 + 128 * jj;
            { const SelArgs sa{QP, KEYS, SS, USC, VSC, EIDX, (float*)(ws + WS_GA), GW, X1B, ws + WS_X8, (float*)(ws + WS_XS)};
              Frame Fs = F; asm volatile("" : "+v"(Fs.tid), "+v"(Fs.lane));
              peer_select_phase(Fs, sa, rb, 4 * jj, 4);
              peer_rows_fp8(Fs, sa, t0, 128); }
#ifdef X_GRIDBAR_P7
            GRID_BAR(6);
#else
            pair_sync(F, pf, ++epoch);
#endif
            SEG(2);
            OPAQUE_RB();
            LAS int* cnt = (LAS int*)(F.lds + RING_OFF + 32768);
            Frame Fe = F; asm volatile("" : "+v"(Fe.tid), "+v"(Fe.lane));
            if (Fe.tid < 16) cnt[Fe.tid] = 0;
            __syncthreads();
            const ExpA ea{ws + WS_X8, (const float*)(ws + WS_XS), UB, EIDX, (const float*)(ws + WS_GA), GW, (float*)(ws + WS_COEF)};
            for (int s = 0; s < 8; ++s) peer_u_phase(Fe, ea, s, t0, 1, 128, cnt + s);
            VM_WAIT(); __syncthreads();
            SEG(3);
            const ExpB eb{args.out, X1B, VB, EIDX, (const float*)(ws + WS_COEF), (float*)(ws + WS_SS2)};
            for (int s = 0; s < 8; ++s) peer_v_phase(Fe, eb, s, t0, 1, 128, cnt + 8 + s);
            VM_WAIT(); __syncthreads();
            SEG(4);
            final_norm_phase(Fe, args.out, (const float*)(ws + WS_SS2), args.in[17], t0 + Fe.wave, t0 + 128, NWAVES);
            __syncthreads();
            SEG(5);
#ifdef TIME_SEG
            if (blockIdx.x == TIME_SEG_BLOCK && F.tid == 0) { VM_WAIT(); args.out[0] = (float)(sg_[TIME_SEG + 1] - sg_[TIME_SEG]) * (0.01f / TIME_UNIT_US); }
#endif
        }
        STAMP(3);
#ifdef TIME_P3_SPREAD
        __syncthreads();
        ts_[4] = __builtin_amdgcn_s_memrealtime();
        if (F.tid == 0) { __hip_atomic_fetch_max((unsigned long long*)(ws + 800), ts_[4] - ts_[3], __ATOMIC_RELAXED, __HIP_MEMORY_SCOPE_AGENT); __hip_atomic_fetch_add((unsigned*)(ws + 840), 1u, __ATOMIC_RELAXED, __HIP_MEMORY_SCOPE_AGENT); }
        if (blockIdx.x == 0 && F.tid == 0) { while (__hip_atomic_load((unsigned*)(ws + 840), __ATOMIC_RELAXED, __HIP_MEMORY_SCOPE_AGENT) < gridDim.x) __builtin_amdgcn_s_sleep(8);
            ts_[4] = ts_[3] + __hip_atomic_load((unsigned long long*)(ws + 800), __ATOMIC_RELAXED, __HIP_MEMORY_SCOPE_AGENT); }
#endif
#ifdef TIME_PHASE
#ifdef TIME_TOTAL
        if (blockIdx.x == 0 && F.tid == 0) { VM_WAIT(); args.out[0] = (float)(ts_[PER_PHASE] - ts_[0]) * (0.01f / TIME_UNIT_US); }
#else
        if (blockIdx.x == 0 && F.tid == 0) { VM_WAIT(); args.out[0] = (float)(ts_[TIME_PHASE + 1] - ts_[TIME_PHASE]) * (0.01f / TIME_UNIT_US); }
#endif
#endif
    }
#undef IN
#undef BOTH
}

#ifdef DEBUG_DUMP
__global__ void dump_kernel(const unsigned char* ws, float* out, float wsmib) {
    const size_t i = (size_t)blockIdx.x * 256 + threadIdx.x; if (i >= (size_t)TOK * 1024) return;
    const size_t t = i >> 10, c = i & 1023; float v = 0.f;
    auto B = [&](size_t off, size_t idx) { return bflo((unsigned)((const bf16*)(ws + off))[idx]); };
#if DEBUG_DUMP == 0
    v = B(WS_H, i) + B(WS_WIN, i % (4608u * 1024u)) + B(WS_WPW, i % (512u * 1024u)) + B(WS_WAO, i % (512u * 1024u)) + B(WS_WOUT, i % (1024u * 1024u)) + B(WS_WQ, i % (2048u * 1024u)) + B(WS_KEYS, i % 32768u) + B(WS_UB, i % (16384u * 1024u)) + B(WS_VB, i % (16384u * 1024u));
#elif DEBUG_DUMP == 1
    v = B(WS_ZGLU, t * 512 + (c & 511)) + 2.f * B(WS_QO, t * 512 + (c & 511)) + 3.f * B(WS_K, t * 512 + (c & 511)) + 4.f * B(WS_V, t * 512 + (c & 511)) + 5.f * B(WS_GC, i) + 6.f * B(WS_GATE_A, i) + ((const float*)(ws + WS_KMEAN))[(t >> 8) * 1024 + (c & 1023)];
#elif DEBUG_DUMP == 2
    v = B(WS_QO, t * 512 + (c & 511)) + 2.f * B(WS_CACT, t * 512 + (c & 511));
#elif DEBUG_DUMP == 20
    v = B(WS_QO, t * 512 + (c & 511));
#elif DEBUG_DUMP == 21
    v = B(WS_CACT, t * 512 + (c & 511));
#elif DEBUG_DUMP == 3
    v = B(WS_MIX, i);
#elif DEBUG_DUMP == 5
    v = B(WS_QP, t * 2048 + c) + 2.f * B(WS_QP, t * 2048 + 1024 + c);
#elif DEBUG_DUMP == 10
    v = B(WS_ZGLU, t * 512 + (c & 511));
#elif DEBUG_DUMP == 11
    v = 2.f * B(WS_QO, t * 512 + (c & 511)) + 3.f * B(WS_K, t * 512 + (c & 511)) + 4.f * B(WS_V, t * 512 + (c & 511));
#elif DEBUG_DUMP == 12
    v = 5.f * B(WS_GC, i) + 6.f * B(WS_GATE_A, i);
#elif DEBUG_DUMP == 13
    v = ((const float*)(ws + WS_KMEAN))[(t >> 8) * 1024 + (c & 1023)];
#elif DEBUG_DUMP == 98
    v = wsmib;
#elif DEBUG_DUMP == 99
    v = 1.0f + (float)(c & 7);
#endif
    out[i] = v;
}
#endif
extern "C" void kernel_launch(void* const* d_in, const int* in_sizes, int n_in, void* d_out, int out_size, void* d_ws, size_t ws_size, hipStream_t stream) {
    static int grid = 0;
    if (grid == 0) {
        if (n_in != 18 || in_sizes[0] != TOK * DM || out_size != TOK * DM || ws_size < WS_END) { fprintf(stderr, "kernel_launch: unexpected shapes (n_in %d, in0 %d, out %d, ws %zu); nothing launched\n", n_in, n_in > 0 ? in_sizes[0] : -1, out_size, ws_size); grid = -1; return; }
        int dev = 0, cus = 0, per_cu = 0;
        if (hipGetDevice(&dev) != hipSuccess || hipDeviceGetAttribute(&cus, hipDeviceAttributeMultiprocessorCount, dev) != hipSuccess) { grid = -1; return; }
        if (hipFuncSetAttribute((const void*)fwd_kernel, hipFuncAttributeMaxDynamicSharedMemorySize, LDS_BYTES) != hipSuccess) { fprintf(stderr, "kernel_launch: hipFuncSetAttribute failed\n"); grid = -1; return; }
        if (hipOccupancyMaxActiveBlocksPerMultiprocessor(&per_cu, (const void*)fwd_kernel, NWAVES * 64, LDS_BYTES) != hipSuccess || per_cu < 1) fprintf(stderr, "kernel_launch: occupancy query reports %d\n", per_cu);
        (void)hipGetLastError();
        grid = cus;
    }
    if (grid < 0) return;
    (void)hipMemsetAsync((char*)d_ws + WS_CTL, 0, CTL_ZERO_BYTES, stream);
    Args a{};
    for (int i = 0; i < 18; ++i) a.in[i] = (const float*)d_in[i];
    a.out = (float*)d_out; a.ws = (unsigned char*)d_ws;
#ifndef NPH_RUN
#define NPH_RUN N_LAUNCHES
#endif
    for (int li = 0; li < NPH_RUN; ++li) {
        a.ph_lo = (N_LAUNCHES == PER_PHASE) ? li : 0; a.ph_hi = (N_LAUNCHES == PER_PHASE) ? li + 1 : PER_PHASE; a.li = li;
        hipLaunchKernelGGL(fwd_kernel, dim3(grid), dim3(NWAVES * 64), LDS_BYTES, stream, a);
    }
#ifdef DEBUG_DUMP
    hipLaunchKernelGGL(dump_kernel, dim3(TOK * 1024 / 256), dim3(256), 0, stream, (const unsigned char*)d_ws, (float*)d_out, (float)(ws_size >> 20));
#endif
}
```

```cpp
#define MK_N_LAUNCHES 1
#ifndef PG8_EPI_DRAIN
#define PG8_EPI_DRAIN 0
#endif
#include <hip/hip_runtime.h>
#include <hip/hip_bf16.h>
#include <cstdio>
#include <cstdint>
#include <cmath>
namespace pg8 {
#define PG8_LAS __attribute__((address_space(3)))
typedef unsigned short bf16_t;
typedef short bf16x8 __attribute__((ext_vector_type(8)));
typedef float f32x4 __attribute__((ext_vector_type(4)));
typedef unsigned u32x4 __attribute__((ext_vector_type(4)));
constexpr int BM = 256, BK = 64, HALF = 128, HTB = HALF * BK * 2  , STAGE_BYTES = 8 * HTB, NXCD = 8, WGM = 8;

__host__ __device__ __forceinline__ int lds_byte(int r, int c) { const int st = (r >> 4) * 2 + (c >> 5), rr = r & 15, cc = c & 31, ob = rr * 64 + cc * 2; return st * 1024 + (ob ^ (((ob >> 9) & 1) << 5)); }
__host__ __device__ __forceinline__ void stage_rc(int b, int& R, int& C) { const int st = b / 1024, sb = b % 1024, swz = sb ^ (((sb >> 9) & 1) << 5); R = (st >> 1) * 16 + swz / 64; C = (st & 1) * 32 + (swz % 64) / 2; }
__host__ __device__ __forceinline__ int perm32(int rho) { const int n = rho >> 4, i = rho & 15; return 8 * (i >> 2) + 4 * n + (i & 3); }

struct Unit { int pm, pn; };
struct Gemm { const bf16_t* A; const bf16_t* Bt; int M, N, K; };

struct StaticOrder {
    int nM, nN, nwg, G, c;
    __host__ __device__ void init(int M, int N, int G_, int c_) { nM = M / BM; nN = N / BM; nwg = nM * nN; G = G_; c = c_; }
    __host__ __device__ bool next(int i, Unit& u) const {
        const long L = (long)i * G + c; if (L >= nwg) return false;
        int wgid = (int)L; { const int q = nwg / NXCD, r = nwg % NXCD, xcd = wgid % NXCD, off = wgid / NXCD; wgid = (xcd < r ? xcd * (q + 1) : r * (q + 1) + (xcd - r) * q) + off; }
        const int nig = WGM * nN, gid = wgid / nig, fm = gid * WGM, gsz = (nM - fm) < WGM ? (nM - fm) : WGM;
        u.pm = fm + ((wgid % nig) % gsz); u.pn = (wgid % nig) / gsz; return true;
    }
    __device__ __forceinline__ void a_ready(const Unit&) const {}
    __device__ __forceinline__ void done(const Unit&) const {}
};

typedef float f32x2c_t __attribute__((ext_vector_type(2))); typedef __bf16 bf16x2c_t __attribute__((ext_vector_type(2)));
__device__ __forceinline__ unsigned cvt_pk_bf16(float lo, float hi) { const f32x2c_t v = {lo, hi}; const bf16x2c_t b = __builtin_convertvector(v, bf16x2c_t); return __builtin_bit_cast(unsigned, b); }
typedef float f32x2 __attribute__((ext_vector_type(2)));
__device__ __forceinline__ float sigm(float v) { return __builtin_amdgcn_rcpf(1.0f + __builtin_amdgcn_exp2f(-1.4426950408889634f * v)); }
__device__ __forceinline__ float bf_lo(unsigned u) { return __uint_as_float(u << 16); }
__device__ __forceinline__ float bf_hi(unsigned u) { return __uint_as_float(u & 0xffff0000u); }
__device__ __forceinline__ u32x4 pack8(const f32x4 a, const f32x4 b) { u32x4 w; w.x = cvt_pk_bf16(a[0], a[1]); w.y = cvt_pk_bf16(a[2], a[3]); w.z = cvt_pk_bf16(b[0], b[1]); w.w = cvt_pk_bf16(b[2], b[3]); return w; }
__device__ __forceinline__ void unpack8(const u32x4 w, f32x4& a, f32x4& b) { a = (f32x4){bf_lo(w.x), bf_hi(w.x), bf_lo(w.y), bf_hi(w.y)}; b = (f32x4){bf_lo(w.z), bf_hi(w.z), bf_lo(w.w), bf_hi(w.w)}; }

#ifndef PG8_WT
#define PG8_WT 1
#endif
__device__ __forceinline__ __amdgpu_buffer_rsrc_t wt_rsrc(const void* p) { return __builtin_amdgcn_make_buffer_rsrc((void*)p, 0, 0x7fffffff, 0x00020000); }
__device__ __forceinline__ void st16(bf16_t* base, const __amdgpu_buffer_rsrc_t r, size_t elem_off, const u32x4 v) {
#if PG8_WT
    __builtin_amdgcn_raw_buffer_store_b128(v, r, (unsigned)(elem_off * 2), 0, 16);
#else
    *(u32x4*)(base + elem_off) = v;
#endif
}
struct EpiIn {
    static constexpr bool PERM = true, AFTER_DRAIN = false, HAS_MID = false;
    bf16_t *zglu, *Q, *gc; float* kmean; float qscale; size_t qkv_stride, gate_stride;
    __device__ __forceinline__ void operator()(const f32x4 (&acc)[2][2][4][2], const Unit& u, int wr, int wc, int fr, int fq) const {
        const int row0 = u.pm * BM + wr * 64 + fr, cw = wc * 32 + 8 * fq, pn = u.pn;
        const __amdgpu_buffer_rsrc_t rz = wt_rsrc(zglu), rq = wt_rsrc(Q), rg = wt_rsrc(gc);
        if (pn < 4) {
#pragma unroll
            for (int ai = 0; ai < 2; ++ai)
#pragma unroll
                for (int m = 0; m < 4; ++m) { const size_t row = (size_t)(row0 + ai * HALF + m * 16);
                    f32x4 z0, z1;
#pragma unroll
                    for (int j = 0; j < 4; ++j) { z0[j] = acc[ai][0][m][0][j] * sigm(acc[ai][1][m][0][j]); z1[j] = acc[ai][0][m][1][j] * sigm(acc[ai][1][m][1][j]); }
                    st16(zglu, rz, row * 512 + pn * 128 + cw, pack8(z0, z1)); }
        } else if (pn < 10) {
            const size_t boff = (size_t)((pn - 4) >> 1) * qkv_stride; const int ct = (pn & 1) * 256; const float sc = pn < 6 ? qscale : 1.0f;
#pragma unroll
            for (int ai = 0; ai < 2; ++ai)
#pragma unroll
                for (int m = 0; m < 4; ++m) { const size_t row = (size_t)(row0 + ai * HALF + m * 16);
#pragma unroll
                    for (int bj = 0; bj < 2; ++bj) st16(Q, rq, boff + row * 512 + ct + bj * HALF + cw, pack8(acc[ai][bj][m][0] * sc, acc[ai][bj][m][1] * sc)); }
            if (pn == 6 || pn == 7) {
#pragma unroll
                for (int bj = 0; bj < 2; ++bj)
#pragma unroll
                    for (int n = 0; n < 2; ++n)
#pragma unroll
                        for (int j = 0; j < 4; ++j) { float s = 0.f;
#pragma unroll
                            for (int ai = 0; ai < 2; ++ai)
#pragma unroll
                                for (int m = 0; m < 4; ++m) s += acc[ai][bj][m][n][j];
                            s += __shfl_xor(s, 1); s += __shfl_xor(s, 2); s += __shfl_xor(s, 4); s += __shfl_xor(s, 8);
                            if (fr == 0) kmean[((size_t)u.pm * 2 + wr) * 512 + ct + bj * HALF + cw + 4 * n + j] = s * (1.0f / 256.0f); }
            }
        } else {
            const size_t boff = (size_t)((pn - 10) >> 2) * gate_stride; const int ct = ((pn - 10) & 3) * 256;
#pragma unroll
            for (int ai = 0; ai < 2; ++ai)
#pragma unroll
                for (int m = 0; m < 4; ++m) { const size_t row = (size_t)(row0 + ai * HALF + m * 16);
#pragma unroll
                    for (int bj = 0; bj < 2; ++bj) { f32x4 s0, s1;
#pragma unroll
                        for (int j = 0; j < 4; ++j) { s0[j] = sigm(acc[ai][bj][m][0][j]); s1[j] = sigm(acc[ai][bj][m][1][j]); }
                        st16(gc, rg, boff + row * 1024 + ct + bj * HALF + cw, pack8(s0, s1)); } }
        }
    }
};
template <bool ADD> struct EpiMix {
    static constexpr bool PERM = true, AFTER_DRAIN = false, HAS_MID = false;
    const bf16_t* gate; const float* bias; bf16_t* mix;
    __device__ __forceinline__ void operator()(const f32x4 (&acc)[2][2][4][2], const Unit& u, int wr, int wc, int fr, int fq) const {
        const int row0 = u.pm * BM + wr * 64 + fr, col0 = u.pn * BM + wc * 32 + 8 * fq;
        f32x4 b0[2], b1[2];
#pragma unroll
        for (int bj = 0; bj < 2; ++bj) { b0[bj] = (f32x4){0.f, 0.f, 0.f, 0.f}; b1[bj] = b0[bj]; if (!ADD) { b0[bj] = *(const f32x4*)(bias + col0 + bj * HALF); b1[bj] = *(const f32x4*)(bias + col0 + bj * HALF + 4); } }
#pragma unroll
        for (int ai = 0; ai < 2; ++ai) {
            u32x4 gq[4][2], mq[4][2];
#pragma unroll
            for (int m = 0; m < 4; ++m)
#pragma unroll
                for (int bj = 0; bj < 2; ++bj) { const size_t off = (size_t)(row0 + ai * HALF + m * 16) * 1024 + col0 + bj * HALF; gq[m][bj] = *(const u32x4*)(gate + off); if (ADD) mq[m][bj] = *(const u32x4*)(mix + off); }
#pragma unroll
            for (int m = 0; m < 4; ++m)
#pragma unroll
                for (int bj = 0; bj < 2; ++bj) { const size_t off = (size_t)(row0 + ai * HALF + m * 16) * 1024 + col0 + bj * HALF;
                    f32x4 g0, g1; unpack8(gq[m][bj], g0, g1);
                    f32x4 v0 = acc[ai][bj][m][0], v1 = acc[ai][bj][m][1];
                    if (!ADD) { v0 = (v0 + b0[bj]) * g0; v1 = (v1 + b1[bj]) * g1; }
                    else { f32x4 p0, p1; unpack8(mq[m][bj], p0, p1); v0 = p0 + v0 * g0; v1 = p1 + v1 * g1; }
                    *(u32x4*)(mix + off) = pack8(v0, v1); }
        }
    }
};
struct EpiMixF {
    static constexpr bool PERM = true, AFTER_DRAIN = false, HAS_MID = true;
    const bf16_t* gc; const bf16_t* ga; const float* bias; bf16_t* mix;
    __device__ __forceinline__ void mid(f32x4 (&acc)[2][2][4][2], const Unit& u, int wr, int wc, int fr, int fq) const {
        const int row0 = u.pm * BM + wr * 64 + fr, col0 = u.pn * BM + wc * 32 + 8 * fq;
#pragma unroll
        for (int ai = 0; ai < 2; ++ai)
#pragma unroll
            for (int m = 0; m < 4; ++m) { u32x4 cq[2], aq[2];
#pragma unroll
                for (int bj = 0; bj < 2; ++bj) { const size_t off = (size_t)(row0 + ai * HALF + m * 16) * 1024 + col0 + bj * HALF; cq[bj] = *(const u32x4*)(gc + off); aq[bj] = *(const u32x4*)(ga + off); }
#pragma unroll
                for (int bj = 0; bj < 2; ++bj) { f32x4 c0, c1, a0, a1; unpack8(cq[bj], c0, c1); unpack8(aq[bj], a0, a1);
                    const f32x4 b0 = *(const f32x4*)(bias + col0 + bj * HALF), b1 = *(const f32x4*)(bias + col0 + bj * HALF + 4);
#pragma unroll
                    for (int j = 0; j < 4; ++j) { acc[ai][bj][m][0][j] = (acc[ai][bj][m][0][j] + b0[j]) * c0[j] * __builtin_amdgcn_rcpf(fmaxf(a0[j], 1e-30f));
                                                  acc[ai][bj][m][1][j] = (acc[ai][bj][m][1][j] + b1[j]) * c1[j] * __builtin_amdgcn_rcpf(fmaxf(a1[j], 1e-30f)); } }
                if (m & 1) asm volatile("" ::: "memory"); }
    }
    __device__ __forceinline__ void operator()(const f32x4 (&acc)[2][2][4][2], const Unit& u, int wr, int wc, int fr, int fq) const {
        const int row0 = u.pm * BM + wr * 64 + fr, col0 = u.pn * BM + wc * 32 + 8 * fq;
        const __amdgpu_buffer_rsrc_t rm = wt_rsrc(mix);
#pragma unroll
        for (int ai = 0; ai < 2; ++ai) { u32x4 aq[4][2];
#pragma unroll
            for (int m = 0; m < 4; ++m)
#pragma unroll
                for (int bj = 0; bj < 2; ++bj) aq[m][bj] = *(const u32x4*)(ga + (size_t)(row0 + ai * HALF + m * 16) * 1024 + col0 + bj * HALF);
#pragma unroll
            for (int m = 0; m < 4; ++m)
#pragma unroll
                for (int bj = 0; bj < 2; ++bj) { f32x4 a0, a1; unpack8(aq[m][bj], a0, a1); f32x4 v0 = acc[ai][bj][m][0], v1 = acc[ai][bj][m][1];
#pragma unroll
                    for (int j = 0; j < 4; ++j) { v0[j] *= fmaxf(a0[j], 1e-30f); v1[j] *= fmaxf(a1[j], 1e-30f); }
                    st16(mix, rm, (size_t)(row0 + ai * HALF + m * 16) * 1024 + col0 + bj * HALF, pack8(v0, v1)); } }
    }
};
struct EpiX1 {
    static constexpr bool PERM = true, AFTER_DRAIN = false, HAS_MID = false;
    const float* x; float* x1; bf16_t* x1b; float* ss;
    __device__ __forceinline__ void operator()(const f32x4 (&acc)[2][2][4][2], const Unit& u, int wr, int wc, int fr, int fq) const {
        const int row0 = u.pm * BM + wr * 64 + fr, col0 = u.pn * BM + wc * 32 + 8 * fq;
        const __amdgpu_buffer_rsrc_t rx = wt_rsrc(x1b);
#pragma unroll
        for (int ai = 0; ai < 2; ++ai) {
            f32x4 xq[4][2][2];
#pragma unroll
            for (int m = 0; m < 4; ++m)
#pragma unroll
                for (int bj = 0; bj < 2; ++bj) { const size_t off = (size_t)(row0 + ai * HALF + m * 16) * 1024 + col0 + bj * HALF; xq[m][bj][0] = *(const f32x4*)(x + off); xq[m][bj][1] = *(const f32x4*)(x + off + 4); }
#pragma unroll
            for (int m = 0; m < 4; ++m) { const size_t row = (size_t)(row0 + ai * HALF + m * 16); float sq = 0.f;
#pragma unroll
                for (int bj = 0; bj < 2; ++bj) { const size_t off = row * 1024 + col0 + bj * HALF;
                    const f32x4 r0 = xq[m][bj][0] + acc[ai][bj][m][0], r1 = xq[m][bj][1] + acc[ai][bj][m][1];
                    st16(x1b, rx, off, pack8(r0, r1));
                    sq += (r0[0] * r0[0] + r0[1] * r0[1]) + (r0[2] * r0[2] + r0[3] * r0[3]) + (r1[0] * r1[0] + r1[1] * r1[1]) + (r1[2] * r1[2] + r1[3] * r1[3]); }
                sq += __shfl_xor(sq, 16); sq += __shfl_xor(sq, 32);
                if (fq == 0) ss[row * 16 + u.pn * 4 + wc] = sq; }
        }
    }
};
struct EpiStore {
    static constexpr bool PERM = true, AFTER_DRAIN = false, HAS_MID = false;
    bf16_t* O; int ldc;
    __device__ __forceinline__ void operator()(const f32x4 (&acc)[2][2][4][2], const Unit& u, int wr, int wc, int fr, int fq) const {
        const int row0 = u.pm * BM + wr * 64 + fr, col0 = u.pn * BM + wc * 32 + 8 * fq;
        const __amdgpu_buffer_rsrc_t ro = wt_rsrc(O);
#pragma unroll
        for (int ai = 0; ai < 2; ++ai)
#pragma unroll
            for (int m = 0; m < 4; ++m) { const size_t row = (size_t)(row0 + ai * HALF + m * 16);
#pragma unroll
                for (int bj = 0; bj < 2; ++bj) st16(O, ro, row * ldc + col0 + bj * HALF, pack8(acc[ai][bj][m][0], acc[ai][bj][m][1])); }
    }
};


template <class Epi, class Sched, bool ALIGN_EPI = false, bool SP2 = false>
__device__ __forceinline__ void gemm_phase(PG8_LAS unsigned char* lds, const Gemm g, const Sched& S, const Epi& E) {
    const int tid = threadIdx.x, wid = __builtin_amdgcn_readfirstlane(tid >> 6), lane = tid & 63, wr = wid >> 2, wc = wid & 3, fr = lane & 15, fq = lane >> 4;
    const int K = g.K, nt = K / BK;
    unsigned voffA[2], voffB[2];
#pragma unroll
    for (int i = 0; i < 2; ++i) { int R, C; stage_rc(tid * 16 + i * 8192, R, C); const int Rb = Epi::PERM ? ((R & ~31) + perm32(R & 31)) : R;
        voffA[i] = (unsigned)(R * K + C) * 2u; voffB[i] = (unsigned)(Rb * K + C) * 2u; }
    const size_t kstep = (size_t)(BK * 2);
    const size_t hstep = (size_t)HALF * K * 2;
    const size_t tstep = 2 * hstep;
    const unsigned ldsw = (unsigned)wid * 1024u;
    const int aoff = lds_byte(wr * 64 + fr, fq * 8), boff = lds_byte(wc * 32 + fr, fq * 8);
#define PG8_SA(b, h) (((b) * 2 + (h)) * HTB)
#define PG8_SB(b, h) ((4 + (b) * 2 + (h)) * HTB)
#define PG8_STAGE(bufoff, gbase, voff) do { _Pragma("unroll") for (int _i = 0; _i < 2; ++_i) \
        __builtin_amdgcn_global_load_lds((const unsigned*)((const char*)(gbase) + (voff)[_i]), (PG8_LAS unsigned*)(lds + (bufoff) + ldsw + _i * 8192), 16, 0, 0); } while (0)
#define PG8_LDA(dst, b, h) do { _Pragma("unroll") for (int m = 0; m < 4; ++m) _Pragma("unroll") for (int k = 0; k < 2; ++k) dst[m][k] = *(const PG8_LAS bf16x8*)(lds + PG8_SA(b, h) + aoff + m * 2048 + k * 1024); } while (0)
#define PG8_LDB(dst, b, h) do { _Pragma("unroll") for (int n = 0; n < 2; ++n) _Pragma("unroll") for (int k = 0; k < 2; ++k) dst[n][k] = *(const PG8_LAS bf16x8*)(lds + PG8_SB(b, h) + boff + n * 2048 + k * 1024); } while (0)
#define PG8_MMA(ai, bj, At, Bt) do { __builtin_amdgcn_s_setprio(1); _Pragma("unroll") for (int m = 0; m < 4; ++m) _Pragma("unroll") for (int n = 0; n < 2; ++n) _Pragma("unroll") for (int k = 0; k < 2; ++k) \
        acc[ai][bj][m][n] = __builtin_amdgcn_mfma_f32_16x16x32_bf16(Bt[n][k], At[m][k], acc[ai][bj][m][n], 0, 0, 0); __builtin_amdgcn_s_setprio(0); } while (0)
#define PG8_WAIT_V(n) asm volatile("s_waitcnt vmcnt(" #n ")" ::: "memory")
#define PG8_WAIT_L(n) asm volatile("s_waitcnt lgkmcnt(" #n ")" ::: "memory")
#define PG8_BAR __builtin_amdgcn_s_barrier()
#define PG8_SCHED __builtin_amdgcn_sched_barrier(0)
    Unit cur, nxt; int ui = 0;
    if (!S.next(0, cur)) return;
    f32x4 acc[2][2][4][2];
#pragma unroll
    for (int a = 0; a < 2; ++a)
#pragma unroll
        for (int b = 0; b < 2; ++b)
#pragma unroll
            for (int m = 0; m < 4; ++m)
#pragma unroll
                for (int n = 0; n < 2; ++n) acc[a][b][m][n] = (f32x4){0.f, 0.f, 0.f, 0.f};
    bf16x8 At[4][2], B0[2][2], B1[2][2];
    const char* cA = (const char*)g.A + (size_t)cur.pm * tstep; const char* cB = (const char*)g.Bt + (size_t)cur.pn * tstep;
    S.a_ready(cur);
    if constexpr (SP2) {
        PG8_STAGE(PG8_SB(0, 0), cB, voffB); PG8_STAGE(PG8_SB(0, 1), cB + hstep, voffB); PG8_STAGE(PG8_SA(0, 0), cA, voffA); PG8_STAGE(PG8_SA(0, 1), cA + hstep, voffA);
        if (wr == 1) PG8_BAR;
        PG8_WAIT_V(2); PG8_BAR;
        PG8_STAGE(PG8_SB(1, 0), cB + kstep, voffB); PG8_STAGE(PG8_SA(1, 0), cA + kstep, voffA); PG8_STAGE(PG8_SB(1, 1), cB + hstep + kstep, voffB);
        PG8_WAIT_V(6); PG8_BAR;
    } else {
        PG8_STAGE(PG8_SB(0, 0), cB, voffB); PG8_STAGE(PG8_SA(0, 0), cA, voffA); PG8_STAGE(PG8_SB(0, 1), cB + hstep, voffB); PG8_STAGE(PG8_SA(0, 1), cA + hstep, voffA);
        if (wr == 1) PG8_BAR;
        PG8_WAIT_V(4); PG8_BAR;
        PG8_STAGE(PG8_SB(1, 0), cB + kstep, voffB); PG8_STAGE(PG8_SA(1, 0), cA + kstep, voffA); PG8_STAGE(PG8_SB(1, 1), cB + hstep + kstep, voffB);
        PG8_WAIT_V(6); PG8_BAR;
    }
    for (;;) {
        const bool has_next = S.next(ui + 1, nxt);
        const char* nA = has_next ? (const char*)g.A + (size_t)nxt.pm * tstep : cA; const char* nB = has_next ? (const char*)g.Bt + (size_t)nxt.pn * tstep : cB;
        if constexpr (Epi::HAS_MID) {
        for (int t = 0; t < nt / 2; t += 2) {
            const bool last = (t == nt - 2);
            const char* a1 = cA + (size_t)(t + 1) * kstep;
            const char* a2 = last ? nA : cA + (size_t)(t + 2) * kstep; const char* b2 = last ? nB : cB + (size_t)(t + 2) * kstep;
            const char* a3 = a2 + kstep; const char* b3 = b2 + kstep;
            if (last && has_next) S.a_ready(nxt);
            if constexpr (SP2) {
            PG8_LDB(B0, 0, 0); PG8_LDB(B1, 0, 1); PG8_SCHED; PG8_LDA(At, 0, 0); PG8_STAGE(PG8_SA(1, 1), a1 + hstep, voffA);
            PG8_WAIT_V(8); PG8_WAIT_L(0); PG8_BAR; PG8_MMA(0, 0, At, B0); PG8_MMA(0, 1, At, B1); PG8_BAR; PG8_SCHED;
            PG8_LDA(At, 0, 1); PG8_STAGE(PG8_SB(0, 0), b2, voffB); PG8_STAGE(PG8_SB(0, 1), b2 + hstep, voffB); PG8_STAGE(PG8_SA(0, 0), a2, voffA);
            PG8_WAIT_V(8); PG8_WAIT_L(0); PG8_BAR; PG8_MMA(1, 0, At, B0); PG8_MMA(1, 1, At, B1); PG8_BAR; PG8_SCHED;
            PG8_LDB(B0, 1, 0); PG8_LDB(B1, 1, 1); PG8_SCHED; PG8_LDA(At, 1, 0); PG8_STAGE(PG8_SA(0, 1), a2 + hstep, voffA);
            PG8_WAIT_V(8); PG8_WAIT_L(0); PG8_BAR; PG8_MMA(0, 0, At, B0); PG8_MMA(0, 1, At, B1); PG8_BAR; PG8_SCHED;
            PG8_LDA(At, 1, 1); PG8_STAGE(PG8_SB(1, 0), b3, voffB); PG8_STAGE(PG8_SB(1, 1), b3 + hstep, voffB); PG8_STAGE(PG8_SA(1, 0), a3, voffA);
            PG8_WAIT_V(8); PG8_WAIT_L(0); PG8_BAR; PG8_MMA(1, 0, At, B0); PG8_MMA(1, 1, At, B1); PG8_BAR; PG8_SCHED;
            } else {
            PG8_LDB(B0, 0, 0); PG8_SCHED; PG8_LDA(At, 0, 0); PG8_STAGE(PG8_SA(1, 1), a1 + hstep, voffA);
            PG8_WAIT_L(8); PG8_BAR; PG8_WAIT_L(0); PG8_MMA(0, 0, At, B0); PG8_BAR; PG8_SCHED;
            PG8_LDB(B1, 0, 1); PG8_STAGE(PG8_SB(0, 0), b2, voffB);
            PG8_BAR; PG8_WAIT_L(0); PG8_MMA(0, 1, At, B1); PG8_BAR;
            PG8_LDA(At, 0, 1); PG8_STAGE(PG8_SA(0, 0), a2, voffA);
            PG8_BAR; PG8_WAIT_L(0); PG8_MMA(1, 0, At, B0); PG8_BAR; PG8_SCHED;
            PG8_STAGE(PG8_SB(0, 1), b2 + hstep, voffB);
            PG8_WAIT_V(6); PG8_BAR; PG8_MMA(1, 1, At, B1); PG8_BAR;
            PG8_LDB(B0, 1, 0); PG8_SCHED; PG8_LDA(At, 1, 0); PG8_STAGE(PG8_SA(0, 1), a2 + hstep, voffA);
            PG8_WAIT_L(8); PG8_BAR; PG8_WAIT_L(0); PG8_MMA(0, 0, At, B0); PG8_BAR; PG8_SCHED;
            PG8_LDB(B1, 1, 1); PG8_STAGE(PG8_SB(1, 0), b3, voffB);
            PG8_BAR; PG8_WAIT_L(0); PG8_MMA(0, 1, At, B1); PG8_BAR;
            PG8_LDA(At, 1, 1); PG8_STAGE(PG8_SA(1, 0), a3, voffA);
            PG8_BAR; PG8_WAIT_L(0); PG8_MMA(1, 0, At, B0); PG8_BAR; PG8_SCHED;
            PG8_STAGE(PG8_SB(1, 1), b3 + hstep, voffB);
            PG8_WAIT_V(6); PG8_BAR; PG8_MMA(1, 1, At, B1); PG8_BAR;
            }
        }
        E.mid(acc, cur, wr, wc, fr, fq);
        for (int t = nt / 2; t < nt; t += 2) {
            const bool last = (t == nt - 2);
            const char* a1 = cA + (size_t)(t + 1) * kstep;
            const char* a2 = last ? nA : cA + (size_t)(t + 2) * kstep; const char* b2 = last ? nB : cB + (size_t)(t + 2) * kstep;
            const char* a3 = a2 + kstep; const char* b3 = b2 + kstep;
            if (last && has_next) S.a_ready(nxt);
            if constexpr (SP2) {
            PG8_LDB(B0, 0, 0); PG8_LDB(B1, 0, 1); PG8_SCHED; PG8_LDA(At, 0, 0); PG8_STAGE(PG8_SA(1, 1), a1 + hstep, voffA);
            PG8_WAIT_V(8); PG8_WAIT_L(0); PG8_BAR; PG8_MMA(0, 0, At, B0); PG8_MMA(0, 1, At, B1); PG8_BAR; PG8_SCHED;
            PG8_LDA(At, 0, 1); PG8_STAGE(PG8_SB(0, 0), b2, voffB); PG8_STAGE(PG8_SB(0, 1), b2 + hstep, voffB); PG8_STAGE(PG8_SA(0, 0), a2, voffA);
            PG8_WAIT_V(8); PG8_WAIT_L(0); PG8_BAR; PG8_MMA(1, 0, At, B0); PG8_MMA(1, 1, At, B1); PG8_BAR; PG8_SCHED;
            PG8_LDB(B0, 1, 0); PG8_LDB(B1, 1, 1); PG8_SCHED; PG8_LDA(At, 1, 0); PG8_STAGE(PG8_SA(0, 1), a2 + hstep, voffA);
            PG8_WAIT_V(8); PG8_WAIT_L(0); PG8_BAR; PG8_MMA(0, 0, At, B0); PG8_MMA(0, 1, At, B1); PG8_BAR; PG8_SCHED;
            PG8_LDA(At, 1, 1); PG8_STAGE(PG8_SB(1, 0), b3, voffB); PG8_STAGE(PG8_SB(1, 1), b3 + hstep, voffB); PG8_STAGE(PG8_SA(1, 0), a3, voffA);
            PG8_WAIT_V(8); PG8_WAIT_L(0); PG8_BAR; PG8_MMA(1, 0, At, B0); PG8_MMA(1, 1, At, B1); PG8_BAR; PG8_SCHED;
            } else {
            PG8_LDB(B0, 0, 0); PG8_SCHED; PG8_LDA(At, 0, 0); PG8_STAGE(PG8_SA(1, 1), a1 + hstep, voffA);
            PG8_WAIT_L(8); PG8_BAR; PG8_WAIT_L(0); PG8_MMA(0, 0, At, B0); PG8_BAR; PG8_SCHED;
            PG8_LDB(B1, 0, 1); PG8_STAGE(PG8_SB(0, 0), b2, voffB);
            PG8_BAR; PG8_WAIT_L(0); PG8_MMA(0, 1, At, B1); PG8_BAR;
            PG8_LDA(At, 0, 1); PG8_STAGE(PG8_SA(0, 0), a2, voffA);
            PG8_BAR; PG8_WAIT_L(0); PG8_MMA(1, 0, At, B0); PG8_BAR; PG8_SCHED;
            PG8_STAGE(PG8_SB(0, 1), b2 + hstep, voffB);
            PG8_WAIT_V(6); PG8_BAR; PG8_MMA(1, 1, At, B1); PG8_BAR;
            PG8_LDB(B0, 1, 0); PG8_SCHED; PG8_LDA(At, 1, 0); PG8_STAGE(PG8_SA(0, 1), a2 + hstep, voffA);
            PG8_WAIT_L(8); PG8_BAR; PG8_WAIT_L(0); PG8_MMA(0, 0, At, B0); PG8_BAR; PG8_SCHED;
            PG8_LDB(B1, 1, 1); PG8_STAGE(PG8_SB(1, 0), b3, voffB);
            PG8_BAR; PG8_WAIT_L(0); PG8_MMA(0, 1, At, B1); PG8_BAR;
            PG8_LDA(At, 1, 1); PG8_STAGE(PG8_SA(1, 0), a3, voffA);
            PG8_BAR; PG8_WAIT_L(0); PG8_MMA(1, 0, At, B0); PG8_BAR; PG8_SCHED;
            PG8_STAGE(PG8_SB(1, 1), b3 + hstep, voffB);
            PG8_WAIT_V(6); PG8_BAR; PG8_MMA(1, 1, At, B1); PG8_BAR;
            }
        }
        } else {
        for (int t = 0; t < nt; t += 2) {
            const bool last = (t == nt - 2);
            const char* a1 = cA + (size_t)(t + 1) * kstep;
            const char* a2 = last ? nA : cA + (size_t)(t + 2) * kstep; const char* b2 = last ? nB : cB + (size_t)(t + 2) * kstep;
            const char* a3 = a2 + kstep; const char* b3 = b2 + kstep;
            if (last && has_next) S.a_ready(nxt);
            if constexpr (SP2) {
            PG8_LDB(B0, 0, 0); PG8_LDB(B1, 0, 1); PG8_SCHED; PG8_LDA(At, 0, 0); PG8_STAGE(PG8_SA(1, 1), a1 + hstep, voffA);
            PG8_WAIT_V(8); PG8_WAIT_L(0); PG8_BAR; PG8_MMA(0, 0, At, B0); PG8_MMA(0, 1, At, B1); PG8_BAR; PG8_SCHED;
            PG8_LDA(At, 0, 1); PG8_STAGE(PG8_SB(0, 0), b2, voffB); PG8_STAGE(PG8_SB(0, 1), b2 + hstep, voffB); PG8_STAGE(PG8_SA(0, 0), a2, voffA);
            PG8_WAIT_V(8); PG8_WAIT_L(0); PG8_BAR; PG8_MMA(1, 0, At, B0); PG8_MMA(1, 1, At, B1); PG8_BAR; PG8_SCHED;
            PG8_LDB(B0, 1, 0); PG8_LDB(B1, 1, 1); PG8_SCHED; PG8_LDA(At, 1, 0); PG8_STAGE(PG8_SA(0, 1), a2 + hstep, voffA);
            PG8_WAIT_V(8); PG8_WAIT_L(0); PG8_BAR; PG8_MMA(0, 0, At, B0); PG8_MMA(0, 1, At, B1); PG8_BAR; PG8_SCHED;
            PG8_LDA(At, 1, 1); PG8_STAGE(PG8_SB(1, 0), b3, voffB); PG8_STAGE(PG8_SB(1, 1), b3 + hstep, voffB); PG8_STAGE(PG8_SA(1, 0), a3, voffA);
            PG8_WAIT_V(8); PG8_WAIT_L(0); PG8_BAR; PG8_MMA(1, 0, At, B0); PG8_MMA(1, 1, At, B1); PG8_BAR; PG8_SCHED;
            } else {
            PG8_LDB(B0, 0, 0); PG8_SCHED; PG8_LDA(At, 0, 0); PG8_STAGE(PG8_SA(1, 1), a1 + hstep, voffA);
            PG8_WAIT_L(8); PG8_BAR; PG8_WAIT_L(0); PG8_MMA(0, 0, At, B0); PG8_BAR; PG8_SCHED;
            PG8_LDB(B1, 0, 1); PG8_STAGE(PG8_SB(0, 0), b2, voffB);
            PG8_BAR; PG8_WAIT_L(0); PG8_MMA(0, 1, At, B1); PG8_BAR;
            PG8_LDA(At, 0, 1); PG8_STAGE(PG8_SA(0, 0), a2, voffA);
            PG8_BAR; PG8_WAIT_L(0); PG8_MMA(1, 0, At, B0); PG8_BAR; PG8_SCHED;
            PG8_STAGE(PG8_SB(0, 1), b2 + hstep, voffB);
            PG8_WAIT_V(6); PG8_BAR; PG8_MMA(1, 1, At, B1); PG8_BAR;
            PG8_LDB(B0, 1, 0); PG8_SCHED; PG8_LDA(At, 1, 0); PG8_STAGE(PG8_SA(0, 1), a2 + hstep, voffA);
            PG8_WAIT_L(8); PG8_BAR; PG8_WAIT_L(0); PG8_MMA(0, 0, At, B0); PG8_BAR; PG8_SCHED;
            PG8_LDB(B1, 1, 1); PG8_STAGE(PG8_SB(1, 0), b3, voffB);
            PG8_BAR; PG8_WAIT_L(0); PG8_MMA(0, 1, At, B1); PG8_BAR;
            PG8_LDA(At, 1, 1); PG8_STAGE(PG8_SA(1, 0), a3, voffA);
            PG8_BAR; PG8_WAIT_L(0); PG8_MMA(1, 0, At, B0); PG8_BAR; PG8_SCHED;
            PG8_STAGE(PG8_SB(1, 1), b3 + hstep, voffB);
            PG8_WAIT_V(6); PG8_BAR; PG8_MMA(1, 1, At, B1); PG8_BAR;
            }
        }
        }
        if constexpr (ALIGN_EPI) { if (wr == 0) PG8_BAR; }
        if constexpr (!Epi::AFTER_DRAIN) { E(acc, cur, wr, wc, fr, fq); S.done(cur);
#if PG8_EPI_DRAIN
            PG8_WAIT_V(0);
#endif
        }
        if (!has_next) break;
#pragma unroll
        for (int a = 0; a < 2; ++a)
#pragma unroll
            for (int b = 0; b < 2; ++b)
#pragma unroll
                for (int m = 0; m < 4; ++m)
#pragma unroll
                    for (int n = 0; n < 2; ++n) acc[a][b][m][n] = (f32x4){0.f, 0.f, 0.f, 0.f};
        cur = nxt; cA = nA; cB = nB; ++ui;
        if constexpr (ALIGN_EPI) { if (wr == 1) PG8_BAR; }
    }
    PG8_WAIT_V(0);
    if constexpr (!ALIGN_EPI) { if (wr == 0) PG8_BAR; }
    PG8_BAR;
    if constexpr (Epi::AFTER_DRAIN) { E.fused(acc, cur, wr, wc, fr, fq, lds, wid, lane); S.done(cur); }
#undef PG8_SA
#undef PG8_SB
#undef PG8_STAGE
#undef PG8_LDA
#undef PG8_LDB
#undef PG8_MMA
#undef PG8_WAIT_V
#undef PG8_WAIT_L
#undef PG8_BAR
#undef PG8_SCHED
}
}

#include <hip/hip_bf16.h>
#include <cmath>
namespace attn_body {
using bf16=__hip_bfloat16;
using bf16x8=__attribute__((ext_vector_type(8)))short;
using s16x4=__attribute__((ext_vector_type(4)))short;
using f32x16=__attribute__((ext_vector_type(16)))float;
using u32x4=__attribute__((ext_vector_type(4)))unsigned;
typedef float f32x4_t __attribute__((ext_vector_type(4)));
constexpr int BATCH=8,NHEAD=8,SEQ=4096,D=64,DM=NHEAD*D;
constexpr int NW=8,QBLK=32,QB=QBLK*NW,KVBLK=64,NQB=SEQ/QB;
constexpr int ATTN_PITCH=DM, ATTN_UNIT_ROWS=QB, OPITCH=1024;
__device__ __forceinline__ int crow(int r,int hi){return (r&3)+8*(r>>2)+4*hi;}
#define SBAR() __builtin_amdgcn_sched_barrier(0)
__device__ __forceinline__ void cmask(f32x16&p0,f32x16&p1,int jb,int qrel,int hi){
  const float NEG=-INFINITY; int kb=64*jb+4*hi;
  #pragma unroll
  for(int r=0;r<16;++r){int kv=kb+(r&3)+8*(r>>2); if(kv>qrel)p0[r]=NEG; if(kv+32>qrel)p1[r]=NEG;}
}

constexpr int NSLOT=3, SLOTB=8192;
constexpr int LDS_K=0, LDS_V=NSLOT*SLOTB, LDS_WS=2*NSLOT*SLOTB, LDS_OST=LDS_WS+NW*64*4, LDS_KM=LDS_OST+NW*4096, LDS_BYTES=LDS_KM+4096;
constexpr float C2=0.125f*1.4426950408889634f;
__device__ __forceinline__ void glds16(const void*gsrc,unsigned lds_dst){unsigned keep;
  asm volatile("s_mov_b32 %0, m0\n\ts_mov_b32 m0, %2\n\ts_nop 0\n\tglobal_load_lds_dwordx4 %1, off\n\ts_mov_b32 m0, %0":"=&s"(keep):"v"(gsrc),"s"(lds_dst):"memory");}
__device__ __forceinline__ float max3f(float a,float b,float c){float r;asm("v_max3_f32 %0, %1, %2, %3":"=v"(r):"v"(a),"v"(b),"v"(c));return r;}
__device__ __forceinline__ float max2f(float a,float b){float r;asm("v_max_f32_e32 %0, %1, %2":"=v"(r):"v"(a),"v"(b));return r;}
__device__ __forceinline__ float fadd_s(float a,float b){float r;asm("v_add_f32_e32 %0, %1, %2":"=v"(r):"v"(a),"v"(b));return r;}
__device__ __forceinline__ float fsub_s(float a,float b){float r;asm("v_sub_f32_e32 %0, %1, %2":"=v"(r):"v"(a),"v"(b));return r;}
typedef float f32x2_t __attribute__((ext_vector_type(2))); typedef __bf16 bf16x2_t __attribute__((ext_vector_type(2)));
__device__ __forceinline__ unsigned cvtpk_s(float lo,float hi){f32x2_t v={lo,hi};bf16x2_t b=__builtin_convertvector(v,bf16x2_t);return __builtin_bit_cast(unsigned,b);}
#define WAIT_BAR(N) asm volatile("s_waitcnt vmcnt(" #N ") lgkmcnt(0)\n\ts_barrier":::"memory")

__device__ __forceinline__ void qkt(f32x16&p0,f32x16&p1,const char*Kslot,const bf16x8*qr,int r32,int hi){
  const char*kb=Kslot+hi*1024+r32*16;
  #pragma unroll
  for(int d0=0;d0<4;++d0){
    const bf16x8 b0=*reinterpret_cast<const bf16x8*>(kb+d0*2048);
    const bf16x8 b1=*reinterpret_cast<const bf16x8*>(kb+d0*2048+512);
    p0=__builtin_amdgcn_mfma_f32_32x32x16_bf16(b0,qr[d0],p0,0,0,0);p1=__builtin_amdgcn_mfma_f32_32x32x16_bf16(b1,qr[d0],p1,0,0,0);}
}
typedef __attribute__((address_space(3))) const char* lds_cptr;
typedef short v4i16_t __attribute__((ext_vector_type(4)));
__device__ __forceinline__ void kload8(bf16x8*kf,lds_cptr kp){
  kf[0]=*(const __attribute__((address_space(3))) bf16x8*)(kp);      kf[1]=*(const __attribute__((address_space(3))) bf16x8*)(kp+512);
  kf[2]=*(const __attribute__((address_space(3))) bf16x8*)(kp+2048); kf[3]=*(const __attribute__((address_space(3))) bf16x8*)(kp+2560);
  kf[4]=*(const __attribute__((address_space(3))) bf16x8*)(kp+4096); kf[5]=*(const __attribute__((address_space(3))) bf16x8*)(kp+4608);
  kf[6]=*(const __attribute__((address_space(3))) bf16x8*)(kp+6144); kf[7]=*(const __attribute__((address_space(3))) bf16x8*)(kp+6656);
}
__device__ __forceinline__ void kload2(bf16x8*kf,lds_cptr kp,int j){ kf[2*j]=*(const __attribute__((address_space(3))) bf16x8*)(kp+j*2048); kf[2*j+1]=*(const __attribute__((address_space(3))) bf16x8*)(kp+j*2048+512); }
__device__ __forceinline__ s16x4 vtr(lds_cptr p){ return __builtin_bit_cast(s16x4,__builtin_amdgcn_ds_read_tr16_b64_v4i16((__attribute__((address_space(3))) v4i16_t*)p)); }
__device__ __forceinline__ float rowmax(const f32x16&p0,const f32x16&p1){
  float a=max3f(p0[0],p0[1],p1[0]),b=max3f(p0[2],p0[3],p1[1]);a=max3f(a,p1[2],p1[3]);
  #pragma unroll
  for(int r=4;r<16;r+=4){a=max3f(a,p0[r],p0[r+1]);b=max3f(b,p0[r+2],p0[r+3]);a=max3f(a,p1[r],p1[r+1]);b=max3f(b,p1[r+2],p1[r+3]);}
  const float m=max2f(a,b);
  auto rr=__builtin_amdgcn_permlane32_swap(__float_as_uint(m),__float_as_uint(m),false,false);
  return max2f(__uint_as_float(rr[0]),__uint_as_float(rr[1]));
}
__device__ __forceinline__ void pv(f32x16*o,int vb,bf16x8 pa0,bf16x8 pa1,bf16x8 pa2,bf16x8 pa3){
  #pragma unroll
  for(int d0=0;d0<2;++d0){s16x4 lo[4],hi[4];
    #pragma unroll
    for(int ks=0;ks<4;++ks){
      asm volatile("ds_read_b64_tr_b16 %0,%1 offset:%c2":"=&v"(lo[ks]):"v"(vb),"i"(d0*4096+ks*1024):"memory");
      asm volatile("ds_read_b64_tr_b16 %0,%1 offset:%c2":"=&v"(hi[ks]):"v"(vb),"i"(d0*4096+ks*1024+512):"memory");}
    asm volatile("s_waitcnt lgkmcnt(0)":::"memory");SBAR();
    #define PK(k) (bf16x8){lo[k][0],lo[k][1],lo[k][2],lo[k][3],hi[k][0],hi[k][1],hi[k][2],hi[k][3]}
    o[d0]=__builtin_amdgcn_mfma_f32_32x32x16_bf16(pa0,PK(0),o[d0],0,0,0);
    o[d0]=__builtin_amdgcn_mfma_f32_32x32x16_bf16(pa1,PK(1),o[d0],0,0,0);
    o[d0]=__builtin_amdgcn_mfma_f32_32x32x16_bf16(pa2,PK(2),o[d0],0,0,0);
    o[d0]=__builtin_amdgcn_mfma_f32_32x32x16_bf16(pa3,PK(3),o[d0],0,0,0);
    #undef PK
  }
}

#ifndef ATTN_STORE16
#define ATTN_STORE16(p,v) __builtin_amdgcn_raw_buffer_store_b128((v),orsrc_,(unsigned)((const char*)(p)-(const char*)O),0,16)
#endif
template<int THRL> __device__ __forceinline__ void attn_unit(int b,int h,int qb,const bf16*Q,const bf16*__restrict__ K,const bf16*__restrict__ V,bf16*O,const float*kmean,char*shm){
  const int tid=threadIdx.x,lane=tid&63,r32=lane&31,hi=lane>>5; const int wid=__builtin_amdgcn_readfirstlane(tid>>6);
  const long rowbase=(long)b*SEQ; const int q0=qb*QB;
  const bf16*Qw=Q+(rowbase+q0+wid*QBLK)*DM+h*D;
  const bf16*Kh=K+rowbase*DM+h*D,*Vh=V+rowbase*DM+h*D;
  const unsigned lds0=(unsigned)(uintptr_t)shm;
  float*wsf=(float*)(shm+LDS_WS)+wid*64;
  const bf16*ksrc=Kh+(long)lane*DM+wid*8;
  const bf16*vsrc=Vh+(long)(16*(wid&3)+(lane>>2))*DM+(wid>>2)*32+(lane&3)*8;
  const unsigned kdst=lds0+LDS_K+wid*1024, vdst=lds0+LDS_V+wid*1024;
  #define POS(t) (((t)<4)?(NT-4+(t)):((t)-4))
  #define DMA_K(t,slot) glds16(ksrc+(long)POS(t)*KVBLK*DM,(unsigned)__builtin_amdgcn_readfirstlane(kdst+(slot)))
  #define DMA_V(t,slot) glds16(vsrc+(long)POS(t)*KVBLK*DM,(unsigned)__builtin_amdgcn_readfirstlane(vdst+(slot)))
  const int vb0=(int)(lds0+LDS_V)+((lane>>4)&1)*32+(lane&3)*8+(4*hi+((lane&15)>>2))*64;
  const char*Kbase=shm+LDS_K; bf16x8 kf[8];
  const lds_cptr shm3=(lds_cptr)shm; const lds_cptr kp0=shm3+LDS_K+hi*1024+r32*16; const lds_cptr vp0=shm3+LDS_V+((lane>>4)&1)*32+(lane&3)*8+(4*hi+((lane&15)>>2))*64;
  const int NT=(q0+QB)/KVBLK;
  DMA_K(0,0);DMA_V(0,0);DMA_K(1,SLOTB);
  bf16x8 qr[4];
  #pragma unroll
  for(int d0=0;d0<4;++d0)qr[d0]=*reinterpret_cast<const bf16x8*>(&Qw[(long)r32*DM+d0*16+hi*8]);
  float mhat=0.f,l_reg=0.f;f32x16 o[2];o[0]=f32x16{};o[1]=f32x16{};
  const float slope2=ldexpf(1.4426950408889634f,-(h+1));
  unsigned selmask=0u;
  { typedef __attribute__((address_space(3))) float* lds_fptr; typedef __attribute__((address_space(3))) const f32x4_t* lds_f4ptr;
    lds_fptr kml=(lds_fptr)((lds_cptr)shm+LDS_KM);
    { const float*src=kmean+((long)b*16)*2*DM+h*D;
      #pragma unroll
      for(int i=0;i<2;++i){const int e=tid+512*i; kml[e]=src[(e>>6)*2*DM+(e&63)]+src[(e>>6)*2*DM+DM+(e&63)];} }
    asm volatile("s_waitcnt vmcnt(0) lgkmcnt(0)\n\ts_barrier":::"memory");
    float qf[32];
    #pragma unroll
    for(int d0=0;d0<4;++d0){
      #pragma unroll
      for(int j=0;j<8;++j)qf[d0*8+j]=__uint_as_float(((unsigned)(unsigned short)qr[d0][j])<<16);}
    float sc[16];
    #pragma unroll
    for(int j=0;j<16;++j){ sc[j]=-INFINITY;
      if(j<qb){ lds_f4ptr kr=(lds_f4ptr)(kml+j*64+hi*8); float a=0.f;
        #pragma unroll
        for(int d0=0;d0<4;++d0){ const f32x4_t k0=kr[d0*4],k1=kr[d0*4+1];
          a+=qf[d0*8+0]*k0[0]+qf[d0*8+1]*k0[1]+qf[d0*8+2]*k0[2]+qf[d0*8+3]*k0[3]+qf[d0*8+4]*k1[0]+qf[d0*8+5]*k1[1]+qf[d0*8+6]*k1[2]+qf[d0*8+7]*k1[3]; }
        a+=__shfl_xor(a,32); sc[j]=a; } }
    #pragma unroll
    for(int j=0;j<15;++j){ int cnt=0;
      #pragma unroll
      for(int k=0;k<15;++k){ if(k!=j) cnt+=((sc[k]>sc[j])||((sc[k]==sc[j])&&(k<j)))?1:0; }
      if(j<qb&&cnt<3) selmask|=(1u<<j); } }
  #define CINIT(C0,C1,t) do{ const int pt_=POS(t); float x_=slope2*(float)(64*pt_-q0+4*hi)-mhat; \
    if((t)>=4){ x_+=((selmask>>(pt_>>2))&1u)?0.f:-30000.f; } const float y_=x_+32.f*slope2; \
    _Pragma("unroll") for(int r=0;r<16;++r){ const float cr_=(float)((r&3)+8*(r>>2)); C0[r]=__builtin_fmaf(slope2,cr_,x_); C1[r]=__builtin_fmaf(slope2,cr_,y_); } }while(0)

  const int qrel=wid*QBLK+r32;
  #define CMASK(P0,P1,t) do{ if((t)<4)cmask(P0,P1,(t),qrel,hi);}while(0)
  bool resc=false;
  #define START(P0,P1) do{ const float rm=rowmax(P0,P1); resc=false; \
    { const float dl=rm; mhat=fadd_s(mhat,dl); \
      _Pragma("unroll") for(int r=0;r<16;++r){P0[r]=fsub_s(P0[r],dl);P1[r]=fsub_s(P1[r],dl);} } \
    _Pragma("unroll") for(int r=0;r<16;++r)P0[r]=__builtin_amdgcn_exp2f(P0[r]); }while(0)
  #define RESC() do{ if(resc){ asm volatile("s_waitcnt lgkmcnt(0)":::"memory"); \
      _Pragma("unroll") for(int d_=0;d_<2;++d_) _Pragma("unroll") for(int r=0;r<16;++r)o[d_][r]*=wsf[crow(r,hi)]; } }while(0)
  f32x16 pA0,pA1,pB0,pB1;
  int sl_prev=0,sl_cur=0,sl_next=SLOTB;
  #define ROT() do{sl_prev=sl_cur;sl_cur=sl_next;sl_next=(sl_next==(NSLOT-1)*SLOTB)?0:sl_next+SLOTB;}while(0)
  DMA_K(2,2*SLOTB);
  WAIT_BAR(3);
  CINIT(pA0,pA1,0); qkt(pA0,pA1,Kbase,qr,r32,hi);asm volatile("s_nop 15\n\ts_nop 7":"+v"(pA0),"+v"(pA1));CMASK(pA0,pA1,0);
  START(pA0,pA1);
  _Pragma("unroll") for(int r=0;r<16;++r)pA1[r]=__builtin_amdgcn_exp2f(pA1[r]);
  WAIT_BAR(0);
  DMA_K(3,0);DMA_V(1,SLOTB);
  ROT();
  kload8(kf,kp0+sl_cur);
  WAIT_BAR(2);
  s16x4 vlo[8],vhi[8]; u32x4 pw0,pw1,pw2,pw3;
  #define PKW(P,B) cvtpk_s(P[B],P[B+1])
  #define PAF(k) __builtin_bit_cast(bf16x8,pw##k)
  #define VFR(i) (bf16x8){vlo[i][0],vlo[i][1],vlo[i][2],vlo[i][3],vhi[i][0],vhi[i][1],vhi[i][2],vhi[i][3]}
  #define PIN(x) asm volatile("":"+v"(x))
  #define MX3(a,b,c) __builtin_fmaxf(__builtin_fmaxf((a),(b)),(c))
  #define GAPA(MF,A0,A1,A2,A3,W0,W1,PW) do{ MF; sacc+=A0; sacc+=A1; sacc+=A2; sacc+=A3; PIN(sacc); W0; W1; PIN(PW); SBAR(); }while(0)
  #define EX(v) __builtin_amdgcn_exp2f(v)
  #define GAPB(MF,X,B) do{ MF; X[B]=EX(X[B]); X[B+1]=EX(X[B+1]); X[B+2]=EX(X[B+2]); X[B+3]=EX(X[B+3]); PIN(X); SBAR(); }while(0)
  #define VRD(i) do{ vlo[i]=vtr(vp_+(((i)>>2)*4096+((i)&3)*1024)); vhi[i]=vtr(vp_+(((i)>>2)*4096+((i)&3)*1024+512)); }while(0)
  #define KRD(G,j) do{ if(G){ kload2(kf,kp0+sl_next,j); SBAR(); } }while(0)
  #define STEP(C0,C1,P0,P1,t,GK,GV,GL) do{ SBAR(); CINIT(C0,C1,t); PIN(C0); PIN(C1); SBAR(); \
    const lds_cptr vp_=vp0+sl_prev; \
    VRD(0); SBAR(); float sacc=(P0[0]+P0[1]); \
    GAPA(C0=__builtin_amdgcn_mfma_f32_32x32x16_bf16(kf[0],qr[0],C0,0,0,0), P0[2],P0[3],P0[4],P0[5],     pw0[0]=PKW(P0,0), pw0[1]=PKW(P0,2), pw0); \
    VRD(4); SBAR(); GAPA(C1=__builtin_amdgcn_mfma_f32_32x32x16_bf16(kf[1],qr[0],C1,0,0,0), P0[6],P0[7],P0[8],P0[9],     pw0[2]=PKW(P0,4), pw0[3]=PKW(P0,6), pw0); \
    VRD(1); SBAR(); GAPA(C0=__builtin_amdgcn_mfma_f32_32x32x16_bf16(kf[2],qr[1],C0,0,0,0),   P0[10],P0[11],P0[12],P0[13], pw1[0]=PKW(P0,8), pw1[1]=PKW(P0,10), pw1); \
    VRD(5); SBAR(); GAPA(C1=__builtin_amdgcn_mfma_f32_32x32x16_bf16(kf[3],qr[1],C1,0,0,0),   P0[14],P0[15],P1[0],P1[1],   pw1[2]=PKW(P0,12),pw1[3]=PKW(P0,14), pw1); \
    VRD(2); SBAR(); GAPA(C0=__builtin_amdgcn_mfma_f32_32x32x16_bf16(kf[4],qr[2],C0,0,0,0),   P1[2],P1[3],P1[4],P1[5],     pw2[0]=PKW(P1,0), pw2[1]=PKW(P1,2), pw2); \
    VRD(6); SBAR(); GAPA(C1=__builtin_amdgcn_mfma_f32_32x32x16_bf16(kf[5],qr[2],C1,0,0,0),   P1[6],P1[7],P1[8],P1[9],     pw2[2]=PKW(P1,4), pw2[3]=PKW(P1,6), pw2); \
    VRD(3); SBAR(); GAPA(C0=__builtin_amdgcn_mfma_f32_32x32x16_bf16(kf[6],qr[3],C0,0,0,0),   P1[10],P1[11],P1[12],P1[13], pw3[0]=PKW(P1,8), pw3[1]=PKW(P1,10), pw3); \
    VRD(7); SBAR(); GAPA(C1=__builtin_amdgcn_mfma_f32_32x32x16_bf16(kf[7],qr[3],C1,0,0,0),   P1[14],P1[15],0.f,0.f,       pw3[2]=PKW(P1,12),pw3[3]=PKW(P1,14), pw3); \
    l_reg+=sacc; \
    if(GK){DMA_K((t)+3,sl_cur);} if(GV){DMA_V((t)+1,sl_next);} \
    CMASK(C0,C1,t); \
    { float a=MX3(C0[0],C0[1],C1[0]),b=MX3(C0[2],C0[3],C1[1]); a=MX3(a,C1[2],C1[3]); \
      _Pragma("unroll") for(int r=4;r<16;r+=4){a=MX3(a,C0[r],C0[r+1]);b=MX3(b,C0[r+2],C0[r+3]);a=MX3(a,C1[r],C1[r+1]);b=MX3(b,C1[r+2],C1[r+3]);} \
      float rm=__builtin_fmaxf(a,b); { auto rr=__builtin_amdgcn_permlane32_swap(__float_as_uint(rm),__float_as_uint(rm),false,false); rm=__builtin_fmaxf(__uint_as_float(rr[0]),__uint_as_float(rr[1])); } \
      resc=false; \
      if(__builtin_expect(__any(rm>(float)THRL),0)){ const float dl=__builtin_fmaxf(rm,0.f); mhat+=dl; \
        _Pragma("unroll") for(int r=0;r<16;++r){C0[r]-=dl;C1[r]-=dl;} \
        const float f=__builtin_amdgcn_exp2f(-dl); l_reg*=f; if(hi==0)wsf[r32]=f; resc=true; } } \
    SBAR(); \
    GAPB(o[0]=__builtin_amdgcn_mfma_f32_32x32x16_bf16(PAF(0),VFR(0),o[0],0,0,0), C0,0); \
    GAPB(o[1]=__builtin_amdgcn_mfma_f32_32x32x16_bf16(PAF(0),VFR(4),o[1],0,0,0), C0,4); \
    KRD(GL,0); GAPB(o[0]=__builtin_amdgcn_mfma_f32_32x32x16_bf16(PAF(1),VFR(1),o[0],0,0,0), C0,8); \
    KRD(GL,1); GAPB(o[1]=__builtin_amdgcn_mfma_f32_32x32x16_bf16(PAF(1),VFR(5),o[1],0,0,0), C0,12); \
    KRD(GL,2); GAPB(o[0]=__builtin_amdgcn_mfma_f32_32x32x16_bf16(PAF(2),VFR(2),o[0],0,0,0), C1,0); \
    KRD(GL,3); GAPB(o[1]=__builtin_amdgcn_mfma_f32_32x32x16_bf16(PAF(2),VFR(6),o[1],0,0,0), C1,4); \
    GAPB(o[0]=__builtin_amdgcn_mfma_f32_32x32x16_bf16(PAF(3),VFR(3),o[0],0,0,0), C1,8); \
    GAPB(o[1]=__builtin_amdgcn_mfma_f32_32x32x16_bf16(PAF(3),VFR(7),o[1],0,0,0), C1,12); \
    }while(0)
  int t=1;
  #define ENDW(tt) do{ if((tt)+3<NT){WAIT_BAR(2);} else if((tt)+2<NT){WAIT_BAR(1);} else {WAIT_BAR(0);} }while(0)
  for(;t<5&&t+1<NT;t+=2){
    STEP(pB0,pB1,pA0,pA1,t,(t+3<NT),(t+1<NT),(t+1<NT));       ENDW(t);   RESC(); ROT();
    STEP(pA0,pA1,pB0,pB1,t+1,(t+4<NT),(t+2<NT),(t+2<NT));     ENDW(t+1); RESC(); ROT();
  }
  #undef CMASK
  #define CMASK(P0,P1,t) do{}while(0)
  for(;t+5<NT;t+=2){
    STEP(pB0,pB1,pA0,pA1,t,true,true,true);     WAIT_BAR(2); RESC(); ROT();
    STEP(pA0,pA1,pB0,pB1,t+1,true,true,true);   WAIT_BAR(2); RESC(); ROT();
  }
  for(;t+1<NT;t+=2){
    STEP(pB0,pB1,pA0,pA1,t,(t+3<NT),(t+1<NT),(t+1<NT));       ENDW(t);   RESC(); ROT();
    STEP(pA0,pA1,pB0,pB1,t+1,(t+4<NT),(t+2<NT),(t+2<NT));     ENDW(t+1); RESC(); ROT();
  }
  #undef CMASK
  #define CMASK(P0,P1,t) do{ if((t)<4)cmask(P0,P1,(t),qrel,hi);}while(0)
  STEP(pB0,pB1,pA0,pA1,NT-1,false,false,false); RESC();
  { float sacc=pB0[0]+pB0[1]; _Pragma("unroll") for(int r=2;r<16;++r)sacc+=pB0[r]; _Pragma("unroll") for(int r=0;r<16;++r)sacc+=pB1[r]; l_reg+=sacc;
    pw0=(u32x4){PKW(pB0,0),PKW(pB0,2),PKW(pB0,4),PKW(pB0,6)};pw1=(u32x4){PKW(pB0,8),PKW(pB0,10),PKW(pB0,12),PKW(pB0,14)};pw2=(u32x4){PKW(pB1,0),PKW(pB1,2),PKW(pB1,4),PKW(pB1,6)};pw3=(u32x4){PKW(pB1,8),PKW(pB1,10),PKW(pB1,12),PKW(pB1,14)};
    SBAR(); pv(o,vb0+sl_cur,PAF(0),PAF(1),PAF(2),PAF(3)); }
  #undef PKW
  #undef PAF
  #undef VFR
  #undef PIN
  #undef MX3
  #undef GAPA
  #undef GAPB
  #undef EX
  #undef VRD
  #undef KRD
  #undef STEP
  #undef ENDW
  {auto rr=__builtin_amdgcn_permlane32_swap(__float_as_uint(l_reg),__float_as_uint(l_reg),false,false);l_reg=__uint_as_float(rr[0])+__uint_as_float(rr[1]);}
  if(hi==0)wsf[32+r32]=l_reg;asm volatile("s_waitcnt lgkmcnt(0)":::"memory");
  float rli[16];
  #pragma unroll
  for(int r=0;r<16;++r)rli[r]=__builtin_amdgcn_rcpf(wsf[32+crow(r,hi)]);
  bf16*Ow=O+(rowbase+q0+wid*QBLK)*OPITCH+h*D; const __amdgpu_buffer_rsrc_t orsrc_=__builtin_amdgcn_make_buffer_rsrc((void*)O,0,0x7fffffff,0x00020000);
  { bf16*stg=(bf16*)(shm+LDS_OST)+wid*2048;
    #pragma unroll
    for(int r=0;r<16;++r){const int orow=crow(r,hi);
      #pragma unroll
      for(int d0=0;d0<2;++d0)stg[orow*64+d0*32+r32]=__float2bfloat16(o[d0][r]*rli[r]);}
    asm volatile("s_waitcnt lgkmcnt(0)":::"memory");
    #pragma unroll
    for(int i=0;i<4;++i){const int row=i*8+(lane>>3),ch=lane&7; const u32x4 v=*(const u32x4*)(stg+row*64+ch*8); ATTN_STORE16(Ow+(long)row*OPITCH+ch*8,v);} }
  asm volatile("s_waitcnt lgkmcnt(0)\n\ts_barrier":::"memory");
  #undef DMA_K
  #undef DMA_V
  #undef POS
  #undef CINIT
  #undef CMASK
  #undef START
  #undef RESC
  #undef ROT
}
constexpr int ATTN_LDS_BYTES=LDS_BYTES;
struct AttnTensors { const bf16* Q; const bf16* K; const bf16* V; bf16* O; const float* kmean; };
struct AttnUnit { int bh; int qb; };
struct StaticOrder {
  int vcu,grid;
  __device__ __forceinline__ explicit StaticOrder(int grid_,int block):vcu((grid_%8==0)?((block%8)*(grid_/8)+block/8):block),grid(grid_){}
  __device__ __forceinline__ bool next(int i,AttnUnit&u)const{ const int item=(i>>1)*grid+vcu; if(item>=BATCH*NHEAD*8)return false; const int s=item&7; u.bh=item>>3; u.qb=(i&1)?15-s:s; return true; }
  __device__ __forceinline__ void a_ready(const AttnUnit&)const{}
  __device__ __forceinline__ void done(const AttnUnit&)const{}
};
template<class Sched,int THRL=8> __device__ __forceinline__ void attn_phase(char*lds,const AttnTensors&T,const Sched&S){
  AttnUnit u;
  for(int i=0;S.next(i,u);++i){ S.a_ready(u); attn_unit<THRL>(u.bh/NHEAD,u.bh%NHEAD,u.qb,T.Q,T.K,T.V,T.O,T.kmean,lds); S.done(u); }
}
#undef SBAR
#undef WAIT_BAR
}

constexpr int NWAVES = 8;
#ifndef MK_N_LAUNCHES
#define MK_N_LAUNCHES 1
#endif
constexpr int N_LAUNCHES = MK_N_LAUNCHES;
constexpr int PER_PHASE = 8;

constexpr int BATCH = 8, SEQ = 4096, DM = 1024, TOK = BATCH * SEQ;
constexpr int CONV_CH = 512, CONV_W = 31, ATT_W = 512, IN_COLS = 4608;
constexpr int P_HEADS = 8, P_NK = 128, P_TOPK = 16, P_E = P_HEADS * P_TOPK  , N_EXP = P_NK * P_NK;
constexpr float NORM_EPS = 1e-6f;

constexpr size_t MiB = 1u << 20;
constexpr size_t WS_CTL = 0, CTL_ZERO_BYTES = 65536;
constexpr size_t WS_KMEAN = 1 * MiB;
constexpr size_t WS_SS = 2 * MiB;
constexpr size_t WS_WIN = 4 * MiB;
constexpr size_t WS_WPW = 13 * MiB, WS_WAO = 14 * MiB;
constexpr size_t WS_WOUT = 15 * MiB;
constexpr size_t WS_WQ = 17 * MiB;
constexpr size_t WS_KEYS = 21 * MiB;
constexpr size_t WS_USC = 22 * MiB, WS_VSC = 22 * MiB + 65536;
constexpr size_t WS_UB = 24 * MiB, WS_VB = 56 * MiB;
constexpr size_t WS_H = 88 * MiB;
constexpr size_t WS_CACT = 88 * MiB;
constexpr size_t WS_EIDX = 104 * MiB, WS_GW = 120 * MiB, WS_GA = 136 * MiB;
constexpr size_t WS_ZGLU = 152 * MiB, WS_QO = 184 * MiB, WS_K = 216 * MiB, WS_V = 248 * MiB;
constexpr size_t WS_MIX = 216 * MiB;
constexpr size_t WS_QP = 152 * MiB;
constexpr size_t WS_COEF = 152 * MiB, WS_SS2 = 168 * MiB;
constexpr size_t WS_GC = 280 * MiB, WS_GATE_A = 344 * MiB;
constexpr size_t WS_X1B = 280 * MiB;
constexpr size_t WS_X8 = 344 * MiB, WS_XS = 377 * MiB;
constexpr size_t WS_END = 408 * MiB;
constexpr int CW_TMO = 0, CW_CODE = 1, CW_CONVQ = 64, CW_BAR = 4096;

constexpr int RING_OFF = 0, RING_BYTES = 131072;
constexpr int LDSCTL_OFF = RING_BYTES, MISC_OFF = LDSCTL_OFF + 320;
constexpr int LDS_BYTES = 155648;
constexpr int VT_PITCH = 144, VT_BYTES = 128 * VT_PITCH, VT_LAST_OFF = LDSCTL_OFF + 1024, P7_CNT_OFF = LDSCTL_OFF + 512;
static_assert(7 * VT_BYTES <= RING_BYTES && VT_LAST_OFF + VT_BYTES <= LDS_BYTES && MISC_OFF + 128 <= P7_CNT_OFF, "PEER v tiles");
constexpr float C8_SCALE = 4096.f;
static_assert(MISC_OFF + 128 <= LDS_BYTES, "LDS map");

#define GAS __attribute__((address_space(1)))
#define LAS __attribute__((address_space(3)))
typedef unsigned short bf16;
typedef unsigned v4u __attribute__((ext_vector_type(4)));
typedef float f32x4 __attribute__((ext_vector_type(4)));
typedef float f32x16 __attribute__((ext_vector_type(16)));
typedef short bf16x8 __attribute__((ext_vector_type(8)));
typedef __bf16 bf16x2_t __attribute__((ext_vector_type(2)));
typedef GAS unsigned gu32;
#define RLX_AGENT __ATOMIC_RELAXED, __HIP_MEMORY_SCOPE_AGENT
#define LDS_WAIT() asm volatile("s_waitcnt lgkmcnt(0)" ::: "memory")
#define VM_WAIT() asm volatile("s_waitcnt vmcnt(0)" ::: "memory")
__device__ __forceinline__ unsigned f2bf(float f) { unsigned u = __builtin_bit_cast(unsigned, f); return (u + 0x7fffu + ((u >> 16) & 1u)) >> 16; }
__device__ __forceinline__ unsigned pk2(float lo, float hi) { return f2bf(lo) | (f2bf(hi) << 16); }
__device__ __forceinline__ float bflo(unsigned u) { return __uint_as_float(u << 16); }
__device__ __forceinline__ float bfhi(unsigned u) { return __uint_as_float(u & 0xffff0000u); }

#define XB_TMO      128
#define XB_XCNT(j)  (256  + 64 * (j))
#define XB_XSUB(j)  (1280 + 64 * (j))
#define XB_XGEN(j)  (2304 + 64 * (j))
#define XB_TOP      3328
#define XB_TOPGEN   3392
#define XCD_BAR_WORDS 3456
#define XB_SPIN_CAP (1u << 18)

__device__ __forceinline__ unsigned xb_ld(unsigned* p)              { return __hip_atomic_load(p, __ATOMIC_RELAXED, __HIP_MEMORY_SCOPE_AGENT); }
__device__ __forceinline__ unsigned xb_add(unsigned* p, unsigned v) { return __hip_atomic_fetch_add(p, v, __ATOMIC_RELAXED, __HIP_MEMORY_SCOPE_AGENT); }
__device__ __forceinline__ unsigned xb_xcc_id() { return (unsigned)__builtin_amdgcn_s_getreg((3 << 11) | 20) & 0xFu; }
#define XB_SPIN(cond, bar) do { unsigned _sp = 0; while (cond) { __builtin_amdgcn_s_sleep(1); \
    if ((++_sp & 255u) == 0u) { if (xb_ld(&(bar)[XB_TMO])) break; if (_sp > XB_SPIN_CAP) { atomicAdd(&(bar)[XB_TMO], 1u); break; } } } } while (0)

struct XcdBarrier {
    unsigned* bar; unsigned x;
    volatile LAS unsigned* st;
};

__device__ __forceinline__ XcdBarrier xcd_barrier_post(unsigned* bar, volatile LAS unsigned* st) {
    XcdBarrier b; b.bar = bar; b.x = xb_xcc_id(); b.st = st;
    if (threadIdx.x == 0) (void)xb_add(&bar[XB_XCNT(b.x)], 1u);
    return b;
}
__device__ __forceinline__ void xcd_barrier_complete(unsigned* bar, unsigned x, unsigned& nloc, unsigned& nx) {
    const unsigned G = gridDim.x * gridDim.y * gridDim.z;
    unsigned sum, cnt, mine, sp = 0u;
    for (;;) {
        sum = 0u; cnt = 0u; mine = 0u;
#pragma unroll
        for (unsigned j = 0; j < 16; ++j) { const unsigned c = xb_ld(&bar[XB_XCNT(j)]); sum += c; cnt += (c > 0u) ? 1u : 0u; mine = (j == x) ? c : mine; }
        if (sum == G) break;
        __builtin_amdgcn_s_sleep(1);
        if ((++sp & 255u) == 0u) { if (xb_ld(&bar[XB_TMO])) break; if (sp > XB_SPIN_CAP) { atomicAdd(&bar[XB_TMO], 1u); break; } }
    }
    nloc = mine > 0u ? mine : 1u; nx = cnt > 0u ? cnt : 1u;
}

__device__ __forceinline__ void xcd_barrier(const XcdBarrier& b) {
    asm volatile("s_waitcnt vmcnt(0)" ::: "memory");
    __syncthreads();
    if (threadIdx.x == 0) {
        unsigned* bar = b.bar;
        __builtin_amdgcn_s_waitcnt(0);
        unsigned nloc = b.st[0], nx = b.st[1];
        if (nloc == 0u) { xcd_barrier_complete(bar, b.x, nloc, nx); b.st[0] = nloc; b.st[1] = nx; }
        const unsigned old = xb_add(&bar[XB_XSUB(b.x)], 1u);
        const unsigned gen = old / nloc;
        if (old + 1u == (gen + 1u) * nloc) {
            __builtin_amdgcn_fence(__ATOMIC_RELEASE, "agent");
            asm volatile("s_waitcnt vmcnt(0)" ::: "memory");
            const unsigned og = xb_add(&bar[XB_TOP], 1u);
            const unsigned tg = og / nx;
            if (og + 1u == (tg + 1u) * nx) xb_add(&bar[XB_TOPGEN], 1u);
            else XB_SPIN(xb_ld(&bar[XB_TOPGEN]) == tg, bar);
            __builtin_amdgcn_fence(__ATOMIC_ACQUIRE, "agent");
            xb_add(&bar[XB_XGEN(b.x)], 1u);
            asm volatile("s_waitcnt vmcnt(0)" ::: "memory");
        } else {
            XB_SPIN(xb_ld(&bar[XB_XGEN(b.x)]) == gen, bar);
            __builtin_amdgcn_fence(__ATOMIC_ACQUIRE, "agent");
            asm volatile("s_waitcnt vmcnt(0)" ::: "memory");
        }
    }
    __syncthreads();
}

struct Frame {
    LAS unsigned char* lds;
    volatile LAS unsigned* MISC;
    gu32* ctl;
    int tid, lane, wave;
    int vcu, G;
};
__device__ __forceinline__ float wave_sum(float v) {
#pragma unroll
    for (int o = 1; o < 64; o <<= 1) v += __shfl_xor(v, o);
    return v;
}

__device__ __forceinline__ float wave_sum_hi(float v) {
    v += __builtin_bit_cast(float, __builtin_amdgcn_update_dpp(0, __builtin_bit_cast(int, v), 0xB1, 0xf, 0xf, false));
    v += __builtin_bit_cast(float, __builtin_amdgcn_update_dpp(0, __builtin_bit_cast(int, v), 0x4E, 0xf, 0xf, false));
    v += __builtin_bit_cast(float, __builtin_amdgcn_update_dpp(0, __builtin_bit_cast(int, v), 0x141, 0xf, 0xf, false));
    v += __builtin_bit_cast(float, __builtin_amdgcn_update_dpp(0, __builtin_bit_cast(int, v), 0x140, 0xf, 0xf, false));
    v += __builtin_bit_cast(float, __builtin_amdgcn_update_dpp(0, __builtin_bit_cast(int, v), 0x142, 0xA, 0xF, false));
    v += __builtin_bit_cast(float, __builtin_amdgcn_update_dpp(0, __builtin_bit_cast(int, v), 0x143, 0xC, 0xF, false));
    return v;
}

__device__ __forceinline__ void p0_transpose_item(const float* W, int K, int N, bf16* WT, int k0, int n0, int dst_row0, const float* kscale, LAS float* scr, int lane, int dpitch = 0, int koff = 0) {
    if (dpitch == 0) dpitch = K;
#pragma unroll 8
    for (int i = 0; i < 32; ++i) { const int kk = 2 * i + (lane >> 5); float v = W[(size_t)(k0 + kk) * N + n0 + (lane & 31)]; if (kscale) v *= kscale[k0 + kk]; scr[kk * 33 + (lane & 31)] = v; }
    LDS_WAIT(); asm volatile("" ::: "memory");
    const int c = lane & 7;
#pragma unroll
    for (int j = 0; j < 4; ++j) { const int n = (lane >> 3) + 8 * j; const LAS float* s = scr + (8 * c) * 33 + n;
        v4u o; o.x = pk2(s[0 * 33], s[1 * 33]); o.y = pk2(s[2 * 33], s[3 * 33]); o.z = pk2(s[4 * 33], s[5 * 33]); o.w = pk2(s[6 * 33], s[7 * 33]);
        *(GAS v4u*)(WT + (size_t)(dst_row0 + n) * dpitch + koff + k0 + 8 * c) = o; }
    LDS_WAIT(); asm volatile("" ::: "memory");
}
__device__ __forceinline__ int perm_in(int s) { if (s < 512) return 256 * (s >> 7) + (s & 127); if (s < 1024) { const int s2 = s - 512; return 256 * (s2 >> 7) + 128 + (s2 & 127); } return s; }
__device__ __forceinline__ float wave_max(float v) {
#pragma unroll
    for (int o = 1; o < 64; o <<= 1) v = fmaxf(v, __shfl_xor(v, o));
    return v;
}
template <bool NORM, int NR> __device__ __forceinline__ void rows_to_bf16(int lane, const float* xrow, size_t rstride, const float* g, bf16* orow) {
    f32x4 v[NR][4]; float s2[NR];
#pragma unroll
    for (int q = 0; q < NR; ++q) { const GAS f32x4* xr = (const GAS f32x4*)(xrow + q * rstride) + lane;
#pragma unroll
        for (int j = 0; j < 4; ++j) v[q][j] = xr[64 * j]; }
#pragma unroll
    for (int q = 0; q < NR; ++q) { s2[q] = 0.f;
#pragma unroll
        for (int j = 0; j < 4; ++j) s2[q] += (v[q][j].x * v[q][j].x + v[q][j].y * v[q][j].y) + (v[q][j].z * v[q][j].z + v[q][j].w * v[q][j].w); }
    float rstd[NR];
#pragma unroll
    for (int q = 0; q < NR; ++q) rstd[q] = NORM ? 1.f / sqrtf(wave_sum(s2[q]) * (1.f / 1024.f) + NORM_EPS) : 1.f;
#pragma unroll
    for (int j = 0; j < 4; ++j) { f32x4 gv = (f32x4){1.f, 1.f, 1.f, 1.f}; if (g) gv = *((const GAS f32x4*)g + lane + 64 * j);
#pragma unroll
        for (int q = 0; q < NR; ++q) { const f32x4 w = v[q][j] * rstd[q] * gv;
            ((GAS unsigned long long*)(orow + q * rstride) + lane)[64 * j] = (unsigned long long)pk2(w.x, w.y) | ((unsigned long long)pk2(w.z, w.w) << 32); } }
}
template <bool NORM> __device__ __forceinline__ void row_to_bf16(int lane, const float* xrow, const float* g, bf16* orow) { rows_to_bf16<NORM, 1>(lane, xrow, 1024, g, orow); }
template <bool SLICED> __device__ __forceinline__ void row_to_fp8(int lane, const float* xrow, const float* g, unsigned char* base, int row, float* isc) {
    const GAS f32x4* xr = (const GAS f32x4*)xrow + lane;
    f32x4 v[4]; float am = 0.f;
#pragma unroll
    for (int j = 0; j < 4; ++j) { v[j] = xr[64 * j]; if (g) v[j] = v[j] * *((const GAS f32x4*)g + lane + 64 * j);
        am = fmaxf(am, fmaxf(fmaxf(fabsf(v[j].x), fabsf(v[j].y)), fmaxf(fabsf(v[j].z), fabsf(v[j].w)))); }
#pragma unroll
    for (int o = 1; o < 64; o <<= 1) am = fmaxf(am, __shfl_xor(am, o));
    const float sc = am > 0.f ? 240.f / am : 1.f;
    if (lane == 0) isc[row] = am > 0.f ? am * (1.f / 240.f) : 1.f;
#pragma unroll
    for (int j = 0; j < 4; ++j) { int w = 0; w = __builtin_amdgcn_cvt_pk_fp8_f32(v[j].x * sc, v[j].y * sc, w, false); w = __builtin_amdgcn_cvt_pk_fp8_f32(v[j].z * sc, v[j].w * sc, w, true);
        if (SLICED) *(GAS int*)(base + (size_t)(2 * j + (lane >> 5)) * ((size_t)N_EXP * 128) + (size_t)row * 128 + 4 * (lane & 31)) = w;
        else *(GAS int*)(base + (size_t)row * 1024 + 4 * (lane + 64 * j)) = w; }
}
__device__ __forceinline__ void rows_to_fp8_uv(int lane, const float* urow, const float* vrow, const float* g, unsigned char* ub8, unsigned char* vb8, int row, float* usc, float* vsc) {
    f32x4 u[4], v[4]; float au = 0.f, av = 0.f;
#pragma unroll
    for (int j = 0; j < 4; ++j) { u[j] = ((const GAS f32x4*)urow + lane)[64 * j]; v[j] = ((const GAS f32x4*)vrow + lane)[64 * j]; }
#pragma unroll
    for (int j = 0; j < 4; ++j) { u[j] = u[j] * *((const GAS f32x4*)g + lane + 64 * j);
        au = fmaxf(au, fmaxf(fmaxf(fabsf(u[j].x), fabsf(u[j].y)), fmaxf(fabsf(u[j].z), fabsf(u[j].w))));
        av = fmaxf(av, fmaxf(fmaxf(fabsf(v[j].x), fabsf(v[j].y)), fmaxf(fabsf(v[j].z), fabsf(v[j].w)))); }
#pragma unroll
    for (int o = 1; o < 64; o <<= 1) { au = fmaxf(au, __shfl_xor(au, o)); av = fmaxf(av, __shfl_xor(av, o)); }
    const float su = au > 0.f ? 240.f / au : 1.f, sv = av > 0.f ? 240.f / av : 1.f;
    if (lane == 0) { usc[row] = au > 0.f ? au * (1.f / 240.f) : 1.f; vsc[row] = av > 0.f ? av * (1.f / 240.f) : 1.f; }
#pragma unroll
    for (int j = 0; j < 4; ++j) { int w = 0; w = __builtin_amdgcn_cvt_pk_fp8_f32(u[j].x * su, u[j].y * su, w, false); w = __builtin_amdgcn_cvt_pk_fp8_f32(u[j].z * su, u[j].w * su, w, true);
        *(GAS int*)(ub8 + (size_t)row * 1024 + 4 * (lane + 64 * j)) = w;
        int x = 0; x = __builtin_amdgcn_cvt_pk_fp8_f32(v[j].x * sv, v[j].y * sv, x, false); x = __builtin_amdgcn_cvt_pk_fp8_f32(v[j].z * sv, v[j].w * sv, x, true);
        *(GAS int*)(vb8 + (size_t)(2 * j + (lane >> 5)) * ((size_t)N_EXP * 128) + (size_t)row * 128 + 4 * (lane & 31)) = x; }
}
struct P0Args { const float *x, *g1, *w_in, *w_pw, *w_ao, *w_out, *g2, *w_q, *k1, *k2, *pu, *pv; bf16 *H, *Win, *Wpw, *Wao, *Wout, *Wq, *keys; unsigned char *ub8, *vb8; float *usc, *vsc; };
__device__ __forceinline__ void p0_prologue(Frame& F, const P0Args& a) {
    LAS float* scr = (LAS float*)(F.lds + RING_OFF + F.wave * 16384);
    const int gw = F.vcu * NWAVES + F.wave, NGW = F.G * NWAVES;
    constexpr int I_IN = 16 * (IN_COLS / 32), I_PW = 8 * 32, I_AO = 8 * 32, I_OUT = 16 * 32, I_Q = 16 * 64;
    constexpr int NITEMS = I_IN + I_PW + I_AO + I_OUT + I_Q;
    for (int it = gw; it < NITEMS; it += NGW) {
        int r = it;
        if (r < I_IN) { const int nb = IN_COLS / 32, kb = r / nb, n0 = 32 * (r % nb); p0_transpose_item(a.w_in, 1024, IN_COLS, a.Win, 64 * kb, n0, perm_in(n0), nullptr, scr, F.lane); continue; } r -= I_IN;
        if (r < I_PW) { const int kb = r / 32, n0 = 32 * (r % 32); p0_transpose_item(a.w_pw, 512, 1024, a.Wpw, 64 * kb, n0, n0, nullptr, scr, F.lane, 1024, 0); continue; } r -= I_PW;
        if (r < I_AO) { const int kb = r / 32, n0 = 32 * (r % 32); p0_transpose_item(a.w_ao, 512, 1024, a.Wpw, 64 * kb, n0, n0, nullptr, scr, F.lane, 1024, 512); continue; }   r -= I_AO;
        if (r < I_OUT) { const int kb = r / 32, n0 = 32 * (r % 32); p0_transpose_item(a.w_out, 1024, 1024, a.Wout, 64 * kb, n0, n0, nullptr, scr, F.lane); continue; } r -= I_OUT;
        { const int kb = r / 64, n0 = 32 * (r % 64); p0_transpose_item(a.w_q, 1024, 2048, a.Wq, 64 * kb, n0, n0, a.g2, scr, F.lane); }
    }
    for (int m = 4 * gw; m < TOK; m += 4 * NGW) rows_to_bf16<true, 4>(F.lane, a.x + (size_t)m * 1024, 1024, a.g1, a.H + (size_t)m * 1024);
    for (int m = gw; m < N_EXP; m += NGW) rows_to_fp8_uv(F.lane, a.pu + (size_t)m * 1024, a.pv + (size_t)m * 1024, a.g2, a.ub8, a.vb8, m, a.usc, a.vsc);
    for (int m = gw; m < 32; m += NGW) { const float* src = (m < 16 ? a.k1 : a.k2) + (size_t)(m & 15) * 1024; row_to_bf16<false>(F.lane, src, nullptr, a.keys + (size_t)m * 1024); }
}

struct ConvArgs { const bf16* zglu; const float *cw, *cb, *lg, *lb; bf16* cact; };
__device__ __forceinline__ void conv_phase(Frame& F, const ConvArgs& a) {
    LAS unsigned char* zs = F.lds + RING_OFF;
    LAS float* part = (LAS float*)(F.lds + RING_OFF + 98304);
    int tid_ = F.tid; asm volatile("" : "+v"(tid_));
    const int cp = tid_ & 255, half = tid_ >> 8, c0 = 2 * cp;
    float w0[CONV_W], w1[CONV_W];
    { const GAS float* p = (const GAS float*)(a.cw + c0);
#pragma unroll
      for (int w = 0; w < CONV_W; ++w) { w0[w] = p[0]; w1[w] = p[1]; p += 512; asm volatile("" : "+v"(p)); } }
    const float b0 = a.cb[c0], b1 = a.cb[c0 + 1], lg0 = a.lg[c0], lg1 = a.lg[c0 + 1], lb0 = a.lb[c0], lb1 = a.lb[c0 + 1];
    for (int tile = F.vcu; tile < TOK / 64; tile += F.G) {
        const int t0 = tile * 64, tb = t0 & (SEQ - 1);
#pragma unroll
        for (int hb = 0; hb < 2; ++hb) { v4u zv[6];
#pragma unroll
          for (int q = 0; q < 6; ++q) { const int i = tid_ + 512 * (6 * hb + q), r = i >> 6, ch = i & 63; zv[q] = (v4u){0u, 0u, 0u, 0u};
              if (i < 94 * 64 && tb - 30 + r >= 0) zv[q] = *(const GAS v4u*)(a.zglu + (size_t)(t0 - 30 + r) * 512 + ch * 8); }
#pragma unroll
          for (int q = 0; q < 6; ++q) { const int i = tid_ + 512 * (6 * hb + q), r = i >> 6, ch = i & 63; if (i < 94 * 64) *(LAS v4u*)(zs + r * 1024 + ch * 16) = zv[q]; } }
        __syncthreads();
        for (int ch8 = 0; ch8 < 4; ++ch8) {
            const int tl = half * 32 + ch8 * 8;
            float z0[38], z1[38];
#pragma unroll
            for (int i = 0; i < 38; ++i) { const unsigned u = *(const LAS unsigned*)(zs + (tl + i) * 1024 + cp * 4); z0[i] = bflo(u); z1[i] = bfhi(u); }
            float a0[8], a1[8];
#pragma unroll
            for (int k = 0; k < 8; ++k) { float s0 = b0, s1 = b1;
#pragma unroll
                for (int w = 0; w < CONV_W; ++w) { s0 += w0[w] * z0[k + w]; s1 += w1[w] * z1[k + w]; }
                a0[k] = s0; a1[k] = s1; }
#pragma unroll
            for (int k = 0; k < 8; ++k) { const float s1 = wave_sum_hi(a0[k] + a1[k]), s2 = wave_sum_hi(a0[k] * a0[k] + a1[k] * a1[k]);
                if (F.lane == 63) { part[((half * 8 + k) * 4 + (F.wave & 3)) * 2] = s1; part[((half * 8 + k) * 4 + (F.wave & 3)) * 2 + 1] = s2; } }
            __syncthreads();
            bf16* op = a.cact + (size_t)(t0 + tl) * 1024 + c0;
#pragma unroll
            for (int k = 0; k < 8; ++k) { const LAS float* p = part + (half * 8 + k) * 8;
                const float S1 = (p[0] + p[2]) + (p[4] + p[6]), S2 = (p[1] + p[3]) + (p[5] + p[7]);
                const float mean = S1 * (1.f / 512.f), var = S2 * (1.f / 512.f) - mean * mean, rstd = __builtin_amdgcn_rsqf(var + NORM_EPS);
                const float y0 = (a0[k] - mean) * rstd * lg0 + lb0, y1 = (a1[k] - mean) * rstd * lg1 + lb1;
                const float o0 = y0 * __builtin_amdgcn_rcpf(1.f + __builtin_amdgcn_exp2f(-1.4426950408889634f * y0)), o1 = y1 * __builtin_amdgcn_rcpf(1.f + __builtin_amdgcn_exp2f(-1.4426950408889634f * y1));
                *(GAS unsigned*)(op + k * 1024) = pk2(o0, o1); }
            __syncthreads();
        }
    }
}

__device__ __forceinline__ int tokey(float v) { const int b = __float_as_int(v); return b ^ ((b >> 31) & 0x7fffffff); }
__device__ __forceinline__ float unkey(int k, int mask) { const int t = k & ~mask; return __int_as_float(t ^ ((t >> 31) & 0x7fffffff)); }
__device__ __forceinline__ void ce_desc(int& a, int& b) { const int hi = a > b ? a : b, lo = a > b ? b : a; a = hi; b = lo; }
template <int N> __device__ __forceinline__ void sort_desc(int (&v)[N]) {
#pragma unroll
    for (int k = 2; k <= N; k <<= 1)
#pragma unroll
        for (int j = k >> 1; j > 0; j >>= 1)
#pragma unroll
            for (int i = 0; i < N; ++i) { const int l = i ^ j; if (l > i) { if ((i & k) == 0) ce_desc(v[i], v[l]); else ce_desc(v[l], v[i]); } }
}
__device__ __forceinline__ void bitonic_merge16_desc(int (&v)[16]) {
#pragma unroll
    for (int j = 8; j > 0; j >>= 1)
#pragma unroll
        for (int i = 0; i < 16; ++i) { const int l = i ^ j; if (l > i) ce_desc(v[i], v[l]); }
}
__device__ __forceinline__ void merge_top16(int (&a)[16], const int (&b)[16]) {
#pragma unroll
    for (int i = 0; i < 16; ++i) a[i] = a[i] > b[15 - i] ? a[i] : b[15 - i];
    bitonic_merge16_desc(a);
}
__device__ __forceinline__ void top16_of_64(const int (&x)[64], int (&out)[16]) {
    int g[16];
#pragma unroll
    for (int i = 0; i < 16; ++i) out[i] = x[i];
    sort_desc<16>(out);
#pragma unroll
    for (int q = 1; q < 4; ++q) {
#pragma unroll
        for (int i = 0; i < 16; ++i) g[i] = x[16 * q + i];
        sort_desc<16>(g); merge_top16(out, g); }
}
__device__ __forceinline__ int crow_(int r, int hi) { return (r & 3) + 8 * (r >> 2) + 4 * hi; }
struct SelArgs { const bf16* qp; const bf16* keys; const float* ss; const float* usc; const float* vsc; int* eidx; float* ga; float* gb; const bf16* x1b; unsigned char* x8; float* xs; };
__device__ __forceinline__ void peer_select_phase(Frame& F, const SelArgs& a) {
    for (int i = F.tid; i < 2 * 128 * 16; i += 512) { const int which = i >> 11, rem = i & 2047, row = rem >> 4, ch = rem & 15;
        const v4u v = *(const GAS v4u*)(a.keys + (size_t)which * 16384 + row * 128 + ch * 8);
        *(LAS v4u*)(F.lds + RING_OFF + which * 32768 + row * 256 + ((ch ^ (row & 15)) << 4)) = v; }
    __syncthreads();
    LAS int* scr = (LAS int*)(F.lds + RING_OFF + 65536 + F.wave * 4096);
    const int lane = F.lane, tl = lane & 31, hi = lane >> 5;
    const int gw = F.vcu * NWAVES + F.wave, NGW = F.G * NWAVES;
    constexpr int NUNITS = (TOK / 32) * P_HEADS;
    constexpr int PA[50] = {0,0,0,0,0,0,0,0,0,0,0,0,0,0,0,0, 1,1,1,1,1,1,1,1, 2,2,2,2,2, 3,3,3,3, 4,4,4, 5,5, 6,6, 7,7, 8,9,10,11,12,13,14,15};
    constexpr int PB[50] = {0,1,2,3,4,5,6,7,8,9,10,11,12,13,14,15, 0,1,2,3,4,5,6,7, 0,1,2,3,4, 0,1,2,3, 0,1,2, 0,1, 0,1, 0,1, 0,0,0,0,0,0,0,0};
    for (int unit = gw; unit < NUNITS; unit += NGW) {
        const int tt = unit >> 3, hh = unit & 7, t = tt * 32 + tl;
        int vk[2][16];
#pragma unroll
        for (int half = 0; half < 2; ++half) {
            const bf16* qrow = a.qp + (size_t)t * 2048 + hh * 256 + half * 128 + hi * 8;
            bf16x8 bq[8];
#pragma unroll
            for (int ks = 0; ks < 8; ++ks) bq[ks] = *(const GAS bf16x8*)(qrow + ks * 16);
            f32x16 acc[4];
#pragma unroll
            for (int nb = 0; nb < 4; ++nb) { acc[nb] = (f32x16){};
#pragma unroll
                for (int ks = 0; ks < 8; ++ks) { const int row = nb * 32 + tl, ch = 2 * ks + hi;
                    const bf16x8 ka = *(const LAS bf16x8*)(F.lds + RING_OFF + half * 32768 + row * 256 + ((ch ^ (row & 15)) << 4));
                    acc[nb] = __builtin_amdgcn_mfma_f32_32x32x16_bf16(ka, bq[ks], acc[nb], 0, 0, 0); } }
            int keys[64];
#pragma unroll
            for (int nb = 0; nb < 4; ++nb)
#pragma unroll
                for (int r = 0; r < 16; ++r) keys[nb * 16 + r] = (tokey(acc[nb][r]) & ~127) | (nb * 32 + crow_(r, hi));
            int top[16]; top16_of_64(keys, top);
            int oth[16];
#pragma unroll
            for (int i = 0; i < 16; ++i) oth[i] = __shfl_xor(top[i], 32);
            merge_top16(top, oth);
#pragma unroll
            for (int i = 0; i < 16; ++i) vk[half][i] = top[i];
        }
        float f1[16], f2[16];
#pragma unroll
        for (int i = 0; i < 16; ++i) { f1[i] = unkey(vk[0][i], 127); f2[i] = unkey(vk[1][i], 127); }
        int ck[64];
#pragma unroll
        for (int i = 0; i < 50; ++i) ck[i] = (tokey(f1[PA[i]] + f2[PB[i]]) & ~255) | (PA[i] * 16 + PB[i]);
#pragma unroll
        for (int i = 50; i < 64; ++i) ck[i] = (int)0x80000000;
        int c[16]; top16_of_64(ck, c);
        if (hi == 0) {
#pragma unroll
            for (int i = 0; i < 16; ++i) { scr[tl * 32 + i] = vk[0][i] & 127; scr[tl * 32 + 16 + i] = vk[1][i] & 127; } }
        float ssum = 0.f;
        { const GAS f32x4* sp = (const GAS f32x4*)(a.ss + (size_t)t * 16);
#pragma unroll
          for (int i = 0; i < 4; ++i) { const f32x4 v = sp[i]; ssum += (v.x + v.y) + (v.z + v.w); } }
        const float rstd = 1.f / sqrtf(ssum * (1.f / 1024.f) + NORM_EPS);
        const float smax = unkey(c[0], 255);
        float e[16], esum = 0.f;
#pragma unroll
        for (int i = 0; i < 16; ++i) { e[i] = __expf((unkey(c[i], 255) - smax) * rstd); esum += e[i]; }
        const float inv = 1.f / esum;
        LDS_WAIT(); asm volatile("" ::: "memory");
        int eo[8]; float go[8];
#pragma unroll
        for (int i = 0; i < 8; ++i) { const int ci = hi ? c[i + 8] : c[i]; const float ei = hi ? e[i + 8] : e[i];
            const int id = ci & 255, i1 = scr[tl * 32 + (id >> 4)], i2 = scr[tl * 32 + 16 + (id & 15)];
            eo[i] = i1 * P_NK + i2; go[i] = ei * inv; }
        float ua[8];
#pragma unroll
        for (int i = 0; i < 8; ++i) { ua[i] = a.usc[eo[i]]; go[i] *= a.vsc[eo[i]]; }
        int* ep = a.eidx + (size_t)t * P_E + hh * 16 + hi * 8; float* gp = a.gb + (size_t)t * P_E + hh * 16 + hi * 8; float* up_ = a.ga + (size_t)t * P_E + hh * 16 + hi * 8;
        *(GAS f32x4*)(up_) = (f32x4){ua[0], ua[1], ua[2], ua[3]}; *(GAS f32x4*)(up_ + 4) = (f32x4){ua[4], ua[5], ua[6], ua[7]};
        *(GAS v4u*)(ep) = (v4u){(unsigned)eo[0], (unsigned)eo[1], (unsigned)eo[2], (unsigned)eo[3]}; *(GAS v4u*)(ep + 4) = (v4u){(unsigned)eo[4], (unsigned)eo[5], (unsigned)eo[6], (unsigned)eo[7]};
        *(GAS f32x4*)(gp) = (f32x4){go[0], go[1], go[2], go[3]}; *(GAS f32x4*)(gp + 4) = (f32x4){go[4], go[5], go[6], go[7]};
        LDS_WAIT(); asm volatile("" ::: "memory");
    }
}

__device__ __forceinline__ void peer_rows_fp8(Frame& F, const SelArgs& a) {
    const int gw = F.vcu * NWAVES + F.wave, NGW = F.G * NWAVES, lane = F.lane;
    for (int t = gw; t < TOK; t += NGW) {
        const GAS v4u* xp = (const GAS v4u*)(a.x1b + (size_t)t * 1024 + 16 * lane); const v4u xa = xp[0], xb = xp[1];
        const float xf[16] = {bflo(xa.x), bfhi(xa.x), bflo(xa.y), bfhi(xa.y), bflo(xa.z), bfhi(xa.z), bflo(xa.w), bfhi(xa.w), bflo(xb.x), bfhi(xb.x), bflo(xb.y), bfhi(xb.y), bflo(xb.z), bfhi(xb.z), bflo(xb.w), bfhi(xb.w)};
        float am = 0.f;
#pragma unroll
        for (int i = 0; i < 16; ++i) am = fmaxf(am, fabsf(xf[i]));
#pragma unroll
        for (int o = 1; o < 64; o <<= 1) am = fmaxf(am, __shfl_xor(am, o));
        const float xsc = am > 0.f ? 240.f / am : 1.f, xinv = am > 0.f ? am * (1.f / 240.f) : 1.f;
        v4u o;
        { int w = 0; w = __builtin_amdgcn_cvt_pk_fp8_f32(xf[0] * xsc, xf[1] * xsc, w, false); w = __builtin_amdgcn_cvt_pk_fp8_f32(xf[2] * xsc, xf[3] * xsc, w, true); o.x = (unsigned)w; }
        { int w = 0; w = __builtin_amdgcn_cvt_pk_fp8_f32(xf[4] * xsc, xf[5] * xsc, w, false); w = __builtin_amdgcn_cvt_pk_fp8_f32(xf[6] * xsc, xf[7] * xsc, w, true); o.y = (unsigned)w; }
        { int w = 0; w = __builtin_amdgcn_cvt_pk_fp8_f32(xf[8] * xsc, xf[9] * xsc, w, false); w = __builtin_amdgcn_cvt_pk_fp8_f32(xf[10] * xsc, xf[11] * xsc, w, true); o.z = (unsigned)w; }
        { int w = 0; w = __builtin_amdgcn_cvt_pk_fp8_f32(xf[12] * xsc, xf[13] * xsc, w, false); w = __builtin_amdgcn_cvt_pk_fp8_f32(xf[14] * xsc, xf[15] * xsc, w, true); o.w = (unsigned)w; }
        *(GAS v4u*)(a.x8 + (size_t)t * 1024 + 16 * lane) = o;
        const float ssum = wave_sum(lane < 16 ? a.ss[(size_t)t * 16 + lane] : 0.f);
        if (lane == 0) a.xs[t] = xinv / sqrtf(ssum * (1.f / 1024.f) + NORM_EPS);
    }
}

typedef float f32x2_t __attribute__((ext_vector_type(2)));
struct ExpA { const unsigned char* x8; const float* xs; const unsigned char* ub8; const int* eidx; const float* ga; const float* gb; unsigned char* coef8; };
__device__ __forceinline__ float row_sum16(float v) {
    v += __builtin_bit_cast(float, __builtin_amdgcn_update_dpp(0, __builtin_bit_cast(int, v), 0xB1, 0xf, 0xf, false));
    v += __builtin_bit_cast(float, __builtin_amdgcn_update_dpp(0, __builtin_bit_cast(int, v), 0x4E, 0xf, 0xf, false));
    v += __builtin_bit_cast(float, __builtin_amdgcn_update_dpp(0, __builtin_bit_cast(int, v), 0x141, 0xf, 0xf, false));
    v += __builtin_bit_cast(float, __builtin_amdgcn_update_dpp(0, __builtin_bit_cast(int, v), 0x140, 0xf, 0xf, false));
    return v;
}
__device__ __forceinline__ float gelu_as(float v) {
    const float av = fabsf(v), t = __builtin_amdgcn_rcpf(av * 0.2316418882f + 1.0f);
    float q = t * 0.5307027145f + (-0.7265760135f); q = q * t + 0.7107068705f; q = q * t + (-0.142248368f); q = q * t + 0.127414796f; q = q * t;
    const float m = v * (q * __builtin_amdgcn_exp2f((v * v) * (-0.72134752044f)));
    return v < 0.f ? m : v - m;
}
__device__ __forceinline__ float wave_sum_diag(float v) {
    v = row_sum16(v);
    v += __builtin_bit_cast(float, __builtin_amdgcn_update_dpp(0, __builtin_bit_cast(int, v), 0x142, 0xA, 0xF, false));
    v += __builtin_bit_cast(float, __builtin_amdgcn_update_dpp(0, __builtin_bit_cast(int, v), 0x143, 0xC, 0xF, false));
    return v;
}
__device__ __forceinline__ int wg_grab(LAS int* c, const int lane) {
    int v = 0; if (lane == 0) v = __hip_atomic_fetch_add(c, 1, __ATOMIC_RELAXED, __HIP_MEMORY_SCOPE_WORKGROUP);
    return __builtin_amdgcn_readfirstlane(v);
}
__device__ __forceinline__ void peer_u_phase(Frame& F, const ExpA& a, const int s, const int tfirst, const int step, LAS int* cnt) {
    const int lane = F.lane;
    LAS int* lstA = (LAS int*)(F.lds + RING_OFF + F.wave * 4096); LAS int* lstB = lstA + 512;
    lstA[lane] = 0; lstA[64 + lane] = 0; lstB[lane] = 0; lstB[64 + lane] = 0;
    const bool diag = ((lane & 15) >> 2) == (lane >> 4); const int dsel = lane & 3;
    const bool b3 = (lane & 8) != 0; const int usel = ((lane >> 5) & 1) * 4 + ((lane >> 4) & 1) * 2 + ((lane >> 3) & 1);
    if (tfirst >= TOK) return;
    struct Raw { v4u x; int e0, e1; float fa0, fa1, fb0, fb1, xs; };
#if defined(ABL_HOTROWS)
#define ABL_ROW(e) (((e) & ~2047) | ((e) & 63))
#else
#define ABL_ROW(e) (e)
#endif
#define PU_RAW(R, T) do { const int tt_ = (T) < TOK ? (T) : tfirst; R.x = *(const GAS v4u*)(a.x8 + (size_t)tt_ * 1024 + 16 * lane); \
        R.e0 = a.eidx[(size_t)tt_ * P_E + lane]; R.e1 = a.eidx[(size_t)tt_ * P_E + 64 + lane]; R.fa0 = a.ga[(size_t)tt_ * P_E + lane]; R.fa1 = a.ga[(size_t)tt_ * P_E + 64 + lane]; \
        R.fb0 = a.gb[(size_t)tt_ * P_E + lane]; R.fb1 = a.gb[(size_t)tt_ * P_E + 64 + lane]; R.xs = a.xs[tt_]; } while (0)
#define PU_PREP(R, LST, XLO, XHI, N, VALID) do { \
        XLO = (long)(((unsigned long long)R.x.y << 32) | R.x.x); XHI = (long)(((unsigned long long)R.x.w << 32) | R.x.z); \
        const bool in0_ = (VALID) && (R.e0 >> 11) == s, in1_ = (VALID) && (R.e1 >> 11) == s; \
        const unsigned long long m0_ = __ballot(in0_), m1_ = __ballot(in1_), lt_ = (1ull << lane) - 1ull; \
        const int n0_ = __popcll(m0_); N = n0_ + __popcll(m1_); \
        LAS float* lsa_ = (LAS float*)(LST + 128); LAS float* lsb_ = (LAS float*)(LST + 256); \
        if (in0_) { const int p = __popcll(m0_ & lt_); LST[p] = lane | (R.e0 << 8); lsa_[p] = R.fa0 * R.xs; lsb_[p] = R.fb0; } \
        if (in1_) { const int p = n0_ + __popcll(m1_ & lt_); LST[p] = (64 + lane) | (R.e1 << 8); lsa_[p] = R.fa1 * R.xs; lsb_[p] = R.fb1; } } while (0)
#define PU_LOAD(W, LST, K0) do { _Pragma("unroll") for (int u = 0; u < 8; ++u) { const int ent_ = LST[((K0) + u) & 127]; W[u] = *(const GAS v4u*)(a.ub8 + (size_t)ABL_ROW(ent_ >> 8) * 1024 + 16 * lane); } } while (0)
#define PU_COMP(W, LST, XLO, XHI, N, T, K0) do { float d[8]; \
            _Pragma("unroll") for (int u = 0; u < 8; ++u) { f32x4 acc = {0.f, 0.f, 0.f, 0.f}; \
                acc = __builtin_amdgcn_mfma_f32_16x16x32_fp8_fp8((long)(((unsigned long long)W[u].y << 32) | W[u].x), XLO, acc, 0, 0, 0); \
                acc = __builtin_amdgcn_mfma_f32_16x16x32_fp8_fp8((long)(((unsigned long long)W[u].w << 32) | W[u].z), XHI, acc, 0, 0, 0); \
                const float v01 = (dsel & 1) ? acc[1] : acc[0], v23 = (dsel & 1) ? acc[3] : acc[2]; \
                d[u] = diag ? ((dsel & 2) ? v23 : v01) : 0.f; } \
            float z_[4], w_[2]; \
            _Pragma("unroll") for (int i = 0; i < 4; ++i) { const auto rr = __builtin_amdgcn_permlane32_swap(__float_as_uint(d[i]), __float_as_uint(d[i + 4]), false, false); z_[i] = __uint_as_float(rr[0]) + __uint_as_float(rr[1]); } \
            _Pragma("unroll") for (int i = 0; i < 2; ++i) { const auto rr = __builtin_amdgcn_permlane16_swap(__float_as_uint(z_[i]), __float_as_uint(z_[i + 2]), false, false); w_[i] = __uint_as_float(rr[0]) + __uint_as_float(rr[1]); } \
            float du = (b3 ? w_[1] : w_[0]) + __builtin_bit_cast(float, __builtin_amdgcn_update_dpp(0, __builtin_bit_cast(int, b3 ? w_[0] : w_[1]), 0x128, 0xf, 0xf, false)); \
            du += __builtin_bit_cast(float, __builtin_amdgcn_update_dpp(0, __builtin_bit_cast(int, du), 0xB1, 0xf, 0xf, false)); \
            du += __builtin_bit_cast(float, __builtin_amdgcn_update_dpp(0, __builtin_bit_cast(int, du), 0x4E, 0xf, 0xf, false)); \
            du += __builtin_bit_cast(float, __builtin_amdgcn_update_dpp(0, __builtin_bit_cast(int, du), 0x141, 0xf, 0xf, false)); \
            const int ku = (K0) + usel; \
            if ((lane & 7) == 0 && ku < N) { const int slot = LST[ku] & 255; const float cf_ = C8_SCALE * ((LAS float*)(LST + 256))[ku] * gelu_as(du * ((LAS float*)(LST + 128))[ku]); \
                a.coef8[(size_t)(T) * P_E + slot] = (unsigned char)__builtin_amdgcn_cvt_pk_fp8_f32(fminf(fmaxf(cf_, -448.f), 448.f), 0.f, 0, false); } } while (0)
    Raw rA, rB;
    const int ntok = (TOK - tfirst + step - 1) / step, npair = (ntok + 1) >> 1;
#define PU_TOK(i) ((i) < ntok ? tfirst + (i) * step : TOK)
    int p = wg_grab(cnt, lane);
    if (p >= npair) return;
    PU_RAW(rA, PU_TOK(2 * p)); PU_RAW(rB, PU_TOK(2 * p + 1));
    while (p < npair) {
        const int pn = wg_grab(cnt, lane);
        const int tA = PU_TOK(2 * p), tB = PU_TOK(2 * p + 1); const bool vB = tB < TOK;
        long xloA, xhiA, xloB, xhiB; int nA, nB;
        PU_PREP(rA, lstA, xloA, xhiA, nA, true);
        PU_PREP(rB, lstB, xloB, xhiB, nB, vB);
        LDS_WAIT(); asm volatile("" ::: "memory");
        v4u wA0[8], wA1[8], wB0[8], wB1[8];
        PU_LOAD(wA0, lstA, 0); PU_LOAD(wB0, lstB, 0); PU_LOAD(wA1, lstA, 8); PU_LOAD(wB1, lstB, 8);
        PU_RAW(rA, PU_TOK(2 * pn)); PU_RAW(rB, PU_TOK(2 * pn + 1));
        PU_COMP(wA0, lstA, xloA, xhiA, nA, tA, 0);
        if (nA > 16) PU_LOAD(wA0, lstA, 16);
        PU_COMP(wB0, lstB, xloB, xhiB, nB, tB, 0);
        if (nB > 16) PU_LOAD(wB0, lstB, 16);
        PU_COMP(wA1, lstA, xloA, xhiA, nA, tA, 8);
        PU_COMP(wB1, lstB, xloB, xhiB, nB, tB, 8);
        if (nA > 16) PU_COMP(wA0, lstA, xloA, xhiA, nA, tA, 16);
        if (nB > 16) PU_COMP(wB0, lstB, xloB, xhiB, nB, tB, 16);
        for (int k0 = 24; k0 < nA; k0 += 8) { PU_LOAD(wA1, lstA, k0); PU_COMP(wA1, lstA, xloA, xhiA, nA, tA, k0); }
        for (int k0 = 24; k0 < nB; k0 += 8) { PU_LOAD(wB1, lstB, k0); PU_COMP(wB1, lstB, xloB, xhiB, nB, tB, k0); }
        LDS_WAIT(); asm volatile("" ::: "memory");
        p = pn;
    }
#undef PU_TOK
#undef PU_RAW
#undef PU_PREP
#undef PU_LOAD
#undef PU_COMP
}
struct ExpB { float* xio; const bf16* x1b; const unsigned char* vb8; const int* eidx; const unsigned char* coef8; float* ss2; };
typedef int v2i_t __attribute__((ext_vector_type(2)));
__device__ __forceinline__ void peer_v_phase(Frame& F, const ExpB& a, const int s, const int t0, const int step, LAS int* cnt) {
    const int lane = F.lane, g = lane >> 3, j = lane & 7, q = lane >> 4, jn = lane & 15;
    const GAS unsigned char* vs = (const GAS unsigned char*)a.vb8 + (size_t)s * ((size_t)N_EXP * 128); const unsigned j16 = 16u * (unsigned)j;
    if (t0 >= TOK) return;
    LAS unsigned char* tile = F.lds + (F.wave < 7 ? F.wave * VT_BYTES : VT_LAST_OFF);
    LAS unsigned char* wbase = tile + g * (16 * VT_PITCH) + 16 * j;
    LAS unsigned char* rbase = tile + (32 * q + (jn >> 1)) * VT_PITCH + 8 * (jn & 1);
    const int chA = 128 * s + 32 * q + jn;
    const bool q1 = (q & 1) != 0, q2 = (q & 2) != 0;
#define PV_LDE(E, T) do { const int tt_ = (T) < TOK ? (T) : t0; const GAS v4u* ep_ = (const GAS v4u*)(a.eidx + (size_t)tt_ * P_E + 16 * g); \
        _Pragma("unroll") for (int k4 = 0; k4 < 4; ++k4) { const v4u ev = ep_[k4]; E[4 * k4] = (int)ev.x; E[4 * k4 + 1] = (int)ev.y; E[4 * k4 + 2] = (int)ev.z; E[4 * k4 + 3] = (int)ev.w; } } while (0)
#define PV_ROWS(W, E, C8, XA, XB, T) do { const int tt_ = (T) < TOK ? (T) : t0; _Pragma("unroll") for (int k = 0; k < 16; ++k) W[k] = *(const GAS v4u*)(vs + (((unsigned)E[k] << 7) | j16)); \
        { const GAS v4u* cp_ = (const GAS v4u*)(a.coef8 + (size_t)tt_ * P_E + 32 * q); C8[0] = cp_[0]; C8[1] = cp_[1]; } \
        { const GAS bf16* xp_ = (const GAS bf16*)(a.x1b + (size_t)tt_ * 1024 + chA); XA = xp_[0]; XB = xp_[16]; } } while (0)
#define PV_COMP(W, C8, XA, XB, T) do { \
        _Pragma("unroll") for (int k = 0; k < 16; ++k) *(LAS v4u*)(wbase + k * VT_PITCH) = W[k]; \
        f32x4 acc[8]; \
        _Pragma("unroll") for (int ct = 0; ct < 8; ++ct) acc[ct] = (f32x4){0.f, 0.f, 0.f, 0.f}; \
        const unsigned cw[8] = {C8[0].x, C8[0].y, C8[0].z, C8[0].w, C8[1].x, C8[1].y, C8[1].z, C8[1].w}; \
        _Pragma("unroll") for (int ks = 0; ks < 4; ++ks) { const long av = (long)(((unsigned long long)cw[2 * ks + 1] << 32) | cw[2 * ks]); \
            _Pragma("unroll") for (int ct = 0; ct < 8; ++ct) { const v2i_t bt = __builtin_amdgcn_ds_read_tr8_b64_v2i32((LAS v2i_t*)(rbase + ks * (8 * VT_PITCH) + 16 * ct)); \
                acc[ct] = __builtin_amdgcn_mfma_f32_16x16x32_fp8_fp8(av, (long)(((unsigned long long)(unsigned)bt.y << 32) | (unsigned)bt.x), acc[ct], 0, 0, 0); } } \
        const float ya = q2 ? (q1 ? acc[6][0] : acc[4][0]) : (q1 ? acc[2][0] : acc[0][0]), yb = q2 ? (q1 ? acc[7][0] : acc[5][0]) : (q1 ? acc[3][0] : acc[1][0]); \
        const float oa = bflo((unsigned)XA) + ya * (1.f / C8_SCALE), ob = bflo((unsigned)XB) + yb * (1.f / C8_SCALE); \
        a.xio[(size_t)(T) * 1024 + chA] = oa; a.xio[(size_t)(T) * 1024 + chA + 16] = ob; \
        float sq = row_sum16(oa * oa + ob * ob); \
        sq += __shfl_xor(sq, 16); sq += __shfl_xor(sq, 32); \
        if (lane == 0) a.ss2[(size_t)(T) * 8 + s] = sq; } while (0)
    int e1[16], e2[16]; v4u wA[16], wB[16], c8A[2], c8B[2]; bf16 xaA, xbA, xaB, xbB;
    const int ntok = (TOK - t0 + step - 1) / step;
#define PV_TOK(i) ((i) < ntok ? t0 + (i) * step : TOK)
    int iA = wg_grab(cnt, lane), iB = wg_grab(cnt, lane);
    if (iA >= ntok) return;
    PV_LDE(e1, PV_TOK(iA));
    PV_LDE(e2, PV_TOK(iB));
    PV_ROWS(wA, e1, c8A, xaA, xbA, PV_TOK(iA));
    for (;;) {
        const int iC = wg_grab(cnt, lane);
        PV_LDE(e1, PV_TOK(iC));
        PV_ROWS(wB, e2, c8B, xaB, xbB, PV_TOK(iB));
        PV_COMP(wA, c8A, xaA, xbA, PV_TOK(iA));
        if (iB >= ntok) break;
        const int iD = wg_grab(cnt, lane);
        PV_LDE(e2, PV_TOK(iD));
        PV_ROWS(wA, e1, c8A, xaA, xbA, PV_TOK(iC));
        PV_COMP(wB, c8B, xaB, xbB, PV_TOK(iB));
        if (iC >= ntok) break;
        iA = iC; iB = iD;
    }
#undef PV_TOK
#undef PV_LDE
#undef PV_ROWS
#undef PV_COMP
}
__device__ __forceinline__ void final_norm_phase(Frame& F, float* xio, const float* ss2, const float* gfinal, const int gw, const int NGW) {
    const int lane = F.lane;
    for (int t = gw; t < TOK; t += NGW) {
        const GAS f32x4* sp = (const GAS f32x4*)(ss2 + (size_t)t * 8); const f32x4 s0 = sp[0], s1 = sp[1];
        const float rstd = 1.f / sqrtf(((s0.x + s0.y) + (s0.z + s0.w) + (s1.x + s1.y) + (s1.z + s1.w)) * (1.f / 1024.f) + NORM_EPS);
        GAS f32x4* xr = (GAS f32x4*)(xio + (size_t)t * 1024) + lane; const GAS f32x4* gf = (const GAS f32x4*)gfinal + lane;
#pragma unroll
        for (int q = 0; q < 4; ++q) xr[64 * q] = xr[64 * q] * rstd * gf[64 * q];
    }
}

struct Args { const float* in[18]; float* out; unsigned char* ws; int ph_lo, ph_hi, li, pad; };
__global__ void __launch_bounds__(NWAVES * 64, 2) fwd_kernel(Args args) {
    extern __shared__ __attribute__((aligned(16))) unsigned char lds[];
    Frame F;
    F.lds = (LAS unsigned char*)lds;
    F.MISC = (volatile LAS unsigned*)(F.lds + MISC_OFF);
    F.tid = threadIdx.x; F.lane = F.tid & 63; F.wave = __builtin_amdgcn_readfirstlane(F.tid >> 6);
    F.G = gridDim.x; { const int bx = blockIdx.x; F.vcu = (F.G % 8 == 0) ? (bx % 8) * (F.G / 8) + bx / 8 : bx; }
    unsigned char* ws = args.ws;
    F.ctl = (gu32*)(ws + WS_CTL);
#define GRID_BAR(seam) do { if (N_LAUNCHES == PER_PHASE) { if (F.tid == 0) __hip_atomic_store(F.ctl + CW_TMO, 0xBADBA0u | (unsigned)(seam), RLX_AGENT); } else { xcd_barrier(bar); } } while (0)
    const float* x = args.in[0];
    bf16* H = (bf16*)(ws + WS_H); bf16* Win = (bf16*)(ws + WS_WIN); bf16* Wpw = (bf16*)(ws + WS_WPW); bf16* Wao = (bf16*)(ws + WS_WAO); bf16* Wout = (bf16*)(ws + WS_WOUT); bf16* Wq = (bf16*)(ws + WS_WQ);
    bf16* KEYS = (bf16*)(ws + WS_KEYS); unsigned char* UB = ws + WS_UB; unsigned char* VB = ws + WS_VB; float* USC = (float*)(ws + WS_USC); float* VSC = (float*)(ws + WS_VSC);
    bf16* ZGLU = (bf16*)(ws + WS_ZGLU); bf16* QO = (bf16*)(ws + WS_QO); bf16* KB = (bf16*)(ws + WS_K); bf16* VBUF = (bf16*)(ws + WS_V); bf16* GC = (bf16*)(ws + WS_GC); bf16* GA = (bf16*)(ws + WS_GATE_A);
    bf16* CACT = (bf16*)(ws + WS_CACT); bf16* MIX = (bf16*)(ws + WS_MIX); bf16* X1B = (bf16*)(ws + WS_X1B); bf16* QP = (bf16*)(ws + WS_QP);
    float* KMEAN = (float*)(ws + WS_KMEAN); float* SS = (float*)(ws + WS_SS); int* EIDX = (int*)(ws + WS_EIDX); float* GW = (float*)(ws + WS_GW);
    for (int u = F.tid; u < (LDS_BYTES - LDSCTL_OFF) / 4; u += NWAVES * 64) ((LAS unsigned*)(F.lds + LDSCTL_OFF))[u] = 0u;
    __syncthreads();
    XcdBarrier bar; bar.bar = (unsigned*)(F.ctl + CW_BAR); bar.x = 0; bar.st = nullptr;
    if (N_LAUNCHES != PER_PHASE) bar = xcd_barrier_post((unsigned*)(F.ctl + CW_BAR), F.MISC + 8);
    const int lo = args.ph_lo, hi = args.ph_hi;
#ifdef TIME_PHASE
    unsigned long long ts_[PER_PHASE + 1]; ts_[0] = __builtin_amdgcn_s_memrealtime();
#define STAMP(k) ts_[(k) + 1] = __builtin_amdgcn_s_memrealtime()
#else
#define STAMP(k) do {} while (0)
#endif
#ifndef PHASE_MASK
#define PHASE_MASK 0xff
#endif
#define IN(k) (((PHASE_MASK >> (k)) & 1) && lo <= (k) && (k) < hi)
#define BOTH(k) (IN(k) && IN((k) + 1))

    if (IN(0)) {
        P0Args a{x, args.in[1], args.in[2], args.in[7], args.in[9], args.in[10], args.in[11], args.in[12], args.in[13], args.in[14], args.in[15], args.in[16], H, Win, Wpw, Wao, Wout, Wq, KEYS, UB, VB, USC, VSC};
        p0_prologue(F, a);
        if (BOTH(0)) GRID_BAR(0);
        STAMP(0);
    }
#ifdef DEBUG_P1_PLAIN
    if (IN(1)) {
        pg8::Gemm g{H, Wq, TOK, 2048, 1024}; pg8::StaticOrder S; S.init(TOK, 2048, F.G, (int)blockIdx.x);
        pg8::EpiStore E{QP, 2048};
        pg8::gemm_phase<pg8::EpiStore, pg8::StaticOrder, true, true>(F.lds + RING_OFF, g, S, E);
    }
#else
    if (IN(1)) {
        pg8::Gemm g{H, Win, TOK, IN_COLS, 1024}; pg8::StaticOrder S; S.init(TOK, IN_COLS, F.G, (int)blockIdx.x);
        pg8::EpiIn E{ZGLU, QO, GC, KMEAN, attn_body::C2, (size_t)(WS_K - WS_QO) / 2, (size_t)(WS_GATE_A - WS_GC) / 2};
        static_assert(WS_V - WS_K == WS_K - WS_QO, "Q|K|V equally spaced");
        pg8::gemm_phase<pg8::EpiIn, pg8::StaticOrder, true, true>(F.lds + RING_OFF, g, S, E);
        if (BOTH(1)) GRID_BAR(1);
        STAMP(1);
    }
#endif
    if (IN(2)) {
        static_assert(attn_body::ATTN_LDS_BYTES <= RING_BYTES && attn_body::ATTN_PITCH == ATT_W, "attention body geometry vs frame");
#ifdef CONV_FIRST
        { const ConvArgs ca{ZGLU, args.in[3], args.in[4], args.in[5], args.in[6], CACT};
          conv_phase(F, ca); }
        __syncthreads();
#ifdef TIME_SPLIT2
        ts_[3] = __builtin_amdgcn_s_memrealtime();
#endif
#endif
        const attn_body::AttnTensors AT{(const attn_body::bf16*)QO, (const attn_body::bf16*)KB, (const attn_body::bf16*)VBUF, (attn_body::bf16*)(CACT + 512), KMEAN};
        const attn_body::StaticOrder S((int)F.G, (int)blockIdx.x);
        attn_body::attn_phase<attn_body::StaticOrder>((char*)lds + RING_OFF, AT, S);
        __syncthreads();
#ifndef CONV_FIRST
        { const ConvArgs ca{ZGLU, args.in[3], args.in[4], args.in[5], args.in[6], CACT};
          conv_phase(F, ca); }
#endif
        if (BOTH(2)) GRID_BAR(2);
#if !(defined(TIME_SPLIT2) && defined(CONV_FIRST))
        STAMP(2);
#endif
    }
    if (IN(3)) {
        { pg8::Gemm g{CACT, Wpw, TOK, 1024, 1024}; pg8::StaticOrder S; S.init(TOK, 1024, F.G, (int)blockIdx.x);
          pg8::EpiMixF E{GC, GA, args.in[8], MIX};
          pg8::gemm_phase<pg8::EpiMixF, pg8::StaticOrder, true, true>(F.lds + RING_OFF, g, S, E); }
        if (BOTH(3)) GRID_BAR(3);
        STAMP(3);
    }
    if (IN(4)) {
        pg8::Gemm g{MIX, Wout, TOK, 1024, 1024}; pg8::StaticOrder S; S.init(TOK, 1024, F.G, (int)blockIdx.x);
        pg8::EpiX1 E{x, args.out, X1B, SS};
        pg8::gemm_phase<pg8::EpiX1, pg8::StaticOrder, true, true>(F.lds + RING_OFF, g, S, E);
        if (BOTH(4)) GRID_BAR(4);
        STAMP(4);
    }
    if (IN(5)) {
        pg8::Gemm g{X1B, Wq, TOK, 2048, 1024}; pg8::StaticOrder S; S.init(TOK, 2048, F.G, (int)blockIdx.x);
        pg8::EpiStore E{QP, 2048};
        pg8::gemm_phase<pg8::EpiStore, pg8::StaticOrder, true, true>(F.lds + RING_OFF, g, S, E);
        if (BOTH(5)) GRID_BAR(5);
        STAMP(5);
    }
    if (IN(6)) {
        const SelArgs sa{QP, KEYS, SS, USC, VSC, EIDX, (float*)(ws + WS_GA), GW, X1B, ws + WS_X8, (float*)(ws + WS_XS)};
        peer_select_phase(F, sa);
        peer_rows_fp8(F, sa);
        if (BOTH(6)) GRID_BAR(6);
        STAMP(6);
    }
    if (IN(7)) {
        LAS int* cnt = (LAS int*)(F.lds + P7_CNT_OFF);
        if (F.tid < 16) cnt[F.tid] = 0;
        __syncthreads();
        const ExpA ea{ws + WS_X8, (const float*)(ws + WS_XS), UB, EIDX, (const float*)(ws + WS_GA), GW, ws + WS_COEF};
        for (int s = 0; s < 8; ++s) peer_u_phase(F, ea, s, F.vcu, F.G, cnt + s);
        VM_WAIT(); __syncthreads();
        const ExpB eb{args.out, X1B, VB, EIDX, ws + WS_COEF, (float*)(ws + WS_SS2)};
        for (int s = 0; s < 8; ++s) peer_v_phase(F, eb, s, F.vcu, F.G, cnt + 8 + s);
        VM_WAIT(); __syncthreads();
        final_norm_phase(F, args.out, (const float*)(ws + WS_SS2), args.in[17], F.vcu + F.G * F.wave, F.G * NWAVES);
#ifdef UNIT_TR8
        __syncthreads();
        if (blockIdx.x == 0 && F.wave == 0) {
            typedef int v2i_ __attribute__((ext_vector_type(2)));
            const int lane = F.lane, g4 = lane >> 4, jj = lane & 15, r = jj >> 1, pp = jj & 1;
            LAS unsigned char* tb = F.lds + RING_OFF + g4 * 2048 + r * 144 + 8 * pp;
            unsigned lo = 0, hi = 0;
            for (int c = 0; c < 4; ++c) { lo |= (unsigned)((r * 16 + 8 * pp + c) | ((g4 & 1) << 7)) << (8 * c); hi |= (unsigned)((r * 16 + 8 * pp + 4 + c) | ((g4 & 1) << 7)) << (8 * c); }
            *(LAS unsigned*)tb = lo; *(LAS unsigned*)(tb + 4) = hi;
            LDS_WAIT(); asm volatile("" ::: "memory");
            const v2i_ rd = __builtin_amdgcn_ds_read_tr8_b64_v2i32((LAS v2i_*)tb);
            unsigned elo = 0, ehi = 0;
            for (int e = 0; e < 4; ++e) { elo |= (unsigned)((e * 16 + jj) | ((g4 & 1) << 7)) << (8 * e); ehi |= (unsigned)(((e + 4) * 16 + jj) | ((g4 & 1) << 7)) << (8 * e); }
            const bool bad = ((unsigned)rd.x != elo) || ((unsigned)rd.y != ehi);
            const int nb = __popcll(__ballot(bad));
            if (lane == 0) { VM_WAIT(); args.out[0] = 200.f + 20.f * (float)nb; }
        }
#endif
        STAMP(7);
#ifdef TIME_P7_SPREAD
        __syncthreads();
        ts_[8] = __builtin_amdgcn_s_memrealtime();
        if (F.tid == 0) { __hip_atomic_fetch_max((unsigned long long*)(ws + 800), ts_[8] - ts_[7], __ATOMIC_RELAXED, __HIP_MEMORY_SCOPE_AGENT); __hip_atomic_fetch_add((unsigned*)(ws + 840), 1u, __ATOMIC_RELAXED, __HIP_MEMORY_SCOPE_AGENT); }
        if (blockIdx.x == 0 && F.tid == 0) { while (__hip_atomic_load((unsigned*)(ws + 840), __ATOMIC_RELAXED, __HIP_MEMORY_SCOPE_AGENT) < gridDim.x) __builtin_amdgcn_s_sleep(8);
            ts_[8] = ts_[7] + __hip_atomic_load((unsigned long long*)(ws + 800), __ATOMIC_RELAXED, __HIP_MEMORY_SCOPE_AGENT); }
#endif
#ifdef TIME_PHASE
#ifdef TIME_TOTAL
        if (blockIdx.x == 0 && F.tid == 0) { VM_WAIT(); args.out[0] = (float)(ts_[PER_PHASE] - ts_[0]) * (0.01f / TIME_UNIT_US); }
#else
        if (blockIdx.x == 0 && F.tid == 0) { VM_WAIT(); args.out[0] = (float)(ts_[TIME_PHASE + 1] - ts_[TIME_PHASE]) * (0.01f / TIME_UNIT_US); }
#endif
#endif
    }
#undef IN
#undef BOTH
}

#ifdef DEBUG_DUMP
__global__ void dump_kernel(const unsigned char* ws, float* out, float wsmib) {
    const size_t i = (size_t)blockIdx.x * 256 + threadIdx.x; if (i >= (size_t)TOK * 1024) return;
    const size_t t = i >> 10, c = i & 1023; float v = 0.f;
    auto B = [&](size_t off, size_t idx) { return bflo((unsigned)((const bf16*)(ws + off))[idx]); };
#if DEBUG_DUMP == 0
    v = B(WS_H, i) + B(WS_WIN, i % (4608u * 1024u)) + B(WS_WPW, i % (512u * 1024u)) + B(WS_WAO, i % (512u * 1024u)) + B(WS_WOUT, i % (1024u * 1024u)) + B(WS_WQ, i % (2048u * 1024u)) + B(WS_KEYS, i % 32768u) + B(WS_UB, i % (16384u * 1024u)) + B(WS_VB, i % (16384u * 1024u));
#elif DEBUG_DUMP == 1
    v = B(WS_ZGLU, t * 512 + (c & 511)) + 2.f * B(WS_QO, t * 512 + (c & 511)) + 3.f * B(WS_K, t * 512 + (c & 511)) + 4.f * B(WS_V, t * 512 + (c & 511)) + 5.f * B(WS_GC, i) + 6.f * B(WS_GATE_A, i) + ((const float*)(ws + WS_KMEAN))[(t >> 8) * 1024 + (c & 1023)];
#elif DEBUG_DUMP == 2
    v = B(WS_QO, t * 512 + (c & 511)) + 2.f * B(WS_CACT, t * 512 + (c & 511));
#elif DEBUG_DUMP == 20
    v = B(WS_QO, t * 512 + (c & 511));
#elif DEBUG_DUMP == 21
    v = B(WS_CACT, t * 512 + (c & 511));
#elif DEBUG_DUMP == 3
    v = B(WS_MIX, i);
#elif DEBUG_DUMP == 5
    v = B(WS_QP, t * 2048 + c) + 2.f * B(WS_QP, t * 2048 + 1024 + c);
#elif DEBUG_DUMP == 10
    v = B(WS_ZGLU, t * 512 + (c & 511));
#elif DEBUG_DUMP == 11
    v = 2.f * B(WS_QO, t * 512 + (c & 511)) + 3.f * B(WS_K, t * 512 + (c & 511)) + 4.f * B(WS_V, t * 512 + (c & 511));
#elif DEBUG_DUMP == 12
    v = 5.f * B(WS_GC, i) + 6.f * B(WS_GATE_A, i);
#elif DEBUG_DUMP == 13
    v = ((const float*)(ws + WS_KMEAN))[(t >> 8) * 1024 + (c & 1023)];
#elif DEBUG_DUMP == 98
    v = wsmib;
#elif DEBUG_DUMP == 99
    v = 1.0f + (float)(c & 7);
#endif
    out[i] = v;
}
#endif
extern "C" void kernel_launch(void* const* d_in, const int* in_sizes, int n_in, void* d_out, int out_size, void* d_ws, size_t ws_size, hipStream_t stream) {
    static int grid = 0;
    if (grid == 0) {
        if (n_in != 18 || in_sizes[0] != TOK * DM || out_size != TOK * DM || ws_size < WS_END) { fprintf(stderr, "kernel_launch: unexpected shapes (n_in %d, in0 %d, out %d, ws %zu); nothing launched\n", n_in, n_in > 0 ? in_sizes[0] : -1, out_size, ws_size); grid = -1; return; }
        int dev = 0, cus = 0, per_cu = 0;
        if (hipGetDevice(&dev) != hipSuccess || hipDeviceGetAttribute(&cus, hipDeviceAttributeMultiprocessorCount, dev) != hipSuccess) { grid = -1; return; }
        if (hipFuncSetAttribute((const void*)fwd_kernel, hipFuncAttributeMaxDynamicSharedMemorySize, LDS_BYTES) != hipSuccess) { fprintf(stderr, "kernel_launch: hipFuncSetAttribute failed\n"); grid = -1; return; }
        if (hipOccupancyMaxActiveBlocksPerMultiprocessor(&per_cu, (const void*)fwd_kernel, NWAVES * 64, LDS_BYTES) != hipSuccess || per_cu < 1) fprintf(stderr, "kernel_launch: occupancy query reports %d\n", per_cu);
        (void)hipGetLastError();
        grid = cus;
    }
    if (grid < 0) return;
    (void)hipMemsetAsync((char*)d_ws + WS_CTL, 0, CTL_ZERO_BYTES, stream);
    Args a{};
    for (int i = 0; i < 18; ++i) a.in[i] = (const float*)d_in[i];
    a.out = (float*)d_out; a.ws = (unsigned char*)d_ws;
#ifndef NPH_RUN
#define NPH_RUN N_LAUNCHES
#endif
    for (int li = 0; li < NPH_RUN; ++li) {
        a.ph_lo = (N_LAUNCHES == PER_PHASE) ? li : 0; a.ph_hi = (N_LAUNCHES == PER_PHASE) ? li + 1 : PER_PHASE; a.li = li;
        hipLaunchKernelGGL(fwd_kernel, dim3(grid), dim3(NWAVES * 64), LDS_BYTES, stream, a);
    }
#ifdef DEBUG_DUMP
    hipLaunchKernelGGL(dump_kernel, dim3(TOK * 1024 / 256), dim3(256), 0, stream, (const unsigned char*)d_ws, (float*)d_out, (float)(ws_size >> 20));
#endif
}
```

```cpp
#define MK_N_LAUNCHES 1
#ifndef PG8_EPI_DRAIN
#define PG8_EPI_DRAIN 0
#endif
#include <hip/hip_runtime.h>
#include <hip/hip_bf16.h>
#include <cstdio>
#include <cstdint>
#include <cmath>
namespace pg8 {
#define PG8_LAS __attribute__((address_space(3)))
typedef unsigned short bf16_t;
typedef short bf16x8 __attribute__((ext_vector_type(8)));
typedef float f32x4 __attribute__((ext_vector_type(4)));
typedef unsigned u32x4 __attribute__((ext_vector_type(4)));
constexpr int BM = 256, BK = 64, HALF = 128, HTB = HALF * BK * 2  , STAGE_BYTES = 8 * HTB, NXCD = 8, WGM = 8;

__host__ __device__ __forceinline__ int lds_byte(int r, int c) { const int st = (r >> 4) * 2 + (c >> 5), rr = r & 15, cc = c & 31, ob = rr * 64 + cc * 2; return st * 1024 + (ob ^ (((ob >> 9) & 1) << 5)); }
__host__ __device__ __forceinline__ void stage_rc(int b, int& R, int& C) { const int st = b / 1024, sb = b % 1024, swz = sb ^ (((sb >> 9) & 1) << 5); R = (st >> 1) * 16 + swz / 64; C = (st & 1) * 32 + (swz % 64) / 2; }
__host__ __device__ __forceinline__ int perm32(int rho) { const int n = rho >> 4, i = rho & 15; return 8 * (i >> 2) + 4 * n + (i & 3); }

struct Unit { int pm, pn; };
struct Gemm { const bf16_t* A; const bf16_t* Bt; int M, N, K; };

struct StaticOrder {
    int nM, nN, nwg, G, c;
    __host__ __device__ void init(int M, int N, int G_, int c_) { nM = M / BM; nN = N / BM; nwg = nM * nN; G = G_; c = c_; }
    __host__ __device__ bool next(int i, Unit& u) const {
        const long L = (long)i * G + c; if (L >= nwg) return false;
        int wgid = (int)L; { const int q = nwg / NXCD, r = nwg % NXCD, xcd = wgid % NXCD, off = wgid / NXCD; wgid = (xcd < r ? xcd * (q + 1) : r * (q + 1) + (xcd - r) * q) + off; }
        const int nig = WGM * nN, gid = wgid / nig, fm = gid * WGM, gsz = (nM - fm) < WGM ? (nM - fm) : WGM;
        u.pm = fm + ((wgid % nig) % gsz); u.pn = (wgid % nig) / gsz; return true;
    }
    __device__ __forceinline__ void a_ready(const Unit&) const {}
    __device__ __forceinline__ void done(const Unit&) const {}
};

typedef float f32x2c_t __attribute__((ext_vector_type(2))); typedef __bf16 bf16x2c_t __attribute__((ext_vector_type(2)));
__device__ __forceinline__ unsigned cvt_pk_bf16(float lo, float hi) { const f32x2c_t v = {lo, hi}; const bf16x2c_t b = __builtin_convertvector(v, bf16x2c_t); return __builtin_bit_cast(unsigned, b); }
typedef float f32x2 __attribute__((ext_vector_type(2)));
__device__ __forceinline__ float sigm(float v) { return __builtin_amdgcn_rcpf(1.0f + __builtin_amdgcn_exp2f(-1.4426950408889634f * v)); }
__device__ __forceinline__ float bf_lo(unsigned u) { return __uint_as_float(u << 16); }
__device__ __forceinline__ float bf_hi(unsigned u) { return __uint_as_float(u & 0xffff0000u); }
__device__ __forceinline__ u32x4 pack8(const f32x4 a, const f32x4 b) { u32x4 w; w.x = cvt_pk_bf16(a[0], a[1]); w.y = cvt_pk_bf16(a[2], a[3]); w.z = cvt_pk_bf16(b[0], b[1]); w.w = cvt_pk_bf16(b[2], b[3]); return w; }
__device__ __forceinline__ void unpack8(const u32x4 w, f32x4& a, f32x4& b) { a = (f32x4){bf_lo(w.x), bf_hi(w.x), bf_lo(w.y), bf_hi(w.y)}; b = (f32x4){bf_lo(w.z), bf_hi(w.z), bf_lo(w.w), bf_hi(w.w)}; }

#ifndef PG8_WT
#define PG8_WT 1
#endif
__device__ __forceinline__ __amdgpu_buffer_rsrc_t wt_rsrc(const void* p) { return __builtin_amdgcn_make_buffer_rsrc((void*)p, 0, 0x7fffffff, 0x00020000); }
__device__ __forceinline__ void st16(bf16_t* base, const __amdgpu_buffer_rsrc_t r, size_t elem_off, const u32x4 v) {
#if PG8_WT
    __builtin_amdgcn_raw_buffer_store_b128(v, r, (unsigned)(elem_off * 2), 0, 16);
#else
    *(u32x4*)(base + elem_off) = v;
#endif
}
struct EpiIn {
    static constexpr bool PERM = true, AFTER_DRAIN = false, HAS_MID = false;
    bf16_t *zglu, *Q, *gc; float* kmean; float qscale; size_t qkv_stride, gate_stride;
    __device__ __forceinline__ void operator()(const f32x4 (&acc)[2][2][4][2], const Unit& u, int wr, int wc, int fr, int fq) const {
        const int row0 = u.pm * BM + wr * 64 + fr, cw = wc * 32 + 8 * fq, pn = u.pn;
        const __amdgpu_buffer_rsrc_t rz = wt_rsrc(zglu), rq = wt_rsrc(Q), rg = wt_rsrc(gc);
        if (pn < 4) {
#pragma unroll
            for (int ai = 0; ai < 2; ++ai)
#pragma unroll
                for (int m = 0; m < 4; ++m) { const size_t row = (size_t)(row0 + ai * HALF + m * 16);
                    f32x4 z0, z1;
#pragma unroll
                    for (int j = 0; j < 4; ++j) { z0[j] = acc[ai][0][m][0][j] * sigm(acc[ai][1][m][0][j]); z1[j] = acc[ai][0][m][1][j] * sigm(acc[ai][1][m][1][j]); }
                    st16(zglu, rz, row * 512 + pn * 128 + cw, pack8(z0, z1)); }
        } else if (pn < 10) {
            const size_t boff = (size_t)((pn - 4) >> 1) * qkv_stride; const int ct = (pn & 1) * 256; const float sc = pn < 6 ? qscale : 1.0f;
#pragma unroll
            for (int ai = 0; ai < 2; ++ai)
#pragma unroll
                for (int m = 0; m < 4; ++m) { const size_t row = (size_t)(row0 + ai * HALF + m * 16);
#pragma unroll
                    for (int bj = 0; bj < 2; ++bj) st16(Q, rq, boff + row * 512 + ct + bj * HALF + cw, pack8(acc[ai][bj][m][0] * sc, acc[ai][bj][m][1] * sc)); }
            if (pn == 6 || pn == 7) {
#pragma unroll
                for (int bj = 0; bj < 2; ++bj)
#pragma unroll
                    for (int n = 0; n < 2; ++n)
#pragma unroll
                        for (int j = 0; j < 4; ++j) { float s = 0.f;
#pragma unroll
                            for (int ai = 0; ai < 2; ++ai)
#pragma unroll
                                for (int m = 0; m < 4; ++m) s += acc[ai][bj][m][n][j];
                            s += __shfl_xor(s, 1); s += __shfl_xor(s, 2); s += __shfl_xor(s, 4); s += __shfl_xor(s, 8);
                            if (fr == 0) kmean[((size_t)u.pm * 2 + wr) * 512 + ct + bj * HALF + cw + 4 * n + j] = s * (1.0f / 256.0f); }
            }
        } else {
            const size_t boff = (size_t)((pn - 10) >> 2) * gate_stride; const int ct = ((pn - 10) & 3) * 256;
#pragma unroll
            for (int ai = 0; ai < 2; ++ai)
#pragma unroll
                for (int m = 0; m < 4; ++m) { const size_t row = (size_t)(row0 + ai * HALF + m * 16);
#pragma unroll
                    for (int bj = 0; bj < 2; ++bj) { f32x4 s0, s1;
#pragma unroll
                        for (int j = 0; j < 4; ++j) { s0[j] = sigm(acc[ai][bj][m][0][j]); s1[j] = sigm(acc[ai][bj][m][1][j]); }
                        st16(gc, rg, boff + row * 1024 + ct + bj * HALF + cw, pack8(s0, s1)); } }
        }
    }
};
template <bool ADD> struct EpiMix {
    static constexpr bool PERM = true, AFTER_DRAIN = false, HAS_MID = false;
    const bf16_t* gate; const float* bias; bf16_t* mix;
    __device__ __forceinline__ void operator()(const f32x4 (&acc)[2][2][4][2], const Unit& u, int wr, int wc, int fr, int fq) const {
        const int row0 = u.pm * BM + wr * 64 + fr, col0 = u.pn * BM + wc * 32 + 8 * fq;
        f32x4 b0[2], b1[2];
#pragma unroll
        for (int bj = 0; bj < 2; ++bj) { b0[bj] = (f32x4){0.f, 0.f, 0.f, 0.f}; b1[bj] = b0[bj]; if (!ADD) { b0[bj] = *(const f32x4*)(bias + col0 + bj * HALF); b1[bj] = *(const f32x4*)(bias + col0 + bj * HALF + 4); } }
#pragma unroll
        for (int ai = 0; ai < 2; ++ai) {
            u32x4 gq[4][2], mq[4][2];
#pragma unroll
            for (int m = 0; m < 4; ++m)
#pragma unroll
                for (int bj = 0; bj < 2; ++bj) { const size_t off = (size_t)(row0 + ai * HALF + m * 16) * 1024 + col0 + bj * HALF; gq[m][bj] = *(const u32x4*)(gate + off); if (ADD) mq[m][bj] = *(const u32x4*)(mix + off); }
#pragma unroll
            for (int m = 0; m < 4; ++m)
#pragma unroll
                for (int bj = 0; bj < 2; ++bj) { const size_t off = (size_t)(row0 + ai * HALF + m * 16) * 1024 + col0 + bj * HALF;
                    f32x4 g0, g1; unpack8(gq[m][bj], g0, g1);
                    f32x4 v0 = acc[ai][bj][m][0], v1 = acc[ai][bj][m][1];
                    if (!ADD) { v0 = (v0 + b0[bj]) * g0; v1 = (v1 + b1[bj]) * g1; }
                    else { f32x4 p0, p1; unpack8(mq[m][bj], p0, p1); v0 = p0 + v0 * g0; v1 = p1 + v1 * g1; }
                    *(u32x4*)(mix + off) = pack8(v0, v1); }
        }
    }
};
struct EpiMixF {
    static constexpr bool PERM = true, AFTER_DRAIN = false, HAS_MID = true;
    const bf16_t* gc; const bf16_t* ga; const float* bias; bf16_t* mix;
    __device__ __forceinline__ void mid(f32x4 (&acc)[2][2][4][2], const Unit& u, int wr, int wc, int fr, int fq) const {
        const int row0 = u.pm * BM + wr * 64 + fr, col0 = u.pn * BM + wc * 32 + 8 * fq;
#pragma unroll
        for (int ai = 0; ai < 2; ++ai)
#pragma unroll
            for (int m = 0; m < 4; ++m) { u32x4 cq[2], aq[2];
#pragma unroll
                for (int bj = 0; bj < 2; ++bj) { const size_t off = (size_t)(row0 + ai * HALF + m * 16) * 1024 + col0 + bj * HALF; cq[bj] = *(const u32x4*)(gc + off); aq[bj] = *(const u32x4*)(ga + off); }
#pragma unroll
                for (int bj = 0; bj < 2; ++bj) { f32x4 c0, c1, a0, a1; unpack8(cq[bj], c0, c1); unpack8(aq[bj], a0, a1);
                    const f32x4 b0 = *(const f32x4*)(bias + col0 + bj * HALF), b1 = *(const f32x4*)(bias + col0 + bj * HALF + 4);
#pragma unroll
                    for (int j = 0; j < 4; ++j) { acc[ai][bj][m][0][j] = (acc[ai][bj][m][0][j] + b0[j]) * c0[j] * __builtin_amdgcn_rcpf(fmaxf(a0[j], 1e-30f));
                                                  acc[ai][bj][m][1][j] = (acc[ai][bj][m][1][j] + b1[j]) * c1[j] * __builtin_amdgcn_rcpf(fmaxf(a1[j], 1e-30f)); } }
                if (m & 1) asm volatile("" ::: "memory"); }
    }
    __device__ __forceinline__ void operator()(const f32x4 (&acc)[2][2][4][2], const Unit& u, int wr, int wc, int fr, int fq) const {
        const int row0 = u.pm * BM + wr * 64 + fr, col0 = u.pn * BM + wc * 32 + 8 * fq;
        const __amdgpu_buffer_rsrc_t rm = wt_rsrc(mix);
#pragma unroll
        for (int ai = 0; ai < 2; ++ai) { u32x4 aq[4][2];
#pragma unroll
            for (int m = 0; m < 4; ++m)
#pragma unroll
                for (int bj = 0; bj < 2; ++bj) aq[m][bj] = *(const u32x4*)(ga + (size_t)(row0 + ai * HALF + m * 16) * 1024 + col0 + bj * HALF);
#pragma unroll
            for (int m = 0; m < 4; ++m)
#pragma unroll
                for (int bj = 0; bj < 2; ++bj) { f32x4 a0, a1; unpack8(aq[m][bj], a0, a1); f32x4 v0 = acc[ai][bj][m][0], v1 = acc[ai][bj][m][1];
#pragma unroll
                    for (int j = 0; j < 4; ++j) { v0[j] *= fmaxf(a0[j], 1e-30f); v1[j] *= fmaxf(a1[j], 1e-30f); }
                    st16(mix, rm, (size_t)(row0 + ai * HALF + m * 16) * 1024 + col0 + bj * HALF, pack8(v0, v1)); } }
    }
};
struct EpiX1 {
    static constexpr bool PERM = true, AFTER_DRAIN = false, HAS_MID = false;
    const float* x; float* x1; bf16_t* x1b; float* ss;
    __device__ __forceinline__ void operator()(const f32x4 (&acc)[2][2][4][2], const Unit& u, int wr, int wc, int fr, int fq) const {
        const int row0 = u.pm * BM + wr * 64 + fr, col0 = u.pn * BM + wc * 32 + 8 * fq;
        const __amdgpu_buffer_rsrc_t rx = wt_rsrc(x1b);
#pragma unroll
        for (int ai = 0; ai < 2; ++ai) {
            f32x4 xq[4][2][2];
#pragma unroll
            for (int m = 0; m < 4; ++m)
#pragma unroll
                for (int bj = 0; bj < 2; ++bj) { const size_t off = (size_t)(row0 + ai * HALF + m * 16) * 1024 + col0 + bj * HALF; xq[m][bj][0] = *(const f32x4*)(x + off); xq[m][bj][1] = *(const f32x4*)(x + off + 4); }
#pragma unroll
            for (int m = 0; m < 4; ++m) { const size_t row = (size_t)(row0 + ai * HALF + m * 16); float sq = 0.f;
#pragma unroll
                for (int bj = 0; bj < 2; ++bj) { const size_t off = row * 1024 + col0 + bj * HALF;
                    const f32x4 r0 = xq[m][bj][0] + acc[ai][bj][m][0], r1 = xq[m][bj][1] + acc[ai][bj][m][1];
                    st16(x1b, rx, off, pack8(r0, r1));
                    sq += (r0[0] * r0[0] + r0[1] * r0[1]) + (r0[2] * r0[2] + r0[3] * r0[3]) + (r1[0] * r1[0] + r1[1] * r1[1]) + (r1[2] * r1[2] + r1[3] * r1[3]); }
                sq += __shfl_xor(sq, 16); sq += __shfl_xor(sq, 32);
                if (fq == 0) ss[row * 16 + u.pn * 4 + wc] = sq; }
        }
    }
};
struct EpiStore {
    static constexpr bool PERM = true, AFTER_DRAIN = false, HAS_MID = false;
    bf16_t* O; int ldc;
    __device__ __forceinline__ void operator()(const f32x4 (&acc)[2][2][4][2], const Unit& u, int wr, int wc, int fr, int fq) const {
        const int row0 = u.pm * BM + wr * 64 + fr, col0 = u.pn * BM + wc * 32 + 8 * fq;
        const __amdgpu_buffer_rsrc_t ro = wt_rsrc(O);
#pragma unroll
        for (int ai = 0; ai < 2; ++ai)
#pragma unroll
            for (int m = 0; m < 4; ++m) { const size_t row = (size_t)(row0 + ai * HALF + m * 16);
#pragma unroll
                for (int bj = 0; bj < 2; ++bj) st16(O, ro, row * ldc + col0 + bj * HALF, pack8(acc[ai][bj][m][0], acc[ai][bj][m][1])); }
    }
};


template <class Epi, class Sched, bool ALIGN_EPI = false, bool SP2 = false>
__device__ __forceinline__ void gemm_phase(PG8_LAS unsigned char* lds, const Gemm g, const Sched& S, const Epi& E) {
    const int tid = threadIdx.x, wid = __builtin_amdgcn_readfirstlane(tid >> 6), lane = tid & 63, wr = wid >> 2, wc = wid & 3, fr = lane & 15, fq = lane >> 4;
    const int K = g.K, nt = K / BK;
    unsigned voffA[2], voffB[2];
#pragma unroll
    for (int i = 0; i < 2; ++i) { int R, C; stage_rc(tid * 16 + i * 8192, R, C); const int Rb = Epi::PERM ? ((R & ~31) + perm32(R & 31)) : R;
        voffA[i] = (unsigned)(R * K + C) * 2u; voffB[i] = (unsigned)(Rb * K + C) * 2u; }
    const size_t kstep = (size_t)(BK * 2);
    const size_t hstep = (size_t)HALF * K * 2;
    const size_t tstep = 2 * hstep;
    const unsigned ldsw = (unsigned)wid * 1024u;
    const int aoff = lds_byte(wr * 64 + fr, fq * 8), boff = lds_byte(wc * 32 + fr, fq * 8);
#define PG8_SA(b, h) (((b) * 2 + (h)) * HTB)
#define PG8_SB(b, h) ((4 + (b) * 2 + (h)) * HTB)
#define PG8_STAGE(bufoff, gbase, voff) do { _Pragma("unroll") for (int _i = 0; _i < 2; ++_i) \
        __builtin_amdgcn_global_load_lds((const unsigned*)((const char*)(gbase) + (voff)[_i]), (PG8_LAS unsigned*)(lds + (bufoff) + ldsw + _i * 8192), 16, 0, 0); } while (0)
#define PG8_LDA(dst, b, h) do { _Pragma("unroll") for (int m = 0; m < 4; ++m) _Pragma("unroll") for (int k = 0; k < 2; ++k) dst[m][k] = *(const PG8_LAS bf16x8*)(lds + PG8_SA(b, h) + aoff + m * 2048 + k * 1024); } while (0)
#define PG8_LDB(dst, b, h) do { _Pragma("unroll") for (int n = 0; n < 2; ++n) _Pragma("unroll") for (int k = 0; k < 2; ++k) dst[n][k] = *(const PG8_LAS bf16x8*)(lds + PG8_SB(b, h) + boff + n * 2048 + k * 1024); } while (0)
#define PG8_MMA(ai, bj, At, Bt) do { __builtin_amdgcn_s_setprio(1); _Pragma("unroll") for (int m = 0; m < 4; ++m) _Pragma("unroll") for (int n = 0; n < 2; ++n) _Pragma("unroll") for (int k = 0; k < 2; ++k) \
        acc[ai][bj][m][n] = __builtin_amdgcn_mfma_f32_16x16x32_bf16(Bt[n][k], At[m][k], acc[ai][bj][m][n], 0, 0, 0); __builtin_amdgcn_s_setprio(0); } while (0)
#define PG8_WAIT_V(n) asm volatile("s_waitcnt vmcnt(" #n ")" ::: "memory")
#define PG8_WAIT_L(n) asm volatile("s_waitcnt lgkmcnt(" #n ")" ::: "memory")
#define PG8_BAR __builtin_amdgcn_s_barrier()
#define PG8_SCHED __builtin_amdgcn_sched_barrier(0)
    Unit cur, nxt; int ui = 0;
    if (!S.next(0, cur)) return;
    f32x4 acc[2][2][4][2];
#pragma unroll
    for (int a = 0; a < 2; ++a)
#pragma unroll
        for (int b = 0; b < 2; ++b)
#pragma unroll
            for (int m = 0; m < 4; ++m)
#pragma unroll
                for (int n = 0; n < 2; ++n) acc[a][b][m][n] = (f32x4){0.f, 0.f, 0.f, 0.f};
    bf16x8 At[4][2], B0[2][2], B1[2][2];
    const char* cA = (const char*)g.A + (size_t)cur.pm * tstep; const char* cB = (const char*)g.Bt + (size_t)cur.pn * tstep;
    S.a_ready(cur);
    if constexpr (SP2) {
        PG8_STAGE(PG8_SB(0, 0), cB, voffB); PG8_STAGE(PG8_SB(0, 1), cB + hstep, voffB); PG8_STAGE(PG8_SA(0, 0), cA, voffA); PG8_STAGE(PG8_SA(0, 1), cA + hstep, voffA);
        if (wr == 1) PG8_BAR;
        PG8_WAIT_V(2); PG8_BAR;
        PG8_STAGE(PG8_SB(1, 0), cB + kstep, voffB); PG8_STAGE(PG8_SA(1, 0), cA + kstep, voffA); PG8_STAGE(PG8_SB(1, 1), cB + hstep + kstep, voffB);
        PG8_WAIT_V(6); PG8_BAR;
    } else {
        PG8_STAGE(PG8_SB(0, 0), cB, voffB); PG8_STAGE(PG8_SA(0, 0), cA, voffA); PG8_STAGE(PG8_SB(0, 1), cB + hstep, voffB); PG8_STAGE(PG8_SA(0, 1), cA + hstep, voffA);
        if (wr == 1) PG8_BAR;
        PG8_WAIT_V(4); PG8_BAR;
        PG8_STAGE(PG8_SB(1, 0), cB + kstep, voffB); PG8_STAGE(PG8_SA(1, 0), cA + kstep, voffA); PG8_STAGE(PG8_SB(1, 1), cB + hstep + kstep, voffB);
        PG8_WAIT_V(6); PG8_BAR;
    }
    for (;;) {
        const bool has_next = S.next(ui + 1, nxt);
        const char* nA = has_next ? (const char*)g.A + (size_t)nxt.pm * tstep : cA; const char* nB = has_next ? (const char*)g.Bt + (size_t)nxt.pn * tstep : cB;
        if constexpr (Epi::HAS_MID) {
        for (int t = 0; t < nt / 2; t += 2) {
            const bool last = (t == nt - 2);
            const char* a1 = cA + (size_t)(t + 1) * kstep;
            const char* a2 = last ? nA : cA + (size_t)(t + 2) * kstep; const char* b2 = last ? nB : cB + (size_t)(t + 2) * kstep;
            const char* a3 = a2 + kstep; const char* b3 = b2 + kstep;
            if (last && has_next) S.a_ready(nxt);
            if constexpr (SP2) {
            PG8_LDB(B0, 0, 0); PG8_LDB(B1, 0, 1); PG8_SCHED; PG8_LDA(At, 0, 0); PG8_STAGE(PG8_SA(1, 1), a1 + hstep, voffA);
            PG8_WAIT_V(8); PG8_WAIT_L(0); PG8_BAR; PG8_MMA(0, 0, At, B0); PG8_MMA(0, 1, At, B1); PG8_BAR; PG8_SCHED;
            PG8_LDA(At, 0, 1); PG8_STAGE(PG8_SB(0, 0), b2, voffB); PG8_STAGE(PG8_SB(0, 1), b2 + hstep, voffB); PG8_STAGE(PG8_SA(0, 0), a2, voffA);
            PG8_WAIT_V(8); PG8_WAIT_L(0); PG8_BAR; PG8_MMA(1, 0, At, B0); PG8_MMA(1, 1, At, B1); PG8_BAR; PG8_SCHED;
            PG8_LDB(B0, 1, 0); PG8_LDB(B1, 1, 1); PG8_SCHED; PG8_LDA(At, 1, 0); PG8_STAGE(PG8_SA(0, 1), a2 + hstep, voffA);
            PG8_WAIT_V(8); PG8_WAIT_L(0); PG8_BAR; PG8_MMA(0, 0, At, B0); PG8_MMA(0, 1, At, B1); PG8_BAR; PG8_SCHED;
            PG8_LDA(At, 1, 1); PG8_STAGE(PG8_SB(1, 0), b3, voffB); PG8_STAGE(PG8_SB(1, 1), b3 + hstep, voffB); PG8_STAGE(PG8_SA(1, 0), a3, voffA);
            PG8_WAIT_V(8); PG8_WAIT_L(0); PG8_BAR; PG8_MMA(1, 0, At, B0); PG8_MMA(1, 1, At, B1); PG8_BAR; PG8_SCHED;
            } else {
            PG8_LDB(B0, 0, 0); PG8_SCHED; PG8_LDA(At, 0, 0); PG8_STAGE(PG8_SA(1, 1), a1 + hstep, voffA);
            PG8_WAIT_L(8); PG8_BAR; PG8_WAIT_L(0); PG8_MMA(0, 0, At, B0); PG8_BAR; PG8_SCHED;
            PG8_LDB(B1, 0, 1); PG8_STAGE(PG8_SB(0, 0), b2, voffB);
            PG8_BAR; PG8_WAIT_L(0); PG8_MMA(0, 1, At, B1); PG8_BAR;
            PG8_LDA(At, 0, 1); PG8_STAGE(PG8_SA(0, 0), a2, voffA);
            PG8_BAR; PG8_WAIT_L(0); PG8_MMA(1, 0, At, B0); PG8_BAR; PG8_SCHED;
            PG8_STAGE(PG8_SB(0, 1), b2 + hstep, voffB);
            PG8_WAIT_V(6); PG8_BAR; PG8_MMA(1, 1, At, B1); PG8_BAR;
            PG8_LDB(B0, 1, 0); PG8_SCHED; PG8_LDA(At, 1, 0); PG8_STAGE(PG8_SA(0, 1), a2 + hstep, voffA);
            PG8_WAIT_L(8); PG8_BAR; PG8_WAIT_L(0); PG8_MMA(0, 0, At, B0); PG8_BAR; PG8_SCHED;
            PG8_LDB(B1, 1, 1); PG8_STAGE(PG8_SB(1, 0), b3, voffB);
            PG8_BAR; PG8_WAIT_L(0); PG8_MMA(0, 1, At, B1); PG8_BAR;
            PG8_LDA(At, 1, 1); PG8_STAGE(PG8_SA(1, 0), a3, voffA);
            PG8_BAR; PG8_WAIT_L(0); PG8_MMA(1, 0, At, B0); PG8_BAR; PG8_SCHED;
            PG8_STAGE(PG8_SB(1, 1), b3 + hstep, voffB);
            PG8_WAIT_V(6); PG8_BAR; PG8_MMA(1, 1, At, B1); PG8_BAR;
            }
        }
        E.mid(acc, cur, wr, wc, fr, fq);
        for (int t = nt / 2; t < nt; t += 2) {
            const bool last = (t == nt - 2);
            const char* a1 = cA + (size_t)(t + 1) * kstep;
            const char* a2 = last ? nA : cA + (size_t)(t + 2) * kstep; const char* b2 = last ? nB : cB + (size_t)(t + 2) * kstep;
            const char* a3 = a2 + kstep; const char* b3 = b2 + kstep;
            if (last && has_next) S.a_ready(nxt);
            if constexpr (SP2) {
            PG8_LDB(B0, 0, 0); PG8_LDB(B1, 0, 1); PG8_SCHED; PG8_LDA(At, 0, 0); PG8_STAGE(PG8_SA(1, 1), a1 + hstep, voffA);
            PG8_WAIT_V(8); PG8_WAIT_L(0); PG8_BAR; PG8_MMA(0, 0, At, B0); PG8_MMA(0, 1, At, B1); PG8_BAR; PG8_SCHED;
            PG8_LDA(At, 0, 1); PG8_STAGE(PG8_SB(0, 0), b2, voffB); PG8_STAGE(PG8_SB(0, 1), b2 + hstep, voffB); PG8_STAGE(PG8_SA(0, 0), a2, voffA);
            PG8_WAIT_V(8); PG8_WAIT_L(0); PG8_BAR; PG8_MMA(1, 0, At, B0); PG8_MMA(1, 1, At, B1); PG8_BAR; PG8_SCHED;
            PG8_LDB(B0, 1, 0); PG8_LDB(B1, 1, 1); PG8_SCHED; PG8_LDA(At, 1, 0); PG8_STAGE(PG8_SA(0, 1), a2 + hstep, voffA);
            PG8_WAIT_V(8); PG8_WAIT_L(0); PG8_BAR; PG8_MMA(0, 0, At, B0); PG8_MMA(0, 1, At, B1); PG8_BAR; PG8_SCHED;
            PG8_LDA(At, 1, 1); PG8_STAGE(PG8_SB(1, 0), b3, voffB); PG8_STAGE(PG8_SB(1, 1), b3 + hstep, voffB); PG8_STAGE(PG8_SA(1, 0), a3, voffA);
            PG8_WAIT_V(8); PG8_WAIT_L(0); PG8_BAR; PG8_MMA(1, 0, At, B0); PG8_MMA(1, 1, At, B1); PG8_BAR; PG8_SCHED;
            } else {
            PG8_LDB(B0, 0, 0); PG8_SCHED; PG8_LDA(At, 0, 0); PG8_STAGE(PG8_SA(1, 1), a1 + hstep, voffA);
            PG8_WAIT_L(8); PG8_BAR; PG8_WAIT_L(0); PG8_MMA(0, 0, At, B0); PG8_BAR; PG8_SCHED;
            PG8_LDB(B1, 0, 1); PG8_STAGE(PG8_SB(0, 0), b2, voffB);
            PG8_BAR; PG8_WAIT_L(0); PG8_MMA(0, 1, At, B1); PG8_BAR;
            PG8_LDA(At, 0, 1); PG8_STAGE(PG8_SA(0, 0), a2, voffA);
            PG8_BAR; PG8_WAIT_L(0); PG8_MMA(1, 0, At, B0); PG8_BAR; PG8_SCHED;
            PG8_STAGE(PG8_SB(0, 1), b2 + hstep, voffB);
            PG8_WAIT_V(6); PG8_BAR; PG8_MMA(1, 1, At, B1); PG8_BAR;
            PG8_LDB(B0, 1, 0); PG8_SCHED; PG8_LDA(At, 1, 0); PG8_STAGE(PG8_SA(0, 1), a2 + hstep, voffA);
            PG8_WAIT_L(8); PG8_BAR; PG8_WAIT_L(0); PG8_MMA(0, 0, At, B0); PG8_BAR; PG8_SCHED;
            PG8_LDB(B1, 1, 1); PG8_STAGE(PG8_SB(1, 0), b3, voffB);
            PG8_BAR; PG8_WAIT_L(0); PG8_MMA(0, 1, At, B1); PG8_BAR;
            PG8_LDA(At, 1, 1); PG8_STAGE(PG8_SA(1, 0), a3, voffA);
            PG8_BAR; PG8_WAIT_L(0); PG8_MMA(1, 0, At, B0); PG8_BAR; PG8_SCHED;
            PG8_STAGE(PG8_SB(1, 1), b3 + hstep, voffB);
            PG8_WAIT_V(6); PG8_BAR; PG8_MMA(1, 1, At, B1); PG8_BAR;
            }
        }
        } else {
        for (int t = 0; t < nt; t += 2) {
            const bool last = (t == nt - 2);
            const char* a1 = cA + (size_t)(t + 1) * kstep;
            const char* a2 = last ? nA : cA + (size_t)(t + 2) * kstep; const char* b2 = last ? nB : cB + (size_t)(t + 2) * kstep;
            const char* a3 = a2 + kstep; const char* b3 = b2 + kstep;
            if (last && has_next) S.a_ready(nxt);
            if constexpr (SP2) {
            PG8_LDB(B0, 0, 0); PG8_LDB(B1, 0, 1); PG8_SCHED; PG8_LDA(At, 0, 0); PG8_STAGE(PG8_SA(1, 1), a1 + hstep, voffA);
            PG8_WAIT_V(8); PG8_WAIT_L(0); PG8_BAR; PG8_MMA(0, 0, At, B0); PG8_MMA(0, 1, At, B1); PG8_BAR; PG8_SCHED;
            PG8_LDA(At, 0, 1); PG8_STAGE(PG8_SB(0, 0), b2, voffB); PG8_STAGE(PG8_SB(0, 1), b2 + hstep, voffB); PG8_STAGE(PG8_SA(0, 0), a2, voffA);
            PG8_WAIT_V(8); PG8_WAIT_L(0); PG8_BAR; PG8_MMA(1, 0, At, B0); PG8_MMA(1, 1, At, B1); PG8_BAR; PG8_SCHED;
            PG8_LDB(B0, 1, 0); PG8_LDB(B1, 1, 1); PG8_SCHED; PG8_LDA(At, 1, 0); PG8_STAGE(PG8_SA(0, 1), a2 + hstep, voffA);
            PG8_WAIT_V(8); PG8_WAIT_L(0); PG8_BAR; PG8_MMA(0, 0, At, B0); PG8_MMA(0, 1, At, B1); PG8_BAR; PG8_SCHED;
            PG8_LDA(At, 1, 1); PG8_STAGE(PG8_SB(1, 0), b3, voffB); PG8_STAGE(PG8_SB(1, 1), b3 + hstep, voffB); PG8_STAGE(PG8_SA(1, 0), a3, voffA);
            PG8_WAIT_V(8); PG8_WAIT_L(0); PG8_BAR; PG8_MMA(1, 0, At, B0); PG8_MMA(1, 1, At, B1); PG8_BAR; PG8_SCHED;
            } else {
            PG8_LDB(B0, 0, 0); PG8_SCHED; PG8_LDA(At, 0, 0); PG8_STAGE(PG8_SA(1, 1), a1 + hstep, voffA);
            PG8_WAIT_L(8); PG8_BAR; PG8_WAIT_L(0); PG8_MMA(0, 0, At, B0); PG8_BAR; PG8_SCHED;
            PG8_LDB(B1, 0, 1); PG8_STAGE(PG8_SB(0, 0), b2, voffB);
            PG8_BAR; PG8_WAIT_L(0); PG8_MMA(0, 1, At, B1); PG8_BAR;
            PG8_LDA(At, 0, 1); PG8_STAGE(PG8_SA(0, 0), a2, voffA);
            PG8_BAR; PG8_WAIT_L(0); PG8_MMA(1, 0, At, B0); PG8_BAR; PG8_SCHED;
            PG8_STAGE(PG8_SB(0, 1), b2 + hstep, voffB);
            PG8_WAIT_V(6); PG8_BAR; PG8_MMA(1, 1, At, B1); PG8_BAR;
            PG8_LDB(B0, 1, 0); PG8_SCHED; PG8_LDA(At, 1, 0); PG8_STAGE(PG8_SA(0, 1), a2 + hstep, voffA);
            PG8_WAIT_L(8); PG8_BAR; PG8_WAIT_L(0); PG8_MMA(0, 0, At, B0); PG8_BAR; PG8_SCHED;
            PG8_LDB(B1, 1, 1); PG8_STAGE(PG8_SB(1, 0), b3, voffB);
            PG8_BAR; PG8_WAIT_L(0); PG8_MMA(0, 1, At, B1); PG8_BAR;
            PG8_LDA(At, 1, 1); PG8_STAGE(PG8_SA(1, 0), a3, voffA);
            PG8_BAR; PG8_WAIT_L(0); PG8_MMA(1, 0, At, B0); PG8_BAR; PG8_SCHED;
            PG8_STAGE(PG8_SB(1, 1), b3 + hstep, voffB);
            PG8_WAIT_V(6); PG8_BAR; PG8_MMA(1, 1, At, B1); PG8_BAR;
            }
        }
        }
        if constexpr (ALIGN_EPI) { if (wr == 0) PG8_BAR; }
        if constexpr (!Epi::AFTER_DRAIN) { E(acc, cur, wr, wc, fr, fq); S.done(cur);
#if PG8_EPI_DRAIN
            PG8_WAIT_V(0);
#endif
        }
        if (!has_next) break;
#pragma unroll
        for (int a = 0; a < 2; ++a)
#pragma unroll
            for (int b = 0; b < 2; ++b)
#pragma unroll
                for (int m = 0; m < 4; ++m)
#pragma unroll
                    for (int n = 0; n < 2; ++n) acc[a][b][m][n] = (f32x4){0.f, 0.f, 0.f, 0.f};
        cur = nxt; cA = nA; cB = nB; ++ui;
        if constexpr (ALIGN_EPI) { if (wr == 1) PG8_BAR; }
    }
    PG8_WAIT_V(0);
    if constexpr (!ALIGN_EPI) { if (wr == 0) PG8_BAR; }
    PG8_BAR;
    if constexpr (Epi::AFTER_DRAIN) { E.fused(acc, cur, wr, wc, fr, fq, lds, wid, lane); S.done(cur); }
#undef PG8_SA
#undef PG8_SB
#undef PG8_STAGE
#undef PG8_LDA
#undef PG8_LDB
#undef PG8_MMA
#undef PG8_WAIT_V
#undef PG8_WAIT_L
#undef PG8_BAR
#undef PG8_SCHED
}
}

#include <hip/hip_bf16.h>
#include <cmath>
namespace attn_body {
using bf16=__hip_bfloat16;
using bf16x8=__attribute__((ext_vector_type(8)))short;
using s16x4=__attribute__((ext_vector_type(4)))short;
using f32x16=__attribute__((ext_vector_type(16)))float;
using u32x4=__attribute__((ext_vector_type(4)))unsigned;
typedef float f32x4_t __attribute__((ext_vector_type(4)));
constexpr int BATCH=8,NHEAD=8,SEQ=4096,D=64,DM=NHEAD*D;
constexpr int NW=8,QBLK=32,QB=QBLK*NW,KVBLK=64,NQB=SEQ/QB;
constexpr int ATTN_PITCH=DM, ATTN_UNIT_ROWS=QB, OPITCH=1024;
__device__ __forceinline__ int crow(int r,int hi){return (r&3)+8*(r>>2)+4*hi;}
#define SBAR() __builtin_amdgcn_sched_barrier(0)
__device__ __forceinline__ void cmask(f32x16&p0,f32x16&p1,int jb,int qrel,int hi){
  const float NEG=-INFINITY; int kb=64*jb+4*hi;
  #pragma unroll
  for(int r=0;r<16;++r){int kv=kb+(r&3)+8*(r>>2); if(kv>qrel)p0[r]=NEG; if(kv+32>qrel)p1[r]=NEG;}
}

constexpr int NSLOT=3, SLOTB=8192;
constexpr int LDS_K=0, LDS_V=NSLOT*SLOTB, LDS_WS=2*NSLOT*SLOTB, LDS_OST=LDS_WS+NW*64*4, LDS_KM=LDS_OST+NW*4096, LDS_BYTES=LDS_KM+4096;
constexpr float C2=0.125f*1.4426950408889634f;
__device__ __forceinline__ void glds16(const void*gsrc,unsigned lds_dst){unsigned keep;
  asm volatile("s_mov_b32 %0, m0\n\ts_mov_b32 m0, %2\n\ts_nop 0\n\tglobal_load_lds_dwordx4 %1, off\n\ts_mov_b32 m0, %0":"=&s"(keep):"v"(gsrc),"s"(lds_dst):"memory");}
__device__ __forceinline__ float max3f(float a,float b,float c){float r;asm("v_max3_f32 %0, %1, %2, %3":"=v"(r):"v"(a),"v"(b),"v"(c));return r;}
__device__ __forceinline__ float max2f(float a,float b){float r;asm("v_max_f32_e32 %0, %1, %2":"=v"(r):"v"(a),"v"(b));return r;}
__device__ __forceinline__ float fadd_s(float a,float b){float r;asm("v_add_f32_e32 %0, %1, %2":"=v"(r):"v"(a),"v"(b));return r;}
__device__ __forceinline__ float fsub_s(float a,float b){float r;asm("v_sub_f32_e32 %0, %1, %2":"=v"(r):"v"(a),"v"(b));return r;}
typedef float f32x2_t __attribute__((ext_vector_type(2))); typedef __bf16 bf16x2_t __attribute__((ext_vector_type(2)));
__device__ __forceinline__ unsigned cvtpk_s(float lo,float hi){f32x2_t v={lo,hi};bf16x2_t b=__builtin_convertvector(v,bf16x2_t);return __builtin_bit_cast(unsigned,b);}
#define WAIT_BAR(N) asm volatile("s_waitcnt vmcnt(" #N ") lgkmcnt(0)\n\ts_barrier":::"memory")

__device__ __forceinline__ void qkt(f32x16&p0,f32x16&p1,const char*Kslot,const bf16x8*qr,int r32,int hi){
  const char*kb=Kslot+hi*1024+r32*16;
  #pragma unroll
  for(int d0=0;d0<4;++d0){
    const bf16x8 b0=*reinterpret_cast<const bf16x8*>(kb+d0*2048);
    const bf16x8 b1=*reinterpret_cast<const bf16x8*>(kb+d0*2048+512);
    p0=__builtin_amdgcn_mfma_f32_32x32x16_bf16(b0,qr[d0],p0,0,0,0);p1=__builtin_amdgcn_mfma_f32_32x32x16_bf16(b1,qr[d0],p1,0,0,0);}
}
typedef __attribute__((address_space(3))) const char* lds_cptr;
typedef short v4i16_t __attribute__((ext_vector_type(4)));
__device__ __forceinline__ void kload8(bf16x8*kf,lds_cptr kp){
  kf[0]=*(const __attribute__((address_space(3))) bf16x8*)(kp);      kf[1]=*(const __attribute__((address_space(3))) bf16x8*)(kp+512);
  kf[2]=*(const __attribute__((address_space(3))) bf16x8*)(kp+2048); kf[3]=*(const __attribute__((address_space(3))) bf16x8*)(kp+2560);
  kf[4]=*(const __attribute__((address_space(3))) bf16x8*)(kp+4096); kf[5]=*(const __attribute__((address_space(3))) bf16x8*)(kp+4608);
  kf[6]=*(const __attribute__((address_space(3))) bf16x8*)(kp+6144); kf[7]=*(const __attribute__((address_space(3))) bf16x8*)(kp+6656);
}
__device__ __forceinline__ void kload2(bf16x8*kf,lds_cptr kp,int j){ kf[2*j]=*(const __attribute__((address_space(3))) bf16x8*)(kp+j*2048); kf[2*j+1]=*(const __attribute__((address_space(3))) bf16x8*)(kp+j*2048+512); }
__device__ __forceinline__ s16x4 vtr(lds_cptr p){ return __builtin_bit_cast(s16x4,__builtin_amdgcn_ds_read_tr16_b64_v4i16((__attribute__((address_space(3))) v4i16_t*)p)); }
__device__ __forceinline__ float rowmax(const f32x16&p0,const f32x16&p1){
  float a=max3f(p0[0],p0[1],p1[0]),b=max3f(p0[2],p0[3],p1[1]);a=max3f(a,p1[2],p1[3]);
  #pragma unroll
  for(int r=4;r<16;r+=4){a=max3f(a,p0[r],p0[r+1]);b=max3f(b,p0[r+2],p0[r+3]);a=max3f(a,p1[r],p1[r+1]);b=max3f(b,p1[r+2],p1[r+3]);}
  const float m=max2f(a,b);
  auto rr=__builtin_amdgcn_permlane32_swap(__float_as_uint(m),__float_as_uint(m),false,false);
  return max2f(__uint_as_float(rr[0]),__uint_as_float(rr[1]));
}
__device__ __forceinline__ void pv(f32x16*o,int vb,bf16x8 pa0,bf16x8 pa1,bf16x8 pa2,bf16x8 pa3){
  #pragma unroll
  for(int d0=0;d0<2;++d0){s16x4 lo[4],hi[4];
    #pragma unroll
    for(int ks=0;ks<4;++ks){
      asm volatile("ds_read_b64_tr_b16 %0,%1 offset:%c2":"=&v"(lo[ks]):"v"(vb),"i"(d0*4096+ks*1024):"memory");
      asm volatile("ds_read_b64_tr_b16 %0,%1 offset:%c2":"=&v"(hi[ks]):"v"(vb),"i"(d0*4096+ks*1024+512):"memory");}
    asm volatile("s_waitcnt lgkmcnt(0)":::"memory");SBAR();
    #define PK(k) (bf16x8){lo[k][0],lo[k][1],lo[k][2],lo[k][3],hi[k][0],hi[k][1],hi[k][2],hi[k][3]}
    o[d0]=__builtin_amdgcn_mfma_f32_32x32x16_bf16(pa0,PK(0),o[d0],0,0,0);
    o[d0]=__builtin_amdgcn_mfma_f32_32x32x16_bf16(pa1,PK(1),o[d0],0,0,0);
    o[d0]=__builtin_amdgcn_mfma_f32_32x32x16_bf16(pa2,PK(2),o[d0],0,0,0);
    o[d0]=__builtin_amdgcn_mfma_f32_32x32x16_bf16(pa3,PK(3),o[d0],0,0,0);
    #undef PK
  }
}

#ifndef ATTN_STORE16
#define ATTN_STORE16(p,v) __builtin_amdgcn_raw_buffer_store_b128((v),orsrc_,(unsigned)((const char*)(p)-(const char*)O),0,16)
#endif
template<int THRL> __device__ __forceinline__ void attn_unit(int b,int h,int qb,const bf16*Q,const bf16*__restrict__ K,const bf16*__restrict__ V,bf16*O,const float*kmean,char*shm){
  const int tid=threadIdx.x,lane=tid&63,r32=lane&31,hi=lane>>5; const int wid=__builtin_amdgcn_readfirstlane(tid>>6);
  const long rowbase=(long)b*SEQ; const int q0=qb*QB;
  const bf16*Qw=Q+(rowbase+q0+wid*QBLK)*DM+h*D;
  const bf16*Kh=K+rowbase*DM+h*D,*Vh=V+rowbase*DM+h*D;
  const unsigned lds0=(unsigned)(uintptr_t)shm;
  float*wsf=(float*)(shm+LDS_WS)+wid*64;
  const bf16*ksrc=Kh+(long)lane*DM+wid*8;
  const bf16*vsrc=Vh+(long)(16*(wid&3)+(lane>>2))*DM+(wid>>2)*32+(lane&3)*8;
  const unsigned kdst=lds0+LDS_K+wid*1024, vdst=lds0+LDS_V+wid*1024;
  #define POS(t) (((t)<4)?(NT-4+(t)):((t)-4))
  #define DMA_K(t,slot) glds16(ksrc+(long)POS(t)*KVBLK*DM,(unsigned)__builtin_amdgcn_readfirstlane(kdst+(slot)))
  #define DMA_V(t,slot) glds16(vsrc+(long)POS(t)*KVBLK*DM,(unsigned)__builtin_amdgcn_readfirstlane(vdst+(slot)))
  const int vb0=(int)(lds0+LDS_V)+((lane>>4)&1)*32+(lane&3)*8+(4*hi+((lane&15)>>2))*64;
  const char*Kbase=shm+LDS_K; bf16x8 kf[8];
  const lds_cptr shm3=(lds_cptr)shm; const lds_cptr kp0=shm3+LDS_K+hi*1024+r32*16; const lds_cptr vp0=shm3+LDS_V+((lane>>4)&1)*32+(lane&3)*8+(4*hi+((lane&15)>>2))*64;
  const int NT=(q0+QB)/KVBLK;
  DMA_K(0,0);DMA_V(0,0);DMA_K(1,SLOTB);
  bf16x8 qr[4];
  #pragma unroll
  for(int d0=0;d0<4;++d0)qr[d0]=*reinterpret_cast<const bf16x8*>(&Qw[(long)r32*DM+d0*16+hi*8]);
  float mhat=0.f,l_reg=0.f;f32x16 o[2];o[0]=f32x16{};o[1]=f32x16{};
  const float slope2=ldexpf(1.4426950408889634f,-(h+1));
  unsigned selmask=0u;
  { typedef __attribute__((address_space(3))) float* lds_fptr; typedef __attribute__((address_space(3))) const f32x4_t* lds_f4ptr;
    lds_fptr kml=(lds_fptr)((lds_cptr)shm+LDS_KM);
    { const float*src=kmean+((long)b*16)*2*DM+h*D;
      #pragma unroll
      for(int i=0;i<2;++i){const int e=tid+512*i; kml[e]=src[(e>>6)*2*DM+(e&63)]+src[(e>>6)*2*DM+DM+(e&63)];} }
    asm volatile("s_waitcnt vmcnt(0) lgkmcnt(0)\n\ts_barrier":::"memory");
    float qf[32];
    #pragma unroll
    for(int d0=0;d0<4;++d0){
      #pragma unroll
      for(int j=0;j<8;++j)qf[d0*8+j]=__uint_as_float(((unsigned)(unsigned short)qr[d0][j])<<16);}
    float sc[16];
    #pragma unroll
    for(int j=0;j<16;++j){ sc[j]=-INFINITY;
      if(j<qb){ lds_f4ptr kr=(lds_f4ptr)(kml+j*64+hi*8); float a=0.f;
        #pragma unroll
        for(int d0=0;d0<4;++d0){ const f32x4_t k0=kr[d0*4],k1=kr[d0*4+1];
          a+=qf[d0*8+0]*k0[0]+qf[d0*8+1]*k0[1]+qf[d0*8+2]*k0[2]+qf[d0*8+3]*k0[3]+qf[d0*8+4]*k1[0]+qf[d0*8+5]*k1[1]+qf[d0*8+6]*k1[2]+qf[d0*8+7]*k1[3]; }
        a+=__shfl_xor(a,32); sc[j]=a; } }
    #pragma unroll
    for(int j=0;j<15;++j){ int cnt=0;
      #pragma unroll
      for(int k=0;k<15;++k){ if(k!=j) cnt+=((sc[k]>sc[j])||((sc[k]==sc[j])&&(k<j)))?1:0; }
      if(j<qb&&cnt<3) selmask|=(1u<<j); } }
  #define CINIT(C0,C1,t) do{ const int pt_=POS(t); float x_=slope2*(float)(64*pt_-q0+4*hi)-mhat; \
    if((t)>=4){ x_+=((selmask>>(pt_>>2))&1u)?0.f:-30000.f; } const float y_=x_+32.f*slope2; \
    _Pragma("unroll") for(int r=0;r<16;++r){ const float cr_=(float)((r&3)+8*(r>>2)); C0[r]=__builtin_fmaf(slope2,cr_,x_); C1[r]=__builtin_fmaf(slope2,cr_,y_); } }while(0)

  const int qrel=wid*QBLK+r32;
  #define CMASK(P0,P1,t) do{ if((t)<4)cmask(P0,P1,(t),qrel,hi);}while(0)
  bool resc=false;
  #define START(P0,P1) do{ const float rm=rowmax(P0,P1); resc=false; \
    { const float dl=rm; mhat=fadd_s(mhat,dl); \
      _Pragma("unroll") for(int r=0;r<16;++r){P0[r]=fsub_s(P0[r],dl);P1[r]=fsub_s(P1[r],dl);} } \
    _Pragma("unroll") for(int r=0;r<16;++r)P0[r]=__builtin_amdgcn_exp2f(P0[r]); }while(0)
  #define RESC() do{ if(resc){ asm volatile("s_waitcnt lgkmcnt(0)":::"memory"); \
      _Pragma("unroll") for(int d_=0;d_<2;++d_) _Pragma("unroll") for(int r=0;r<16;++r)o[d_][r]*=wsf[crow(r,hi)]; } }while(0)
  f32x16 pA0,pA1,pB0,pB1;
  int sl_prev=0,sl_cur=0,sl_next=SLOTB;
  #define ROT() do{sl_prev=sl_cur;sl_cur=sl_next;sl_next=(sl_next==(NSLOT-1)*SLOTB)?0:sl_next+SLOTB;}while(0)
  DMA_K(2,2*SLOTB);
  WAIT_BAR(3);
  CINIT(pA0,pA1,0); qkt(pA0,pA1,Kbase,qr,r32,hi);asm volatile("s_nop 15\n\ts_nop 7":"+v"(pA0),"+v"(pA1));CMASK(pA0,pA1,0);
  START(pA0,pA1);
  _Pragma("unroll") for(int r=0;r<16;++r)pA1[r]=__builtin_amdgcn_exp2f(pA1[r]);
  WAIT_BAR(0);
  DMA_K(3,0);DMA_V(1,SLOTB);
  ROT();
  kload8(kf,kp0+sl_cur);
  WAIT_BAR(2);
  s16x4 vlo[8],vhi[8]; u32x4 pw0,pw1,pw2,pw3;
  #define PKW(P,B) cvtpk_s(P[B],P[B+1])
  #define PAF(k) __builtin_bit_cast(bf16x8,pw##k)
  #define VFR(i) (bf16x8){vlo[i][0],vlo[i][1],vlo[i][2],vlo[i][3],vhi[i][0],vhi[i][1],vhi[i][2],vhi[i][3]}
  #define PIN(x) asm volatile("":"+v"(x))
  #define MX3(a,b,c) __builtin_fmaxf(__builtin_fmaxf((a),(b)),(c))
  #define GAPA(MF,A0,A1,A2,A3,W0,W1,PW) do{ MF; sacc+=A0; sacc+=A1; sacc+=A2; sacc+=A3; PIN(sacc); W0; W1; PIN(PW); SBAR(); }while(0)
  #define EX(v) __builtin_amdgcn_exp2f(v)
  #define GAPB(MF,X,B) do{ MF; X[B]=EX(X[B]); X[B+1]=EX(X[B+1]); X[B+2]=EX(X[B+2]); X[B+3]=EX(X[B+3]); PIN(X); SBAR(); }while(0)
  #define VRD(i) do{ vlo[i]=vtr(vp_+(((i)>>2)*4096+((i)&3)*1024)); vhi[i]=vtr(vp_+(((i)>>2)*4096+((i)&3)*1024+512)); }while(0)
  #define KRD(G,j) do{ if(G){ kload2(kf,kp0+sl_next,j); SBAR(); } }while(0)
  #define STEP(C0,C1,P0,P1,t,GK,GV,GL) do{ SBAR(); CINIT(C0,C1,t); PIN(C0); PIN(C1); SBAR(); \
    const lds_cptr vp_=vp0+sl_prev; \
    VRD(0); SBAR(); float sacc=(P0[0]+P0[1]); \
    GAPA(C0=__builtin_amdgcn_mfma_f32_32x32x16_bf16(kf[0],qr[0],C0,0,0,0), P0[2],P0[3],P0[4],P0[5],     pw0[0]=PKW(P0,0), pw0[1]=PKW(P0,2), pw0); \
    VRD(4); SBAR(); GAPA(C1=__builtin_amdgcn_mfma_f32_32x32x16_bf16(kf[1],qr[0],C1,0,0,0), P0[6],P0[7],P0[8],P0[9],     pw0[2]=PKW(P0,4), pw0[3]=PKW(P0,6), pw0); \
    VRD(1); SBAR(); GAPA(C0=__builtin_amdgcn_mfma_f32_32x32x16_bf16(kf[2],qr[1],C0,0,0,0),   P0[10],P0[11],P0[12],P0[13], pw1[0]=PKW(P0,8), pw1[1]=PKW(P0,10), pw1); \
    VRD(5); SBAR(); GAPA(C1=__builtin_amdgcn_mfma_f32_32x32x16_bf16(kf[3],qr[1],C1,0,0,0),   P0[14],P0[15],P1[0],P1[1],   pw1[2]=PKW(P0,12),pw1[3]=PKW(P0,14), pw1); \
    VRD(2); SBAR(); GAPA(C0=__builtin_amdgcn_mfma_f32_32x32x16_bf16(kf[4],qr[2],C0,0,0,0),   P1[2],P1[3],P1[4],P1[5],     pw2[0]=PKW(P1,0), pw2[1]=PKW(P1,2), pw2); \
    VRD(6); SBAR(); GAPA(C1=__builtin_amdgcn_mfma_f32_32x32x16_bf16(kf[5],qr[2],C1,0,0,0),   P1[6],P1[7],P1[8],P1[9],     pw2[2]=PKW(P1,4), pw2[3]=PKW(P1,6), pw2); \
    VRD(3); SBAR(); GAPA(C0=__builtin_amdgcn_mfma_f32_32x32x16_bf16(kf[6],qr[3],C0,0,0,0),   P1[10],P1[11],P1[12],P1[13], pw3[0]=PKW(P1,8), pw3[1]=PKW(P1,10), pw3); \
    VRD(7); SBAR(); GAPA(C1=__builtin_amdgcn_mfma_f32_32x32x16_bf16(kf[7],qr[3],C1,0,0,0),   P1[14],P1[15],0.f,0.f,       pw3[2]=PKW(P1,12),pw3[3]=PKW(P1,14), pw3); \
    l_reg+=sacc; \
    if(GK){DMA_K((t)+3,sl_cur);} if(GV){DMA_V((t)+1,sl_next);} \
    CMASK(C0,C1,t); \
    { float a=MX3(C0[0],C0[1],C1[0]),b=MX3(C0[2],C0[3],C1[1]); a=MX3(a,C1[2],C1[3]); \
      _Pragma("unroll") for(int r=4;r<16;r+=4){a=MX3(a,C0[r],C0[r+1]);b=MX3(b,C0[r+2],C0[r+3]);a=MX3(a,C1[r],C1[r+1]);b=MX3(b,C1[r+2],C1[r+3]);} \
      float rm=__builtin_fmaxf(a,b); { auto rr=__builtin_amdgcn_permlane32_swap(__float_as_uint(rm),__float_as_uint(rm),false,false); rm=__builtin_fmaxf(__uint_as_float(rr[0]),__uint_as_float(rr[1])); } \
      resc=false; \
      if(__builtin_expect(__any(rm>(float)THRL),0)){ const float dl=__builtin_fmaxf(rm,0.f); mhat+=dl; \
        _Pragma("unroll") for(int r=0;r<16;++r){C0[r]-=dl;C1[r]-=dl;} \
        const float f=__builtin_amdgcn_exp2f(-dl); l_reg*=f; if(hi==0)wsf[r32]=f; resc=true; } } \
    SBAR(); \
    GAPB(o[0]=__builtin_amdgcn_mfma_f32_32x32x16_bf16(PAF(0),VFR(0),o[0],0,0,0), C0,0); \
    GAPB(o[1]=__builtin_amdgcn_mfma_f32_32x32x16_bf16(PAF(0),VFR(4),o[1],0,0,0), C0,4); \
    KRD(GL,0); GAPB(o[0]=__builtin_amdgcn_mfma_f32_32x32x16_bf16(PAF(1),VFR(1),o[0],0,0,0), C0,8); \
    KRD(GL,1); GAPB(o[1]=__builtin_amdgcn_mfma_f32_32x32x16_bf16(PAF(1),VFR(5),o[1],0,0,0), C0,12); \
    KRD(GL,2); GAPB(o[0]=__builtin_amdgcn_mfma_f32_32x32x16_bf16(PAF(2),VFR(2),o[0],0,0,0), C1,0); \
    KRD(GL,3); GAPB(o[1]=__builtin_amdgcn_mfma_f32_32x32x16_bf16(PAF(2),VFR(6),o[1],0,0,0), C1,4); \
    GAPB(o[0]=__builtin_amdgcn_mfma_f32_32x32x16_bf16(PAF(3),VFR(3),o[0],0,0,0), C1,8); \
    GAPB(o[1]=__builtin_amdgcn_mfma_f32_32x32x16_bf16(PAF(3),VFR(7),o[1],0,0,0), C1,12); \
    }while(0)
  int t=1;
  #define ENDW(tt) do{ if((tt)+3<NT){WAIT_BAR(2);} else if((tt)+2<NT){WAIT_BAR(1);} else {WAIT_BAR(0);} }while(0)
  for(;t<5&&t+1<NT;t+=2){
    STEP(pB0,pB1,pA0,pA1,t,(t+3<NT),(t+1<NT),(t+1<NT));       ENDW(t);   RESC(); ROT();
    STEP(pA0,pA1,pB0,pB1,t+1,(t+4<NT),(t+2<NT),(t+2<NT));     ENDW(t+1); RESC(); ROT();
  }
  #undef CMASK
  #define CMASK(P0,P1,t) do{}while(0)
  for(;t+5<NT;t+=2){
    STEP(pB0,pB1,pA0,pA1,t,true,true,true);     WAIT_BAR(2); RESC(); ROT();
    STEP(pA0,pA1,pB0,pB1,t+1,true,true,true);   WAIT_BAR(2); RESC(); ROT();
  }
  for(;t+1<NT;t+=2){
    STEP(pB0,pB1,pA0,pA1,t,(t+3<NT),(t+1<NT),(t+1<NT));       ENDW(t);   RESC(); ROT();
    STEP(pA0,pA1,pB0,pB1,t+1,(t+4<NT),(t+2<NT),(t+2<NT));     ENDW(t+1); RESC(); ROT();
  }
  #undef CMASK
  #define CMASK(P0,P1,t) do{ if((t)<4)cmask(P0,P1,(t),qrel,hi);}while(0)
  STEP(pB0,pB1,pA0,pA1,NT-1,false,false,false); RESC();
  { float sacc=pB0[0]+pB0[1]; _Pragma("unroll") for(int r=2;r<16;++r)sacc+=pB0[r]; _Pragma("unroll") for(int r=0;r<16;++r)sacc+=pB1[r]; l_reg+=sacc;
    pw0=(u32x4){PKW(pB0,0),PKW(pB0,2),PKW(pB0,4),PKW(pB0,6)};pw1=(u32x4){PKW(pB0,8),PKW(pB0,10),PKW(pB0,12),PKW(pB0,14)};pw2=(u32x4){PKW(pB1,0),PKW(pB1,2),PKW(pB1,4),PKW(pB1,6)};pw3=(u32x4){PKW(pB1,8),PKW(pB1,10),PKW(pB1,12),PKW(pB1,14)};
    SBAR(); pv(o,vb0+sl_cur,PAF(0),PAF(1),PAF(2),PAF(3)); }
  #undef PKW
  #undef PAF
  #undef VFR
  #undef PIN
  #undef MX3
  #undef GAPA
  #undef GAPB
  #undef EX
  #undef VRD
  #undef KRD
  #undef STEP
  #undef ENDW
  {auto rr=__builtin_amdgcn_permlane32_swap(__float_as_uint(l_reg),__float_as_uint(l_reg),false,false);l_reg=__uint_as_float(rr[0])+__uint_as_float(rr[1]);}
  if(hi==0)wsf[32+r32]=l_reg;asm volatile("s_waitcnt lgkmcnt(0)":::"memory");
  float rli[16];
  #pragma unroll
  for(int r=0;r<16;++r)rli[r]=__builtin_amdgcn_rcpf(wsf[32+crow(r,hi)]);
  bf16*Ow=O+(rowbase+q0+wid*QBLK)*OPITCH+h*D; const __amdgpu_buffer_rsrc_t orsrc_=__builtin_amdgcn_make_buffer_rsrc((void*)O,0,0x7fffffff,0x00020000);
  { bf16*stg=(bf16*)(shm+LDS_OST)+wid*2048;
    #pragma unroll
    for(int r=0;r<16;++r){const int orow=crow(r,hi);
      #pragma unroll
      for(int d0=0;d0<2;++d0)stg[orow*64+d0*32+r32]=__float2bfloat16(o[d0][r]*rli[r]);}
    asm volatile("s_waitcnt lgkmcnt(0)":::"memory");
    #pragma unroll
    for(int i=0;i<4;++i){const int row=i*8+(lane>>3),ch=lane&7; const u32x4 v=*(const u32x4*)(stg+row*64+ch*8); ATTN_STORE16(Ow+(long)row*OPITCH+ch*8,v);} }
  asm volatile("s_waitcnt lgkmcnt(0)\n\ts_barrier":::"memory");
  #undef DMA_K
  #undef DMA_V
  #undef POS
  #undef CINIT
  #undef CMASK
  #undef START
  #undef RESC
  #undef ROT
}
constexpr int ATTN_LDS_BYTES=LDS_BYTES;
struct AttnTensors { const bf16* Q; const bf16* K; const bf16* V; bf16* O; const float* kmean; };
struct AttnUnit { int bh; int qb; };
struct StaticOrder {
  int vcu,grid;
  __device__ __forceinline__ explicit StaticOrder(int grid_,int block):vcu((grid_%8==0)?((block%8)*(grid_/8)+block/8):block),grid(grid_){}
  __device__ __forceinline__ bool next(int i,AttnUnit&u)const{ const int item=(i>>1)*grid+vcu; if(item>=BATCH*NHEAD*8)return false; const int s=item&7; u.bh=item>>3; u.qb=(i&1)?15-s:s; return true; }
  __device__ __forceinline__ void a_ready(const AttnUnit&)const{}
  __device__ __forceinline__ void done(const AttnUnit&)const{}
};
template<class Sched,int THRL=8> __device__ __forceinline__ void attn_phase(char*lds,const AttnTensors&T,const Sched&S){
  AttnUnit u;
  for(int i=0;S.next(i,u);++i){ S.a_ready(u); attn_unit<THRL>(u.bh/NHEAD,u.bh%NHEAD,u.qb,T.Q,T.K,T.V,T.O,T.kmean,lds); S.done(u); }
}
#undef SBAR
#undef WAIT_BAR
}

constexpr int NWAVES = 8;
#ifndef MK_N_LAUNCHES
#define MK_N_LAUNCHES 1
#endif
constexpr int N_LAUNCHES = MK_N_LAUNCHES;
constexpr int PER_PHASE = 8;

constexpr int BATCH = 8, SEQ = 4096, DM = 1024, TOK = BATCH * SEQ;
constexpr int CONV_CH = 512, CONV_W = 31, ATT_W = 512, IN_COLS = 4608;
constexpr int P_HEADS = 8, P_NK = 128, P_TOPK = 16, P_E = P_HEADS * P_TOPK  , N_EXP = P_NK * P_NK;
constexpr float NORM_EPS = 1e-6f;

constexpr size_t MiB = 1u << 20;
constexpr size_t WS_CTL = 0, CTL_ZERO_BYTES = 65536;
constexpr size_t WS_KMEAN = 1 * MiB;
constexpr size_t WS_SS = 2 * MiB;
constexpr size_t WS_WIN = 4 * MiB;
constexpr size_t WS_WPW = 13 * MiB, WS_WAO = 14 * MiB;
constexpr size_t WS_WOUT = 15 * MiB;
constexpr size_t WS_WQ = 17 * MiB;
constexpr size_t WS_KEYS = 21 * MiB;
constexpr size_t WS_USC = 22 * MiB, WS_VSC = 22 * MiB + 65536;
constexpr size_t WS_UB = 24 * MiB, WS_VB = 56 * MiB;
constexpr size_t WS_H = 88 * MiB;
constexpr size_t WS_CACT = 88 * MiB;
constexpr size_t WS_EIDX = 104 * MiB, WS_GW = 120 * MiB, WS_GA = 136 * MiB;
constexpr size_t WS_ZGLU = 152 * MiB, WS_QO = 184 * MiB, WS_K = 216 * MiB, WS_V = 248 * MiB;
constexpr size_t WS_MIX = 216 * MiB;
constexpr size_t WS_QP = 152 * MiB;
constexpr size_t WS_COEF = 152 * MiB, WS_SS2 = 168 * MiB;
constexpr size_t WS_GC = 280 * MiB, WS_GATE_A = 344 * MiB;
constexpr size_t WS_X1B = 280 * MiB;
constexpr size_t WS_X8 = 344 * MiB, WS_XS = 377 * MiB;
constexpr size_t WS_END = 408 * MiB;
constexpr int CW_TMO = 0, CW_CODE = 1, CW_CONVQ = 64, CW_BAR = 4096;

constexpr int RING_OFF = 0, RING_BYTES = 131072;
constexpr int LDSCTL_OFF = RING_BYTES, MISC_OFF = LDSCTL_OFF + 320;
constexpr int LDS_BYTES = 155648;
constexpr int VT_PITCH = 80, VT_BYTES = 128 * VT_PITCH, VT_LAST_OFF = LDSCTL_OFF + 1024, P7_CNT_OFF = LDSCTL_OFF + 512;
static_assert(7 * VT_BYTES <= RING_BYTES && VT_LAST_OFF + VT_BYTES <= LDS_BYTES && MISC_OFF + 128 <= P7_CNT_OFF, "PEER v tiles");
constexpr float C8_SCALE = 4096.f;
static_assert(MISC_OFF + 128 <= LDS_BYTES, "LDS map");

#define GAS __attribute__((address_space(1)))
#define LAS __attribute__((address_space(3)))
typedef unsigned short bf16;
typedef unsigned v4u __attribute__((ext_vector_type(4)));
typedef float f32x4 __attribute__((ext_vector_type(4)));
typedef float f32x16 __attribute__((ext_vector_type(16)));
typedef short bf16x8 __attribute__((ext_vector_type(8)));
typedef __bf16 bf16x2_t __attribute__((ext_vector_type(2)));
typedef GAS unsigned gu32;
#define RLX_AGENT __ATOMIC_RELAXED, __HIP_MEMORY_SCOPE_AGENT
#define LDS_WAIT() asm volatile("s_waitcnt lgkmcnt(0)" ::: "memory")
#define VM_WAIT() asm volatile("s_waitcnt vmcnt(0)" ::: "memory")
__device__ __forceinline__ unsigned f2bf(float f) { unsigned u = __builtin_bit_cast(unsigned, f); return (u + 0x7fffu + ((u >> 16) & 1u)) >> 16; }
__device__ __forceinline__ unsigned pk2(float lo, float hi) { return f2bf(lo) | (f2bf(hi) << 16); }
__device__ __forceinline__ float bflo(unsigned u) { return __uint_as_float(u << 16); }
__device__ __forceinline__ float bfhi(unsigned u) { return __uint_as_float(u & 0xffff0000u); }

#define XB_TMO      128
#define XB_XCNT(j)  (256  + 64 * (j))
#define XB_XSUB(j)  (1280 + 64 * (j))
#define XB_XGEN(j)  (2304 + 64 * (j))
#define XB_TOP      3328
#define XB_TOPGEN   3392
#define XCD_BAR_WORDS 3456
#define XB_SPIN_CAP (1u << 18)

__device__ __forceinline__ unsigned xb_ld(unsigned* p)              { return __hip_atomic_load(p, __ATOMIC_RELAXED, __HIP_MEMORY_SCOPE_AGENT); }
__device__ __forceinline__ unsigned xb_add(unsigned* p, unsigned v) { return __hip_atomic_fetch_add(p, v, __ATOMIC_RELAXED, __HIP_MEMORY_SCOPE_AGENT); }
__device__ __forceinline__ unsigned xb_xcc_id() { return (unsigned)__builtin_amdgcn_s_getreg((3 << 11) | 20) & 0xFu; }
#define XB_SPIN(cond, bar) do { unsigned _sp = 0; while (cond) { __builtin_amdgcn_s_sleep(1); \
    if ((++_sp & 255u) == 0u) { if (xb_ld(&(bar)[XB_TMO])) break; if (_sp > XB_SPIN_CAP) { atomicAdd(&(bar)[XB_TMO], 1u); break; } } } } while (0)

struct XcdBarrier {
    unsigned* bar; unsigned x;
    volatile LAS unsigned* st;
};

__device__ __forceinline__ XcdBarrier xcd_barrier_post(unsigned* bar, volatile LAS unsigned* st) {
    XcdBarrier b; b.bar = bar; b.x = xb_xcc_id(); b.st = st;
    if (threadIdx.x == 0) (void)xb_add(&bar[XB_XCNT(b.x)], 1u);
    return b;
}
__device__ __forceinline__ void xcd_barrier_complete(unsigned* bar, unsigned x, unsigned& nloc, unsigned& nx) {
    const unsigned G = gridDim.x * gridDim.y * gridDim.z;
    unsigned sum, cnt, mine, sp = 0u;
    for (;;) {
        sum = 0u; cnt = 0u; mine = 0u;
#pragma unroll
        for (unsigned j = 0; j < 16; ++j) { const unsigned c = xb_ld(&bar[XB_XCNT(j)]); sum += c; cnt += (c > 0u) ? 1u : 0u; mine = (j == x) ? c : mine; }
        if (sum == G) break;
        __builtin_amdgcn_s_sleep(1);
        if ((++sp & 255u) == 0u) { if (xb_ld(&bar[XB_TMO])) break; if (sp > XB_SPIN_CAP) { atomicAdd(&bar[XB_TMO], 1u); break; } }
    }
    nloc = mine > 0u ? mine : 1u; nx = cnt > 0u ? cnt : 1u;
}

__device__ __forceinline__ void xcd_barrier(const XcdBarrier& b) {
    asm volatile("s_waitcnt vmcnt(0)" ::: "memory");
    __syncthreads();
    if (threadIdx.x == 0) {
        unsigned* bar = b.bar;
        __builtin_amdgcn_s_waitcnt(0);
        unsigned nloc = b.st[0], nx = b.st[1];
        if (nloc == 0u) { xcd_barrier_complete(bar, b.x, nloc, nx); b.st[0] = nloc; b.st[1] = nx; }
        const unsigned old = xb_add(&bar[XB_XSUB(b.x)], 1u);
        const unsigned gen = old / nloc;
        if (old + 1u == (gen + 1u) * nloc) {
            __builtin_amdgcn_fence(__ATOMIC_RELEASE, "agent");
            asm volatile("s_waitcnt vmcnt(0)" ::: "memory");
            const unsigned og = xb_add(&bar[XB_TOP], 1u);
            const unsigned tg = og / nx;
            if (og + 1u == (tg + 1u) * nx) xb_add(&bar[XB_TOPGEN], 1u);
            else XB_SPIN(xb_ld(&bar[XB_TOPGEN]) == tg, bar);
            __builtin_amdgcn_fence(__ATOMIC_ACQUIRE, "agent");
            xb_add(&bar[XB_XGEN(b.x)], 1u);
            asm volatile("s_waitcnt vmcnt(0)" ::: "memory");
        } else {
            XB_SPIN(xb_ld(&bar[XB_XGEN(b.x)]) == gen, bar);
            __builtin_amdgcn_fence(__ATOMIC_ACQUIRE, "agent");
            asm volatile("s_waitcnt vmcnt(0)" ::: "memory");
        }
    }
    __syncthreads();
}

struct Frame {
    LAS unsigned char* lds;
    volatile LAS unsigned* MISC;
    gu32* ctl;
    int tid, lane, wave;
    int vcu, G;
};
__device__ __forceinline__ float wave_sum(float v) {
#pragma unroll
    for (int o = 1; o < 64; o <<= 1) v += __shfl_xor(v, o);
    return v;
}

__device__ __forceinline__ float wave_sum_hi(float v) {
    v += __builtin_bit_cast(float, __builtin_amdgcn_update_dpp(0, __builtin_bit_cast(int, v), 0xB1, 0xf, 0xf, false));
    v += __builtin_bit_cast(float, __builtin_amdgcn_update_dpp(0, __builtin_bit_cast(int, v), 0x4E, 0xf, 0xf, false));
    v += __builtin_bit_cast(float, __builtin_amdgcn_update_dpp(0, __builtin_bit_cast(int, v), 0x141, 0xf, 0xf, false));
    v += __builtin_bit_cast(float, __builtin_amdgcn_update_dpp(0, __builtin_bit_cast(int, v), 0x140, 0xf, 0xf, false));
    v += __builtin_bit_cast(float, __builtin_amdgcn_update_dpp(0, __builtin_bit_cast(int, v), 0x142, 0xA, 0xF, false));
    v += __builtin_bit_cast(float, __builtin_amdgcn_update_dpp(0, __builtin_bit_cast(int, v), 0x143, 0xC, 0xF, false));
    return v;
}

__device__ __forceinline__ void p0_transpose_item(const float* W, int K, int N, bf16* WT, int k0, int n0, int dst_row0, const float* kscale, LAS float* scr, int lane, int dpitch = 0, int koff = 0) {
    if (dpitch == 0) dpitch = K;
#pragma unroll 8
    for (int i = 0; i < 32; ++i) { const int kk = 2 * i + (lane >> 5); float v = W[(size_t)(k0 + kk) * N + n0 + (lane & 31)]; if (kscale) v *= kscale[k0 + kk]; scr[kk * 33 + (lane & 31)] = v; }
    LDS_WAIT(); asm volatile("" ::: "memory");
    const int c = lane & 7;
#pragma unroll
    for (int j = 0; j < 4; ++j) { const int n = (lane >> 3) + 8 * j; const LAS float* s = scr + (8 * c) * 33 + n;
        v4u o; o.x = pk2(s[0 * 33], s[1 * 33]); o.y = pk2(s[2 * 33], s[3 * 33]); o.z = pk2(s[4 * 33], s[5 * 33]); o.w = pk2(s[6 * 33], s[7 * 33]);
        *(GAS v4u*)(WT + (size_t)(dst_row0 + n) * dpitch + koff + k0 + 8 * c) = o; }
    LDS_WAIT(); asm volatile("" ::: "memory");
}
__device__ __forceinline__ int perm_in(int s) { if (s < 512) return 256 * (s >> 7) + (s & 127); if (s < 1024) { const int s2 = s - 512; return 256 * (s2 >> 7) + 128 + (s2 & 127); } return s; }
__device__ __forceinline__ float wave_max(float v) {
#pragma unroll
    for (int o = 1; o < 64; o <<= 1) v = fmaxf(v, __shfl_xor(v, o));
    return v;
}
template <bool NORM, int NR> __device__ __forceinline__ void rows_to_bf16(int lane, const float* xrow, size_t rstride, const float* g, bf16* orow) {
    f32x4 v[NR][4]; float s2[NR];
#pragma unroll
    for (int q = 0; q < NR; ++q) { const GAS f32x4* xr = (const GAS f32x4*)(xrow + q * rstride) + lane;
#pragma unroll
        for (int j = 0; j < 4; ++j) v[q][j] = xr[64 * j]; }
#pragma unroll
    for (int q = 0; q < NR; ++q) { s2[q] = 0.f;
#pragma unroll
        for (int j = 0; j < 4; ++j) s2[q] += (v[q][j].x * v[q][j].x + v[q][j].y * v[q][j].y) + (v[q][j].z * v[q][j].z + v[q][j].w * v[q][j].w); }
    float rstd[NR];
#pragma unroll
    for (int q = 0; q < NR; ++q) rstd[q] = NORM ? 1.f / sqrtf(wave_sum(s2[q]) * (1.f / 1024.f) + NORM_EPS) : 1.f;
#pragma unroll
    for (int j = 0; j < 4; ++j) { f32x4 gv = (f32x4){1.f, 1.f, 1.f, 1.f}; if (g) gv = *((const GAS f32x4*)g + lane + 64 * j);
#pragma unroll
        for (int q = 0; q < NR; ++q) { const f32x4 w = v[q][j] * rstd[q] * gv;
            ((GAS unsigned long long*)(orow + q * rstride) + lane)[64 * j] = (unsigned long long)pk2(w.x, w.y) | ((unsigned long long)pk2(w.z, w.w) << 32); } }
}
template <bool NORM> __device__ __forceinline__ void row_to_bf16(int lane, const float* xrow, const float* g, bf16* orow) { rows_to_bf16<NORM, 1>(lane, xrow, 1024, g, orow); }
template <bool SLICED> __device__ __forceinline__ void row_to_fp8(int lane, const float* xrow, const float* g, unsigned char* base, int row, float* isc) {
    const GAS f32x4* xr = (const GAS f32x4*)xrow + lane;
    f32x4 v[4]; float am = 0.f;
#pragma unroll
    for (int j = 0; j < 4; ++j) { v[j] = xr[64 * j]; if (g) v[j] = v[j] * *((const GAS f32x4*)g + lane + 64 * j);
        am = fmaxf(am, fmaxf(fmaxf(fabsf(v[j].x), fabsf(v[j].y)), fmaxf(fabsf(v[j].z), fabsf(v[j].w)))); }
#pragma unroll
    for (int o = 1; o < 64; o <<= 1) am = fmaxf(am, __shfl_xor(am, o));
    const float sc = am > 0.f ? 240.f / am : 1.f;
    if (lane == 0) isc[row] = am > 0.f ? am * (1.f / 240.f) : 1.f;
#pragma unroll
    for (int j = 0; j < 4; ++j) { int w = 0; w = __builtin_amdgcn_cvt_pk_fp8_f32(v[j].x * sc, v[j].y * sc, w, false); w = __builtin_amdgcn_cvt_pk_fp8_f32(v[j].z * sc, v[j].w * sc, w, true);
        if (SLICED) *(GAS int*)(base + (size_t)(2 * j + (lane >> 5)) * ((size_t)N_EXP * 128) + (size_t)row * 128 + 4 * (lane & 31)) = w;
        else *(GAS int*)(base + (size_t)row * 1024 + 4 * (lane + 64 * j)) = w; }
}
__device__ __forceinline__ void rows_to_fp8_uv(int lane, const float* urow, const float* vrow, const float* g, unsigned char* ub8, unsigned char* vb8, int row, float* usc, float* vsc) {
    f32x4 u[4], v[4]; float au = 0.f, av = 0.f;
#pragma unroll
    for (int j = 0; j < 4; ++j) { u[j] = ((const GAS f32x4*)urow + lane)[64 * j]; v[j] = ((const GAS f32x4*)vrow + lane)[64 * j]; }
#pragma unroll
    for (int j = 0; j < 4; ++j) { u[j] = u[j] * *((const GAS f32x4*)g + lane + 64 * j);
        au = fmaxf(au, fmaxf(fmaxf(fabsf(u[j].x), fabsf(u[j].y)), fmaxf(fabsf(u[j].z), fabsf(u[j].w))));
        av = fmaxf(av, fmaxf(fmaxf(fabsf(v[j].x), fabsf(v[j].y)), fmaxf(fabsf(v[j].z), fabsf(v[j].w)))); }
#pragma unroll
    for (int o = 1; o < 64; o <<= 1) { au = fmaxf(au, __shfl_xor(au, o)); av = fmaxf(av, __shfl_xor(av, o)); }
    const float su = au > 0.f ? 240.f / au : 1.f, sv = av > 0.f ? 6.f / av : 1.f;
    if (lane == 0) { usc[row] = au > 0.f ? au * (1.f / 240.f) : 1.f; vsc[row] = av > 0.f ? av * (1.f / 6.f) : 1.f; }
#pragma unroll
    for (int j = 0; j < 4; ++j) { int w = 0; w = __builtin_amdgcn_cvt_pk_fp8_f32(u[j].x * su, u[j].y * su, w, false); w = __builtin_amdgcn_cvt_pk_fp8_f32(u[j].z * su, u[j].w * su, w, true);
        *(GAS int*)(ub8 + (size_t)row * 1024 + 4 * (lane + 64 * j)) = w;
        { const float fv[4] = {v[j].x * sv, v[j].y * sv, v[j].z * sv, v[j].w * sv}; unsigned pk = 0;
#pragma unroll
          for (int i = 0; i < 4; ++i) { const float af = fabsf(fv[i]);
              const unsigned code = (af < 0.25f ? 0u : af < 0.75f ? 1u : af < 1.25f ? 2u : af < 1.75f ? 3u : af < 2.5f ? 4u : af < 3.5f ? 5u : af < 5.f ? 6u : 7u) | (fv[i] < 0.f ? 8u : 0u);
              pk |= code << (4 * i); }
          const int c = 4 * lane + 256 * j;
          *(GAS unsigned short*)(vb8 + (size_t)(c >> 7) * ((size_t)N_EXP * 64) + (size_t)row * 64 + ((c & 127) >> 1)) = (unsigned short)pk; } }
}
struct P0Args { const float *x, *g1, *w_in, *w_pw, *w_ao, *w_out, *g2, *w_q, *k1, *k2, *pu, *pv; bf16 *H, *Win, *Wpw, *Wao, *Wout, *Wq, *keys; unsigned char *ub8, *vb8; float *usc, *vsc; };
__device__ __forceinline__ void p0_prologue(Frame& F, const P0Args& a) {
    LAS float* scr = (LAS float*)(F.lds + RING_OFF + F.wave * 16384);
    const int gw = F.vcu * NWAVES + F.wave, NGW = F.G * NWAVES;
    constexpr int I_IN = 16 * (IN_COLS / 32), I_PW = 8 * 32, I_AO = 8 * 32, I_OUT = 16 * 32, I_Q = 16 * 64;
    constexpr int NITEMS = I_IN + I_PW + I_AO + I_OUT + I_Q;
    for (int it = gw; it < NITEMS; it += NGW) {
        int r = it;
        if (r < I_IN) { const int nb = IN_COLS / 32, kb = r / nb, n0 = 32 * (r % nb); p0_transpose_item(a.w_in, 1024, IN_COLS, a.Win, 64 * kb, n0, perm_in(n0), nullptr, scr, F.lane); continue; } r -= I_IN;
        if (r < I_PW) { const int kb = r / 32, n0 = 32 * (r % 32); p0_transpose_item(a.w_pw, 512, 1024, a.Wpw, 64 * kb, n0, n0, nullptr, scr, F.lane, 1024, 0); continue; } r -= I_PW;
        if (r < I_AO) { const int kb = r / 32, n0 = 32 * (r % 32); p0_transpose_item(a.w_ao, 512, 1024, a.Wpw, 64 * kb, n0, n0, nullptr, scr, F.lane, 1024, 512); continue; }   r -= I_AO;
        if (r < I_OUT) { const int kb = r / 32, n0 = 32 * (r % 32); p0_transpose_item(a.w_out, 1024, 1024, a.Wout, 64 * kb, n0, n0, nullptr, scr, F.lane); continue; } r -= I_OUT;
        { const int kb = r / 64, n0 = 32 * (r % 64); p0_transpose_item(a.w_q, 1024, 2048, a.Wq, 64 * kb, n0, n0, a.g2, scr, F.lane); }
    }
    for (int m = 4 * gw; m < TOK; m += 4 * NGW) rows_to_bf16<true, 4>(F.lane, a.x + (size_t)m * 1024, 1024, a.g1, a.H + (size_t)m * 1024);
    for (int m = gw; m < N_EXP; m += NGW) rows_to_fp8_uv(F.lane, a.pu + (size_t)m * 1024, a.pv + (size_t)m * 1024, a.g2, a.ub8, a.vb8, m, a.usc, a.vsc);
    for (int m = gw; m < 32; m += NGW) { const float* src = (m < 16 ? a.k1 : a.k2) + (size_t)(m & 15) * 1024; row_to_bf16<false>(F.lane, src, nullptr, a.keys + (size_t)m * 1024); }
}

struct ConvArgs { const bf16* zglu; const float *cw, *cb, *lg, *lb; bf16* cact; };
__device__ __forceinline__ void conv_phase(Frame& F, const ConvArgs& a) {
    LAS unsigned char* zs = F.lds + RING_OFF;
    LAS float* part = (LAS float*)(F.lds + RING_OFF + 98304);
    int tid_ = F.tid; asm volatile("" : "+v"(tid_));
    const int cp = tid_ & 255, half = tid_ >> 8, c0 = 2 * cp;
    float w0[CONV_W], w1[CONV_W];
    { const GAS float* p = (const GAS float*)(a.cw + c0);
#pragma unroll
      for (int w = 0; w < CONV_W; ++w) { w0[w] = p[0]; w1[w] = p[1]; p += 512; asm volatile("" : "+v"(p)); } }
    const float b0 = a.cb[c0], b1 = a.cb[c0 + 1], lg0 = a.lg[c0], lg1 = a.lg[c0 + 1], lb0 = a.lb[c0], lb1 = a.lb[c0 + 1];
    for (int tile = F.vcu; tile < TOK / 64; tile += F.G) {
        const int t0 = tile * 64, tb = t0 & (SEQ - 1);
#pragma unroll
        for (int hb = 0; hb < 2; ++hb) { v4u zv[6];
#pragma unroll
          for (int q = 0; q < 6; ++q) { const int i = tid_ + 512 * (6 * hb + q), r = i >> 6, ch = i & 63; zv[q] = (v4u){0u, 0u, 0u, 0u};
              if (i < 94 * 64 && tb - 30 + r >= 0) zv[q] = *(const GAS v4u*)(a.zglu + (size_t)(t0 - 30 + r) * 512 + ch * 8); }
#pragma unroll
          for (int q = 0; q < 6; ++q) { const int i = tid_ + 512 * (6 * hb + q), r = i >> 6, ch = i & 63; if (i < 94 * 64) *(LAS v4u*)(zs + r * 1024 + ch * 16) = zv[q]; } }
        __syncthreads();
        for (int ch8 = 0; ch8 < 4; ++ch8) {
            const int tl = half * 32 + ch8 * 8;
            float z0[38], z1[38];
#pragma unroll
            for (int i = 0; i < 38; ++i) { const unsigned u = *(const LAS unsigned*)(zs + (tl + i) * 1024 + cp * 4); z0[i] = bflo(u); z1[i] = bfhi(u); }
            float a0[8], a1[8];
#pragma unroll
            for (int k = 0; k < 8; ++k) { float s0 = b0, s1 = b1;
#pragma unroll
                for (int w = 0; w < CONV_W; ++w) { s0 += w0[w] * z0[k + w]; s1 += w1[w] * z1[k + w]; }
                a0[k] = s0; a1[k] = s1; }
#pragma unroll
            for (int k = 0; k < 8; ++k) { const float s1 = wave_sum_hi(a0[k] + a1[k]), s2 = wave_sum_hi(a0[k] * a0[k] + a1[k] * a1[k]);
                if (F.lane == 63) { part[((half * 8 + k) * 4 + (F.wave & 3)) * 2] = s1; part[((half * 8 + k) * 4 + (F.wave & 3)) * 2 + 1] = s2; } }
            __syncthreads();
            bf16* op = a.cact + (size_t)(t0 + tl) * 1024 + c0;
#pragma unroll
            for (int k = 0; k < 8; ++k) { const LAS float* p = part + (half * 8 + k) * 8;
                const float S1 = (p[0] + p[2]) + (p[4] + p[6]), S2 = (p[1] + p[3]) + (p[5] + p[7]);
                const float mean = S1 * (1.f / 512.f), var = S2 * (1.f / 512.f) - mean * mean, rstd = __builtin_amdgcn_rsqf(var + NORM_EPS);
                const float y0 = (a0[k] - mean) * rstd * lg0 + lb0, y1 = (a1[k] - mean) * rstd * lg1 + lb1;
                const float o0 = y0 * __builtin_amdgcn_rcpf(1.f + __builtin_amdgcn_exp2f(-1.4426950408889634f * y0)), o1 = y1 * __builtin_amdgcn_rcpf(1.f + __builtin_amdgcn_exp2f(-1.4426950408889634f * y1));
                *(GAS unsigned*)(op + k * 1024) = pk2(o0, o1); }
            __syncthreads();
        }
    }
}

__device__ __forceinline__ int tokey(float v) { const int b = __float_as_int(v); return b ^ ((b >> 31) & 0x7fffffff); }
__device__ __forceinline__ float unkey(int k, int mask) { const int t = k & ~mask; return __int_as_float(t ^ ((t >> 31) & 0x7fffffff)); }
__device__ __forceinline__ void ce_desc(int& a, int& b) { const int hi = a > b ? a : b, lo = a > b ? b : a; a = hi; b = lo; }
template <int N> __device__ __forceinline__ void sort_desc(int (&v)[N]) {
#pragma unroll
    for (int k = 2; k <= N; k <<= 1)
#pragma unroll
        for (int j = k >> 1; j > 0; j >>= 1)
#pragma unroll
            for (int i = 0; i < N; ++i) { const int l = i ^ j; if (l > i) { if ((i & k) == 0) ce_desc(v[i], v[l]); else ce_desc(v[l], v[i]); } }
}
__device__ __forceinline__ void bitonic_merge16_desc(int (&v)[16]) {
#pragma unroll
    for (int j = 8; j > 0; j >>= 1)
#pragma unroll
        for (int i = 0; i < 16; ++i) { const int l = i ^ j; if (l > i) ce_desc(v[i], v[l]); }
}
__device__ __forceinline__ void merge_top16(int (&a)[16], const int (&b)[16]) {
#pragma unroll
    for (int i = 0; i < 16; ++i) a[i] = a[i] > b[15 - i] ? a[i] : b[15 - i];
    bitonic_merge16_desc(a);
}
__device__ __forceinline__ void top16_of_64(const int (&x)[64], int (&out)[16]) {
    int g[16];
#pragma unroll
    for (int i = 0; i < 16; ++i) out[i] = x[i];
    sort_desc<16>(out);
#pragma unroll
    for (int q = 1; q < 4; ++q) {
#pragma unroll
        for (int i = 0; i < 16; ++i) g[i] = x[16 * q + i];
        sort_desc<16>(g); merge_top16(out, g); }
}
__device__ __forceinline__ int crow_(int r, int hi) { return (r & 3) + 8 * (r >> 2) + 4 * hi; }
struct SelArgs { const bf16* qp; const bf16* keys; const float* ss; const float* usc; const float* vsc; int* eidx; float* ga; float* gb; const bf16* x1b; unsigned char* x8; float* xs; };
__device__ __forceinline__ void peer_select_phase(Frame& F, const SelArgs& a) {
    for (int i = F.tid; i < 2 * 128 * 16; i += 512) { const int which = i >> 11, rem = i & 2047, row = rem >> 4, ch = rem & 15;
        const v4u v = *(const GAS v4u*)(a.keys + (size_t)which * 16384 + row * 128 + ch * 8);
        *(LAS v4u*)(F.lds + RING_OFF + which * 32768 + row * 256 + ((ch ^ (row & 15)) << 4)) = v; }
    __syncthreads();
    LAS int* scr = (LAS int*)(F.lds + RING_OFF + 65536 + F.wave * 4096);
    const int lane = F.lane, tl = lane & 31, hi = lane >> 5;
    const int gw = F.vcu * NWAVES + F.wave, NGW = F.G * NWAVES;
    constexpr int NUNITS = (TOK / 32) * P_HEADS;
    constexpr int PA[50] = {0,0,0,0,0,0,0,0,0,0,0,0,0,0,0,0, 1,1,1,1,1,1,1,1, 2,2,2,2,2, 3,3,3,3, 4,4,4, 5,5, 6,6, 7,7, 8,9,10,11,12,13,14,15};
    constexpr int PB[50] = {0,1,2,3,4,5,6,7,8,9,10,11,12,13,14,15, 0,1,2,3,4,5,6,7, 0,1,2,3,4, 0,1,2,3, 0,1,2, 0,1, 0,1, 0,1, 0,0,0,0,0,0,0,0};
    for (int unit = gw; unit < NUNITS; unit += NGW) {
        const int tt = unit >> 3, hh = unit & 7, t = tt * 32 + tl;
        int vk[2][16];
#pragma unroll
        for (int half = 0; half < 2; ++half) {
            const bf16* qrow = a.qp + (size_t)t * 2048 + hh * 256 + half * 128 + hi * 8;
            bf16x8 bq[8];
#pragma unroll
            for (int ks = 0; ks < 8; ++ks) bq[ks] = *(const GAS bf16x8*)(qrow + ks * 16);
            f32x16 acc[4];
#pragma unroll
            for (int nb = 0; nb < 4; ++nb) { acc[nb] = (f32x16){};
#pragma unroll
                for (int ks = 0; ks < 8; ++ks) { const int row = nb * 32 + tl, ch = 2 * ks + hi;
                    const bf16x8 ka = *(const LAS bf16x8*)(F.lds + RING_OFF + half * 32768 + row * 256 + ((ch ^ (row & 15)) << 4));
                    acc[nb] = __builtin_amdgcn_mfma_f32_32x32x16_bf16(ka, bq[ks], acc[nb], 0, 0, 0); } }
            int keys[64];
#pragma unroll
            for (int nb = 0; nb < 4; ++nb)
#pragma unroll
                for (int r = 0; r < 16; ++r) keys[nb * 16 + r] = (tokey(acc[nb][r]) & ~127) | (nb * 32 + crow_(r, hi));
            int top[16]; top16_of_64(keys, top);
            int oth[16];
#pragma unroll
            for (int i = 0; i < 16; ++i) oth[i] = __shfl_xor(top[i], 32);
            merge_top16(top, oth);
#pragma unroll
            for (int i = 0; i < 16; ++i) vk[half][i] = top[i];
        }
        float f1[16], f2[16];
#pragma unroll
        for (int i = 0; i < 16; ++i) { f1[i] = unkey(vk[0][i], 127); f2[i] = unkey(vk[1][i], 127); }
        int ck[64];
#pragma unroll
        for (int i = 0; i < 50; ++i) ck[i] = (tokey(f1[PA[i]] + f2[PB[i]]) & ~255) | (PA[i] * 16 + PB[i]);
#pragma unroll
        for (int i = 50; i < 64; ++i) ck[i] = (int)0x80000000;
        int c[16]; top16_of_64(ck, c);
        if (hi == 0) {
#pragma unroll
            for (int i = 0; i < 16; ++i) { scr[tl * 32 + i] = vk[0][i] & 127; scr[tl * 32 + 16 + i] = vk[1][i] & 127; } }
        float ssum = 0.f;
        { const GAS f32x4* sp = (const GAS f32x4*)(a.ss + (size_t)t * 16);
#pragma unroll
          for (int i = 0; i < 4; ++i) { const f32x4 v = sp[i]; ssum += (v.x + v.y) + (v.z + v.w); } }
        const float rstd = 1.f / sqrtf(ssum * (1.f / 1024.f) + NORM_EPS);
        const float smax = unkey(c[0], 255);
        float e[16], esum = 0.f;
#pragma unroll
        for (int i = 0; i < 16; ++i) { e[i] = __expf((unkey(c[i], 255) - smax) * rstd); esum += e[i]; }
        const float inv = 1.f / esum;
        LDS_WAIT(); asm volatile("" ::: "memory");
        int eo[8]; float go[8];
#pragma unroll
        for (int i = 0; i < 8; ++i) { const int ci = hi ? c[i + 8] : c[i]; const float ei = hi ? e[i + 8] : e[i];
            const int id = ci & 255, i1 = scr[tl * 32 + (id >> 4)], i2 = scr[tl * 32 + 16 + (id & 15)];
            eo[i] = i1 * P_NK + i2; go[i] = ei * inv; }
        float ua[8];
#pragma unroll
        for (int i = 0; i < 8; ++i) { ua[i] = a.usc[eo[i]]; go[i] *= a.vsc[eo[i]]; }
        int* ep = a.eidx + (size_t)t * P_E + hh * 16 + hi * 8; float* gp = a.gb + (size_t)t * P_E + hh * 16 + hi * 8; float* up_ = a.ga + (size_t)t * P_E + hh * 16 + hi * 8;
        *(GAS f32x4*)(up_) = (f32x4){ua[0], ua[1], ua[2], ua[3]}; *(GAS f32x4*)(up_ + 4) = (f32x4){ua[4], ua[5], ua[6], ua[7]};
        *(GAS v4u*)(ep) = (v4u){(unsigned)eo[0], (unsigned)eo[1], (unsigned)eo[2], (unsigned)eo[3]}; *(GAS v4u*)(ep + 4) = (v4u){(unsigned)eo[4], (unsigned)eo[5], (unsigned)eo[6], (unsigned)eo[7]};
        *(GAS f32x4*)(gp) = (f32x4){go[0], go[1], go[2], go[3]}; *(GAS f32x4*)(gp + 4) = (f32x4){go[4], go[5], go[6], go[7]};
        LDS_WAIT(); asm volatile("" ::: "memory");
    }
}

__device__ __forceinline__ void peer_rows_fp8(Frame& F, const SelArgs& a) {
    const int gw = F.vcu * NWAVES + F.wave, NGW = F.G * NWAVES, lane = F.lane;
    for (int t = gw; t < TOK; t += NGW) {
        const GAS v4u* xp = (const GAS v4u*)(a.x1b + (size_t)t * 1024 + 16 * lane); const v4u xa = xp[0], xb = xp[1];
        const float xf[16] = {bflo(xa.x), bfhi(xa.x), bflo(xa.y), bfhi(xa.y), bflo(xa.z), bfhi(xa.z), bflo(xa.w), bfhi(xa.w), bflo(xb.x), bfhi(xb.x), bflo(xb.y), bfhi(xb.y), bflo(xb.z), bfhi(xb.z), bflo(xb.w), bfhi(xb.w)};
        float am = 0.f;
#pragma unroll
        for (int i = 0; i < 16; ++i) am = fmaxf(am, fabsf(xf[i]));
#pragma unroll
        for (int o = 1; o < 64; o <<= 1) am = fmaxf(am, __shfl_xor(am, o));
        const float xsc = am > 0.f ? 240.f / am : 1.f, xinv = am > 0.f ? am * (1.f / 240.f) : 1.f;
        v4u o;
        { int w = 0; w = __builtin_amdgcn_cvt_pk_fp8_f32(xf[0] * xsc, xf[1] * xsc, w, false); w = __builtin_amdgcn_cvt_pk_fp8_f32(xf[2] * xsc, xf[3] * xsc, w, true); o.x = (unsigned)w; }
        { int w = 0; w = __builtin_amdgcn_cvt_pk_fp8_f32(xf[4] * xsc, xf[5] * xsc, w, false); w = __builtin_amdgcn_cvt_pk_fp8_f32(xf[6] * xsc, xf[7] * xsc, w, true); o.y = (unsigned)w; }
        { int w = 0; w = __builtin_amdgcn_cvt_pk_fp8_f32(xf[8] * xsc, xf[9] * xsc, w, false); w = __builtin_amdgcn_cvt_pk_fp8_f32(xf[10] * xsc, xf[11] * xsc, w, true); o.z = (unsigned)w; }
        { int w = 0; w = __builtin_amdgcn_cvt_pk_fp8_f32(xf[12] * xsc, xf[13] * xsc, w, false); w = __builtin_amdgcn_cvt_pk_fp8_f32(xf[14] * xsc, xf[15] * xsc, w, true); o.w = (unsigned)w; }
        *(GAS v4u*)(a.x8 + (size_t)t * 1024 + 16 * lane) = o;
        const float ssum = wave_sum(lane < 16 ? a.ss[(size_t)t * 16 + lane] : 0.f);
        if (lane == 0) a.xs[t] = xinv / sqrtf(ssum * (1.f / 1024.f) + NORM_EPS);
    }
}

typedef float f32x2_t __attribute__((ext_vector_type(2)));
struct ExpA { const unsigned char* x8; const float* xs; const unsigned char* ub8; const int* eidx; const float* ga; const float* gb; unsigned char* coef8; };
__device__ __forceinline__ float row_sum16(float v) {
    v += __builtin_bit_cast(float, __builtin_amdgcn_update_dpp(0, __builtin_bit_cast(int, v), 0xB1, 0xf, 0xf, false));
    v += __builtin_bit_cast(float, __builtin_amdgcn_update_dpp(0, __builtin_bit_cast(int, v), 0x4E, 0xf, 0xf, false));
    v += __builtin_bit_cast(float, __builtin_amdgcn_update_dpp(0, __builtin_bit_cast(int, v), 0x141, 0xf, 0xf, false));
    v += __builtin_bit_cast(float, __builtin_amdgcn_update_dpp(0, __builtin_bit_cast(int, v), 0x140, 0xf, 0xf, false));
    return v;
}
__device__ __forceinline__ float gelu_as(float v) {
    const float av = fabsf(v), t = __builtin_amdgcn_rcpf(av * 0.2316418882f + 1.0f);
    float q = t * 0.5307027145f + (-0.7265760135f); q = q * t + 0.7107068705f; q = q * t + (-0.142248368f); q = q * t + 0.127414796f; q = q * t;
    const float m = v * (q * __builtin_amdgcn_exp2f((v * v) * (-0.72134752044f)));
    return v < 0.f ? m : v - m;
}
__device__ __forceinline__ float wave_sum_diag(float v) {
    v = row_sum16(v);
    v += __builtin_bit_cast(float, __builtin_amdgcn_update_dpp(0, __builtin_bit_cast(int, v), 0x142, 0xA, 0xF, false));
    v += __builtin_bit_cast(float, __builtin_amdgcn_update_dpp(0, __builtin_bit_cast(int, v), 0x143, 0xC, 0xF, false));
    return v;
}
__device__ __forceinline__ int wg_grab(LAS int* c, const int lane) {
    int v = 0; if (lane == 0) v = __hip_atomic_fetch_add(c, 1, __ATOMIC_RELAXED, __HIP_MEMORY_SCOPE_WORKGROUP);
    return __builtin_amdgcn_readfirstlane(v);
}
__device__ __forceinline__ void peer_u_phase(Frame& F, const ExpA& a, const int s, const int tfirst, const int step, LAS int* cnt) {
    const int lane = F.lane;
    LAS int* lstA = (LAS int*)(F.lds + RING_OFF + F.wave * 4096); LAS int* lstB = lstA + 512;
    lstA[lane] = 0; lstA[64 + lane] = 0; lstB[lane] = 0; lstB[64 + lane] = 0;
    const bool diag = ((lane & 15) >> 2) == (lane >> 4); const int dsel = lane & 3;
    const bool b3 = (lane & 8) != 0; const int usel = ((lane >> 5) & 1) * 4 + ((lane >> 4) & 1) * 2 + ((lane >> 3) & 1);
    if (tfirst >= TOK) return;
    struct Raw { v4u x; int e0, e1; float fa0, fa1, fb0, fb1, xs; };
#if defined(ABL_HOTROWS)
#define ABL_ROW(e) (((e) & ~2047) | ((e) & 63))
#else
#define ABL_ROW(e) (e)
#endif
#define PU_RAW(R, T) do { const int tt_ = (T) < TOK ? (T) : tfirst; R.x = *(const GAS v4u*)(a.x8 + (size_t)tt_ * 1024 + 16 * lane); \
        R.e0 = a.eidx[(size_t)tt_ * P_E + lane]; R.e1 = a.eidx[(size_t)tt_ * P_E + 64 + lane]; R.fa0 = a.ga[(size_t)tt_ * P_E + lane]; R.fa1 = a.ga[(size_t)tt_ * P_E + 64 + lane]; \
        R.fb0 = a.gb[(size_t)tt_ * P_E + lane]; R.fb1 = a.gb[(size_t)tt_ * P_E + 64 + lane]; R.xs = a.xs[tt_]; } while (0)
#define PU_PREP(R, LST, XLO, XHI, N, VALID) do { \
        XLO = (long)(((unsigned long long)R.x.y << 32) | R.x.x); XHI = (long)(((unsigned long long)R.x.w << 32) | R.x.z); \
        const bool in0_ = (VALID) && (R.e0 >> 11) == s, in1_ = (VALID) && (R.e1 >> 11) == s; \
        const unsigned long long m0_ = __ballot(in0_), m1_ = __ballot(in1_), lt_ = (1ull << lane) - 1ull; \
        const int n0_ = __popcll(m0_); N = n0_ + __popcll(m1_); \
        LAS float* lsa_ = (LAS float*)(LST + 128); LAS float* lsb_ = (LAS float*)(LST + 256); \
        if (in0_) { const int p = __popcll(m0_ & lt_); LST[p] = lane | (R.e0 << 8); lsa_[p] = R.fa0 * R.xs; lsb_[p] = R.fb0; } \
        if (in1_) { const int p = n0_ + __popcll(m1_ & lt_); LST[p] = (64 + lane) | (R.e1 << 8); lsa_[p] = R.fa1 * R.xs; lsb_[p] = R.fb1; } } while (0)
#define PU_LOAD(W, LST, K0) do { _Pragma("unroll") for (int u = 0; u < 8; ++u) { const int ent_ = LST[((K0) + u) & 127]; W[u] = *(const GAS v4u*)(a.ub8 + (size_t)ABL_ROW(ent_ >> 8) * 1024 + 16 * lane); } } while (0)
#define PU_COMP(W, LST, XLO, XHI, N, T, K0) do { float d[8]; \
            _Pragma("unroll") for (int u = 0; u < 8; ++u) { f32x4 acc = {0.f, 0.f, 0.f, 0.f}; \
                acc = __builtin_amdgcn_mfma_f32_16x16x32_fp8_fp8((long)(((unsigned long long)W[u].y << 32) | W[u].x), XLO, acc, 0, 0, 0); \
                acc = __builtin_amdgcn_mfma_f32_16x16x32_fp8_fp8((long)(((unsigned long long)W[u].w << 32) | W[u].z), XHI, acc, 0, 0, 0); \
                const float v01 = (dsel & 1) ? acc[1] : acc[0], v23 = (dsel & 1) ? acc[3] : acc[2]; \
                d[u] = diag ? ((dsel & 2) ? v23 : v01) : 0.f; } \
            float z_[4], w_[2]; \
            _Pragma("unroll") for (int i = 0; i < 4; ++i) { const auto rr = __builtin_amdgcn_permlane32_swap(__float_as_uint(d[i]), __float_as_uint(d[i + 4]), false, false); z_[i] = __uint_as_float(rr[0]) + __uint_as_float(rr[1]); } \
            _Pragma("unroll") for (int i = 0; i < 2; ++i) { const auto rr = __builtin_amdgcn_permlane16_swap(__float_as_uint(z_[i]), __float_as_uint(z_[i + 2]), false, false); w_[i] = __uint_as_float(rr[0]) + __uint_as_float(rr[1]); } \
            float du = (b3 ? w_[1] : w_[0]) + __builtin_bit_cast(float, __builtin_amdgcn_update_dpp(0, __builtin_bit_cast(int, b3 ? w_[0] : w_[1]), 0x128, 0xf, 0xf, false)); \
            du += __builtin_bit_cast(float, __builtin_amdgcn_update_dpp(0, __builtin_bit_cast(int, du), 0xB1, 0xf, 0xf, false)); \
            du += __builtin_bit_cast(float, __builtin_amdgcn_update_dpp(0, __builtin_bit_cast(int, du), 0x4E, 0xf, 0xf, false)); \
            du += __builtin_bit_cast(float, __builtin_amdgcn_update_dpp(0, __builtin_bit_cast(int, du), 0x141, 0xf, 0xf, false)); \
            const int ku = (K0) + usel; \
            if ((lane & 7) == 0 && ku < N) { const int slot = LST[ku] & 255; const float cf_ = C8_SCALE * ((LAS float*)(LST + 256))[ku] * gelu_as(du * ((LAS float*)(LST + 128))[ku]); \
                a.coef8[(size_t)(T) * P_E + slot] = (unsigned char)__builtin_amdgcn_cvt_pk_fp8_f32(fminf(fmaxf(cf_, -448.f), 448.f), 0.f, 0, false); } } while (0)
    Raw rA, rB;
    const int ntok = (TOK - tfirst + step - 1) / step, npair = (ntok + 1) >> 1;
#define PU_TOK(i) ((i) < ntok ? tfirst + (i) * step : TOK)
    int p = wg_grab(cnt, lane);
    if (p >= npair) return;
    PU_RAW(rA, PU_TOK(2 * p)); PU_RAW(rB, PU_TOK(2 * p + 1));
    while (p < npair) {
        const int pn = wg_grab(cnt, lane);
        const int tA = PU_TOK(2 * p), tB = PU_TOK(2 * p + 1); const bool vB = tB < TOK;
        long xloA, xhiA, xloB, xhiB; int nA, nB;
        PU_PREP(rA, lstA, xloA, xhiA, nA, true);
        PU_PREP(rB, lstB, xloB, xhiB, nB, vB);
        LDS_WAIT(); asm volatile("" ::: "memory");
        v4u wA0[8], wA1[8], wB0[8], wB1[8];
        PU_LOAD(wA0, lstA, 0); PU_LOAD(wB0, lstB, 0); PU_LOAD(wA1, lstA, 8); PU_LOAD(wB1, lstB, 8);
        PU_RAW(rA, PU_TOK(2 * pn)); PU_RAW(rB, PU_TOK(2 * pn + 1));
        PU_COMP(wA0, lstA, xloA, xhiA, nA, tA, 0);
        if (nA > 16) PU_LOAD(wA0, lstA, 16);
        PU_COMP(wB0, lstB, xloB, xhiB, nB, tB, 0);
        if (nB > 16) PU_LOAD(wB0, lstB, 16);
        PU_COMP(wA1, lstA, xloA, xhiA, nA, tA, 8);
        PU_COMP(wB1, lstB, xloB, xhiB, nB, tB, 8);
        if (nA > 16) PU_COMP(wA0, lstA, xloA, xhiA, nA, tA, 16);
        if (nB > 16) PU_COMP(wB0, lstB, xloB, xhiB, nB, tB, 16);
        for (int k0 = 24; k0 < nA; k0 += 8) { PU_LOAD(wA1, lstA, k0); PU_COMP(wA1, lstA, xloA, xhiA, nA, tA, k0); }
        for (int k0 = 24; k0 < nB; k0 += 8) { PU_LOAD(wB1, lstB, k0); PU_COMP(wB1, lstB, xloB, xhiB, nB, tB, k0); }
        LDS_WAIT(); asm volatile("" ::: "memory");
        p = pn;
    }
#undef PU_TOK
#undef PU_RAW
#undef PU_PREP
#undef PU_LOAD
#undef PU_COMP
}
struct ExpB { float* xio; const bf16* x1b; const unsigned char* vb8; const int* eidx; const unsigned char* coef8; float* ss2; };
typedef int v2i_t __attribute__((ext_vector_type(2)));
typedef int v8i_t __attribute__((ext_vector_type(8)));
__device__ __forceinline__ void peer_v_phase(Frame& F, const ExpB& a, const int s, const int t0, const int step, LAS int* cnt) {
    const int lane = F.lane, g = lane >> 2, j = lane & 3, q = lane >> 4, jn = lane & 15;
    const GAS unsigned char* vs = (const GAS unsigned char*)a.vb8 + (size_t)s * ((size_t)N_EXP * 64); const unsigned j16 = 16u * (unsigned)j;
    if (t0 >= TOK) return;
    LAS unsigned char* tile = F.lds + (F.wave < 7 ? F.wave * VT_BYTES : VT_LAST_OFF);
    LAS unsigned char* wbase = tile + g * (8 * VT_PITCH) + 16 * j;
    LAS unsigned char* rbase = tile + (32 * q + jn) * VT_PITCH;
    const int chA = 128 * s + 32 * q + jn;
    const bool q1 = (q & 1) != 0, q2 = (q & 2) != 0;
#define PV_LDE(E, T) do { const int tt_ = (T) < TOK ? (T) : t0; const GAS v4u* ep_ = (const GAS v4u*)(a.eidx + (size_t)tt_ * P_E + 8 * g); \
        _Pragma("unroll") for (int k4 = 0; k4 < 2; ++k4) { const v4u ev = ep_[k4]; E[4 * k4] = (int)ev.x; E[4 * k4 + 1] = (int)ev.y; E[4 * k4 + 2] = (int)ev.z; E[4 * k4 + 3] = (int)ev.w; } } while (0)
#define PV_ROWS(W, E, C8, XA, XB, T) do { const int tt_ = (T) < TOK ? (T) : t0; _Pragma("unroll") for (int k = 0; k < 8; ++k) W[k] = *(const GAS v4u*)(vs + (((unsigned)E[k] << 6) | j16)); \
        { const GAS v4u* cp_ = (const GAS v4u*)(a.coef8 + (size_t)tt_ * P_E + 16 * q); C8[0] = cp_[0]; C8[1] = cp_[4]; }   \
        { const GAS bf16* xp_ = (const GAS bf16*)(a.x1b + (size_t)tt_ * 1024 + chA); XA = xp_[0]; XB = xp_[16]; } } while (0)
#define PV_COMP(W, C8, XA, XB, T) do { \
        _Pragma("unroll") for (int k = 0; k < 8; ++k) *(LAS v4u*)(wbase + k * VT_PITCH) = W[k]; \
        const v8i_t av = {(int)C8[0].x, (int)C8[0].y, (int)C8[0].z, (int)C8[0].w, (int)C8[1].x, (int)C8[1].y, (int)C8[1].z, (int)C8[1].w}; \
        f32x4 acc[8]; \
        _Pragma("unroll") for (int ct = 0; ct < 8; ++ct) { \
            const v2i_t b0 = __builtin_amdgcn_ds_read_tr4_b64_v2i32((LAS v2i_t*)(rbase + 8 * ct)), b1 = __builtin_amdgcn_ds_read_tr4_b64_v2i32((LAS v2i_t*)(rbase + 16 * VT_PITCH + 8 * ct)); \
            const v8i_t bv = {b0.x, b0.y, b1.x, b1.y, 0, 0, 0, 0}; \
            acc[ct] = __builtin_amdgcn_mfma_scale_f32_16x16x128_f8f6f4(av, bv, (f32x4){0.f, 0.f, 0.f, 0.f}, 0, 4, 0, 0, 0, 0); } \
        const float ya = q2 ? (q1 ? acc[6][0] : acc[4][0]) : (q1 ? acc[2][0] : acc[0][0]), yb = q2 ? (q1 ? acc[7][0] : acc[5][0]) : (q1 ? acc[3][0] : acc[1][0]); \
        const float oa = bflo((unsigned)XA) + ya * (1.f / C8_SCALE), ob = bflo((unsigned)XB) + yb * (1.f / C8_SCALE); \
        a.xio[(size_t)(T) * 1024 + chA] = oa; a.xio[(size_t)(T) * 1024 + chA + 16] = ob; \
        float sq = row_sum16(oa * oa + ob * ob); \
        sq += __shfl_xor(sq, 16); sq += __shfl_xor(sq, 32); \
        if (lane == 0) a.ss2[(size_t)(T) * 8 + s] = sq; } while (0)
    int e1[8], e2[8]; v4u wA[8], wB[8], c8A[2], c8B[2]; bf16 xaA, xbA, xaB, xbB;
    const int ntok = (TOK - t0 + step - 1) / step;
#define PV_TOK(i) ((i) < ntok ? t0 + (i) * step : TOK)
    int iA = wg_grab(cnt, lane), iB = wg_grab(cnt, lane);
    if (iA >= ntok) return;
    PV_LDE(e1, PV_TOK(iA));
    PV_LDE(e2, PV_TOK(iB));
    PV_ROWS(wA, e1, c8A, xaA, xbA, PV_TOK(iA));
    for (;;) {
        const int iC = wg_grab(cnt, lane);
        PV_LDE(e1, PV_TOK(iC));
        PV_ROWS(wB, e2, c8B, xaB, xbB, PV_TOK(iB));
        PV_COMP(wA, c8A, xaA, xbA, PV_TOK(iA));
        if (iB >= ntok) break;
        const int iD = wg_grab(cnt, lane);
        PV_LDE(e2, PV_TOK(iD));
        PV_ROWS(wA, e1, c8A, xaA, xbA, PV_TOK(iC));
        PV_COMP(wB, c8B, xaB, xbB, PV_TOK(iB));
        if (iC >= ntok) break;
        iA = iC; iB = iD;
    }
#undef PV_TOK
#undef PV_LDE
#undef PV_ROWS
#undef PV_COMP
}
__device__ __forceinline__ void final_norm_phase(Frame& F, float* xio, const float* ss2, const float* gfinal, const int gw, const int NGW) {
    const int lane = F.lane;
    for (int t = gw; t < TOK; t += NGW) {
        const GAS f32x4* sp = (const GAS f32x4*)(ss2 + (size_t)t * 8); const f32x4 s0 = sp[0], s1 = sp[1];
        const float rstd = 1.f / sqrtf(((s0.x + s0.y) + (s0.z + s0.w) + (s1.x + s1.y) + (s1.z + s1.w)) * (1.f / 1024.f) + NORM_EPS);
        GAS f32x4* xr = (GAS f32x4*)(xio + (size_t)t * 1024) + lane; const GAS f32x4* gf = (const GAS f32x4*)gfinal + lane;
#pragma unroll
        for (int q = 0; q < 4; ++q) xr[64 * q] = xr[64 * q] * rstd * gf[64 * q];
    }
}

struct Args { const float* in[18]; float* out; unsigned char* ws; int ph_lo, ph_hi, li, pad; };
__global__ void __launch_bounds__(NWAVES * 64, 2) fwd_kernel(Args args) {
    extern __shared__ __attribute__((aligned(16))) unsigned char lds[];
    Frame F;
    F.lds = (LAS unsigned char*)lds;
    F.MISC = (volatile LAS unsigned*)(F.lds + MISC_OFF);
    F.tid = threadIdx.x; F.lane = F.tid & 63; F.wave = __builtin_amdgcn_readfirstlane(F.tid >> 6);
    F.G = gridDim.x; { const int bx = blockIdx.x; F.vcu = (F.G % 8 == 0) ? (bx % 8) * (F.G / 8) + bx / 8 : bx; }
    unsigned char* ws = args.ws;
    F.ctl = (gu32*)(ws + WS_CTL);
#define GRID_BAR(seam) do { if (N_LAUNCHES == PER_PHASE) { if (F.tid == 0) __hip_atomic_store(F.ctl + CW_TMO, 0xBADBA0u | (unsigned)(seam), RLX_AGENT); } else { xcd_barrier(bar); } } while (0)
    const float* x = args.in[0];
    bf16* H = (bf16*)(ws + WS_H); bf16* Win = (bf16*)(ws + WS_WIN); bf16* Wpw = (bf16*)(ws + WS_WPW); bf16* Wao = (bf16*)(ws + WS_WAO); bf16* Wout = (bf16*)(ws + WS_WOUT); bf16* Wq = (bf16*)(ws + WS_WQ);
    bf16* KEYS = (bf16*)(ws + WS_KEYS); unsigned char* UB = ws + WS_UB; unsigned char* VB = ws + WS_VB; float* USC = (float*)(ws + WS_USC); float* VSC = (float*)(ws + WS_VSC);
    bf16* ZGLU = (bf16*)(ws + WS_ZGLU); bf16* QO = (bf16*)(ws + WS_QO); bf16* KB = (bf16*)(ws + WS_K); bf16* VBUF = (bf16*)(ws + WS_V); bf16* GC = (bf16*)(ws + WS_GC); bf16* GA = (bf16*)(ws + WS_GATE_A);
    bf16* CACT = (bf16*)(ws + WS_CACT); bf16* MIX = (bf16*)(ws + WS_MIX); bf16* X1B = (bf16*)(ws + WS_X1B); bf16* QP = (bf16*)(ws + WS_QP);
    float* KMEAN = (float*)(ws + WS_KMEAN); float* SS = (float*)(ws + WS_SS); int* EIDX = (int*)(ws + WS_EIDX); float* GW = (float*)(ws + WS_GW);
    for (int u = F.tid; u < (LDS_BYTES - LDSCTL_OFF) / 4; u += NWAVES * 64) ((LAS unsigned*)(F.lds + LDSCTL_OFF))[u] = 0u;
    __syncthreads();
    XcdBarrier bar; bar.bar = (unsigned*)(F.ctl + CW_BAR); bar.x = 0; bar.st = nullptr;
    if (N_LAUNCHES != PER_PHASE) bar = xcd_barrier_post((unsigned*)(F.ctl + CW_BAR), F.MISC + 8);
    const int lo = args.ph_lo, hi = args.ph_hi;
#ifdef TIME_PHASE
    unsigned long long ts_[PER_PHASE + 1]; ts_[0] = __builtin_amdgcn_s_memrealtime();
#define STAMP(k) ts_[(k) + 1] = __builtin_amdgcn_s_memrealtime()
#else
#define STAMP(k) do {} while (0)
#endif
#ifndef PHASE_MASK
#define PHASE_MASK 0xff
#endif
#define IN(k) (((PHASE_MASK >> (k)) & 1) && lo <= (k) && (k) < hi)
#define BOTH(k) (IN(k) && IN((k) + 1))

    if (IN(0)) {
        P0Args a{x, args.in[1], args.in[2], args.in[7], args.in[9], args.in[10], args.in[11], args.in[12], args.in[13], args.in[14], args.in[15], args.in[16], H, Win, Wpw, Wao, Wout, Wq, KEYS, UB, VB, USC, VSC};
        p0_prologue(F, a);
        if (BOTH(0)) GRID_BAR(0);
        STAMP(0);
    }
#ifdef DEBUG_P1_PLAIN
    if (IN(1)) {
        pg8::Gemm g{H, Wq, TOK, 2048, 1024}; pg8::StaticOrder S; S.init(TOK, 2048, F.G, (int)blockIdx.x);
        pg8::EpiStore E{QP, 2048};
        pg8::gemm_phase<pg8::EpiStore, pg8::StaticOrder, true, true>(F.lds + RING_OFF, g, S, E);
    }
#else
    if (IN(1)) {
        pg8::Gemm g{H, Win, TOK, IN_COLS, 1024}; pg8::StaticOrder S; S.init(TOK, IN_COLS, F.G, (int)blockIdx.x);
        pg8::EpiIn E{ZGLU, QO, GC, KMEAN, attn_body::C2, (size_t)(WS_K - WS_QO) / 2, (size_t)(WS_GATE_A - WS_GC) / 2};
        static_assert(WS_V - WS_K == WS_K - WS_QO, "Q|K|V equally spaced");
        pg8::gemm_phase<pg8::EpiIn, pg8::StaticOrder, true, true>(F.lds + RING_OFF, g, S, E);
        if (BOTH(1)) GRID_BAR(1);
        STAMP(1);
    }
#endif
    if (IN(2)) {
        static_assert(attn_body::ATTN_LDS_BYTES <= RING_BYTES && attn_body::ATTN_PITCH == ATT_W, "attention body geometry vs frame");
#ifdef CONV_FIRST
        { const ConvArgs ca{ZGLU, args.in[3], args.in[4], args.in[5], args.in[6], CACT};
          conv_phase(F, ca); }
        __syncthreads();
#ifdef TIME_SPLIT2
        ts_[3] = __builtin_amdgcn_s_memrealtime();
#endif
#endif
        const attn_body::AttnTensors AT{(const attn_body::bf16*)QO, (const attn_body::bf16*)KB, (const attn_body::bf16*)VBUF, (attn_body::bf16*)(CACT + 512), KMEAN};
        const attn_body::StaticOrder S((int)F.G, (int)blockIdx.x);
        attn_body::attn_phase<attn_body::StaticOrder>((char*)lds + RING_OFF, AT, S);
        __syncthreads();
#ifndef CONV_FIRST
        { const ConvArgs ca{ZGLU, args.in[3], args.in[4], args.in[5], args.in[6], CACT};
          conv_phase(F, ca); }
#endif
        if (BOTH(2)) GRID_BAR(2);
#if !(defined(TIME_SPLIT2) && defined(CONV_FIRST))
        STAMP(2);
#endif
    }
    if (IN(3)) {
        { pg8::Gemm g{CACT, Wpw, TOK, 1024, 1024}; pg8::StaticOrder S; S.init(TOK, 1024, F.G, (int)blockIdx.x);
          pg8::EpiMixF E{GC, GA, args.in[8], MIX};
          pg8::gemm_phase<pg8::EpiMixF, pg8::StaticOrder, true, true>(F.lds + RING_OFF, g, S, E); }
        if (BOTH(3)) GRID_BAR(3);
        STAMP(3);
    }
    if (IN(4)) {
        pg8::Gemm g{MIX, Wout, TOK, 1024, 1024}; pg8::StaticOrder S; S.init(TOK, 1024, F.G, (int)blockIdx.x);
        pg8::EpiX1 E{x, args.out, X1B, SS};
        pg8::gemm_phase<pg8::EpiX1, pg8::StaticOrder, true, true>(F.lds + RING_OFF, g, S, E);
        if (BOTH(4)) GRID_BAR(4);
        STAMP(4);
    }
    if (IN(5)) {
        pg8::Gemm g{X1B, Wq, TOK, 2048, 1024}; pg8::StaticOrder S; S.init(TOK, 2048, F.G, (int)blockIdx.x);
        pg8::EpiStore E{QP, 2048};
        pg8::gemm_phase<pg8::EpiStore, pg8::StaticOrder, true, true>(F.lds + RING_OFF, g, S, E);
        if (BOTH(5)) GRID_BAR(5);
        STAMP(5);
    }
    if (IN(6)) {
        const SelArgs sa{QP, KEYS, SS, USC, VSC, EIDX, (float*)(ws + WS_GA), GW, X1B, ws + WS_X8, (float*)(ws + WS_XS)};
        peer_select_phase(F, sa);
        peer_rows_fp8(F, sa);
        if (BOTH(6)) GRID_BAR(6);
        STAMP(6);
    }
    if (IN(7)) {
        LAS int* cnt = (LAS int*)(F.lds + P7_CNT_OFF);
        if (F.tid < 16) cnt[F.tid] = 0;
        __syncthreads();
        const ExpA ea{ws + WS_X8, (const float*)(ws + WS_XS), UB, EIDX, (const float*)(ws + WS_GA), GW, ws + WS_COEF};
        for (int s = 0; s < 8; ++s) peer_u_phase(F, ea, s, F.vcu, F.G, cnt + s);
        VM_WAIT(); __syncthreads();
        const ExpB eb{args.out, X1B, VB, EIDX, ws + WS_COEF, (float*)(ws + WS_SS2)};
        for (int s = 0; s < 8; ++s) peer_v_phase(F, eb, s, F.vcu, F.G, cnt + 8 + s);
        VM_WAIT(); __syncthreads();
        final_norm_phase(F, args.out, (const float*)(ws + WS_SS2), args.in[17], F.vcu + F.G * F.wave, F.G * NWAVES);
#ifdef UNIT_MFMA4
        __syncthreads();
        if (blockIdx.x == 0 && F.wave == 0) {
            typedef int v8i_ __attribute__((ext_vector_type(8)));
            const int lane = F.lane, qq = lane >> 4;
            const v8i_ av = {0x38383838, 0x38383838, 0x38383838, 0x38383838, 0x38383838, 0x38383838, 0x38383838, 0x38383838};
            v8i_ bv = {0x22222222, 0x22222222, 0x22222222, 0x22222222, 0, 0, 0, 0};
            if (UNIT_MFMA4 == 2) bv = (v8i_){0x11111111, 0, 0, 0, 0, 0, 0, 0};
            v8i_ av2 = av;
            if (UNIT_MFMA4 == 3) { const bool on = qq == 1; av2 = (v8i_){0, on ? 0x00005800 : 0, 0, 0, 0, 0, 0, 0}; bv = (v8i_){on ? 0x00700000 : 0, 0, 0, 0, 0, 0, 0, 0}; }
            if (UNIT_MFMA4 == 4) { const bool on = qq == 2; av2 = (v8i_){0, 0, 0, 0, 0, on ? 0x58000000 : 0, 0, 0}; bv = (v8i_){0, 0, on ? 0x70000000 : 0, 0, 0, 0, 0, 0}; }
            const f32x4 d = __builtin_amdgcn_mfma_scale_f32_16x16x128_f8f6f4(av2, bv, (f32x4){0.f, 0.f, 0.f, 0.f}, 0, 4, 0, 0, 0, 0);
            if (UNIT_MFMA4 >= 100) {
                const int eb = UNIT_MFMA4 - 100; int found = 98;
                v8i_ bs = {0, 0, 0, 0, 0, 0, 0, 0}; if (qq == 2) bs[eb >> 3] = 7 << (4 * (eb & 7));
#pragma nounroll
                for (int qe = 0; qe < 128; ++qe) { int qa = qe >> 5, ea = qe & 31; asm volatile("" : "+s"(qa), "+s"(ea)); v8i_ as = {0, 0, 0, 0, 0, 0, 0, 0};
#pragma unroll
                    for (int w = 0; w < 8; ++w) as[w] = (qq == qa && (ea >> 2) == w) ? (0x58 << (8 * (ea & 3))) : 0;
                    const f32x4 dd = __builtin_amdgcn_mfma_scale_f32_16x16x128_f8f6f4(as, bs, (f32x4){0.f, 0.f, 0.f, 0.f}, 0, 4, 0, 0, 0, 0);
                    if (dd[0] > 1.f) found = (qa == UNIT_QA ? 3 * ea + 4 : 99); }
                if (lane == 0) { VM_WAIT(); args.out[0] = (float)found; }
            } else
            if (lane == 0) { VM_WAIT(); args.out[0] = 200.f + d[0]; }
        }
#endif
#ifdef UNIT_TR4
        __syncthreads();
        if (blockIdx.x == 0 && F.wave == 0) {
            typedef int v2i_ __attribute__((ext_vector_type(2)));
            const int lane = F.lane, g4 = lane >> 4, jj = lane & 15;
            LAS unsigned char* tb = F.lds + RING_OFF + g4 * 2048 + jj * 80;
            int okmask = 0;
            for (int hyp = 0; hyp < 4; ++hyp) { const int st = hyp & 1, ot = hyp >> 1;
                unsigned long long rowbits = 0;
                for (int n = 0; n < 16; ++n) { const unsigned v = (unsigned)(3 * jj + 5 * n + g4) & 15u; const int nib = st ? (n ^ 1) : n; rowbits |= (unsigned long long)v << (4 * nib); }
                *(LAS unsigned*)tb = (unsigned)rowbits; *(LAS unsigned*)(tb + 4) = (unsigned)(rowbits >> 32);
                LDS_WAIT(); asm volatile("" ::: "memory");
                const v2i_ rd = __builtin_amdgcn_ds_read_tr4_b64_v2i32((LAS v2i_*)tb);
                unsigned long long ex = 0;
                for (int k = 0; k < 16; ++k) { const unsigned v = (unsigned)(3 * k + 5 * jj + g4) & 15u; const int nib = ot ? (k ^ 1) : k; ex |= (unsigned long long)v << (4 * nib); }
                const bool bad = ((unsigned)rd.x != (unsigned)ex) || ((unsigned)rd.y != (unsigned)(ex >> 32));
                if (__ballot(bad) == 0ull) okmask |= 1 << hyp;
                LDS_WAIT(); asm volatile("" ::: "memory"); }
            if (lane == 0) { VM_WAIT(); args.out[0] = 200.f + 20.f * (float)okmask; }
        }
#endif
        STAMP(7);
#ifdef TIME_P7_SPREAD
        __syncthreads();
        ts_[8] = __builtin_amdgcn_s_memrealtime();
        if (F.tid == 0) { __hip_atomic_fetch_max((unsigned long long*)(ws + 800), ts_[8] - ts_[7], __ATOMIC_RELAXED, __HIP_MEMORY_SCOPE_AGENT); __hip_atomic_fetch_add((unsigned*)(ws + 840), 1u, __ATOMIC_RELAXED, __HIP_MEMORY_SCOPE_AGENT); }
        if (blockIdx.x == 0 && F.tid == 0) { while (__hip_atomic_load((unsigned*)(ws + 840), __ATOMIC_RELAXED, __HIP_MEMORY_SCOPE_AGENT) < gridDim.x) __builtin_amdgcn_s_sleep(8);
            ts_[8] = ts_[7] + __hip_atomic_load((unsigned long long*)(ws + 800), __ATOMIC_RELAXED, __HIP_MEMORY_SCOPE_AGENT); }
#endif
#ifdef TIME_PHASE
#ifdef TIME_TOTAL
        if (blockIdx.x == 0 && F.tid == 0) { VM_WAIT(); args.out[0] = (float)(ts_[PER_PHASE] - ts_[0]) * (0.01f / TIME_UNIT_US); }
#else
        if (blockIdx.x == 0 && F.tid == 0) { VM_WAIT(); args.out[0] = (float)(ts_[TIME_PHASE + 1] - ts_[TIME_PHASE]) * (0.01f / TIME_UNIT_US); }
#endif
#endif
    }
#undef IN
#undef BOTH
}

#ifdef DEBUG_DUMP
__global__ void dump_kernel(const unsigned char* ws, float* out, float wsmib) {
    const size_t i = (size_t)blockIdx.x * 256 + threadIdx.x; if (i >= (size_t)TOK * 1024) return;
    const size_t t = i >> 10, c = i & 1023; float v = 0.f;
    auto B = [&](size_t off, size_t idx) { return bflo((unsigned)((const bf16*)(ws + off))[idx]); };
#if DEBUG_DUMP == 0
    v = B(WS_H, i) + B(WS_WIN, i % (4608u * 1024u)) + B(WS_WPW, i % (512u * 1024u)) + B(WS_WAO, i % (512u * 1024u)) + B(WS_WOUT, i % (1024u * 1024u)) + B(WS_WQ, i % (2048u * 1024u)) + B(WS_KEYS, i % 32768u) + B(WS_UB, i % (16384u * 1024u)) + B(WS_VB, i % (16384u * 1024u));
#elif DEBUG_DUMP == 1
    v = B(WS_ZGLU, t * 512 + (c & 511)) + 2.f * B(WS_QO, t * 512 + (c & 511)) + 3.f * B(WS_K, t * 512 + (c & 511)) + 4.f * B(WS_V, t * 512 + (c & 511)) + 5.f * B(WS_GC, i) + 6.f * B(WS_GATE_A, i) + ((const float*)(ws + WS_KMEAN))[(t >> 8) * 1024 + (c & 1023)];
#elif DEBUG_DUMP == 2
    v = B(WS_QO, t * 512 + (c & 511)) + 2.f * B(WS_CACT, t * 512 + (c & 511));
#elif DEBUG_DUMP == 20
    v = B(WS_QO, t * 512 + (c & 511));
#elif DEBUG_DUMP == 21
    v = B(WS_CACT, t * 512 + (c & 511));
#elif DEBUG_DUMP == 3
    v = B(WS_MIX, i);
#elif DEBUG_DUMP == 5
    v = B(WS_QP, t * 2048 + c) + 2.f * B(WS_QP, t * 2048 + 1024 + c);
#elif DEBUG_DUMP == 10
    v = B(WS_ZGLU, t * 512 + (c & 511));
#elif DEBUG_DUMP == 11
    v = 2.f * B(WS_QO, t * 512 + (c & 511)) + 3.f * B(WS_K, t * 512 + (c & 511)) + 4.f * B(WS_V, t * 512 + (c & 511));
#elif DEBUG_DUMP == 12
    v = 5.f * B(WS_GC, i) + 6.f * B(WS_GATE_A, i);
#elif DEBUG_DUMP == 13
    v = ((const float*)(ws + WS_KMEAN))[(t >> 8) * 1024 + (c & 1023)];
#elif DEBUG_DUMP == 98
    v = wsmib;
#elif DEBUG_DUMP == 99
    v = 1.0f + (float)(c & 7);
#endif
    out[i] = v;
}
#endif
extern "C" void kernel_launch(void* const* d_in, const int* in_sizes, int n_in, void* d_out, int out_size, void* d_ws, size_t ws_size, hipStream_t stream) {
    static int grid = 0;
    if (grid == 0) {
        if (n_in != 18 || in_sizes[0] != TOK * DM || out_size != TOK * DM || ws_size < WS_END) { fprintf(stderr, "kernel_launch: unexpected shapes (n_in %d, in0 %d, out %d, ws %zu); nothing launched\n", n_in, n_in > 0 ? in_sizes[0] : -1, out_size, ws_size); grid = -1; return; }
        int dev = 0, cus = 0, per_cu = 0;
        if (hipGetDevice(&dev) != hipSuccess || hipDeviceGetAttribute(&cus, hipDeviceAttributeMultiprocessorCount, dev) != hipSuccess) { grid = -1; return; }
        if (hipFuncSetAttribute((const void*)fwd_kernel, hipFuncAttributeMaxDynamicSharedMemorySize, LDS_BYTES) != hipSuccess) { fprintf(stderr, "kernel_launch: hipFuncSetAttribute failed\n"); grid = -1; return; }
        if (hipOccupancyMaxActiveBlocksPerMultiprocessor(&per_cu, (const void*)fwd_kernel, NWAVES * 64, LDS_BYTES) != hipSuccess || per_cu < 1) fprintf(stderr, "kernel_launch: occupancy query reports %d\n", per_cu);
        (void)hipGetLastError();
        grid = cus;
    }
    if (grid < 0) return;
    (void)hipMemsetAsync((char*)d_ws + WS_CTL, 0, CTL_ZERO_BYTES, stream);
    Args a{};
    for (int i = 0; i < 18; ++i) a.in[i] = (const float*)d_in[i];
    a.out = (float*)d_out; a.ws = (unsigned char*)d_ws;
#ifndef NPH_RUN
#define NPH_RUN N_LAUNCHES
#endif
    for (int li = 0; li < NPH_RUN; ++li) {
        a.ph_lo = (N_LAUNCHES == PER_PHASE) ? li : 0; a.ph_hi = (N_LAUNCHES == PER_PHASE) ? li + 1 : PER_PHASE; a.li = li;
        hipLaunchKernelGGL(fwd_kernel, dim3(grid), dim3(NWAVES * 64), LDS_BYTES, stream, a);
    }
#ifdef DEBUG_DUMP
    hipLaunchKernelGGL(dump_kernel, dim3(TOK * 1024 / 256), dim3(256), 0, stream, (const unsigned char*)d_ws, (float*)d_out, (float)(ws_size >> 20));
#endif
}
```

```cpp
#define MK_N_LAUNCHES 1
#ifndef PG8_EPI_DRAIN
#define PG8_EPI_DRAIN 0
#endif
#include <hip/hip_runtime.h>
#include <hip/hip_bf16.h>
#include <cstdio>
#include <cstdint>
#include <cmath>
namespace pg8 {
#define PG8_LAS __attribute__((address_space(3)))
typedef unsigned short bf16_t;
typedef short bf16x8 __attribute__((ext_vector_type(8)));
typedef float f32x4 __attribute__((ext_vector_type(4)));
typedef unsigned u32x4 __attribute__((ext_vector_type(4)));
constexpr int BM = 256, BK = 64, HALF = 128, HTB = HALF * BK * 2  , STAGE_BYTES = 8 * HTB, NXCD = 8, WGM = 8;

__host__ __device__ __forceinline__ int lds_byte(int r, int c) { const int st = (r >> 4) * 2 + (c >> 5), rr = r & 15, cc = c & 31, ob = rr * 64 + cc * 2; return st * 1024 + (ob ^ (((ob >> 9) & 1) << 5)); }
__host__ __device__ __forceinline__ void stage_rc(int b, int& R, int& C) { const int st = b / 1024, sb = b % 1024, swz = sb ^ (((sb >> 9) & 1) << 5); R = (st >> 1) * 16 + swz / 64; C = (st & 1) * 32 + (swz % 64) / 2; }
__host__ __device__ __forceinline__ int perm32(int rho) { const int n = rho >> 4, i = rho & 15; return 8 * (i >> 2) + 4 * n + (i & 3); }

struct Unit { int pm, pn; };
struct Gemm { const bf16_t* A; const bf16_t* Bt; int M, N, K; };

struct StaticOrder {
    int nM, nN, nwg, G, c;
    __host__ __device__ void init(int M, int N, int G_, int c_) { nM = M / BM; nN = N / BM; nwg = nM * nN; G = G_; c = c_; }
    __host__ __device__ bool next(int i, Unit& u) const {
        const long L = (long)i * G + c; if (L >= nwg) return false;
        int wgid = (int)L; { const int q = nwg / NXCD, r = nwg % NXCD, xcd = wgid % NXCD, off = wgid / NXCD; wgid = (xcd < r ? xcd * (q + 1) : r * (q + 1) + (xcd - r) * q) + off; }
        const int nig = WGM * nN, gid = wgid / nig, fm = gid * WGM, gsz = (nM - fm) < WGM ? (nM - fm) : WGM;
        u.pm = fm + ((wgid % nig) % gsz); u.pn = (wgid % nig) / gsz; return true;
    }
    __device__ __forceinline__ void a_ready(const Unit&) const {}
    __device__ __forceinline__ void done(const Unit&) const {}
};

typedef float f32x2c_t __attribute__((ext_vector_type(2))); typedef __bf16 bf16x2c_t __attribute__((ext_vector_type(2)));
__device__ __forceinline__ unsigned cvt_pk_bf16(float lo, float hi) { const f32x2c_t v = {lo, hi}; const bf16x2c_t b = __builtin_convertvector(v, bf16x2c_t); return __builtin_bit_cast(unsigned, b); }
typedef float f32x2 __attribute__((ext_vector_type(2)));
__device__ __forceinline__ float sigm(float v) { return __builtin_amdgcn_rcpf(1.0f + __builtin_amdgcn_exp2f(-1.4426950408889634f * v)); }
__device__ __forceinline__ float bf_lo(unsigned u) { return __uint_as_float(u << 16); }
__device__ __forceinline__ float bf_hi(unsigned u) { return __uint_as_float(u & 0xffff0000u); }
__device__ __forceinline__ u32x4 pack8(const f32x4 a, const f32x4 b) { u32x4 w; w.x = cvt_pk_bf16(a[0], a[1]); w.y = cvt_pk_bf16(a[2], a[3]); w.z = cvt_pk_bf16(b[0], b[1]); w.w = cvt_pk_bf16(b[2], b[3]); return w; }
__device__ __forceinline__ void unpack8(const u32x4 w, f32x4& a, f32x4& b) { a = (f32x4){bf_lo(w.x), bf_hi(w.x), bf_lo(w.y), bf_hi(w.y)}; b = (f32x4){bf_lo(w.z), bf_hi(w.z), bf_lo(w.w), bf_hi(w.w)}; }

#ifndef PG8_WT
#define PG8_WT 1
#endif
__device__ __forceinline__ __amdgpu_buffer_rsrc_t wt_rsrc(const void* p) { return __builtin_amdgcn_make_buffer_rsrc((void*)p, 0, 0x7fffffff, 0x00020000); }
__device__ __forceinline__ void st16(bf16_t* base, const __amdgpu_buffer_rsrc_t r, size_t elem_off, const u32x4 v) {
#if PG8_WT
    __builtin_amdgcn_raw_buffer_store_b128(v, r, (unsigned)(elem_off * 2), 0, 16);
#else
    *(u32x4*)(base + elem_off) = v;
#endif
}
struct EpiIn {
    static constexpr bool PERM = true, AFTER_DRAIN = false, HAS_MID = false;
    bf16_t *zglu, *Q, *gc; float* kmean; float qscale; size_t qkv_stride, gate_stride;
    __device__ __forceinline__ void operator()(const f32x4 (&acc)[2][2][4][2], const Unit& u, int wr, int wc, int fr, int fq) const {
        const int row0 = u.pm * BM + wr * 64 + fr, cw = wc * 32 + 8 * fq, pn = u.pn;
        const __amdgpu_buffer_rsrc_t rz = wt_rsrc(zglu), rq = wt_rsrc(Q), rg = wt_rsrc(gc);
        if (pn < 4) {
#pragma unroll
            for (int ai = 0; ai < 2; ++ai)
#pragma unroll
                for (int m = 0; m < 4; ++m) { const size_t row = (size_t)(row0 + ai * HALF + m * 16);
                    f32x4 z0, z1;
#pragma unroll
                    for (int j = 0; j < 4; ++j) { z0[j] = acc[ai][0][m][0][j] * sigm(acc[ai][1][m][0][j]); z1[j] = acc[ai][0][m][1][j] * sigm(acc[ai][1][m][1][j]); }
                    st16(zglu, rz, row * 512 + pn * 128 + cw, pack8(z0, z1)); }
        } else if (pn < 10) {
            const size_t boff = (size_t)((pn - 4) >> 1) * qkv_stride; const int ct = (pn & 1) * 256; const float sc = pn < 6 ? qscale : 1.0f;
#pragma unroll
            for (int ai = 0; ai < 2; ++ai)
#pragma unroll
                for (int m = 0; m < 4; ++m) { const size_t row = (size_t)(row0 + ai * HALF + m * 16);
#pragma unroll
                    for (int bj = 0; bj < 2; ++bj) st16(Q, rq, boff + row * 512 + ct + bj * HALF + cw, pack8(acc[ai][bj][m][0] * sc, acc[ai][bj][m][1] * sc)); }
            if (pn == 6 || pn == 7) {
#pragma unroll
                for (int bj = 0; bj < 2; ++bj)
#pragma unroll
                    for (int n = 0; n < 2; ++n)
#pragma unroll
                        for (int j = 0; j < 4; ++j) { float s = 0.f;
#pragma unroll
                            for (int ai = 0; ai < 2; ++ai)
#pragma unroll
                                for (int m = 0; m < 4; ++m) s += acc[ai][bj][m][n][j];
                            s += __shfl_xor(s, 1); s += __shfl_xor(s, 2); s += __shfl_xor(s, 4); s += __shfl_xor(s, 8);
                            if (fr == 0) kmean[((size_t)u.pm * 2 + wr) * 512 + ct + bj * HALF + cw + 4 * n + j] = s * (1.0f / 256.0f); }
            }
        } else {
            const size_t boff = (size_t)((pn - 10) >> 2) * gate_stride; const int ct = ((pn - 10) & 3) * 256;
#pragma unroll
            for (int ai = 0; ai < 2; ++ai)
#pragma unroll
                for (int m = 0; m < 4; ++m) { const size_t row = (size_t)(row0 + ai * HALF + m * 16);
#pragma unroll
                    for (int bj = 0; bj < 2; ++bj) { f32x4 s0, s1;
#pragma unroll
                        for (int j = 0; j < 4; ++j) { s0[j] = sigm(acc[ai][bj][m][0][j]); s1[j] = sigm(acc[ai][bj][m][1][j]); }
                        st16(gc, rg, boff + row * 1024 + ct + bj * HALF + cw, pack8(s0, s1)); } }
        }
    }
};
template <bool ADD> struct EpiMix {
    static constexpr bool PERM = true, AFTER_DRAIN = false, HAS_MID = false;
    const bf16_t* gate; const float* bias; bf16_t* mix;
    __device__ __forceinline__ void operator()(const f32x4 (&acc)[2][2][4][2], const Unit& u, int wr, int wc, int fr, int fq) const {
        const int row0 = u.pm * BM + wr * 64 + fr, col0 = u.pn * BM + wc * 32 + 8 * fq;
        f32x4 b0[2], b1[2];
#pragma unroll
        for (int bj = 0; bj < 2; ++bj) { b0[bj] = (f32x4){0.f, 0.f, 0.f, 0.f}; b1[bj] = b0[bj]; if (!ADD) { b0[bj] = *(const f32x4*)(bias + col0 + bj * HALF); b1[bj] = *(const f32x4*)(bias + col0 + bj * HALF + 4); } }
#pragma unroll
        for (int ai = 0; ai < 2; ++ai) {
            u32x4 gq[4][2], mq[4][2];
#pragma unroll
            for (int m = 0; m < 4; ++m)
#pragma unroll
                for (int bj = 0; bj < 2; ++bj) { const size_t off = (size_t)(row0 + ai * HALF + m * 16) * 1024 + col0 + bj * HALF; gq[m][bj] = *(const u32x4*)(gate + off); if (ADD) mq[m][bj] = *(const u32x4*)(mix + off); }
#pragma unroll
            for (int m = 0; m < 4; ++m)
#pragma unroll
                for (int bj = 0; bj < 2; ++bj) { const size_t off = (size_t)(row0 + ai * HALF + m * 16) * 1024 + col0 + bj * HALF;
                    f32x4 g0, g1; unpack8(gq[m][bj], g0, g1);
                    f32x4 v0 = acc[ai][bj][m][0], v1 = acc[ai][bj][m][1];
                    if (!ADD) { v0 = (v0 + b0[bj]) * g0; v1 = (v1 + b1[bj]) * g1; }
                    else { f32x4 p0, p1; unpack8(mq[m][bj], p0, p1); v0 = p0 + v0 * g0; v1 = p1 + v1 * g1; }
                    *(u32x4*)(mix + off) = pack8(v0, v1); }
        }
    }
};
struct EpiMixF {
    static constexpr bool PERM = true, AFTER_DRAIN = false, HAS_MID = true;
    const bf16_t* gc; const bf16_t* ga; const float* bias; bf16_t* mix;
    __device__ __forceinline__ void mid(f32x4 (&acc)[2][2][4][2], const Unit& u, int wr, int wc, int fr, int fq) const {
        const int row0 = u.pm * BM + wr * 64 + fr, col0 = u.pn * BM + wc * 32 + 8 * fq;
#pragma unroll
        for (int ai = 0; ai < 2; ++ai)
#pragma unroll
            for (int m = 0; m < 4; ++m) { u32x4 cq[2], aq[2];
#pragma unroll
                for (int bj = 0; bj < 2; ++bj) { const size_t off = (size_t)(row0 + ai * HALF + m * 16) * 1024 + col0 + bj * HALF; cq[bj] = *(const u32x4*)(gc + off); aq[bj] = *(const u32x4*)(ga + off); }
#pragma unroll
                for (int bj = 0; bj < 2; ++bj) { f32x4 c0, c1, a0, a1; unpack8(cq[bj], c0, c1); unpack8(aq[bj], a0, a1);
                    const f32x4 b0 = *(const f32x4*)(bias + col0 + bj * HALF), b1 = *(const f32x4*)(bias + col0 + bj * HALF + 4);
#pragma unroll
                    for (int j = 0; j < 4; ++j) { acc[ai][bj][m][0][j] = (acc[ai][bj][m][0][j] + b0[j]) * c0[j] * __builtin_amdgcn_rcpf(fmaxf(a0[j], 1e-30f));
                                                  acc[ai][bj][m][1][j] = (acc[ai][bj][m][1][j] + b1[j]) * c1[j] * __builtin_amdgcn_rcpf(fmaxf(a1[j], 1e-30f)); } }
                if (m & 1) asm volatile("" ::: "memory"); }
    }
    __device__ __forceinline__ void operator()(const f32x4 (&acc)[2][2][4][2], const Unit& u, int wr, int wc, int fr, int fq) const {
        const int row0 = u.pm * BM + wr * 64 + fr, col0 = u.pn * BM + wc * 32 + 8 * fq;
        const __amdgpu_buffer_rsrc_t rm = wt_rsrc(mix);
#pragma unroll
        for (int ai = 0; ai < 2; ++ai) { u32x4 aq[4][2];
#pragma unroll
            for (int m = 0; m < 4; ++m)
#pragma unroll
                for (int bj = 0; bj < 2; ++bj) aq[m][bj] = *(const u32x4*)(ga + (size_t)(row0 + ai * HALF + m * 16) * 1024 + col0 + bj * HALF);
#pragma unroll
            for (int m = 0; m < 4; ++m)
#pragma unroll
                for (int bj = 0; bj < 2; ++bj) { f32x4 a0, a1; unpack8(aq[m][bj], a0, a1); f32x4 v0 = acc[ai][bj][m][0], v1 = acc[ai][bj][m][1];
#pragma unroll
                    for (int j = 0; j < 4; ++j) { v0[j] *= fmaxf(a0[j], 1e-30f); v1[j] *= fmaxf(a1[j], 1e-30f); }
                    st16(mix, rm, (size_t)(row0 + ai * HALF + m * 16) * 1024 + col0 + bj * HALF, pack8(v0, v1)); } }
    }
};
struct EpiX1 {
    static constexpr bool PERM = true, AFTER_DRAIN = false, HAS_MID = false;
    const float* x; float* x1; bf16_t* x1b; float* ss;
    __device__ __forceinline__ void operator()(const f32x4 (&acc)[2][2][4][2], const Unit& u, int wr, int wc, int fr, int fq) const {
        const int row0 = u.pm * BM + wr * 64 + fr, col0 = u.pn * BM + wc * 32 + 8 * fq;
        const __amdgpu_buffer_rsrc_t rx = wt_rsrc(x1b);
#pragma unroll
        for (int ai = 0; ai < 2; ++ai) {
            f32x4 xq[4][2][2];
#pragma unroll
            for (int m = 0; m < 4; ++m)
#pragma unroll
                for (int bj = 0; bj < 2; ++bj) { const size_t off = (size_t)(row0 + ai * HALF + m * 16) * 1024 + col0 + bj * HALF; xq[m][bj][0] = *(const f32x4*)(x + off); xq[m][bj][1] = *(const f32x4*)(x + off + 4); }
#pragma unroll
            for (int m = 0; m < 4; ++m) { const size_t row = (size_t)(row0 + ai * HALF + m * 16); float sq = 0.f;
#pragma unroll
                for (int bj = 0; bj < 2; ++bj) { const size_t off = row * 1024 + col0 + bj * HALF;
                    const f32x4 r0 = xq[m][bj][0] + acc[ai][bj][m][0], r1 = xq[m][bj][1] + acc[ai][bj][m][1];
                    st16(x1b, rx, off, pack8(r0, r1));
                    sq += (r0[0] * r0[0] + r0[1] * r0[1]) + (r0[2] * r0[2] + r0[3] * r0[3]) + (r1[0] * r1[0] + r1[1] * r1[1]) + (r1[2] * r1[2] + r1[3] * r1[3]); }
                sq += __shfl_xor(sq, 16); sq += __shfl_xor(sq, 32);
                if (fq == 0) ss[row * 16 + u.pn * 4 + wc] = sq; }
        }
    }
};
struct EpiStore {
    static constexpr bool PERM = true, AFTER_DRAIN = false, HAS_MID = false;
    bf16_t* O; int ldc;
    __device__ __forceinline__ void operator()(const f32x4 (&acc)[2][2][4][2], const Unit& u, int wr, int wc, int fr, int fq) const {
        const int row0 = u.pm * BM + wr * 64 + fr, col0 = u.pn * BM + wc * 32 + 8 * fq;
        const __amdgpu_buffer_rsrc_t ro = wt_rsrc(O);
#pragma unroll
        for (int ai = 0; ai < 2; ++ai)
#pragma unroll
            for (int m = 0; m < 4; ++m) { const size_t row = (size_t)(row0 + ai * HALF + m * 16);
#pragma unroll
                for (int bj = 0; bj < 2; ++bj) st16(O, ro, row * ldc + col0 + bj * HALF, pack8(acc[ai][bj][m][0], acc[ai][bj][m][1])); }
    }
};


template <class Epi, class Sched, bool ALIGN_EPI = false, bool SP2 = false>
__device__ __forceinline__ void gemm_phase(PG8_LAS unsigned char* lds, const Gemm g, const Sched& S, const Epi& E) {
    const int tid = threadIdx.x, wid = __builtin_amdgcn_readfirstlane(tid >> 6), lane = tid & 63, wr = wid >> 2, wc = wid & 3, fr = lane & 15, fq = lane >> 4;
    const int K = g.K, nt = K / BK;
    unsigned voffA[2], voffB[2];
#pragma unroll
    for (int i = 0; i < 2; ++i) { int R, C; stage_rc(tid * 16 + i * 8192, R, C); const int Rb = Epi::PERM ? ((R & ~31) + perm32(R & 31)) : R;
        voffA[i] = (unsigned)(R * K + C) * 2u; voffB[i] = (unsigned)(Rb * K + C) * 2u; }
    const size_t kstep = (size_t)(BK * 2);
    const size_t hstep = (size_t)HALF * K * 2;
    const size_t tstep = 2 * hstep;
    const unsigned ldsw = (unsigned)wid * 1024u;
    const int aoff = lds_byte(wr * 64 + fr, fq * 8), boff = lds_byte(wc * 32 + fr, fq * 8);
#define PG8_SA(b, h) (((b) * 2 + (h)) * HTB)
#define PG8_SB(b, h) ((4 + (b) * 2 + (h)) * HTB)
#define PG8_STAGE(bufoff, gbase, voff) do { _Pragma("unroll") for (int _i = 0; _i < 2; ++_i) \
        __builtin_amdgcn_global_load_lds((const unsigned*)((const char*)(gbase) + (voff)[_i]), (PG8_LAS unsigned*)(lds + (bufoff) + ldsw + _i * 8192), 16, 0, 0); } while (0)
#define PG8_LDA(dst, b, h) do { _Pragma("unroll") for (int m = 0; m < 4; ++m) _Pragma("unroll") for (int k = 0; k < 2; ++k) dst[m][k] = *(const PG8_LAS bf16x8*)(lds + PG8_SA(b, h) + aoff + m * 2048 + k * 1024); } while (0)
#define PG8_LDB(dst, b, h) do { _Pragma("unroll") for (int n = 0; n < 2; ++n) _Pragma("unroll") for (int k = 0; k < 2; ++k) dst[n][k] = *(const PG8_LAS bf16x8*)(lds + PG8_SB(b, h) + boff + n * 2048 + k * 1024); } while (0)
#define PG8_MMA(ai, bj, At, Bt) do { __builtin_amdgcn_s_setprio(1); _Pragma("unroll") for (int m = 0; m < 4; ++m) _Pragma("unroll") for (int n = 0; n < 2; ++n) _Pragma("unroll") for (int k = 0; k < 2; ++k) \
        acc[ai][bj][m][n] = __builtin_amdgcn_mfma_f32_16x16x32_bf16(Bt[n][k], At[m][k], acc[ai][bj][m][n], 0, 0, 0); __builtin_amdgcn_s_setprio(0); } while (0)
#define PG8_WAIT_V(n) asm volatile("s_waitcnt vmcnt(" #n ")" ::: "memory")
#define PG8_WAIT_L(n) asm volatile("s_waitcnt lgkmcnt(" #n ")" ::: "memory")
#define PG8_BAR __builtin_amdgcn_s_barrier()
#define PG8_SCHED __builtin_amdgcn_sched_barrier(0)
    Unit cur, nxt; int ui = 0;
    if (!S.next(0, cur)) return;
    f32x4 acc[2][2][4][2];
#pragma unroll
    for (int a = 0; a < 2; ++a)
#pragma unroll
        for (int b = 0; b < 2; ++b)
#pragma unroll
            for (int m = 0; m < 4; ++m)
#pragma unroll
                for (int n = 0; n < 2; ++n) acc[a][b][m][n] = (f32x4){0.f, 0.f, 0.f, 0.f};
    bf16x8 At[4][2], B0[2][2], B1[2][2];
    const char* cA = (const char*)g.A + (size_t)cur.pm * tstep; const char* cB = (const char*)g.Bt + (size_t)cur.pn * tstep;
    S.a_ready(cur);
    if constexpr (SP2) {
        PG8_STAGE(PG8_SB(0, 0), cB, voffB); PG8_STAGE(PG8_SB(0, 1), cB + hstep, voffB); PG8_STAGE(PG8_SA(0, 0), cA, voffA); PG8_STAGE(PG8_SA(0, 1), cA + hstep, voffA);
        if (wr == 1) PG8_BAR;
        PG8_WAIT_V(2); PG8_BAR;
        PG8_STAGE(PG8_SB(1, 0), cB + kstep, voffB); PG8_STAGE(PG8_SA(1, 0), cA + kstep, voffA); PG8_STAGE(PG8_SB(1, 1), cB + hstep + kstep, voffB);
        PG8_WAIT_V(6); PG8_BAR;
    } else {
        PG8_STAGE(PG8_SB(0, 0), cB, voffB); PG8_STAGE(PG8_SA(0, 0), cA, voffA); PG8_STAGE(PG8_SB(0, 1), cB + hstep, voffB); PG8_STAGE(PG8_SA(0, 1), cA + hstep, voffA);
        if (wr == 1) PG8_BAR;
        PG8_WAIT_V(4); PG8_BAR;
        PG8_STAGE(PG8_SB(1, 0), cB + kstep, voffB); PG8_STAGE(PG8_SA(1, 0), cA + kstep, voffA); PG8_STAGE(PG8_SB(1, 1), cB + hstep + kstep, voffB);
        PG8_WAIT_V(6); PG8_BAR;
    }
    for (;;) {
        const bool has_next = S.next(ui + 1, nxt);
        const char* nA = has_next ? (const char*)g.A + (size_t)nxt.pm * tstep : cA; const char* nB = has_next ? (const char*)g.Bt + (size_t)nxt.pn * tstep : cB;
        if constexpr (Epi::HAS_MID) {
        for (int t = 0; t < nt / 2; t += 2) {
            const bool last = (t == nt - 2);
            const char* a1 = cA + (size_t)(t + 1) * kstep;
            const char* a2 = last ? nA : cA + (size_t)(t + 2) * kstep; const char* b2 = last ? nB : cB + (size_t)(t + 2) * kstep;
            const char* a3 = a2 + kstep; const char* b3 = b2 + kstep;
            if (last && has_next) S.a_ready(nxt);
            if constexpr (SP2) {
            PG8_LDB(B0, 0, 0); PG8_LDB(B1, 0, 1); PG8_SCHED; PG8_LDA(At, 0, 0); PG8_STAGE(PG8_SA(1, 1), a1 + hstep, voffA);
            PG8_WAIT_V(8); PG8_WAIT_L(0); PG8_BAR; PG8_MMA(0, 0, At, B0); PG8_MMA(0, 1, At, B1); PG8_BAR; PG8_SCHED;
            PG8_LDA(At, 0, 1); PG8_STAGE(PG8_SB(0, 0), b2, voffB); PG8_STAGE(PG8_SB(0, 1), b2 + hstep, voffB); PG8_STAGE(PG8_SA(0, 0), a2, voffA);
            PG8_WAIT_V(8); PG8_WAIT_L(0); PG8_BAR; PG8_MMA(1, 0, At, B0); PG8_MMA(1, 1, At, B1); PG8_BAR; PG8_SCHED;
            PG8_LDB(B0, 1, 0); PG8_LDB(B1, 1, 1); PG8_SCHED; PG8_LDA(At, 1, 0); PG8_STAGE(PG8_SA(0, 1), a2 + hstep, voffA);
            PG8_WAIT_V(8); PG8_WAIT_L(0); PG8_BAR; PG8_MMA(0, 0, At, B0); PG8_MMA(0, 1, At, B1); PG8_BAR; PG8_SCHED;
            PG8_LDA(At, 1, 1); PG8_STAGE(PG8_SB(1, 0), b3, voffB); PG8_STAGE(PG8_SB(1, 1), b3 + hstep, voffB); PG8_STAGE(PG8_SA(1, 0), a3, voffA);
            PG8_WAIT_V(8); PG8_WAIT_L(0); PG8_BAR; PG8_MMA(1, 0, At, B0); PG8_MMA(1, 1, At, B1); PG8_BAR; PG8_SCHED;
            } else {
            PG8_LDB(B0, 0, 0); PG8_SCHED; PG8_LDA(At, 0, 0); PG8_STAGE(PG8_SA(1, 1), a1 + hstep, voffA);
            PG8_WAIT_L(8); PG8_BAR; PG8_WAIT_L(0); PG8_MMA(0, 0, At, B0); PG8_BAR; PG8_SCHED;
            PG8_LDB(B1, 0, 1); PG8_STAGE(PG8_SB(0, 0), b2, voffB);
            PG8_BAR; PG8_WAIT_L(0); PG8_MMA(0, 1, At, B1); PG8_BAR;
            PG8_LDA(At, 0, 1); PG8_STAGE(PG8_SA(0, 0), a2, voffA);
            PG8_BAR; PG8_WAIT_L(0); PG8_MMA(1, 0, At, B0); PG8_BAR; PG8_SCHED;
            PG8_STAGE(PG8_SB(0, 1), b2 + hstep, voffB);
            PG8_WAIT_V(6); PG8_BAR; PG8_MMA(1, 1, At, B1); PG8_BAR;
            PG8_LDB(B0, 1, 0); PG8_SCHED; PG8_LDA(At, 1, 0); PG8_STAGE(PG8_SA(0, 1), a2 + hstep, voffA);
            PG8_WAIT_L(8); PG8_BAR; PG8_WAIT_L(0); PG8_MMA(0, 0, At, B0); PG8_BAR; PG8_SCHED;
            PG8_LDB(B1, 1, 1); PG8_STAGE(PG8_SB(1, 0), b3, voffB);
            PG8_BAR; PG8_WAIT_L(0); PG8_MMA(0, 1, At, B1); PG8_BAR;
            PG8_LDA(At, 1, 1); PG8_STAGE(PG8_SA(1, 0), a3, voffA);
            PG8_BAR; PG8_WAIT_L(0); PG8_MMA(1, 0, At, B0); PG8_BAR; PG8_SCHED;
            PG8_STAGE(PG8_SB(1, 1), b3 + hstep, voffB);
            PG8_WAIT_V(6); PG8_BAR; PG8_MMA(1, 1, At, B1); PG8_BAR;
            }
        }
        E.mid(acc, cur, wr, wc, fr, fq);
        for (int t = nt / 2; t < nt; t += 2) {
            const bool last = (t == nt - 2);
            const char* a1 = cA + (size_t)(t + 1) * kstep;
            const char* a2 = last ? nA : cA + (size_t)(t + 2) * kstep; const char* b2 = last ? nB : cB + (size_t)(t + 2) * kstep;
            const char* a3 = a2 + kstep; const char* b3 = b2 + kstep;
            if (last && has_next) S.a_ready(nxt);
            if constexpr (SP2) {
            PG8_LDB(B0, 0, 0); PG8_LDB(B1, 0, 1); PG8_SCHED; PG8_LDA(At, 0, 0); PG8_STAGE(PG8_SA(1, 1), a1 + hstep, voffA);
            PG8_WAIT_V(8); PG8_WAIT_L(0); PG8_BAR; PG8_MMA(0, 0, At, B0); PG8_MMA(0, 1, At, B1); PG8_BAR; PG8_SCHED;
            PG8_LDA(At, 0, 1); PG8_STAGE(PG8_SB(0, 0), b2, voffB); PG8_STAGE(PG8_SB(0, 1), b2 + hstep, voffB); PG8_STAGE(PG8_SA(0, 0), a2, voffA);
            PG8_WAIT_V(8); PG8_WAIT_L(0); PG8_BAR; PG8_MMA(1, 0, At, B0); PG8_MMA(1, 1, At, B1); PG8_BAR; PG8_SCHED;
            PG8_LDB(B0, 1, 0); PG8_LDB(B1, 1, 1); PG8_SCHED; PG8_LDA(At, 1, 0); PG8_STAGE(PG8_SA(0, 1), a2 + hstep, voffA);
            PG8_WAIT_V(8); PG8_WAIT_L(0); PG8_BAR; PG8_MMA(0, 0, At, B0); PG8_MMA(0, 1, At, B1); PG8_BAR; PG8_SCHED;
            PG8_LDA(At, 1, 1); PG8_STAGE(PG8_SB(1, 0), b3, voffB); PG8_STAGE(PG8_SB(1, 1), b3 + hstep, voffB); PG8_STAGE(PG8_SA(1, 0), a3, voffA);
            PG8_WAIT_V(8); PG8_WAIT_L(0); PG8_BAR; PG8_MMA(1, 0, At, B0); PG8_MMA(1, 1, At, B1); PG8_BAR; PG8_SCHED;
            } else {
            PG8_LDB(B0, 0, 0); PG8_SCHED; PG8_LDA(At, 0, 0); PG8_STAGE(PG8_SA(1, 1), a1 + hstep, voffA);
            PG8_WAIT_L(8); PG8_BAR; PG8_WAIT_L(0); PG8_MMA(0, 0, At, B0); PG8_BAR; PG8_SCHED;
            PG8_LDB(B1, 0, 1); PG8_STAGE(PG8_SB(0, 0), b2, voffB);
            PG8_BAR; PG8_WAIT_L(0); PG8_MMA(0, 1, At, B1); PG8_BAR;
            PG8_LDA(At, 0, 1); PG8_STAGE(PG8_SA(0, 0), a2, voffA);
            PG8_BAR; PG8_WAIT_L(0); PG8_MMA(1, 0, At, B0); PG8_BAR; PG8_SCHED;
            PG8_STAGE(PG8_SB(0, 1), b2 + hstep, voffB);
            PG8_WAIT_V(6); PG8_BAR; PG8_MMA(1, 1, At, B1); PG8_BAR;
            PG8_LDB(B0, 1, 0); PG8_SCHED; PG8_LDA(At, 1, 0); PG8_STAGE(PG8_SA(0, 1), a2 + hstep, voffA);
            PG8_WAIT_L(8); PG8_BAR; PG8_WAIT_L(0); PG8_MMA(0, 0, At, B0); PG8_BAR; PG8_SCHED;
            PG8_LDB(B1, 1, 1); PG8_STAGE(PG8_SB(1, 0), b3, voffB);
            PG8_BAR; PG8_WAIT_L(0); PG8_MMA(0, 1, At, B1); PG8_BAR;
            PG8_LDA(At, 1, 1); PG8_STAGE(PG8_SA(1, 0), a3, voffA);
            PG8_BAR; PG8_WAIT_L(0); PG8_MMA(1, 0, At, B0); PG8_BAR; PG8_SCHED;
            PG8_STAGE(PG8_SB(1, 1), b3 + hstep, voffB);
            PG8_WAIT_V(6); PG8_BAR; PG8_MMA(1, 1, At, B1); PG8_BAR;
            }
        }
        } else {
        for (int t = 0; t < nt; t += 2) {
            const bool last = (t == nt - 2);
            const char* a1 = cA + (size_t)(t + 1) * kstep;
            const char* a2 = last ? nA : cA + (size_t)(t + 2) * kstep; const char* b2 = last ? nB : cB + (size_t)(t + 2) * kstep;
            const char* a3 = a2 + kstep; const char* b3 = b2 + kstep;
            if (last && has_next) S.a_ready(nxt);
            if constexpr (SP2) {
            PG8_LDB(B0, 0, 0); PG8_LDB(B1, 0, 1); PG8_SCHED; PG8_LDA(At, 0, 0); PG8_STAGE(PG8_SA(1, 1), a1 + hstep, voffA);
            PG8_WAIT_V(8); PG8_WAIT_L(0); PG8_BAR; PG8_MMA(0, 0, At, B0); PG8_MMA(0, 1, At, B1); PG8_BAR; PG8_SCHED;
            PG8_LDA(At, 0, 1); PG8_STAGE(PG8_SB(0, 0), b2, voffB); PG8_STAGE(PG8_SB(0, 1), b2 + hstep, voffB); PG8_STAGE(PG8_SA(0, 0), a2, voffA);
            PG8_WAIT_V(8); PG8_WAIT_L(0); PG8_BAR; PG8_MMA(1, 0, At, B0); PG8_MMA(1, 1, At, B1); PG8_BAR; PG8_SCHED;
            PG8_LDB(B0, 1, 0); PG8_LDB(B1, 1, 1); PG8_SCHED; PG8_LDA(At, 1, 0); PG8_STAGE(PG8_SA(0, 1), a2 + hstep, voffA);
            PG8_WAIT_V(8); PG8_WAIT_L(0); PG8_BAR; PG8_MMA(0, 0, At, B0); PG8_MMA(0, 1, At, B1); PG8_BAR; PG8_SCHED;
            PG8_LDA(At, 1, 1); PG8_STAGE(PG8_SB(1, 0), b3, voffB); PG8_STAGE(PG8_SB(1, 1), b3 + hstep, voffB); PG8_STAGE(PG8_SA(1, 0), a3, voffA);
            PG8_WAIT_V(8); PG8_WAIT_L(0); PG8_BAR; PG8_MMA(1, 0, At, B0); PG8_MMA(1, 1, At, B1); PG8_BAR; PG8_SCHED;
            } else {
            PG8_LDB(B0, 0, 0); PG8_SCHED; PG8_LDA(At, 0, 0); PG8_STAGE(PG8_SA(1, 1), a1 + hstep, voffA);
            PG8_WAIT_L(8); PG8_BAR; PG8_WAIT_L(0); PG8_MMA(0, 0, At, B0); PG8_BAR; PG8_SCHED;
            PG8_LDB(B1, 0, 1); PG8_STAGE(PG8_SB(0, 0), b2, voffB);
            PG8_BAR; PG8_WAIT_L(0); PG8_MMA(0, 1, At, B1); PG8_BAR;
            PG8_LDA(At, 0, 1); PG8_STAGE(PG8_SA(0, 0), a2, voffA);
            PG8_BAR; PG8_WAIT_L(0); PG8_MMA(1, 0, At, B0); PG8_BAR; PG8_SCHED;
            PG8_STAGE(PG8_SB(0, 1), b2 + hstep, voffB);
            PG8_WAIT_V(6); PG8_BAR; PG8_MMA(1, 1, At, B1); PG8_BAR;
            PG8_LDB(B0, 1, 0); PG8_SCHED; PG8_LDA(At, 1, 0); PG8_STAGE(PG8_SA(0, 1), a2 + hstep, voffA);
            PG8_WAIT_L(8); PG8_BAR; PG8_WAIT_L(0); PG8_MMA(0, 0, At, B0); PG8_BAR; PG8_SCHED;
            PG8_LDB(B1, 1, 1); PG8_STAGE(PG8_SB(1, 0), b3, voffB);
            PG8_BAR; PG8_WAIT_L(0); PG8_MMA(0, 1, At, B1); PG8_BAR;
            PG8_LDA(At, 1, 1); PG8_STAGE(PG8_SA(1, 0), a3, voffA);
            PG8_BAR; PG8_WAIT_L(0); PG8_MMA(1, 0, At, B0); PG8_BAR; PG8_SCHED;
            PG8_STAGE(PG8_SB(1, 1), b3 + hstep, voffB);
            PG8_WAIT_V(6); PG8_BAR; PG8_MMA(1, 1, At, B1); PG8_BAR;
            }
        }
        }
        if constexpr (ALIGN_EPI) { if (wr == 0) PG8_BAR; }
        if constexpr (!Epi::AFTER_DRAIN) { E(acc, cur, wr, wc, fr, fq); S.done(cur);
#if PG8_EPI_DRAIN
            PG8_WAIT_V(0);
#endif
        }
        if (!has_next) break;
#pragma unroll
        for (int a = 0; a < 2; ++a)
#pragma unroll
            for (int b = 0; b < 2; ++b)
#pragma unroll
                for (int m = 0; m < 4; ++m)
#pragma unroll
                    for (int n = 0; n < 2; ++n) acc[a][b][m][n] = (f32x4){0.f, 0.f, 0.f, 0.f};
        cur = nxt; cA = nA; cB = nB; ++ui;
        if constexpr (ALIGN_EPI) { if (wr == 1) PG8_BAR; }
    }
    PG8_WAIT_V(0);
    if constexpr (!ALIGN_EPI) { if (wr == 0) PG8_BAR; }
    PG8_BAR;
    if constexpr (Epi::AFTER_DRAIN) { E.fused(acc, cur, wr, wc, fr, fq, lds, wid, lane); S.done(cur); }
#undef PG8_SA
#undef PG8_SB
#undef PG8_STAGE
#undef PG8_LDA
#undef PG8_LDB
#undef PG8_MMA
#undef PG8_WAIT_V
#undef PG8_WAIT_L
#undef PG8_BAR
#undef PG8_SCHED
}
}

#include <hip/hip_bf16.h>
#include <cmath>
namespace attn_body {
using bf16=__hip_bfloat16;
using bf16x8=__attribute__((ext_vector_type(8)))short;
using s16x4=__attribute__((ext_vector_type(4)))short;
using f32x16=__attribute__((ext_vector_type(16)))float;
using u32x4=__attribute__((ext_vector_type(4)))unsigned;
typedef float f32x4_t __attribute__((ext_vector_type(4)));
constexpr int BATCH=8,NHEAD=8,SEQ=4096,D=64,DM=NHEAD*D;
constexpr int NW=8,QBLK=32,QB=QBLK*NW,KVBLK=64,NQB=SEQ/QB;
constexpr int ATTN_PITCH=DM, ATTN_UNIT_ROWS=QB, OPITCH=1024;
__device__ __forceinline__ int crow(int r,int hi){return (r&3)+8*(r>>2)+4*hi;}
#define SBAR() __builtin_amdgcn_sched_barrier(0)
__device__ __forceinline__ void cmask(f32x16&p0,f32x16&p1,int jb,int qrel,int hi){
  const float NEG=-INFINITY; int kb=64*jb+4*hi;
  #pragma unroll
  for(int r=0;r<16;++r){int kv=kb+(r&3)+8*(r>>2); if(kv>qrel)p0[r]=NEG; if(kv+32>qrel)p1[r]=NEG;}
}

constexpr int NSLOT=3, SLOTB=8192;
constexpr int LDS_K=0, LDS_V=NSLOT*SLOTB, LDS_WS=2*NSLOT*SLOTB, LDS_OST=LDS_WS+NW*64*4, LDS_KM=LDS_OST+NW*4096, LDS_BYTES=LDS_KM+4096;
constexpr float C2=0.125f*1.4426950408889634f;
__device__ __forceinline__ void glds16(const void*gsrc,unsigned lds_dst){unsigned keep;
  asm volatile("s_mov_b32 %0, m0\n\ts_mov_b32 m0, %2\n\ts_nop 0\n\tglobal_load_lds_dwordx4 %1, off\n\ts_mov_b32 m0, %0":"=&s"(keep):"v"(gsrc),"s"(lds_dst):"memory");}
__device__ __forceinline__ float max3f(float a,float b,float c){float r;asm("v_max3_f32 %0, %1, %2, %3":"=v"(r):"v"(a),"v"(b),"v"(c));return r;}
__device__ __forceinline__ float max2f(float a,float b){float r;asm("v_max_f32_e32 %0, %1, %2":"=v"(r):"v"(a),"v"(b));return r;}
__device__ __forceinline__ float fadd_s(float a,float b){float r;asm("v_add_f32_e32 %0, %1, %2":"=v"(r):"v"(a),"v"(b));return r;}
__device__ __forceinline__ float fsub_s(float a,float b){float r;asm("v_sub_f32_e32 %0, %1, %2":"=v"(r):"v"(a),"v"(b));return r;}
typedef float f32x2_t __attribute__((ext_vector_type(2))); typedef __bf16 bf16x2_t __attribute__((ext_vector_type(2)));
__device__ __forceinline__ unsigned cvtpk_s(float lo,float hi){f32x2_t v={lo,hi};bf16x2_t b=__builtin_convertvector(v,bf16x2_t);return __builtin_bit_cast(unsigned,b);}
#define WAIT_BAR(N) asm volatile("s_waitcnt vmcnt(" #N ") lgkmcnt(0)\n\ts_barrier":::"memory")

__device__ __forceinline__ void qkt(f32x16&p0,f32x16&p1,const char*Kslot,const bf16x8*qr,int r32,int hi){
  const char*kb=Kslot+hi*1024+r32*16;
  #pragma unroll
  for(int d0=0;d0<4;++d0){
    const bf16x8 b0=*reinterpret_cast<const bf16x8*>(kb+d0*2048);
    const bf16x8 b1=*reinterpret_cast<const bf16x8*>(kb+d0*2048+512);
    p0=__builtin_amdgcn_mfma_f32_32x32x16_bf16(b0,qr[d0],p0,0,0,0);p1=__builtin_amdgcn_mfma_f32_32x32x16_bf16(b1,qr[d0],p1,0,0,0);}
}
typedef __attribute__((address_space(3))) const char* lds_cptr;
typedef short v4i16_t __attribute__((ext_vector_type(4)));
__device__ __forceinline__ void kload8(bf16x8*kf,lds_cptr kp){
  kf[0]=*(const __attribute__((address_space(3))) bf16x8*)(kp);      kf[1]=*(const __attribute__((address_space(3))) bf16x8*)(kp+512);
  kf[2]=*(const __attribute__((address_space(3))) bf16x8*)(kp+2048); kf[3]=*(const __attribute__((address_space(3))) bf16x8*)(kp+2560);
  kf[4]=*(const __attribute__((address_space(3))) bf16x8*)(kp+4096); kf[5]=*(const __attribute__((address_space(3))) bf16x8*)(kp+4608);
  kf[6]=*(const __attribute__((address_space(3))) bf16x8*)(kp+6144); kf[7]=*(const __attribute__((address_space(3))) bf16x8*)(kp+6656);
}
__device__ __forceinline__ void kload2(bf16x8*kf,lds_cptr kp,int j){ kf[2*j]=*(const __attribute__((address_space(3))) bf16x8*)(kp+j*2048); kf[2*j+1]=*(const __attribute__((address_space(3))) bf16x8*)(kp+j*2048+512); }
__device__ __forceinline__ s16x4 vtr(lds_cptr p){ return __builtin_bit_cast(s16x4,__builtin_amdgcn_ds_read_tr16_b64_v4i16((__attribute__((address_space(3))) v4i16_t*)p)); }
__device__ __forceinline__ float rowmax(const f32x16&p0,const f32x16&p1){
  float a=max3f(p0[0],p0[1],p1[0]),b=max3f(p0[2],p0[3],p1[1]);a=max3f(a,p1[2],p1[3]);
  #pragma unroll
  for(int r=4;r<16;r+=4){a=max3f(a,p0[r],p0[r+1]);b=max3f(b,p0[r+2],p0[r+3]);a=max3f(a,p1[r],p1[r+1]);b=max3f(b,p1[r+2],p1[r+3]);}
  const float m=max2f(a,b);
  auto rr=__builtin_amdgcn_permlane32_swap(__float_as_uint(m),__float_as_uint(m),false,false);
  return max2f(__uint_as_float(rr[0]),__uint_as_float(rr[1]));
}
__device__ __forceinline__ void pv(f32x16*o,int vb,bf16x8 pa0,bf16x8 pa1,bf16x8 pa2,bf16x8 pa3){
  #pragma unroll
  for(int d0=0;d0<2;++d0){s16x4 lo[4],hi[4];
    #pragma unroll
    for(int ks=0;ks<4;++ks){
      asm volatile("ds_read_b64_tr_b16 %0,%1 offset:%c2":"=&v"(lo[ks]):"v"(vb),"i"(d0*4096+ks*1024):"memory");
      asm volatile("ds_read_b64_tr_b16 %0,%1 offset:%c2":"=&v"(hi[ks]):"v"(vb),"i"(d0*4096+ks*1024+512):"memory");}
    asm volatile("s_waitcnt lgkmcnt(0)":::"memory");SBAR();
    #define PK(k) (bf16x8){lo[k][0],lo[k][1],lo[k][2],lo[k][3],hi[k][0],hi[k][1],hi[k][2],hi[k][3]}
    o[d0]=__builtin_amdgcn_mfma_f32_32x32x16_bf16(pa0,PK(0),o[d0],0,0,0);
    o[d0]=__builtin_amdgcn_mfma_f32_32x32x16_bf16(pa1,PK(1),o[d0],0,0,0);
    o[d0]=__builtin_amdgcn_mfma_f32_32x32x16_bf16(pa2,PK(2),o[d0],0,0,0);
    o[d0]=__builtin_amdgcn_mfma_f32_32x32x16_bf16(pa3,PK(3),o[d0],0,0,0);
    #undef PK
  }
}

#ifndef ATTN_STORE16
#define ATTN_STORE16(p,v) __builtin_amdgcn_raw_buffer_store_b128((v),orsrc_,(unsigned)((const char*)(p)-(const char*)O),0,16)
#endif
template<int THRL> __device__ __forceinline__ void attn_unit(int b,int h,int qb,const bf16*Q,const bf16*__restrict__ K,const bf16*__restrict__ V,bf16*O,const float*kmean,char*shm){
  const int tid=threadIdx.x,lane=tid&63,r32=lane&31,hi=lane>>5; const int wid=__builtin_amdgcn_readfirstlane(tid>>6);
  const long rowbase=(long)b*SEQ; const int q0=qb*QB;
  const bf16*Qw=Q+(rowbase+q0+wid*QBLK)*DM+h*D;
  const bf16*Kh=K+rowbase*DM+h*D,*Vh=V+rowbase*DM+h*D;
  const unsigned lds0=(unsigned)(uintptr_t)shm;
  float*wsf=(float*)(shm+LDS_WS)+wid*64;
  const bf16*ksrc=Kh+(long)lane*DM+wid*8;
  const bf16*vsrc=Vh+(long)(16*(wid&3)+(lane>>2))*DM+(wid>>2)*32+(lane&3)*8;
  const unsigned kdst=lds0+LDS_K+wid*1024, vdst=lds0+LDS_V+wid*1024;
  #define POS(t) (((t)<4)?(NT-4+(t)):((t)-4))
  #define DMA_K(t,slot) glds16(ksrc+(long)POS(t)*KVBLK*DM,(unsigned)__builtin_amdgcn_readfirstlane(kdst+(slot)))
  #define DMA_V(t,slot) glds16(vsrc+(long)POS(t)*KVBLK*DM,(unsigned)__builtin_amdgcn_readfirstlane(vdst+(slot)))
  const int vb0=(int)(lds0+LDS_V)+((lane>>4)&1)*32+(lane&3)*8+(4*hi+((lane&15)>>2))*64;
  const char*Kbase=shm+LDS_K; bf16x8 kf[8];
  const lds_cptr shm3=(lds_cptr)shm; const lds_cptr kp0=shm3+LDS_K+hi*1024+r32*16; const lds_cptr vp0=shm3+LDS_V+((lane>>4)&1)*32+(lane&3)*8+(4*hi+((lane&15)>>2))*64;
  const int NT=(q0+QB)/KVBLK;
  DMA_K(0,0);DMA_V(0,0);DMA_K(1,SLOTB);
  bf16x8 qr[4];
  #pragma unroll
  for(int d0=0;d0<4;++d0)qr[d0]=*reinterpret_cast<const bf16x8*>(&Qw[(long)r32*DM+d0*16+hi*8]);
  float mhat=0.f,l_reg=0.f;f32x16 o[2];o[0]=f32x16{};o[1]=f32x16{};
  const float slope2=ldexpf(1.4426950408889634f,-(h+1));
  unsigned selmask=0u;
  { typedef __attribute__((address_space(3))) float* lds_fptr; typedef __attribute__((address_space(3))) const f32x4_t* lds_f4ptr;
    lds_fptr kml=(lds_fptr)((lds_cptr)shm+LDS_KM);
    { const float*src=kmean+((long)b*16)*2*DM+h*D;
      #pragma unroll
      for(int i=0;i<2;++i){const int e=tid+512*i; kml[e]=src[(e>>6)*2*DM+(e&63)]+src[(e>>6)*2*DM+DM+(e&63)];} }
    asm volatile("s_waitcnt vmcnt(0) lgkmcnt(0)\n\ts_barrier":::"memory");
    float qf[32];
    #pragma unroll
    for(int d0=0;d0<4;++d0){
      #pragma unroll
      for(int j=0;j<8;++j)qf[d0*8+j]=__uint_as_float(((unsigned)(unsigned short)qr[d0][j])<<16);}
    float sc[16];
    #pragma unroll
    for(int j=0;j<16;++j){ sc[j]=-INFINITY;
      if(j<qb){ lds_f4ptr kr=(lds_f4ptr)(kml+j*64+hi*8); float a=0.f;
        #pragma unroll
        for(int d0=0;d0<4;++d0){ const f32x4_t k0=kr[d0*4],k1=kr[d0*4+1];
          a+=qf[d0*8+0]*k0[0]+qf[d0*8+1]*k0[1]+qf[d0*8+2]*k0[2]+qf[d0*8+3]*k0[3]+qf[d0*8+4]*k1[0]+qf[d0*8+5]*k1[1]+qf[d0*8+6]*k1[2]+qf[d0*8+7]*k1[3]; }
        a+=__shfl_xor(a,32); sc[j]=a; } }
    #pragma unroll
    for(int j=0;j<15;++j){ int cnt=0;
      #pragma unroll
      for(int k=0;k<15;++k){ if(k!=j) cnt+=((sc[k]>sc[j])||((sc[k]==sc[j])&&(k<j)))?1:0; }
      if(j<qb&&cnt<3) selmask|=(1u<<j); } }
  #define CINIT(C0,C1,t) do{ const int pt_=POS(t); float x_=slope2*(float)(64*pt_-q0+4*hi)-mhat; \
    if((t)>=4){ x_+=((selmask>>(pt_>>2))&1u)?0.f:-30000.f; } const float y_=x_+32.f*slope2; \
    _Pragma("unroll") for(int r=0;r<16;++r){ const float cr_=(float)((r&3)+8*(r>>2)); C0[r]=__builtin_fmaf(slope2,cr_,x_); C1[r]=__builtin_fmaf(slope2,cr_,y_); } }while(0)

  const int qrel=wid*QBLK+r32;
  #define CMASK(P0,P1,t) do{ if((t)<4)cmask(P0,P1,(t),qrel,hi);}while(0)
  bool resc=false;
  #define START(P0,P1) do{ const float rm=rowmax(P0,P1); resc=false; \
    { const float dl=rm; mhat=fadd_s(mhat,dl); \
      _Pragma("unroll") for(int r=0;r<16;++r){P0[r]=fsub_s(P0[r],dl);P1[r]=fsub_s(P1[r],dl);} } \
    _Pragma("unroll") for(int r=0;r<16;++r)P0[r]=__builtin_amdgcn_exp2f(P0[r]); }while(0)
  #define RESC() do{ if(resc){ asm volatile("s_waitcnt lgkmcnt(0)":::"memory"); \
      _Pragma("unroll") for(int d_=0;d_<2;++d_) _Pragma("unroll") for(int r=0;r<16;++r)o[d_][r]*=wsf[crow(r,hi)]; } }while(0)
  f32x16 pA0,pA1,pB0,pB1;
  int sl_prev=0,sl_cur=0,sl_next=SLOTB;
  #define ROT() do{sl_prev=sl_cur;sl_cur=sl_next;sl_next=(sl_next==(NSLOT-1)*SLOTB)?0:sl_next+SLOTB;}while(0)
  DMA_K(2,2*SLOTB);
  WAIT_BAR(3);
  CINIT(pA0,pA1,0); qkt(pA0,pA1,Kbase,qr,r32,hi);asm volatile("s_nop 15\n\ts_nop 7":"+v"(pA0),"+v"(pA1));CMASK(pA0,pA1,0);
  START(pA0,pA1);
  _Pragma("unroll") for(int r=0;r<16;++r)pA1[r]=__builtin_amdgcn_exp2f(pA1[r]);
  WAIT_BAR(0);
  DMA_K(3,0);DMA_V(1,SLOTB);
  ROT();
  kload8(kf,kp0+sl_cur);
  WAIT_BAR(2);
  s16x4 vlo[8],vhi[8]; u32x4 pw0,pw1,pw2,pw3;
  #define PKW(P,B) cvtpk_s(P[B],P[B+1])
  #define PAF(k) __builtin_bit_cast(bf16x8,pw##k)
  #define VFR(i) (bf16x8){vlo[i][0],vlo[i][1],vlo[i][2],vlo[i][3],vhi[i][0],vhi[i][1],vhi[i][2],vhi[i][3]}
  #define PIN(x) asm volatile("":"+v"(x))
  #define MX3(a,b,c) __builtin_fmaxf(__builtin_fmaxf((a),(b)),(c))
  #define GAPA(MF,A0,A1,A2,A3,W0,W1,PW) do{ MF; sacc+=A0; sacc+=A1; sacc+=A2; sacc+=A3; PIN(sacc); W0; W1; PIN(PW); SBAR(); }while(0)
  #define EX(v) __builtin_amdgcn_exp2f(v)
  #define GAPB(MF,X,B) do{ MF; X[B]=EX(X[B]); X[B+1]=EX(X[B+1]); X[B+2]=EX(X[B+2]); X[B+3]=EX(X[B+3]); PIN(X); SBAR(); }while(0)
  #define VRD(i) do{ vlo[i]=vtr(vp_+(((i)>>2)*4096+((i)&3)*1024)); vhi[i]=vtr(vp_+(((i)>>2)*4096+((i)&3)*1024+512)); }while(0)
  #define KRD(G,j) do{ if(G){ kload2(kf,kp0+sl_next,j); SBAR(); } }while(0)
  #define STEP(C0,C1,P0,P1,t,GK,GV,GL) do{ SBAR(); CINIT(C0,C1,t); PIN(C0); PIN(C1); SBAR(); \
    const lds_cptr vp_=vp0+sl_prev; \
    VRD(0); SBAR(); float sacc=(P0[0]+P0[1]); \
    GAPA(C0=__builtin_amdgcn_mfma_f32_32x32x16_bf16(kf[0],qr[0],C0,0,0,0), P0[2],P0[3],P0[4],P0[5],     pw0[0]=PKW(P0,0), pw0[1]=PKW(P0,2), pw0); \
    VRD(4); SBAR(); GAPA(C1=__builtin_amdgcn_mfma_f32_32x32x16_bf16(kf[1],qr[0],C1,0,0,0), P0[6],P0[7],P0[8],P0[9],     pw0[2]=PKW(P0,4), pw0[3]=PKW(P0,6), pw0); \
    VRD(1); SBAR(); GAPA(C0=__builtin_amdgcn_mfma_f32_32x32x16_bf16(kf[2],qr[1],C0,0,0,0),   P0[10],P0[11],P0[12],P0[13], pw1[0]=PKW(P0,8), pw1[1]=PKW(P0,10), pw1); \
    VRD(5); SBAR(); GAPA(C1=__builtin_amdgcn_mfma_f32_32x32x16_bf16(kf[3],qr[1],C1,0,0,0),   P0[14],P0[15],P1[0],P1[1],   pw1[2]=PKW(P0,12),pw1[3]=PKW(P0,14), pw1); \
    VRD(2); SBAR(); GAPA(C0=__builtin_amdgcn_mfma_f32_32x32x16_bf16(kf[4],qr[2],C0,0,0,0),   P1[2],P1[3],P1[4],P1[5],     pw2[0]=PKW(P1,0), pw2[1]=PKW(P1,2), pw2); \
    VRD(6); SBAR(); GAPA(C1=__builtin_amdgcn_mfma_f32_32x32x16_bf16(kf[5],qr[2],C1,0,0,0),   P1[6],P1[7],P1[8],P1[9],     pw2[2]=PKW(P1,4), pw2[3]=PKW(P1,6), pw2); \
    VRD(3); SBAR(); GAPA(C0=__builtin_amdgcn_mfma_f32_32x32x16_bf16(kf[6],qr[3],C0,0,0,0),   P1[10],P1[11],P1[12],P1[13], pw3[0]=PKW(P1,8), pw3[1]=PKW(P1,10), pw3); \
    VRD(7); SBAR(); GAPA(C1=__builtin_amdgcn_mfma_f32_32x32x16_bf16(kf[7],qr[3],C1,0,0,0),   P1[14],P1[15],0.f,0.f,       pw3[2]=PKW(P1,12),pw3[3]=PKW(P1,14), pw3); \
    l_reg+=sacc; \
    if(GK){DMA_K((t)+3,sl_cur);} if(GV){DMA_V((t)+1,sl_next);} \
    CMASK(C0,C1,t); \
    { float a=MX3(C0[0],C0[1],C1[0]),b=MX3(C0[2],C0[3],C1[1]); a=MX3(a,C1[2],C1[3]); \
      _Pragma("unroll") for(int r=4;r<16;r+=4){a=MX3(a,C0[r],C0[r+1]);b=MX3(b,C0[r+2],C0[r+3]);a=MX3(a,C1[r],C1[r+1]);b=MX3(b,C1[r+2],C1[r+3]);} \
      float rm=__builtin_fmaxf(a,b); { auto rr=__builtin_amdgcn_permlane32_swap(__float_as_uint(rm),__float_as_uint(rm),false,false); rm=__builtin_fmaxf(__uint_as_float(rr[0]),__uint_as_float(rr[1])); } \
      resc=false; \
      if(__builtin_expect(__any(rm>(float)THRL),0)){ const float dl=__builtin_fmaxf(rm,0.f); mhat+=dl; \
        _Pragma("unroll") for(int r=0;r<16;++r){C0[r]-=dl;C1[r]-=dl;} \
        const float f=__builtin_amdgcn_exp2f(-dl); l_reg*=f; if(hi==0)wsf[r32]=f; resc=true; } } \
    SBAR(); \
    GAPB(o[0]=__builtin_amdgcn_mfma_f32_32x32x16_bf16(PAF(0),VFR(0),o[0],0,0,0), C0,0); \
    GAPB(o[1]=__builtin_amdgcn_mfma_f32_32x32x16_bf16(PAF(0),VFR(4),o[1],0,0,0), C0,4); \
    KRD(GL,0); GAPB(o[0]=__builtin_amdgcn_mfma_f32_32x32x16_bf16(PAF(1),VFR(1),o[0],0,0,0), C0,8); \
    KRD(GL,1); GAPB(o[1]=__builtin_amdgcn_mfma_f32_32x32x16_bf16(PAF(1),VFR(5),o[1],0,0,0), C0,12); \
    KRD(GL,2); GAPB(o[0]=__builtin_amdgcn_mfma_f32_32x32x16_bf16(PAF(2),VFR(2),o[0],0,0,0), C1,0); \
    KRD(GL,3); GAPB(o[1]=__builtin_amdgcn_mfma_f32_32x32x16_bf16(PAF(2),VFR(6),o[1],0,0,0), C1,4); \
    GAPB(o[0]=__builtin_amdgcn_mfma_f32_32x32x16_bf16(PAF(3),VFR(3),o[0],0,0,0), C1,8); \
    GAPB(o[1]=__builtin_amdgcn_mfma_f32_32x32x16_bf16(PAF(3),VFR(7),o[1],0,0,0), C1,12); \
    }while(0)
  int t=1;
  #define ENDW(tt) do{ if((tt)+3<NT){WAIT_BAR(2);} else if((tt)+2<NT){WAIT_BAR(1);} else {WAIT_BAR(0);} }while(0)
  for(;t<5&&t+1<NT;t+=2){
    STEP(pB0,pB1,pA0,pA1,t,(t+3<NT),(t+1<NT),(t+1<NT));       ENDW(t);   RESC(); ROT();
    STEP(pA0,pA1,pB0,pB1,t+1,(t+4<NT),(t+2<NT),(t+2<NT));     ENDW(t+1); RESC(); ROT();
  }
  #undef CMASK
  #define CMASK(P0,P1,t) do{}while(0)
  for(;t+5<NT;t+=2){
    STEP(pB0,pB1,pA0,pA1,t,true,true,true);     WAIT_BAR(2); RESC(); ROT();
    STEP(pA0,pA1,pB0,pB1,t+1,true,true,true);   WAIT_BAR(2); RESC(); ROT();
  }
  for(;t+1<NT;t+=2){
    STEP(pB0,pB1,pA0,pA1,t,(t+3<NT),(t+1<NT),(t+1<NT));       ENDW(t);   RESC(); ROT();
    STEP(pA0,pA1,pB0,pB1,t+1,(t+4<NT),(t+2<NT),(t+2<NT));     ENDW(t+1); RESC(); ROT();
  }
  #undef CMASK
  #define CMASK(P0,P1,t) do{ if((t)<4)cmask(P0,P1,(t),qrel,hi);}while(0)
  STEP(pB0,pB1,pA0,pA1,NT-1,false,false,false); RESC();
  { float sacc=pB0[0]+pB0[1]; _Pragma("unroll") for(int r=2;r<16;++r)sacc+=pB0[r]; _Pragma("unroll") for(int r=0;r<16;++r)sacc+=pB1[r]; l_reg+=sacc;
    pw0=(u32x4){PKW(pB0,0),PKW(pB0,2),PKW(pB0,4),PKW(pB0,6)};pw1=(u32x4){PKW(pB0,8),PKW(pB0,10),PKW(pB0,12),PKW(pB0,14)};pw2=(u32x4){PKW(pB1,0),PKW(pB1,2),PKW(pB1,4),PKW(pB1,6)};pw3=(u32x4){PKW(pB1,8),PKW(pB1,10),PKW(pB1,12),PKW(pB1,14)};
    SBAR(); pv(o,vb0+sl_cur,PAF(0),PAF(1),PAF(2),PAF(3)); }
  #undef PKW
  #undef PAF
  #undef VFR
  #undef PIN
  #undef MX3
  #undef GAPA
  #undef GAPB
  #undef EX
  #undef VRD
  #undef KRD
  #undef STEP
  #undef ENDW
  {auto rr=__builtin_amdgcn_permlane32_swap(__float_as_uint(l_reg),__float_as_uint(l_reg),false,false);l_reg=__uint_as_float(rr[0])+__uint_as_float(rr[1]);}
  if(hi==0)wsf[32+r32]=l_reg;asm volatile("s_waitcnt lgkmcnt(0)":::"memory");
  float rli[16];
  #pragma unroll
  for(int r=0;r<16;++r)rli[r]=__builtin_amdgcn_rcpf(wsf[32+crow(r,hi)]);
  bf16*Ow=O+(rowbase+q0+wid*QBLK)*OPITCH+h*D; const __amdgpu_buffer_rsrc_t orsrc_=__builtin_amdgcn_make_buffer_rsrc((void*)O,0,0x7fffffff,0x00020000);
  { bf16*stg=(bf16*)(shm+LDS_OST)+wid*2048;
    #pragma unroll
    for(int r=0;r<16;++r){const int orow=crow(r,hi);
      #pragma unroll
      for(int d0=0;d0<2;++d0)stg[orow*64+d0*32+r32]=__float2bfloat16(o[d0][r]*rli[r]);}
    asm volatile("s_waitcnt lgkmcnt(0)":::"memory");
    #pragma unroll
    for(int i=0;i<4;++i){const int row=i*8+(lane>>3),ch=lane&7; const u32x4 v=*(const u32x4*)(stg+row*64+ch*8); ATTN_STORE16(Ow+(long)row*OPITCH+ch*8,v);} }
  asm volatile("s_waitcnt lgkmcnt(0)\n\ts_barrier":::"memory");
  #undef DMA_K
  #undef DMA_V
  #undef POS
  #undef CINIT
  #undef CMASK
  #undef START
  #undef RESC
  #undef ROT
}
constexpr int ATTN_LDS_BYTES=LDS_BYTES;
struct AttnTensors { const bf16* Q; const bf16* K; const bf16* V; bf16* O; const float* kmean; };
struct AttnUnit { int bh; int qb; };
struct StaticOrder {
  int vcu,grid;
  __device__ __forceinline__ explicit StaticOrder(int grid_,int block):vcu((grid_%8==0)?((block%8)*(grid_/8)+block/8):block),grid(grid_){}
  __device__ __forceinline__ bool next(int i,AttnUnit&u)const{ const int item=(i>>1)*grid+vcu; if(item>=BATCH*NHEAD*8)return false; const int s=item&7; u.bh=item>>3; u.qb=(i&1)?15-s:s; return true; }
  __device__ __forceinline__ void a_ready(const AttnUnit&)const{}
  __device__ __forceinline__ void done(const AttnUnit&)const{}
};
template<class Sched,int THRL=8> __device__ __forceinline__ void attn_phase(char*lds,const AttnTensors&T,const Sched&S){
  AttnUnit u;
  for(int i=0;S.next(i,u);++i){ S.a_ready(u); attn_unit<THRL>(u.bh/NHEAD,u.bh%NHEAD,u.qb,T.Q,T.K,T.V,T.O,T.kmean,lds); S.done(u); }
}
#undef SBAR
#undef WAIT_BAR
}

constexpr int NWAVES = 8;
#ifndef MK_N_LAUNCHES
#define MK_N_LAUNCHES 1
#endif
constexpr int N_LAUNCHES = MK_N_LAUNCHES;
constexpr int PER_PHASE = 8;

constexpr int BATCH = 8, SEQ = 4096, DM = 1024, TOK = BATCH * SEQ;
constexpr int CONV_CH = 512, CONV_W = 31, ATT_W = 512, IN_COLS = 4608;
constexpr int P_HEADS = 8, P_NK = 128, P_TOPK = 16, P_E = P_HEADS * P_TOPK  , N_EXP = P_NK * P_NK;
constexpr float NORM_EPS = 1e-6f;

constexpr size_t MiB = 1u << 20;
constexpr size_t WS_CTL = 0, CTL_ZERO_BYTES = 65536;
constexpr size_t WS_KMEAN = 1 * MiB;
constexpr size_t WS_SS = 2 * MiB;
constexpr size_t WS_WIN = 4 * MiB;
constexpr size_t WS_WPW = 13 * MiB, WS_WAO = 14 * MiB;
constexpr size_t WS_WOUT = 15 * MiB;
constexpr size_t WS_WQ = 17 * MiB;
constexpr size_t WS_KEYS = 21 * MiB;
constexpr size_t WS_USC = 22 * MiB, WS_VSC = 22 * MiB + 65536;
constexpr size_t WS_UB = 24 * MiB, WS_VB = 56 * MiB;
constexpr size_t WS_H = 88 * MiB;
constexpr size_t WS_CACT = 88 * MiB;
constexpr size_t WS_EIDX = 104 * MiB, WS_GW = 120 * MiB, WS_GA = 136 * MiB;
constexpr size_t WS_ZGLU = 152 * MiB, WS_QO = 184 * MiB, WS_K = 216 * MiB, WS_V = 248 * MiB;
constexpr size_t WS_MIX = 216 * MiB;
constexpr size_t WS_QP = 152 * MiB;
constexpr size_t WS_COEF = 152 * MiB, WS_SS2 = 168 * MiB;
constexpr size_t WS_GC = 280 * MiB, WS_GATE_A = 344 * MiB;
constexpr size_t WS_X1B = 280 * MiB;
constexpr size_t WS_X8 = 344 * MiB, WS_XS = 377 * MiB;
constexpr size_t WS_END = 408 * MiB;
constexpr int CW_TMO = 0, CW_CODE = 1, CW_CONVQ = 64, CW_BAR = 4096;

constexpr int RING_OFF = 0, RING_BYTES = 131072;
constexpr int LDSCTL_OFF = RING_BYTES, MISC_OFF = LDSCTL_OFF + 320;
constexpr int LDS_BYTES = 155648;
constexpr int VT_PITCH = 144, VT_BYTES = 128 * VT_PITCH, VT_LAST_OFF = LDSCTL_OFF + 1024, P7_CNT_OFF = LDSCTL_OFF + 512;
static_assert(7 * VT_BYTES <= RING_BYTES && VT_LAST_OFF + VT_BYTES <= LDS_BYTES && MISC_OFF + 128 <= P7_CNT_OFF, "PEER v tiles");
constexpr float C8_SCALE = 4096.f;
static_assert(MISC_OFF + 128 <= LDS_BYTES, "LDS map");

#define GAS __attribute__((address_space(1)))
#define LAS __attribute__((address_space(3)))
typedef unsigned short bf16;
typedef unsigned v4u __attribute__((ext_vector_type(4)));
typedef float f32x4 __attribute__((ext_vector_type(4)));
typedef float f32x16 __attribute__((ext_vector_type(16)));
typedef short bf16x8 __attribute__((ext_vector_type(8)));
typedef __bf16 bf16x2_t __attribute__((ext_vector_type(2)));
typedef GAS unsigned gu32;
#define RLX_AGENT __ATOMIC_RELAXED, __HIP_MEMORY_SCOPE_AGENT
#define LDS_WAIT() asm volatile("s_waitcnt lgkmcnt(0)" ::: "memory")
#define VM_WAIT() asm volatile("s_waitcnt vmcnt(0)" ::: "memory")
__device__ __forceinline__ unsigned f2bf(float f) { unsigned u = __builtin_bit_cast(unsigned, f); return (u + 0x7fffu + ((u >> 16) & 1u)) >> 16; }
__device__ __forceinline__ unsigned pk2(float lo, float hi) { return f2bf(lo) | (f2bf(hi) << 16); }
__device__ __forceinline__ float bflo(unsigned u) { return __uint_as_float(u << 16); }
__device__ __forceinline__ float bfhi(unsigned u) { return __uint_as_float(u & 0xffff0000u); }

#define XB_TMO      128
#define XB_XCNT(j)  (256  + 64 * (j))
#define XB_XSUB(j)  (1280 + 64 * (j))
#define XB_XGEN(j)  (2304 + 64 * (j))
#define XB_TOP      3328
#define XB_TOPGEN   3392
#define XCD_BAR_WORDS 3456
#define XB_SPIN_CAP (1u << 18)

__device__ __forceinline__ unsigned xb_ld(unsigned* p)              { return __hip_atomic_load(p, __ATOMIC_RELAXED, __HIP_MEMORY_SCOPE_AGENT); }
__device__ __forceinline__ unsigned xb_add(unsigned* p, unsigned v) { return __hip_atomic_fetch_add(p, v, __ATOMIC_RELAXED, __HIP_MEMORY_SCOPE_AGENT); }
__device__ __forceinline__ unsigned xb_xcc_id() { return (unsigned)__builtin_amdgcn_s_getreg((3 << 11) | 20) & 0xFu; }
#define XB_SPIN(cond, bar) do { unsigned _sp = 0; while (cond) { __builtin_amdgcn_s_sleep(1); \
    if ((++_sp & 255u) == 0u) { if (xb_ld(&(bar)[XB_TMO])) break; if (_sp > XB_SPIN_CAP) { atomicAdd(&(bar)[XB_TMO], 1u); break; } } } } while (0)

struct XcdBarrier {
    unsigned* bar; unsigned x;
    volatile LAS unsigned* st;
};

__device__ __forceinline__ XcdBarrier xcd_barrier_post(unsigned* bar, volatile LAS unsigned* st) {
    XcdBarrier b; b.bar = bar; b.x = xb_xcc_id(); b.st = st;
    if (threadIdx.x == 0) (void)xb_add(&bar[XB_XCNT(b.x)], 1u);
    return b;
}
__device__ __forceinline__ void xcd_barrier_complete(unsigned* bar, unsigned x, unsigned& nloc, unsigned& nx) {
    const unsigned G = gridDim.x * gridDim.y * gridDim.z;
    unsigned sum, cnt, mine, sp = 0u;
    for (;;) {
        sum = 0u; cnt = 0u; mine = 0u;
#pragma unroll
        for (unsigned j = 0; j < 16; ++j) { const unsigned c = xb_ld(&bar[XB_XCNT(j)]); sum += c; cnt += (c > 0u) ? 1u : 0u; mine = (j == x) ? c : mine; }
        if (sum == G) break;
        __builtin_amdgcn_s_sleep(1);
        if ((++sp & 255u) == 0u) { if (xb_ld(&bar[XB_TMO])) break; if (sp > XB_SPIN_CAP) { atomicAdd(&bar[XB_TMO], 1u); break; } }
    }
    nloc = mine > 0u ? mine : 1u; nx = cnt > 0u ? cnt : 1u;
}

__device__ __forceinline__ void xcd_barrier(const XcdBarrier& b) {
    asm volatile("s_waitcnt vmcnt(0)" ::: "memory");
    __syncthreads();
    if (threadIdx.x == 0) {
        unsigned* bar = b.bar;
        __builtin_amdgcn_s_waitcnt(0);
        unsigned nloc = b.st[0], nx = b.st[1];
        if (nloc == 0u) { xcd_barrier_complete(bar, b.x, nloc, nx); b.st[0] = nloc; b.st[1] = nx; }
        const unsigned old = xb_add(&bar[XB_XSUB(b.x)], 1u);
        const unsigned gen = old / nloc;
        if (old + 1u == (gen + 1u) * nloc) {
            __builtin_amdgcn_fence(__ATOMIC_RELEASE, "agent");
            asm volatile("s_waitcnt vmcnt(0)" ::: "memory");
            const unsigned og = xb_add(&bar[XB_TOP], 1u);
            const unsigned tg = og / nx;
            if (og + 1u == (tg + 1u) * nx) xb_add(&bar[XB_TOPGEN], 1u);
            else XB_SPIN(xb_ld(&bar[XB_TOPGEN]) == tg, bar);
            __builtin_amdgcn_fence(__ATOMIC_ACQUIRE, "agent");
            xb_add(&bar[XB_XGEN(b.x)], 1u);
            asm volatile("s_waitcnt vmcnt(0)" ::: "memory");
        } else {
            XB_SPIN(xb_ld(&bar[XB_XGEN(b.x)]) == gen, bar);
            __builtin_amdgcn_fence(__ATOMIC_ACQUIRE, "agent");
            asm volatile("s_waitcnt vmcnt(0)" ::: "memory");
        }
    }
    __syncthreads();
}

struct Frame {
    LAS unsigned char* lds;
    volatile LAS unsigned* MISC;
    gu32* ctl;
    int tid, lane, wave;
    int vcu, G;
};
__device__ __forceinline__ float wave_sum(float v) {
#pragma unroll
    for (int o = 1; o < 64; o <<= 1) v += __shfl_xor(v, o);
    return v;
}

__device__ __forceinline__ float wave_sum_hi(float v) {
    v += __builtin_bit_cast(float, __builtin_amdgcn_update_dpp(0, __builtin_bit_cast(int, v), 0xB1, 0xf, 0xf, false));
    v += __builtin_bit_cast(float, __builtin_amdgcn_update_dpp(0, __builtin_bit_cast(int, v), 0x4E, 0xf, 0xf, false));
    v += __builtin_bit_cast(float, __builtin_amdgcn_update_dpp(0, __builtin_bit_cast(int, v), 0x141, 0xf, 0xf, false));
    v += __builtin_bit_cast(float, __builtin_amdgcn_update_dpp(0, __builtin_bit_cast(int, v), 0x140, 0xf, 0xf, false));
    v += __builtin_bit_cast(float, __builtin_amdgcn_update_dpp(0, __builtin_bit_cast(int, v), 0x142, 0xA, 0xF, false));
    v += __builtin_bit_cast(float, __builtin_amdgcn_update_dpp(0, __builtin_bit_cast(int, v), 0x143, 0xC, 0xF, false));
    return v;
}

__device__ __forceinline__ void p0_transpose_item(const float* W, int K, int N, bf16* WT, int k0, int n0, int dst_row0, const float* kscale, LAS float* scr, int lane, int dpitch = 0, int koff = 0) {
    if (dpitch == 0) dpitch = K;
#pragma unroll 8
    for (int i = 0; i < 32; ++i) { const int kk = 2 * i + (lane >> 5); float v = W[(size_t)(k0 + kk) * N + n0 + (lane & 31)]; if (kscale) v *= kscale[k0 + kk]; scr[kk * 33 + (lane & 31)] = v; }
    LDS_WAIT(); asm volatile("" ::: "memory");
    const int c = lane & 7;
#pragma unroll
    for (int j = 0; j < 4; ++j) { const int n = (lane >> 3) + 8 * j; const LAS float* s = scr + (8 * c) * 33 + n;
        v4u o; o.x = pk2(s[0 * 33], s[1 * 33]); o.y = pk2(s[2 * 33], s[3 * 33]); o.z = pk2(s[4 * 33], s[5 * 33]); o.w = pk2(s[6 * 33], s[7 * 33]);
        *(GAS v4u*)(WT + (size_t)(dst_row0 + n) * dpitch + koff + k0 + 8 * c) = o; }
    LDS_WAIT(); asm volatile("" ::: "memory");
}
__device__ __forceinline__ int perm_in(int s) { if (s < 512) return 256 * (s >> 7) + (s & 127); if (s < 1024) { const int s2 = s - 512; return 256 * (s2 >> 7) + 128 + (s2 & 127); } return s; }
__device__ __forceinline__ float wave_max(float v) {
#pragma unroll
    for (int o = 1; o < 64; o <<= 1) v = fmaxf(v, __shfl_xor(v, o));
    return v;
}
template <bool NORM, int NR> __device__ __forceinline__ void rows_to_bf16(int lane, const float* xrow, size_t rstride, const float* g, bf16* orow) {
    f32x4 v[NR][4]; float s2[NR];
#pragma unroll
    for (int q = 0; q < NR; ++q) { const GAS f32x4* xr = (const GAS f32x4*)(xrow + q * rstride) + lane;
#pragma unroll
        for (int j = 0; j < 4; ++j) v[q][j] = xr[64 * j]; }
#pragma unroll
    for (int q = 0; q < NR; ++q) { s2[q] = 0.f;
#pragma unroll
        for (int j = 0; j < 4; ++j) s2[q] += (v[q][j].x * v[q][j].x + v[q][j].y * v[q][j].y) + (v[q][j].z * v[q][j].z + v[q][j].w * v[q][j].w); }
    float rstd[NR];
#pragma unroll
    for (int q = 0; q < NR; ++q) rstd[q] = NORM ? 1.f / sqrtf(wave_sum(s2[q]) * (1.f / 1024.f) + NORM_EPS) : 1.f;
#pragma unroll
    for (int j = 0; j < 4; ++j) { f32x4 gv = (f32x4){1.f, 1.f, 1.f, 1.f}; if (g) gv = *((const GAS f32x4*)g + lane + 64 * j);
#pragma unroll
        for (int q = 0; q < NR; ++q) { const f32x4 w = v[q][j] * rstd[q] * gv;
            ((GAS unsigned long long*)(orow + q * rstride) + lane)[64 * j] = (unsigned long long)pk2(w.x, w.y) | ((unsigned long long)pk2(w.z, w.w) << 32); } }
}
template <bool NORM> __device__ __forceinline__ void row_to_bf16(int lane, const float* xrow, const float* g, bf16* orow) { rows_to_bf16<NORM, 1>(lane, xrow, 1024, g, orow); }
template <bool SLICED> __device__ __forceinline__ void row_to_fp8(int lane, const float* xrow, const float* g, unsigned char* base, int row, float* isc) {
    const GAS f32x4* xr = (const GAS f32x4*)xrow + lane;
    f32x4 v[4]; float am = 0.f;
#pragma unroll
    for (int j = 0; j < 4; ++j) { v[j] = xr[64 * j]; if (g) v[j] = v[j] * *((const GAS f32x4*)g + lane + 64 * j);
        am = fmaxf(am, fmaxf(fmaxf(fabsf(v[j].x), fabsf(v[j].y)), fmaxf(fabsf(v[j].z), fabsf(v[j].w)))); }
#pragma unroll
    for (int o = 1; o < 64; o <<= 1) am = fmaxf(am, __shfl_xor(am, o));
    const float sc = am > 0.f ? 240.f / am : 1.f;
    if (lane == 0) isc[row] = am > 0.f ? am * (1.f / 240.f) : 1.f;
#pragma unroll
    for (int j = 0; j < 4; ++j) { int w = 0; w = __builtin_amdgcn_cvt_pk_fp8_f32(v[j].x * sc, v[j].y * sc, w, false); w = __builtin_amdgcn_cvt_pk_fp8_f32(v[j].z * sc, v[j].w * sc, w, true);
        if (SLICED) *(GAS int*)(base + (size_t)(2 * j + (lane >> 5)) * ((size_t)N_EXP * 128) + (size_t)row * 128 + 4 * (lane & 31)) = w;
        else *(GAS int*)(base + (size_t)row * 1024 + 4 * (lane + 64 * j)) = w; }
}
__device__ __forceinline__ void rows_to_fp8_uv(int lane, const float* urow, const float* vrow, const float* g, unsigned char* ub8, unsigned char* vb8, int row, float* usc, float* vsc) {
    f32x4 u[4], v[4]; float au = 0.f, av = 0.f;
#pragma unroll
    for (int j = 0; j < 4; ++j) { u[j] = ((const GAS f32x4*)urow + lane)[64 * j]; v[j] = ((const GAS f32x4*)vrow + lane)[64 * j]; }
#pragma unroll
    for (int j = 0; j < 4; ++j) { u[j] = u[j] * *((const GAS f32x4*)g + lane + 64 * j);
        au = fmaxf(au, fmaxf(fmaxf(fabsf(u[j].x), fabsf(u[j].y)), fmaxf(fabsf(u[j].z), fabsf(u[j].w))));
        av = fmaxf(av, fmaxf(fmaxf(fabsf(v[j].x), fabsf(v[j].y)), fmaxf(fabsf(v[j].z), fabsf(v[j].w)))); }
#pragma unroll
    for (int o = 1; o < 64; o <<= 1) { au = fmaxf(au, __shfl_xor(au, o)); av = fmaxf(av, __shfl_xor(av, o)); }
    const float su = au > 0.f ? 240.f / au : 1.f, sv = av > 0.f ? 6.f / av : 1.f;
    if (lane == 0) { usc[row] = au > 0.f ? au * (1.f / 240.f) : 1.f; vsc[row] = av > 0.f ? av * (1.f / 6.f) : 1.f; }
#pragma unroll
    for (int j = 0; j < 4; ++j) { int w = 0; w = __builtin_amdgcn_cvt_pk_fp8_f32(u[j].x * su, u[j].y * su, w, false); w = __builtin_amdgcn_cvt_pk_fp8_f32(u[j].z * su, u[j].w * su, w, true);
        *(GAS int*)(ub8 + (size_t)row * 1024 + 4 * (lane + 64 * j)) = w;
        { const float fv[4] = {v[j].x * sv, v[j].y * sv, v[j].z * sv, v[j].w * sv}; unsigned pk = 0;
#pragma unroll
          for (int i = 0; i < 4; ++i) { const float af = fabsf(fv[i]);
              const unsigned code = (af < 0.25f ? 0u : af < 0.75f ? 1u : af < 1.25f ? 2u : af < 1.75f ? 3u : af < 2.5f ? 4u : af < 3.5f ? 5u : af < 5.f ? 6u : 7u) | (fv[i] < 0.f ? 8u : 0u);
              pk |= code << (4 * i); }
          const int c = 4 * lane + 256 * j;
          *(GAS unsigned short*)(vb8 + (size_t)(c >> 8) * ((size_t)N_EXP * 128) + (size_t)row * 128 + ((c & 255) >> 1)) = (unsigned short)pk; } }
}
struct P0Args { const float *x, *g1, *w_in, *w_pw, *w_ao, *w_out, *g2, *w_q, *k1, *k2, *pu, *pv; bf16 *H, *Win, *Wpw, *Wao, *Wout, *Wq, *keys; unsigned char *ub8, *vb8; float *usc, *vsc; };
__device__ __forceinline__ void p0_prologue(Frame& F, const P0Args& a) {
    LAS float* scr = (LAS float*)(F.lds + RING_OFF + F.wave * 16384);
    const int gw = F.vcu * NWAVES + F.wave, NGW = F.G * NWAVES;
    constexpr int I_IN = 16 * (IN_COLS / 32), I_PW = 8 * 32, I_AO = 8 * 32, I_OUT = 16 * 32, I_Q = 16 * 64;
    constexpr int NITEMS = I_IN + I_PW + I_AO + I_OUT + I_Q;
    for (int it = gw; it < NITEMS; it += NGW) {
        int r = it;
        if (r < I_IN) { const int nb = IN_COLS / 32, kb = r / nb, n0 = 32 * (r % nb); p0_transpose_item(a.w_in, 1024, IN_COLS, a.Win, 64 * kb, n0, perm_in(n0), nullptr, scr, F.lane); continue; } r -= I_IN;
        if (r < I_PW) { const int kb = r / 32, n0 = 32 * (r % 32); p0_transpose_item(a.w_pw, 512, 1024, a.Wpw, 64 * kb, n0, n0, nullptr, scr, F.lane, 1024, 0); continue; } r -= I_PW;
        if (r < I_AO) { const int kb = r / 32, n0 = 32 * (r % 32); p0_transpose_item(a.w_ao, 512, 1024, a.Wpw, 64 * kb, n0, n0, nullptr, scr, F.lane, 1024, 512); continue; }   r -= I_AO;
        if (r < I_OUT) { const int kb = r / 32, n0 = 32 * (r % 32); p0_transpose_item(a.w_out, 1024, 1024, a.Wout, 64 * kb, n0, n0, nullptr, scr, F.lane); continue; } r -= I_OUT;
        { const int kb = r / 64, n0 = 32 * (r % 64); p0_transpose_item(a.w_q, 1024, 2048, a.Wq, 64 * kb, n0, n0, a.g2, scr, F.lane); }
    }
    for (int m = 4 * gw; m < TOK; m += 4 * NGW) rows_to_bf16<true, 4>(F.lane, a.x + (size_t)m * 1024, 1024, a.g1, a.H + (size_t)m * 1024);
    for (int m = gw; m < N_EXP; m += NGW) rows_to_fp8_uv(F.lane, a.pu + (size_t)m * 1024, a.pv + (size_t)m * 1024, a.g2, a.ub8, a.vb8, m, a.usc, a.vsc);
    for (int m = gw; m < 32; m += NGW) { const float* src = (m < 16 ? a.k1 : a.k2) + (size_t)(m & 15) * 1024; row_to_bf16<false>(F.lane, src, nullptr, a.keys + (size_t)m * 1024); }
}

struct ConvArgs { const bf16* zglu; const float *cw, *cb, *lg, *lb; bf16* cact; };
__device__ __forceinline__ void conv_phase(Frame& F, const ConvArgs& a) {
    LAS unsigned char* zs = F.lds + RING_OFF;
    LAS float* part = (LAS float*)(F.lds + RING_OFF + 98304);
    int tid_ = F.tid; asm volatile("" : "+v"(tid_));
    const int cp = tid_ & 255, half = tid_ >> 8, c0 = 2 * cp;
    float w0[CONV_W], w1[CONV_W];
    { const GAS float* p = (const GAS float*)(a.cw + c0);
#pragma unroll
      for (int w = 0; w < CONV_W; ++w) { w0[w] = p[0]; w1[w] = p[1]; p += 512; asm volatile("" : "+v"(p)); } }
    const float b0 = a.cb[c0], b1 = a.cb[c0 + 1], lg0 = a.lg[c0], lg1 = a.lg[c0 + 1], lb0 = a.lb[c0], lb1 = a.lb[c0 + 1];
    for (int tile = F.vcu; tile < TOK / 64; tile += F.G) {
        const int t0 = tile * 64, tb = t0 & (SEQ - 1);
#pragma unroll
        for (int hb = 0; hb < 2; ++hb) { v4u zv[6];
#pragma unroll
          for (int q = 0; q < 6; ++q) { const int i = tid_ + 512 * (6 * hb + q), r = i >> 6, ch = i & 63; zv[q] = (v4u){0u, 0u, 0u, 0u};
              if (i < 94 * 64 && tb - 30 + r >= 0) zv[q] = *(const GAS v4u*)(a.zglu + (size_t)(t0 - 30 + r) * 512 + ch * 8); }
#pragma unroll
          for (int q = 0; q < 6; ++q) { const int i = tid_ + 512 * (6 * hb + q), r = i >> 6, ch = i & 63; if (i < 94 * 64) *(LAS v4u*)(zs + r * 1024 + ch * 16) = zv[q]; } }
        __syncthreads();
        for (int ch8 = 0; ch8 < 4; ++ch8) {
            const int tl = half * 32 + ch8 * 8;
            float z0[38], z1[38];
#pragma unroll
            for (int i = 0; i < 38; ++i) { const unsigned u = *(const LAS unsigned*)(zs + (tl + i) * 1024 + cp * 4); z0[i] = bflo(u); z1[i] = bfhi(u); }
            float a0[8], a1[8];
#pragma unroll
            for (int k = 0; k < 8; ++k) { float s0 = b0, s1 = b1;
#pragma unroll
                for (int w = 0; w < CONV_W; ++w) { s0 += w0[w] * z0[k + w]; s1 += w1[w] * z1[k + w]; }
                a0[k] = s0; a1[k] = s1; }
#pragma unroll
            for (int k = 0; k < 8; ++k) { const float s1 = wave_sum_hi(a0[k] + a1[k]), s2 = wave_sum_hi(a0[k] * a0[k] + a1[k] * a1[k]);
                if (F.lane == 63) { part[((half * 8 + k) * 4 + (F.wave & 3)) * 2] = s1; part[((half * 8 + k) * 4 + (F.wave & 3)) * 2 + 1] = s2; } }
            __syncthreads();
            bf16* op = a.cact + (size_t)(t0 + tl) * 1024 + c0;
#pragma unroll
            for (int k = 0; k < 8; ++k) { const LAS float* p = part + (half * 8 + k) * 8;
                const float S1 = (p[0] + p[2]) + (p[4] + p[6]), S2 = (p[1] + p[3]) + (p[5] + p[7]);
                const float mean = S1 * (1.f / 512.f), var = S2 * (1.f / 512.f) - mean * mean, rstd = __builtin_amdgcn_rsqf(var + NORM_EPS);
                const float y0 = (a0[k] - mean) * rstd * lg0 + lb0, y1 = (a1[k] - mean) * rstd * lg1 + lb1;
                const float o0 = y0 * __builtin_amdgcn_rcpf(1.f + __builtin_amdgcn_exp2f(-1.4426950408889634f * y0)), o1 = y1 * __builtin_amdgcn_rcpf(1.f + __builtin_amdgcn_exp2f(-1.4426950408889634f * y1));
                *(GAS unsigned*)(op + k * 1024) = pk2(o0, o1); }
            __syncthreads();
        }
    }
}

__device__ __forceinline__ int tokey(float v) { const int b = __float_as_int(v); return b ^ ((b >> 31) & 0x7fffffff); }
__device__ __forceinline__ float unkey(int k, int mask) { const int t = k & ~mask; return __int_as_float(t ^ ((t >> 31) & 0x7fffffff)); }
__device__ __forceinline__ void ce_desc(int& a, int& b) { const int hi = a > b ? a : b, lo = a > b ? b : a; a = hi; b = lo; }
template <int N> __device__ __forceinline__ void sort_desc(int (&v)[N]) {
#pragma unroll
    for (int k = 2; k <= N; k <<= 1)
#pragma unroll
        for (int j = k >> 1; j > 0; j >>= 1)
#pragma unroll
            for (int i = 0; i < N; ++i) { const int l = i ^ j; if (l > i) { if ((i & k) == 0) ce_desc(v[i], v[l]); else ce_desc(v[l], v[i]); } }
}
__device__ __forceinline__ void bitonic_merge16_desc(int (&v)[16]) {
#pragma unroll
    for (int j = 8; j > 0; j >>= 1)
#pragma unroll
        for (int i = 0; i < 16; ++i) { const int l = i ^ j; if (l > i) ce_desc(v[i], v[l]); }
}
__device__ __forceinline__ void merge_top16(int (&a)[16], const int (&b)[16]) {
#pragma unroll
    for (int i = 0; i < 16; ++i) a[i] = a[i] > b[15 - i] ? a[i] : b[15 - i];
    bitonic_merge16_desc(a);
}
__device__ __forceinline__ void top16_of_64(const int (&x)[64], int (&out)[16]) {
    int g[16];
#pragma unroll
    for (int i = 0; i < 16; ++i) out[i] = x[i];
    sort_desc<16>(out);
#pragma unroll
    for (int q = 1; q < 4; ++q) {
#pragma unroll
        for (int i = 0; i < 16; ++i) g[i] = x[16 * q + i];
        sort_desc<16>(g); merge_top16(out, g); }
}
__device__ __forceinline__ int crow_(int r, int hi) { return (r & 3) + 8 * (r >> 2) + 4 * hi; }
struct SelArgs { const bf16* qp; const bf16* keys; const float* ss; const float* usc; const float* vsc; int* eidx; float* ga; float* gb; const bf16* x1b; unsigned char* x8; float* xs; };
__device__ __forceinline__ void peer_select_phase(Frame& F, const SelArgs& a) {
    for (int i = F.tid; i < 2 * 128 * 16; i += 512) { const int which = i >> 11, rem = i & 2047, row = rem >> 4, ch = rem & 15;
        const v4u v = *(const GAS v4u*)(a.keys + (size_t)which * 16384 + row * 128 + ch * 8);
        *(LAS v4u*)(F.lds + RING_OFF + which * 32768 + row * 256 + ((ch ^ (row & 15)) << 4)) = v; }
    __syncthreads();
    LAS int* scr = (LAS int*)(F.lds + RING_OFF + 65536 + F.wave * 4096);
    const int lane = F.lane, tl = lane & 31, hi = lane >> 5;
    const int gw = F.vcu * NWAVES + F.wave, NGW = F.G * NWAVES;
    constexpr int NUNITS = (TOK / 32) * P_HEADS;
    constexpr int PA[50] = {0,0,0,0,0,0,0,0,0,0,0,0,0,0,0,0, 1,1,1,1,1,1,1,1, 2,2,2,2,2, 3,3,3,3, 4,4,4, 5,5, 6,6, 7,7, 8,9,10,11,12,13,14,15};
    constexpr int PB[50] = {0,1,2,3,4,5,6,7,8,9,10,11,12,13,14,15, 0,1,2,3,4,5,6,7, 0,1,2,3,4, 0,1,2,3, 0,1,2, 0,1, 0,1, 0,1, 0,0,0,0,0,0,0,0};
    for (int unit = gw; unit < NUNITS; unit += NGW) {
        const int tt = unit >> 3, hh = unit & 7, t = tt * 32 + tl;
        int vk[2][16];
#pragma unroll
        for (int half = 0; half < 2; ++half) {
            const bf16* qrow = a.qp + (size_t)t * 2048 + hh * 256 + half * 128 + hi * 8;
            bf16x8 bq[8];
#pragma unroll
            for (int ks = 0; ks < 8; ++ks) bq[ks] = *(const GAS bf16x8*)(qrow + ks * 16);
            f32x16 acc[4];
#pragma unroll
            for (int nb = 0; nb < 4; ++nb) { acc[nb] = (f32x16){};
#pragma unroll
                for (int ks = 0; ks < 8; ++ks) { const int row = nb * 32 + tl, ch = 2 * ks + hi;
                    const bf16x8 ka = *(const LAS bf16x8*)(F.lds + RING_OFF + half * 32768 + row * 256 + ((ch ^ (row & 15)) << 4));
                    acc[nb] = __builtin_amdgcn_mfma_f32_32x32x16_bf16(ka, bq[ks], acc[nb], 0, 0, 0); } }
            int keys[64];
#pragma unroll
            for (int nb = 0; nb < 4; ++nb)
#pragma unroll
                for (int r = 0; r < 16; ++r) keys[nb * 16 + r] = (tokey(acc[nb][r]) & ~127) | (nb * 32 + crow_(r, hi));
            int top[16]; top16_of_64(keys, top);
            int oth[16];
#pragma unroll
            for (int i = 0; i < 16; ++i) oth[i] = __shfl_xor(top[i], 32);
            merge_top16(top, oth);
#pragma unroll
            for (int i = 0; i < 16; ++i) vk[half][i] = top[i];
        }
        float f1[16], f2[16];
#pragma unroll
        for (int i = 0; i < 16; ++i) { f1[i] = unkey(vk[0][i], 127); f2[i] = unkey(vk[1][i], 127); }
        int ck[64];
#pragma unroll
        for (int i = 0; i < 50; ++i) ck[i] = (tokey(f1[PA[i]] + f2[PB[i]]) & ~255) | (PA[i] * 16 + PB[i]);
#pragma unroll
        for (int i = 50; i < 64; ++i) ck[i] = (int)0x80000000;
        int c[16]; top16_of_64(ck, c);
        if (hi == 0) {
#pragma unroll
            for (int i = 0; i < 16; ++i) { scr[tl * 32 + i] = vk[0][i] & 127; scr[tl * 32 + 16 + i] = vk[1][i] & 127; } }
        float ssum = 0.f;
        { const GAS f32x4* sp = (const GAS f32x4*)(a.ss + (size_t)t * 16);
#pragma unroll
          for (int i = 0; i < 4; ++i) { const f32x4 v = sp[i]; ssum += (v.x + v.y) + (v.z + v.w); } }
        const float rstd = 1.f / sqrtf(ssum * (1.f / 1024.f) + NORM_EPS);
        const float smax = unkey(c[0], 255);
        float e[16], esum = 0.f;
#pragma unroll
        for (int i = 0; i < 16; ++i) { e[i] = __expf((unkey(c[i], 255) - smax) * rstd); esum += e[i]; }
        const float inv = 1.f / esum;
        LDS_WAIT(); asm volatile("" ::: "memory");
        int eo[8]; float go[8];
#pragma unroll
        for (int i = 0; i < 8; ++i) { const int ci = hi ? c[i + 8] : c[i]; const float ei = hi ? e[i + 8] : e[i];
            const int id = ci & 255, i1 = scr[tl * 32 + (id >> 4)], i2 = scr[tl * 32 + 16 + (id & 15)];
            eo[i] = i1 * P_NK + i2; go[i] = ei * inv; }
        float ua[8];
#pragma unroll
        for (int i = 0; i < 8; ++i) { ua[i] = a.usc[eo[i]]; go[i] *= a.vsc[eo[i]]; }
        int* ep = a.eidx + (size_t)t * P_E + hh * 16 + hi * 8; float* gp = a.gb + (size_t)t * P_E + hh * 16 + hi * 8; float* up_ = a.ga + (size_t)t * P_E + hh * 16 + hi * 8;
        *(GAS f32x4*)(up_) = (f32x4){ua[0], ua[1], ua[2], ua[3]}; *(GAS f32x4*)(up_ + 4) = (f32x4){ua[4], ua[5], ua[6], ua[7]};
        *(GAS v4u*)(ep) = (v4u){(unsigned)eo[0], (unsigned)eo[1], (unsigned)eo[2], (unsigned)eo[3]}; *(GAS v4u*)(ep + 4) = (v4u){(unsigned)eo[4], (unsigned)eo[5], (unsigned)eo[6], (unsigned)eo[7]};
        *(GAS f32x4*)(gp) = (f32x4){go[0], go[1], go[2], go[3]}; *(GAS f32x4*)(gp + 4) = (f32x4){go[4], go[5], go[6], go[7]};
        LDS_WAIT(); asm volatile("" ::: "memory");
    }
}

__device__ __forceinline__ void peer_rows_fp8(Frame& F, const SelArgs& a) {
    const int gw = F.vcu * NWAVES + F.wave, NGW = F.G * NWAVES, lane = F.lane;
    for (int t = gw; t < TOK; t += NGW) {
        const GAS v4u* xp = (const GAS v4u*)(a.x1b + (size_t)t * 1024 + 16 * lane); const v4u xa = xp[0], xb = xp[1];
        const float xf[16] = {bflo(xa.x), bfhi(xa.x), bflo(xa.y), bfhi(xa.y), bflo(xa.z), bfhi(xa.z), bflo(xa.w), bfhi(xa.w), bflo(xb.x), bfhi(xb.x), bflo(xb.y), bfhi(xb.y), bflo(xb.z), bfhi(xb.z), bflo(xb.w), bfhi(xb.w)};
        float am = 0.f;
#pragma unroll
        for (int i = 0; i < 16; ++i) am = fmaxf(am, fabsf(xf[i]));
#pragma unroll
        for (int o = 1; o < 64; o <<= 1) am = fmaxf(am, __shfl_xor(am, o));
        const float xsc = am > 0.f ? 240.f / am : 1.f, xinv = am > 0.f ? am * (1.f / 240.f) : 1.f;
        v4u o;
        { int w = 0; w = __builtin_amdgcn_cvt_pk_fp8_f32(xf[0] * xsc, xf[1] * xsc, w, false); w = __builtin_amdgcn_cvt_pk_fp8_f32(xf[2] * xsc, xf[3] * xsc, w, true); o.x = (unsigned)w; }
        { int w = 0; w = __builtin_amdgcn_cvt_pk_fp8_f32(xf[4] * xsc, xf[5] * xsc, w, false); w = __builtin_amdgcn_cvt_pk_fp8_f32(xf[6] * xsc, xf[7] * xsc, w, true); o.y = (unsigned)w; }
        { int w = 0; w = __builtin_amdgcn_cvt_pk_fp8_f32(xf[8] * xsc, xf[9] * xsc, w, false); w = __builtin_amdgcn_cvt_pk_fp8_f32(xf[10] * xsc, xf[11] * xsc, w, true); o.z = (unsigned)w; }
        { int w = 0; w = __builtin_amdgcn_cvt_pk_fp8_f32(xf[12] * xsc, xf[13] * xsc, w, false); w = __builtin_amdgcn_cvt_pk_fp8_f32(xf[14] * xsc, xf[15] * xsc, w, true); o.w = (unsigned)w; }
        *(GAS v4u*)(a.x8 + (size_t)t * 1024 + 16 * lane) = o;
        const float ssum = wave_sum(lane < 16 ? a.ss[(size_t)t * 16 + lane] : 0.f);
        if (lane == 0) a.xs[t] = xinv / sqrtf(ssum * (1.f / 1024.f) + NORM_EPS);
    }
}

typedef float f32x2_t __attribute__((ext_vector_type(2)));
struct ExpA { const unsigned char* x8; const float* xs; const unsigned char* ub8; const int* eidx; const float* ga; const float* gb; unsigned char* coef8; };
__device__ __forceinline__ float row_sum16(float v) {
    v += __builtin_bit_cast(float, __builtin_amdgcn_update_dpp(0, __builtin_bit_cast(int, v), 0xB1, 0xf, 0xf, false));
    v += __builtin_bit_cast(float, __builtin_amdgcn_update_dpp(0, __builtin_bit_cast(int, v), 0x4E, 0xf, 0xf, false));
    v += __builtin_bit_cast(float, __builtin_amdgcn_update_dpp(0, __builtin_bit_cast(int, v), 0x141, 0xf, 0xf, false));
    v += __builtin_bit_cast(float, __builtin_amdgcn_update_dpp(0, __builtin_bit_cast(int, v), 0x140, 0xf, 0xf, false));
    return v;
}
__device__ __forceinline__ float gelu_as(float v) {
    const float av = fabsf(v), t = __builtin_amdgcn_rcpf(av * 0.2316418882f + 1.0f);
    float q = t * 0.5307027145f + (-0.7265760135f); q = q * t + 0.7107068705f; q = q * t + (-0.142248368f); q = q * t + 0.127414796f; q = q * t;
    const float m = v * (q * __builtin_amdgcn_exp2f((v * v) * (-0.72134752044f)));
    return v < 0.f ? m : v - m;
}
__device__ __forceinline__ float wave_sum_diag(float v) {
    v = row_sum16(v);
    v += __builtin_bit_cast(float, __builtin_amdgcn_update_dpp(0, __builtin_bit_cast(int, v), 0x142, 0xA, 0xF, false));
    v += __builtin_bit_cast(float, __builtin_amdgcn_update_dpp(0, __builtin_bit_cast(int, v), 0x143, 0xC, 0xF, false));
    return v;
}
__device__ __forceinline__ int wg_grab(LAS int* c, const int lane) {
    int v = 0; if (lane == 0) v = __hip_atomic_fetch_add(c, 1, __ATOMIC_RELAXED, __HIP_MEMORY_SCOPE_WORKGROUP);
    return __builtin_amdgcn_readfirstlane(v);
}
__device__ __forceinline__ void peer_u_phase(Frame& F, const ExpA& a, const int s, const int tfirst, const int step, LAS int* cnt) {
    const int lane = F.lane;
    LAS int* lstA = (LAS int*)(F.lds + RING_OFF + F.wave * 4096); LAS int* lstB = lstA + 512;
    lstA[lane] = 0; lstA[64 + lane] = 0; lstB[lane] = 0; lstB[64 + lane] = 0;
    const bool diag = ((lane & 15) >> 2) == (lane >> 4); const int dsel = lane & 3;
    const bool b3 = (lane & 8) != 0; const int usel = ((lane >> 5) & 1) * 4 + ((lane >> 4) & 1) * 2 + ((lane >> 3) & 1);
    if (tfirst >= TOK) return;
    struct Raw { v4u x; int e0, e1; float fa0, fa1, fb0, fb1, xs; };
#if defined(ABL_HOTROWS)
#define ABL_ROW(e) (((e) & ~2047) | ((e) & 63))
#else
#define ABL_ROW(e) (e)
#endif
#define PU_RAW(R, T) do { const int tt_ = (T) < TOK ? (T) : tfirst; R.x = *(const GAS v4u*)(a.x8 + (size_t)tt_ * 1024 + 16 * lane); \
        R.e0 = a.eidx[(size_t)tt_ * P_E + lane]; R.e1 = a.eidx[(size_t)tt_ * P_E + 64 + lane]; R.fa0 = a.ga[(size_t)tt_ * P_E + lane]; R.fa1 = a.ga[(size_t)tt_ * P_E + 64 + lane]; \
        R.fb0 = a.gb[(size_t)tt_ * P_E + lane]; R.fb1 = a.gb[(size_t)tt_ * P_E + 64 + lane]; R.xs = a.xs[tt_]; } while (0)
#define PU_PREP(R, LST, XLO, XHI, N, VALID) do { \
        XLO = (long)(((unsigned long long)R.x.y << 32) | R.x.x); XHI = (long)(((unsigned long long)R.x.w << 32) | R.x.z); \
        const bool in0_ = (VALID) && (R.e0 >> 11) == s, in1_ = (VALID) && (R.e1 >> 11) == s; \
        const unsigned long long m0_ = __ballot(in0_), m1_ = __ballot(in1_), lt_ = (1ull << lane) - 1ull; \
        const int n0_ = __popcll(m0_); N = n0_ + __popcll(m1_); \
        LAS float* lsa_ = (LAS float*)(LST + 128); LAS float* lsb_ = (LAS float*)(LST + 256); \
        if (in0_) { const int p = __popcll(m0_ & lt_); LST[p] = lane | (R.e0 << 8); lsa_[p] = R.fa0 * R.xs; lsb_[p] = R.fb0; } \
        if (in1_) { const int p = n0_ + __popcll(m1_ & lt_); LST[p] = (64 + lane) | (R.e1 << 8); lsa_[p] = R.fa1 * R.xs; lsb_[p] = R.fb1; } } while (0)
#define PU_LOAD(W, LST, K0) do { _Pragma("unroll") for (int u = 0; u < 8; ++u) { const int ent_ = LST[((K0) + u) & 127]; W[u] = *(const GAS v4u*)(a.ub8 + (size_t)ABL_ROW(ent_ >> 8) * 1024 + 16 * lane); } } while (0)
#define PU_COMP(W, LST, XLO, XHI, N, T, K0) do { float d[8]; \
            _Pragma("unroll") for (int u = 0; u < 8; ++u) { f32x4 acc = {0.f, 0.f, 0.f, 0.f}; \
                acc = __builtin_amdgcn_mfma_f32_16x16x32_fp8_fp8((long)(((unsigned long long)W[u].y << 32) | W[u].x), XLO, acc, 0, 0, 0); \
                acc = __builtin_amdgcn_mfma_f32_16x16x32_fp8_fp8((long)(((unsigned long long)W[u].w << 32) | W[u].z), XHI, acc, 0, 0, 0); \
                const float v01 = (dsel & 1) ? acc[1] : acc[0], v23 = (dsel & 1) ? acc[3] : acc[2]; \
                d[u] = diag ? ((dsel & 2) ? v23 : v01) : 0.f; } \
            float z_[4], w_[2]; \
            _Pragma("unroll") for (int i = 0; i < 4; ++i) { const auto rr = __builtin_amdgcn_permlane32_swap(__float_as_uint(d[i]), __float_as_uint(d[i + 4]), false, false); z_[i] = __uint_as_float(rr[0]) + __uint_as_float(rr[1]); } \
            _Pragma("unroll") for (int i = 0; i < 2; ++i) { const auto rr = __builtin_amdgcn_permlane16_swap(__float_as_uint(z_[i]), __float_as_uint(z_[i + 2]), false, false); w_[i] = __uint_as_float(rr[0]) + __uint_as_float(rr[1]); } \
            float du = (b3 ? w_[1] : w_[0]) + __builtin_bit_cast(float, __builtin_amdgcn_update_dpp(0, __builtin_bit_cast(int, b3 ? w_[0] : w_[1]), 0x128, 0xf, 0xf, false)); \
            du += __builtin_bit_cast(float, __builtin_amdgcn_update_dpp(0, __builtin_bit_cast(int, du), 0xB1, 0xf, 0xf, false)); \
            du += __builtin_bit_cast(float, __builtin_amdgcn_update_dpp(0, __builtin_bit_cast(int, du), 0x4E, 0xf, 0xf, false)); \
            du += __builtin_bit_cast(float, __builtin_amdgcn_update_dpp(0, __builtin_bit_cast(int, du), 0x141, 0xf, 0xf, false)); \
            const int ku = (K0) + usel; \
            if ((lane & 7) == 0 && ku < N) { const int slot = LST[ku] & 255; const float cf_ = C8_SCALE * ((LAS float*)(LST + 256))[ku] * gelu_as(du * ((LAS float*)(LST + 128))[ku]); \
                a.coef8[(size_t)(T) * P_E + slot] = (unsigned char)__builtin_amdgcn_cvt_pk_fp8_f32(fminf(fmaxf(cf_, -448.f), 448.f), 0.f, 0, false); } } while (0)
    Raw rA, rB;
    const int ntok = (TOK - tfirst + step - 1) / step, npair = (ntok + 1) >> 1;
#define PU_TOK(i) ((i) < ntok ? tfirst + (i) * step : TOK)
    int p = wg_grab(cnt, lane);
    if (p >= npair) return;
    PU_RAW(rA, PU_TOK(2 * p)); PU_RAW(rB, PU_TOK(2 * p + 1));
    while (p < npair) {
        const int pn = wg_grab(cnt, lane);
        const int tA = PU_TOK(2 * p), tB = PU_TOK(2 * p + 1); const bool vB = tB < TOK;
        long xloA, xhiA, xloB, xhiB; int nA, nB;
        PU_PREP(rA, lstA, xloA, xhiA, nA, true);
        PU_PREP(rB, lstB, xloB, xhiB, nB, vB);
        LDS_WAIT(); asm volatile("" ::: "memory");
        v4u wA0[8], wA1[8], wB0[8], wB1[8];
        PU_LOAD(wA0, lstA, 0); PU_LOAD(wB0, lstB, 0); PU_LOAD(wA1, lstA, 8); PU_LOAD(wB1, lstB, 8);
        PU_RAW(rA, PU_TOK(2 * pn)); PU_RAW(rB, PU_TOK(2 * pn + 1));
        PU_COMP(wA0, lstA, xloA, xhiA, nA, tA, 0);
        if (nA > 16) PU_LOAD(wA0, lstA, 16);
        PU_COMP(wB0, lstB, xloB, xhiB, nB, tB, 0);
        if (nB > 16) PU_LOAD(wB0, lstB, 16);
        PU_COMP(wA1, lstA, xloA, xhiA, nA, tA, 8);
        PU_COMP(wB1, lstB, xloB, xhiB, nB, tB, 8);
        if (nA > 16) PU_COMP(wA0, lstA, xloA, xhiA, nA, tA, 16);
        if (nB > 16) PU_COMP(wB0, lstB, xloB, xhiB, nB, tB, 16);
        for (int k0 = 24; k0 < nA; k0 += 8) { PU_LOAD(wA1, lstA, k0); PU_COMP(wA1, lstA, xloA, xhiA, nA, tA, k0); }
        for (int k0 = 24; k0 < nB; k0 += 8) { PU_LOAD(wB1, lstB, k0); PU_COMP(wB1, lstB, xloB, xhiB, nB, tB, k0); }
        LDS_WAIT(); asm volatile("" ::: "memory");
        p = pn;
    }
#undef PU_TOK
#undef PU_RAW
#undef PU_PREP
#undef PU_LOAD
#undef PU_COMP
}
struct ExpB { float* xio; const bf16* x1b; const unsigned char* vb8; const int* eidx; const unsigned char* coef8; float* ss2; };
typedef int v2i_t __attribute__((ext_vector_type(2)));
typedef int v8i_t __attribute__((ext_vector_type(8)));
constexpr int V_SLICES = 4;
__device__ __forceinline__ void peer_v_phase(Frame& F, const ExpB& a, const int s, const int t0, const int step, LAS int* cnt) {
    const int lane = F.lane, g = lane >> 3, j = lane & 7, q = lane >> 4, jn = lane & 15;
    const GAS unsigned char* vs = (const GAS unsigned char*)a.vb8 + (size_t)s * ((size_t)N_EXP * 128); const unsigned j16 = 16u * (unsigned)j;
    if (t0 >= TOK) return;
    LAS unsigned char* tile = F.lds + (F.wave < 7 ? F.wave * VT_BYTES : VT_LAST_OFF);
    LAS unsigned char* wbase = tile + g * (16 * VT_PITCH) + 16 * j;
    LAS unsigned char* rbase = tile + (32 * q + jn) * VT_PITCH;
    const int chA = 256 * s + 64 * q + jn;
#define PV_LDE(E, T) do { const int tt_ = (T) < TOK ? (T) : t0; const GAS v4u* ep_ = (const GAS v4u*)(a.eidx + (size_t)tt_ * P_E + 16 * g); \
        _Pragma("unroll") for (int k4 = 0; k4 < 4; ++k4) { const v4u ev = ep_[k4]; E[4 * k4] = (int)ev.x; E[4 * k4 + 1] = (int)ev.y; E[4 * k4 + 2] = (int)ev.z; E[4 * k4 + 3] = (int)ev.w; } } while (0)
#define PV_ROWS(W, E, C8, X, T) do { const int tt_ = (T) < TOK ? (T) : t0; _Pragma("unroll") for (int k = 0; k < 16; ++k) W[k] = *(const GAS v4u*)(vs + (((unsigned)E[k] << 7) | j16)); \
        { const GAS v4u* cp_ = (const GAS v4u*)(a.coef8 + (size_t)tt_ * P_E + 16 * q); C8[0] = cp_[0]; C8[1] = cp_[4]; }   \
        { const GAS bf16* xp_ = (const GAS bf16*)(a.x1b + (size_t)tt_ * 1024 + chA); _Pragma("unroll") for (int i = 0; i < 4; ++i) X[i] = xp_[16 * i]; } } while (0)
#define PV_COMP(W, C8, X, T) do { \
        _Pragma("unroll") for (int k = 0; k < 16; ++k) *(LAS v4u*)(wbase + k * VT_PITCH) = W[k]; \
        const v8i_t av = {(int)C8[0].x, (int)C8[0].y, (int)C8[0].z, (int)C8[0].w, (int)C8[1].x, (int)C8[1].y, (int)C8[1].z, (int)C8[1].w}; \
        float y[4] = {0.f, 0.f, 0.f, 0.f}; \
        _Pragma("unroll") for (int ct = 0; ct < 16; ++ct) { \
            const v2i_t b0 = __builtin_amdgcn_ds_read_tr4_b64_v2i32((LAS v2i_t*)(rbase + 8 * ct)), b1 = __builtin_amdgcn_ds_read_tr4_b64_v2i32((LAS v2i_t*)(rbase + 16 * VT_PITCH + 8 * ct)); \
            const v8i_t bv = {b0.x, b0.y, b1.x, b1.y, 0, 0, 0, 0}; \
            const f32x4 d_ = __builtin_amdgcn_mfma_scale_f32_16x16x128_f8f6f4(av, bv, (f32x4){0.f, 0.f, 0.f, 0.f}, 0, 4, 0, 0, 0, 0); \
            y[ct & 3] = (q == (ct >> 2)) ? d_[0] : y[ct & 3]; } \
        float sq = 0.f; \
        _Pragma("unroll") for (int i = 0; i < 4; ++i) { const float o_ = bflo((unsigned)X[i]) + y[i] * (1.f / C8_SCALE); a.xio[(size_t)(T) * 1024 + chA + 16 * i] = o_; sq += o_ * o_; } \
        sq = row_sum16(sq); \
        sq += __shfl_xor(sq, 16); sq += __shfl_xor(sq, 32); \
        if (lane == 0) a.ss2[(size_t)(T) * V_SLICES + s] = sq; } while (0)
    int e1[16], e2[16]; v4u wA[16], wB[16], c8A[2], c8B[2]; bf16 xA[4], xB[4];
    const int ntok = (TOK - t0 + step - 1) / step;
#define PV_TOK(i) ((i) < ntok ? t0 + (i) * step : TOK)
    int iA = wg_grab(cnt, lane), iB = wg_grab(cnt, lane);
    if (iA >= ntok) return;
    PV_LDE(e1, PV_TOK(iA));
    PV_LDE(e2, PV_TOK(iB));
    PV_ROWS(wA, e1, c8A, xA, PV_TOK(iA));
    for (;;) {
        const int iC = wg_grab(cnt, lane);
        PV_LDE(e1, PV_TOK(iC));
        PV_ROWS(wB, e2, c8B, xB, PV_TOK(iB));
        PV_COMP(wA, c8A, xA, PV_TOK(iA));
        if (iB >= ntok) break;
        const int iD = wg_grab(cnt, lane);
        PV_LDE(e2, PV_TOK(iD));
        PV_ROWS(wA, e1, c8A, xA, PV_TOK(iC));
        PV_COMP(wB, c8B, xB, PV_TOK(iB));
        if (iC >= ntok) break;
        iA = iC; iB = iD;
    }
#undef PV_TOK
#undef PV_LDE
#undef PV_ROWS
#undef PV_COMP
}
__device__ __forceinline__ void final_norm_phase(Frame& F, float* xio, const float* ss2, const float* gfinal, const int gw, const int NGW) {
    const int lane = F.lane;
    for (int t = gw; t < TOK; t += NGW) {
        const f32x4 s0 = *(const GAS f32x4*)(ss2 + (size_t)t * V_SLICES); static_assert(V_SLICES == 4, "ss2 row");
        const float rstd = 1.f / sqrtf(((s0.x + s0.y) + (s0.z + s0.w)) * (1.f / 1024.f) + NORM_EPS);
        GAS f32x4* xr = (GAS f32x4*)(xio + (size_t)t * 1024) + lane; const GAS f32x4* gf = (const GAS f32x4*)gfinal + lane;
#pragma unroll
        for (int q = 0; q < 4; ++q) xr[64 * q] = xr[64 * q] * rstd * gf[64 * q];
    }
}

struct Args { const float* in[18]; float* out; unsigned char* ws; int ph_lo, ph_hi, li, pad; };
__global__ void __launch_bounds__(NWAVES * 64, 2) fwd_kernel(Args args) {
    extern __shared__ __attribute__((aligned(16))) unsigned char lds[];
    Frame F;
    F.lds = (LAS unsigned char*)lds;
    F.MISC = (volatile LAS unsigned*)(F.lds + MISC_OFF);
    F.tid = threadIdx.x; F.lane = F.tid & 63; F.wave = __builtin_amdgcn_readfirstlane(F.tid >> 6);
    F.G = gridDim.x; { const int bx = blockIdx.x; F.vcu = (F.G % 8 == 0) ? (bx % 8) * (F.G / 8) + bx / 8 : bx; }
    unsigned char* ws = args.ws;
    F.ctl = (gu32*)(ws + WS_CTL);
#define GRID_BAR(seam) do { if (N_LAUNCHES == PER_PHASE) { if (F.tid == 0) __hip_atomic_store(F.ctl + CW_TMO, 0xBADBA0u | (unsigned)(seam), RLX_AGENT); } else { xcd_barrier(bar); } } while (0)
    const float* x = args.in[0];
    bf16* H = (bf16*)(ws + WS_H); bf16* Win = (bf16*)(ws + WS_WIN); bf16* Wpw = (bf16*)(ws + WS_WPW); bf16* Wao = (bf16*)(ws + WS_WAO); bf16* Wout = (bf16*)(ws + WS_WOUT); bf16* Wq = (bf16*)(ws + WS_WQ);
    bf16* KEYS = (bf16*)(ws + WS_KEYS); unsigned char* UB = ws + WS_UB; unsigned char* VB = ws + WS_VB; float* USC = (float*)(ws + WS_USC); float* VSC = (float*)(ws + WS_VSC);
    bf16* ZGLU = (bf16*)(ws + WS_ZGLU); bf16* QO = (bf16*)(ws + WS_QO); bf16* KB = (bf16*)(ws + WS_K); bf16* VBUF = (bf16*)(ws + WS_V); bf16* GC = (bf16*)(ws + WS_GC); bf16* GA = (bf16*)(ws + WS_GATE_A);
    bf16* CACT = (bf16*)(ws + WS_CACT); bf16* MIX = (bf16*)(ws + WS_MIX); bf16* X1B = (bf16*)(ws + WS_X1B); bf16* QP = (bf16*)(ws + WS_QP);
    float* KMEAN = (float*)(ws + WS_KMEAN); float* SS = (float*)(ws + WS_SS); int* EIDX = (int*)(ws + WS_EIDX); float* GW = (float*)(ws + WS_GW);
    for (int u = F.tid; u < (LDS_BYTES - LDSCTL_OFF) / 4; u += NWAVES * 64) ((LAS unsigned*)(F.lds + LDSCTL_OFF))[u] = 0u;
    __syncthreads();
    XcdBarrier bar; bar.bar = (unsigned*)(F.ctl + CW_BAR); bar.x = 0; bar.st = nullptr;
    if (N_LAUNCHES != PER_PHASE) bar = xcd_barrier_post((unsigned*)(F.ctl + CW_BAR), F.MISC + 8);
    const int lo = args.ph_lo, hi = args.ph_hi;
#ifdef TIME_PHASE
    unsigned long long ts_[PER_PHASE + 1]; ts_[0] = __builtin_amdgcn_s_memrealtime();
#define STAMP(k) ts_[(k) + 1] = __builtin_amdgcn_s_memrealtime()
#else
#define STAMP(k) do {} while (0)
#endif
#ifndef PHASE_MASK
#define PHASE_MASK 0xff
#endif
#define IN(k) (((PHASE_MASK >> (k)) & 1) && lo <= (k) && (k) < hi)
#define BOTH(k) (IN(k) && IN((k) + 1))

    if (IN(0)) {
        P0Args a{x, args.in[1], args.in[2], args.in[7], args.in[9], args.in[10], args.in[11], args.in[12], args.in[13], args.in[14], args.in[15], args.in[16], H, Win, Wpw, Wao, Wout, Wq, KEYS, UB, VB, USC, VSC};
        p0_prologue(F, a);
        if (BOTH(0)) GRID_BAR(0);
        STAMP(0);
    }
#ifdef DEBUG_P1_PLAIN
    if (IN(1)) {
        pg8::Gemm g{H, Wq, TOK, 2048, 1024}; pg8::StaticOrder S; S.init(TOK, 2048, F.G, (int)blockIdx.x);
        pg8::EpiStore E{QP, 2048};
        pg8::gemm_phase<pg8::EpiStore, pg8::StaticOrder, true, true>(F.lds + RING_OFF, g, S, E);
    }
#else
    if (IN(1)) {
        pg8::Gemm g{H, Win, TOK, IN_COLS, 1024}; pg8::StaticOrder S; S.init(TOK, IN_COLS, F.G, (int)blockIdx.x);
        pg8::EpiIn E{ZGLU, QO, GC, KMEAN, attn_body::C2, (size_t)(WS_K - WS_QO) / 2, (size_t)(WS_GATE_A - WS_GC) / 2};
        static_assert(WS_V - WS_K == WS_K - WS_QO, "Q|K|V equally spaced");
        pg8::gemm_phase<pg8::EpiIn, pg8::StaticOrder, true, true>(F.lds + RING_OFF, g, S, E);
        if (BOTH(1)) GRID_BAR(1);
        STAMP(1);
    }
#endif
    if (IN(2)) {
        static_assert(attn_body::ATTN_LDS_BYTES <= RING_BYTES && attn_body::ATTN_PITCH == ATT_W, "attention body geometry vs frame");
#ifdef CONV_FIRST
        { const ConvArgs ca{ZGLU, args.in[3], args.in[4], args.in[5], args.in[6], CACT};
          conv_phase(F, ca); }
        __syncthreads();
#ifdef TIME_SPLIT2
        ts_[3] = __builtin_amdgcn_s_memrealtime();
#endif
#endif
        const attn_body::AttnTensors AT{(const attn_body::bf16*)QO, (const attn_body::bf16*)KB, (const attn_body::bf16*)VBUF, (attn_body::bf16*)(CACT + 512), KMEAN};
        const attn_body::StaticOrder S((int)F.G, (int)blockIdx.x);
        attn_body::attn_phase<attn_body::StaticOrder>((char*)lds + RING_OFF, AT, S);
        __syncthreads();
#ifndef CONV_FIRST
        { const ConvArgs ca{ZGLU, args.in[3], args.in[4], args.in[5], args.in[6], CACT};
          conv_phase(F, ca); }
#endif
        if (BOTH(2)) GRID_BAR(2);
#if !(defined(TIME_SPLIT2) && defined(CONV_FIRST))
        STAMP(2);
#endif
    }
    if (IN(3)) {
        { pg8::Gemm g{CACT, Wpw, TOK, 1024, 1024}; pg8::StaticOrder S; S.init(TOK, 1024, F.G, (int)blockIdx.x);
          pg8::EpiMixF E{GC, GA, args.in[8], MIX};
          pg8::gemm_phase<pg8::EpiMixF, pg8::StaticOrder, true, true>(F.lds + RING_OFF, g, S, E); }
        if (BOTH(3)) GRID_BAR(3);
        STAMP(3);
    }
    if (IN(4)) {
        pg8::Gemm g{MIX, Wout, TOK, 1024, 1024}; pg8::StaticOrder S; S.init(TOK, 1024, F.G, (int)blockIdx.x);
        pg8::EpiX1 E{x, args.out, X1B, SS};
        pg8::gemm_phase<pg8::EpiX1, pg8::StaticOrder, true, true>(F.lds + RING_OFF, g, S, E);
        if (BOTH(4)) GRID_BAR(4);
        STAMP(4);
    }
    if (IN(5)) {
        pg8::Gemm g{X1B, Wq, TOK, 2048, 1024}; pg8::StaticOrder S; S.init(TOK, 2048, F.G, (int)blockIdx.x);
        pg8::EpiStore E{QP, 2048};
        pg8::gemm_phase<pg8::EpiStore, pg8::StaticOrder, true, true>(F.lds + RING_OFF, g, S, E);
        if (BOTH(5)) GRID_BAR(5);
        STAMP(5);
    }
    if (IN(6)) {
        const SelArgs sa{QP, KEYS, SS, USC, VSC, EIDX, (float*)(ws + WS_GA), GW, X1B, ws + WS_X8, (float*)(ws + WS_XS)};
        peer_select_phase(F, sa);
        peer_rows_fp8(F, sa);
        if (BOTH(6)) GRID_BAR(6);
        STAMP(6);
    }
    if (IN(7)) {
        LAS int* cnt = (LAS int*)(F.lds + P7_CNT_OFF);
        if (F.tid < 16) cnt[F.tid] = 0;
        __syncthreads();
        const ExpA ea{ws + WS_X8, (const float*)(ws + WS_XS), UB, EIDX, (const float*)(ws + WS_GA), GW, ws + WS_COEF};
        for (int s = 0; s < 8; ++s) peer_u_phase(F, ea, s, F.vcu, F.G, cnt + s);
        VM_WAIT(); __syncthreads();
#ifdef TIME_V
        const unsigned long long tv0_ = __builtin_amdgcn_s_memrealtime();
#endif
        const ExpB eb{args.out, X1B, VB, EIDX, ws + WS_COEF, (float*)(ws + WS_SS2)};
        for (int s = 0; s < V_SLICES; ++s) peer_v_phase(F, eb, s, F.vcu, F.G, cnt + 8 + s);
        VM_WAIT(); __syncthreads();
#ifdef TIME_V
        const float tvv_ = (float)(__builtin_amdgcn_s_memrealtime() - tv0_) * (0.01f / TIME_V);
#endif
        final_norm_phase(F, args.out, (const float*)(ws + WS_SS2), args.in[17], F.vcu + F.G * F.wave, F.G * NWAVES);
#ifdef UNIT_MFMA4
        __syncthreads();
        if (blockIdx.x == 0 && F.wave == 0) {
            typedef int v8i_ __attribute__((ext_vector_type(8)));
            const int lane = F.lane, qq = lane >> 4;
            const v8i_ av = {0x38383838, 0x38383838, 0x38383838, 0x38383838, 0x38383838, 0x38383838, 0x38383838, 0x38383838};
            v8i_ bv = {0x22222222, 0x22222222, 0x22222222, 0x22222222, 0, 0, 0, 0};
            if (UNIT_MFMA4 == 2) bv = (v8i_){0x11111111, 0, 0, 0, 0, 0, 0, 0};
            v8i_ av2 = av;
            if (UNIT_MFMA4 == 3) { const bool on = qq == 1; av2 = (v8i_){0, on ? 0x00005800 : 0, 0, 0, 0, 0, 0, 0}; bv = (v8i_){on ? 0x00700000 : 0, 0, 0, 0, 0, 0, 0, 0}; }
            if (UNIT_MFMA4 == 4) { const bool on = qq == 2; av2 = (v8i_){0, 0, 0, 0, 0, on ? 0x58000000 : 0, 0, 0}; bv = (v8i_){0, 0, on ? 0x70000000 : 0, 0, 0, 0, 0, 0}; }
            const f32x4 d = __builtin_amdgcn_mfma_scale_f32_16x16x128_f8f6f4(av2, bv, (f32x4){0.f, 0.f, 0.f, 0.f}, 0, 4, 0, 0, 0, 0);
            if (UNIT_MFMA4 >= 100) {
                const int eb = UNIT_MFMA4 - 100; int found = 98;
                v8i_ bs = {0, 0, 0, 0, 0, 0, 0, 0}; if (qq == 2) bs[eb >> 3] = 7 << (4 * (eb & 7));
#pragma nounroll
                for (int qe = 0; qe < 128; ++qe) { int qa = qe >> 5, ea = qe & 31; asm volatile("" : "+s"(qa), "+s"(ea)); v8i_ as = {0, 0, 0, 0, 0, 0, 0, 0};
#pragma unroll
                    for (int w = 0; w < 8; ++w) as[w] = (qq == qa && (ea >> 2) == w) ? (0x58 << (8 * (ea & 3))) : 0;
                    const f32x4 dd = __builtin_amdgcn_mfma_scale_f32_16x16x128_f8f6f4(as, bs, (f32x4){0.f, 0.f, 0.f, 0.f}, 0, 4, 0, 0, 0, 0);
                    if (dd[0] > 1.f) found = (qa == UNIT_QA ? 3 * ea + 4 : 99); }
                if (lane == 0) { VM_WAIT(); args.out[0] = (float)found; }
            } else
            if (lane == 0) { VM_WAIT(); args.out[0] = 200.f + d[0]; }
        }
#endif
#ifdef UNIT_TR4
        __syncthreads();
        if (blockIdx.x == 0 && F.wave == 0) {
            typedef int v2i_ __attribute__((ext_vector_type(2)));
            const int lane = F.lane, g4 = lane >> 4, jj = lane & 15;
            LAS unsigned char* tb = F.lds + RING_OFF + g4 * 2048 + jj * 80;
            int okmask = 0;
            for (int hyp = 0; hyp < 4; ++hyp) { const int st = hyp & 1, ot = hyp >> 1;
                unsigned long long rowbits = 0;
                for (int n = 0; n < 16; ++n) { const unsigned v = (unsigned)(3 * jj + 5 * n + g4) & 15u; const int nib = st ? (n ^ 1) : n; rowbits |= (unsigned long long)v << (4 * nib); }
                *(LAS unsigned*)tb = (unsigned)rowbits; *(LAS unsigned*)(tb + 4) = (unsigned)(rowbits >> 32);
                LDS_WAIT(); asm volatile("" ::: "memory");
                const v2i_ rd = __builtin_amdgcn_ds_read_tr4_b64_v2i32((LAS v2i_*)tb);
                unsigned long long ex = 0;
                for (int k = 0; k < 16; ++k) { const unsigned v = (unsigned)(3 * k + 5 * jj + g4) & 15u; const int nib = ot ? (k ^ 1) : k; ex |= (unsigned long long)v << (4 * nib); }
                const bool bad = ((unsigned)rd.x != (unsigned)ex) || ((unsigned)rd.y != (unsigned)(ex >> 32));
                if (__ballot(bad) == 0ull) okmask |= 1 << hyp;
                LDS_WAIT(); asm volatile("" ::: "memory"); }
            if (lane == 0) { VM_WAIT(); args.out[0] = 200.f + 20.f * (float)okmask; }
        }
#endif
#ifdef TIME_V
        __syncthreads();
        if (blockIdx.x == TIME_V_BLOCK && F.tid == 0) { VM_WAIT(); args.out[0] = tvv_; }
#endif
        STAMP(7);
#ifdef TIME_P7_SPREAD
        __syncthreads();
        ts_[8] = __builtin_amdgcn_s_memrealtime();
        if (F.tid == 0) { __hip_atomic_fetch_max((unsigned long long*)(ws + 800), ts_[8] - ts_[7], __ATOMIC_RELAXED, __HIP_MEMORY_SCOPE_AGENT); __hip_atomic_fetch_add((unsigned*)(ws + 840), 1u, __ATOMIC_RELAXED, __HIP_MEMORY_SCOPE_AGENT); }
        if (blockIdx.x == 0 && F.tid == 0) { while (__hip_atomic_load((unsigned*)(ws + 840), __ATOMIC_RELAXED, __HIP_MEMORY_SCOPE_AGENT) < gridDim.x) __builtin_amdgcn_s_sleep(8);
            ts_[8] = ts_[7] + __hip_atomic_load((unsigned long long*)(ws + 800), __ATOMIC_RELAXED, __HIP_MEMORY_SCOPE_AGENT); }
#endif
#ifdef TIME_PHASE
#ifdef TIME_TOTAL
        if (blockIdx.x == 0 && F.tid == 0) { VM_WAIT(); args.out[0] = (float)(ts_[PER_PHASE] - ts_[0]) * (0.01f / TIME_UNIT_US); }
#else
        if (blockIdx.x == 0 && F.tid == 0) { VM_WAIT(); args.out[0] = (float)(ts_[TIME_PHASE + 1] - ts_[TIME_PHASE]) * (0.01f / TIME_UNIT_US); }
#endif
#endif
    }
#undef IN
#undef BOTH
}

#ifdef DEBUG_DUMP
__global__ void dump_kernel(const unsigned char* ws, float* out, float wsmib) {
    const size_t i = (size_t)blockIdx.x * 256 + threadIdx.x; if (i >= (size_t)TOK * 1024) return;
    const size_t t = i >> 10, c = i & 1023; float v = 0.f;
    auto B = [&](size_t off, size_t idx) { return bflo((unsigned)((const bf16*)(ws + off))[idx]); };
#if DEBUG_DUMP == 0
    v = B(WS_H, i) + B(WS_WIN, i % (4608u * 1024u)) + B(WS_WPW, i % (512u * 1024u)) + B(WS_WAO, i % (512u * 1024u)) + B(WS_WOUT, i % (1024u * 1024u)) + B(WS_WQ, i % (2048u * 1024u)) + B(WS_KEYS, i % 32768u) + B(WS_UB, i % (16384u * 1024u)) + B(WS_VB, i % (16384u * 1024u));
#elif DEBUG_DUMP == 1
    v = B(WS_ZGLU, t * 512 + (c & 511)) + 2.f * B(WS_QO, t * 512 + (c & 511)) + 3.f * B(WS_K, t * 512 + (c & 511)) + 4.f * B(WS_V, t * 512 + (c & 511)) + 5.f * B(WS_GC, i) + 6.f * B(WS_GATE_A, i) + ((const float*)(ws + WS_KMEAN))[(t >> 8) * 1024 + (c & 1023)];
#elif DEBUG_DUMP == 2
    v = B(WS_QO, t * 512 + (c & 511)) + 2.f * B(WS_CACT, t * 512 + (c & 511));
#elif DEBUG_DUMP == 20
    v = B(WS_QO, t * 512 + (c & 511));
#elif DEBUG_DUMP == 21
    v = B(WS_CACT, t * 512 + (c & 511));
#elif DEBUG_DUMP == 3
    v = B(WS_MIX, i);
#elif DEBUG_DUMP == 5
    v = B(WS_QP, t * 2048 + c) + 2.f * B(WS_QP, t * 2048 + 1024 + c);
#elif DEBUG_DUMP == 10
    v = B(WS_ZGLU, t * 512 + (c & 511));
#elif DEBUG_DUMP == 11
    v = 2.f * B(WS_QO, t * 512 + (c & 511)) + 3.f * B(WS_K, t * 512 + (c & 511)) + 4.f * B(WS_V, t * 512 + (c & 511));
#elif DEBUG_DUMP == 12
    v = 5.f * B(WS_GC, i) + 6.f * B(WS_GATE_A, i);
#elif DEBUG_DUMP == 13
    v = ((const float*)(ws + WS_KMEAN))[(t >> 8) * 1024 + (c & 1023)];
#elif DEBUG_DUMP == 98
    v = wsmib;
#elif DEBUG_DUMP == 99
    v = 1.0f + (float)(c & 7);
#endif
    out[i] = v;
}
#endif
extern "C" void kernel_launch(void* const* d_in, const int* in_sizes, int n_in, void* d_out, int out_size, void* d_ws, size_t ws_size, hipStream_t stream) {
    static int grid = 0;
    if (grid == 0) {
        if (n_in != 18 || in_sizes[0] != TOK * DM || out_size != TOK * DM || ws_size < WS_END) { fprintf(stderr, "kernel_launch: unexpected shapes (n_in %d, in0 %d, out %d, ws %zu); nothing launched\n", n_in, n_in > 0 ? in_sizes[0] : -1, out_size, ws_size); grid = -1; return; }
        int dev = 0, cus = 0, per_cu = 0;
        if (hipGetDevice(&dev) != hipSuccess || hipDeviceGetAttribute(&cus, hipDeviceAttributeMultiprocessorCount, dev) != hipSuccess) { grid = -1; return; }
        if (hipFuncSetAttribute((const void*)fwd_kernel, hipFuncAttributeMaxDynamicSharedMemorySize, LDS_BYTES) != hipSuccess) { fprintf(stderr, "kernel_launch: hipFuncSetAttribute failed\n"); grid = -1; return; }
        if (hipOccupancyMaxActiveBlocksPerMultiprocessor(&per_cu, (const void*)fwd_kernel, NWAVES * 64, LDS_BYTES) != hipSuccess || per_cu < 1) fprintf(stderr, "kernel_launch: occupancy query reports %d\n", per_cu);
        (void)hipGetLastError();
        grid = cus;
    }
    if (grid < 0) return;
    (void)hipMemsetAsync((char*)d_ws + WS_CTL, 0, CTL_ZERO_BYTES, stream);
    Args a{};
    for (int i = 0; i < 18; ++i) a.in[i] = (const float*)d_in[i];
    a.out = (float*)d_out; a.ws = (unsigned char*)d_ws;
#ifndef NPH_RUN
#define NPH_RUN N_LAUNCHES
#endif
    for (int li = 0; li < NPH_RUN; ++li) {
        a.ph_lo = (N_LAUNCHES == PER_PHASE) ? li : 0; a.ph_hi = (N_LAUNCHES == PER_PHASE) ? li + 1 : PER_PHASE; a.li = li;
        hipLaunchKernelGGL(fwd_kernel, dim3(grid), dim3(NWAVES * 64), LDS_BYTES, stream, a);
    }
#ifdef DEBUG_DUMP
    hipLaunchKernelGGL(dump_kernel, dim3(TOK * 1024 / 256), dim3(256), 0, stream, (const unsigned char*)d_ws, (float*)d_out, (float)(ws_size >> 20));
#endif
}
```

```cpp
#define MK_N_LAUNCHES 1
#ifndef PG8_EPI_DRAIN
#define PG8_EPI_DRAIN 0
#endif
#include <hip/hip_runtime.h>
#include <hip/hip_bf16.h>
#include <cstdio>
#include <cstdint>
#include <cmath>
namespace pg8 {
#define PG8_LAS __attribute__((address_space(3)))
typedef unsigned short bf16_t;
typedef short bf16x8 __attribute__((ext_vector_type(8)));
typedef float f32x4 __attribute__((ext_vector_type(4)));
typedef unsigned u32x4 __attribute__((ext_vector_type(4)));
constexpr int BM = 256, BK = 64, HALF = 128, HTB = HALF * BK * 2  , STAGE_BYTES = 8 * HTB, NXCD = 8, WGM = 8;

__host__ __device__ __forceinline__ int lds_byte(int r, int c) { const int st = (r >> 4) * 2 + (c >> 5), rr = r & 15, cc = c & 31, ob = rr * 64 + cc * 2; return st * 1024 + (ob ^ (((ob >> 9) & 1) << 5)); }
__host__ __device__ __forceinline__ void stage_rc(int b, int& R, int& C) { const int st = b / 1024, sb = b % 1024, swz = sb ^ (((sb >> 9) & 1) << 5); R = (st >> 1) * 16 + swz / 64; C = (st & 1) * 32 + (swz % 64) / 2; }
__host__ __device__ __forceinline__ int perm32(int rho) { const int n = rho >> 4, i = rho & 15; return 8 * (i >> 2) + 4 * n + (i & 3); }

struct Unit { int pm, pn; };
struct Gemm { const bf16_t* A; const bf16_t* Bt; int M, N, K; };

struct StaticOrder {
    int nM, nN, nwg, G, c;
    __host__ __device__ void init(int M, int N, int G_, int c_) { nM = M / BM; nN = N / BM; nwg = nM * nN; G = G_; c = c_; }
    __host__ __device__ bool next(int i, Unit& u) const {
        const long L = (long)i * G + c; if (L >= nwg) return false;
        int wgid = (int)L; { const int q = nwg / NXCD, r = nwg % NXCD, xcd = wgid % NXCD, off = wgid / NXCD; wgid = (xcd < r ? xcd * (q + 1) : r * (q + 1) + (xcd - r) * q) + off; }
        const int nig = WGM * nN, gid = wgid / nig, fm = gid * WGM, gsz = (nM - fm) < WGM ? (nM - fm) : WGM;
        u.pm = fm + ((wgid % nig) % gsz); u.pn = (wgid % nig) / gsz; return true;
    }
    __device__ __forceinline__ void a_ready(const Unit&) const {}
    __device__ __forceinline__ void done(const Unit&) const {}
};

typedef float f32x2c_t __attribute__((ext_vector_type(2))); typedef __bf16 bf16x2c_t __attribute__((ext_vector_type(2)));
__device__ __forceinline__ unsigned cvt_pk_bf16(float lo, float hi) { const f32x2c_t v = {lo, hi}; const bf16x2c_t b = __builtin_convertvector(v, bf16x2c_t); return __builtin_bit_cast(unsigned, b); }
typedef float f32x2 __attribute__((ext_vector_type(2)));
__device__ __forceinline__ float sigm(float v) { return __builtin_amdgcn_rcpf(1.0f + __builtin_amdgcn_exp2f(-1.4426950408889634f * v)); }
__device__ __forceinline__ float bf_lo(unsigned u) { return __uint_as_float(u << 16); }
__device__ __forceinline__ float bf_hi(unsigned u) { return __uint_as_float(u & 0xffff0000u); }
__device__ __forceinline__ u32x4 pack8(const f32x4 a, const f32x4 b) { u32x4 w; w.x = cvt_pk_bf16(a[0], a[1]); w.y = cvt_pk_bf16(a[2], a[3]); w.z = cvt_pk_bf16(b[0], b[1]); w.w = cvt_pk_bf16(b[2], b[3]); return w; }
__device__ __forceinline__ void unpack8(const u32x4 w, f32x4& a, f32x4& b) { a = (f32x4){bf_lo(w.x), bf_hi(w.x), bf_lo(w.y), bf_hi(w.y)}; b = (f32x4){bf_lo(w.z), bf_hi(w.z), bf_lo(w.w), bf_hi(w.w)}; }

#ifndef PG8_WT
#define PG8_WT 1
#endif
__device__ __forceinline__ __amdgpu_buffer_rsrc_t wt_rsrc(const void* p) { return __builtin_amdgcn_make_buffer_rsrc((void*)p, 0, 0x7fffffff, 0x00020000); }
__device__ __forceinline__ void st16(bf16_t* base, const __amdgpu_buffer_rsrc_t r, size_t elem_off, const u32x4 v) {
#if PG8_WT
    __builtin_amdgcn_raw_buffer_store_b128(v, r, (unsigned)(elem_off * 2), 0, 16);
#else
    *(u32x4*)(base + elem_off) = v;
#endif
}
struct EpiIn {
    static constexpr bool PERM = true, AFTER_DRAIN = false, HAS_MID = false;
    bf16_t *zglu, *Q, *gc; float* kmean; float qscale; size_t qkv_stride, gate_stride;
    __device__ __forceinline__ void operator()(const f32x4 (&acc)[2][2][4][2], const Unit& u, int wr, int wc, int fr, int fq) const {
        const int row0 = u.pm * BM + wr * 64 + fr, cw = wc * 32 + 8 * fq, pn = u.pn;
        const __amdgpu_buffer_rsrc_t rz = wt_rsrc(zglu), rq = wt_rsrc(Q), rg = wt_rsrc(gc);
        if (pn < 4) {
#pragma unroll
            for (int ai = 0; ai < 2; ++ai)
#pragma unroll
                for (int m = 0; m < 4; ++m) { const size_t row = (size_t)(row0 + ai * HALF + m * 16);
                    f32x4 z0, z1;
#pragma unroll
                    for (int j = 0; j < 4; ++j) { z0[j] = acc[ai][0][m][0][j] * sigm(acc[ai][1][m][0][j]); z1[j] = acc[ai][0][m][1][j] * sigm(acc[ai][1][m][1][j]); }
                    st16(zglu, rz, row * 512 + pn * 128 + cw, pack8(z0, z1)); }
        } else if (pn < 10) {
            const size_t boff = (size_t)((pn - 4) >> 1) * qkv_stride; const int ct = (pn & 1) * 256; const float sc = pn < 6 ? qscale : 1.0f;
#pragma unroll
            for (int ai = 0; ai < 2; ++ai)
#pragma unroll
                for (int m = 0; m < 4; ++m) { const size_t row = (size_t)(row0 + ai * HALF + m * 16);
#pragma unroll
                    for (int bj = 0; bj < 2; ++bj) st16(Q, rq, boff + row * 512 + ct + bj * HALF + cw, pack8(acc[ai][bj][m][0] * sc, acc[ai][bj][m][1] * sc)); }
            if (pn == 6 || pn == 7) {
#pragma unroll
                for (int bj = 0; bj < 2; ++bj)
#pragma unroll
                    for (int n = 0; n < 2; ++n)
#pragma unroll
                        for (int j = 0; j < 4; ++j) { float s = 0.f;
#pragma unroll
                            for (int ai = 0; ai < 2; ++ai)
#pragma unroll
                                for (int m = 0; m < 4; ++m) s += acc[ai][bj][m][n][j];
                            s += __shfl_xor(s, 1); s += __shfl_xor(s, 2); s += __shfl_xor(s, 4); s += __shfl_xor(s, 8);
                            if (fr == 0) kmean[((size_t)u.pm * 2 + wr) * 512 + ct + bj * HALF + cw + 4 * n + j] = s * (1.0f / 256.0f); }
            }
        } else {
            const size_t boff = (size_t)((pn - 10) >> 2) * gate_stride; const int ct = ((pn - 10) & 3) * 256;
#pragma unroll
            for (int ai = 0; ai < 2; ++ai)
#pragma unroll
                for (int m = 0; m < 4; ++m) { const size_t row = (size_t)(row0 + ai * HALF + m * 16);
#pragma unroll
                    for (int bj = 0; bj < 2; ++bj) { f32x4 s0, s1;
#pragma unroll
                        for (int j = 0; j < 4; ++j) { s0[j] = sigm(acc[ai][bj][m][0][j]); s1[j] = sigm(acc[ai][bj][m][1][j]); }
                        st16(gc, rg, boff + row * 1024 + ct + bj * HALF + cw, pack8(s0, s1)); } }
        }
    }
};
template <bool ADD> struct EpiMix {
    static constexpr bool PERM = true, AFTER_DRAIN = false, HAS_MID = false;
    const bf16_t* gate; const float* bias; bf16_t* mix;
    __device__ __forceinline__ void operator()(const f32x4 (&acc)[2][2][4][2], const Unit& u, int wr, int wc, int fr, int fq) const {
        const int row0 = u.pm * BM + wr * 64 + fr, col0 = u.pn * BM + wc * 32 + 8 * fq;
        f32x4 b0[2], b1[2];
#pragma unroll
        for (int bj = 0; bj < 2; ++bj) { b0[bj] = (f32x4){0.f, 0.f, 0.f, 0.f}; b1[bj] = b0[bj]; if (!ADD) { b0[bj] = *(const f32x4*)(bias + col0 + bj * HALF); b1[bj] = *(const f32x4*)(bias + col0 + bj * HALF + 4); } }
#pragma unroll
        for (int ai = 0; ai < 2; ++ai) {
            u32x4 gq[4][2], mq[4][2];
#pragma unroll
            for (int m = 0; m < 4; ++m)
#pragma unroll
                for (int bj = 0; bj < 2; ++bj) { const size_t off = (size_t)(row0 + ai * HALF + m * 16) * 1024 + col0 + bj * HALF; gq[m][bj] = *(const u32x4*)(gate + off); if (ADD) mq[m][bj] = *(const u32x4*)(mix + off); }
#pragma unroll
            for (int m = 0; m < 4; ++m)
#pragma unroll
                for (int bj = 0; bj < 2; ++bj) { const size_t off = (size_t)(row0 + ai * HALF + m * 16) * 1024 + col0 + bj * HALF;
                    f32x4 g0, g1; unpack8(gq[m][bj], g0, g1);
                    f32x4 v0 = acc[ai][bj][m][0], v1 = acc[ai][bj][m][1];
                    if (!ADD) { v0 = (v0 + b0[bj]) * g0; v1 = (v1 + b1[bj]) * g1; }
                    else { f32x4 p0, p1; unpack8(mq[m][bj], p0, p1); v0 = p0 + v0 * g0; v1 = p1 + v1 * g1; }
                    *(u32x4*)(mix + off) = pack8(v0, v1); }
        }
    }
};
struct EpiMixF {
    static constexpr bool PERM = true, AFTER_DRAIN = false, HAS_MID = true;
    const bf16_t* gc; const bf16_t* ga; const float* bias; bf16_t* mix;
    __device__ __forceinline__ void mid(f32x4 (&acc)[2][2][4][2], const Unit& u, int wr, int wc, int fr, int fq) const {
        const int row0 = u.pm * BM + wr * 64 + fr, col0 = u.pn * BM + wc * 32 + 8 * fq;
#pragma unroll
        for (int ai = 0; ai < 2; ++ai)
#pragma unroll
            for (int m = 0; m < 4; ++m) { u32x4 cq[2], aq[2];
#pragma unroll
                for (int bj = 0; bj < 2; ++bj) { const size_t off = (size_t)(row0 + ai * HALF + m * 16) * 1024 + col0 + bj * HALF; cq[bj] = *(const u32x4*)(gc + off); aq[bj] = *(const u32x4*)(ga + off); }
#pragma unroll
                for (int bj = 0; bj < 2; ++bj) { f32x4 c0, c1, a0, a1; unpack8(cq[bj], c0, c1); unpack8(aq[bj], a0, a1);
                    const f32x4 b0 = *(const f32x4*)(bias + col0 + bj * HALF), b1 = *(const f32x4*)(bias + col0 + bj * HALF + 4);
#pragma unroll
                    for (int j = 0; j < 4; ++j) { acc[ai][bj][m][0][j] = (acc[ai][bj][m][0][j] + b0[j]) * c0[j] * __builtin_amdgcn_rcpf(fmaxf(a0[j], 1e-30f));
                                                  acc[ai][bj][m][1][j] = (acc[ai][bj][m][1][j] + b1[j]) * c1[j] * __builtin_amdgcn_rcpf(fmaxf(a1[j], 1e-30f)); } }
                if (m & 1) asm volatile("" ::: "memory"); }
    }
    __device__ __forceinline__ void operator()(const f32x4 (&acc)[2][2][4][2], const Unit& u, int wr, int wc, int fr, int fq) const {
        const int row0 = u.pm * BM + wr * 64 + fr, col0 = u.pn * BM + wc * 32 + 8 * fq;
        const __amdgpu_buffer_rsrc_t rm = wt_rsrc(mix);
#pragma unroll
        for (int ai = 0; ai < 2; ++ai) { u32x4 aq[4][2];
#pragma unroll
            for (int m = 0; m < 4; ++m)
#pragma unroll
                for (int bj = 0; bj < 2; ++bj) aq[m][bj] = *(const u32x4*)(ga + (size_t)(row0 + ai * HALF + m * 16) * 1024 + col0 + bj * HALF);
#pragma unroll
            for (int m = 0; m < 4; ++m)
#pragma unroll
                for (int bj = 0; bj < 2; ++bj) { f32x4 a0, a1; unpack8(aq[m][bj], a0, a1); f32x4 v0 = acc[ai][bj][m][0], v1 = acc[ai][bj][m][1];
#pragma unroll
                    for (int j = 0; j < 4; ++j) { v0[j] *= fmaxf(a0[j], 1e-30f); v1[j] *= fmaxf(a1[j], 1e-30f); }
                    st16(mix, rm, (size_t)(row0 + ai * HALF + m * 16) * 1024 + col0 + bj * HALF, pack8(v0, v1)); } }
    }
};
struct EpiX1 {
    static constexpr bool PERM = true, AFTER_DRAIN = false, HAS_MID = false;
    const float* x; float* x1; bf16_t* x1b; float* ss;
    __device__ __forceinline__ void operator()(const f32x4 (&acc)[2][2][4][2], const Unit& u, int wr, int wc, int fr, int fq) const {
        const int row0 = u.pm * BM + wr * 64 + fr, col0 = u.pn * BM + wc * 32 + 8 * fq;
        const __amdgpu_buffer_rsrc_t rx = wt_rsrc(x1b);
#pragma unroll
        for (int ai = 0; ai < 2; ++ai) {
            f32x4 xq[4][2][2];
#pragma unroll
            for (int m = 0; m < 4; ++m)
#pragma unroll
                for (int bj = 0; bj < 2; ++bj) { const size_t off = (size_t)(row0 + ai * HALF + m * 16) * 1024 + col0 + bj * HALF; xq[m][bj][0] = *(const f32x4*)(x + off); xq[m][bj][1] = *(const f32x4*)(x + off + 4); }
#pragma unroll
            for (int m = 0; m < 4; ++m) { const size_t row = (size_t)(row0 + ai * HALF + m * 16); float sq = 0.f;
#pragma unroll
                for (int bj = 0; bj < 2; ++bj) { const size_t off = row * 1024 + col0 + bj * HALF;
                    const f32x4 r0 = xq[m][bj][0] + acc[ai][bj][m][0], r1 = xq[m][bj][1] + acc[ai][bj][m][1];
                    st16(x1b, rx, off, pack8(r0, r1));
                    sq += (r0[0] * r0[0] + r0[1] * r0[1]) + (r0[2] * r0[2] + r0[3] * r0[3]) + (r1[0] * r1[0] + r1[1] * r1[1]) + (r1[2] * r1[2] + r1[3] * r1[3]); }
                sq += __shfl_xor(sq, 16); sq += __shfl_xor(sq, 32);
                if (fq == 0) ss[row * 16 + u.pn * 4 + wc] = sq; }
        }
    }
};
struct EpiStore {
    static constexpr bool PERM = true, AFTER_DRAIN = false, HAS_MID = false;
    bf16_t* O; int ldc;
    __device__ __forceinline__ void operator()(const f32x4 (&acc)[2][2][4][2], const Unit& u, int wr, int wc, int fr, int fq) const {
        const int row0 = u.pm * BM + wr * 64 + fr, col0 = u.pn * BM + wc * 32 + 8 * fq;
        const __amdgpu_buffer_rsrc_t ro = wt_rsrc(O);
#pragma unroll
        for (int ai = 0; ai < 2; ++ai)
#pragma unroll
            for (int m = 0; m < 4; ++m) { const size_t row = (size_t)(row0 + ai * HALF + m * 16);
#pragma unroll
                for (int bj = 0; bj < 2; ++bj) st16(O, ro, row * ldc + col0 + bj * HALF, pack8(acc[ai][bj][m][0], acc[ai][bj][m][1])); }
    }
};


template <class Epi, class Sched, bool ALIGN_EPI = false, bool SP2 = false>
__device__ __forceinline__ void gemm_phase(PG8_LAS unsigned char* lds, const Gemm g, const Sched& S, const Epi& E) {
    const int tid = threadIdx.x, wid = __builtin_amdgcn_readfirstlane(tid >> 6), lane = tid & 63, wr = wid >> 2, wc = wid & 3, fr = lane & 15, fq = lane >> 4;
    const int K = g.K, nt = K / BK;
    unsigned voffA[2], voffB[2];
#pragma unroll
    for (int i = 0; i < 2; ++i) { int R, C; stage_rc(tid * 16 + i * 8192, R, C); const int Rb = Epi::PERM ? ((R & ~31) + perm32(R & 31)) : R;
        voffA[i] = (unsigned)(R * K + C) * 2u; voffB[i] = (unsigned)(Rb * K + C) * 2u; }
    const size_t kstep = (size_t)(BK * 2);
    const size_t hstep = (size_t)HALF * K * 2;
    const size_t tstep = 2 * hstep;
    const unsigned ldsw = (unsigned)wid * 1024u;
    const int aoff = lds_byte(wr * 64 + fr, fq * 8), boff = lds_byte(wc * 32 + fr, fq * 8);
#define PG8_SA(b, h) (((b) * 2 + (h)) * HTB)
#define PG8_SB(b, h) ((4 + (b) * 2 + (h)) * HTB)
#define PG8_STAGE(bufoff, gbase, voff) do { _Pragma("unroll") for (int _i = 0; _i < 2; ++_i) \
        __builtin_amdgcn_global_load_lds((const unsigned*)((const char*)(gbase) + (voff)[_i]), (PG8_LAS unsigned*)(lds + (bufoff) + ldsw + _i * 8192), 16, 0, 0); } while (0)
#define PG8_LDA(dst, b, h) do { _Pragma("unroll") for (int m = 0; m < 4; ++m) _Pragma("unroll") for (int k = 0; k < 2; ++k) dst[m][k] = *(const PG8_LAS bf16x8*)(lds + PG8_SA(b, h) + aoff + m * 2048 + k * 1024); } while (0)
#define PG8_LDB(dst, b, h) do { _Pragma("unroll") for (int n = 0; n < 2; ++n) _Pragma("unroll") for (int k = 0; k < 2; ++k) dst[n][k] = *(const PG8_LAS bf16x8*)(lds + PG8_SB(b, h) + boff + n * 2048 + k * 1024); } while (0)
#define PG8_MMA(ai, bj, At, Bt) do { __builtin_amdgcn_s_setprio(1); _Pragma("unroll") for (int m = 0; m < 4; ++m) _Pragma("unroll") for (int n = 0; n < 2; ++n) _Pragma("unroll") for (int k = 0; k < 2; ++k) \
        acc[ai][bj][m][n] = __builtin_amdgcn_mfma_f32_16x16x32_bf16(Bt[n][k], At[m][k], acc[ai][bj][m][n], 0, 0, 0); __builtin_amdgcn_s_setprio(0); } while (0)
#define PG8_WAIT_V(n) asm volatile("s_waitcnt vmcnt(" #n ")" ::: "memory")
#define PG8_WAIT_L(n) asm volatile("s_waitcnt lgkmcnt(" #n ")" ::: "memory")
#define PG8_BAR __builtin_amdgcn_s_barrier()
#define PG8_SCHED __builtin_amdgcn_sched_barrier(0)
    Unit cur, nxt; int ui = 0;
    if (!S.next(0, cur)) return;
    f32x4 acc[2][2][4][2];
#pragma unroll
    for (int a = 0; a < 2; ++a)
#pragma unroll
        for (int b = 0; b < 2; ++b)
#pragma unroll
            for (int m = 0; m < 4; ++m)
#pragma unroll
                for (int n = 0; n < 2; ++n) acc[a][b][m][n] = (f32x4){0.f, 0.f, 0.f, 0.f};
    bf16x8 At[4][2], B0[2][2], B1[2][2];
    const char* cA = (const char*)g.A + (size_t)cur.pm * tstep; const char* cB = (const char*)g.Bt + (size_t)cur.pn * tstep;
    S.a_ready(cur);
    if constexpr (SP2) {
        PG8_STAGE(PG8_SB(0, 0), cB, voffB); PG8_STAGE(PG8_SB(0, 1), cB + hstep, voffB); PG8_STAGE(PG8_SA(0, 0), cA, voffA); PG8_STAGE(PG8_SA(0, 1), cA + hstep, voffA);
        if (wr == 1) PG8_BAR;
        PG8_WAIT_V(2); PG8_BAR;
        PG8_STAGE(PG8_SB(1, 0), cB + kstep, voffB); PG8_STAGE(PG8_SA(1, 0), cA + kstep, voffA); PG8_STAGE(PG8_SB(1, 1), cB + hstep + kstep, voffB);
        PG8_WAIT_V(6); PG8_BAR;
    } else {
        PG8_STAGE(PG8_SB(0, 0), cB, voffB); PG8_STAGE(PG8_SA(0, 0), cA, voffA); PG8_STAGE(PG8_SB(0, 1), cB + hstep, voffB); PG8_STAGE(PG8_SA(0, 1), cA + hstep, voffA);
        if (wr == 1) PG8_BAR;
        PG8_WAIT_V(4); PG8_BAR;
        PG8_STAGE(PG8_SB(1, 0), cB + kstep, voffB); PG8_STAGE(PG8_SA(1, 0), cA + kstep, voffA); PG8_STAGE(PG8_SB(1, 1), cB + hstep + kstep, voffB);
        PG8_WAIT_V(6); PG8_BAR;
    }
    for (;;) {
        const bool has_next = S.next(ui + 1, nxt);
        const char* nA = has_next ? (const char*)g.A + (size_t)nxt.pm * tstep : cA; const char* nB = has_next ? (const char*)g.Bt + (size_t)nxt.pn * tstep : cB;
        if constexpr (Epi::HAS_MID) {
        for (int t = 0; t < nt / 2; t += 2) {
            const bool last = (t == nt - 2);
            const char* a1 = cA + (size_t)(t + 1) * kstep;
            const char* a2 = last ? nA : cA + (size_t)(t + 2) * kstep; const char* b2 = last ? nB : cB + (size_t)(t + 2) * kstep;
            const char* a3 = a2 + kstep; const char* b3 = b2 + kstep;
            if (last && has_next) S.a_ready(nxt);
            if constexpr (SP2) {
            PG8_LDB(B0, 0, 0); PG8_LDB(B1, 0, 1); PG8_SCHED; PG8_LDA(At, 0, 0); PG8_STAGE(PG8_SA(1, 1), a1 + hstep, voffA);
            PG8_WAIT_V(8); PG8_WAIT_L(0); PG8_BAR; PG8_MMA(0, 0, At, B0); PG8_MMA(0, 1, At, B1); PG8_BAR; PG8_SCHED;
            PG8_LDA(At, 0, 1); PG8_STAGE(PG8_SB(0, 0), b2, voffB); PG8_STAGE(PG8_SB(0, 1), b2 + hstep, voffB); PG8_STAGE(PG8_SA(0, 0), a2, voffA);
            PG8_WAIT_V(8); PG8_WAIT_L(0); PG8_BAR; PG8_MMA(1, 0, At, B0); PG8_MMA(1, 1, At, B1); PG8_BAR; PG8_SCHED;
            PG8_LDB(B0, 1, 0); PG8_LDB(B1, 1, 1); PG8_SCHED; PG8_LDA(At, 1, 0); PG8_STAGE(PG8_SA(0, 1), a2 + hstep, voffA);
            PG8_WAIT_V(8); PG8_WAIT_L(0); PG8_BAR; PG8_MMA(0, 0, At, B0); PG8_MMA(0, 1, At, B1); PG8_BAR; PG8_SCHED;
            PG8_LDA(At, 1, 1); PG8_STAGE(PG8_SB(1, 0), b3, voffB); PG8_STAGE(PG8_SB(1, 1), b3 + hstep, voffB); PG8_STAGE(PG8_SA(1, 0), a3, voffA);
            PG8_WAIT_V(8); PG8_WAIT_L(0); PG8_BAR; PG8_MMA(1, 0, At, B0); PG8_MMA(1, 1, At, B1); PG8_BAR; PG8_SCHED;
            } else {
            PG8_LDB(B0, 0, 0); PG8_SCHED; PG8_LDA(At, 0, 0); PG8_STAGE(PG8_SA(1, 1), a1 + hstep, voffA);
            PG8_WAIT_L(8); PG8_BAR; PG8_WAIT_L(0); PG8_MMA(0, 0, At, B0); PG8_BAR; PG8_SCHED;
            PG8_LDB(B1, 0, 1); PG8_STAGE(PG8_SB(0, 0), b2, voffB);
            PG8_BAR; PG8_WAIT_L(0); PG8_MMA(0, 1, At, B1); PG8_BAR;
            PG8_LDA(At, 0, 1); PG8_STAGE(PG8_SA(0, 0), a2, voffA);
            PG8_BAR; PG8_WAIT_L(0); PG8_MMA(1, 0, At, B0); PG8_BAR; PG8_SCHED;
            PG8_STAGE(PG8_SB(0, 1), b2 + hstep, voffB);
            PG8_WAIT_V(6); PG8_BAR; PG8_MMA(1, 1, At, B1); PG8_BAR;
            PG8_LDB(B0, 1, 0); PG8_SCHED; PG8_LDA(At, 1, 0); PG8_STAGE(PG8_SA(0, 1), a2 + hstep, voffA);
            PG8_WAIT_L(8); PG8_BAR; PG8_WAIT_L(0); PG8_MMA(0, 0, At, B0); PG8_BAR; PG8_SCHED;
            PG8_LDB(B1, 1, 1); PG8_STAGE(PG8_SB(1, 0), b3, voffB);
            PG8_BAR; PG8_WAIT_L(0); PG8_MMA(0, 1, At, B1); PG8_BAR;
            PG8_LDA(At, 1, 1); PG8_STAGE(PG8_SA(1, 0), a3, voffA);
            PG8_BAR; PG8_WAIT_L(0); PG8_MMA(1, 0, At, B0); PG8_BAR; PG8_SCHED;
            PG8_STAGE(PG8_SB(1, 1), b3 + hstep, voffB);
            PG8_WAIT_V(6); PG8_BAR; PG8_MMA(1, 1, At, B1); PG8_BAR;
            }
        }
        E.mid(acc, cur, wr, wc, fr, fq);
        for (int t = nt / 2; t < nt; t += 2) {
            const bool last = (t == nt - 2);
            const char* a1 = cA + (size_t)(t + 1) * kstep;
            const char* a2 = last ? nA : cA + (size_t)(t + 2) * kstep; const char* b2 = last ? nB : cB + (size_t)(t + 2) * kstep;
            const char* a3 = a2 + kstep; const char* b3 = b2 + kstep;
            if (last && has_next) S.a_ready(nxt);
            if constexpr (SP2) {
            PG8_LDB(B0, 0, 0); PG8_LDB(B1, 0, 1); PG8_SCHED; PG8_LDA(At, 0, 0); PG8_STAGE(PG8_SA(1, 1), a1 + hstep, voffA);
            PG8_WAIT_V(8); PG8_WAIT_L(0); PG8_BAR; PG8_MMA(0, 0, At, B0); PG8_MMA(0, 1, At, B1); PG8_BAR; PG8_SCHED;
            PG8_LDA(At, 0, 1); PG8_STAGE(PG8_SB(0, 0), b2, voffB); PG8_STAGE(PG8_SB(0, 1), b2 + hstep, voffB); PG8_STAGE(PG8_SA(0, 0), a2, voffA);
            PG8_WAIT_V(8); PG8_WAIT_L(0); PG8_BAR; PG8_MMA(1, 0, At, B0); PG8_MMA(1, 1, At, B1); PG8_BAR; PG8_SCHED;
            PG8_LDB(B0, 1, 0); PG8_LDB(B1, 1, 1); PG8_SCHED; PG8_LDA(At, 1, 0); PG8_STAGE(PG8_SA(0, 1), a2 + hstep, voffA);
            PG8_WAIT_V(8); PG8_WAIT_L(0); PG8_BAR; PG8_MMA(0, 0, At, B0); PG8_MMA(0, 1, At, B1); PG8_BAR; PG8_SCHED;
            PG8_LDA(At, 1, 1); PG8_STAGE(PG8_SB(1, 0), b3, voffB); PG8_STAGE(PG8_SB(1, 1), b3 + hstep, voffB); PG8_STAGE(PG8_SA(1, 0), a3, voffA);
            PG8_WAIT_V(8); PG8_WAIT_L(0); PG8_BAR; PG8_MMA(1, 0, At, B0); PG8_MMA(1, 1, At, B1); PG8_BAR; PG8_SCHED;
            } else {
            PG8_LDB(B0, 0, 0); PG8_SCHED; PG8_LDA(At, 0, 0); PG8_STAGE(PG8_SA(1, 1), a1 + hstep, voffA);
            PG8_WAIT_L(8); PG8_BAR; PG8_WAIT_L(0); PG8_MMA(0, 0, At, B0); PG8_BAR; PG8_SCHED;
            PG8_LDB(B1, 0, 1); PG8_STAGE(PG8_SB(0, 0), b2, voffB);
            PG8_BAR; PG8_WAIT_L(0); PG8_MMA(0, 1, At, B1); PG8_BAR;
            PG8_LDA(At, 0, 1); PG8_STAGE(PG8_SA(0, 0), a2, voffA);
            PG8_BAR; PG8_WAIT_L(0); PG8_MMA(1, 0, At, B0); PG8_BAR; PG8_SCHED;
            PG8_STAGE(PG8_SB(0, 1), b2 + hstep, voffB);
            PG8_WAIT_V(6); PG8_BAR; PG8_MMA(1, 1, At, B1); PG8_BAR;
            PG8_LDB(B0, 1, 0); PG8_SCHED; PG8_LDA(At, 1, 0); PG8_STAGE(PG8_SA(0, 1), a2 + hstep, voffA);
            PG8_WAIT_L(8); PG8_BAR; PG8_WAIT_L(0); PG8_MMA(0, 0, At, B0); PG8_BAR; PG8_SCHED;
            PG8_LDB(B1, 1, 1); PG8_STAGE(PG8_SB(1, 0), b3, voffB);
            PG8_BAR; PG8_WAIT_L(0); PG8_MMA(0, 1, At, B1); PG8_BAR;
            PG8_LDA(At, 1, 1); PG8_STAGE(PG8_SA(1, 0), a3, voffA);
            PG8_BAR; PG8_WAIT_L(0); PG8_MMA(1, 0, At, B0); PG8_BAR; PG8_SCHED;
            PG8_STAGE(PG8_SB(1, 1), b3 + hstep, voffB);
            PG8_WAIT_V(6); PG8_BAR; PG8_MMA(1, 1, At, B1); PG8_BAR;
            }
        }
        } else {
        for (int t = 0; t < nt; t += 2) {
            const bool last = (t == nt - 2);
            const char* a1 = cA + (size_t)(t + 1) * kstep;
            const char* a2 = last ? nA : cA + (size_t)(t + 2) * kstep; const char* b2 = last ? nB : cB + (size_t)(t + 2) * kstep;
            const char* a3 = a2 + kstep; const char* b3 = b2 + kstep;
            if (last && has_next) S.a_ready(nxt);
            if constexpr (SP2) {
            PG8_LDB(B0, 0, 0); PG8_LDB(B1, 0, 1); PG8_SCHED; PG8_LDA(At, 0, 0); PG8_STAGE(PG8_SA(1, 1), a1 + hstep, voffA);
            PG8_WAIT_V(8); PG8_WAIT_L(0); PG8_BAR; PG8_MMA(0, 0, At, B0); PG8_MMA(0, 1, At, B1); PG8_BAR; PG8_SCHED;
            PG8_LDA(At, 0, 1); PG8_STAGE(PG8_SB(0, 0), b2, voffB); PG8_STAGE(PG8_SB(0, 1), b2 + hstep, voffB); PG8_STAGE(PG8_SA(0, 0), a2, voffA);
            PG8_WAIT_V(8); PG8_WAIT_L(0); PG8_BAR; PG8_MMA(1, 0, At, B0); PG8_MMA(1, 1, At, B1); PG8_BAR; PG8_SCHED;
            PG8_LDB(B0, 1, 0); PG8_LDB(B1, 1, 1); PG8_SCHED; PG8_LDA(At, 1, 0); PG8_STAGE(PG8_SA(0, 1), a2 + hstep, voffA);
            PG8_WAIT_V(8); PG8_WAIT_L(0); PG8_BAR; PG8_MMA(0, 0, At, B0); PG8_MMA(0, 1, At, B1); PG8_BAR; PG8_SCHED;
            PG8_LDA(At, 1, 1); PG8_STAGE(PG8_SB(1, 0), b3, voffB); PG8_STAGE(PG8_SB(1, 1), b3 + hstep, voffB); PG8_STAGE(PG8_SA(1, 0), a3, voffA);
            PG8_WAIT_V(8); PG8_WAIT_L(0); PG8_BAR; PG8_MMA(1, 0, At, B0); PG8_MMA(1, 1, At, B1); PG8_BAR; PG8_SCHED;
            } else {
            PG8_LDB(B0, 0, 0); PG8_SCHED; PG8_LDA(At, 0, 0); PG8_STAGE(PG8_SA(1, 1), a1 + hstep, voffA);
            PG8_WAIT_L(8); PG8_BAR; PG8_WAIT_L(0); PG8_MMA(0, 0, At, B0); PG8_BAR; PG8_SCHED;
            PG8_LDB(B1, 0, 1); PG8_STAGE(PG8_SB(0, 0), b2, voffB);
            PG8_BAR; PG8_WAIT_L(0); PG8_MMA(0, 1, At, B1); PG8_BAR;
            PG8_LDA(At, 0, 1); PG8_STAGE(PG8_SA(0, 0), a2, voffA);
            PG8_BAR; PG8_WAIT_L(0); PG8_MMA(1, 0, At, B0); PG8_BAR; PG8_SCHED;
            PG8_STAGE(PG8_SB(0, 1), b2 + hstep, voffB);
            PG8_WAIT_V(6); PG8_BAR; PG8_MMA(1, 1, At, B1); PG8_BAR;
            PG8_LDB(B0, 1, 0); PG8_SCHED; PG8_LDA(At, 1, 0); PG8_STAGE(PG8_SA(0, 1), a2 + hstep, voffA);
            PG8_WAIT_L(8); PG8_BAR; PG8_WAIT_L(0); PG8_MMA(0, 0, At, B0); PG8_BAR; PG8_SCHED;
            PG8_LDB(B1, 1, 1); PG8_STAGE(PG8_SB(1, 0), b3, voffB);
            PG8_BAR; PG8_WAIT_L(0); PG8_MMA(0, 1, At, B1); PG8_BAR;
            PG8_LDA(At, 1, 1); PG8_STAGE(PG8_SA(1, 0), a3, voffA);
            PG8_BAR; PG8_WAIT_L(0); PG8_MMA(1, 0, At, B0); PG8_BAR; PG8_SCHED;
            PG8_STAGE(PG8_SB(1, 1), b3 + hstep, voffB);
            PG8_WAIT_V(6); PG8_BAR; PG8_MMA(1, 1, At, B1); PG8_BAR;
            }
        }
        }
        if constexpr (ALIGN_EPI) { if (wr == 0) PG8_BAR; }
        if constexpr (!Epi::AFTER_DRAIN) { E(acc, cur, wr, wc, fr, fq); S.done(cur);
#if PG8_EPI_DRAIN
            PG8_WAIT_V(0);
#endif
        }
        if (!has_next) break;
#pragma unroll
        for (int a = 0; a < 2; ++a)
#pragma unroll
            for (int b = 0; b < 2; ++b)
#pragma unroll
                for (int m = 0; m < 4; ++m)
#pragma unroll
                    for (int n = 0; n < 2; ++n) acc[a][b][m][n] = (f32x4){0.f, 0.f, 0.f, 0.f};
        cur = nxt; cA = nA; cB = nB; ++ui;
        if constexpr (ALIGN_EPI) { if (wr == 1) PG8_BAR; }
    }
    PG8_WAIT_V(0);
    if constexpr (!ALIGN_EPI) { if (wr == 0) PG8_BAR; }
    PG8_BAR;
    if constexpr (Epi::AFTER_DRAIN) { E.fused(acc, cur, wr, wc, fr, fq, lds, wid, lane); S.done(cur); }
#undef PG8_SA
#undef PG8_SB
#undef PG8_STAGE
#undef PG8_LDA
#undef PG8_LDB
#undef PG8_MMA
#undef PG8_WAIT_V
#undef PG8_WAIT_L
#undef PG8_BAR
#undef PG8_SCHED
}
}

#include <hip/hip_bf16.h>
#include <cmath>
namespace attn_body {
using bf16=__hip_bfloat16;
using bf16x8=__attribute__((ext_vector_type(8)))short;
using s16x4=__attribute__((ext_vector_type(4)))short;
using f32x16=__attribute__((ext_vector_type(16)))float;
using u32x4=__attribute__((ext_vector_type(4)))unsigned;
typedef float f32x4_t __attribute__((ext_vector_type(4)));
constexpr int BATCH=8,NHEAD=8,SEQ=4096,D=64,DM=NHEAD*D;
constexpr int NW=8,QBLK=32,QB=QBLK*NW,KVBLK=64,NQB=SEQ/QB;
constexpr int ATTN_PITCH=DM, ATTN_UNIT_ROWS=QB, OPITCH=1024;
__device__ __forceinline__ int crow(int r,int hi){return (r&3)+8*(r>>2)+4*hi;}
#define SBAR() __builtin_amdgcn_sched_barrier(0)
__device__ __forceinline__ void cmask(f32x16&p0,f32x16&p1,int jb,int qrel,int hi){
  const float NEG=-INFINITY; int kb=64*jb+4*hi;
  #pragma unroll
  for(int r=0;r<16;++r){int kv=kb+(r&3)+8*(r>>2); if(kv>qrel)p0[r]=NEG; if(kv+32>qrel)p1[r]=NEG;}
}

constexpr int NSLOT=3, SLOTB=8192;
constexpr int LDS_K=0, LDS_V=NSLOT*SLOTB, LDS_WS=2*NSLOT*SLOTB, LDS_OST=LDS_WS+NW*64*4, LDS_KM=LDS_OST+NW*4096, LDS_BYTES=LDS_KM+4096;
constexpr float C2=0.125f*1.4426950408889634f;
__device__ __forceinline__ void glds16(const void*gsrc,unsigned lds_dst){unsigned keep;
  asm volatile("s_mov_b32 %0, m0\n\ts_mov_b32 m0, %2\n\ts_nop 0\n\tglobal_load_lds_dwordx4 %1, off\n\ts_mov_b32 m0, %0":"=&s"(keep):"v"(gsrc),"s"(lds_dst):"memory");}
__device__ __forceinline__ float max3f(float a,float b,float c){float r;asm("v_max3_f32 %0, %1, %2, %3":"=v"(r):"v"(a),"v"(b),"v"(c));return r;}
__device__ __forceinline__ float max2f(float a,float b){float r;asm("v_max_f32_e32 %0, %1, %2":"=v"(r):"v"(a),"v"(b));return r;}
__device__ __forceinline__ float fadd_s(float a,float b){float r;asm("v_add_f32_e32 %0, %1, %2":"=v"(r):"v"(a),"v"(b));return r;}
__device__ __forceinline__ float fsub_s(float a,float b){float r;asm("v_sub_f32_e32 %0, %1, %2":"=v"(r):"v"(a),"v"(b));return r;}
typedef float f32x2_t __attribute__((ext_vector_type(2))); typedef __bf16 bf16x2_t __attribute__((ext_vector_type(2)));
__device__ __forceinline__ unsigned cvtpk_s(float lo,float hi){f32x2_t v={lo,hi};bf16x2_t b=__builtin_convertvector(v,bf16x2_t);return __builtin_bit_cast(unsigned,b);}
#define WAIT_BAR(N) asm volatile("s_waitcnt vmcnt(" #N ") lgkmcnt(0)\n\ts_barrier":::"memory")

__device__ __forceinline__ void qkt(f32x16&p0,f32x16&p1,const char*Kslot,const bf16x8*qr,int r32,int hi){
  const char*kb=Kslot+hi*1024+r32*16;
  #pragma unroll
  for(int d0=0;d0<4;++d0){
    const bf16x8 b0=*reinterpret_cast<const bf16x8*>(kb+d0*2048);
    const bf16x8 b1=*reinterpret_cast<const bf16x8*>(kb+d0*2048+512);
    p0=__builtin_amdgcn_mfma_f32_32x32x16_bf16(b0,qr[d0],p0,0,0,0);p1=__builtin_amdgcn_mfma_f32_32x32x16_bf16(b1,qr[d0],p1,0,0,0);}
}
typedef __attribute__((address_space(3))) const char* lds_cptr;
typedef short v4i16_t __attribute__((ext_vector_type(4)));
__device__ __forceinline__ void kload8(bf16x8*kf,lds_cptr kp){
  kf[0]=*(const __attribute__((address_space(3))) bf16x8*)(kp);      kf[1]=*(const __attribute__((address_space(3))) bf16x8*)(kp+512);
  kf[2]=*(const __attribute__((address_space(3))) bf16x8*)(kp+2048); kf[3]=*(const __attribute__((address_space(3))) bf16x8*)(kp+2560);
  kf[4]=*(const __attribute__((address_space(3))) bf16x8*)(kp+4096); kf[5]=*(const __attribute__((address_space(3))) bf16x8*)(kp+4608);
  kf[6]=*(const __attribute__((address_space(3))) bf16x8*)(kp+6144); kf[7]=*(const __attribute__((address_space(3))) bf16x8*)(kp+6656);
}
__device__ __forceinline__ void kload2(bf16x8*kf,lds_cptr kp,int j){ kf[2*j]=*(const __attribute__((address_space(3))) bf16x8*)(kp+j*2048); kf[2*j+1]=*(const __attribute__((address_space(3))) bf16x8*)(kp+j*2048+512); }
__device__ __forceinline__ s16x4 vtr(lds_cptr p){ return __builtin_bit_cast(s16x4,__builtin_amdgcn_ds_read_tr16_b64_v4i16((__attribute__((address_space(3))) v4i16_t*)p)); }
__device__ __forceinline__ float rowmax(const f32x16&p0,const f32x16&p1){
  float a=max3f(p0[0],p0[1],p1[0]),b=max3f(p0[2],p0[3],p1[1]);a=max3f(a,p1[2],p1[3]);
  #pragma unroll
  for(int r=4;r<16;r+=4){a=max3f(a,p0[r],p0[r+1]);b=max3f(b,p0[r+2],p0[r+3]);a=max3f(a,p1[r],p1[r+1]);b=max3f(b,p1[r+2],p1[r+3]);}
  const float m=max2f(a,b);
  auto rr=__builtin_amdgcn_permlane32_swap(__float_as_uint(m),__float_as_uint(m),false,false);
  return max2f(__uint_as_float(rr[0]),__uint_as_float(rr[1]));
}
__device__ __forceinline__ void pv(f32x16*o,int vb,bf16x8 pa0,bf16x8 pa1,bf16x8 pa2,bf16x8 pa3){
  #pragma unroll
  for(int d0=0;d0<2;++d0){s16x4 lo[4],hi[4];
    #pragma unroll
    for(int ks=0;ks<4;++ks){
      asm volatile("ds_read_b64_tr_b16 %0,%1 offset:%c2":"=&v"(lo[ks]):"v"(vb),"i"(d0*4096+ks*1024):"memory");
      asm volatile("ds_read_b64_tr_b16 %0,%1 offset:%c2":"=&v"(hi[ks]):"v"(vb),"i"(d0*4096+ks*1024+512):"memory");}
    asm volatile("s_waitcnt lgkmcnt(0)":::"memory");SBAR();
    #define PK(k) (bf16x8){lo[k][0],lo[k][1],lo[k][2],lo[k][3],hi[k][0],hi[k][1],hi[k][2],hi[k][3]}
    o[d0]=__builtin_amdgcn_mfma_f32_32x32x16_bf16(pa0,PK(0),o[d0],0,0,0);
    o[d0]=__builtin_amdgcn_mfma_f32_32x32x16_bf16(pa1,PK(1),o[d0],0,0,0);
    o[d0]=__builtin_amdgcn_mfma_f32_32x32x16_bf16(pa2,PK(2),o[d0],0,0,0);
    o[d0]=__builtin_amdgcn_mfma_f32_32x32x16_bf16(pa3,PK(3),o[d0],0,0,0);
    #undef PK
  }
}

#ifndef ATTN_STORE16
#define ATTN_STORE16(p,v) __builtin_amdgcn_raw_buffer_store_b128((v),orsrc_,(unsigned)((const char*)(p)-(const char*)O),0,16)
#endif
template<int THRL> __device__ __forceinline__ void attn_unit(int b,int h,int qb,const bf16*Q,const bf16*__restrict__ K,const bf16*__restrict__ V,bf16*O,const float*kmean,char*shm){
  const int tid=threadIdx.x,lane=tid&63,r32=lane&31,hi=lane>>5; const int wid=__builtin_amdgcn_readfirstlane(tid>>6);
  const long rowbase=(long)b*SEQ; const int q0=qb*QB;
  const bf16*Qw=Q+(rowbase+q0+wid*QBLK)*DM+h*D;
  const bf16*Kh=K+rowbase*DM+h*D,*Vh=V+rowbase*DM+h*D;
  const unsigned lds0=(unsigned)(uintptr_t)shm;
  float*wsf=(float*)(shm+LDS_WS)+wid*64;
  const bf16*ksrc=Kh+(long)lane*DM+wid*8;
  const bf16*vsrc=Vh+(long)(16*(wid&3)+(lane>>2))*DM+(wid>>2)*32+(lane&3)*8;
  const unsigned kdst=lds0+LDS_K+wid*1024, vdst=lds0+LDS_V+wid*1024;
  #define POS(t) (((t)<4)?(NT-4+(t)):((t)-4))
  #define DMA_K(t,slot) glds16(ksrc+(long)POS(t)*KVBLK*DM,(unsigned)__builtin_amdgcn_readfirstlane(kdst+(slot)))
  #define DMA_V(t,slot) glds16(vsrc+(long)POS(t)*KVBLK*DM,(unsigned)__builtin_amdgcn_readfirstlane(vdst+(slot)))
  const int vb0=(int)(lds0+LDS_V)+((lane>>4)&1)*32+(lane&3)*8+(4*hi+((lane&15)>>2))*64;
  const char*Kbase=shm+LDS_K; bf16x8 kf[8];
  const lds_cptr shm3=(lds_cptr)shm; const lds_cptr kp0=shm3+LDS_K+hi*1024+r32*16; const lds_cptr vp0=shm3+LDS_V+((lane>>4)&1)*32+(lane&3)*8+(4*hi+((lane&15)>>2))*64;
  const int NT=(q0+QB)/KVBLK;
  DMA_K(0,0);DMA_V(0,0);DMA_K(1,SLOTB);
  bf16x8 qr[4];
  #pragma unroll
  for(int d0=0;d0<4;++d0)qr[d0]=*reinterpret_cast<const bf16x8*>(&Qw[(long)r32*DM+d0*16+hi*8]);
  float mhat=0.f,l_reg=0.f;f32x16 o[2];o[0]=f32x16{};o[1]=f32x16{};
  const float slope2=ldexpf(1.4426950408889634f,-(h+1));
  unsigned selmask=0u;
  { typedef __attribute__((address_space(3))) float* lds_fptr; typedef __attribute__((address_space(3))) const f32x4_t* lds_f4ptr;
    lds_fptr kml=(lds_fptr)((lds_cptr)shm+LDS_KM);
    { const float*src=kmean+((long)b*16)*2*DM+h*D;
      #pragma unroll
      for(int i=0;i<2;++i){const int e=tid+512*i; kml[e]=src[(e>>6)*2*DM+(e&63)]+src[(e>>6)*2*DM+DM+(e&63)];} }
    asm volatile("s_waitcnt vmcnt(0) lgkmcnt(0)\n\ts_barrier":::"memory");
    float qf[32];
    #pragma unroll
    for(int d0=0;d0<4;++d0){
      #pragma unroll
      for(int j=0;j<8;++j)qf[d0*8+j]=__uint_as_float(((unsigned)(unsigned short)qr[d0][j])<<16);}
    float sc[16];
    #pragma unroll
    for(int j=0;j<16;++j){ sc[j]=-INFINITY;
      if(j<qb){ lds_f4ptr kr=(lds_f4ptr)(kml+j*64+hi*8); float a=0.f;
        #pragma unroll
        for(int d0=0;d0<4;++d0){ const f32x4_t k0=kr[d0*4],k1=kr[d0*4+1];
          a+=qf[d0*8+0]*k0[0]+qf[d0*8+1]*k0[1]+qf[d0*8+2]*k0[2]+qf[d0*8+3]*k0[3]+qf[d0*8+4]*k1[0]+qf[d0*8+5]*k1[1]+qf[d0*8+6]*k1[2]+qf[d0*8+7]*k1[3]; }
        a+=__shfl_xor(a,32); sc[j]=a; } }
    #pragma unroll
    for(int j=0;j<15;++j){ int cnt=0;
      #pragma unroll
      for(int k=0;k<15;++k){ if(k!=j) cnt+=((sc[k]>sc[j])||((sc[k]==sc[j])&&(k<j)))?1:0; }
      if(j<qb&&cnt<3) selmask|=(1u<<j); } }
  #define CINIT(C0,C1,t) do{ const int pt_=POS(t); float x_=slope2*(float)(64*pt_-q0+4*hi)-mhat; \
    if((t)>=4){ x_+=((selmask>>(pt_>>2))&1u)?0.f:-30000.f; } const float y_=x_+32.f*slope2; \
    _Pragma("unroll") for(int r=0;r<16;++r){ const float cr_=(float)((r&3)+8*(r>>2)); C0[r]=__builtin_fmaf(slope2,cr_,x_); C1[r]=__builtin_fmaf(slope2,cr_,y_); } }while(0)

  const int qrel=wid*QBLK+r32;
  #define CMASK(P0,P1,t) do{ if((t)<4)cmask(P0,P1,(t),qrel,hi);}while(0)
  bool resc=false;
  #define START(P0,P1) do{ const float rm=rowmax(P0,P1); resc=false; \
    { const float dl=rm; mhat=fadd_s(mhat,dl); \
      _Pragma("unroll") for(int r=0;r<16;++r){P0[r]=fsub_s(P0[r],dl);P1[r]=fsub_s(P1[r],dl);} } \
    _Pragma("unroll") for(int r=0;r<16;++r)P0[r]=__builtin_amdgcn_exp2f(P0[r]); }while(0)
  #define RESC() do{ if(resc){ asm volatile("s_waitcnt lgkmcnt(0)":::"memory"); \
      _Pragma("unroll") for(int d_=0;d_<2;++d_) _Pragma("unroll") for(int r=0;r<16;++r)o[d_][r]*=wsf[crow(r,hi)]; } }while(0)
  f32x16 pA0,pA1,pB0,pB1;
  int sl_prev=0,sl_cur=0,sl_next=SLOTB;
  #define ROT() do{sl_prev=sl_cur;sl_cur=sl_next;sl_next=(sl_next==(NSLOT-1)*SLOTB)?0:sl_next+SLOTB;}while(0)
  DMA_K(2,2*SLOTB);
  WAIT_BAR(3);
  CINIT(pA0,pA1,0); qkt(pA0,pA1,Kbase,qr,r32,hi);asm volatile("s_nop 15\n\ts_nop 7":"+v"(pA0),"+v"(pA1));CMASK(pA0,pA1,0);
  START(pA0,pA1);
  _Pragma("unroll") for(int r=0;r<16;++r)pA1[r]=__builtin_amdgcn_exp2f(pA1[r]);
  WAIT_BAR(0);
  DMA_K(3,0);DMA_V(1,SLOTB);
  ROT();
  kload8(kf,kp0+sl_cur);
  WAIT_BAR(2);
  s16x4 vlo[8],vhi[8]; u32x4 pw0,pw1,pw2,pw3;
  #define PKW(P,B) cvtpk_s(P[B],P[B+1])
  #define PAF(k) __builtin_bit_cast(bf16x8,pw##k)
  #define VFR(i) (bf16x8){vlo[i][0],vlo[i][1],vlo[i][2],vlo[i][3],vhi[i][0],vhi[i][1],vhi[i][2],vhi[i][3]}
  #define PIN(x) asm volatile("":"+v"(x))
  #define MX3(a,b,c) __builtin_fmaxf(__builtin_fmaxf((a),(b)),(c))
  #define GAPA(MF,A0,A1,A2,A3,W0,W1,PW) do{ MF; sacc+=A0; sacc+=A1; sacc+=A2; sacc+=A3; PIN(sacc); W0; W1; PIN(PW); SBAR(); }while(0)
  #define EX(v) __builtin_amdgcn_exp2f(v)
  #define GAPB(MF,X,B) do{ MF; X[B]=EX(X[B]); X[B+1]=EX(X[B+1]); X[B+2]=EX(X[B+2]); X[B+3]=EX(X[B+3]); PIN(X); SBAR(); }while(0)
  #define VRD(i) do{ vlo[i]=vtr(vp_+(((i)>>2)*4096+((i)&3)*1024)); vhi[i]=vtr(vp_+(((i)>>2)*4096+((i)&3)*1024+512)); }while(0)
  #define KRD(G,j) do{ if(G){ kload2(kf,kp0+sl_next,j); SBAR(); } }while(0)
  #define STEP(C0,C1,P0,P1,t,GK,GV,GL) do{ SBAR(); CINIT(C0,C1,t); PIN(C0); PIN(C1); SBAR(); \
    const lds_cptr vp_=vp0+sl_prev; \
    VRD(0); SBAR(); float sacc=(P0[0]+P0[1]); \
    GAPA(C0=__builtin_amdgcn_mfma_f32_32x32x16_bf16(kf[0],qr[0],C0,0,0,0), P0[2],P0[3],P0[4],P0[5],     pw0[0]=PKW(P0,0), pw0[1]=PKW(P0,2), pw0); \
    VRD(4); SBAR(); GAPA(C1=__builtin_amdgcn_mfma_f32_32x32x16_bf16(kf[1],qr[0],C1,0,0,0), P0[6],P0[7],P0[8],P0[9],     pw0[2]=PKW(P0,4), pw0[3]=PKW(P0,6), pw0); \
    VRD(1); SBAR(); GAPA(C0=__builtin_amdgcn_mfma_f32_32x32x16_bf16(kf[2],qr[1],C0,0,0,0),   P0[10],P0[11],P0[12],P0[13], pw1[0]=PKW(P0,8), pw1[1]=PKW(P0,10), pw1); \
    VRD(5); SBAR(); GAPA(C1=__builtin_amdgcn_mfma_f32_32x32x16_bf16(kf[3],qr[1],C1,0,0,0),   P0[14],P0[15],P1[0],P1[1],   pw1[2]=PKW(P0,12),pw1[3]=PKW(P0,14), pw1); \
    VRD(2); SBAR(); GAPA(C0=__builtin_amdgcn_mfma_f32_32x32x16_bf16(kf[4],qr[2],C0,0,0,0),   P1[2],P1[3],P1[4],P1[5],     pw2[0]=PKW(P1,0), pw2[1]=PKW(P1,2), pw2); \
    VRD(6); SBAR(); GAPA(C1=__builtin_amdgcn_mfma_f32_32x32x16_bf16(kf[5],qr[2],C1,0,0,0),   P1[6],P1[7],P1[8],P1[9],     pw2[2]=PKW(P1,4), pw2[3]=PKW(P1,6), pw2); \
    VRD(3); SBAR(); GAPA(C0=__builtin_amdgcn_mfma_f32_32x32x16_bf16(kf[6],qr[3],C0,0,0,0),   P1[10],P1[11],P1[12],P1[13], pw3[0]=PKW(P1,8), pw3[1]=PKW(P1,10), pw3); \
    VRD(7); SBAR(); GAPA(C1=__builtin_amdgcn_mfma_f32_32x32x16_bf16(kf[7],qr[3],C1,0,0,0),   P1[14],P1[15],0.f,0.f,       pw3[2]=PKW(P1,12),pw3[3]=PKW(P1,14), pw3); \
    l_reg+=sacc; \
    if(GK){DMA_K((t)+3,sl_cur);} if(GV){DMA_V((t)+1,sl_next);} \
    CMASK(C0,C1,t); \
    { float a=MX3(C0[0],C0[1],C1[0]),b=MX3(C0[2],C0[3],C1[1]); a=MX3(a,C1[2],C1[3]); \
      _Pragma("unroll") for(int r=4;r<16;r+=4){a=MX3(a,C0[r],C0[r+1]);b=MX3(b,C0[r+2],C0[r+3]);a=MX3(a,C1[r],C1[r+1]);b=MX3(b,C1[r+2],C1[r+3]);} \
      float rm=__builtin_fmaxf(a,b); { auto rr=__builtin_amdgcn_permlane32_swap(__float_as_uint(rm),__float_as_uint(rm),false,false); rm=__builtin_fmaxf(__uint_as_float(rr[0]),__uint_as_float(rr[1])); } \
      resc=false; \
      if(__builtin_expect(__any(rm>(float)THRL),0)){ const float dl=__builtin_fmaxf(rm,0.f); mhat+=dl; \
        _Pragma("unroll") for(int r=0;r<16;++r){C0[r]-=dl;C1[r]-=dl;} \
        const float f=__builtin_amdgcn_exp2f(-dl); l_reg*=f; if(hi==0)wsf[r32]=f; resc=true; } } \
    SBAR(); \
    GAPB(o[0]=__builtin_amdgcn_mfma_f32_32x32x16_bf16(PAF(0),VFR(0),o[0],0,0,0), C0,0); \
    GAPB(o[1]=__builtin_amdgcn_mfma_f32_32x32x16_bf16(PAF(0),VFR(4),o[1],0,0,0), C0,4); \
    KRD(GL,0); GAPB(o[0]=__builtin_amdgcn_mfma_f32_32x32x16_bf16(PAF(1),VFR(1),o[0],0,0,0), C0,8); \
    KRD(GL,1); GAPB(o[1]=__builtin_amdgcn_mfma_f32_32x32x16_bf16(PAF(1),VFR(5),o[1],0,0,0), C0,12); \
    KRD(GL,2); GAPB(o[0]=__builtin_amdgcn_mfma_f32_32x32x16_bf16(PAF(2),VFR(2),o[0],0,0,0), C1,0); \
    KRD(GL,3); GAPB(o[1]=__builtin_amdgcn_mfma_f32_32x32x16_bf16(PAF(2),VFR(6),o[1],0,0,0), C1,4); \
    GAPB(o[0]=__builtin_amdgcn_mfma_f32_32x32x16_bf16(PAF(3),VFR(3),o[0],0,0,0), C1,8); \
    GAPB(o[1]=__builtin_amdgcn_mfma_f32_32x32x16_bf16(PAF(3),VFR(7),o[1],0,0,0), C1,12); \
    }while(0)
  int t=1;
  #define ENDW(tt) do{ if((tt)+3<NT){WAIT_BAR(2);} else if((tt)+2<NT){WAIT_BAR(1);} else {WAIT_BAR(0);} }while(0)
  for(;t<5&&t+1<NT;t+=2){
    STEP(pB0,pB1,pA0,pA1,t,(t+3<NT),(t+1<NT),(t+1<NT));       ENDW(t);   RESC(); ROT();
    STEP(pA0,pA1,pB0,pB1,t+1,(t+4<NT),(t+2<NT),(t+2<NT));     ENDW(t+1); RESC(); ROT();
  }
  #undef CMASK
  #define CMASK(P0,P1,t) do{}while(0)
  for(;t+5<NT;t+=2){
    STEP(pB0,pB1,pA0,pA1,t,true,true,true);     WAIT_BAR(2); RESC(); ROT();
    STEP(pA0,pA1,pB0,pB1,t+1,true,true,true);   WAIT_BAR(2); RESC(); ROT();
  }
  for(;t+1<NT;t+=2){
    STEP(pB0,pB1,pA0,pA1,t,(t+3<NT),(t+1<NT),(t+1<NT));       ENDW(t);   RESC(); ROT();
    STEP(pA0,pA1,pB0,pB1,t+1,(t+4<NT),(t+2<NT),(t+2<NT));     ENDW(t+1); RESC(); ROT();
  }
  #undef CMASK
  #define CMASK(P0,P1,t) do{ if((t)<4)cmask(P0,P1,(t),qrel,hi);}while(0)
  STEP(pB0,pB1,pA0,pA1,NT-1,false,false,false); RESC();
  { float sacc=pB0[0]+pB0[1]; _Pragma("unroll") for(int r=2;r<16;++r)sacc+=pB0[r]; _Pragma("unroll") for(int r=0;r<16;++r)sacc+=pB1[r]; l_reg+=sacc;
    pw0=(u32x4){PKW(pB0,0),PKW(pB0,2),PKW(pB0,4),PKW(pB0,6)};pw1=(u32x4){PKW(pB0,8),PKW(pB0,10),PKW(pB0,12),PKW(pB0,14)};pw2=(u32x4){PKW(pB1,0),PKW(pB1,2),PKW(pB1,4),PKW(pB1,6)};pw3=(u32x4){PKW(pB1,8),PKW(pB1,10),PKW(pB1,12),PKW(pB1,14)};
    SBAR(); pv(o,vb0+sl_cur,PAF(0),PAF(1),PAF(2),PAF(3)); }
  #undef PKW
  #undef PAF
  #undef VFR
  #undef PIN
  #undef MX3
  #undef GAPA
  #undef GAPB
  #undef EX
  #undef VRD
  #undef KRD
  #undef STEP
  #undef ENDW
  {auto rr=__builtin_amdgcn_permlane32_swap(__float_as_uint(l_reg),__float_as_uint(l_reg),false,false);l_reg=__uint_as_float(rr[0])+__uint_as_float(rr[1]);}
  if(hi==0)wsf[32+r32]=l_reg;asm volatile("s_waitcnt lgkmcnt(0)":::"memory");
  float rli[16];
  #pragma unroll
  for(int r=0;r<16;++r)rli[r]=__builtin_amdgcn_rcpf(wsf[32+crow(r,hi)]);
  bf16*Ow=O+(rowbase+q0+wid*QBLK)*OPITCH+h*D; const __amdgpu_buffer_rsrc_t orsrc_=__builtin_amdgcn_make_buffer_rsrc((void*)O,0,0x7fffffff,0x00020000);
  { bf16*stg=(bf16*)(shm+LDS_OST)+wid*2048;
    #pragma unroll
    for(int r=0;r<16;++r){const int orow=crow(r,hi);
      #pragma unroll
      for(int d0=0;d0<2;++d0)stg[orow*64+d0*32+r32]=__float2bfloat16(o[d0][r]*rli[r]);}
    asm volatile("s_waitcnt lgkmcnt(0)":::"memory");
    #pragma unroll
    for(int i=0;i<4;++i){const int row=i*8+(lane>>3),ch=lane&7; const u32x4 v=*(const u32x4*)(stg+row*64+ch*8); ATTN_STORE16(Ow+(long)row*OPITCH+ch*8,v);} }
  asm volatile("s_waitcnt lgkmcnt(0)\n\ts_barrier":::"memory");
  #undef DMA_K
  #undef DMA_V
  #undef POS
  #undef CINIT
  #undef CMASK
  #undef START
  #undef RESC
  #undef ROT
}
constexpr int ATTN_LDS_BYTES=LDS_BYTES;
struct AttnTensors { const bf16* Q; const bf16* K; const bf16* V; bf16* O; const float* kmean; };
struct AttnUnit { int bh; int qb; };
struct StaticOrder {
  int vcu,grid;
  __device__ __forceinline__ explicit StaticOrder(int grid_,int block):vcu((grid_%8==0)?((block%8)*(grid_/8)+block/8):block),grid(grid_){}
  __device__ __forceinline__ bool next(int i,AttnUnit&u)const{ const int item=(i>>1)*grid+vcu; if(item>=BATCH*NHEAD*8)return false; const int s=item&7; u.bh=item>>3; u.qb=(i&1)?15-s:s; return true; }
  __device__ __forceinline__ void a_ready(const AttnUnit&)const{}
  __device__ __forceinline__ void done(const AttnUnit&)const{}
};
template<class Sched,int THRL=8> __device__ __forceinline__ void attn_phase(char*lds,const AttnTensors&T,const Sched&S){
  AttnUnit u;
  for(int i=0;S.next(i,u);++i){ S.a_ready(u); attn_unit<THRL>(u.bh/NHEAD,u.bh%NHEAD,u.qb,T.Q,T.K,T.V,T.O,T.kmean,lds); S.done(u); }
}
#undef SBAR
#undef WAIT_BAR
}

constexpr int NWAVES = 8;
#ifndef MK_N_LAUNCHES
#define MK_N_LAUNCHES 1
#endif
constexpr int N_LAUNCHES = MK_N_LAUNCHES;
constexpr int PER_PHASE = 8;

constexpr int BATCH = 8, SEQ = 4096, DM = 1024, TOK = BATCH * SEQ;
constexpr int CONV_CH = 512, CONV_W = 31, ATT_W = 512, IN_COLS = 4608;
constexpr int P_HEADS = 8, P_NK = 128, P_TOPK = 16, P_E = P_HEADS * P_TOPK  , N_EXP = P_NK * P_NK;
constexpr float NORM_EPS = 1e-6f;

constexpr size_t MiB = 1u << 20;
constexpr size_t WS_CTL = 0, CTL_ZERO_BYTES = 65536;
constexpr size_t WS_KMEAN = 1 * MiB;
constexpr size_t WS_SS = 2 * MiB;
constexpr size_t WS_WIN = 4 * MiB;
constexpr size_t WS_WPW = 13 * MiB, WS_WAO = 14 * MiB;
constexpr size_t WS_WOUT = 15 * MiB;
constexpr size_t WS_WQ = 17 * MiB;
constexpr size_t WS_KEYS = 21 * MiB;
constexpr size_t WS_USC = 22 * MiB, WS_VSC = 22 * MiB + 65536;
constexpr size_t WS_UB = 24 * MiB, WS_VB = 56 * MiB;
constexpr size_t WS_H = 88 * MiB;
constexpr size_t WS_CACT = 88 * MiB;
constexpr size_t WS_EIDX = 104 * MiB, WS_GW = 120 * MiB, WS_GA = 136 * MiB;
constexpr size_t WS_ZGLU = 152 * MiB, WS_QO = 184 * MiB, WS_K = 216 * MiB, WS_V = 248 * MiB;
constexpr size_t WS_MIX = 216 * MiB;
constexpr size_t WS_QP = 152 * MiB;
constexpr size_t WS_COEF = 152 * MiB, WS_SS2 = 168 * MiB;
constexpr size_t WS_GC = 280 * MiB, WS_GATE_A = 344 * MiB;
constexpr size_t WS_X1B = 280 * MiB;
constexpr size_t WS_X8 = 344 * MiB, WS_XS = 377 * MiB;
constexpr size_t WS_END = 408 * MiB;
constexpr int CW_TMO = 0, CW_CODE = 1, CW_CONVQ = 64, CW_BAR = 4096;

constexpr int RING_OFF = 0, RING_BYTES = 131072;
constexpr int LDSCTL_OFF = RING_BYTES, MISC_OFF = LDSCTL_OFF + 320;
constexpr int LDS_BYTES = 155648;
constexpr int VT_PITCH = 144, VT_BYTES = 128 * VT_PITCH, VT_LAST_OFF = LDSCTL_OFF + 1024, P7_CNT_OFF = LDSCTL_OFF + 512;
static_assert(7 * VT_BYTES <= RING_BYTES && VT_LAST_OFF + VT_BYTES <= LDS_BYTES && MISC_OFF + 128 <= P7_CNT_OFF, "PEER v tiles");
constexpr float C8_SCALE = 4096.f;
static_assert(MISC_OFF + 128 <= LDS_BYTES, "LDS map");

#define GAS __attribute__((address_space(1)))
#define LAS __attribute__((address_space(3)))
typedef unsigned short bf16;
typedef unsigned v4u __attribute__((ext_vector_type(4)));
typedef float f32x4 __attribute__((ext_vector_type(4)));
typedef float f32x16 __attribute__((ext_vector_type(16)));
typedef short bf16x8 __attribute__((ext_vector_type(8)));
typedef __bf16 bf16x2_t __attribute__((ext_vector_type(2)));
typedef GAS unsigned gu32;
#define RLX_AGENT __ATOMIC_RELAXED, __HIP_MEMORY_SCOPE_AGENT
#define LDS_WAIT() asm volatile("s_waitcnt lgkmcnt(0)" ::: "memory")
#define VM_WAIT() asm volatile("s_waitcnt vmcnt(0)" ::: "memory")
__device__ __forceinline__ unsigned f2bf(float f) { unsigned u = __builtin_bit_cast(unsigned, f); return (u + 0x7fffu + ((u >> 16) & 1u)) >> 16; }
__device__ __forceinline__ unsigned pk2(float lo, float hi) { return f2bf(lo) | (f2bf(hi) << 16); }
__device__ __forceinline__ float bflo(unsigned u) { return __uint_as_float(u << 16); }
__device__ __forceinline__ float bfhi(unsigned u) { return __uint_as_float(u & 0xffff0000u); }

#define XB_TMO      128
#define XB_XCNT(j)  (256  + 64 * (j))
#define XB_XSUB(j)  (1280 + 64 * (j))
#define XB_XGEN(j)  (2304 + 64 * (j))
#define XB_TOP      3328
#define XB_TOPGEN   3392
#define XCD_BAR_WORDS 3456
#define XB_SPIN_CAP (1u << 18)

__device__ __forceinline__ unsigned xb_ld(unsigned* p)              { return __hip_atomic_load(p, __ATOMIC_RELAXED, __HIP_MEMORY_SCOPE_AGENT); }
__device__ __forceinline__ unsigned xb_add(unsigned* p, unsigned v) { return __hip_atomic_fetch_add(p, v, __ATOMIC_RELAXED, __HIP_MEMORY_SCOPE_AGENT); }
__device__ __forceinline__ unsigned xb_xcc_id() { return (unsigned)__builtin_amdgcn_s_getreg((3 << 11) | 20) & 0xFu; }
#define XB_SPIN(cond, bar) do { unsigned _sp = 0; while (cond) { __builtin_amdgcn_s_sleep(1); \
    if ((++_sp & 255u) == 0u) { if (xb_ld(&(bar)[XB_TMO])) break; if (_sp > XB_SPIN_CAP) { atomicAdd(&(bar)[XB_TMO], 1u); break; } } } } while (0)

struct XcdBarrier {
    unsigned* bar; unsigned x;
    volatile LAS unsigned* st;
};

__device__ __forceinline__ XcdBarrier xcd_barrier_post(unsigned* bar, volatile LAS unsigned* st) {
    XcdBarrier b; b.bar = bar; b.x = xb_xcc_id(); b.st = st;
    if (threadIdx.x == 0) (void)xb_add(&bar[XB_XCNT(b.x)], 1u);
    return b;
}
__device__ __forceinline__ void xcd_barrier_complete(unsigned* bar, unsigned x, unsigned& nloc, unsigned& nx) {
    const unsigned G = gridDim.x * gridDim.y * gridDim.z;
    unsigned sum, cnt, mine, sp = 0u;
    for (;;) {
        sum = 0u; cnt = 0u; mine = 0u;
#pragma unroll
        for (unsigned j = 0; j < 16; ++j) { const unsigned c = xb_ld(&bar[XB_XCNT(j)]); sum += c; cnt += (c > 0u) ? 1u : 0u; mine = (j == x) ? c : mine; }
        if (sum == G) break;
        __builtin_amdgcn_s_sleep(1);
        if ((++sp & 255u) == 0u) { if (xb_ld(&bar[XB_TMO])) break; if (sp > XB_SPIN_CAP) { atomicAdd(&bar[XB_TMO], 1u); break; } }
    }
    nloc = mine > 0u ? mine : 1u; nx = cnt > 0u ? cnt : 1u;
}

__device__ __forceinline__ void xcd_barrier(const XcdBarrier& b) {
    asm volatile("s_waitcnt vmcnt(0)" ::: "memory");
    __syncthreads();
    if (threadIdx.x == 0) {
        unsigned* bar = b.bar;
        __builtin_amdgcn_s_waitcnt(0);
        unsigned nloc = b.st[0], nx = b.st[1];
        if (nloc == 0u) { xcd_barrier_complete(bar, b.x, nloc, nx); b.st[0] = nloc; b.st[1] = nx; }
        const unsigned old = xb_add(&bar[XB_XSUB(b.x)], 1u);
        const unsigned gen = old / nloc;
        if (old + 1u == (gen + 1u) * nloc) {
            __builtin_amdgcn_fence(__ATOMIC_RELEASE, "agent");
            asm volatile("s_waitcnt vmcnt(0)" ::: "memory");
            const unsigned og = xb_add(&bar[XB_TOP], 1u);
            const unsigned tg = og / nx;
            if (og + 1u == (tg + 1u) * nx) xb_add(&bar[XB_TOPGEN], 1u);
            else XB_SPIN(xb_ld(&bar[XB_TOPGEN]) == tg, bar);
            __builtin_amdgcn_fence(__ATOMIC_ACQUIRE, "agent");
            xb_add(&bar[XB_XGEN(b.x)], 1u);
            asm volatile("s_waitcnt vmcnt(0)" ::: "memory");
        } else {
            XB_SPIN(xb_ld(&bar[XB_XGEN(b.x)]) == gen, bar);
            __builtin_amdgcn_fence(__ATOMIC_ACQUIRE, "agent");
            asm volatile("s_waitcnt vmcnt(0)" ::: "memory");
        }
    }
    __syncthreads();
}

struct Frame {
    LAS unsigned char* lds;
    volatile LAS unsigned* MISC;
    gu32* ctl;
    int tid, lane, wave;
    int vcu, G;
};
__device__ __forceinline__ float wave_sum(float v) {
#pragma unroll
    for (int o = 1; o < 64; o <<= 1) v += __shfl_xor(v, o);
    return v;
}

__device__ __forceinline__ float wave_sum_hi(float v) {
    v += __builtin_bit_cast(float, __builtin_amdgcn_update_dpp(0, __builtin_bit_cast(int, v), 0xB1, 0xf, 0xf, false));
    v += __builtin_bit_cast(float, __builtin_amdgcn_update_dpp(0, __builtin_bit_cast(int, v), 0x4E, 0xf, 0xf, false));
    v += __builtin_bit_cast(float, __builtin_amdgcn_update_dpp(0, __builtin_bit_cast(int, v), 0x141, 0xf, 0xf, false));
    v += __builtin_bit_cast(float, __builtin_amdgcn_update_dpp(0, __builtin_bit_cast(int, v), 0x140, 0xf, 0xf, false));
    v += __builtin_bit_cast(float, __builtin_amdgcn_update_dpp(0, __builtin_bit_cast(int, v), 0x142, 0xA, 0xF, false));
    v += __builtin_bit_cast(float, __builtin_amdgcn_update_dpp(0, __builtin_bit_cast(int, v), 0x143, 0xC, 0xF, false));
    return v;
}

__device__ __forceinline__ void p0_transpose_item(const float* W, int K, int N, bf16* WT, int k0, int n0, int dst_row0, const float* kscale, LAS float* scr, int lane, int dpitch = 0, int koff = 0) {
    if (dpitch == 0) dpitch = K;
#pragma unroll 8
    for (int i = 0; i < 32; ++i) { const int kk = 2 * i + (lane >> 5); float v = W[(size_t)(k0 + kk) * N + n0 + (lane & 31)]; if (kscale) v *= kscale[k0 + kk]; scr[kk * 33 + (lane & 31)] = v; }
    LDS_WAIT(); asm volatile("" ::: "memory");
    const int c = lane & 7;
#pragma unroll
    for (int j = 0; j < 4; ++j) { const int n = (lane >> 3) + 8 * j; const LAS float* s = scr + (8 * c) * 33 + n;
        v4u o; o.x = pk2(s[0 * 33], s[1 * 33]); o.y = pk2(s[2 * 33], s[3 * 33]); o.z = pk2(s[4 * 33], s[5 * 33]); o.w = pk2(s[6 * 33], s[7 * 33]);
        *(GAS v4u*)(WT + (size_t)(dst_row0 + n) * dpitch + koff + k0 + 8 * c) = o; }
    LDS_WAIT(); asm volatile("" ::: "memory");
}
__device__ __forceinline__ int perm_in(int s) { if (s < 512) return 256 * (s >> 7) + (s & 127); if (s < 1024) { const int s2 = s - 512; return 256 * (s2 >> 7) + 128 + (s2 & 127); } return s; }
__device__ __forceinline__ float wave_max(float v) {
#pragma unroll
    for (int o = 1; o < 64; o <<= 1) v = fmaxf(v, __shfl_xor(v, o));
    return v;
}
template <bool NORM, int NR> __device__ __forceinline__ void rows_to_bf16(int lane, const float* xrow, size_t rstride, const float* g, bf16* orow) {
    f32x4 v[NR][4]; float s2[NR];
#pragma unroll
    for (int q = 0; q < NR; ++q) { const GAS f32x4* xr = (const GAS f32x4*)(xrow + q * rstride) + lane;
#pragma unroll
        for (int j = 0; j < 4; ++j) v[q][j] = xr[64 * j]; }
#pragma unroll
    for (int q = 0; q < NR; ++q) { s2[q] = 0.f;
#pragma unroll
        for (int j = 0; j < 4; ++j) s2[q] += (v[q][j].x * v[q][j].x + v[q][j].y * v[q][j].y) + (v[q][j].z * v[q][j].z + v[q][j].w * v[q][j].w); }
    float rstd[NR];
#pragma unroll
    for (int q = 0; q < NR; ++q) rstd[q] = NORM ? 1.f / sqrtf(wave_sum(s2[q]) * (1.f / 1024.f) + NORM_EPS) : 1.f;
#pragma unroll
    for (int j = 0; j < 4; ++j) { f32x4 gv = (f32x4){1.f, 1.f, 1.f, 1.f}; if (g) gv = *((const GAS f32x4*)g + lane + 64 * j);
#pragma unroll
        for (int q = 0; q < NR; ++q) { const f32x4 w = v[q][j] * rstd[q] * gv;
            ((GAS unsigned long long*)(orow + q * rstride) + lane)[64 * j] = (unsigned long long)pk2(w.x, w.y) | ((unsigned long long)pk2(w.z, w.w) << 32); } }
}
template <bool NORM> __device__ __forceinline__ void row_to_bf16(int lane, const float* xrow, const float* g, bf16* orow) { rows_to_bf16<NORM, 1>(lane, xrow, 1024, g, orow); }
template <bool SLICED> __device__ __forceinline__ void row_to_fp8(int lane, const float* xrow, const float* g, unsigned char* base, int row, float* isc) {
    const GAS f32x4* xr = (const GAS f32x4*)xrow + lane;
    f32x4 v[4]; float am = 0.f;
#pragma unroll
    for (int j = 0; j < 4; ++j) { v[j] = xr[64 * j]; if (g) v[j] = v[j] * *((const GAS f32x4*)g + lane + 64 * j);
        am = fmaxf(am, fmaxf(fmaxf(fabsf(v[j].x), fabsf(v[j].y)), fmaxf(fabsf(v[j].z), fabsf(v[j].w)))); }
#pragma unroll
    for (int o = 1; o < 64; o <<= 1) am = fmaxf(am, __shfl_xor(am, o));
    const float sc = am > 0.f ? 240.f / am : 1.f;
    if (lane == 0) isc[row] = am > 0.f ? am * (1.f / 240.f) : 1.f;
#pragma unroll
    for (int j = 0; j < 4; ++j) { int w = 0; w = __builtin_amdgcn_cvt_pk_fp8_f32(v[j].x * sc, v[j].y * sc, w, false); w = __builtin_amdgcn_cvt_pk_fp8_f32(v[j].z * sc, v[j].w * sc, w, true);
        if (SLICED) *(GAS int*)(base + (size_t)(2 * j + (lane >> 5)) * ((size_t)N_EXP * 128) + (size_t)row * 128 + 4 * (lane & 31)) = w;
        else *(GAS int*)(base + (size_t)row * 1024 + 4 * (lane + 64 * j)) = w; }
}
__device__ __forceinline__ void rows_to_fp8_uv(int lane, const float* urow, const float* vrow, const float* g, unsigned char* ub8, unsigned char* vb8, int row, float* usc, float* vsc) {
    f32x4 u[4], v[4]; float au = 0.f, av = 0.f;
#pragma unroll
    for (int j = 0; j < 4; ++j) { u[j] = ((const GAS f32x4*)urow + lane)[64 * j]; v[j] = ((const GAS f32x4*)vrow + lane)[64 * j]; }
#pragma unroll
    for (int j = 0; j < 4; ++j) { u[j] = u[j] * *((const GAS f32x4*)g + lane + 64 * j);
        au = fmaxf(au, fmaxf(fmaxf(fabsf(u[j].x), fabsf(u[j].y)), fmaxf(fabsf(u[j].z), fabsf(u[j].w))));
        av = fmaxf(av, fmaxf(fmaxf(fabsf(v[j].x), fabsf(v[j].y)), fmaxf(fabsf(v[j].z), fabsf(v[j].w)))); }
#pragma unroll
    for (int o = 1; o < 64; o <<= 1) { au = fmaxf(au, __shfl_xor(au, o)); av = fmaxf(av, __shfl_xor(av, o)); }
    const float su = au > 0.f ? 6.f / au : 1.f, sv = av > 0.f ? 6.f / av : 1.f;
    if (lane == 0) { usc[row] = au > 0.f ? au * (1.f / 6.f) : 1.f; vsc[row] = av > 0.f ? av * (1.f / 6.f) : 1.f; }
#pragma unroll
    for (int j = 0; j < 4; ++j) {
        { const float fu[4] = {u[j].x * su, u[j].y * su, u[j].z * su, u[j].w * su}; unsigned pk = 0;
#pragma unroll
          for (int i = 0; i < 4; ++i) { const float af = fabsf(fu[i]);
              const unsigned code = (af < 0.25f ? 0u : af < 0.75f ? 1u : af < 1.25f ? 2u : af < 1.75f ? 3u : af < 2.5f ? 4u : af < 3.5f ? 5u : af < 5.f ? 6u : 7u) | (fu[i] < 0.f ? 8u : 0u);
              pk |= code << (4 * i); }
          *(GAS unsigned short*)(ub8 + (size_t)row * 512 + 2 * (lane + 64 * j)) = (unsigned short)pk; }
        { const float fv[4] = {v[j].x * sv, v[j].y * sv, v[j].z * sv, v[j].w * sv}; unsigned pk = 0;
#pragma unroll
          for (int i = 0; i < 4; ++i) { const float af = fabsf(fv[i]);
              const unsigned code = (af < 0.25f ? 0u : af < 0.75f ? 1u : af < 1.25f ? 2u : af < 1.75f ? 3u : af < 2.5f ? 4u : af < 3.5f ? 5u : af < 5.f ? 6u : 7u) | (fv[i] < 0.f ? 8u : 0u);
              pk |= code << (4 * i); }
          const int c = 4 * lane + 256 * j;
          *(GAS unsigned short*)(vb8 + (size_t)(c >> 8) * ((size_t)N_EXP * 128) + (size_t)row * 128 + ((c & 255) >> 1)) = (unsigned short)pk; } }
}
struct P0Args { const float *x, *g1, *w_in, *w_pw, *w_ao, *w_out, *g2, *w_q, *k1, *k2, *pu, *pv; bf16 *H, *Win, *Wpw, *Wao, *Wout, *Wq, *keys; unsigned char *ub8, *vb8; float *usc, *vsc; };
__device__ __forceinline__ void p0_prologue(Frame& F, const P0Args& a) {
    LAS float* scr = (LAS float*)(F.lds + RING_OFF + F.wave * 16384);
    const int gw = F.vcu * NWAVES + F.wave, NGW = F.G * NWAVES;
    constexpr int I_IN = 16 * (IN_COLS / 32), I_PW = 8 * 32, I_AO = 8 * 32, I_OUT = 16 * 32, I_Q = 16 * 64;
    constexpr int NITEMS = I_IN + I_PW + I_AO + I_OUT + I_Q;
    for (int it = gw; it < NITEMS; it += NGW) {
        int r = it;
        if (r < I_IN) { const int nb = IN_COLS / 32, kb = r / nb, n0 = 32 * (r % nb); p0_transpose_item(a.w_in, 1024, IN_COLS, a.Win, 64 * kb, n0, perm_in(n0), nullptr, scr, F.lane); continue; } r -= I_IN;
        if (r < I_PW) { const int kb = r / 32, n0 = 32 * (r % 32); p0_transpose_item(a.w_pw, 512, 1024, a.Wpw, 64 * kb, n0, n0, nullptr, scr, F.lane, 1024, 0); continue; } r -= I_PW;
        if (r < I_AO) { const int kb = r / 32, n0 = 32 * (r % 32); p0_transpose_item(a.w_ao, 512, 1024, a.Wpw, 64 * kb, n0, n0, nullptr, scr, F.lane, 1024, 512); continue; }   r -= I_AO;
        if (r < I_OUT) { const int kb = r / 32, n0 = 32 * (r % 32); p0_transpose_item(a.w_out, 1024, 1024, a.Wout, 64 * kb, n0, n0, nullptr, scr, F.lane); continue; } r -= I_OUT;
        { const int kb = r / 64, n0 = 32 * (r % 64); p0_transpose_item(a.w_q, 1024, 2048, a.Wq, 64 * kb, n0, n0, a.g2, scr, F.lane); }
    }
    for (int m = 4 * gw; m < TOK; m += 4 * NGW) rows_to_bf16<true, 4>(F.lane, a.x + (size_t)m * 1024, 1024, a.g1, a.H + (size_t)m * 1024);
    for (int m = gw; m < N_EXP; m += NGW) rows_to_fp8_uv(F.lane, a.pu + (size_t)m * 1024, a.pv + (size_t)m * 1024, a.g2, a.ub8, a.vb8, m, a.usc, a.vsc);
    for (int m = gw; m < 32; m += NGW) { const float* src = (m < 16 ? a.k1 : a.k2) + (size_t)(m & 15) * 1024; row_to_bf16<false>(F.lane, src, nullptr, a.keys + (size_t)m * 1024); }
}

struct ConvArgs { const bf16* zglu; const float *cw, *cb, *lg, *lb; bf16* cact; };
__device__ __forceinline__ void conv_phase(Frame& F, const ConvArgs& a) {
    LAS unsigned char* zs = F.lds + RING_OFF;
    LAS float* part = (LAS float*)(F.lds + RING_OFF + 98304);
    int tid_ = F.tid; asm volatile("" : "+v"(tid_));
    const int cp = tid_ & 255, half = tid_ >> 8, c0 = 2 * cp;
    float w0[CONV_W], w1[CONV_W];
    { const GAS float* p = (const GAS float*)(a.cw + c0);
#pragma unroll
      for (int w = 0; w < CONV_W; ++w) { w0[w] = p[0]; w1[w] = p[1]; p += 512; asm volatile("" : "+v"(p)); } }
    const float b0 = a.cb[c0], b1 = a.cb[c0 + 1], lg0 = a.lg[c0], lg1 = a.lg[c0 + 1], lb0 = a.lb[c0], lb1 = a.lb[c0 + 1];
    for (int tile = F.vcu; tile < TOK / 64; tile += F.G) {
        const int t0 = tile * 64, tb = t0 & (SEQ - 1);
#pragma unroll
        for (int hb = 0; hb < 2; ++hb) { v4u zv[6];
#pragma unroll
          for (int q = 0; q < 6; ++q) { const int i = tid_ + 512 * (6 * hb + q), r = i >> 6, ch = i & 63; zv[q] = (v4u){0u, 0u, 0u, 0u};
              if (i < 94 * 64 && tb - 30 + r >= 0) zv[q] = *(const GAS v4u*)(a.zglu + (size_t)(t0 - 30 + r) * 512 + ch * 8); }
#pragma unroll
          for (int q = 0; q < 6; ++q) { const int i = tid_ + 512 * (6 * hb + q), r = i >> 6, ch = i & 63; if (i < 94 * 64) *(LAS v4u*)(zs + r * 1024 + ch * 16) = zv[q]; } }
        __syncthreads();
        for (int ch8 = 0; ch8 < 4; ++ch8) {
            const int tl = half * 32 + ch8 * 8;
            float z0[38], z1[38];
#pragma unroll
            for (int i = 0; i < 38; ++i) { const unsigned u = *(const LAS unsigned*)(zs + (tl + i) * 1024 + cp * 4); z0[i] = bflo(u); z1[i] = bfhi(u); }
            float a0[8], a1[8];
#pragma unroll
            for (int k = 0; k < 8; ++k) { float s0 = b0, s1 = b1;
#pragma unroll
                for (int w = 0; w < CONV_W; ++w) { s0 += w0[w] * z0[k + w]; s1 += w1[w] * z1[k + w]; }
                a0[k] = s0; a1[k] = s1; }
#pragma unroll
            for (int k = 0; k < 8; ++k) { const float s1 = wave_sum_hi(a0[k] + a1[k]), s2 = wave_sum_hi(a0[k] * a0[k] + a1[k] * a1[k]);
                if (F.lane == 63) { part[((half * 8 + k) * 4 + (F.wave & 3)) * 2] = s1; part[((half * 8 + k) * 4 + (F.wave & 3)) * 2 + 1] = s2; } }
            __syncthreads();
            bf16* op = a.cact + (size_t)(t0 + tl) * 1024 + c0;
#pragma unroll
            for (int k = 0; k < 8; ++k) { const LAS float* p = part + (half * 8 + k) * 8;
                const float S1 = (p[0] + p[2]) + (p[4] + p[6]), S2 = (p[1] + p[3]) + (p[5] + p[7]);
                const float mean = S1 * (1.f / 512.f), var = S2 * (1.f / 512.f) - mean * mean, rstd = __builtin_amdgcn_rsqf(var + NORM_EPS);
                const float y0 = (a0[k] - mean) * rstd * lg0 + lb0, y1 = (a1[k] - mean) * rstd * lg1 + lb1;
                const float o0 = y0 * __builtin_amdgcn_rcpf(1.f + __builtin_amdgcn_exp2f(-1.4426950408889634f * y0)), o1 = y1 * __builtin_amdgcn_rcpf(1.f + __builtin_amdgcn_exp2f(-1.4426950408889634f * y1));
                *(GAS unsigned*)(op + k * 1024) = pk2(o0, o1); }
            __syncthreads();
        }
    }
}

__device__ __forceinline__ int tokey(float v) { const int b = __float_as_int(v); return b ^ ((b >> 31) & 0x7fffffff); }
__device__ __forceinline__ float unkey(int k, int mask) { const int t = k & ~mask; return __int_as_float(t ^ ((t >> 31) & 0x7fffffff)); }
__device__ __forceinline__ void ce_desc(int& a, int& b) { const int hi = a > b ? a : b, lo = a > b ? b : a; a = hi; b = lo; }
template <int N> __device__ __forceinline__ void sort_desc(int (&v)[N]) {
#pragma unroll
    for (int k = 2; k <= N; k <<= 1)
#pragma unroll
        for (int j = k >> 1; j > 0; j >>= 1)
#pragma unroll
            for (int i = 0; i < N; ++i) { const int l = i ^ j; if (l > i) { if ((i & k) == 0) ce_desc(v[i], v[l]); else ce_desc(v[l], v[i]); } }
}
__device__ __forceinline__ void bitonic_merge16_desc(int (&v)[16]) {
#pragma unroll
    for (int j = 8; j > 0; j >>= 1)
#pragma unroll
        for (int i = 0; i < 16; ++i) { const int l = i ^ j; if (l > i) ce_desc(v[i], v[l]); }
}
__device__ __forceinline__ void merge_top16(int (&a)[16], const int (&b)[16]) {
#pragma unroll
    for (int i = 0; i < 16; ++i) a[i] = a[i] > b[15 - i] ? a[i] : b[15 - i];
    bitonic_merge16_desc(a);
}
__device__ __forceinline__ void top16_of_64(const int (&x)[64], int (&out)[16]) {
    int g[16];
#pragma unroll
    for (int i = 0; i < 16; ++i) out[i] = x[i];
    sort_desc<16>(out);
#pragma unroll
    for (int q = 1; q < 4; ++q) {
#pragma unroll
        for (int i = 0; i < 16; ++i) g[i] = x[16 * q + i];
        sort_desc<16>(g); merge_top16(out, g); }
}
__device__ __forceinline__ int crow_(int r, int hi) { return (r & 3) + 8 * (r >> 2) + 4 * hi; }
struct SelArgs { const bf16* qp; const bf16* keys; const float* ss; const float* usc; const float* vsc; int* eidx; float* ga; float* gb; const bf16* x1b; unsigned char* x8; float* xs; };
__device__ __forceinline__ void peer_select_phase(Frame& F, const SelArgs& a) {
    for (int i = F.tid; i < 2 * 128 * 16; i += 512) { const int which = i >> 11, rem = i & 2047, row = rem >> 4, ch = rem & 15;
        const v4u v = *(const GAS v4u*)(a.keys + (size_t)which * 16384 + row * 128 + ch * 8);
        *(LAS v4u*)(F.lds + RING_OFF + which * 32768 + row * 256 + ((ch ^ (row & 15)) << 4)) = v; }
    __syncthreads();
    LAS int* scr = (LAS int*)(F.lds + RING_OFF + 65536 + F.wave * 4096);
    const int lane = F.lane, tl = lane & 31, hi = lane >> 5;
    const int gw = F.vcu * NWAVES + F.wave, NGW = F.G * NWAVES;
    constexpr int NUNITS = (TOK / 32) * P_HEADS;
    constexpr int PA[50] = {0,0,0,0,0,0,0,0,0,0,0,0,0,0,0,0, 1,1,1,1,1,1,1,1, 2,2,2,2,2, 3,3,3,3, 4,4,4, 5,5, 6,6, 7,7, 8,9,10,11,12,13,14,15};
    constexpr int PB[50] = {0,1,2,3,4,5,6,7,8,9,10,11,12,13,14,15, 0,1,2,3,4,5,6,7, 0,1,2,3,4, 0,1,2,3, 0,1,2, 0,1, 0,1, 0,1, 0,0,0,0,0,0,0,0};
    for (int unit = gw; unit < NUNITS; unit += NGW) {
        const int tt = unit >> 3, hh = unit & 7, t = tt * 32 + tl;
        int vk[2][16];
#pragma unroll
        for (int half = 0; half < 2; ++half) {
            const bf16* qrow = a.qp + (size_t)t * 2048 + hh * 256 + half * 128 + hi * 8;
            bf16x8 bq[8];
#pragma unroll
            for (int ks = 0; ks < 8; ++ks) bq[ks] = *(const GAS bf16x8*)(qrow + ks * 16);
            f32x16 acc[4];
#pragma unroll
            for (int nb = 0; nb < 4; ++nb) { acc[nb] = (f32x16){};
#pragma unroll
                for (int ks = 0; ks < 8; ++ks) { const int row = nb * 32 + tl, ch = 2 * ks + hi;
                    const bf16x8 ka = *(const LAS bf16x8*)(F.lds + RING_OFF + half * 32768 + row * 256 + ((ch ^ (row & 15)) << 4));
                    acc[nb] = __builtin_amdgcn_mfma_f32_32x32x16_bf16(ka, bq[ks], acc[nb], 0, 0, 0); } }
            int keys[64];
#pragma unroll
            for (int nb = 0; nb < 4; ++nb)
#pragma unroll
                for (int r = 0; r < 16; ++r) keys[nb * 16 + r] = (tokey(acc[nb][r]) & ~127) | (nb * 32 + crow_(r, hi));
            int top[16]; top16_of_64(keys, top);
            int oth[16];
#pragma unroll
            for (int i = 0; i < 16; ++i) oth[i] = __shfl_xor(top[i], 32);
            merge_top16(top, oth);
#pragma unroll
            for (int i = 0; i < 16; ++i) vk[half][i] = top[i];
        }
        float f1[16], f2[16];
#pragma unroll
        for (int i = 0; i < 16; ++i) { f1[i] = unkey(vk[0][i], 127); f2[i] = unkey(vk[1][i], 127); }
        int ck[64];
#pragma unroll
        for (int i = 0; i < 50; ++i) ck[i] = (tokey(f1[PA[i]] + f2[PB[i]]) & ~255) | (PA[i] * 16 + PB[i]);
#pragma unroll
        for (int i = 50; i < 64; ++i) ck[i] = (int)0x80000000;
        int c[16]; top16_of_64(ck, c);
        if (hi == 0) {
#pragma unroll
            for (int i = 0; i < 16; ++i) { scr[tl * 32 + i] = vk[0][i] & 127; scr[tl * 32 + 16 + i] = vk[1][i] & 127; } }
        float ssum = 0.f;
        { const GAS f32x4* sp = (const GAS f32x4*)(a.ss + (size_t)t * 16);
#pragma unroll
          for (int i = 0; i < 4; ++i) { const f32x4 v = sp[i]; ssum += (v.x + v.y) + (v.z + v.w); } }
        const float rstd = 1.f / sqrtf(ssum * (1.f / 1024.f) + NORM_EPS);
        const float smax = unkey(c[0], 255);
        float e[16], esum = 0.f;
#pragma unroll
        for (int i = 0; i < 16; ++i) { e[i] = __expf((unkey(c[i], 255) - smax) * rstd); esum += e[i]; }
        const float inv = 1.f / esum;
        LDS_WAIT(); asm volatile("" ::: "memory");
        int eo[8]; float go[8];
#pragma unroll
        for (int i = 0; i < 8; ++i) { const int ci = hi ? c[i + 8] : c[i]; const float ei = hi ? e[i + 8] : e[i];
            const int id = ci & 255, i1 = scr[tl * 32 + (id >> 4)], i2 = scr[tl * 32 + 16 + (id & 15)];
            eo[i] = i1 * P_NK + i2; go[i] = ei * inv; }
        float ua[8];
#pragma unroll
        for (int i = 0; i < 8; ++i) { ua[i] = a.usc[eo[i]]; go[i] *= a.vsc[eo[i]]; }
        int* ep = a.eidx + (size_t)t * P_E + hh * 16 + hi * 8; float* gp = a.gb + (size_t)t * P_E + hh * 16 + hi * 8; float* up_ = a.ga + (size_t)t * P_E + hh * 16 + hi * 8;
        *(GAS f32x4*)(up_) = (f32x4){ua[0], ua[1], ua[2], ua[3]}; *(GAS f32x4*)(up_ + 4) = (f32x4){ua[4], ua[5], ua[6], ua[7]};
        *(GAS v4u*)(ep) = (v4u){(unsigned)eo[0], (unsigned)eo[1], (unsigned)eo[2], (unsigned)eo[3]}; *(GAS v4u*)(ep + 4) = (v4u){(unsigned)eo[4], (unsigned)eo[5], (unsigned)eo[6], (unsigned)eo[7]};
        *(GAS f32x4*)(gp) = (f32x4){go[0], go[1], go[2], go[3]}; *(GAS f32x4*)(gp + 4) = (f32x4){go[4], go[5], go[6], go[7]};
        LDS_WAIT(); asm volatile("" ::: "memory");
    }
}

__device__ __forceinline__ void peer_rows_fp8(Frame& F, const SelArgs& a) {
    const int gw = F.vcu * NWAVES + F.wave, NGW = F.G * NWAVES, lane = F.lane;
    for (int t = gw; t < TOK; t += NGW) {
        const GAS v4u* xp = (const GAS v4u*)(a.x1b + (size_t)t * 1024 + 16 * lane); const v4u xa = xp[0], xb = xp[1];
        const float xf[16] = {bflo(xa.x), bfhi(xa.x), bflo(xa.y), bfhi(xa.y), bflo(xa.z), bfhi(xa.z), bflo(xa.w), bfhi(xa.w), bflo(xb.x), bfhi(xb.x), bflo(xb.y), bfhi(xb.y), bflo(xb.z), bfhi(xb.z), bflo(xb.w), bfhi(xb.w)};
        float am = 0.f;
#pragma unroll
        for (int i = 0; i < 16; ++i) am = fmaxf(am, fabsf(xf[i]));
#pragma unroll
        for (int o = 1; o < 64; o <<= 1) am = fmaxf(am, __shfl_xor(am, o));
        const float xsc = am > 0.f ? 240.f / am : 1.f, xinv = am > 0.f ? am * (1.f / 240.f) : 1.f;
        v4u o;
        { int w = 0; w = __builtin_amdgcn_cvt_pk_fp8_f32(xf[0] * xsc, xf[1] * xsc, w, false); w = __builtin_amdgcn_cvt_pk_fp8_f32(xf[2] * xsc, xf[3] * xsc, w, true); o.x = (unsigned)w; }
        { int w = 0; w = __builtin_amdgcn_cvt_pk_fp8_f32(xf[4] * xsc, xf[5] * xsc, w, false); w = __builtin_amdgcn_cvt_pk_fp8_f32(xf[6] * xsc, xf[7] * xsc, w, true); o.y = (unsigned)w; }
        { int w = 0; w = __builtin_amdgcn_cvt_pk_fp8_f32(xf[8] * xsc, xf[9] * xsc, w, false); w = __builtin_amdgcn_cvt_pk_fp8_f32(xf[10] * xsc, xf[11] * xsc, w, true); o.z = (unsigned)w; }
        { int w = 0; w = __builtin_amdgcn_cvt_pk_fp8_f32(xf[12] * xsc, xf[13] * xsc, w, false); w = __builtin_amdgcn_cvt_pk_fp8_f32(xf[14] * xsc, xf[15] * xsc, w, true); o.w = (unsigned)w; }
        *(GAS v4u*)(a.x8 + (size_t)t * 1024 + 16 * lane) = o;
        const float ssum = wave_sum(lane < 16 ? a.ss[(size_t)t * 16 + lane] : 0.f);
        if (lane == 0) a.xs[t] = xinv / sqrtf(ssum * (1.f / 1024.f) + NORM_EPS);
    }
}

typedef float f32x2_t __attribute__((ext_vector_type(2)));
struct ExpA { const unsigned char* x8; const float* xs; const unsigned char* ub8; const int* eidx; const float* ga; const float* gb; unsigned char* coef8; };
__device__ __forceinline__ float row_sum16(float v) {
    v += __builtin_bit_cast(float, __builtin_amdgcn_update_dpp(0, __builtin_bit_cast(int, v), 0xB1, 0xf, 0xf, false));
    v += __builtin_bit_cast(float, __builtin_amdgcn_update_dpp(0, __builtin_bit_cast(int, v), 0x4E, 0xf, 0xf, false));
    v += __builtin_bit_cast(float, __builtin_amdgcn_update_dpp(0, __builtin_bit_cast(int, v), 0x141, 0xf, 0xf, false));
    v += __builtin_bit_cast(float, __builtin_amdgcn_update_dpp(0, __builtin_bit_cast(int, v), 0x140, 0xf, 0xf, false));
    return v;
}
__device__ __forceinline__ float gelu_as(float v) {
    const float av = fabsf(v), t = __builtin_amdgcn_rcpf(av * 0.2316418882f + 1.0f);
    float q = t * 0.5307027145f + (-0.7265760135f); q = q * t + 0.7107068705f; q = q * t + (-0.142248368f); q = q * t + 0.127414796f; q = q * t;
    const float m = v * (q * __builtin_amdgcn_exp2f((v * v) * (-0.72134752044f)));
    return v < 0.f ? m : v - m;
}
__device__ __forceinline__ float wave_sum_diag(float v) {
    v = row_sum16(v);
    v += __builtin_bit_cast(float, __builtin_amdgcn_update_dpp(0, __builtin_bit_cast(int, v), 0x142, 0xA, 0xF, false));
    v += __builtin_bit_cast(float, __builtin_amdgcn_update_dpp(0, __builtin_bit_cast(int, v), 0x143, 0xC, 0xF, false));
    return v;
}
__device__ __forceinline__ int wg_grab(LAS int* c, const int lane) {
    int v = 0; if (lane == 0) v = __hip_atomic_fetch_add(c, 1, __ATOMIC_RELAXED, __HIP_MEMORY_SCOPE_WORKGROUP);
    return __builtin_amdgcn_readfirstlane(v);
}
typedef int v2i_t __attribute__((ext_vector_type(2)));
typedef int v8i_t __attribute__((ext_vector_type(8)));
__device__ __forceinline__ void peer_u_phase(Frame& F, const ExpA& a, const int s, const int tfirst, const int step, LAS int* cnt) {
    const int lane = F.lane, q = lane >> 4, jn = lane & 15, half = lane >> 5, c32 = lane & 31;
    if (tfirst >= TOK) return;
    constexpr int UP = 528;
    LAS unsigned char* wb = F.lds + (F.wave < 7 ? F.wave * VT_BYTES : VT_LAST_OFF);
    static_assert(16 * UP + 2 * 1024 + 2 * 1536 <= VT_BYTES, "u-side LDS");
    LAS unsigned char* twr = wb + half * UP + 16 * c32;
    LAS unsigned char* tra = wb + jn * UP + 16 * q;
    const GAS unsigned char* ubase = (const GAS unsigned char*)a.ub8; const unsigned lane16c = 16u * (unsigned)c32;
    const int padent = s << 21;
#define UX(P) (wb + 16 * UP + 1024 * (P))
#define UL(P) ((LAS int*)(wb + 16 * UP + 2048 + 1536 * (P)))
    struct Raw { v4u x; int e0, e1; float fa0, fa1, fb0, fb1, xs; };
#define PU_RAW(R, T) do { const int tt_ = (T) < TOK ? (T) : tfirst; R.x = *(const GAS v4u*)(a.x8 + (size_t)tt_ * 1024 + 16 * lane); \
        R.e0 = a.eidx[(size_t)tt_ * P_E + lane]; R.e1 = a.eidx[(size_t)tt_ * P_E + 64 + lane]; R.fa0 = a.ga[(size_t)tt_ * P_E + lane]; R.fa1 = a.ga[(size_t)tt_ * P_E + 64 + lane]; \
        R.fb0 = a.gb[(size_t)tt_ * P_E + lane]; R.fb1 = a.gb[(size_t)tt_ * P_E + 64 + lane]; R.xs = a.xs[tt_]; } while (0)
#define PU_PREP(R, P, N, VALID) do { LAS int* LST = UL(P); \
        const bool in0_ = (VALID) && (R.e0 >> 11) == s, in1_ = (VALID) && (R.e1 >> 11) == s; \
        const unsigned long long m0_ = __ballot(in0_), m1_ = __ballot(in1_), lt_ = (1ull << lane) - 1ull; \
        const int n0_ = __popcll(m0_); N = n0_ + __popcll(m1_); \
        LAS float* lsa_ = (LAS float*)(LST + 128); LAS float* lsb_ = (LAS float*)(LST + 256); \
        if (N + lane < 128) LST[N + lane] = padent; if (N + 64 + lane < 128) LST[N + 64 + lane] = padent; \
        if (in0_) { const int p = __popcll(m0_ & lt_); LST[p] = lane | (R.e0 << 10); lsa_[p] = R.fa0 * R.xs; lsb_[p] = R.fb0; } \
        if (in1_) { const int p = n0_ + __popcll(m1_ & lt_); LST[p] = (64 + lane) | (R.e1 << 10); lsa_[p] = R.fa1 * R.xs; lsb_[p] = R.fb1; } \
        *(LAS v4u*)(UX(P) + 16 * lane) = R.x; } while (0)
#define PU_ISSUE(W, P, B) do { _Pragma("unroll") for (int u = 0; u < 8; ++u) { const unsigned ent_ = (unsigned)UL(P)[16 * (B) + 2 * u + half]; \
        W[u] = *(const GAS v4u*)(ubase + (((ent_ >> 1) & 0xFFFFFE00u) | lane16c)); } } while (0)
#define PU_COMP(W, P, B, N, T) do { \
        _Pragma("unroll") for (int u = 0; u < 8; ++u) *(LAS v4u*)(twr + u * (2 * UP)) = W[u]; \
        f32x4 acc = {0.f, 0.f, 0.f, 0.f}; \
        _Pragma("unroll") for (int kk = 0; kk < 8; ++kk) { const v4u ar = *(const LAS v4u*)(tra + 64 * kk); \
            const v4u xl = *(const LAS v4u*)(UX(P) + 128 * kk + 16 * q), xh = *(const LAS v4u*)(UX(P) + 128 * kk + 64 + 16 * q);     \
            const v8i_t av = {(int)ar.x, (int)ar.y, (int)ar.z, (int)ar.w, 0, 0, 0, 0}, bv = {(int)xl.x, (int)xl.y, (int)xl.z, (int)xl.w, (int)xh.x, (int)xh.y, (int)xh.z, (int)xh.w}; \
            acc = __builtin_amdgcn_mfma_scale_f32_16x16x128_f8f6f4(av, bv, acc, 4, 0, 0, 0, 0, 0); } \
        const float du = (jn & 2) ? ((jn & 1) ? acc[3] : acc[2]) : ((jn & 1) ? acc[1] : acc[0]); \
        const int ku = 16 * (B) + 4 * q + (jn & 3); \
        if (jn < 4 && ku < N) { LAS int* LST = UL(P); const int slot = LST[ku] & 127; \
            const float cf_ = C8_SCALE * ((LAS float*)(LST + 256))[ku] * gelu_as(du * ((LAS float*)(LST + 128))[ku]); \
            a.coef8[(size_t)(T) * P_E + slot] = (unsigned char)__builtin_amdgcn_cvt_pk_fp8_f32(fminf(fmaxf(cf_, -448.f), 448.f), 0.f, 0, false); } } while (0)
    const int ntok = (TOK - tfirst + step - 1) / step;
#define PU_TOK(i) ((i) < ntok ? tfirst + (i) * step : TOK)
    Raw raw; int nA = 0, nB = 0;
    v4u wA0[8], wA1[8], wB0[8], wB1[8];
    int iA = wg_grab(cnt, lane), iB = wg_grab(cnt, lane), iC = wg_grab(cnt, lane);
    if (iA >= ntok) return;
    PU_RAW(raw, PU_TOK(iA)); PU_PREP(raw, 0, nA, true);
    PU_RAW(raw, PU_TOK(iB));
    PU_ISSUE(wA0, 0, 0); if (nA > 16) PU_ISSUE(wA1, 0, 1);
    PU_PREP(raw, 1, nB, iB < ntok);
    PU_RAW(raw, PU_TOK(iC));
    for (;;) {
        PU_ISSUE(wB0, 1, 0); if (nB > 16) PU_ISSUE(wB1, 1, 1);
        { const int tA = PU_TOK(iA);
          PU_COMP(wA0, 0, 0, nA, tA);
          if (nA > 16) PU_COMP(wA1, 0, 1, nA, tA);
          for (int b = 2; 16 * b < nA; ++b) { PU_ISSUE(wA0, 0, b); PU_COMP(wA0, 0, b, nA, tA); } }
        if (iB >= ntok) break;
        const int iD = wg_grab(cnt, lane);
        PU_PREP(raw, 0, nA, iC < ntok);
        PU_RAW(raw, PU_TOK(iD));
        PU_ISSUE(wA0, 0, 0); if (nA > 16) PU_ISSUE(wA1, 0, 1);
        { const int tB = PU_TOK(iB);
          PU_COMP(wB0, 1, 0, nB, tB);
          if (nB > 16) PU_COMP(wB1, 1, 1, nB, tB);
          for (int b = 2; 16 * b < nB; ++b) { PU_ISSUE(wB0, 1, b); PU_COMP(wB0, 1, b, nB, tB); } }
        if (iC >= ntok) break;
        const int iE = wg_grab(cnt, lane);
        PU_PREP(raw, 1, nB, iD < ntok);
        PU_RAW(raw, PU_TOK(iE));
        iA = iC; iB = iD; iC = iE;
    }
#undef PU_TOK
#undef PU_RAW
#undef PU_PREP
#undef PU_ISSUE
#undef PU_COMP
#undef UX
#undef UL
}
struct ExpB { float* xio; const bf16* x1b; const unsigned char* vb8; const int* eidx; const unsigned char* coef8; float* ss2; };
constexpr int V_SLICES = 4;
__device__ __forceinline__ void peer_v_phase(Frame& F, const ExpB& a, const int s, const int t0, const int step, LAS int* cnt) {
    const int lane = F.lane, g = lane >> 3, j = lane & 7, q = lane >> 4, jn = lane & 15;
    const GAS unsigned char* vs = (const GAS unsigned char*)a.vb8 + (size_t)s * ((size_t)N_EXP * 128); const unsigned j16 = 16u * (unsigned)j;
    if (t0 >= TOK) return;
    LAS unsigned char* tile = F.lds + (F.wave < 7 ? F.wave * VT_BYTES : VT_LAST_OFF);
    LAS unsigned char* wbase = tile + g * (16 * VT_PITCH) + 16 * j;
    LAS unsigned char* rbase = tile + (32 * q + jn) * VT_PITCH;
    const int chA = 256 * s + 64 * q + jn;
#define PV_LDE(E, T) do { const int tt_ = (T) < TOK ? (T) : t0; const GAS v4u* ep_ = (const GAS v4u*)(a.eidx + (size_t)tt_ * P_E + 16 * g); \
        _Pragma("unroll") for (int k4 = 0; k4 < 4; ++k4) { const v4u ev = ep_[k4]; E[4 * k4] = (int)ev.x; E[4 * k4 + 1] = (int)ev.y; E[4 * k4 + 2] = (int)ev.z; E[4 * k4 + 3] = (int)ev.w; } } while (0)
#define PV_ROWS(W, E, C8, X, T) do { const int tt_ = (T) < TOK ? (T) : t0; _Pragma("unroll") for (int k = 0; k < 16; ++k) W[k] = *(const GAS v4u*)(vs + (((unsigned)E[k] << 7) | j16)); \
        { const GAS v4u* cp_ = (const GAS v4u*)(a.coef8 + (size_t)tt_ * P_E + 16 * q); C8[0] = cp_[0]; C8[1] = cp_[4]; }   \
        { const GAS bf16* xp_ = (const GAS bf16*)(a.x1b + (size_t)tt_ * 1024 + chA); _Pragma("unroll") for (int i = 0; i < 4; ++i) X[i] = xp_[16 * i]; } } while (0)
#define PV_COMP(W, C8, X, T) do { \
        _Pragma("unroll") for (int k = 0; k < 16; ++k) *(LAS v4u*)(wbase + k * VT_PITCH) = W[k]; \
        const v8i_t av = {(int)C8[0].x, (int)C8[0].y, (int)C8[0].z, (int)C8[0].w, (int)C8[1].x, (int)C8[1].y, (int)C8[1].z, (int)C8[1].w}; \
        float y[4] = {0.f, 0.f, 0.f, 0.f}; \
        _Pragma("unroll") for (int ct = 0; ct < 16; ++ct) { \
            const v2i_t b0 = __builtin_amdgcn_ds_read_tr4_b64_v2i32((LAS v2i_t*)(rbase + 8 * ct)), b1 = __builtin_amdgcn_ds_read_tr4_b64_v2i32((LAS v2i_t*)(rbase + 16 * VT_PITCH + 8 * ct)); \
            const v8i_t bv = {b0.x, b0.y, b1.x, b1.y, 0, 0, 0, 0}; \
            const f32x4 d_ = __builtin_amdgcn_mfma_scale_f32_16x16x128_f8f6f4(av, bv, (f32x4){0.f, 0.f, 0.f, 0.f}, 0, 4, 0, 0, 0, 0); \
            y[ct & 3] = (q == (ct >> 2)) ? d_[0] : y[ct & 3]; } \
        float sq = 0.f; \
        _Pragma("unroll") for (int i = 0; i < 4; ++i) { const float o_ = bflo((unsigned)X[i]) + y[i] * (1.f / C8_SCALE); a.xio[(size_t)(T) * 1024 + chA + 16 * i] = o_; sq += o_ * o_; } \
        sq = row_sum16(sq); \
        sq += __shfl_xor(sq, 16); sq += __shfl_xor(sq, 32); \
        if (lane == 0) a.ss2[(size_t)(T) * V_SLICES + s] = sq; } while (0)
    int e1[16], e2[16]; v4u wA[16], wB[16], c8A[2], c8B[2]; bf16 xA[4], xB[4];
    const int ntok = (TOK - t0 + step - 1) / step;
#define PV_TOK(i) ((i) < ntok ? t0 + (i) * step : TOK)
    int iA = wg_grab(cnt, lane), iB = wg_grab(cnt, lane);
    if (iA >= ntok) return;
    PV_LDE(e1, PV_TOK(iA));
    PV_LDE(e2, PV_TOK(iB));
    PV_ROWS(wA, e1, c8A, xA, PV_TOK(iA));
    for (;;) {
        const int iC = wg_grab(cnt, lane);
        PV_LDE(e1, PV_TOK(iC));
        PV_ROWS(wB, e2, c8B, xB, PV_TOK(iB));
        PV_COMP(wA, c8A, xA, PV_TOK(iA));
        if (iB >= ntok) break;
        const int iD = wg_grab(cnt, lane);
        PV_LDE(e2, PV_TOK(iD));
        PV_ROWS(wA, e1, c8A, xA, PV_TOK(iC));
        PV_COMP(wB, c8B, xB, PV_TOK(iB));
        if (iC >= ntok) break;
        iA = iC; iB = iD;
    }
#undef PV_TOK
#undef PV_LDE
#undef PV_ROWS
#undef PV_COMP
}
__device__ __forceinline__ void final_norm_phase(Frame& F, float* xio, const float* ss2, const float* gfinal, const int gw, const int NGW) {
    const int lane = F.lane;
    for (int t = gw; t < TOK; t += NGW) {
        const f32x4 s0 = *(const GAS f32x4*)(ss2 + (size_t)t * V_SLICES); static_assert(V_SLICES == 4, "ss2 row");
        const float rstd = 1.f / sqrtf(((s0.x + s0.y) + (s0.z + s0.w)) * (1.f / 1024.f) + NORM_EPS);
        GAS f32x4* xr = (GAS f32x4*)(xio + (size_t)t * 1024) + lane; const GAS f32x4* gf = (const GAS f32x4*)gfinal + lane;
#pragma unroll
        for (int q = 0; q < 4; ++q) xr[64 * q] = xr[64 * q] * rstd * gf[64 * q];
    }
}

struct Args { const float* in[18]; float* out; unsigned char* ws; int ph_lo, ph_hi, li, pad; };
__global__ void __launch_bounds__(NWAVES * 64, 2) fwd_kernel(Args args) {
    extern __shared__ __attribute__((aligned(16))) unsigned char lds[];
    Frame F;
    F.lds = (LAS unsigned char*)lds;
    F.MISC = (volatile LAS unsigned*)(F.lds + MISC_OFF);
    F.tid = threadIdx.x; F.lane = F.tid & 63; F.wave = __builtin_amdgcn_readfirstlane(F.tid >> 6);
    F.G = gridDim.x; { const int bx = blockIdx.x; F.vcu = (F.G % 8 == 0) ? (bx % 8) * (F.G / 8) + bx / 8 : bx; }
    unsigned char* ws = args.ws;
    F.ctl = (gu32*)(ws + WS_CTL);
#define GRID_BAR(seam) do { if (N_LAUNCHES == PER_PHASE) { if (F.tid == 0) __hip_atomic_store(F.ctl + CW_TMO, 0xBADBA0u | (unsigned)(seam), RLX_AGENT); } else { xcd_barrier(bar); } } while (0)
    const float* x = args.in[0];
    bf16* H = (bf16*)(ws + WS_H); bf16* Win = (bf16*)(ws + WS_WIN); bf16* Wpw = (bf16*)(ws + WS_WPW); bf16* Wao = (bf16*)(ws + WS_WAO); bf16* Wout = (bf16*)(ws + WS_WOUT); bf16* Wq = (bf16*)(ws + WS_WQ);
    bf16* KEYS = (bf16*)(ws + WS_KEYS); unsigned char* UB = ws + WS_UB; unsigned char* VB = ws + WS_VB; float* USC = (float*)(ws + WS_USC); float* VSC = (float*)(ws + WS_VSC);
    bf16* ZGLU = (bf16*)(ws + WS_ZGLU); bf16* QO = (bf16*)(ws + WS_QO); bf16* KB = (bf16*)(ws + WS_K); bf16* VBUF = (bf16*)(ws + WS_V); bf16* GC = (bf16*)(ws + WS_GC); bf16* GA = (bf16*)(ws + WS_GATE_A);
    bf16* CACT = (bf16*)(ws + WS_CACT); bf16* MIX = (bf16*)(ws + WS_MIX); bf16* X1B = (bf16*)(ws + WS_X1B); bf16* QP = (bf16*)(ws + WS_QP);
    float* KMEAN = (float*)(ws + WS_KMEAN); float* SS = (float*)(ws + WS_SS); int* EIDX = (int*)(ws + WS_EIDX); float* GW = (float*)(ws + WS_GW);
    for (int u = F.tid; u < (LDS_BYTES - LDSCTL_OFF) / 4; u += NWAVES * 64) ((LAS unsigned*)(F.lds + LDSCTL_OFF))[u] = 0u;
    __syncthreads();
    XcdBarrier bar; bar.bar = (unsigned*)(F.ctl + CW_BAR); bar.x = 0; bar.st = nullptr;
    if (N_LAUNCHES != PER_PHASE) bar = xcd_barrier_post((unsigned*)(F.ctl + CW_BAR), F.MISC + 8);
    const int lo = args.ph_lo, hi = args.ph_hi;
#ifdef TIME_PHASE
    unsigned long long ts_[PER_PHASE + 1]; ts_[0] = __builtin_amdgcn_s_memrealtime();
#define STAMP(k) ts_[(k) + 1] = __builtin_amdgcn_s_memrealtime()
#else
#define STAMP(k) do {} while (0)
#endif
#ifndef PHASE_MASK
#define PHASE_MASK 0xff
#endif
#define IN(k) (((PHASE_MASK >> (k)) & 1) && lo <= (k) && (k) < hi)
#define BOTH(k) (IN(k) && IN((k) + 1))

    if (IN(0)) {
        P0Args a{x, args.in[1], args.in[2], args.in[7], args.in[9], args.in[10], args.in[11], args.in[12], args.in[13], args.in[14], args.in[15], args.in[16], H, Win, Wpw, Wao, Wout, Wq, KEYS, UB, VB, USC, VSC};
        p0_prologue(F, a);
        if (BOTH(0)) GRID_BAR(0);
        STAMP(0);
    }
#ifdef DEBUG_P1_PLAIN
    if (IN(1)) {
        pg8::Gemm g{H, Wq, TOK, 2048, 1024}; pg8::StaticOrder S; S.init(TOK, 2048, F.G, (int)blockIdx.x);
        pg8::EpiStore E{QP, 2048};
        pg8::gemm_phase<pg8::EpiStore, pg8::StaticOrder, true, true>(F.lds + RING_OFF, g, S, E);
    }
#else
    if (IN(1)) {
        pg8::Gemm g{H, Win, TOK, IN_COLS, 1024}; pg8::StaticOrder S; S.init(TOK, IN_COLS, F.G, (int)blockIdx.x);
        pg8::EpiIn E{ZGLU, QO, GC, KMEAN, attn_body::C2, (size_t)(WS_K - WS_QO) / 2, (size_t)(WS_GATE_A - WS_GC) / 2};
        static_assert(WS_V - WS_K == WS_K - WS_QO, "Q|K|V equally spaced");
        pg8::gemm_phase<pg8::EpiIn, pg8::StaticOrder, true, true>(F.lds + RING_OFF, g, S, E);
        if (BOTH(1)) GRID_BAR(1);
        STAMP(1);
    }
#endif
    if (IN(2)) {
        static_assert(attn_body::ATTN_LDS_BYTES <= RING_BYTES && attn_body::ATTN_PITCH == ATT_W, "attention body geometry vs frame");
#ifdef CONV_FIRST
        { const ConvArgs ca{ZGLU, args.in[3], args.in[4], args.in[5], args.in[6], CACT};
          conv_phase(F, ca); }
        __syncthreads();
#ifdef TIME_SPLIT2
        ts_[3] = __builtin_amdgcn_s_memrealtime();
#endif
#endif
        const attn_body::AttnTensors AT{(const attn_body::bf16*)QO, (const attn_body::bf16*)KB, (const attn_body::bf16*)VBUF, (attn_body::bf16*)(CACT + 512), KMEAN};
        const attn_body::StaticOrder S((int)F.G, (int)blockIdx.x);
        attn_body::attn_phase<attn_body::StaticOrder>((char*)lds + RING_OFF, AT, S);
        __syncthreads();
#ifndef CONV_FIRST
        { const ConvArgs ca{ZGLU, args.in[3], args.in[4], args.in[5], args.in[6], CACT};
          conv_phase(F, ca); }
#endif
        if (BOTH(2)) GRID_BAR(2);
#if !(defined(TIME_SPLIT2) && defined(CONV_FIRST))
        STAMP(2);
#endif
    }
    if (IN(3)) {
        { pg8::Gemm g{CACT, Wpw, TOK, 1024, 1024}; pg8::StaticOrder S; S.init(TOK, 1024, F.G, (int)blockIdx.x);
          pg8::EpiMixF E{GC, GA, args.in[8], MIX};
          pg8::gemm_phase<pg8::EpiMixF, pg8::StaticOrder, true, true>(F.lds + RING_OFF, g, S, E); }
        if (BOTH(3)) GRID_BAR(3);
        STAMP(3);
    }
    if (IN(4)) {
        pg8::Gemm g{MIX, Wout, TOK, 1024, 1024}; pg8::StaticOrder S; S.init(TOK, 1024, F.G, (int)blockIdx.x);
        pg8::EpiX1 E{x, args.out, X1B, SS};
        pg8::gemm_phase<pg8::EpiX1, pg8::StaticOrder, true, true>(F.lds + RING_OFF, g, S, E);
        if (BOTH(4)) GRID_BAR(4);
        STAMP(4);
    }
    if (IN(5)) {
        pg8::Gemm g{X1B, Wq, TOK, 2048, 1024}; pg8::StaticOrder S; S.init(TOK, 2048, F.G, (int)blockIdx.x);
        pg8::EpiStore E{QP, 2048};
        pg8::gemm_phase<pg8::EpiStore, pg8::StaticOrder, true, true>(F.lds + RING_OFF, g, S, E);
        if (BOTH(5)) GRID_BAR(5);
        STAMP(5);
    }
    if (IN(6)) {
        const SelArgs sa{QP, KEYS, SS, USC, VSC, EIDX, (float*)(ws + WS_GA), GW, X1B, ws + WS_X8, (float*)(ws + WS_XS)};
        peer_select_phase(F, sa);
        peer_rows_fp8(F, sa);
        if (BOTH(6)) GRID_BAR(6);
        STAMP(6);
    }
    if (IN(7)) {
        LAS int* cnt = (LAS int*)(F.lds + P7_CNT_OFF);
        if (F.tid < 16) cnt[F.tid] = 0;
        __syncthreads();
        const ExpA ea{ws + WS_X8, (const float*)(ws + WS_XS), UB, EIDX, (const float*)(ws + WS_GA), GW, ws + WS_COEF};
        for (int s = 0; s < 8; ++s) peer_u_phase(F, ea, s, F.vcu, F.G, cnt + s);
        VM_WAIT(); __syncthreads();
#ifdef TIME_V
        const unsigned long long tv0_ = __builtin_amdgcn_s_memrealtime();
#endif
        const ExpB eb{args.out, X1B, VB, EIDX, ws + WS_COEF, (float*)(ws + WS_SS2)};
        for (int s = 0; s < V_SLICES; ++s) peer_v_phase(F, eb, s, F.vcu, F.G, cnt + 8 + s);
        VM_WAIT(); __syncthreads();
#ifdef TIME_V
        const float tvv_ = (float)(__builtin_amdgcn_s_memrealtime() - tv0_) * (0.01f / TIME_V);
#endif
        final_norm_phase(F, args.out, (const float*)(ws + WS_SS2), args.in[17], F.vcu + F.G * F.wave, F.G * NWAVES);
#ifdef UNIT_MFMA4
        __syncthreads();
        if (blockIdx.x == 0 && F.wave == 0) {
            typedef int v8i_ __attribute__((ext_vector_type(8)));
            const int lane = F.lane, qq = lane >> 4;
            const v8i_ av = {0x38383838, 0x38383838, 0x38383838, 0x38383838, 0x38383838, 0x38383838, 0x38383838, 0x38383838};
            v8i_ bv = {0x22222222, 0x22222222, 0x22222222, 0x22222222, 0, 0, 0, 0};
            if (UNIT_MFMA4 == 2) bv = (v8i_){0x11111111, 0, 0, 0, 0, 0, 0, 0};
            v8i_ av2 = av;
            if (UNIT_MFMA4 == 3) { const bool on = qq == 1; av2 = (v8i_){0, on ? 0x00005800 : 0, 0, 0, 0, 0, 0, 0}; bv = (v8i_){on ? 0x00700000 : 0, 0, 0, 0, 0, 0, 0, 0}; }
            if (UNIT_MFMA4 == 4) { const bool on = qq == 2; av2 = (v8i_){0, 0, 0, 0, 0, on ? 0x58000000 : 0, 0, 0}; bv = (v8i_){0, 0, on ? 0x70000000 : 0, 0, 0, 0, 0, 0}; }
            const f32x4 d = __builtin_amdgcn_mfma_scale_f32_16x16x128_f8f6f4(av2, bv, (f32x4){0.f, 0.f, 0.f, 0.f}, 0, 4, 0, 0, 0, 0);
            if (UNIT_MFMA4 >= 100) {
                const int eb = UNIT_MFMA4 - 100; int found = 98;
                v8i_ bs = {0, 0, 0, 0, 0, 0, 0, 0}; if (qq == 2) bs[eb >> 3] = 7 << (4 * (eb & 7));
#pragma nounroll
                for (int qe = 0; qe < 128; ++qe) { int qa = qe >> 5, ea = qe & 31; asm volatile("" : "+s"(qa), "+s"(ea)); v8i_ as = {0, 0, 0, 0, 0, 0, 0, 0};
#pragma unroll
                    for (int w = 0; w < 8; ++w) as[w] = (qq == qa && (ea >> 2) == w) ? (0x58 << (8 * (ea & 3))) : 0;
                    const f32x4 dd = __builtin_amdgcn_mfma_scale_f32_16x16x128_f8f6f4(as, bs, (f32x4){0.f, 0.f, 0.f, 0.f}, 0, 4, 0, 0, 0, 0);
                    if (dd[0] > 1.f) found = (qa == UNIT_QA ? 3 * ea + 4 : 99); }
                if (lane == 0) { VM_WAIT(); args.out[0] = (float)found; }
            } else
            if (lane == 0) { VM_WAIT(); args.out[0] = 200.f + d[0]; }
        }
#endif
#ifdef UNIT_TR4
        __syncthreads();
        if (blockIdx.x == 0 && F.wave == 0) {
            typedef int v2i_ __attribute__((ext_vector_type(2)));
            const int lane = F.lane, g4 = lane >> 4, jj = lane & 15;
            LAS unsigned char* tb = F.lds + RING_OFF + g4 * 2048 + jj * 80;
            int okmask = 0;
            for (int hyp = 0; hyp < 4; ++hyp) { const int st = hyp & 1, ot = hyp >> 1;
                unsigned long long rowbits = 0;
                for (int n = 0; n < 16; ++n) { const unsigned v = (unsigned)(3 * jj + 5 * n + g4) & 15u; const int nib = st ? (n ^ 1) : n; rowbits |= (unsigned long long)v << (4 * nib); }
                *(LAS unsigned*)tb = (unsigned)rowbits; *(LAS unsigned*)(tb + 4) = (unsigned)(rowbits >> 32);
                LDS_WAIT(); asm volatile("" ::: "memory");
                const v2i_ rd = __builtin_amdgcn_ds_read_tr4_b64_v2i32((LAS v2i_*)tb);
                unsigned long long ex = 0;
                for (int k = 0; k < 16; ++k) { const unsigned v = (unsigned)(3 * k + 5 * jj + g4) & 15u; const int nib = ot ? (k ^ 1) : k; ex |= (unsigned long long)v << (4 * nib); }
                const bool bad = ((unsigned)rd.x != (unsigned)ex) || ((unsigned)rd.y != (unsigned)(ex >> 32));
                if (__ballot(bad) == 0ull) okmask |= 1 << hyp;
                LDS_WAIT(); asm volatile("" ::: "memory"); }
            if (lane == 0) { VM_WAIT(); args.out[0] = 200.f + 20.f * (float)okmask; }
        }
#endif
#ifdef TIME_V
        __syncthreads();
        if (blockIdx.x == TIME_V_BLOCK && F.tid == 0) { VM_WAIT(); args.out[0] = tvv_; }
#endif
        STAMP(7);
#ifdef TIME_P7_SPREAD
        __syncthreads();
        ts_[8] = __builtin_amdgcn_s_memrealtime();
        if (F.tid == 0) { __hip_atomic_fetch_max((unsigned long long*)(ws + 800), ts_[8] - ts_[7], __ATOMIC_RELAXED, __HIP_MEMORY_SCOPE_AGENT); __hip_atomic_fetch_add((unsigned*)(ws + 840), 1u, __ATOMIC_RELAXED, __HIP_MEMORY_SCOPE_AGENT); }
        if (blockIdx.x == 0 && F.tid == 0) { while (__hip_atomic_load((unsigned*)(ws + 840), __ATOMIC_RELAXED, __HIP_MEMORY_SCOPE_AGENT) < gridDim.x) __builtin_amdgcn_s_sleep(8);
            ts_[8] = ts_[7] + __hip_atomic_load((unsigned long long*)(ws + 800), __ATOMIC_RELAXED, __HIP_MEMORY_SCOPE_AGENT); }
#endif
#ifdef TIME_PHASE
#ifdef TIME_TOTAL
        if (blockIdx.x == 0 && F.tid == 0) { VM_WAIT(); args.out[0] = (float)(ts_[PER_PHASE] - ts_[0]) * (0.01f / TIME_UNIT_US); }
#else
        if (blockIdx.x == 0 && F.tid == 0) { VM_WAIT(); args.out[0] = (float)(ts_[TIME_PHASE + 1] - ts_[TIME_PHASE]) * (0.01f / TIME_UNIT_US); }
#endif
#endif
    }
#undef IN
#undef BOTH
}

#ifdef DEBUG_DUMP
__global__ void dump_kernel(const unsigned char* ws, float* out, float wsmib) {
    const size_t i = (size_t)blockIdx.x * 256 + threadIdx.x; if (i >= (size_t)TOK * 1024) return;
    const size_t t = i >> 10, c = i & 1023; float v = 0.f;
    auto B = [&](size_t off, size_t idx) { return bflo((unsigned)((const bf16*)(ws + off))[idx]); };
#if DEBUG_DUMP == 0
    v = B(WS_H, i) + B(WS_WIN, i % (4608u * 1024u)) + B(WS_WPW, i % (512u * 1024u)) + B(WS_WAO, i % (512u * 1024u)) + B(WS_WOUT, i % (1024u * 1024u)) + B(WS_WQ, i % (2048u * 1024u)) + B(WS_KEYS, i % 32768u) + B(WS_UB, i % (16384u * 1024u)) + B(WS_VB, i % (16384u * 1024u));
#elif DEBUG_DUMP == 1
    v = B(WS_ZGLU, t * 512 + (c & 511)) + 2.f * B(WS_QO, t * 512 + (c & 511)) + 3.f * B(WS_K, t * 512 + (c & 511)) + 4.f * B(WS_V, t * 512 + (c & 511)) + 5.f * B(WS_GC, i) + 6.f * B(WS_GATE_A, i) + ((const float*)(ws + WS_KMEAN))[(t >> 8) * 1024 + (c & 1023)];
#elif DEBUG_DUMP == 2
    v = B(WS_QO, t * 512 + (c & 511)) + 2.f * B(WS_CACT, t * 512 + (c & 511));
#elif DEBUG_DUMP == 20
    v = B(WS_QO, t * 512 + (c & 511));
#elif DEBUG_DUMP == 21
    v = B(WS_CACT, t * 512 + (c & 511));
#elif DEBUG_DUMP == 3
    v = B(WS_MIX, i);
#elif DEBUG_DUMP == 5
    v = B(WS_QP, t * 2048 + c) + 2.f * B(WS_QP, t * 2048 + 1024 + c);
#elif DEBUG_DUMP == 10
    v = B(WS_ZGLU, t * 512 + (c & 511));
#elif DEBUG_DUMP == 11
    v = 2.f * B(WS_QO, t * 512 + (c & 511)) + 3.f * B(WS_K, t * 512 + (c & 511)) + 4.f * B(WS_V, t * 512 + (c & 511));
#elif DEBUG_DUMP == 12
    v = 5.f * B(WS_GC, i) + 6.f * B(WS_GATE_A, i);
#elif DEBUG_DUMP == 13
    v = ((const float*)(ws + WS_KMEAN))[(t >> 8) * 1024 + (c & 1023)];
#elif DEBUG_DUMP == 98
    v = wsmib;
#elif DEBUG_DUMP == 99
    v = 1.0f + (float)(c & 7);
#endif
    out[i] = v;
}
#endif
extern "C" void kernel_launch(void* const* d_in, const int* in_sizes, int n_in, void* d_out, int out_size, void* d_ws, size_t ws_size, hipStream_t stream) {
    static int grid = 0;
    if (grid == 0) {
        if (n_in != 18 || in_sizes[0] != TOK * DM || out_size != TOK * DM || ws_size < WS_END) { fprintf(stderr, "kernel_launch: unexpected shapes (n_in %d, in0 %d, out %d, ws %zu); nothing launched\n", n_in, n_in > 0 ? in_sizes[0] : -1, out_size, ws_size); grid = -1; return; }
        int dev = 0, cus = 0, per_cu = 0;
        if (hipGetDevice(&dev) != hipSuccess || hipDeviceGetAttribute(&cus, hipDeviceAttributeMultiprocessorCount, dev) != hipSuccess) { grid = -1; return; }
        if (hipFuncSetAttribute((const void*)fwd_kernel, hipFuncAttributeMaxDynamicSharedMemorySize, LDS_BYTES) != hipSuccess) { fprintf(stderr, "kernel_launch: hipFuncSetAttribute failed\n"); grid = -1; return; }
        if (hipOccupancyMaxActiveBlocksPerMultiprocessor(&per_cu, (const void*)fwd_kernel, NWAVES * 64, LDS_BYTES) != hipSuccess || per_cu < 1) fprintf(stderr, "kernel_launch: occupancy query reports %d\n", per_cu);
        (void)hipGetLastError();
        grid = cus;
    }
    if (grid < 0) return;
    (void)hipMemsetAsync((char*)d_ws + WS_CTL, 0, CTL_ZERO_BYTES, stream);
    Args a{};
    for (int i = 0; i < 18; ++i) a.in[i] = (const float*)d_in[i];
    a.out = (float*)d_out; a.ws = (unsigned char*)d_ws;
#ifndef NPH_RUN
#define NPH_RUN N_LAUNCHES
#endif
    for (int li = 0; li < NPH_RUN; ++li) {
        a.ph_lo = (N_LAUNCHES == PER_PHASE) ? li : 0; a.ph_hi = (N_LAUNCHES == PER_PHASE) ? li + 1 : PER_PHASE; a.li = li;
        hipLaunchKernelGGL(fwd_kernel, dim3(grid), dim3(NWAVES * 64), LDS_BYTES, stream, a);
    }
#ifdef DEBUG_DUMP
    hipLaunchKernelGGL(dump_kernel, dim3(TOK * 1024 / 256), dim3(256), 0, stream, (const unsigned char*)d_ws, (float*)d_out, (float)(ws_size >> 20));
#endif
}
```

```cpp
#define MK_N_LAUNCHES 1
#ifndef PG8_EPI_DRAIN
#define PG8_EPI_DRAIN 0
#endif
#include <hip/hip_runtime.h>
#include <hip/hip_bf16.h>
#include <cstdio>
#include <cstdint>
#include <cmath>
namespace pg8 {
#define PG8_LAS __attribute__((address_space(3)))
typedef unsigned short bf16_t;
typedef short bf16x8 __attribute__((ext_vector_type(8)));
typedef float f32x4 __attribute__((ext_vector_type(4)));
typedef unsigned u32x4 __attribute__((ext_vector_type(4)));
constexpr int BM = 256, BK = 64, HALF = 128, HTB = HALF * BK * 2  , STAGE_BYTES = 8 * HTB, NXCD = 8, WGM = 8;

__host__ __device__ __forceinline__ int lds_byte(int r, int c) { const int st = (r >> 4) * 2 + (c >> 5), rr = r & 15, cc = c & 31, ob = rr * 64 + cc * 2; return st * 1024 + (ob ^ (((ob >> 9) & 1) << 5)); }
__host__ __device__ __forceinline__ void stage_rc(int b, int& R, int& C) { const int st = b / 1024, sb = b % 1024, swz = sb ^ (((sb >> 9) & 1) << 5); R = (st >> 1) * 16 + swz / 64; C = (st & 1) * 32 + (swz % 64) / 2; }
__host__ __device__ __forceinline__ int perm32(int rho) { const int n = rho >> 4, i = rho & 15; return 8 * (i >> 2) + 4 * n + (i & 3); }

struct Unit { int pm, pn; };
struct Gemm { const bf16_t* A; const bf16_t* Bt; int M, N, K; };

struct StaticOrder {
    int nM, nN, nwg, G, c;
    __host__ __device__ void init(int M, int N, int G_, int c_) { nM = M / BM; nN = N / BM; nwg = nM * nN; G = G_; c = c_; }
    __host__ __device__ bool next(int i, Unit& u) const {
        const long L = (long)i * G + c; if (L >= nwg) return false;
        int wgid = (int)L; { const int q = nwg / NXCD, r = nwg % NXCD, xcd = wgid % NXCD, off = wgid / NXCD; wgid = (xcd < r ? xcd * (q + 1) : r * (q + 1) + (xcd - r) * q) + off; }
        const int nig = WGM * nN, gid = wgid / nig, fm = gid * WGM, gsz = (nM - fm) < WGM ? (nM - fm) : WGM;
        u.pm = fm + ((wgid % nig) % gsz); u.pn = (wgid % nig) / gsz; return true;
    }
    __device__ __forceinline__ void a_ready(const Unit&) const {}
    __device__ __forceinline__ void done(const Unit&) const {}
};

typedef float f32x2c_t __attribute__((ext_vector_type(2))); typedef __bf16 bf16x2c_t __attribute__((ext_vector_type(2)));
__device__ __forceinline__ unsigned cvt_pk_bf16(float lo, float hi) { const f32x2c_t v = {lo, hi}; const bf16x2c_t b = __builtin_convertvector(v, bf16x2c_t); return __builtin_bit_cast(unsigned, b); }
typedef float f32x2 __attribute__((ext_vector_type(2)));
__device__ __forceinline__ float sigm(float v) { return __builtin_amdgcn_rcpf(1.0f + __builtin_amdgcn_exp2f(-1.4426950408889634f * v)); }
__device__ __forceinline__ float bf_lo(unsigned u) { return __uint_as_float(u << 16); }
__device__ __forceinline__ float bf_hi(unsigned u) { return __uint_as_float(u & 0xffff0000u); }
__device__ __forceinline__ u32x4 pack8(const f32x4 a, const f32x4 b) { u32x4 w; w.x = cvt_pk_bf16(a[0], a[1]); w.y = cvt_pk_bf16(a[2], a[3]); w.z = cvt_pk_bf16(b[0], b[1]); w.w = cvt_pk_bf16(b[2], b[3]); return w; }
__device__ __forceinline__ void unpack8(const u32x4 w, f32x4& a, f32x4& b) { a = (f32x4){bf_lo(w.x), bf_hi(w.x), bf_lo(w.y), bf_hi(w.y)}; b = (f32x4){bf_lo(w.z), bf_hi(w.z), bf_lo(w.w), bf_hi(w.w)}; }

#ifndef PG8_WT
#define PG8_WT 1
#endif
__device__ __forceinline__ __amdgpu_buffer_rsrc_t wt_rsrc(const void* p) { return __builtin_amdgcn_make_buffer_rsrc((void*)p, 0, 0x7fffffff, 0x00020000); }
__device__ __forceinline__ void st16(bf16_t* base, const __amdgpu_buffer_rsrc_t r, size_t elem_off, const u32x4 v) {
#if PG8_WT
    __builtin_amdgcn_raw_buffer_store_b128(v, r, (unsigned)(elem_off * 2), 0, 16);
#else
    *(u32x4*)(base + elem_off) = v;
#endif
}
struct EpiIn {
    static constexpr bool PERM = true, AFTER_DRAIN = false, HAS_MID = false;
    bf16_t *zglu, *Q, *gc; float* kmean; float qscale; size_t qkv_stride, gate_stride;
    __device__ __forceinline__ void operator()(const f32x4 (&acc)[2][2][4][2], const Unit& u, int wr, int wc, int fr, int fq) const {
        const int row0 = u.pm * BM + wr * 64 + fr, cw = wc * 32 + 8 * fq, pn = u.pn;
        const __amdgpu_buffer_rsrc_t rz = wt_rsrc(zglu), rq = wt_rsrc(Q), rg = wt_rsrc(gc);
        if (pn < 4) {
#pragma unroll
            for (int ai = 0; ai < 2; ++ai)
#pragma unroll
                for (int m = 0; m < 4; ++m) { const size_t row = (size_t)(row0 + ai * HALF + m * 16);
                    f32x4 z0, z1;
#pragma unroll
                    for (int j = 0; j < 4; ++j) { z0[j] = acc[ai][0][m][0][j] * sigm(acc[ai][1][m][0][j]); z1[j] = acc[ai][0][m][1][j] * sigm(acc[ai][1][m][1][j]); }
                    st16(zglu, rz, row * 512 + pn * 128 + cw, pack8(z0, z1)); }
        } else if (pn < 10) {
            const size_t boff = (size_t)((pn - 4) >> 1) * qkv_stride; const int ct = (pn & 1) * 256; const float sc = pn < 6 ? qscale : 1.0f;
#pragma unroll
            for (int ai = 0; ai < 2; ++ai)
#pragma unroll
                for (int m = 0; m < 4; ++m) { const size_t row = (size_t)(row0 + ai * HALF + m * 16);
#pragma unroll
                    for (int bj = 0; bj < 2; ++bj) st16(Q, rq, boff + row * 512 + ct + bj * HALF + cw, pack8(acc[ai][bj][m][0] * sc, acc[ai][bj][m][1] * sc)); }
            if (pn == 6 || pn == 7) {
#pragma unroll
                for (int bj = 0; bj < 2; ++bj)
#pragma unroll
                    for (int n = 0; n < 2; ++n)
#pragma unroll
                        for (int j = 0; j < 4; ++j) { float s = 0.f;
#pragma unroll
                            for (int ai = 0; ai < 2; ++ai)
#pragma unroll
                                for (int m = 0; m < 4; ++m) s += acc[ai][bj][m][n][j];
                            s += __shfl_xor(s, 1); s += __shfl_xor(s, 2); s += __shfl_xor(s, 4); s += __shfl_xor(s, 8);
                            if (fr == 0) kmean[((size_t)u.pm * 2 + wr) * 512 + ct + bj * HALF + cw + 4 * n + j] = s * (1.0f / 256.0f); }
            }
        } else {
            const size_t boff = (size_t)((pn - 10) >> 2) * gate_stride; const int ct = ((pn - 10) & 3) * 256;
#pragma unroll
            for (int ai = 0; ai < 2; ++ai)
#pragma unroll
                for (int m = 0; m < 4; ++m) { const size_t row = (size_t)(row0 + ai * HALF + m * 16);
#pragma unroll
                    for (int bj = 0; bj < 2; ++bj) { f32x4 s0, s1;
#pragma unroll
                        for (int j = 0; j < 4; ++j) { s0[j] = sigm(acc[ai][bj][m][0][j]); s1[j] = sigm(acc[ai][bj][m][1][j]); }
                        st16(gc, rg, boff + row * 1024 + ct + bj * HALF + cw, pack8(s0, s1)); } }
        }
    }
};
template <bool ADD> struct EpiMix {
    static constexpr bool PERM = true, AFTER_DRAIN = false, HAS_MID = false;
    const bf16_t* gate; const float* bias; bf16_t* mix;
    __device__ __forceinline__ void operator()(const f32x4 (&acc)[2][2][4][2], const Unit& u, int wr, int wc, int fr, int fq) const {
        const int row0 = u.pm * BM + wr * 64 + fr, col0 = u.pn * BM + wc * 32 + 8 * fq;
        f32x4 b0[2], b1[2];
#pragma unroll
        for (int bj = 0; bj < 2; ++bj) { b0[bj] = (f32x4){0.f, 0.f, 0.f, 0.f}; b1[bj] = b0[bj]; if (!ADD) { b0[bj] = *(const f32x4*)(bias + col0 + bj * HALF); b1[bj] = *(const f32x4*)(bias + col0 + bj * HALF + 4); } }
#pragma unroll
        for (int ai = 0; ai < 2; ++ai) {
            u32x4 gq[4][2], mq[4][2];
#pragma unroll
            for (int m = 0; m < 4; ++m)
#pragma unroll
                for (int bj = 0; bj < 2; ++bj) { const size_t off = (size_t)(row0 + ai * HALF + m * 16) * 1024 + col0 + bj * HALF; gq[m][bj] = *(const u32x4*)(gate + off); if (ADD) mq[m][bj] = *(const u32x4*)(mix + off); }
#pragma unroll
            for (int m = 0; m < 4; ++m)
#pragma unroll
                for (int bj = 0; bj < 2; ++bj) { const size_t off = (size_t)(row0 + ai * HALF + m * 16) * 1024 + col0 + bj * HALF;
                    f32x4 g0, g1; unpack8(gq[m][bj], g0, g1);
                    f32x4 v0 = acc[ai][bj][m][0], v1 = acc[ai][bj][m][1];
                    if (!ADD) { v0 = (v0 + b0[bj]) * g0; v1 = (v1 + b1[bj]) * g1; }
                    else { f32x4 p0, p1; unpack8(mq[m][bj], p0, p1); v0 = p0 + v0 * g0; v1 = p1 + v1 * g1; }
                    *(u32x4*)(mix + off) = pack8(v0, v1); }
        }
    }
};
struct EpiMixF {
    static constexpr bool PERM = true, AFTER_DRAIN = false, HAS_MID = true;
    const bf16_t* gc; const bf16_t* ga; const float* bias; bf16_t* mix;
    __device__ __forceinline__ void mid(f32x4 (&acc)[2][2][4][2], const Unit& u, int wr, int wc, int fr, int fq) const {
        const int row0 = u.pm * BM + wr * 64 + fr, col0 = u.pn * BM + wc * 32 + 8 * fq;
#pragma unroll
        for (int ai = 0; ai < 2; ++ai)
#pragma unroll
            for (int m = 0; m < 4; ++m) { u32x4 cq[2], aq[2];
#pragma unroll
                for (int bj = 0; bj < 2; ++bj) { const size_t off = (size_t)(row0 + ai * HALF + m * 16) * 1024 + col0 + bj * HALF; cq[bj] = *(const u32x4*)(gc + off); aq[bj] = *(const u32x4*)(ga + off); }
#pragma unroll
                for (int bj = 0; bj < 2; ++bj) { f32x4 c0, c1, a0, a1; unpack8(cq[bj], c0, c1); unpack8(aq[bj], a0, a1);
                    const f32x4 b0 = *(const f32x4*)(bias + col0 + bj * HALF), b1 = *(const f32x4*)(bias + col0 + bj * HALF + 4);
#pragma unroll
                    for (int j = 0; j < 4; ++j) { acc[ai][bj][m][0][j] = (acc[ai][bj][m][0][j] + b0[j]) * c0[j] * __builtin_amdgcn_rcpf(fmaxf(a0[j], 1e-30f));
                                                  acc[ai][bj][m][1][j] = (acc[ai][bj][m][1][j] + b1[j]) * c1[j] * __builtin_amdgcn_rcpf(fmaxf(a1[j], 1e-30f)); } }
                if (m & 1) asm volatile("" ::: "memory"); }
    }
    __device__ __forceinline__ void operator()(const f32x4 (&acc)[2][2][4][2], const Unit& u, int wr, int wc, int fr, int fq) const {
        const int row0 = u.pm * BM + wr * 64 + fr, col0 = u.pn * BM + wc * 32 + 8 * fq;
        const __amdgpu_buffer_rsrc_t rm = wt_rsrc(mix);
#pragma unroll
        for (int ai = 0; ai < 2; ++ai) { u32x4 aq[4][2];
#pragma unroll
            for (int m = 0; m < 4; ++m)
#pragma unroll
                for (int bj = 0; bj < 2; ++bj) aq[m][bj] = *(const u32x4*)(ga + (size_t)(row0 + ai * HALF + m * 16) * 1024 + col0 + bj * HALF);
#pragma unroll
            for (int m = 0; m < 4; ++m)
#pragma unroll
                for (int bj = 0; bj < 2; ++bj) { f32x4 a0, a1; unpack8(aq[m][bj], a0, a1); f32x4 v0 = acc[ai][bj][m][0], v1 = acc[ai][bj][m][1];
#pragma unroll
                    for (int j = 0; j < 4; ++j) { v0[j] *= fmaxf(a0[j], 1e-30f); v1[j] *= fmaxf(a1[j], 1e-30f); }
                    st16(mix, rm, (size_t)(row0 + ai * HALF + m * 16) * 1024 + col0 + bj * HALF, pack8(v0, v1)); } }
    }
};
struct EpiX1 {
    static constexpr bool PERM = true, AFTER_DRAIN = false, HAS_MID = false;
    const float* x; float* x1; bf16_t* x1b; float* ss;
    __device__ __forceinline__ void operator()(const f32x4 (&acc)[2][2][4][2], const Unit& u, int wr, int wc, int fr, int fq) const {
        const int row0 = u.pm * BM + wr * 64 + fr, col0 = u.pn * BM + wc * 32 + 8 * fq;
        const __amdgpu_buffer_rsrc_t rx = wt_rsrc(x1b);
#pragma unroll
        for (int ai = 0; ai < 2; ++ai) {
            f32x4 xq[4][2][2];
#pragma unroll
            for (int m = 0; m < 4; ++m)
#pragma unroll
                for (int bj = 0; bj < 2; ++bj) { const size_t off = (size_t)(row0 + ai * HALF + m * 16) * 1024 + col0 + bj * HALF; xq[m][bj][0] = *(const f32x4*)(x + off); xq[m][bj][1] = *(const f32x4*)(x + off + 4); }
#pragma unroll
            for (int m = 0; m < 4; ++m) { const size_t row = (size_t)(row0 + ai * HALF + m * 16); float sq = 0.f;
#pragma unroll
                for (int bj = 0; bj < 2; ++bj) { const size_t off = row * 1024 + col0 + bj * HALF;
                    const f32x4 r0 = xq[m][bj][0] + acc[ai][bj][m][0], r1 = xq[m][bj][1] + acc[ai][bj][m][1];
                    st16(x1b, rx, off, pack8(r0, r1));
                    sq += (r0[0] * r0[0] + r0[1] * r0[1]) + (r0[2] * r0[2] + r0[3] * r0[3]) + (r1[0] * r1[0] + r1[1] * r1[1]) + (r1[2] * r1[2] + r1[3] * r1[3]); }
                sq += __shfl_xor(sq, 16); sq += __shfl_xor(sq, 32);
                if (fq == 0) ss[row * 16 + u.pn * 4 + wc] = sq; }
        }
    }
};
struct EpiStore {
    static constexpr bool PERM = true, AFTER_DRAIN = false, HAS_MID = false;
    bf16_t* O; int ldc;
    __device__ __forceinline__ void operator()(const f32x4 (&acc)[2][2][4][2], const Unit& u, int wr, int wc, int fr, int fq) const {
        const int row0 = u.pm * BM + wr * 64 + fr, col0 = u.pn * BM + wc * 32 + 8 * fq;
        const __amdgpu_buffer_rsrc_t ro = wt_rsrc(O);
#pragma unroll
        for (int ai = 0; ai < 2; ++ai)
#pragma unroll
            for (int m = 0; m < 4; ++m) { const size_t row = (size_t)(row0 + ai * HALF + m * 16);
#pragma unroll
                for (int bj = 0; bj < 2; ++bj) st16(O, ro, row * ldc + col0 + bj * HALF, pack8(acc[ai][bj][m][0], acc[ai][bj][m][1])); }
    }
};


template <class Epi, class Sched, bool ALIGN_EPI = false, bool SP2 = false>
__device__ __forceinline__ void gemm_phase(PG8_LAS unsigned char* lds, const Gemm g, const Sched& S, const Epi& E) {
    const int tid = threadIdx.x, wid = __builtin_amdgcn_readfirstlane(tid >> 6), lane = tid & 63, wr = wid >> 2, wc = wid & 3, fr = lane & 15, fq = lane >> 4;
    const int K = g.K, nt = K / BK;
    unsigned voffA[2], voffB[2];
#pragma unroll
    for (int i = 0; i < 2; ++i) { int R, C; stage_rc(tid * 16 + i * 8192, R, C); const int Rb = Epi::PERM ? ((R & ~31) + perm32(R & 31)) : R;
        voffA[i] = (unsigned)(R * K + C) * 2u; voffB[i] = (unsigned)(Rb * K + C) * 2u; }
    const size_t kstep = (size_t)(BK * 2);
    const size_t hstep = (size_t)HALF * K * 2;
    const size_t tstep = 2 * hstep;
    const unsigned ldsw = (unsigned)wid * 1024u;
    const int aoff = lds_byte(wr * 64 + fr, fq * 8), boff = lds_byte(wc * 32 + fr, fq * 8);
#define PG8_SA(b, h) (((b) * 2 + (h)) * HTB)
#define PG8_SB(b, h) ((4 + (b) * 2 + (h)) * HTB)
#define PG8_STAGE(bufoff, gbase, voff) do { _Pragma("unroll") for (int _i = 0; _i < 2; ++_i) \
        __builtin_amdgcn_global_load_lds((const unsigned*)((const char*)(gbase) + (voff)[_i]), (PG8_LAS unsigned*)(lds + (bufoff) + ldsw + _i * 8192), 16, 0, 0); } while (0)
#define PG8_LDA(dst, b, h) do { _Pragma("unroll") for (int m = 0; m < 4; ++m) _Pragma("unroll") for (int k = 0; k < 2; ++k) dst[m][k] = *(const PG8_LAS bf16x8*)(lds + PG8_SA(b, h) + aoff + m * 2048 + k * 1024); } while (0)
#define PG8_LDB(dst, b, h) do { _Pragma("unroll") for (int n = 0; n < 2; ++n) _Pragma("unroll") for (int k = 0; k < 2; ++k) dst[n][k] = *(const PG8_LAS bf16x8*)(lds + PG8_SB(b, h) + boff + n * 2048 + k * 1024); } while (0)
#define PG8_MMA(ai, bj, At, Bt) do { __builtin_amdgcn_s_setprio(1); _Pragma("unroll") for (int m = 0; m < 4; ++m) _Pragma("unroll") for (int n = 0; n < 2; ++n) _Pragma("unroll") for (int k = 0; k < 2; ++k) \
        acc[ai][bj][m][n] = __builtin_amdgcn_mfma_f32_16x16x32_bf16(Bt[n][k], At[m][k], acc[ai][bj][m][n], 0, 0, 0); __builtin_amdgcn_s_setprio(0); } while (0)
#define PG8_WAIT_V(n) asm volatile("s_waitcnt vmcnt(" #n ")" ::: "memory")
#define PG8_WAIT_L(n) asm volatile("s_waitcnt lgkmcnt(" #n ")" ::: "memory")
#define PG8_BAR __builtin_amdgcn_s_barrier()
#define PG8_SCHED __builtin_amdgcn_sched_barrier(0)
    Unit cur, nxt; int ui = 0;
    if (!S.next(0, cur)) return;
    f32x4 acc[2][2][4][2];
#pragma unroll
    for (int a = 0; a < 2; ++a)
#pragma unroll
        for (int b = 0; b < 2; ++b)
#pragma unroll
            for (int m = 0; m < 4; ++m)
#pragma unroll
                for (int n = 0; n < 2; ++n) acc[a][b][m][n] = (f32x4){0.f, 0.f, 0.f, 0.f};
    bf16x8 At[4][2], B0[2][2], B1[2][2];
    const char* cA = (const char*)g.A + (size_t)cur.pm * tstep; const char* cB = (const char*)g.Bt + (size_t)cur.pn * tstep;
    S.a_ready(cur);
    if constexpr (SP2) {
        PG8_STAGE(PG8_SB(0, 0), cB, voffB); PG8_STAGE(PG8_SB(0, 1), cB + hstep, voffB); PG8_STAGE(PG8_SA(0, 0), cA, voffA); PG8_STAGE(PG8_SA(0, 1), cA + hstep, voffA);
        if (wr == 1) PG8_BAR;
        PG8_WAIT_V(2); PG8_BAR;
        PG8_STAGE(PG8_SB(1, 0), cB + kstep, voffB); PG8_STAGE(PG8_SA(1, 0), cA + kstep, voffA); PG8_STAGE(PG8_SB(1, 1), cB + hstep + kstep, voffB);
        PG8_WAIT_V(6); PG8_BAR;
    } else {
        PG8_STAGE(PG8_SB(0, 0), cB, voffB); PG8_STAGE(PG8_SA(0, 0), cA, voffA); PG8_STAGE(PG8_SB(0, 1), cB + hstep, voffB); PG8_STAGE(PG8_SA(0, 1), cA + hstep, voffA);
        if (wr == 1) PG8_BAR;
        PG8_WAIT_V(4); PG8_BAR;
        PG8_STAGE(PG8_SB(1, 0), cB + kstep, voffB); PG8_STAGE(PG8_SA(1, 0), cA + kstep, voffA); PG8_STAGE(PG8_SB(1, 1), cB + hstep + kstep, voffB);
        PG8_WAIT_V(6); PG8_BAR;
    }
    for (;;) {
        const bool has_next = S.next(ui + 1, nxt);
        const char* nA = has_next ? (const char*)g.A + (size_t)nxt.pm * tstep : cA; const char* nB = has_next ? (const char*)g.Bt + (size_t)nxt.pn * tstep : cB;
        if constexpr (Epi::HAS_MID) {
        for (int t = 0; t < nt / 2; t += 2) {
            const bool last = (t == nt - 2);
            const char* a1 = cA + (size_t)(t + 1) * kstep;
            const char* a2 = last ? nA : cA + (size_t)(t + 2) * kstep; const char* b2 = last ? nB : cB + (size_t)(t + 2) * kstep;
            const char* a3 = a2 + kstep; const char* b3 = b2 + kstep;
            if (last && has_next) S.a_ready(nxt);
            if constexpr (SP2) {
            PG8_LDB(B0, 0, 0); PG8_LDB(B1, 0, 1); PG8_SCHED; PG8_LDA(At, 0, 0); PG8_STAGE(PG8_SA(1, 1), a1 + hstep, voffA);
            PG8_WAIT_V(8); PG8_WAIT_L(0); PG8_BAR; PG8_MMA(0, 0, At, B0); PG8_MMA(0, 1, At, B1); PG8_BAR; PG8_SCHED;
            PG8_LDA(At, 0, 1); PG8_STAGE(PG8_SB(0, 0), b2, voffB); PG8_STAGE(PG8_SB(0, 1), b2 + hstep, voffB); PG8_STAGE(PG8_SA(0, 0), a2, voffA);
            PG8_WAIT_V(8); PG8_WAIT_L(0); PG8_BAR; PG8_MMA(1, 0, At, B0); PG8_MMA(1, 1, At, B1); PG8_BAR; PG8_SCHED;
            PG8_LDB(B0, 1, 0); PG8_LDB(B1, 1, 1); PG8_SCHED; PG8_LDA(At, 1, 0); PG8_STAGE(PG8_SA(0, 1), a2 + hstep, voffA);
            PG8_WAIT_V(8); PG8_WAIT_L(0); PG8_BAR; PG8_MMA(0, 0, At, B0); PG8_MMA(0, 1, At, B1); PG8_BAR; PG8_SCHED;
            PG8_LDA(At, 1, 1); PG8_STAGE(PG8_SB(1, 0), b3, voffB); PG8_STAGE(PG8_SB(1, 1), b3 + hstep, voffB); PG8_STAGE(PG8_SA(1, 0), a3, voffA);
            PG8_WAIT_V(8); PG8_WAIT_L(0); PG8_BAR; PG8_MMA(1, 0, At, B0); PG8_MMA(1, 1, At, B1); PG8_BAR; PG8_SCHED;
            } else {
            PG8_LDB(B0, 0, 0); PG8_SCHED; PG8_LDA(At, 0, 0); PG8_STAGE(PG8_SA(1, 1), a1 + hstep, voffA);
            PG8_WAIT_L(8); PG8_BAR; PG8_WAIT_L(0); PG8_MMA(0, 0, At, B0); PG8_BAR; PG8_SCHED;
            PG8_LDB(B1, 0, 1); PG8_STAGE(PG8_SB(0, 0), b2, voffB);
            PG8_BAR; PG8_WAIT_L(0); PG8_MMA(0, 1, At, B1); PG8_BAR;
            PG8_LDA(At, 0, 1); PG8_STAGE(PG8_SA(0, 0), a2, voffA);
            PG8_BAR; PG8_WAIT_L(0); PG8_MMA(1, 0, At, B0); PG8_BAR; PG8_SCHED;
            PG8_STAGE(PG8_SB(0, 1), b2 + hstep, voffB);
            PG8_WAIT_V(6); PG8_BAR; PG8_MMA(1, 1, At, B1); PG8_BAR;
            PG8_LDB(B0, 1, 0); PG8_SCHED; PG8_LDA(At, 1, 0); PG8_STAGE(PG8_SA(0, 1), a2 + hstep, voffA);
            PG8_WAIT_L(8); PG8_BAR; PG8_WAIT_L(0); PG8_MMA(0, 0, At, B0); PG8_BAR; PG8_SCHED;
            PG8_LDB(B1, 1, 1); PG8_STAGE(PG8_SB(1, 0), b3, voffB);
            PG8_BAR; PG8_WAIT_L(0); PG8_MMA(0, 1, At, B1); PG8_BAR;
            PG8_LDA(At, 1, 1); PG8_STAGE(PG8_SA(1, 0), a3, voffA);
            PG8_BAR; PG8_WAIT_L(0); PG8_MMA(1, 0, At, B0); PG8_BAR; PG8_SCHED;
            PG8_STAGE(PG8_SB(1, 1), b3 + hstep, voffB);
            PG8_WAIT_V(6); PG8_BAR; PG8_MMA(1, 1, At, B1); PG8_BAR;
            }
        }
        E.mid(acc, cur, wr, wc, fr, fq);
        for (int t = nt / 2; t < nt; t += 2) {
            const bool last = (t == nt - 2);
            const char* a1 = cA + (size_t)(t + 1) * kstep;
            const char* a2 = last ? nA : cA + (size_t)(t + 2) * kstep; const char* b2 = last ? nB : cB + (size_t)(t + 2) * kstep;
            const char* a3 = a2 + kstep; const char* b3 = b2 + kstep;
            if (last && has_next) S.a_ready(nxt);
            if constexpr (SP2) {
            PG8_LDB(B0, 0, 0); PG8_LDB(B1, 0, 1); PG8_SCHED; PG8_LDA(At, 0, 0); PG8_STAGE(PG8_SA(1, 1), a1 + hstep, voffA);
            PG8_WAIT_V(8); PG8_WAIT_L(0); PG8_BAR; PG8_MMA(0, 0, At, B0); PG8_MMA(0, 1, At, B1); PG8_BAR; PG8_SCHED;
            PG8_LDA(At, 0, 1); PG8_STAGE(PG8_SB(0, 0), b2, voffB); PG8_STAGE(PG8_SB(0, 1), b2 + hstep, voffB); PG8_STAGE(PG8_SA(0, 0), a2, voffA);
            PG8_WAIT_V(8); PG8_WAIT_L(0); PG8_BAR; PG8_MMA(1, 0, At, B0); PG8_MMA(1, 1, At, B1); PG8_BAR; PG8_SCHED;
            PG8_LDB(B0, 1, 0); PG8_LDB(B1, 1, 1); PG8_SCHED; PG8_LDA(At, 1, 0); PG8_STAGE(PG8_SA(0, 1), a2 + hstep, voffA);
            PG8_WAIT_V(8); PG8_WAIT_L(0); PG8_BAR; PG8_MMA(0, 0, At, B0); PG8_MMA(0, 1, At, B1); PG8_BAR; PG8_SCHED;
            PG8_LDA(At, 1, 1); PG8_STAGE(PG8_SB(1, 0), b3, voffB); PG8_STAGE(PG8_SB(1, 1), b3 + hstep, voffB); PG8_STAGE(PG8_SA(1, 0), a3, voffA);
            PG8_WAIT_V(8); PG8_WAIT_L(0); PG8_BAR; PG8_MMA(1, 0, At, B0); PG8_MMA(1, 1, At, B1); PG8_BAR; PG8_SCHED;
            } else {
            PG8_LDB(B0, 0, 0); PG8_SCHED; PG8_LDA(At, 0, 0); PG8_STAGE(PG8_SA(1, 1), a1 + hstep, voffA);
            PG8_WAIT_L(8); PG8_BAR; PG8_WAIT_L(0); PG8_MMA(0, 0, At, B0); PG8_BAR; PG8_SCHED;
            PG8_LDB(B1, 0, 1); PG8_STAGE(PG8_SB(0, 0), b2, voffB);
            PG8_BAR; PG8_WAIT_L(0); PG8_MMA(0, 1, At, B1); PG8_BAR;
            PG8_LDA(At, 0, 1); PG8_STAGE(PG8_SA(0, 0), a2, voffA);
            PG8_BAR; PG8_WAIT_L(0); PG8_MMA(1, 0, At, B0); PG8_BAR; PG8_SCHED;
            PG8_STAGE(PG8_SB(0, 1), b2 + hstep, voffB);
            PG8_WAIT_V(6); PG8_BAR; PG8_MMA(1, 1, At, B1); PG8_BAR;
            PG8_LDB(B0, 1, 0); PG8_SCHED; PG8_LDA(At, 1, 0); PG8_STAGE(PG8_SA(0, 1), a2 + hstep, voffA);
            PG8_WAIT_L(8); PG8_BAR; PG8_WAIT_L(0); PG8_MMA(0, 0, At, B0); PG8_BAR; PG8_SCHED;
            PG8_LDB(B1, 1, 1); PG8_STAGE(PG8_SB(1, 0), b3, voffB);
            PG8_BAR; PG8_WAIT_L(0); PG8_MMA(0, 1, At, B1); PG8_BAR;
            PG8_LDA(At, 1, 1); PG8_STAGE(PG8_SA(1, 0), a3, voffA);
            PG8_BAR; PG8_WAIT_L(0); PG8_MMA(1, 0, At, B0); PG8_BAR; PG8_SCHED;
            PG8_STAGE(PG8_SB(1, 1), b3 + hstep, voffB);
            PG8_WAIT_V(6); PG8_BAR; PG8_MMA(1, 1, At, B1); PG8_BAR;
            }
        }
        } else {
        for (int t = 0; t < nt; t += 2) {
            const bool last = (t == nt - 2);
            const char* a1 = cA + (size_t)(t + 1) * kstep;
            const char* a2 = last ? nA : cA + (size_t)(t + 2) * kstep; const char* b2 = last ? nB : cB + (size_t)(t + 2) * kstep;
            const char* a3 = a2 + kstep; const char* b3 = b2 + kstep;
            if (last && has_next) S.a_ready(nxt);
            if constexpr (SP2) {
            PG8_LDB(B0, 0, 0); PG8_LDB(B1, 0, 1); PG8_SCHED; PG8_LDA(At, 0, 0); PG8_STAGE(PG8_SA(1, 1), a1 + hstep, voffA);
            PG8_WAIT_V(8); PG8_WAIT_L(0); PG8_BAR; PG8_MMA(0, 0, At, B0); PG8_MMA(0, 1, At, B1); PG8_BAR; PG8_SCHED;
            PG8_LDA(At, 0, 1); PG8_STAGE(PG8_SB(0, 0), b2, voffB); PG8_STAGE(PG8_SB(0, 1), b2 + hstep, voffB); PG8_STAGE(PG8_SA(0, 0), a2, voffA);
            PG8_WAIT_V(8); PG8_WAIT_L(0); PG8_BAR; PG8_MMA(1, 0, At, B0); PG8_MMA(1, 1, At, B1); PG8_BAR; PG8_SCHED;
            PG8_LDB(B0, 1, 0); PG8_LDB(B1, 1, 1); PG8_SCHED; PG8_LDA(At, 1, 0); PG8_STAGE(PG8_SA(0, 1), a2 + hstep, voffA);
            PG8_WAIT_V(8); PG8_WAIT_L(0); PG8_BAR; PG8_MMA(0, 0, At, B0); PG8_MMA(0, 1, At, B1); PG8_BAR; PG8_SCHED;
            PG8_LDA(At, 1, 1); PG8_STAGE(PG8_SB(1, 0), b3, voffB); PG8_STAGE(PG8_SB(1, 1), b3 + hstep, voffB); PG8_STAGE(PG8_SA(1, 0), a3, voffA);
            PG8_WAIT_V(8); PG8_WAIT_L(0); PG8_BAR; PG8_MMA(1, 0, At, B0); PG8_MMA(1, 1, At, B1); PG8_BAR; PG8_SCHED;
            } else {
            PG8_LDB(B0, 0, 0); PG8_SCHED; PG8_LDA(At, 0, 0); PG8_STAGE(PG8_SA(1, 1), a1 + hstep, voffA);
            PG8_WAIT_L(8); PG8_BAR; PG8_WAIT_L(0); PG8_MMA(0, 0, At, B0); PG8_BAR; PG8_SCHED;
            PG8_LDB(B1, 0, 1); PG8_STAGE(PG8_SB(0, 0), b2, voffB);
            PG8_BAR; PG8_WAIT_L(0); PG8_MMA(0, 1, At, B1); PG8_BAR;
            PG8_LDA(At, 0, 1); PG8_STAGE(PG8_SA(0, 0), a2, voffA);
            PG8_BAR; PG8_WAIT_L(0); PG8_MMA(1, 0, At, B0); PG8_BAR; PG8_SCHED;
            PG8_STAGE(PG8_SB(0, 1), b2 + hstep, voffB);
            PG8_WAIT_V(6); PG8_BAR; PG8_MMA(1, 1, At, B1); PG8_BAR;
            PG8_LDB(B0, 1, 0); PG8_SCHED; PG8_LDA(At, 1, 0); PG8_STAGE(PG8_SA(0, 1), a2 + hstep, voffA);
            PG8_WAIT_L(8); PG8_BAR; PG8_WAIT_L(0); PG8_MMA(0, 0, At, B0); PG8_BAR; PG8_SCHED;
            PG8_LDB(B1, 1, 1); PG8_STAGE(PG8_SB(1, 0), b3, voffB);
            PG8_BAR; PG8_WAIT_L(0); PG8_MMA(0, 1, At, B1); PG8_BAR;
            PG8_LDA(At, 1, 1); PG8_STAGE(PG8_SA(1, 0), a3, voffA);
            PG8_BAR; PG8_WAIT_L(0); PG8_MMA(1, 0, At, B0); PG8_BAR; PG8_SCHED;
            PG8_STAGE(PG8_SB(1, 1), b3 + hstep, voffB);
            PG8_WAIT_V(6); PG8_BAR; PG8_MMA(1, 1, At, B1); PG8_BAR;
            }
        }
        }
        if constexpr (ALIGN_EPI) { if (wr == 0) PG8_BAR; }
        if constexpr (!Epi::AFTER_DRAIN) { E(acc, cur, wr, wc, fr, fq); S.done(cur);
#if PG8_EPI_DRAIN
            PG8_WAIT_V(0);
#endif
        }
        if (!has_next) break;
#pragma unroll
        for (int a = 0; a < 2; ++a)
#pragma unroll
            for (int b = 0; b < 2; ++b)
#pragma unroll
                for (int m = 0; m < 4; ++m)
#pragma unroll
                    for (int n = 0; n < 2; ++n) acc[a][b][m][n] = (f32x4){0.f, 0.f, 0.f, 0.f};
        cur = nxt; cA = nA; cB = nB; ++ui;
        if constexpr (ALIGN_EPI) { if (wr == 1) PG8_BAR; }
    }
    PG8_WAIT_V(0);
    if constexpr (!ALIGN_EPI) { if (wr == 0) PG8_BAR; }
    PG8_BAR;
    if constexpr (Epi::AFTER_DRAIN) { E.fused(acc, cur, wr, wc, fr, fq, lds, wid, lane); S.done(cur); }
#undef PG8_SA
#undef PG8_SB
#undef PG8_STAGE
#undef PG8_LDA
#undef PG8_LDB
#undef PG8_MMA
#undef PG8_WAIT_V
#undef PG8_WAIT_L
#undef PG8_BAR
#undef PG8_SCHED
}
}

#include <hip/hip_bf16.h>
#include <cmath>
namespace attn_body {
using bf16=__hip_bfloat16;
using bf16x8=__attribute__((ext_vector_type(8)))short;
using s16x4=__attribute__((ext_vector_type(4)))short;
using f32x16=__attribute__((ext_vector_type(16)))float;
using u32x4=__attribute__((ext_vector_type(4)))unsigned;
typedef float f32x4_t __attribute__((ext_vector_type(4)));
constexpr int BATCH=8,NHEAD=8,SEQ=4096,D=64,DM=NHEAD*D;
constexpr int NW=8,QBLK=32,QB=QBLK*NW,KVBLK=64,NQB=SEQ/QB;
constexpr int ATTN_PITCH=DM, ATTN_UNIT_ROWS=QB, OPITCH=1024;
__device__ __forceinline__ int crow(int r,int hi){return (r&3)+8*(r>>2)+4*hi;}
#define SBAR() __builtin_amdgcn_sched_barrier(0)
__device__ __forceinline__ void cmask(f32x16&p0,f32x16&p1,int jb,int qrel,int hi){
  const float NEG=-INFINITY; int kb=64*jb+4*hi;
  #pragma unroll
  for(int r=0;r<16;++r){int kv=kb+(r&3)+8*(r>>2); if(kv>qrel)p0[r]=NEG; if(kv+32>qrel)p1[r]=NEG;}
}

constexpr int NSLOT=3, SLOTB=8192;
constexpr int LDS_K=0, LDS_V=NSLOT*SLOTB, LDS_WS=2*NSLOT*SLOTB, LDS_OST=LDS_WS+NW*64*4, LDS_KM=LDS_OST+NW*4096, LDS_BYTES=LDS_KM+4096;
constexpr float C2=0.125f*1.4426950408889634f;
__device__ __forceinline__ void glds16(const void*gsrc,unsigned lds_dst){unsigned keep;
  asm volatile("s_mov_b32 %0, m0\n\ts_mov_b32 m0, %2\n\ts_nop 0\n\tglobal_load_lds_dwordx4 %1, off\n\ts_mov_b32 m0, %0":"=&s"(keep):"v"(gsrc),"s"(lds_dst):"memory");}
__device__ __forceinline__ float max3f(float a,float b,float c){float r;asm("v_max3_f32 %0, %1, %2, %3":"=v"(r):"v"(a),"v"(b),"v"(c));return r;}
__device__ __forceinline__ float max2f(float a,float b){float r;asm("v_max_f32_e32 %0, %1, %2":"=v"(r):"v"(a),"v"(b));return r;}
__device__ __forceinline__ float fadd_s(float a,float b){float r;asm("v_add_f32_e32 %0, %1, %2":"=v"(r):"v"(a),"v"(b));return r;}
__device__ __forceinline__ float fsub_s(float a,float b){float r;asm("v_sub_f32_e32 %0, %1, %2":"=v"(r):"v"(a),"v"(b));return r;}
typedef float f32x2_t __attribute__((ext_vector_type(2))); typedef __bf16 bf16x2_t __attribute__((ext_vector_type(2)));
__device__ __forceinline__ unsigned cvtpk_s(float lo,float hi){f32x2_t v={lo,hi};bf16x2_t b=__builtin_convertvector(v,bf16x2_t);return __builtin_bit_cast(unsigned,b);}
#define WAIT_BAR(N) asm volatile("s_waitcnt vmcnt(" #N ") lgkmcnt(0)\n\ts_barrier":::"memory")

__device__ __forceinline__ void qkt(f32x16&p0,f32x16&p1,const char*Kslot,const bf16x8*qr,int r32,int hi){
  const char*kb=Kslot+hi*1024+r32*16;
  #pragma unroll
  for(int d0=0;d0<4;++d0){
    const bf16x8 b0=*reinterpret_cast<const bf16x8*>(kb+d0*2048);
    const bf16x8 b1=*reinterpret_cast<const bf16x8*>(kb+d0*2048+512);
    p0=__builtin_amdgcn_mfma_f32_32x32x16_bf16(b0,qr[d0],p0,0,0,0);p1=__builtin_amdgcn_mfma_f32_32x32x16_bf16(b1,qr[d0],p1,0,0,0);}
}
typedef __attribute__((address_space(3))) const char* lds_cptr;
typedef short v4i16_t __attribute__((ext_vector_type(4)));
__device__ __forceinline__ void kload8(bf16x8*kf,lds_cptr kp){
  kf[0]=*(const __attribute__((address_space(3))) bf16x8*)(kp);      kf[1]=*(const __attribute__((address_space(3))) bf16x8*)(kp+512);
  kf[2]=*(const __attribute__((address_space(3))) bf16x8*)(kp+2048); kf[3]=*(const __attribute__((address_space(3))) bf16x8*)(kp+2560);
  kf[4]=*(const __attribute__((address_space(3))) bf16x8*)(kp+4096); kf[5]=*(const __attribute__((address_space(3))) bf16x8*)(kp+4608);
  kf[6]=*(const __attribute__((address_space(3))) bf16x8*)(kp+6144); kf[7]=*(const __attribute__((address_space(3))) bf16x8*)(kp+6656);
}
__device__ __forceinline__ void kload2(bf16x8*kf,lds_cptr kp,int j){ kf[2*j]=*(const __attribute__((address_space(3))) bf16x8*)(kp+j*2048); kf[2*j+1]=*(const __attribute__((address_space(3))) bf16x8*)(kp+j*2048+512); }
__device__ __forceinline__ s16x4 vtr(lds_cptr p){ return __builtin_bit_cast(s16x4,__builtin_amdgcn_ds_read_tr16_b64_v4i16((__attribute__((address_space(3))) v4i16_t*)p)); }
__device__ __forceinline__ float rowmax(const f32x16&p0,const f32x16&p1){
  float a=max3f(p0[0],p0[1],p1[0]),b=max3f(p0[2],p0[3],p1[1]);a=max3f(a,p1[2],p1[3]);
  #pragma unroll
  for(int r=4;r<16;r+=4){a=max3f(a,p0[r],p0[r+1]);b=max3f(b,p0[r+2],p0[r+3]);a=max3f(a,p1[r],p1[r+1]);b=max3f(b,p1[r+2],p1[r+3]);}
  const float m=max2f(a,b);
  auto rr=__builtin_amdgcn_permlane32_swap(__float_as_uint(m),__float_as_uint(m),false,false);
  return max2f(__uint_as_float(rr[0]),__uint_as_float(rr[1]));
}
__device__ __forceinline__ void pv(f32x16*o,int vb,bf16x8 pa0,bf16x8 pa1,bf16x8 pa2,bf16x8 pa3){
  #pragma unroll
  for(int d0=0;d0<2;++d0){s16x4 lo[4],hi[4];
    #pragma unroll
    for(int ks=0;ks<4;++ks){
      asm volatile("ds_read_b64_tr_b16 %0,%1 offset:%c2":"=&v"(lo[ks]):"v"(vb),"i"(d0*4096+ks*1024):"memory");
      asm volatile("ds_read_b64_tr_b16 %0,%1 offset:%c2":"=&v"(hi[ks]):"v"(vb),"i"(d0*4096+ks*1024+512):"memory");}
    asm volatile("s_waitcnt lgkmcnt(0)":::"memory");SBAR();
    #define PK(k) (bf16x8){lo[k][0],lo[k][1],lo[k][2],lo[k][3],hi[k][0],hi[k][1],hi[k][2],hi[k][3]}
    o[d0]=__builtin_amdgcn_mfma_f32_32x32x16_bf16(pa0,PK(0),o[d0],0,0,0);
    o[d0]=__builtin_amdgcn_mfma_f32_32x32x16_bf16(pa1,PK(1),o[d0],0,0,0);
    o[d0]=__builtin_amdgcn_mfma_f32_32x32x16_bf16(pa2,PK(2),o[d0],0,0,0);
    o[d0]=__builtin_amdgcn_mfma_f32_32x32x16_bf16(pa3,PK(3),o[d0],0,0,0);
    #undef PK
  }
}

#ifndef ATTN_STORE16
#define ATTN_STORE16(p,v) __builtin_amdgcn_raw_buffer_store_b128((v),orsrc_,(unsigned)((const char*)(p)-(const char*)O),0,16)
#endif
template<int THRL> __device__ __forceinline__ void attn_unit(int b,int h,int qb,const bf16*Q,const bf16*__restrict__ K,const bf16*__restrict__ V,bf16*O,const float*kmean,char*shm){
  const int tid=threadIdx.x,lane=tid&63,r32=lane&31,hi=lane>>5; const int wid=__builtin_amdgcn_readfirstlane(tid>>6);
  const long rowbase=(long)b*SEQ; const int q0=qb*QB;
  const bf16*Qw=Q+(rowbase+q0+wid*QBLK)*DM+h*D;
  const bf16*Kh=K+rowbase*DM+h*D,*Vh=V+rowbase*DM+h*D;
  const unsigned lds0=(unsigned)(uintptr_t)shm;
  float*wsf=(float*)(shm+LDS_WS)+wid*64;
  const bf16*ksrc=Kh+(long)lane*DM+wid*8;
  const bf16*vsrc=Vh+(long)(16*(wid&3)+(lane>>2))*DM+(wid>>2)*32+(lane&3)*8;
  const unsigned kdst=lds0+LDS_K+wid*1024, vdst=lds0+LDS_V+wid*1024;
  #define POS(t) (((t)<4)?(NT-4+(t)):((t)-4))
  #define DMA_K(t,slot) glds16(ksrc+(long)POS(t)*KVBLK*DM,(unsigned)__builtin_amdgcn_readfirstlane(kdst+(slot)))
  #define DMA_V(t,slot) glds16(vsrc+(long)POS(t)*KVBLK*DM,(unsigned)__builtin_amdgcn_readfirstlane(vdst+(slot)))
  const int vb0=(int)(lds0+LDS_V)+((lane>>4)&1)*32+(lane&3)*8+(4*hi+((lane&15)>>2))*64;
  const char*Kbase=shm+LDS_K; bf16x8 kf[8];
  const lds_cptr shm3=(lds_cptr)shm; const lds_cptr kp0=shm3+LDS_K+hi*1024+r32*16; const lds_cptr vp0=shm3+LDS_V+((lane>>4)&1)*32+(lane&3)*8+(4*hi+((lane&15)>>2))*64;
  const int NT=(q0+QB)/KVBLK;
  DMA_K(0,0);DMA_V(0,0);DMA_K(1,SLOTB);
  bf16x8 qr[4];
  #pragma unroll
  for(int d0=0;d0<4;++d0)qr[d0]=*reinterpret_cast<const bf16x8*>(&Qw[(long)r32*DM+d0*16+hi*8]);
  float mhat=0.f,l_reg=0.f;f32x16 o[2];o[0]=f32x16{};o[1]=f32x16{};
  const float slope2=ldexpf(1.4426950408889634f,-(h+1));
  unsigned selmask=0u;
  { typedef __attribute__((address_space(3))) float* lds_fptr; typedef __attribute__((address_space(3))) const f32x4_t* lds_f4ptr;
    lds_fptr kml=(lds_fptr)((lds_cptr)shm+LDS_KM);
    { const float*src=kmean+((long)b*16)*2*DM+h*D;
      #pragma unroll
      for(int i=0;i<2;++i){const int e=tid+512*i; kml[e]=src[(e>>6)*2*DM+(e&63)]+src[(e>>6)*2*DM+DM+(e&63)];} }
    asm volatile("s_waitcnt vmcnt(0) lgkmcnt(0)\n\ts_barrier":::"memory");
    float qf[32];
    #pragma unroll
    for(int d0=0;d0<4;++d0){
      #pragma unroll
      for(int j=0;j<8;++j)qf[d0*8+j]=__uint_as_float(((unsigned)(unsigned short)qr[d0][j])<<16);}
    float sc[16];
    #pragma unroll
    for(int j=0;j<16;++j){ sc[j]=-INFINITY;
      if(j<qb){ lds_f4ptr kr=(lds_f4ptr)(kml+j*64+hi*8); float a=0.f;
        #pragma unroll
        for(int d0=0;d0<4;++d0){ const f32x4_t k0=kr[d0*4],k1=kr[d0*4+1];
          a+=qf[d0*8+0]*k0[0]+qf[d0*8+1]*k0[1]+qf[d0*8+2]*k0[2]+qf[d0*8+3]*k0[3]+qf[d0*8+4]*k1[0]+qf[d0*8+5]*k1[1]+qf[d0*8+6]*k1[2]+qf[d0*8+7]*k1[3]; }
        a+=__shfl_xor(a,32); sc[j]=a; } }
    #pragma unroll
    for(int j=0;j<15;++j){ int cnt=0;
      #pragma unroll
      for(int k=0;k<15;++k){ if(k!=j) cnt+=((sc[k]>sc[j])||((sc[k]==sc[j])&&(k<j)))?1:0; }
      if(j<qb&&cnt<3) selmask|=(1u<<j); } }
  #define CINIT(C0,C1,t) do{ const int pt_=POS(t); float x_=slope2*(float)(64*pt_-q0+4*hi)-mhat; \
    if((t)>=4){ x_+=((selmask>>(pt_>>2))&1u)?0.f:-30000.f; } const float y_=x_+32.f*slope2; \
    _Pragma("unroll") for(int r=0;r<16;++r){ const float cr_=(float)((r&3)+8*(r>>2)); C0[r]=__builtin_fmaf(slope2,cr_,x_); C1[r]=__builtin_fmaf(slope2,cr_,y_); } }while(0)

  const int qrel=wid*QBLK+r32;
  #define CMASK(P0,P1,t) do{ if((t)<4)cmask(P0,P1,(t),qrel,hi);}while(0)
  bool resc=false;
  #define START(P0,P1) do{ const float rm=rowmax(P0,P1); resc=false; \
    { const float dl=rm; mhat=fadd_s(mhat,dl); \
      _Pragma("unroll") for(int r=0;r<16;++r){P0[r]=fsub_s(P0[r],dl);P1[r]=fsub_s(P1[r],dl);} } \
    _Pragma("unroll") for(int r=0;r<16;++r)P0[r]=__builtin_amdgcn_exp2f(P0[r]); }while(0)
  #define RESC() do{ if(resc){ asm volatile("s_waitcnt lgkmcnt(0)":::"memory"); \
      _Pragma("unroll") for(int d_=0;d_<2;++d_) _Pragma("unroll") for(int r=0;r<16;++r)o[d_][r]*=wsf[crow(r,hi)]; } }while(0)
  f32x16 pA0,pA1,pB0,pB1;
  int sl_prev=0,sl_cur=0,sl_next=SLOTB;
  #define ROT() do{sl_prev=sl_cur;sl_cur=sl_next;sl_next=(sl_next==(NSLOT-1)*SLOTB)?0:sl_next+SLOTB;}while(0)
  DMA_K(2,2*SLOTB);
  WAIT_BAR(3);
  CINIT(pA0,pA1,0); qkt(pA0,pA1,Kbase,qr,r32,hi);asm volatile("s_nop 15\n\ts_nop 7":"+v"(pA0),"+v"(pA1));CMASK(pA0,pA1,0);
  START(pA0,pA1);
  _Pragma("unroll") for(int r=0;r<16;++r)pA1[r]=__builtin_amdgcn_exp2f(pA1[r]);
  WAIT_BAR(0);
  DMA_K(3,0);DMA_V(1,SLOTB);
  ROT();
  kload8(kf,kp0+sl_cur);
  WAIT_BAR(2);
  s16x4 vlo[8],vhi[8]; u32x4 pw0,pw1,pw2,pw3;
  #define PKW(P,B) cvtpk_s(P[B],P[B+1])
  #define PAF(k) __builtin_bit_cast(bf16x8,pw##k)
  #define VFR(i) (bf16x8){vlo[i][0],vlo[i][1],vlo[i][2],vlo[i][3],vhi[i][0],vhi[i][1],vhi[i][2],vhi[i][3]}
  #define PIN(x) asm volatile("":"+v"(x))
  #define MX3(a,b,c) __builtin_fmaxf(__builtin_fmaxf((a),(b)),(c))
  #define GAPA(MF,A0,A1,A2,A3,W0,W1,PW) do{ MF; sacc+=A0; sacc+=A1; sacc+=A2; sacc+=A3; PIN(sacc); W0; W1; PIN(PW); SBAR(); }while(0)
  #define EX(v) __builtin_amdgcn_exp2f(v)
  #define GAPB(MF,X,B) do{ MF; X[B]=EX(X[B]); X[B+1]=EX(X[B+1]); X[B+2]=EX(X[B+2]); X[B+3]=EX(X[B+3]); PIN(X); SBAR(); }while(0)
  #define VRD(i) do{ vlo[i]=vtr(vp_+(((i)>>2)*4096+((i)&3)*1024)); vhi[i]=vtr(vp_+(((i)>>2)*4096+((i)&3)*1024+512)); }while(0)
  #define KRD(G,j) do{ if(G){ kload2(kf,kp0+sl_next,j); SBAR(); } }while(0)
  #define STEP(C0,C1,P0,P1,t,GK,GV,GL) do{ SBAR(); CINIT(C0,C1,t); PIN(C0); PIN(C1); SBAR(); \
    const lds_cptr vp_=vp0+sl_prev; \
    VRD(0); SBAR(); float sacc=(P0[0]+P0[1]); \
    GAPA(C0=__builtin_amdgcn_mfma_f32_32x32x16_bf16(kf[0],qr[0],C0,0,0,0), P0[2],P0[3],P0[4],P0[5],     pw0[0]=PKW(P0,0), pw0[1]=PKW(P0,2), pw0); \
    VRD(4); SBAR(); GAPA(C1=__builtin_amdgcn_mfma_f32_32x32x16_bf16(kf[1],qr[0],C1,0,0,0), P0[6],P0[7],P0[8],P0[9],     pw0[2]=PKW(P0,4), pw0[3]=PKW(P0,6), pw0); \
    VRD(1); SBAR(); GAPA(C0=__builtin_amdgcn_mfma_f32_32x32x16_bf16(kf[2],qr[1],C0,0,0,0),   P0[10],P0[11],P0[12],P0[13], pw1[0]=PKW(P0,8), pw1[1]=PKW(P0,10), pw1); \
    VRD(5); SBAR(); GAPA(C1=__builtin_amdgcn_mfma_f32_32x32x16_bf16(kf[3],qr[1],C1,0,0,0),   P0[14],P0[15],P1[0],P1[1],   pw1[2]=PKW(P0,12),pw1[3]=PKW(P0,14), pw1); \
    VRD(2); SBAR(); GAPA(C0=__builtin_amdgcn_mfma_f32_32x32x16_bf16(kf[4],qr[2],C0,0,0,0),   P1[2],P1[3],P1[4],P1[5],     pw2[0]=PKW(P1,0), pw2[1]=PKW(P1,2), pw2); \
    VRD(6); SBAR(); GAPA(C1=__builtin_amdgcn_mfma_f32_32x32x16_bf16(kf[5],qr[2],C1,0,0,0),   P1[6],P1[7],P1[8],P1[9],     pw2[2]=PKW(P1,4), pw2[3]=PKW(P1,6), pw2); \
    VRD(3); SBAR(); GAPA(C0=__builtin_amdgcn_mfma_f32_32x32x16_bf16(kf[6],qr[3],C0,0,0,0),   P1[10],P1[11],P1[12],P1[13], pw3[0]=PKW(P1,8), pw3[1]=PKW(P1,10), pw3); \
    VRD(7); SBAR(); GAPA(C1=__builtin_amdgcn_mfma_f32_32x32x16_bf16(kf[7],qr[3],C1,0,0,0),   P1[14],P1[15],0.f,0.f,       pw3[2]=PKW(P1,12),pw3[3]=PKW(P1,14), pw3); \
    l_reg+=sacc; \
    if(GK){DMA_K((t)+3,sl_cur);} if(GV){DMA_V((t)+1,sl_next);} \
    CMASK(C0,C1,t); \
    { float a=MX3(C0[0],C0[1],C1[0]),b=MX3(C0[2],C0[3],C1[1]); a=MX3(a,C1[2],C1[3]); \
      _Pragma("unroll") for(int r=4;r<16;r+=4){a=MX3(a,C0[r],C0[r+1]);b=MX3(b,C0[r+2],C0[r+3]);a=MX3(a,C1[r],C1[r+1]);b=MX3(b,C1[r+2],C1[r+3]);} \
      float rm=__builtin_fmaxf(a,b); { auto rr=__builtin_amdgcn_permlane32_swap(__float_as_uint(rm),__float_as_uint(rm),false,false); rm=__builtin_fmaxf(__uint_as_float(rr[0]),__uint_as_float(rr[1])); } \
      resc=false; \
      if(__builtin_expect(__any(rm>(float)THRL),0)){ const float dl=__builtin_fmaxf(rm,0.f); mhat+=dl; \
        _Pragma("unroll") for(int r=0;r<16;++r){C0[r]-=dl;C1[r]-=dl;} \
        const float f=__builtin_amdgcn_exp2f(-dl); l_reg*=f; if(hi==0)wsf[r32]=f; resc=true; } } \
    SBAR(); \
    GAPB(o[0]=__builtin_amdgcn_mfma_f32_32x32x16_bf16(PAF(0),VFR(0),o[0],0,0,0), C0,0); \
    GAPB(o[1]=__builtin_amdgcn_mfma_f32_32x32x16_bf16(PAF(0),VFR(4),o[1],0,0,0), C0,4); \
    KRD(GL,0); GAPB(o[0]=__builtin_amdgcn_mfma_f32_32x32x16_bf16(PAF(1),VFR(1),o[0],0,0,0), C0,8); \
    KRD(GL,1); GAPB(o[1]=__builtin_amdgcn_mfma_f32_32x32x16_bf16(PAF(1),VFR(5),o[1],0,0,0), C0,12); \
    KRD(GL,2); GAPB(o[0]=__builtin_amdgcn_mfma_f32_32x32x16_bf16(PAF(2),VFR(2),o[0],0,0,0), C1,0); \
    KRD(GL,3); GAPB(o[1]=__builtin_amdgcn_mfma_f32_32x32x16_bf16(PAF(2),VFR(6),o[1],0,0,0), C1,4); \
    GAPB(o[0]=__builtin_amdgcn_mfma_f32_32x32x16_bf16(PAF(3),VFR(3),o[0],0,0,0), C1,8); \
    GAPB(o[1]=__builtin_amdgcn_mfma_f32_32x32x16_bf16(PAF(3),VFR(7),o[1],0,0,0), C1,12); \
    }while(0)
  int t=1;
  #define ENDW(tt) do{ if((tt)+3<NT){WAIT_BAR(2);} else if((tt)+2<NT){WAIT_BAR(1);} else {WAIT_BAR(0);} }while(0)
  for(;t<5&&t+1<NT;t+=2){
    STEP(pB0,pB1,pA0,pA1,t,(t+3<NT),(t+1<NT),(t+1<NT));       ENDW(t);   RESC(); ROT();
    STEP(pA0,pA1,pB0,pB1,t+1,(t+4<NT),(t+2<NT),(t+2<NT));     ENDW(t+1); RESC(); ROT();
  }
  #undef CMASK
  #define CMASK(P0,P1,t) do{}while(0)
  for(;t+5<NT;t+=2){
    STEP(pB0,pB1,pA0,pA1,t,true,true,true);     WAIT_BAR(2); RESC(); ROT();
    STEP(pA0,pA1,pB0,pB1,t+1,true,true,true);   WAIT_BAR(2); RESC(); ROT();
  }
  for(;t+1<NT;t+=2){
    STEP(pB0,pB1,pA0,pA1,t,(t+3<NT),(t+1<NT),(t+1<NT));       ENDW(t);   RESC(); ROT();
    STEP(pA0,pA1,pB0,pB1,t+1,(t+4<NT),(t+2<NT),(t+2<NT));     ENDW(t+1); RESC(); ROT();
  }
  #undef CMASK
  #define CMASK(P0,P1,t) do{ if((t)<4)cmask(P0,P1,(t),qrel,hi);}while(0)
  STEP(pB0,pB1,pA0,pA1,NT-1,false,false,false); RESC();
  { float sacc=pB0[0]+pB0[1]; _Pragma("unroll") for(int r=2;r<16;++r)sacc+=pB0[r]; _Pragma("unroll") for(int r=0;r<16;++r)sacc+=pB1[r]; l_reg+=sacc;
    pw0=(u32x4){PKW(pB0,0),PKW(pB0,2),PKW(pB0,4),PKW(pB0,6)};pw1=(u32x4){PKW(pB0,8),PKW(pB0,10),PKW(pB0,12),PKW(pB0,14)};pw2=(u32x4){PKW(pB1,0),PKW(pB1,2),PKW(pB1,4),PKW(pB1,6)};pw3=(u32x4){PKW(pB1,8),PKW(pB1,10),PKW(pB1,12),PKW(pB1,14)};
    SBAR(); pv(o,vb0+sl_cur,PAF(0),PAF(1),PAF(2),PAF(3)); }
  #undef PKW
  #undef PAF
  #undef VFR
  #undef PIN
  #undef MX3
  #undef GAPA
  #undef GAPB
  #undef EX
  #undef VRD
  #undef KRD
  #undef STEP
  #undef ENDW
  {auto rr=__builtin_amdgcn_permlane32_swap(__float_as_uint(l_reg),__float_as_uint(l_reg),false,false);l_reg=__uint_as_float(rr[0])+__uint_as_float(rr[1]);}
  if(hi==0)wsf[32+r32]=l_reg;asm volatile("s_waitcnt lgkmcnt(0)":::"memory");
  float rli[16];
  #pragma unroll
  for(int r=0;r<16;++r)rli[r]=__builtin_amdgcn_rcpf(wsf[32+crow(r,hi)]);
  bf16*Ow=O+(rowbase+q0+wid*QBLK)*OPITCH+h*D; const __amdgpu_buffer_rsrc_t orsrc_=__builtin_amdgcn_make_buffer_rsrc((void*)O,0,0x7fffffff,0x00020000);
  { bf16*stg=(bf16*)(shm+LDS_OST)+wid*2048;
    #pragma unroll
    for(int r=0;r<16;++r){const int orow=crow(r,hi);
      #pragma unroll
      for(int d0=0;d0<2;++d0)stg[orow*64+d0*32+r32]=__float2bfloat16(o[d0][r]*rli[r]);}
    asm volatile("s_waitcnt lgkmcnt(0)":::"memory");
    #pragma unroll
    for(int i=0;i<4;++i){const int row=i*8+(lane>>3),ch=lane&7; const u32x4 v=*(const u32x4*)(stg+row*64+ch*8); ATTN_STORE16(Ow+(long)row*OPITCH+ch*8,v);} }
  asm volatile("s_waitcnt lgkmcnt(0)\n\ts_barrier":::"memory");
  #undef DMA_K
  #undef DMA_V
  #undef POS
  #undef CINIT
  #undef CMASK
  #undef START
  #undef RESC
  #undef ROT
}
constexpr int ATTN_LDS_BYTES=LDS_BYTES;
struct AttnTensors { const bf16* Q; const bf16* K; const bf16* V; bf16* O; const float* kmean; };
struct AttnUnit { int bh; int qb; };
struct StaticOrder {
  int vcu,grid;
  __device__ __forceinline__ explicit StaticOrder(int grid_,int block):vcu((grid_%8==0)?((block%8)*(grid_/8)+block/8):block),grid(grid_){}
  __device__ __forceinline__ bool next(int i,AttnUnit&u)const{ const int item=(i>>1)*grid+vcu; if(item>=BATCH*NHEAD*8)return false; const int s=item&7; u.bh=item>>3; u.qb=(i&1)?15-s:s; return true; }
  __device__ __forceinline__ void a_ready(const AttnUnit&)const{}
  __device__ __forceinline__ void done(const AttnUnit&)const{}
};
template<class Sched,int THRL=8> __device__ __forceinline__ void attn_phase(char*lds,const AttnTensors&T,const Sched&S){
  AttnUnit u;
  for(int i=0;S.next(i,u);++i){ S.a_ready(u); attn_unit<THRL>(u.bh/NHEAD,u.bh%NHEAD,u.qb,T.Q,T.K,T.V,T.O,T.kmean,lds); S.done(u); }
}
#undef SBAR
#undef WAIT_BAR
}

constexpr int NWAVES = 8;
#ifndef MK_N_LAUNCHES
#define MK_N_LAUNCHES 1
#endif
constexpr int N_LAUNCHES = MK_N_LAUNCHES;
constexpr int PER_PHASE = 8;

constexpr int BATCH = 8, SEQ = 4096, DM = 1024, TOK = BATCH * SEQ;
constexpr int CONV_CH = 512, CONV_W = 31, ATT_W = 512, IN_COLS = 4608;
constexpr int P_HEADS = 8, P_NK = 128, P_TOPK = 16, P_E = P_HEADS * P_TOPK  , N_EXP = P_NK * P_NK;
constexpr float NORM_EPS = 1e-6f;

constexpr size_t MiB = 1u << 20;
constexpr size_t WS_CTL = 0, CTL_ZERO_BYTES = 65536;
constexpr size_t WS_KMEAN = 1 * MiB;
constexpr size_t WS_SS = 2 * MiB;
constexpr size_t WS_WIN = 4 * MiB;
constexpr size_t WS_WPW = 13 * MiB, WS_WAO = 14 * MiB;
constexpr size_t WS_WOUT = 15 * MiB;
constexpr size_t WS_WQ = 17 * MiB;
constexpr size_t WS_KEYS = 21 * MiB;
constexpr size_t WS_USC = 22 * MiB, WS_VSC = 22 * MiB + 65536;
constexpr size_t WS_UB = 24 * MiB, WS_VB = 56 * MiB;
constexpr size_t WS_H = 88 * MiB;
constexpr size_t WS_CACT = 88 * MiB;
constexpr size_t WS_EIDX = 104 * MiB, WS_GW = 120 * MiB, WS_GA = 136 * MiB;
constexpr size_t WS_ZGLU = 152 * MiB, WS_QO = 184 * MiB, WS_K = 216 * MiB, WS_V = 248 * MiB;
constexpr size_t WS_MIX = 216 * MiB;
constexpr size_t WS_QP = 152 * MiB;
constexpr size_t WS_COEF = 152 * MiB, WS_SS2 = 168 * MiB;
constexpr size_t WS_GC = 280 * MiB, WS_GATE_A = 344 * MiB;
constexpr size_t WS_X1B = 280 * MiB;
constexpr size_t WS_X8 = 344 * MiB, WS_XS = 377 * MiB;
constexpr size_t WS_END = 408 * MiB;
constexpr int CW_TMO = 0, CW_CODE = 1, CW_CONVQ = 64, CW_BAR = 4096;

constexpr int RING_OFF = 0, RING_BYTES = 131072;
constexpr int LDSCTL_OFF = RING_BYTES, MISC_OFF = LDSCTL_OFF + 320;
constexpr int LDS_BYTES = 155648;
constexpr int VT_PITCH = 144, VT_BYTES = 128 * VT_PITCH, VT_LAST_OFF = LDSCTL_OFF + 1024, P7_CNT_OFF = LDSCTL_OFF + 512;
static_assert(7 * VT_BYTES <= RING_BYTES && VT_LAST_OFF + VT_BYTES <= LDS_BYTES && MISC_OFF + 128 <= P7_CNT_OFF, "PEER v tiles");
constexpr float C8_SCALE = 4096.f;
static_assert(MISC_OFF + 128 <= LDS_BYTES, "LDS map");

#define GAS __attribute__((address_space(1)))
#define LAS __attribute__((address_space(3)))
typedef unsigned short bf16;
typedef unsigned v4u __attribute__((ext_vector_type(4)));
typedef float f32x4 __attribute__((ext_vector_type(4)));
typedef float f32x16 __attribute__((ext_vector_type(16)));
typedef short bf16x8 __attribute__((ext_vector_type(8)));
typedef __bf16 bf16x2_t __attribute__((ext_vector_type(2)));
typedef GAS unsigned gu32;
#define RLX_AGENT __ATOMIC_RELAXED, __HIP_MEMORY_SCOPE_AGENT
#define LDS_WAIT() asm volatile("s_waitcnt lgkmcnt(0)" ::: "memory")
#define VM_WAIT() asm volatile("s_waitcnt vmcnt(0)" ::: "memory")
__device__ __forceinline__ unsigned f2bf(float f) { unsigned u = __builtin_bit_cast(unsigned, f); return (u + 0x7fffu + ((u >> 16) & 1u)) >> 16; }
__device__ __forceinline__ unsigned pk2(float lo, float hi) { return f2bf(lo) | (f2bf(hi) << 16); }
__device__ __forceinline__ float bflo(unsigned u) { return __uint_as_float(u << 16); }
__device__ __forceinline__ float bfhi(unsigned u) { return __uint_as_float(u & 0xffff0000u); }

#define XB_TMO      128
#define XB_XCNT(j)  (256  + 64 * (j))
#define XB_XSUB(j)  (1280 + 64 * (j))
#define XB_XGEN(j)  (2304 + 64 * (j))
#define XB_TOP      3328
#define XB_TOPGEN   3392
#define XCD_BAR_WORDS 3456
#define XB_SPIN_CAP (1u << 18)

__device__ __forceinline__ unsigned xb_ld(unsigned* p)              { return __hip_atomic_load(p, __ATOMIC_RELAXED, __HIP_MEMORY_SCOPE_AGENT); }
__device__ __forceinline__ unsigned xb_add(unsigned* p, unsigned v) { return __hip_atomic_fetch_add(p, v, __ATOMIC_RELAXED, __HIP_MEMORY_SCOPE_AGENT); }
__device__ __forceinline__ unsigned xb_xcc_id() { return (unsigned)__builtin_amdgcn_s_getreg((3 << 11) | 20) & 0xFu; }
#define XB_SPIN(cond, bar) do { unsigned _sp = 0; while (cond) { __builtin_amdgcn_s_sleep(1); \
    if ((++_sp & 255u) == 0u) { if (xb_ld(&(bar)[XB_TMO])) break; if (_sp > XB_SPIN_CAP) { atomicAdd(&(bar)[XB_TMO], 1u); break; } } } } while (0)

struct XcdBarrier {
    unsigned* bar; unsigned x;
    volatile LAS unsigned* st;
};

__device__ __forceinline__ XcdBarrier xcd_barrier_post(unsigned* bar, volatile LAS unsigned* st) {
    XcdBarrier b; b.bar = bar; b.x = xb_xcc_id(); b.st = st;
    if (threadIdx.x == 0) (void)xb_add(&bar[XB_XCNT(b.x)], 1u);
    return b;
}
__device__ __forceinline__ void xcd_barrier_complete(unsigned* bar, unsigned x, unsigned& nloc, unsigned& nx) {
    const unsigned G = gridDim.x * gridDim.y * gridDim.z;
    unsigned sum, cnt, mine, sp = 0u;
    for (;;) {
        sum = 0u; cnt = 0u; mine = 0u;
#pragma unroll
        for (unsigned j = 0; j < 16; ++j) { const unsigned c = xb_ld(&bar[XB_XCNT(j)]); sum += c; cnt += (c > 0u) ? 1u : 0u; mine = (j == x) ? c : mine; }
        if (sum == G) break;
        __builtin_amdgcn_s_sleep(1);
        if ((++sp & 255u) == 0u) { if (xb_ld(&bar[XB_TMO])) break; if (sp > XB_SPIN_CAP) { atomicAdd(&bar[XB_TMO], 1u); break; } }
    }
    nloc = mine > 0u ? mine : 1u; nx = cnt > 0u ? cnt : 1u;
}

__device__ __forceinline__ void xcd_barrier(const XcdBarrier& b) {
    asm volatile("s_waitcnt vmcnt(0)" ::: "memory");
    __syncthreads();
    if (threadIdx.x == 0) {
        unsigned* bar = b.bar;
        __builtin_amdgcn_s_waitcnt(0);
        unsigned nloc = b.st[0], nx = b.st[1];
        if (nloc == 0u) { xcd_barrier_complete(bar, b.x, nloc, nx); b.st[0] = nloc; b.st[1] = nx; }
        const unsigned old = xb_add(&bar[XB_XSUB(b.x)], 1u);
        const unsigned gen = old / nloc;
        if (old + 1u == (gen + 1u) * nloc) {
            __builtin_amdgcn_fence(__ATOMIC_RELEASE, "agent");
            asm volatile("s_waitcnt vmcnt(0)" ::: "memory");
            const unsigned og = xb_add(&bar[XB_TOP], 1u);
            const unsigned tg = og / nx;
            if (og + 1u == (tg + 1u) * nx) xb_add(&bar[XB_TOPGEN], 1u);
            else XB_SPIN(xb_ld(&bar[XB_TOPGEN]) == tg, bar);
            __builtin_amdgcn_fence(__ATOMIC_ACQUIRE, "agent");
            xb_add(&bar[XB_XGEN(b.x)], 1u);
            asm volatile("s_waitcnt vmcnt(0)" ::: "memory");
        } else {
            XB_SPIN(xb_ld(&bar[XB_XGEN(b.x)]) == gen, bar);
            __builtin_amdgcn_fence(__ATOMIC_ACQUIRE, "agent");
            asm volatile("s_waitcnt vmcnt(0)" ::: "memory");
        }
    }
    __syncthreads();
}

struct Frame {
    LAS unsigned char* lds;
    volatile LAS unsigned* MISC;
    gu32* ctl;
    int tid, lane, wave;
    int vcu, G;
};
__device__ __forceinline__ float wave_sum(float v) {
#pragma unroll
    for (int o = 1; o < 64; o <<= 1) v += __shfl_xor(v, o);
    return v;
}

__device__ __forceinline__ float wave_sum_hi(float v) {
    v += __builtin_bit_cast(float, __builtin_amdgcn_update_dpp(0, __builtin_bit_cast(int, v), 0xB1, 0xf, 0xf, false));
    v += __builtin_bit_cast(float, __builtin_amdgcn_update_dpp(0, __builtin_bit_cast(int, v), 0x4E, 0xf, 0xf, false));
    v += __builtin_bit_cast(float, __builtin_amdgcn_update_dpp(0, __builtin_bit_cast(int, v), 0x141, 0xf, 0xf, false));
    v += __builtin_bit_cast(float, __builtin_amdgcn_update_dpp(0, __builtin_bit_cast(int, v), 0x140, 0xf, 0xf, false));
    v += __builtin_bit_cast(float, __builtin_amdgcn_update_dpp(0, __builtin_bit_cast(int, v), 0x142, 0xA, 0xF, false));
    v += __builtin_bit_cast(float, __builtin_amdgcn_update_dpp(0, __builtin_bit_cast(int, v), 0x143, 0xC, 0xF, false));
    return v;
}

__device__ __forceinline__ void p0_transpose_item(const float* W, int K, int N, bf16* WT, int k0, int n0, int dst_row0, const float* kscale, LAS float* scr, int lane, int dpitch = 0, int koff = 0) {
    if (dpitch == 0) dpitch = K;
#pragma unroll 8
    for (int i = 0; i < 32; ++i) { const int kk = 2 * i + (lane >> 5); float v = W[(size_t)(k0 + kk) * N + n0 + (lane & 31)]; if (kscale) v *= kscale[k0 + kk]; scr[kk * 33 + (lane & 31)] = v; }
    LDS_WAIT(); asm volatile("" ::: "memory");
    const int c = lane & 7;
#pragma unroll
    for (int j = 0; j < 4; ++j) { const int n = (lane >> 3) + 8 * j; const LAS float* s = scr + (8 * c) * 33 + n;
        v4u o; o.x = pk2(s[0 * 33], s[1 * 33]); o.y = pk2(s[2 * 33], s[3 * 33]); o.z = pk2(s[4 * 33], s[5 * 33]); o.w = pk2(s[6 * 33], s[7 * 33]);
        *(GAS v4u*)(WT + (size_t)(dst_row0 + n) * dpitch + koff + k0 + 8 * c) = o; }
    LDS_WAIT(); asm volatile("" ::: "memory");
}
__device__ __forceinline__ int perm_in(int s) { if (s < 512) return 256 * (s >> 7) + (s & 127); if (s < 1024) { const int s2 = s - 512; return 256 * (s2 >> 7) + 128 + (s2 & 127); } return s; }
__device__ __forceinline__ float wave_max(float v) {
#pragma unroll
    for (int o = 1; o < 64; o <<= 1) v = fmaxf(v, __shfl_xor(v, o));
    return v;
}
template <bool NORM, int NR> __device__ __forceinline__ void rows_to_bf16(int lane, const float* xrow, size_t rstride, const float* g, bf16* orow) {
    f32x4 v[NR][4]; float s2[NR];
#pragma unroll
    for (int q = 0; q < NR; ++q) { const GAS f32x4* xr = (const GAS f32x4*)(xrow + q * rstride) + lane;
#pragma unroll
        for (int j = 0; j < 4; ++j) v[q][j] = xr[64 * j]; }
#pragma unroll
    for (int q = 0; q < NR; ++q) { s2[q] = 0.f;
#pragma unroll
        for (int j = 0; j < 4; ++j) s2[q] += (v[q][j].x * v[q][j].x + v[q][j].y * v[q][j].y) + (v[q][j].z * v[q][j].z + v[q][j].w * v[q][j].w); }
    float rstd[NR];
#pragma unroll
    for (int q = 0; q < NR; ++q) rstd[q] = NORM ? 1.f / sqrtf(wave_sum(s2[q]) * (1.f / 1024.f) + NORM_EPS) : 1.f;
#pragma unroll
    for (int j = 0; j < 4; ++j) { f32x4 gv = (f32x4){1.f, 1.f, 1.f, 1.f}; if (g) gv = *((const GAS f32x4*)g + lane + 64 * j);
#pragma unroll
        for (int q = 0; q < NR; ++q) { const f32x4 w = v[q][j] * rstd[q] * gv;
            ((GAS unsigned long long*)(orow + q * rstride) + lane)[64 * j] = (unsigned long long)pk2(w.x, w.y) | ((unsigned long long)pk2(w.z, w.w) << 32); } }
}
template <bool NORM> __device__ __forceinline__ void row_to_bf16(int lane, const float* xrow, const float* g, bf16* orow) { rows_to_bf16<NORM, 1>(lane, xrow, 1024, g, orow); }
template <bool SLICED> __device__ __forceinline__ void row_to_fp8(int lane, const float* xrow, const float* g, unsigned char* base, int row, float* isc) {
    const GAS f32x4* xr = (const GAS f32x4*)xrow + lane;
    f32x4 v[4]; float am = 0.f;
#pragma unroll
    for (int j = 0; j < 4; ++j) { v[j] = xr[64 * j]; if (g) v[j] = v[j] * *((const GAS f32x4*)g + lane + 64 * j);
        am = fmaxf(am, fmaxf(fmaxf(fabsf(v[j].x), fabsf(v[j].y)), fmaxf(fabsf(v[j].z), fabsf(v[j].w)))); }
#pragma unroll
    for (int o = 1; o < 64; o <<= 1) am = fmaxf(am, __shfl_xor(am, o));
    const float sc = am > 0.f ? 240.f / am : 1.f;
    if (lane == 0) isc[row] = am > 0.f ? am * (1.f / 240.f) : 1.f;
#pragma unroll
    for (int j = 0; j < 4; ++j) { int w = 0; w = __builtin_amdgcn_cvt_pk_fp8_f32(v[j].x * sc, v[j].y * sc, w, false); w = __builtin_amdgcn_cvt_pk_fp8_f32(v[j].z * sc, v[j].w * sc, w, true);
        if (SLICED) *(GAS int*)(base + (size_t)(2 * j + (lane >> 5)) * ((size_t)N_EXP * 128) + (size_t)row * 128 + 4 * (lane & 31)) = w;
        else *(GAS int*)(base + (size_t)row * 1024 + 4 * (lane + 64 * j)) = w; }
}
__device__ __forceinline__ void rows_to_fp8_uv(int lane, const float* urow, const float* vrow, const float* g, unsigned char* ub8, unsigned char* vb8, int row, float* usc, float* vsc) {
    f32x4 u[4], v[4]; float au = 0.f, av = 0.f;
#pragma unroll
    for (int j = 0; j < 4; ++j) { u[j] = ((const GAS f32x4*)urow + lane)[64 * j]; v[j] = ((const GAS f32x4*)vrow + lane)[64 * j]; }
#pragma unroll
    for (int j = 0; j < 4; ++j) { u[j] = u[j] * *((const GAS f32x4*)g + lane + 64 * j);
        au = fmaxf(au, fmaxf(fmaxf(fabsf(u[j].x), fabsf(u[j].y)), fmaxf(fabsf(u[j].z), fabsf(u[j].w))));
        av = fmaxf(av, fmaxf(fmaxf(fabsf(v[j].x), fabsf(v[j].y)), fmaxf(fabsf(v[j].z), fabsf(v[j].w)))); }
#pragma unroll
    for (int o = 1; o < 64; o <<= 1) { au = fmaxf(au, __shfl_xor(au, o)); av = fmaxf(av, __shfl_xor(av, o)); }
    const float su = au > 0.f ? 6.f / au : 1.f, sv = av > 0.f ? 6.f / av : 1.f;
    if (lane == 0) { usc[row] = au > 0.f ? au * (1.f / 6.f) : 1.f; vsc[row] = av > 0.f ? av * (1.f / 6.f) : 1.f; }
#pragma unroll
    for (int j = 0; j < 4; ++j) {
        { const float fu[4] = {u[j].x * su, u[j].y * su, u[j].z * su, u[j].w * su}; unsigned pk = 0;
#pragma unroll
          for (int i = 0; i < 4; ++i) { const float af = fabsf(fu[i]);
              const unsigned code = (af < 0.25f ? 0u : af < 0.75f ? 1u : af < 1.25f ? 2u : af < 1.75f ? 3u : af < 2.5f ? 4u : af < 3.5f ? 5u : af < 5.f ? 6u : 7u) | (fu[i] < 0.f ? 8u : 0u);
              pk |= code << (4 * i); }
          *(GAS unsigned short*)(ub8 + (size_t)row * 512 + 2 * (lane + 64 * j)) = (unsigned short)pk; }
        { const float fv[4] = {v[j].x * sv, v[j].y * sv, v[j].z * sv, v[j].w * sv}; unsigned pk = 0;
#pragma unroll
          for (int i = 0; i < 4; ++i) { const float af = fabsf(fv[i]);
              const unsigned code = (af < 0.25f ? 0u : af < 0.75f ? 1u : af < 1.25f ? 2u : af < 1.75f ? 3u : af < 2.5f ? 4u : af < 3.5f ? 5u : af < 5.f ? 6u : 7u) | (fv[i] < 0.f ? 8u : 0u);
              pk |= code << (4 * i); }
          const int c = 4 * lane + 256 * j;
          *(GAS unsigned short*)(vb8 + (size_t)(c >> 8) * ((size_t)N_EXP * 128) + (size_t)row * 128 + ((c & 255) >> 1)) = (unsigned short)pk; } }
}
struct P0Args { const float *x, *g1, *w_in, *w_pw, *w_ao, *w_out, *g2, *w_q, *k1, *k2, *pu, *pv; bf16 *H, *Win, *Wpw, *Wao, *Wout, *Wq, *keys; unsigned char *ub8, *vb8; float *usc, *vsc; };
__device__ __forceinline__ void p0_prologue(Frame& F, const P0Args& a) {
    LAS float* scr = (LAS float*)(F.lds + RING_OFF + F.wave * 16384);
    const int gw = F.vcu * NWAVES + F.wave, NGW = F.G * NWAVES;
    constexpr int I_IN = 16 * (IN_COLS / 32), I_PW = 8 * 32, I_AO = 8 * 32, I_OUT = 16 * 32, I_Q = 16 * 64;
    constexpr int NITEMS = I_IN + I_PW + I_AO + I_OUT + I_Q;
    for (int it = gw; it < NITEMS; it += NGW) {
        int r = it;
        if (r < I_IN) { const int nb = IN_COLS / 32, kb = r / nb, n0 = 32 * (r % nb); p0_transpose_item(a.w_in, 1024, IN_COLS, a.Win, 64 * kb, n0, perm_in(n0), nullptr, scr, F.lane); continue; } r -= I_IN;
        if (r < I_PW) { const int kb = r / 32, n0 = 32 * (r % 32); p0_transpose_item(a.w_pw, 512, 1024, a.Wpw, 64 * kb, n0, n0, nullptr, scr, F.lane, 1024, 0); continue; } r -= I_PW;
        if (r < I_AO) { const int kb = r / 32, n0 = 32 * (r % 32); p0_transpose_item(a.w_ao, 512, 1024, a.Wpw, 64 * kb, n0, n0, nullptr, scr, F.lane, 1024, 512); continue; }   r -= I_AO;
        if (r < I_OUT) { const int kb = r / 32, n0 = 32 * (r % 32); p0_transpose_item(a.w_out, 1024, 1024, a.Wout, 64 * kb, n0, n0, nullptr, scr, F.lane); continue; } r -= I_OUT;
        { const int kb = r / 64, n0 = 32 * (r % 64); p0_transpose_item(a.w_q, 1024, 2048, a.Wq, 64 * kb, n0, n0, a.g2, scr, F.lane); }
    }
    for (int m = 4 * gw; m < TOK; m += 4 * NGW) rows_to_bf16<true, 4>(F.lane, a.x + (size_t)m * 1024, 1024, a.g1, a.H + (size_t)m * 1024);
    for (int m = gw; m < N_EXP; m += NGW) rows_to_fp8_uv(F.lane, a.pu + (size_t)m * 1024, a.pv + (size_t)m * 1024, a.g2, a.ub8, a.vb8, m, a.usc, a.vsc);
    for (int m = gw; m < 32; m += NGW) { const float* src = (m < 16 ? a.k1 : a.k2) + (size_t)(m & 15) * 1024; row_to_bf16<false>(F.lane, src, nullptr, a.keys + (size_t)m * 1024); }
}

struct ConvArgs { const bf16* zglu; const float *cw, *cb, *lg, *lb; bf16* cact; };
__device__ __forceinline__ void conv_phase(Frame& F, const ConvArgs& a) {
    LAS unsigned char* zs = F.lds + RING_OFF;
    LAS float* part = (LAS float*)(F.lds + RING_OFF + 98304);
    int tid_ = F.tid; asm volatile("" : "+v"(tid_));
    const int cp = tid_ & 255, half = tid_ >> 8, c0 = 2 * cp;
    float w0[CONV_W], w1[CONV_W];
    { const GAS float* p = (const GAS float*)(a.cw + c0);
#pragma unroll
      for (int w = 0; w < CONV_W; ++w) { w0[w] = p[0]; w1[w] = p[1]; p += 512; asm volatile("" : "+v"(p)); } }
    const float b0 = a.cb[c0], b1 = a.cb[c0 + 1], lg0 = a.lg[c0], lg1 = a.lg[c0 + 1], lb0 = a.lb[c0], lb1 = a.lb[c0 + 1];
    for (int tile = F.vcu; tile < TOK / 64; tile += F.G) {
        const int t0 = tile * 64, tb = t0 & (SEQ - 1);
#pragma unroll
        for (int hb = 0; hb < 2; ++hb) { v4u zv[6];
#pragma unroll
          for (int q = 0; q < 6; ++q) { const int i = tid_ + 512 * (6 * hb + q), r = i >> 6, ch = i & 63; zv[q] = (v4u){0u, 0u, 0u, 0u};
              if (i < 94 * 64 && tb - 30 + r >= 0) zv[q] = *(const GAS v4u*)(a.zglu + (size_t)(t0 - 30 + r) * 512 + ch * 8); }
#pragma unroll
          for (int q = 0; q < 6; ++q) { const int i = tid_ + 512 * (6 * hb + q), r = i >> 6, ch = i & 63; if (i < 94 * 64) *(LAS v4u*)(zs + r * 1024 + ch * 16) = zv[q]; } }
        __syncthreads();
        for (int ch8 = 0; ch8 < 4; ++ch8) {
            const int tl = half * 32 + ch8 * 8;
            float z0[38], z1[38];
#pragma unroll
            for (int i = 0; i < 38; ++i) { const unsigned u = *(const LAS unsigned*)(zs + (tl + i) * 1024 + cp * 4); z0[i] = bflo(u); z1[i] = bfhi(u); }
            float a0[8], a1[8];
#pragma unroll
            for (int k = 0; k < 8; ++k) { float s0 = b0, s1 = b1;
#pragma unroll
                for (int w = 0; w < CONV_W; ++w) { s0 += w0[w] * z0[k + w]; s1 += w1[w] * z1[k + w]; }
                a0[k] = s0; a1[k] = s1; }
#pragma unroll
            for (int k = 0; k < 8; ++k) { const float s1 = wave_sum_hi(a0[k] + a1[k]), s2 = wave_sum_hi(a0[k] * a0[k] + a1[k] * a1[k]);
                if (F.lane == 63) { part[((half * 8 + k) * 4 + (F.wave & 3)) * 2] = s1; part[((half * 8 + k) * 4 + (F.wave & 3)) * 2 + 1] = s2; } }
            __syncthreads();
            bf16* op = a.cact + (size_t)(t0 + tl) * 1024 + c0;
#pragma unroll
            for (int k = 0; k < 8; ++k) { const LAS float* p = part + (half * 8 + k) * 8;
                const float S1 = (p[0] + p[2]) + (p[4] + p[6]), S2 = (p[1] + p[3]) + (p[5] + p[7]);
                const float mean = S1 * (1.f / 512.f), var = S2 * (1.f / 512.f) - mean * mean, rstd = __builtin_amdgcn_rsqf(var + NORM_EPS);
                const float y0 = (a0[k] - mean) * rstd * lg0 + lb0, y1 = (a1[k] - mean) * rstd * lg1 + lb1;
                const float o0 = y0 * __builtin_amdgcn_rcpf(1.f + __builtin_amdgcn_exp2f(-1.4426950408889634f * y0)), o1 = y1 * __builtin_amdgcn_rcpf(1.f + __builtin_amdgcn_exp2f(-1.4426950408889634f * y1));
                *(GAS unsigned*)(op + k * 1024) = pk2(o0, o1); }
            __syncthreads();
        }
    }
}

__device__ __forceinline__ int tokey(float v) { const int b = __float_as_int(v); return b ^ ((b >> 31) & 0x7fffffff); }
__device__ __forceinline__ float unkey(int k, int mask) { const int t = k & ~mask; return __int_as_float(t ^ ((t >> 31) & 0x7fffffff)); }
__device__ __forceinline__ void ce_desc(int& a, int& b) { const int hi = a > b ? a : b, lo = a > b ? b : a; a = hi; b = lo; }
template <int N> __device__ __forceinline__ void sort_desc(int (&v)[N]) {
#pragma unroll
    for (int k = 2; k <= N; k <<= 1)
#pragma unroll
        for (int j = k >> 1; j > 0; j >>= 1)
#pragma unroll
            for (int i = 0; i < N; ++i) { const int l = i ^ j; if (l > i) { if ((i & k) == 0) ce_desc(v[i], v[l]); else ce_desc(v[l], v[i]); } }
}
__device__ __forceinline__ void bitonic_merge16_desc(int (&v)[16]) {
#pragma unroll
    for (int j = 8; j > 0; j >>= 1)
#pragma unroll
        for (int i = 0; i < 16; ++i) { const int l = i ^ j; if (l > i) ce_desc(v[i], v[l]); }
}
__device__ __forceinline__ void merge_top16(int (&a)[16], const int (&b)[16]) {
#pragma unroll
    for (int i = 0; i < 16; ++i) a[i] = a[i] > b[15 - i] ? a[i] : b[15 - i];
    bitonic_merge16_desc(a);
}
__device__ __forceinline__ void top16_of_64(const int (&x)[64], int (&out)[16]) {
    int g[16];
#pragma unroll
    for (int i = 0; i < 16; ++i) out[i] = x[i];
    sort_desc<16>(out);
#pragma unroll
    for (int q = 1; q < 4; ++q) {
#pragma unroll
        for (int i = 0; i < 16; ++i) g[i] = x[16 * q + i];
        sort_desc<16>(g); merge_top16(out, g); }
}
__device__ __forceinline__ int crow_(int r, int hi) { return (r & 3) + 8 * (r >> 2) + 4 * hi; }
struct SelArgs { const bf16* qp; const bf16* keys; const float* ss; const float* usc; const float* vsc; int* eidx; float* ga; float* gb; const bf16* x1b; unsigned char* x8; float* xs; };
__device__ __forceinline__ void peer_select_phase(Frame& F, const SelArgs& a) {
    for (int i = F.tid; i < 2 * 128 * 16; i += 512) { const int which = i >> 11, rem = i & 2047, row = rem >> 4, ch = rem & 15;
        const v4u v = *(const GAS v4u*)(a.keys + (size_t)which * 16384 + row * 128 + ch * 8);
        *(LAS v4u*)(F.lds + RING_OFF + which * 32768 + row * 256 + ((ch ^ (row & 15)) << 4)) = v; }
    __syncthreads();
    LAS int* scr = (LAS int*)(F.lds + RING_OFF + 65536 + F.wave * 4096);
    const int lane = F.lane, tl = lane & 31, hi = lane >> 5;
    const int gw = F.vcu * NWAVES + F.wave, NGW = F.G * NWAVES;
    constexpr int NUNITS = (TOK / 32) * P_HEADS;
    constexpr int PA[50] = {0,0,0,0,0,0,0,0,0,0,0,0,0,0,0,0, 1,1,1,1,1,1,1,1, 2,2,2,2,2, 3,3,3,3, 4,4,4, 5,5, 6,6, 7,7, 8,9,10,11,12,13,14,15};
    constexpr int PB[50] = {0,1,2,3,4,5,6,7,8,9,10,11,12,13,14,15, 0,1,2,3,4,5,6,7, 0,1,2,3,4, 0,1,2,3, 0,1,2, 0,1, 0,1, 0,1, 0,0,0,0,0,0,0,0};
    for (int unit = gw; unit < NUNITS; unit += NGW) {
        const int tt = unit >> 3, hh = unit & 7, t = tt * 32 + tl;
        int vk[2][16];
#pragma unroll
        for (int half = 0; half < 2; ++half) {
            const bf16* qrow = a.qp + (size_t)t * 2048 + hh * 256 + half * 128 + hi * 8;
            bf16x8 bq[8];
#pragma unroll
            for (int ks = 0; ks < 8; ++ks) bq[ks] = *(const GAS bf16x8*)(qrow + ks * 16);
            f32x16 acc[4];
#pragma unroll
            for (int nb = 0; nb < 4; ++nb) { acc[nb] = (f32x16){};
#pragma unroll
                for (int ks = 0; ks < 8; ++ks) { const int row = nb * 32 + tl, ch = 2 * ks + hi;
                    const bf16x8 ka = *(const LAS bf16x8*)(F.lds + RING_OFF + half * 32768 + row * 256 + ((ch ^ (row & 15)) << 4));
                    acc[nb] = __builtin_amdgcn_mfma_f32_32x32x16_bf16(ka, bq[ks], acc[nb], 0, 0, 0); } }
            int keys[64];
#pragma unroll
            for (int nb = 0; nb < 4; ++nb)
#pragma unroll
                for (int r = 0; r < 16; ++r) keys[nb * 16 + r] = (tokey(acc[nb][r]) & ~127) | (nb * 32 + crow_(r, hi));
            int top[16]; top16_of_64(keys, top);
            int oth[16];
#pragma unroll
            for (int i = 0; i < 16; ++i) oth[i] = __shfl_xor(top[i], 32);
            merge_top16(top, oth);
#pragma unroll
            for (int i = 0; i < 16; ++i) vk[half][i] = top[i];
        }
        float f1[16], f2[16];
#pragma unroll
        for (int i = 0; i < 16; ++i) { f1[i] = unkey(vk[0][i], 127); f2[i] = unkey(vk[1][i], 127); }
        int ck[64];
#pragma unroll
        for (int i = 0; i < 50; ++i) ck[i] = (tokey(f1[PA[i]] + f2[PB[i]]) & ~255) | (PA[i] * 16 + PB[i]);
#pragma unroll
        for (int i = 50; i < 64; ++i) ck[i] = (int)0x80000000;
        int c[16]; top16_of_64(ck, c);
        if (hi == 0) {
#pragma unroll
            for (int i = 0; i < 16; ++i) { scr[tl * 32 + i] = vk[0][i] & 127; scr[tl * 32 + 16 + i] = vk[1][i] & 127; } }
        float ssum = 0.f;
        { const GAS f32x4* sp = (const GAS f32x4*)(a.ss + (size_t)t * 16);
#pragma unroll
          for (int i = 0; i < 4; ++i) { const f32x4 v = sp[i]; ssum += (v.x + v.y) + (v.z + v.w); } }
        const float rstd = 1.f / sqrtf(ssum * (1.f / 1024.f) + NORM_EPS);
        const float smax = unkey(c[0], 255);
        float e[16], esum = 0.f;
#pragma unroll
        for (int i = 0; i < 16; ++i) { e[i] = __expf((unkey(c[i], 255) - smax) * rstd); esum += e[i]; }
        const float inv = 1.f / esum;
        LDS_WAIT(); asm volatile("" ::: "memory");
        int eo[8]; float go[8];
#pragma unroll
        for (int i = 0; i < 8; ++i) { const int ci = hi ? c[i + 8] : c[i]; const float ei = hi ? e[i + 8] : e[i];
            const int id = ci & 255, i1 = scr[tl * 32 + (id >> 4)], i2 = scr[tl * 32 + 16 + (id & 15)];
            eo[i] = i1 * P_NK + i2; go[i] = ei * inv; }
        float ua[8];
#pragma unroll
        for (int i = 0; i < 8; ++i) { ua[i] = a.usc[eo[i]]; go[i] *= a.vsc[eo[i]]; }
        int* ep = a.eidx + (size_t)t * P_E + hh * 16 + hi * 8; float* gp = a.gb + (size_t)t * P_E + hh * 16 + hi * 8; float* up_ = a.ga + (size_t)t * P_E + hh * 16 + hi * 8;
        *(GAS f32x4*)(up_) = (f32x4){ua[0], ua[1], ua[2], ua[3]}; *(GAS f32x4*)(up_ + 4) = (f32x4){ua[4], ua[5], ua[6], ua[7]};
        *(GAS v4u*)(ep) = (v4u){(unsigned)eo[0], (unsigned)eo[1], (unsigned)eo[2], (unsigned)eo[3]}; *(GAS v4u*)(ep + 4) = (v4u){(unsigned)eo[4], (unsigned)eo[5], (unsigned)eo[6], (unsigned)eo[7]};
        *(GAS f32x4*)(gp) = (f32x4){go[0], go[1], go[2], go[3]}; *(GAS f32x4*)(gp + 4) = (f32x4){go[4], go[5], go[6], go[7]};
        LDS_WAIT(); asm volatile("" ::: "memory");
    }
}

__device__ __forceinline__ void peer_rows_fp8(Frame& F, const SelArgs& a) {
    const int gw = F.vcu * NWAVES + F.wave, NGW = F.G * NWAVES, lane = F.lane;
    for (int t = gw; t < TOK; t += NGW) {
        const GAS v4u* xp = (const GAS v4u*)(a.x1b + (size_t)t * 1024 + 16 * lane); const v4u xa = xp[0], xb = xp[1];
        const float xf[16] = {bflo(xa.x), bfhi(xa.x), bflo(xa.y), bfhi(xa.y), bflo(xa.z), bfhi(xa.z), bflo(xa.w), bfhi(xa.w), bflo(xb.x), bfhi(xb.x), bflo(xb.y), bfhi(xb.y), bflo(xb.z), bfhi(xb.z), bflo(xb.w), bfhi(xb.w)};
        float am = 0.f;
#pragma unroll
        for (int i = 0; i < 16; ++i) am = fmaxf(am, fabsf(xf[i]));
#pragma unroll
        for (int o = 1; o < 64; o <<= 1) am = fmaxf(am, __shfl_xor(am, o));
        const float xsc = am > 0.f ? 240.f / am : 1.f, xinv = am > 0.f ? am * (1.f / 240.f) : 1.f;
        v4u o;
        { int w = 0; w = __builtin_amdgcn_cvt_pk_fp8_f32(xf[0] * xsc, xf[1] * xsc, w, false); w = __builtin_amdgcn_cvt_pk_fp8_f32(xf[2] * xsc, xf[3] * xsc, w, true); o.x = (unsigned)w; }
        { int w = 0; w = __builtin_amdgcn_cvt_pk_fp8_f32(xf[4] * xsc, xf[5] * xsc, w, false); w = __builtin_amdgcn_cvt_pk_fp8_f32(xf[6] * xsc, xf[7] * xsc, w, true); o.y = (unsigned)w; }
        { int w = 0; w = __builtin_amdgcn_cvt_pk_fp8_f32(xf[8] * xsc, xf[9] * xsc, w, false); w = __builtin_amdgcn_cvt_pk_fp8_f32(xf[10] * xsc, xf[11] * xsc, w, true); o.z = (unsigned)w; }
        { int w = 0; w = __builtin_amdgcn_cvt_pk_fp8_f32(xf[12] * xsc, xf[13] * xsc, w, false); w = __builtin_amdgcn_cvt_pk_fp8_f32(xf[14] * xsc, xf[15] * xsc, w, true); o.w = (unsigned)w; }
        *(GAS v4u*)(a.x8 + (size_t)t * 1024 + 16 * lane) = o;
        const float ssum = wave_sum(lane < 16 ? a.ss[(size_t)t * 16 + lane] : 0.f);
        if (lane == 0) a.xs[t] = xinv / sqrtf(ssum * (1.f / 1024.f) + NORM_EPS);
    }
}

typedef float f32x2_t __attribute__((ext_vector_type(2)));
struct ExpA { const unsigned char* x8; const float* xs; const unsigned char* ub8; const int* eidx; const float* ga; const float* gb; unsigned char* coef8; };
__device__ __forceinline__ float row_sum16(float v) {
    v += __builtin_bit_cast(float, __builtin_amdgcn_update_dpp(0, __builtin_bit_cast(int, v), 0xB1, 0xf, 0xf, false));
    v += __builtin_bit_cast(float, __builtin_amdgcn_update_dpp(0, __builtin_bit_cast(int, v), 0x4E, 0xf, 0xf, false));
    v += __builtin_bit_cast(float, __builtin_amdgcn_update_dpp(0, __builtin_bit_cast(int, v), 0x141, 0xf, 0xf, false));
    v += __builtin_bit_cast(float, __builtin_amdgcn_update_dpp(0, __builtin_bit_cast(int, v), 0x140, 0xf, 0xf, false));
    return v;
}
__device__ __forceinline__ float gelu_as(float v) {
    const float av = fabsf(v), t = __builtin_amdgcn_rcpf(av * 0.2316418882f + 1.0f);
    float q = t * 0.5307027145f + (-0.7265760135f); q = q * t + 0.7107068705f; q = q * t + (-0.142248368f); q = q * t + 0.127414796f; q = q * t;
    const float m = v * (q * __builtin_amdgcn_exp2f((v * v) * (-0.72134752044f)));
    return v < 0.f ? m : v - m;
}
__device__ __forceinline__ float wave_sum_diag(float v) {
    v = row_sum16(v);
    v += __builtin_bit_cast(float, __builtin_amdgcn_update_dpp(0, __builtin_bit_cast(int, v), 0x142, 0xA, 0xF, false));
    v += __builtin_bit_cast(float, __builtin_amdgcn_update_dpp(0, __builtin_bit_cast(int, v), 0x143, 0xC, 0xF, false));
    return v;
}
__device__ __forceinline__ int wg_grab(LAS int* c, const int lane) {
    int v = 0; if (lane == 0) v = __hip_atomic_fetch_add(c, 1, __ATOMIC_RELAXED, __HIP_MEMORY_SCOPE_WORKGROUP);
    return __builtin_amdgcn_readfirstlane(v);
}
typedef int v2i_t __attribute__((ext_vector_type(2)));
typedef int v8i_t __attribute__((ext_vector_type(8)));
__device__ __forceinline__ void peer_u_phase(Frame& F, const ExpA& a, const int s, const int tfirst, const int step, LAS int* cnt) {
    const int lane = F.lane, q = lane >> 4, jn = lane & 15, half = lane >> 5, c32 = lane & 31;
    if (tfirst >= TOK) return;
    constexpr int UP = 528;
    LAS unsigned char* wb = F.lds + (F.wave < 7 ? F.wave * VT_BYTES : VT_LAST_OFF);
    static_assert(16 * UP + 2 * 1024 + 2 * 1536 <= VT_BYTES, "u-side LDS");
    LAS unsigned char* twr = wb + half * UP + 16 * c32;
    LAS unsigned char* tra = wb + jn * UP + 16 * q;
    const GAS unsigned char* ubase = (const GAS unsigned char*)a.ub8; const unsigned lane16c = 16u * (unsigned)c32;
    const int padent = s << 21;
#define UX(P) (wb + 16 * UP + 1024 * (P))
#define UL(P) ((LAS int*)(wb + 16 * UP + 2048 + 1536 * (P)))
    struct Raw { v4u x; int e0, e1; float fa0, fa1, fb0, fb1, xs; };
#define PU_RAW(R, T) do { const int tt_ = (T) < TOK ? (T) : tfirst; R.x = *(const GAS v4u*)(a.x8 + (size_t)tt_ * 1024 + 16 * lane); \
        R.e0 = a.eidx[(size_t)tt_ * P_E + lane]; R.e1 = a.eidx[(size_t)tt_ * P_E + 64 + lane]; R.fa0 = a.ga[(size_t)tt_ * P_E + lane]; R.fa1 = a.ga[(size_t)tt_ * P_E + 64 + lane]; \
        R.fb0 = a.gb[(size_t)tt_ * P_E + lane]; R.fb1 = a.gb[(size_t)tt_ * P_E + 64 + lane]; R.xs = a.xs[tt_]; } while (0)
#define PU_PREP(R, P, N, VALID) do { LAS int* LST = UL(P); \
        const bool in0_ = (VALID) && (R.e0 >> 11) == s, in1_ = (VALID) && (R.e1 >> 11) == s; \
        const unsigned long long m0_ = __ballot(in0_), m1_ = __ballot(in1_), lt_ = (1ull << lane) - 1ull; \
        const int n0_ = __popcll(m0_); N = n0_ + __popcll(m1_); \
        LAS float* lsa_ = (LAS float*)(LST + 128); LAS float* lsb_ = (LAS float*)(LST + 256); \
        if (N + lane < 128) LST[N + lane] = padent; if (N + 64 + lane < 128) LST[N + 64 + lane] = padent; \
        if (in0_) { const int p = __popcll(m0_ & lt_); LST[p] = lane | (R.e0 << 10); lsa_[p] = R.fa0 * R.xs; lsb_[p] = R.fb0; } \
        if (in1_) { const int p = n0_ + __popcll(m1_ & lt_); LST[p] = (64 + lane) | (R.e1 << 10); lsa_[p] = R.fa1 * R.xs; lsb_[p] = R.fb1; } \
        *(LAS v4u*)(UX(P) + 16 * lane) = R.x; } while (0)
#define PU_ISSUE(W, P, B) do { _Pragma("unroll") for (int u = 0; u < 8; ++u) { const unsigned ent_ = (unsigned)UL(P)[16 * (B) + 2 * u + half]; \
        W[u] = *(const GAS v4u*)(ubase + (((ent_ >> 1) & 0xFFFFFE00u) | lane16c)); } } while (0)
#define PU_COMP(W, P, B, N, T) do { \
        _Pragma("unroll") for (int u = 0; u < 8; ++u) *(LAS v4u*)(twr + u * (2 * UP)) = W[u]; \
          \
        f32x4 acc0_ = {0.f, 0.f, 0.f, 0.f}, acc1_ = {0.f, 0.f, 0.f, 0.f}; v4u ar_[4], xl_[4], xh_[4]; \
        _Pragma("unroll") for (int kk = 0; kk < 2; ++kk) { ar_[kk] = *(const LAS v4u*)(tra + 64 * kk); xl_[kk] = *(const LAS v4u*)(UX(P) + 128 * kk + 16 * q); xh_[kk] = *(const LAS v4u*)(UX(P) + 128 * kk + 64 + 16 * q); } \
        _Pragma("unroll") for (int kk = 0; kk < 8; kk += 2) { \
            if (kk + 2 < 8) { _Pragma("unroll") for (int d = 2; d < 4; ++d) { const int k2 = kk + d; ar_[k2 & 3] = *(const LAS v4u*)(tra + 64 * k2); xl_[k2 & 3] = *(const LAS v4u*)(UX(P) + 128 * k2 + 16 * q); xh_[k2 & 3] = *(const LAS v4u*)(UX(P) + 128 * k2 + 64 + 16 * q); } } \
            { const v4u ar = ar_[kk & 3], xl = xl_[kk & 3], xh = xh_[kk & 3]; const v8i_t av = {(int)ar.x, (int)ar.y, (int)ar.z, (int)ar.w, 0, 0, 0, 0}, bv = {(int)xl.x, (int)xl.y, (int)xl.z, (int)xl.w, (int)xh.x, (int)xh.y, (int)xh.z, (int)xh.w}; \
              acc0_ = __builtin_amdgcn_mfma_scale_f32_16x16x128_f8f6f4(av, bv, acc0_, 4, 0, 0, 0, 0, 0); } \
            { const v4u ar = ar_[(kk + 1) & 3], xl = xl_[(kk + 1) & 3], xh = xh_[(kk + 1) & 3]; const v8i_t av = {(int)ar.x, (int)ar.y, (int)ar.z, (int)ar.w, 0, 0, 0, 0}, bv = {(int)xl.x, (int)xl.y, (int)xl.z, (int)xl.w, (int)xh.x, (int)xh.y, (int)xh.z, (int)xh.w}; \
              acc1_ = __builtin_amdgcn_mfma_scale_f32_16x16x128_f8f6f4(av, bv, acc1_, 4, 0, 0, 0, 0, 0); } } \
        const f32x4 acc = acc0_ + acc1_; \
        const float du = (jn & 2) ? ((jn & 1) ? acc[3] : acc[2]) : ((jn & 1) ? acc[1] : acc[0]); \
        const int ku = 16 * (B) + 4 * q + (jn & 3); \
        if (jn < 4 && ku < N) { LAS int* LST = UL(P); const int slot = LST[ku] & 127; \
            const float cf_ = C8_SCALE * ((LAS float*)(LST + 256))[ku] * gelu_as(du * ((LAS float*)(LST + 128))[ku]); \
            a.coef8[(size_t)(T) * P_E + slot] = (unsigned char)__builtin_amdgcn_cvt_pk_fp8_f32(fminf(fmaxf(cf_, -448.f), 448.f), 0.f, 0, false); } } while (0)
    const int ntok = (TOK - tfirst + step - 1) / step;
#define PU_TOK(i) ((i) < ntok ? tfirst + (i) * step : TOK)
    Raw raw; int nA = 0, nB = 0;
    v4u wA0[8], wA1[8], wB0[8], wB1[8];
    int iA = wg_grab(cnt, lane), iB = wg_grab(cnt, lane), iC = wg_grab(cnt, lane);
    if (iA >= ntok) return;
    PU_RAW(raw, PU_TOK(iA)); PU_PREP(raw, 0, nA, true);
    PU_RAW(raw, PU_TOK(iB));
    PU_ISSUE(wA0, 0, 0); if (nA > 16) PU_ISSUE(wA1, 0, 1);
    PU_PREP(raw, 1, nB, iB < ntok);
    PU_RAW(raw, PU_TOK(iC));
    for (;;) {
        PU_ISSUE(wB0, 1, 0); if (nB > 16) PU_ISSUE(wB1, 1, 1);
        { const int tA = PU_TOK(iA);
          PU_COMP(wA0, 0, 0, nA, tA);
          if (nA > 16) PU_COMP(wA1, 0, 1, nA, tA);
          for (int b = 2; 16 * b < nA; ++b) { PU_ISSUE(wA0, 0, b); PU_COMP(wA0, 0, b, nA, tA); } }
        if (iB >= ntok) break;
        const int iD = wg_grab(cnt, lane);
        PU_PREP(raw, 0, nA, iC < ntok);
        PU_RAW(raw, PU_TOK(iD));
        PU_ISSUE(wA0, 0, 0); if (nA > 16) PU_ISSUE(wA1, 0, 1);
        { const int tB = PU_TOK(iB);
          PU_COMP(wB0, 1, 0, nB, tB);
          if (nB > 16) PU_COMP(wB1, 1, 1, nB, tB);
          for (int b = 2; 16 * b < nB; ++b) { PU_ISSUE(wB0, 1, b); PU_COMP(wB0, 1, b, nB, tB); } }
        if (iC >= ntok) break;
        const int iE = wg_grab(cnt, lane);
        PU_PREP(raw, 1, nB, iD < ntok);
        PU_RAW(raw, PU_TOK(iE));
        iA = iC; iB = iD; iC = iE;
    }
#undef PU_TOK
#undef PU_RAW
#undef PU_PREP
#undef PU_ISSUE
#undef PU_COMP
#undef UX
#undef UL
}
struct ExpB { float* xio; const bf16* x1b; const unsigned char* vb8; const int* eidx; const unsigned char* coef8; float* ss2; };
constexpr int V_SLICES = 4;
__device__ __forceinline__ void peer_v_phase(Frame& F, const ExpB& a, const int s, const int t0, const int step, LAS int* cnt) {
    const int lane = F.lane, g = lane >> 3, j = lane & 7, q = lane >> 4, jn = lane & 15;
    const GAS unsigned char* vs = (const GAS unsigned char*)a.vb8 + (size_t)s * ((size_t)N_EXP * 128); const unsigned j16 = 16u * (unsigned)j;
    if (t0 >= TOK) return;
    LAS unsigned char* tile = F.lds + (F.wave < 7 ? F.wave * VT_BYTES : VT_LAST_OFF);
    LAS unsigned char* wbase = tile + g * (16 * VT_PITCH) + 16 * j;
    LAS unsigned char* rbase = tile + (32 * q + jn) * VT_PITCH;
    const int chA = 256 * s + 64 * q + jn;
#define PV_LDE(E, T) do { const int tt_ = (T) < TOK ? (T) : t0; const GAS v4u* ep_ = (const GAS v4u*)(a.eidx + (size_t)tt_ * P_E + 16 * g); \
        _Pragma("unroll") for (int k4 = 0; k4 < 4; ++k4) { const v4u ev = ep_[k4]; E[4 * k4] = (int)ev.x; E[4 * k4 + 1] = (int)ev.y; E[4 * k4 + 2] = (int)ev.z; E[4 * k4 + 3] = (int)ev.w; } } while (0)
#define PV_ROWS(W, E, C8, X, T) do { const int tt_ = (T) < TOK ? (T) : t0; _Pragma("unroll") for (int k = 0; k < 16; ++k) W[k] = *(const GAS v4u*)(vs + (((unsigned)E[k] << 7) | j16)); \
        { const GAS v4u* cp_ = (const GAS v4u*)(a.coef8 + (size_t)tt_ * P_E + 16 * q); C8[0] = cp_[0]; C8[1] = cp_[4]; }   \
        { const GAS bf16* xp_ = (const GAS bf16*)(a.x1b + (size_t)tt_ * 1024 + chA); _Pragma("unroll") for (int i = 0; i < 4; ++i) X[i] = xp_[16 * i]; } } while (0)
#define PV_COMP(W, C8, X, T) do { \
        _Pragma("unroll") for (int k = 0; k < 16; ++k) *(LAS v4u*)(wbase + k * VT_PITCH) = W[k]; \
        const v8i_t av = {(int)C8[0].x, (int)C8[0].y, (int)C8[0].z, (int)C8[0].w, (int)C8[1].x, (int)C8[1].y, (int)C8[1].z, (int)C8[1].w}; \
        float y[4] = {0.f, 0.f, 0.f, 0.f}; \
        _Pragma("unroll") for (int ct = 0; ct < 16; ++ct) { \
            const v2i_t b0 = __builtin_amdgcn_ds_read_tr4_b64_v2i32((LAS v2i_t*)(rbase + 8 * ct)), b1 = __builtin_amdgcn_ds_read_tr4_b64_v2i32((LAS v2i_t*)(rbase + 16 * VT_PITCH + 8 * ct)); \
            const v8i_t bv = {b0.x, b0.y, b1.x, b1.y, 0, 0, 0, 0}; \
            const f32x4 d_ = __builtin_amdgcn_mfma_scale_f32_16x16x128_f8f6f4(av, bv, (f32x4){0.f, 0.f, 0.f, 0.f}, 0, 4, 0, 0, 0, 0); \
            y[ct & 3] = (q == (ct >> 2)) ? d_[0] : y[ct & 3]; } \
        float sq = 0.f; \
        _Pragma("unroll") for (int i = 0; i < 4; ++i) { const float o_ = bflo((unsigned)X[i]) + y[i] * (1.f / C8_SCALE); a.xio[(size_t)(T) * 1024 + chA + 16 * i] = o_; sq += o_ * o_; } \
        sq = row_sum16(sq); \
        sq += __shfl_xor(sq, 16); sq += __shfl_xor(sq, 32); \
        if (lane == 0) a.ss2[(size_t)(T) * V_SLICES + s] = sq; } while (0)
    int e1[16], e2[16]; v4u wA[16], wB[16], c8A[2], c8B[2]; bf16 xA[4], xB[4];
    const int ntok = (TOK - t0 + step - 1) / step;
#define PV_TOK(i) ((i) < ntok ? t0 + (i) * step : TOK)
    int iA = wg_grab(cnt, lane), iB = wg_grab(cnt, lane);
    if (iA >= ntok) return;
    PV_LDE(e1, PV_TOK(iA));
    PV_LDE(e2, PV_TOK(iB));
    PV_ROWS(wA, e1, c8A, xA, PV_TOK(iA));
    for (;;) {
        const int iC = wg_grab(cnt, lane);
        PV_LDE(e1, PV_TOK(iC));
        PV_ROWS(wB, e2, c8B, xB, PV_TOK(iB));
        PV_COMP(wA, c8A, xA, PV_TOK(iA));
        if (iB >= ntok) break;
        const int iD = wg_grab(cnt, lane);
        PV_LDE(e2, PV_TOK(iD));
        PV_ROWS(wA, e1, c8A, xA, PV_TOK(iC));
        PV_COMP(wB, c8B, xB, PV_TOK(iB));
        if (iC >= ntok) break;
        iA = iC; iB = iD;
    }
#undef PV_TOK
#undef PV_LDE
#undef PV_ROWS
#undef PV_COMP
}
__device__ __forceinline__ void final_norm_phase(Frame& F, float* xio, const float* ss2, const float* gfinal, const int gw, const int NGW) {
    const int lane = F.lane;
    for (int t = gw; t < TOK; t += NGW) {
        const f32x4 s0 = *(const GAS f32x4*)(ss2 + (size_t)t * V_SLICES); static_assert(V_SLICES == 4, "ss2 row");
        const float rstd = 1.f / sqrtf(((s0.x + s0.y) + (s0.z + s0.w)) * (1.f / 1024.f) + NORM_EPS);
        GAS f32x4* xr = (GAS f32x4*)(xio + (size_t)t * 1024) + lane; const GAS f32x4* gf = (const GAS f32x4*)gfinal + lane;
#pragma unroll
        for (int q = 0; q < 4; ++q) xr[64 * q] = xr[64 * q] * rstd * gf[64 * q];
    }
}

struct Args { const float* in[18]; float* out; unsigned char* ws; int ph_lo, ph_hi, li, pad; };
__global__ void __launch_bounds__(NWAVES * 64, 2) fwd_kernel(Args args) {
    extern __shared__ __attribute__((aligned(16))) unsigned char lds[];
    Frame F;
    F.lds = (LAS unsigned char*)lds;
    F.MISC = (volatile LAS unsigned*)(F.lds + MISC_OFF);
    F.tid = threadIdx.x; F.lane = F.tid & 63; F.wave = __builtin_amdgcn_readfirstlane(F.tid >> 6);
    F.G = gridDim.x; { const int bx = blockIdx.x; F.vcu = (F.G % 8 == 0) ? (bx % 8) * (F.G / 8) + bx / 8 : bx; }
    unsigned char* ws = args.ws;
    F.ctl = (gu32*)(ws + WS_CTL);
#define GRID_BAR(seam) do { if (N_LAUNCHES == PER_PHASE) { if (F.tid == 0) __hip_atomic_store(F.ctl + CW_TMO, 0xBADBA0u | (unsigned)(seam), RLX_AGENT); } else { xcd_barrier(bar); } } while (0)
    const float* x = args.in[0];
    bf16* H = (bf16*)(ws + WS_H); bf16* Win = (bf16*)(ws + WS_WIN); bf16* Wpw = (bf16*)(ws + WS_WPW); bf16* Wao = (bf16*)(ws + WS_WAO); bf16* Wout = (bf16*)(ws + WS_WOUT); bf16* Wq = (bf16*)(ws + WS_WQ);
    bf16* KEYS = (bf16*)(ws + WS_KEYS); unsigned char* UB = ws + WS_UB; unsigned char* VB = ws + WS_VB; float* USC = (float*)(ws + WS_USC); float* VSC = (float*)(ws + WS_VSC);
    bf16* ZGLU = (bf16*)(ws + WS_ZGLU); bf16* QO = (bf16*)(ws + WS_QO); bf16* KB = (bf16*)(ws + WS_K); bf16* VBUF = (bf16*)(ws + WS_V); bf16* GC = (bf16*)(ws + WS_GC); bf16* GA = (bf16*)(ws + WS_GATE_A);
    bf16* CACT = (bf16*)(ws + WS_CACT); bf16* MIX = (bf16*)(ws + WS_MIX); bf16* X1B = (bf16*)(ws + WS_X1B); bf16* QP = (bf16*)(ws + WS_QP);
    float* KMEAN = (float*)(ws + WS_KMEAN); float* SS = (float*)(ws + WS_SS); int* EIDX = (int*)(ws + WS_EIDX); float* GW = (float*)(ws + WS_GW);
    for (int u = F.tid; u < (LDS_BYTES - LDSCTL_OFF) / 4; u += NWAVES * 64) ((LAS unsigned*)(F.lds + LDSCTL_OFF))[u] = 0u;
    __syncthreads();
    XcdBarrier bar; bar.bar = (unsigned*)(F.ctl + CW_BAR); bar.x = 0; bar.st = nullptr;
    if (N_LAUNCHES != PER_PHASE) bar = xcd_barrier_post((unsigned*)(F.ctl + CW_BAR), F.MISC + 8);
    const int lo = args.ph_lo, hi = args.ph_hi;
#ifdef TIME_PHASE
    unsigned long long ts_[PER_PHASE + 1]; ts_[0] = __builtin_amdgcn_s_memrealtime();
#define STAMP(k) ts_[(k) + 1] = __builtin_amdgcn_s_memrealtime()
#else
#define STAMP(k) do {} while (0)
#endif
#ifndef PHASE_MASK
#define PHASE_MASK 0xff
#endif
#define IN(k) (((PHASE_MASK >> (k)) & 1) && lo <= (k) && (k) < hi)
#define BOTH(k) (IN(k) && IN((k) + 1))

    if (IN(0)) {
        P0Args a{x, args.in[1], args.in[2], args.in[7], args.in[9], args.in[10], args.in[11], args.in[12], args.in[13], args.in[14], args.in[15], args.in[16], H, Win, Wpw, Wao, Wout, Wq, KEYS, UB, VB, USC, VSC};
        p0_prologue(F, a);
        if (BOTH(0)) GRID_BAR(0);
        STAMP(0);
    }
#ifdef DEBUG_P1_PLAIN
    if (IN(1)) {
        pg8::Gemm g{H, Wq, TOK, 2048, 1024}; pg8::StaticOrder S; S.init(TOK, 2048, F.G, (int)blockIdx.x);
        pg8::EpiStore E{QP, 2048};
        pg8::gemm_phase<pg8::EpiStore, pg8::StaticOrder, true, true>(F.lds + RING_OFF, g, S, E);
    }
#else
    if (IN(1)) {
        pg8::Gemm g{H, Win, TOK, IN_COLS, 1024}; pg8::StaticOrder S; S.init(TOK, IN_COLS, F.G, (int)blockIdx.x);
        pg8::EpiIn E{ZGLU, QO, GC, KMEAN, attn_body::C2, (size_t)(WS_K - WS_QO) / 2, (size_t)(WS_GATE_A - WS_GC) / 2};
        static_assert(WS_V - WS_K == WS_K - WS_QO, "Q|K|V equally spaced");
        pg8::gemm_phase<pg8::EpiIn, pg8::StaticOrder, true, true>(F.lds + RING_OFF, g, S, E);
        if (BOTH(1)) GRID_BAR(1);
        STAMP(1);
    }
#endif
    if (IN(2)) {
        static_assert(attn_body::ATTN_LDS_BYTES <= RING_BYTES && attn_body::ATTN_PITCH == ATT_W, "attention body geometry vs frame");
#ifdef CONV_FIRST
        { const ConvArgs ca{ZGLU, args.in[3], args.in[4], args.in[5], args.in[6], CACT};
          conv_phase(F, ca); }
        __syncthreads();
#ifdef TIME_SPLIT2
        ts_[3] = __builtin_amdgcn_s_memrealtime();
#endif
#endif
        const attn_body::AttnTensors AT{(const attn_body::bf16*)QO, (const attn_body::bf16*)KB, (const attn_body::bf16*)VBUF, (attn_body::bf16*)(CACT + 512), KMEAN};
        const attn_body::StaticOrder S((int)F.G, (int)blockIdx.x);
        attn_body::attn_phase<attn_body::StaticOrder>((char*)lds + RING_OFF, AT, S);
        __syncthreads();
#ifndef CONV_FIRST
        { const ConvArgs ca{ZGLU, args.in[3], args.in[4], args.in[5], args.in[6], CACT};
          conv_phase(F, ca); }
#endif
        if (BOTH(2)) GRID_BAR(2);
#if !(defined(TIME_SPLIT2) && defined(CONV_FIRST))
        STAMP(2);
#endif
    }
    if (IN(3)) {
        { pg8::Gemm g{CACT, Wpw, TOK, 1024, 1024}; pg8::StaticOrder S; S.init(TOK, 1024, F.G, (int)blockIdx.x);
          pg8::EpiMixF E{GC, GA, args.in[8], MIX};
          pg8::gemm_phase<pg8::EpiMixF, pg8::StaticOrder, true, true>(F.lds + RING_OFF, g, S, E); }
        if (BOTH(3)) GRID_BAR(3);
        STAMP(3);
    }
    if (IN(4)) {
        pg8::Gemm g{MIX, Wout, TOK, 1024, 1024}; pg8::StaticOrder S; S.init(TOK, 1024, F.G, (int)blockIdx.x);
        pg8::EpiX1 E{x, args.out, X1B, SS};
        pg8::gemm_phase<pg8::EpiX1, pg8::StaticOrder, true, true>(F.lds + RING_OFF, g, S, E);
        if (BOTH(4)) GRID_BAR(4);
        STAMP(4);
    }
    if (IN(5)) {
        pg8::Gemm g{X1B, Wq, TOK, 2048, 1024}; pg8::StaticOrder S; S.init(TOK, 2048, F.G, (int)blockIdx.x);
        pg8::EpiStore E{QP, 2048};
        pg8::gemm_phase<pg8::EpiStore, pg8::StaticOrder, true, true>(F.lds + RING_OFF, g, S, E);
        if (BOTH(5)) GRID_BAR(5);
        STAMP(5);
    }
    if (IN(6)) {
        const SelArgs sa{QP, KEYS, SS, USC, VSC, EIDX, (float*)(ws + WS_GA), GW, X1B, ws + WS_X8, (float*)(ws + WS_XS)};
        peer_select_phase(F, sa);
        peer_rows_fp8(F, sa);
        if (BOTH(6)) GRID_BAR(6);
        STAMP(6);
    }
    if (IN(7)) {
#ifdef TIME_U
        const unsigned long long tu0_ = __builtin_amdgcn_s_memrealtime();
#endif
        LAS int* cnt = (LAS int*)(F.lds + P7_CNT_OFF);
        if (F.tid < 16) cnt[F.tid] = 0;
        __syncthreads();
        const ExpA ea{ws + WS_X8, (const float*)(ws + WS_XS), UB, EIDX, (const float*)(ws + WS_GA), GW, ws + WS_COEF};
        for (int s = 0; s < 8; ++s) peer_u_phase(F, ea, s, F.vcu, F.G, cnt + s);
        VM_WAIT(); __syncthreads();
#ifdef TIME_V
        const unsigned long long tv0_ = __builtin_amdgcn_s_memrealtime();
#endif
        const ExpB eb{args.out, X1B, VB, EIDX, ws + WS_COEF, (float*)(ws + WS_SS2)};
        for (int s = 0; s < V_SLICES; ++s) peer_v_phase(F, eb, s, F.vcu, F.G, cnt + 8 + s);
        VM_WAIT(); __syncthreads();
#ifdef TIME_V
#ifdef TIME_U
        const float tvv_ = (float)(tv0_ - tu0_) * (0.01f / TIME_V);
#else
        const float tvv_ = (float)(__builtin_amdgcn_s_memrealtime() - tv0_) * (0.01f / TIME_V);
#endif
#endif
        final_norm_phase(F, args.out, (const float*)(ws + WS_SS2), args.in[17], F.vcu + F.G * F.wave, F.G * NWAVES);
#ifdef UNIT_MFMA4
        __syncthreads();
        if (blockIdx.x == 0 && F.wave == 0) {
            typedef int v8i_ __attribute__((ext_vector_type(8)));
            const int lane = F.lane, qq = lane >> 4;
            const v8i_ av = {0x38383838, 0x38383838, 0x38383838, 0x38383838, 0x38383838, 0x38383838, 0x38383838, 0x38383838};
            v8i_ bv = {0x22222222, 0x22222222, 0x22222222, 0x22222222, 0, 0, 0, 0};
            if (UNIT_MFMA4 == 2) bv = (v8i_){0x11111111, 0, 0, 0, 0, 0, 0, 0};
            v8i_ av2 = av;
            if (UNIT_MFMA4 == 3) { const bool on = qq == 1; av2 = (v8i_){0, on ? 0x00005800 : 0, 0, 0, 0, 0, 0, 0}; bv = (v8i_){on ? 0x00700000 : 0, 0, 0, 0, 0, 0, 0, 0}; }
            if (UNIT_MFMA4 == 4) { const bool on = qq == 2; av2 = (v8i_){0, 0, 0, 0, 0, on ? 0x58000000 : 0, 0, 0}; bv = (v8i_){0, 0, on ? 0x70000000 : 0, 0, 0, 0, 0, 0}; }
            const f32x4 d = __builtin_amdgcn_mfma_scale_f32_16x16x128_f8f6f4(av2, bv, (f32x4){0.f, 0.f, 0.f, 0.f}, 0, 4, 0, 0, 0, 0);
            if (UNIT_MFMA4 >= 100) {
                const int eb = UNIT_MFMA4 - 100; int found = 98;
                v8i_ bs = {0, 0, 0, 0, 0, 0, 0, 0}; if (qq == 2) bs[eb >> 3] = 7 << (4 * (eb & 7));
#pragma nounroll
                for (int qe = 0; qe < 128; ++qe) { int qa = qe >> 5, ea = qe & 31; asm volatile("" : "+s"(qa), "+s"(ea)); v8i_ as = {0, 0, 0, 0, 0, 0, 0, 0};
#pragma unroll
                    for (int w = 0; w < 8; ++w) as[w] = (qq == qa && (ea >> 2) == w) ? (0x58 << (8 * (ea & 3))) : 0;
                    const f32x4 dd = __builtin_amdgcn_mfma_scale_f32_16x16x128_f8f6f4(as, bs, (f32x4){0.f, 0.f, 0.f, 0.f}, 0, 4, 0, 0, 0, 0);
                    if (dd[0] > 1.f) found = (qa == UNIT_QA ? 3 * ea + 4 : 99); }
                if (lane == 0) { VM_WAIT(); args.out[0] = (float)found; }
            } else
            if (lane == 0) { VM_WAIT(); args.out[0] = 200.f + d[0]; }
        }
#endif
#ifdef UNIT_TR4
        __syncthreads();
        if (blockIdx.x == 0 && F.wave == 0) {
            typedef int v2i_ __attribute__((ext_vector_type(2)));
            const int lane = F.lane, g4 = lane >> 4, jj = lane & 15;
            LAS unsigned char* tb = F.lds + RING_OFF + g4 * 2048 + jj * 80;
            int okmask = 0;
            for (int hyp = 0; hyp < 4; ++hyp) { const int st = hyp & 1, ot = hyp >> 1;
                unsigned long long rowbits = 0;
                for (int n = 0; n < 16; ++n) { const unsigned v = (unsigned)(3 * jj + 5 * n + g4) & 15u; const int nib = st ? (n ^ 1) : n; rowbits |= (unsigned long long)v << (4 * nib); }
                *(LAS unsigned*)tb = (unsigned)rowbits; *(LAS unsigned*)(tb + 4) = (unsigned)(rowbits >> 32);
                LDS_WAIT(); asm volatile("" ::: "memory");
                const v2i_ rd = __builtin_amdgcn_ds_read_tr4_b64_v2i32((LAS v2i_*)tb);
                unsigned long long ex = 0;
                for (int k = 0; k < 16; ++k) { const unsigned v = (unsigned)(3 * k + 5 * jj + g4) & 15u; const int nib = ot ? (k ^ 1) : k; ex |= (unsigned long long)v << (4 * nib); }
                const bool bad = ((unsigned)rd.x != (unsigned)ex) || ((unsigned)rd.y != (unsigned)(ex >> 32));
                if (__ballot(bad) == 0ull) okmask |= 1 << hyp;
                LDS_WAIT(); asm volatile("" ::: "memory"); }
            if (lane == 0) { VM_WAIT(); args.out[0] = 200.f + 20.f * (float)okmask; }
        }
#endif
#ifdef TIME_V
        __syncthreads();
        if (blockIdx.x == TIME_V_BLOCK && F.tid == 0) { VM_WAIT(); args.out[0] = tvv_; }
#endif
        STAMP(7);
#ifdef TIME_P7_SPREAD
        __syncthreads();
        ts_[8] = __builtin_amdgcn_s_memrealtime();
        if (F.tid == 0) { __hip_atomic_fetch_max((unsigned long long*)(ws + 800), ts_[8] - ts_[7], __ATOMIC_RELAXED, __HIP_MEMORY_SCOPE_AGENT); __hip_atomic_fetch_add((unsigned*)(ws + 840), 1u, __ATOMIC_RELAXED, __HIP_MEMORY_SCOPE_AGENT); }
        if (blockIdx.x == 0 && F.tid == 0) { while (__hip_atomic_load((unsigned*)(ws + 840), __ATOMIC_RELAXED, __HIP_MEMORY_SCOPE_AGENT) < gridDim.x) __builtin_amdgcn_s_sleep(8);
            ts_[8] = ts_[7] + __hip_atomic_load((unsigned long long*)(ws + 800), __ATOMIC_RELAXED, __HIP_MEMORY_SCOPE_AGENT); }
#endif
#ifdef TIME_PHASE
#ifdef TIME_TOTAL
        if (blockIdx.x == 0 && F.tid == 0) { VM_WAIT(); args.out[0] = (float)(ts_[PER_PHASE] - ts_[0]) * (0.01f / TIME_UNIT_US); }
#else
        if (blockIdx.x == 0 && F.tid == 0) { VM_WAIT(); args.out[0] = (float)(ts_[TIME_PHASE + 1] - ts_[TIME_PHASE]) * (0.01f / TIME_UNIT_US); }
#endif
#endif
    }
#undef IN
#undef BOTH
}

#ifdef DEBUG_DUMP
__global__ void dump_kernel(const unsigned char* ws, float* out, float wsmib) {
    const size_t i = (size_t)blockIdx.x * 256 + threadIdx.x; if (i >= (size_t)TOK * 1024) return;
    const size_t t = i >> 10, c = i & 1023; float v = 0.f;
    auto B = [&](size_t off, size_t idx) { return bflo((unsigned)((const bf16*)(ws + off))[idx]); };
#if DEBUG_DUMP == 0
    v = B(WS_H, i) + B(WS_WIN, i % (4608u * 1024u)) + B(WS_WPW, i % (512u * 1024u)) + B(WS_WAO, i % (512u * 1024u)) + B(WS_WOUT, i % (1024u * 1024u)) + B(WS_WQ, i % (2048u * 1024u)) + B(WS_KEYS, i % 32768u) + B(WS_UB, i % (16384u * 1024u)) + B(WS_VB, i % (16384u * 1024u));
#elif DEBUG_DUMP == 1
    v = B(WS_ZGLU, t * 512 + (c & 511)) + 2.f * B(WS_QO, t * 512 + (c & 511)) + 3.f * B(WS_K, t * 512 + (c & 511)) + 4.f * B(WS_V, t * 512 + (c & 511)) + 5.f * B(WS_GC, i) + 6.f * B(WS_GATE_A, i) + ((const float*)(ws + WS_KMEAN))[(t >> 8) * 1024 + (c & 1023)];
#elif DEBUG_DUMP == 2
    v = B(WS_QO, t * 512 + (c & 511)) + 2.f * B(WS_CACT, t * 512 + (c & 511));
#elif DEBUG_DUMP == 20
    v = B(WS_QO, t * 512 + (c & 511));
#elif DEBUG_DUMP == 21
    v = B(WS_CACT, t * 512 + (c & 511));
#elif DEBUG_DUMP == 3
    v = B(WS_MIX, i);
#elif DEBUG_DUMP == 5
    v = B(WS_QP, t * 2048 + c) + 2.f * B(WS_QP, t * 2048 + 1024 + c);
#elif DEBUG_DUMP == 10
    v = B(WS_ZGLU, t * 512 + (c & 511));
#elif DEBUG_DUMP == 11
    v = 2.f * B(WS_QO, t * 512 + (c & 511)) + 3.f * B(WS_K, t * 512 + (c & 511)) + 4.f * B(WS_V, t * 512 + (c & 511));
#elif DEBUG_DUMP == 12
    v = 5.f * B(WS_GC, i) + 6.f * B(WS_GATE_A, i);
#elif DEBUG_DUMP == 13
    v = ((const float*)(ws + WS_KMEAN))[(t >> 8) * 1024 + (c & 1023)];
#elif DEBUG_DUMP == 98
    v = wsmib;
#elif DEBUG_DUMP == 99
    v = 1.0f + (float)(c & 7);
#endif
    out[i] = v;
}
#endif
extern "C" void kernel_launch(void* const* d_in, const int* in_sizes, int n_in, void* d_out, int out_size, void* d_ws, size_t ws_size, hipStream_t stream) {
    static int grid = 0;
    if (grid == 0) {
        if (n_in != 18 || in_sizes[0] != TOK * DM || out_size != TOK * DM || ws_size < WS_END) { fprintf(stderr, "kernel_launch: unexpected shapes (n_in %d, in0 %d, out %d, ws %zu); nothing launched\n", n_in, n_in > 0 ? in_sizes[0] : -1, out_size, ws_size); grid = -1; return; }
        int dev = 0, cus = 0, per_cu = 0;
        if (hipGetDevice(&dev) != hipSuccess || hipDeviceGetAttribute(&cus, hipDeviceAttributeMultiprocessorCount, dev) != hipSuccess) { grid = -1; return; }
        if (hipFuncSetAttribute((const void*)fwd_kernel, hipFuncAttributeMaxDynamicSharedMemorySize, LDS_BYTES) != hipSuccess) { fprintf(stderr, "kernel_launch: hipFuncSetAttribute failed\n"); grid = -1; return; }
        if (hipOccupancyMaxActiveBlocksPerMultiprocessor(&per_cu, (const void*)fwd_kernel, NWAVES * 64, LDS_BYTES) != hipSuccess || per_cu < 1) fprintf(stderr, "kernel_launch: occupancy query reports %d\n", per_cu);
        (void)hipGetLastError();
        grid = cus;
    }
    if (grid < 0) return;
    (void)hipMemsetAsync((char*)d_ws + WS_CTL, 0, CTL_ZERO_BYTES, stream);
    Args a{};
    for (int i = 0; i < 18; ++i) a.in[i] = (const float*)d_in[i];
    a.out = (float*)d_out; a.ws = (unsigned char*)d_ws;
#ifndef NPH_RUN
#define NPH_RUN N_LAUNCHES
#endif
    for (int li = 0; li < NPH_RUN; ++li) {
        a.ph_lo = (N_LAUNCHES == PER_PHASE) ? li : 0; a.ph_hi = (N_LAUNCHES == PER_PHASE) ? li + 1 : PER_PHASE; a.li = li;
        hipLaunchKernelGGL(fwd_kernel, dim3(grid), dim3(NWAVES * 64), LDS_BYTES, stream, a);
    }
#ifdef DEBUG_DUMP
    hipLaunchKernelGGL(dump_kernel, dim3(TOK * 1024 / 256), dim3(256), 0, stream, (const unsigned char*)d_ws, (float*)d_out, (float)(ws_size >> 20));
#endif
}
```

```cpp
#define MK_N_LAUNCHES 1
#ifndef PG8_EPI_DRAIN
#define PG8_EPI_DRAIN 0
#endif
#include <hip/hip_runtime.h>
#include <hip/hip_bf16.h>
#include <cstdio>
#include <cstdint>
#include <cmath>
namespace pg8 {
#define PG8_LAS __attribute__((address_space(3)))
typedef unsigned short bf16_t;
typedef short bf16x8 __attribute__((ext_vector_type(8)));
typedef float f32x4 __attribute__((ext_vector_type(4)));
typedef unsigned u32x4 __attribute__((ext_vector_type(4)));
constexpr int BM = 256, BK = 64, HALF = 128, HTB = HALF * BK * 2  , STAGE_BYTES = 8 * HTB, NXCD = 8, WGM = 8;

__host__ __device__ __forceinline__ int lds_byte(int r, int c) { const int st = (r >> 4) * 2 + (c >> 5), rr = r & 15, cc = c & 31, ob = rr * 64 + cc * 2; return st * 1024 + (ob ^ (((ob >> 9) & 1) << 5)); }
__host__ __device__ __forceinline__ void stage_rc(int b, int& R, int& C) { const int st = b / 1024, sb = b % 1024, swz = sb ^ (((sb >> 9) & 1) << 5); R = (st >> 1) * 16 + swz / 64; C = (st & 1) * 32 + (swz % 64) / 2; }
__host__ __device__ __forceinline__ int perm32(int rho) { const int n = rho >> 4, i = rho & 15; return 8 * (i >> 2) + 4 * n + (i & 3); }

struct Unit { int pm, pn; };
struct Gemm { const bf16_t* A; const bf16_t* Bt; int M, N, K; };

struct StaticOrder {
    int nM, nN, nwg, G, c;
    __host__ __device__ void init(int M, int N, int G_, int c_) { nM = M / BM; nN = N / BM; nwg = nM * nN; G = G_; c = c_; }
    __host__ __device__ bool next(int i, Unit& u) const {
        const long L = (long)i * G + c; if (L >= nwg) return false;
        int wgid = (int)L; { const int q = nwg / NXCD, r = nwg % NXCD, xcd = wgid % NXCD, off = wgid / NXCD; wgid = (xcd < r ? xcd * (q + 1) : r * (q + 1) + (xcd - r) * q) + off; }
        const int nig = WGM * nN, gid = wgid / nig, fm = gid * WGM, gsz = (nM - fm) < WGM ? (nM - fm) : WGM;
        u.pm = fm + ((wgid % nig) % gsz); u.pn = (wgid % nig) / gsz; return true;
    }
    __device__ __forceinline__ void a_ready(const Unit&) const {}
    __device__ __forceinline__ void done(const Unit&) const {}
};

typedef float f32x2c_t __attribute__((ext_vector_type(2))); typedef __bf16 bf16x2c_t __attribute__((ext_vector_type(2)));
__device__ __forceinline__ unsigned cvt_pk_bf16(float lo, float hi) { const f32x2c_t v = {lo, hi}; const bf16x2c_t b = __builtin_convertvector(v, bf16x2c_t); return __builtin_bit_cast(unsigned, b); }
typedef float f32x2 __attribute__((ext_vector_type(2)));
__device__ __forceinline__ float sigm(float v) { return __builtin_amdgcn_rcpf(1.0f + __builtin_amdgcn_exp2f(-1.4426950408889634f * v)); }
__device__ __forceinline__ float bf_lo(unsigned u) { return __uint_as_float(u << 16); }
__device__ __forceinline__ float bf_hi(unsigned u) { return __uint_as_float(u & 0xffff0000u); }
__device__ __forceinline__ u32x4 pack8(const f32x4 a, const f32x4 b) { u32x4 w; w.x = cvt_pk_bf16(a[0], a[1]); w.y = cvt_pk_bf16(a[2], a[3]); w.z = cvt_pk_bf16(b[0], b[1]); w.w = cvt_pk_bf16(b[2], b[3]); return w; }
__device__ __forceinline__ void unpack8(const u32x4 w, f32x4& a, f32x4& b) { a = (f32x4){bf_lo(w.x), bf_hi(w.x), bf_lo(w.y), bf_hi(w.y)}; b = (f32x4){bf_lo(w.z), bf_hi(w.z), bf_lo(w.w), bf_hi(w.w)}; }

#ifndef PG8_WT
#define PG8_WT 1
#endif
__device__ __forceinline__ __amdgpu_buffer_rsrc_t wt_rsrc(const void* p) { return __builtin_amdgcn_make_buffer_rsrc((void*)p, 0, 0x7fffffff, 0x00020000); }
__device__ __forceinline__ void st16(bf16_t* base, const __amdgpu_buffer_rsrc_t r, size_t elem_off, const u32x4 v) {
#if PG8_WT
    __builtin_amdgcn_raw_buffer_store_b128(v, r, (unsigned)(elem_off * 2), 0, 16);
#else
    *(u32x4*)(base + elem_off) = v;
#endif
}
struct EpiIn {
    static constexpr bool PERM = true, AFTER_DRAIN = false, HAS_MID = false;
    bf16_t *zglu, *Q, *gc; float* kmean; float qscale; size_t qkv_stride, gate_stride;
    __device__ __forceinline__ void operator()(const f32x4 (&acc)[2][2][4][2], const Unit& u, int wr, int wc, int fr, int fq) const {
        const int row0 = u.pm * BM + wr * 64 + fr, cw = wc * 32 + 8 * fq, pn = u.pn;
        const __amdgpu_buffer_rsrc_t rz = wt_rsrc(zglu), rq = wt_rsrc(Q), rg = wt_rsrc(gc);
        if (pn < 4) {
#pragma unroll
            for (int ai = 0; ai < 2; ++ai)
#pragma unroll
                for (int m = 0; m < 4; ++m) { const size_t row = (size_t)(row0 + ai * HALF + m * 16);
                    f32x4 z0, z1;
#pragma unroll
                    for (int j = 0; j < 4; ++j) { z0[j] = acc[ai][0][m][0][j] * sigm(acc[ai][1][m][0][j]); z1[j] = acc[ai][0][m][1][j] * sigm(acc[ai][1][m][1][j]); }
                    st16(zglu, rz, row * 512 + pn * 128 + cw, pack8(z0, z1)); }
        } else if (pn < 10) {
            const size_t boff = (size_t)((pn - 4) >> 1) * qkv_stride; const int ct = (pn & 1) * 256; const float sc = pn < 6 ? qscale : 1.0f;
#pragma unroll
            for (int ai = 0; ai < 2; ++ai)
#pragma unroll
                for (int m = 0; m < 4; ++m) { const size_t row = (size_t)(row0 + ai * HALF + m * 16);
#pragma unroll
                    for (int bj = 0; bj < 2; ++bj) st16(Q, rq, boff + row * 512 + ct + bj * HALF + cw, pack8(acc[ai][bj][m][0] * sc, acc[ai][bj][m][1] * sc)); }
            if (pn == 6 || pn == 7) {
#pragma unroll
                for (int bj = 0; bj < 2; ++bj)
#pragma unroll
                    for (int n = 0; n < 2; ++n)
#pragma unroll
                        for (int j = 0; j < 4; ++j) { float s = 0.f;
#pragma unroll
                            for (int ai = 0; ai < 2; ++ai)
#pragma unroll
                                for (int m = 0; m < 4; ++m) s += acc[ai][bj][m][n][j];
                            s += __shfl_xor(s, 1); s += __shfl_xor(s, 2); s += __shfl_xor(s, 4); s += __shfl_xor(s, 8);
                            if (fr == 0) kmean[((size_t)u.pm * 2 + wr) * 512 + ct + bj * HALF + cw + 4 * n + j] = s * (1.0f / 256.0f); }
            }
        } else {
            const size_t boff = (size_t)((pn - 10) >> 2) * gate_stride; const int ct = ((pn - 10) & 3) * 256;
#pragma unroll
            for (int ai = 0; ai < 2; ++ai)
#pragma unroll
                for (int m = 0; m < 4; ++m) { const size_t row = (size_t)(row0 + ai * HALF + m * 16);
#pragma unroll
                    for (int bj = 0; bj < 2; ++bj) { f32x4 s0, s1;
#pragma unroll
                        for (int j = 0; j < 4; ++j) { s0[j] = sigm(acc[ai][bj][m][0][j]); s1[j] = sigm(acc[ai][bj][m][1][j]); }
                        st16(gc, rg, boff + row * 1024 + ct + bj * HALF + cw, pack8(s0, s1)); } }
        }
    }
};
template <bool ADD> struct EpiMix {
    static constexpr bool PERM = true, AFTER_DRAIN = false, HAS_MID = false;
    const bf16_t* gate; const float* bias; bf16_t* mix;
    __device__ __forceinline__ void operator()(const f32x4 (&acc)[2][2][4][2], const Unit& u, int wr, int wc, int fr, int fq) const {
        const int row0 = u.pm * BM + wr * 64 + fr, col0 = u.pn * BM + wc * 32 + 8 * fq;
        f32x4 b0[2], b1[2];
#pragma unroll
        for (int bj = 0; bj < 2; ++bj) { b0[bj] = (f32x4){0.f, 0.f, 0.f, 0.f}; b1[bj] = b0[bj]; if (!ADD) { b0[bj] = *(const f32x4*)(bias + col0 + bj * HALF); b1[bj] = *(const f32x4*)(bias + col0 + bj * HALF + 4); } }
#pragma unroll
        for (int ai = 0; ai < 2; ++ai) {
            u32x4 gq[4][2], mq[4][2];
#pragma unroll
            for (int m = 0; m < 4; ++m)
#pragma unroll
                for (int bj = 0; bj < 2; ++bj) { const size_t off = (size_t)(row0 + ai * HALF + m * 16) * 1024 + col0 + bj * HALF; gq[m][bj] = *(const u32x4*)(gate + off); if (ADD) mq[m][bj] = *(const u32x4*)(mix + off); }
#pragma unroll
            for (int m = 0; m < 4; ++m)
#pragma unroll
                for (int bj = 0; bj < 2; ++bj) { const size_t off = (size_t)(row0 + ai * HALF + m * 16) * 1024 + col0 + bj * HALF;
                    f32x4 g0, g1; unpack8(gq[m][bj], g0, g1);
                    f32x4 v0 = acc[ai][bj][m][0], v1 = acc[ai][bj][m][1];
                    if (!ADD) { v0 = (v0 + b0[bj]) * g0; v1 = (v1 + b1[bj]) * g1; }
                    else { f32x4 p0, p1; unpack8(mq[m][bj], p0, p1); v0 = p0 + v0 * g0; v1 = p1 + v1 * g1; }
                    *(u32x4*)(mix + off) = pack8(v0, v1); }
        }
    }
};
struct EpiMixF {
    static constexpr bool PERM = true, AFTER_DRAIN = false, HAS_MID = true;
    const bf16_t* gc; const bf16_t* ga; const float* bias; bf16_t* mix;
    __device__ __forceinline__ void mid(f32x4 (&acc)[2][2][4][2], const Unit& u, int wr, int wc, int fr, int fq) const {
        const int row0 = u.pm * BM + wr * 64 + fr, col0 = u.pn * BM + wc * 32 + 8 * fq;
#pragma unroll
        for (int ai = 0; ai < 2; ++ai)
#pragma unroll
            for (int m = 0; m < 4; ++m) { u32x4 cq[2], aq[2];
#pragma unroll
                for (int bj = 0; bj < 2; ++bj) { const size_t off = (size_t)(row0 + ai * HALF + m * 16) * 1024 + col0 + bj * HALF; cq[bj] = *(const u32x4*)(gc + off); aq[bj] = *(const u32x4*)(ga + off); }
#pragma unroll
                for (int bj = 0; bj < 2; ++bj) { f32x4 c0, c1, a0, a1; unpack8(cq[bj], c0, c1); unpack8(aq[bj], a0, a1);
                    const f32x4 b0 = *(const f32x4*)(bias + col0 + bj * HALF), b1 = *(const f32x4*)(bias + col0 + bj * HALF + 4);
#pragma unroll
                    for (int j = 0; j < 4; ++j) { acc[ai][bj][m][0][j] = (acc[ai][bj][m][0][j] + b0[j]) * c0[j] * __builtin_amdgcn_rcpf(fmaxf(a0[j], 1e-30f));
                                                  acc[ai][bj][m][1][j] = (acc[ai][bj][m][1][j] + b1[j]) * c1[j] * __builtin_amdgcn_rcpf(fmaxf(a1[j], 1e-30f)); } }
                if (m & 1) asm volatile("" ::: "memory"); }
    }
    __device__ __forceinline__ void operator()(const f32x4 (&acc)[2][2][4][2], const Unit& u, int wr, int wc, int fr, int fq) const {
        const int row0 = u.pm * BM + wr * 64 + fr, col0 = u.pn * BM + wc * 32 + 8 * fq;
        const __amdgpu_buffer_rsrc_t rm = wt_rsrc(mix);
#pragma unroll
        for (int ai = 0; ai < 2; ++ai) { u32x4 aq[4][2];
#pragma unroll
            for (int m = 0; m < 4; ++m)
#pragma unroll
                for (int bj = 0; bj < 2; ++bj) aq[m][bj] = *(const u32x4*)(ga + (size_t)(row0 + ai * HALF + m * 16) * 1024 + col0 + bj * HALF);
#pragma unroll
            for (int m = 0; m < 4; ++m)
#pragma unroll
                for (int bj = 0; bj < 2; ++bj) { f32x4 a0, a1; unpack8(aq[m][bj], a0, a1); f32x4 v0 = acc[ai][bj][m][0], v1 = acc[ai][bj][m][1];
#pragma unroll
                    for (int j = 0; j < 4; ++j) { v0[j] *= fmaxf(a0[j], 1e-30f); v1[j] *= fmaxf(a1[j], 1e-30f); }
                    st16(mix, rm, (size_t)(row0 + ai * HALF + m * 16) * 1024 + col0 + bj * HALF, pack8(v0, v1)); } }
    }
};
struct EpiX1 {
    static constexpr bool PERM = true, AFTER_DRAIN = false, HAS_MID = false;
    const float* x; float* x1; bf16_t* x1b; float* ss;
    __device__ __forceinline__ void operator()(const f32x4 (&acc)[2][2][4][2], const Unit& u, int wr, int wc, int fr, int fq) const {
        const int row0 = u.pm * BM + wr * 64 + fr, col0 = u.pn * BM + wc * 32 + 8 * fq;
        const __amdgpu_buffer_rsrc_t rx = wt_rsrc(x1b);
#pragma unroll
        for (int ai = 0; ai < 2; ++ai) {
            f32x4 xq[4][2][2];
#pragma unroll
            for (int m = 0; m < 4; ++m)
#pragma unroll
                for (int bj = 0; bj < 2; ++bj) { const size_t off = (size_t)(row0 + ai * HALF + m * 16) * 1024 + col0 + bj * HALF; xq[m][bj][0] = *(const f32x4*)(x + off); xq[m][bj][1] = *(const f32x4*)(x + off + 4); }
#pragma unroll
            for (int m = 0; m < 4; ++m) { const size_t row = (size_t)(row0 + ai * HALF + m * 16); float sq = 0.f;
#pragma unroll
                for (int bj = 0; bj < 2; ++bj) { const size_t off = row * 1024 + col0 + bj * HALF;
                    const f32x4 r0 = xq[m][bj][0] + acc[ai][bj][m][0], r1 = xq[m][bj][1] + acc[ai][bj][m][1];
                    st16(x1b, rx, off, pack8(r0, r1));
                    sq += (r0[0] * r0[0] + r0[1] * r0[1]) + (r0[2] * r0[2] + r0[3] * r0[3]) + (r1[0] * r1[0] + r1[1] * r1[1]) + (r1[2] * r1[2] + r1[3] * r1[3]); }
                sq += __shfl_xor(sq, 16); sq += __shfl_xor(sq, 32);
                if (fq == 0) ss[row * 16 + u.pn * 4 + wc] = sq; }
        }
    }
};
struct EpiStore {
    static constexpr bool PERM = true, AFTER_DRAIN = false, HAS_MID = false;
    bf16_t* O; int ldc;
    __device__ __forceinline__ void operator()(const f32x4 (&acc)[2][2][4][2], const Unit& u, int wr, int wc, int fr, int fq) const {
        const int row0 = u.pm * BM + wr * 64 + fr, col0 = u.pn * BM + wc * 32 + 8 * fq;
        const __amdgpu_buffer_rsrc_t ro = wt_rsrc(O);
#pragma unroll
        for (int ai = 0; ai < 2; ++ai)
#pragma unroll
            for (int m = 0; m < 4; ++m) { const size_t row = (size_t)(row0 + ai * HALF + m * 16);
#pragma unroll
                for (int bj = 0; bj < 2; ++bj) st16(O, ro, row * ldc + col0 + bj * HALF, pack8(acc[ai][bj][m][0], acc[ai][bj][m][1])); }
    }
};


template <class Epi, class Sched, bool ALIGN_EPI = false, bool SP2 = false>
__device__ __forceinline__ void gemm_phase(PG8_LAS unsigned char* lds, const Gemm g, const Sched& S, const Epi& E) {
    const int tid = threadIdx.x, wid = __builtin_amdgcn_readfirstlane(tid >> 6), lane = tid & 63, wr = wid >> 2, wc = wid & 3, fr = lane & 15, fq = lane >> 4;
    const int K = g.K, nt = K / BK;
    unsigned voffA[2], voffB[2];
#pragma unroll
    for (int i = 0; i < 2; ++i) { int R, C; stage_rc(tid * 16 + i * 8192, R, C); const int Rb = Epi::PERM ? ((R & ~31) + perm32(R & 31)) : R;
        voffA[i] = (unsigned)(R * K + C) * 2u; voffB[i] = (unsigned)(Rb * K + C) * 2u; }
    const size_t kstep = (size_t)(BK * 2);
    const size_t hstep = (size_t)HALF * K * 2;
    const size_t tstep = 2 * hstep;
    const unsigned ldsw = (unsigned)wid * 1024u;
    const int aoff = lds_byte(wr * 64 + fr, fq * 8), boff = lds_byte(wc * 32 + fr, fq * 8);
#define PG8_SA(b, h) (((b) * 2 + (h)) * HTB)
#define PG8_SB(b, h) ((4 + (b) * 2 + (h)) * HTB)
#define PG8_STAGE(bufoff, gbase, voff) do { _Pragma("unroll") for (int _i = 0; _i < 2; ++_i) \
        __builtin_amdgcn_global_load_lds((const unsigned*)((const char*)(gbase) + (voff)[_i]), (PG8_LAS unsigned*)(lds + (bufoff) + ldsw + _i * 8192), 16, 0, 0); } while (0)
#define PG8_LDA(dst, b, h) do { _Pragma("unroll") for (int m = 0; m < 4; ++m) _Pragma("unroll") for (int k = 0; k < 2; ++k) dst[m][k] = *(const PG8_LAS bf16x8*)(lds + PG8_SA(b, h) + aoff + m * 2048 + k * 1024); } while (0)
#define PG8_LDB(dst, b, h) do { _Pragma("unroll") for (int n = 0; n < 2; ++n) _Pragma("unroll") for (int k = 0; k < 2; ++k) dst[n][k] = *(const PG8_LAS bf16x8*)(lds + PG8_SB(b, h) + boff + n * 2048 + k * 1024); } while (0)
#define PG8_MMA(ai, bj, At, Bt) do { __builtin_amdgcn_s_setprio(1); _Pragma("unroll") for (int m = 0; m < 4; ++m) _Pragma("unroll") for (int n = 0; n < 2; ++n) _Pragma("unroll") for (int k = 0; k < 2; ++k) \
        acc[ai][bj][m][n] = __builtin_amdgcn_mfma_f32_16x16x32_bf16(Bt[n][k], At[m][k], acc[ai][bj][m][n], 0, 0, 0); __builtin_amdgcn_s_setprio(0); } while (0)
#define PG8_WAIT_V(n) asm volatile("s_waitcnt vmcnt(" #n ")" ::: "memory")
#define PG8_WAIT_L(n) asm volatile("s_waitcnt lgkmcnt(" #n ")" ::: "memory")
#define PG8_BAR __builtin_amdgcn_s_barrier()
#define PG8_SCHED __builtin_amdgcn_sched_barrier(0)
    Unit cur, nxt; int ui = 0;
    if (!S.next(0, cur)) return;
    f32x4 acc[2][2][4][2];
#pragma unroll
    for (int a = 0; a < 2; ++a)
#pragma unroll
        for (int b = 0; b < 2; ++b)
#pragma unroll
            for (int m = 0; m < 4; ++m)
#pragma unroll
                for (int n = 0; n < 2; ++n) acc[a][b][m][n] = (f32x4){0.f, 0.f, 0.f, 0.f};
    bf16x8 At[4][2], B0[2][2], B1[2][2];
    const char* cA = (const char*)g.A + (size_t)cur.pm * tstep; const char* cB = (const char*)g.Bt + (size_t)cur.pn * tstep;
    S.a_ready(cur);
    if constexpr (SP2) {
        PG8_STAGE(PG8_SB(0, 0), cB, voffB); PG8_STAGE(PG8_SB(0, 1), cB + hstep, voffB); PG8_STAGE(PG8_SA(0, 0), cA, voffA); PG8_STAGE(PG8_SA(0, 1), cA + hstep, voffA);
        if (wr == 1) PG8_BAR;
        PG8_WAIT_V(2); PG8_BAR;
        PG8_STAGE(PG8_SB(1, 0), cB + kstep, voffB); PG8_STAGE(PG8_SA(1, 0), cA + kstep, voffA); PG8_STAGE(PG8_SB(1, 1), cB + hstep + kstep, voffB);
        PG8_WAIT_V(6); PG8_BAR;
    } else {
        PG8_STAGE(PG8_SB(0, 0), cB, voffB); PG8_STAGE(PG8_SA(0, 0), cA, voffA); PG8_STAGE(PG8_SB(0, 1), cB + hstep, voffB); PG8_STAGE(PG8_SA(0, 1), cA + hstep, voffA);
        if (wr == 1) PG8_BAR;
        PG8_WAIT_V(4); PG8_BAR;
        PG8_STAGE(PG8_SB(1, 0), cB + kstep, voffB); PG8_STAGE(PG8_SA(1, 0), cA + kstep, voffA); PG8_STAGE(PG8_SB(1, 1), cB + hstep + kstep, voffB);
        PG8_WAIT_V(6); PG8_BAR;
    }
    for (;;) {
        const bool has_next = S.next(ui + 1, nxt);
        const char* nA = has_next ? (const char*)g.A + (size_t)nxt.pm * tstep : cA; const char* nB = has_next ? (const char*)g.Bt + (size_t)nxt.pn * tstep : cB;
        if constexpr (Epi::HAS_MID) {
        for (int t = 0; t < nt / 2; t += 2) {
            const bool last = (t == nt - 2);
            const char* a1 = cA + (size_t)(t + 1) * kstep;
            const char* a2 = last ? nA : cA + (size_t)(t + 2) * kstep; const char* b2 = last ? nB : cB + (size_t)(t + 2) * kstep;
            const char* a3 = a2 + kstep; const char* b3 = b2 + kstep;
            if (last && has_next) S.a_ready(nxt);
            if constexpr (SP2) {
            PG8_LDB(B0, 0, 0); PG8_LDB(B1, 0, 1); PG8_SCHED; PG8_LDA(At, 0, 0); PG8_STAGE(PG8_SA(1, 1), a1 + hstep, voffA);
            PG8_WAIT_V(8); PG8_WAIT_L(0); PG8_BAR; PG8_MMA(0, 0, At, B0); PG8_MMA(0, 1, At, B1); PG8_BAR; PG8_SCHED;
            PG8_LDA(At, 0, 1); PG8_STAGE(PG8_SB(0, 0), b2, voffB); PG8_STAGE(PG8_SB(0, 1), b2 + hstep, voffB); PG8_STAGE(PG8_SA(0, 0), a2, voffA);
            PG8_WAIT_V(8); PG8_WAIT_L(0); PG8_BAR; PG8_MMA(1, 0, At, B0); PG8_MMA(1, 1, At, B1); PG8_BAR; PG8_SCHED;
            PG8_LDB(B0, 1, 0); PG8_LDB(B1, 1, 1); PG8_SCHED; PG8_LDA(At, 1, 0); PG8_STAGE(PG8_SA(0, 1), a2 + hstep, voffA);
            PG8_WAIT_V(8); PG8_WAIT_L(0); PG8_BAR; PG8_MMA(0, 0, At, B0); PG8_MMA(0, 1, At, B1); PG8_BAR; PG8_SCHED;
            PG8_LDA(At, 1, 1); PG8_STAGE(PG8_SB(1, 0), b3, voffB); PG8_STAGE(PG8_SB(1, 1), b3 + hstep, voffB); PG8_STAGE(PG8_SA(1, 0), a3, voffA);
            PG8_WAIT_V(8); PG8_WAIT_L(0); PG8_BAR; PG8_MMA(1, 0, At, B0); PG8_MMA(1, 1, At, B1); PG8_BAR; PG8_SCHED;
            } else {
            PG8_LDB(B0, 0, 0); PG8_SCHED; PG8_LDA(At, 0, 0); PG8_STAGE(PG8_SA(1, 1), a1 + hstep, voffA);
            PG8_WAIT_L(8); PG8_BAR; PG8_WAIT_L(0); PG8_MMA(0, 0, At, B0); PG8_BAR; PG8_SCHED;
            PG8_LDB(B1, 0, 1); PG8_STAGE(PG8_SB(0, 0), b2, voffB);
            PG8_BAR; PG8_WAIT_L(0); PG8_MMA(0, 1, At, B1); PG8_BAR;
            PG8_LDA(At, 0, 1); PG8_STAGE(PG8_SA(0, 0), a2, voffA);
            PG8_BAR; PG8_WAIT_L(0); PG8_MMA(1, 0, At, B0); PG8_BAR; PG8_SCHED;
            PG8_STAGE(PG8_SB(0, 1), b2 + hstep, voffB);
            PG8_WAIT_V(6); PG8_BAR; PG8_MMA(1, 1, At, B1); PG8_BAR;
            PG8_LDB(B0, 1, 0); PG8_SCHED; PG8_LDA(At, 1, 0); PG8_STAGE(PG8_SA(0, 1), a2 + hstep, voffA);
            PG8_WAIT_L(8); PG8_BAR; PG8_WAIT_L(0); PG8_MMA(0, 0, At, B0); PG8_BAR; PG8_SCHED;
            PG8_LDB(B1, 1, 1); PG8_STAGE(PG8_SB(1, 0), b3, voffB);
            PG8_BAR; PG8_WAIT_L(0); PG8_MMA(0, 1, At, B1); PG8_BAR;
            PG8_LDA(At, 1, 1); PG8_STAGE(PG8_SA(1, 0), a3, voffA);
            PG8_BAR; PG8_WAIT_L(0); PG8_MMA(1, 0, At, B0); PG8_BAR; PG8_SCHED;
            PG8_STAGE(PG8_SB(1, 1), b3 + hstep, voffB);
            PG8_WAIT_V(6); PG8_BAR; PG8_MMA(1, 1, At, B1); PG8_BAR;
            }
        }
        E.mid(acc, cur, wr, wc, fr, fq);
        for (int t = nt / 2; t < nt; t += 2) {
            const bool last = (t == nt - 2);
            const char* a1 = cA + (size_t)(t + 1) * kstep;
            const char* a2 = last ? nA : cA + (size_t)(t + 2) * kstep; const char* b2 = last ? nB : cB + (size_t)(t + 2) * kstep;
            const char* a3 = a2 + kstep; const char* b3 = b2 + kstep;
            if (last && has_next) S.a_ready(nxt);
            if constexpr (SP2) {
            PG8_LDB(B0, 0, 0); PG8_LDB(B1, 0, 1); PG8_SCHED; PG8_LDA(At, 0, 0); PG8_STAGE(PG8_SA(1, 1), a1 + hstep, voffA);
            PG8_WAIT_V(8); PG8_WAIT_L(0); PG8_BAR; PG8_MMA(0, 0, At, B0); PG8_MMA(0, 1, At, B1); PG8_BAR; PG8_SCHED;
            PG8_LDA(At, 0, 1); PG8_STAGE(PG8_SB(0, 0), b2, voffB); PG8_STAGE(PG8_SB(0, 1), b2 + hstep, voffB); PG8_STAGE(PG8_SA(0, 0), a2, voffA);
            PG8_WAIT_V(8); PG8_WAIT_L(0); PG8_BAR; PG8_MMA(1, 0, At, B0); PG8_MMA(1, 1, At, B1); PG8_BAR; PG8_SCHED;
            PG8_LDB(B0, 1, 0); PG8_LDB(B1, 1, 1); PG8_SCHED; PG8_LDA(At, 1, 0); PG8_STAGE(PG8_SA(0, 1), a2 + hstep, voffA);
            PG8_WAIT_V(8); PG8_WAIT_L(0); PG8_BAR; PG8_MMA(0, 0, At, B0); PG8_MMA(0, 1, At, B1); PG8_BAR; PG8_SCHED;
            PG8_LDA(At, 1, 1); PG8_STAGE(PG8_SB(1, 0), b3, voffB); PG8_STAGE(PG8_SB(1, 1), b3 + hstep, voffB); PG8_STAGE(PG8_SA(1, 0), a3, voffA);
            PG8_WAIT_V(8); PG8_WAIT_L(0); PG8_BAR; PG8_MMA(1, 0, At, B0); PG8_MMA(1, 1, At, B1); PG8_BAR; PG8_SCHED;
            } else {
            PG8_LDB(B0, 0, 0); PG8_SCHED; PG8_LDA(At, 0, 0); PG8_STAGE(PG8_SA(1, 1), a1 + hstep, voffA);
            PG8_WAIT_L(8); PG8_BAR; PG8_WAIT_L(0); PG8_MMA(0, 0, At, B0); PG8_BAR; PG8_SCHED;
            PG8_LDB(B1, 0, 1); PG8_STAGE(PG8_SB(0, 0), b2, voffB);
            PG8_BAR; PG8_WAIT_L(0); PG8_MMA(0, 1, At, B1); PG8_BAR;
            PG8_LDA(At, 0, 1); PG8_STAGE(PG8_SA(0, 0), a2, voffA);
            PG8_BAR; PG8_WAIT_L(0); PG8_MMA(1, 0, At, B0); PG8_BAR; PG8_SCHED;
            PG8_STAGE(PG8_SB(0, 1), b2 + hstep, voffB);
            PG8_WAIT_V(6); PG8_BAR; PG8_MMA(1, 1, At, B1); PG8_BAR;
            PG8_LDB(B0, 1, 0); PG8_SCHED; PG8_LDA(At, 1, 0); PG8_STAGE(PG8_SA(0, 1), a2 + hstep, voffA);
            PG8_WAIT_L(8); PG8_BAR; PG8_WAIT_L(0); PG8_MMA(0, 0, At, B0); PG8_BAR; PG8_SCHED;
            PG8_LDB(B1, 1, 1); PG8_STAGE(PG8_SB(1, 0), b3, voffB);
            PG8_BAR; PG8_WAIT_L(0); PG8_MMA(0, 1, At, B1); PG8_BAR;
            PG8_LDA(At, 1, 1); PG8_STAGE(PG8_SA(1, 0), a3, voffA);
            PG8_BAR; PG8_WAIT_L(0); PG8_MMA(1, 0, At, B0); PG8_BAR; PG8_SCHED;
            PG8_STAGE(PG8_SB(1, 1), b3 + hstep, voffB);
            PG8_WAIT_V(6); PG8_BAR; PG8_MMA(1, 1, At, B1); PG8_BAR;
            }
        }
        } else {
        for (int t = 0; t < nt; t += 2) {
            const bool last = (t == nt - 2);
            const char* a1 = cA + (size_t)(t + 1) * kstep;
            const char* a2 = last ? nA : cA + (size_t)(t + 2) * kstep; const char* b2 = last ? nB : cB + (size_t)(t + 2) * kstep;
            const char* a3 = a2 + kstep; const char* b3 = b2 + kstep;
            if (last && has_next) S.a_ready(nxt);
            if constexpr (SP2) {
            PG8_LDB(B0, 0, 0); PG8_LDB(B1, 0, 1); PG8_SCHED; PG8_LDA(At, 0, 0); PG8_STAGE(PG8_SA(1, 1), a1 + hstep, voffA);
            PG8_WAIT_V(8); PG8_WAIT_L(0); PG8_BAR; PG8_MMA(0, 0, At, B0); PG8_MMA(0, 1, At, B1); PG8_BAR; PG8_SCHED;
            PG8_LDA(At, 0, 1); PG8_STAGE(PG8_SB(0, 0), b2, voffB); PG8_STAGE(PG8_SB(0, 1), b2 + hstep, voffB); PG8_STAGE(PG8_SA(0, 0), a2, voffA);
            PG8_WAIT_V(8); PG8_WAIT_L(0); PG8_BAR; PG8_MMA(1, 0, At, B0); PG8_MMA(1, 1, At, B1); PG8_BAR; PG8_SCHED;
            PG8_LDB(B0, 1, 0); PG8_LDB(B1, 1, 1); PG8_SCHED; PG8_LDA(At, 1, 0); PG8_STAGE(PG8_SA(0, 1), a2 + hstep, voffA);
            PG8_WAIT_V(8); PG8_WAIT_L(0); PG8_BAR; PG8_MMA(0, 0, At, B0); PG8_MMA(0, 1, At, B1); PG8_BAR; PG8_SCHED;
            PG8_LDA(At, 1, 1); PG8_STAGE(PG8_SB(1, 0), b3, voffB); PG8_STAGE(PG8_SB(1, 1), b3 + hstep, voffB); PG8_STAGE(PG8_SA(1, 0), a3, voffA);
            PG8_WAIT_V(8); PG8_WAIT_L(0); PG8_BAR; PG8_MMA(1, 0, At, B0); PG8_MMA(1, 1, At, B1); PG8_BAR; PG8_SCHED;
            } else {
            PG8_LDB(B0, 0, 0); PG8_SCHED; PG8_LDA(At, 0, 0); PG8_STAGE(PG8_SA(1, 1), a1 + hstep, voffA);
            PG8_WAIT_L(8); PG8_BAR; PG8_WAIT_L(0); PG8_MMA(0, 0, At, B0); PG8_BAR; PG8_SCHED;
            PG8_LDB(B1, 0, 1); PG8_STAGE(PG8_SB(0, 0), b2, voffB);
            PG8_BAR; PG8_WAIT_L(0); PG8_MMA(0, 1, At, B1); PG8_BAR;
            PG8_LDA(At, 0, 1); PG8_STAGE(PG8_SA(0, 0), a2, voffA);
            PG8_BAR; PG8_WAIT_L(0); PG8_MMA(1, 0, At, B0); PG8_BAR; PG8_SCHED;
            PG8_STAGE(PG8_SB(0, 1), b2 + hstep, voffB);
            PG8_WAIT_V(6); PG8_BAR; PG8_MMA(1, 1, At, B1); PG8_BAR;
            PG8_LDB(B0, 1, 0); PG8_SCHED; PG8_LDA(At, 1, 0); PG8_STAGE(PG8_SA(0, 1), a2 + hstep, voffA);
            PG8_WAIT_L(8); PG8_BAR; PG8_WAIT_L(0); PG8_MMA(0, 0, At, B0); PG8_BAR; PG8_SCHED;
            PG8_LDB(B1, 1, 1); PG8_STAGE(PG8_SB(1, 0), b3, voffB);
            PG8_BAR; PG8_WAIT_L(0); PG8_MMA(0, 1, At, B1); PG8_BAR;
            PG8_LDA(At, 1, 1); PG8_STAGE(PG8_SA(1, 0), a3, voffA);
            PG8_BAR; PG8_WAIT_L(0); PG8_MMA(1, 0, At, B0); PG8_BAR; PG8_SCHED;
            PG8_STAGE(PG8_SB(1, 1), b3 + hstep, voffB);
            PG8_WAIT_V(6); PG8_BAR; PG8_MMA(1, 1, At, B1); PG8_BAR;
            }
        }
        }
        if constexpr (ALIGN_EPI) { if (wr == 0) PG8_BAR; }
        if constexpr (!Epi::AFTER_DRAIN) { E(acc, cur, wr, wc, fr, fq); S.done(cur);
#if PG8_EPI_DRAIN
            PG8_WAIT_V(0);
#endif
        }
        if (!has_next) break;
#pragma unroll
        for (int a = 0; a < 2; ++a)
#pragma unroll
            for (int b = 0; b < 2; ++b)
#pragma unroll
                for (int m = 0; m < 4; ++m)
#pragma unroll
                    for (int n = 0; n < 2; ++n) acc[a][b][m][n] = (f32x4){0.f, 0.f, 0.f, 0.f};
        cur = nxt; cA = nA; cB = nB; ++ui;
        if constexpr (ALIGN_EPI) { if (wr == 1) PG8_BAR; }
    }
    PG8_WAIT_V(0);
    if constexpr (!ALIGN_EPI) { if (wr == 0) PG8_BAR; }
    PG8_BAR;
    if constexpr (Epi::AFTER_DRAIN) { E.fused(acc, cur, wr, wc, fr, fq, lds, wid, lane); S.done(cur); }
#undef PG8_SA
#undef PG8_SB
#undef PG8_STAGE
#undef PG8_LDA
#undef PG8_LDB
#undef PG8_MMA
#undef PG8_WAIT_V
#undef PG8_WAIT_L
#undef PG8_BAR
#undef PG8_SCHED
}
}

#include <hip/hip_bf16.h>
#include <cmath>
namespace attn_body {
using bf16=__hip_bfloat16;
using bf16x8=__attribute__((ext_vector_type(8)))short;
using s16x4=__attribute__((ext_vector_type(4)))short;
using f32x16=__attribute__((ext_vector_type(16)))float;
using u32x4=__attribute__((ext_vector_type(4)))unsigned;
typedef float f32x4_t __attribute__((ext_vector_type(4)));
constexpr int BATCH=8,NHEAD=8,SEQ=4096,D=64,DM=NHEAD*D;
constexpr int NW=8,QBLK=32,QB=QBLK*NW,KVBLK=64,NQB=SEQ/QB;
constexpr int ATTN_PITCH=DM, ATTN_UNIT_ROWS=QB, OPITCH=1024;
__device__ __forceinline__ int crow(int r,int hi){return (r&3)+8*(r>>2)+4*hi;}
#define SBAR() __builtin_amdgcn_sched_barrier(0)
__device__ __forceinline__ void cmask(f32x16&p0,f32x16&p1,int jb,int qrel,int hi){
  const float NEG=-INFINITY; int kb=64*jb+4*hi;
  #pragma unroll
  for(int r=0;r<16;++r){int kv=kb+(r&3)+8*(r>>2); if(kv>qrel)p0[r]=NEG; if(kv+32>qrel)p1[r]=NEG;}
}

constexpr int NSLOT=3, SLOTB=8192;
constexpr int LDS_K=0, LDS_V=NSLOT*SLOTB, LDS_WS=2*NSLOT*SLOTB, LDS_OST=LDS_WS+NW*64*4, LDS_KM=LDS_OST+NW*4096, LDS_BYTES=LDS_KM+4096;
constexpr float C2=0.125f*1.4426950408889634f;
__device__ __forceinline__ void glds16(const void*gsrc,unsigned lds_dst){unsigned keep;
  asm volatile("s_mov_b32 %0, m0\n\ts_mov_b32 m0, %2\n\ts_nop 0\n\tglobal_load_lds_dwordx4 %1, off\n\ts_mov_b32 m0, %0":"=&s"(keep):"v"(gsrc),"s"(lds_dst):"memory");}
__device__ __forceinline__ float max3f(float a,float b,float c){float r;asm("v_max3_f32 %0, %1, %2, %3":"=v"(r):"v"(a),"v"(b),"v"(c));return r;}
__device__ __forceinline__ float max2f(float a,float b){float r;asm("v_max_f32_e32 %0, %1, %2":"=v"(r):"v"(a),"v"(b));return r;}
__device__ __forceinline__ float fadd_s(float a,float b){float r;asm("v_add_f32_e32 %0, %1, %2":"=v"(r):"v"(a),"v"(b));return r;}
__device__ __forceinline__ float fsub_s(float a,float b){float r;asm("v_sub_f32_e32 %0, %1, %2":"=v"(r):"v"(a),"v"(b));return r;}
typedef float f32x2_t __attribute__((ext_vector_type(2))); typedef __bf16 bf16x2_t __attribute__((ext_vector_type(2)));
__device__ __forceinline__ unsigned cvtpk_s(float lo,float hi){f32x2_t v={lo,hi};bf16x2_t b=__builtin_convertvector(v,bf16x2_t);return __builtin_bit_cast(unsigned,b);}
#define WAIT_BAR(N) asm volatile("s_waitcnt vmcnt(" #N ") lgkmcnt(0)\n\ts_barrier":::"memory")

__device__ __forceinline__ void qkt(f32x16&p0,f32x16&p1,const char*Kslot,const bf16x8*qr,int r32,int hi){
  const char*kb=Kslot+hi*1024+r32*16;
  #pragma unroll
  for(int d0=0;d0<4;++d0){
    const bf16x8 b0=*reinterpret_cast<const bf16x8*>(kb+d0*2048);
    const bf16x8 b1=*reinterpret_cast<const bf16x8*>(kb+d0*2048+512);
    p0=__builtin_amdgcn_mfma_f32_32x32x16_bf16(b0,qr[d0],p0,0,0,0);p1=__builtin_amdgcn_mfma_f32_32x32x16_bf16(b1,qr[d0],p1,0,0,0);}
}
typedef __attribute__((address_space(3))) const char* lds_cptr;
typedef short v4i16_t __attribute__((ext_vector_type(4)));
__device__ __forceinline__ void kload8(bf16x8*kf,lds_cptr kp){
  kf[0]=*(const __attribute__((address_space(3))) bf16x8*)(kp);      kf[1]=*(const __attribute__((address_space(3))) bf16x8*)(kp+512);
  kf[2]=*(const __attribute__((address_space(3))) bf16x8*)(kp+2048); kf[3]=*(const __attribute__((address_space(3))) bf16x8*)(kp+2560);
  kf[4]=*(const __attribute__((address_space(3))) bf16x8*)(kp+4096); kf[5]=*(const __attribute__((address_space(3))) bf16x8*)(kp+4608);
  kf[6]=*(const __attribute__((address_space(3))) bf16x8*)(kp+6144); kf[7]=*(const __attribute__((address_space(3))) bf16x8*)(kp+6656);
}
__device__ __forceinline__ void kload2(bf16x8*kf,lds_cptr kp,int j){ kf[2*j]=*(const __attribute__((address_space(3))) bf16x8*)(kp+j*2048); kf[2*j+1]=*(const __attribute__((address_space(3))) bf16x8*)(kp+j*2048+512); }
__device__ __forceinline__ s16x4 vtr(lds_cptr p){ return __builtin_bit_cast(s16x4,__builtin_amdgcn_ds_read_tr16_b64_v4i16((__attribute__((address_space(3))) v4i16_t*)p)); }
__device__ __forceinline__ float rowmax(const f32x16&p0,const f32x16&p1){
  float a=max3f(p0[0],p0[1],p1[0]),b=max3f(p0[2],p0[3],p1[1]);a=max3f(a,p1[2],p1[3]);
  #pragma unroll
  for(int r=4;r<16;r+=4){a=max3f(a,p0[r],p0[r+1]);b=max3f(b,p0[r+2],p0[r+3]);a=max3f(a,p1[r],p1[r+1]);b=max3f(b,p1[r+2],p1[r+3]);}
  const float m=max2f(a,b);
  auto rr=__builtin_amdgcn_permlane32_swap(__float_as_uint(m),__float_as_uint(m),false,false);
  return max2f(__uint_as_float(rr[0]),__uint_as_float(rr[1]));
}
__device__ __forceinline__ void pv(f32x16*o,int vb,bf16x8 pa0,bf16x8 pa1,bf16x8 pa2,bf16x8 pa3){
  #pragma unroll
  for(int d0=0;d0<2;++d0){s16x4 lo[4],hi[4];
    #pragma unroll
    for(int ks=0;ks<4;++ks){
      asm volatile("ds_read_b64_tr_b16 %0,%1 offset:%c2":"=&v"(lo[ks]):"v"(vb),"i"(d0*4096+ks*1024):"memory");
      asm volatile("ds_read_b64_tr_b16 %0,%1 offset:%c2":"=&v"(hi[ks]):"v"(vb),"i"(d0*4096+ks*1024+512):"memory");}
    asm volatile("s_waitcnt lgkmcnt(0)":::"memory");SBAR();
    #define PK(k) (bf16x8){lo[k][0],lo[k][1],lo[k][2],lo[k][3],hi[k][0],hi[k][1],hi[k][2],hi[k][3]}
    o[d0]=__builtin_amdgcn_mfma_f32_32x32x16_bf16(pa0,PK(0),o[d0],0,0,0);
    o[d0]=__builtin_amdgcn_mfma_f32_32x32x16_bf16(pa1,PK(1),o[d0],0,0,0);
    o[d0]=__builtin_amdgcn_mfma_f32_32x32x16_bf16(pa2,PK(2),o[d0],0,0,0);
    o[d0]=__builtin_amdgcn_mfma_f32_32x32x16_bf16(pa3,PK(3),o[d0],0,0,0);
    #undef PK
  }
}

#ifndef ATTN_STORE16
#define ATTN_STORE16(p,v) __builtin_amdgcn_raw_buffer_store_b128((v),orsrc_,(unsigned)((const char*)(p)-(const char*)O),0,16)
#endif
template<int THRL> __device__ __forceinline__ void attn_unit(int b,int h,int qb,const bf16*Q,const bf16*__restrict__ K,const bf16*__restrict__ V,bf16*O,const float*kmean,char*shm){
  const int tid=threadIdx.x,lane=tid&63,r32=lane&31,hi=lane>>5; const int wid=__builtin_amdgcn_readfirstlane(tid>>6);
  const long rowbase=(long)b*SEQ; const int q0=qb*QB;
  const bf16*Qw=Q+(rowbase+q0+wid*QBLK)*DM+h*D;
  const bf16*Kh=K+rowbase*DM+h*D,*Vh=V+rowbase*DM+h*D;
  const unsigned lds0=(unsigned)(uintptr_t)shm;
  float*wsf=(float*)(shm+LDS_WS)+wid*64;
  const bf16*ksrc=Kh+(long)lane*DM+wid*8;
  const bf16*vsrc=Vh+(long)(16*(wid&3)+(lane>>2))*DM+(wid>>2)*32+(lane&3)*8;
  const unsigned kdst=lds0+LDS_K+wid*1024, vdst=lds0+LDS_V+wid*1024;
  #define POS(t) (((t)<4)?(NT-4+(t)):((t)-4))
  #define DMA_K(t,slot) glds16(ksrc+(long)POS(t)*KVBLK*DM,(unsigned)__builtin_amdgcn_readfirstlane(kdst+(slot)))
  #define DMA_V(t,slot) glds16(vsrc+(long)POS(t)*KVBLK*DM,(unsigned)__builtin_amdgcn_readfirstlane(vdst+(slot)))
  const int vb0=(int)(lds0+LDS_V)+((lane>>4)&1)*32+(lane&3)*8+(4*hi+((lane&15)>>2))*64;
  const char*Kbase=shm+LDS_K; bf16x8 kf[8];
  const lds_cptr shm3=(lds_cptr)shm; const lds_cptr kp0=shm3+LDS_K+hi*1024+r32*16; const lds_cptr vp0=shm3+LDS_V+((lane>>4)&1)*32+(lane&3)*8+(4*hi+((lane&15)>>2))*64;
  const int NT=(q0+QB)/KVBLK;
  DMA_K(0,0);DMA_V(0,0);DMA_K(1,SLOTB);
  bf16x8 qr[4];
  #pragma unroll
  for(int d0=0;d0<4;++d0)qr[d0]=*reinterpret_cast<const bf16x8*>(&Qw[(long)r32*DM+d0*16+hi*8]);
  float mhat=0.f,l_reg=0.f;f32x16 o[2];o[0]=f32x16{};o[1]=f32x16{};
  const float slope2=ldexpf(1.4426950408889634f,-(h+1));
  unsigned selmask=0u;
  { typedef __attribute__((address_space(3))) float* lds_fptr; typedef __attribute__((address_space(3))) const f32x4_t* lds_f4ptr;
    lds_fptr kml=(lds_fptr)((lds_cptr)shm+LDS_KM);
    { const float*src=kmean+((long)b*16)*2*DM+h*D;
      #pragma unroll
      for(int i=0;i<2;++i){const int e=tid+512*i; kml[e]=src[(e>>6)*2*DM+(e&63)]+src[(e>>6)*2*DM+DM+(e&63)];} }
    asm volatile("s_waitcnt vmcnt(0) lgkmcnt(0)\n\ts_barrier":::"memory");
    float qf[32];
    #pragma unroll
    for(int d0=0;d0<4;++d0){
      #pragma unroll
      for(int j=0;j<8;++j)qf[d0*8+j]=__uint_as_float(((unsigned)(unsigned short)qr[d0][j])<<16);}
    float sc[16];
    #pragma unroll
    for(int j=0;j<16;++j){ sc[j]=-INFINITY;
      if(j<qb){ lds_f4ptr kr=(lds_f4ptr)(kml+j*64+hi*8); float a=0.f;
        #pragma unroll
        for(int d0=0;d0<4;++d0){ const f32x4_t k0=kr[d0*4],k1=kr[d0*4+1];
          a+=qf[d0*8+0]*k0[0]+qf[d0*8+1]*k0[1]+qf[d0*8+2]*k0[2]+qf[d0*8+3]*k0[3]+qf[d0*8+4]*k1[0]+qf[d0*8+5]*k1[1]+qf[d0*8+6]*k1[2]+qf[d0*8+7]*k1[3]; }
        a+=__shfl_xor(a,32); sc[j]=a; } }
    #pragma unroll
    for(int j=0;j<15;++j){ int cnt=0;
      #pragma unroll
      for(int k=0;k<15;++k){ if(k!=j) cnt+=((sc[k]>sc[j])||((sc[k]==sc[j])&&(k<j)))?1:0; }
      if(j<qb&&cnt<3) selmask|=(1u<<j); } }
  #define CINIT(C0,C1,t) do{ const int pt_=POS(t); float x_=slope2*(float)(64*pt_-q0+4*hi)-mhat; \
    if((t)>=4){ x_+=((selmask>>(pt_>>2))&1u)?0.f:-30000.f; } const float y_=x_+32.f*slope2; \
    _Pragma("unroll") for(int r=0;r<16;++r){ const float cr_=(float)((r&3)+8*(r>>2)); C0[r]=__builtin_fmaf(slope2,cr_,x_); C1[r]=__builtin_fmaf(slope2,cr_,y_); } }while(0)

  const int qrel=wid*QBLK+r32;
  #define CMASK(P0,P1,t) do{ if((t)<4)cmask(P0,P1,(t),qrel,hi);}while(0)
  bool resc=false;
  #define START(P0,P1) do{ const float rm=rowmax(P0,P1); resc=false; \
    { const float dl=rm; mhat=fadd_s(mhat,dl); \
      _Pragma("unroll") for(int r=0;r<16;++r){P0[r]=fsub_s(P0[r],dl);P1[r]=fsub_s(P1[r],dl);} } \
    _Pragma("unroll") for(int r=0;r<16;++r)P0[r]=__builtin_amdgcn_exp2f(P0[r]); }while(0)
  #define RESC() do{ if(resc){ asm volatile("s_waitcnt lgkmcnt(0)":::"memory"); \
      _Pragma("unroll") for(int d_=0;d_<2;++d_) _Pragma("unroll") for(int r=0;r<16;++r)o[d_][r]*=wsf[crow(r,hi)]; } }while(0)
  f32x16 pA0,pA1,pB0,pB1;
  int sl_prev=0,sl_cur=0,sl_next=SLOTB;
  #define ROT() do{sl_prev=sl_cur;sl_cur=sl_next;sl_next=(sl_next==(NSLOT-1)*SLOTB)?0:sl_next+SLOTB;}while(0)
  DMA_K(2,2*SLOTB);
  WAIT_BAR(3);
  CINIT(pA0,pA1,0); qkt(pA0,pA1,Kbase,qr,r32,hi);asm volatile("s_nop 15\n\ts_nop 7":"+v"(pA0),"+v"(pA1));CMASK(pA0,pA1,0);
  START(pA0,pA1);
  _Pragma("unroll") for(int r=0;r<16;++r)pA1[r]=__builtin_amdgcn_exp2f(pA1[r]);
  WAIT_BAR(0);
  DMA_K(3,0);DMA_V(1,SLOTB);
  ROT();
  kload8(kf,kp0+sl_cur);
  WAIT_BAR(2);
  s16x4 vlo[8],vhi[8]; u32x4 pw0,pw1,pw2,pw3;
  #define PKW(P,B) cvtpk_s(P[B],P[B+1])
  #define PAF(k) __builtin_bit_cast(bf16x8,pw##k)
  #define VFR(i) (bf16x8){vlo[i][0],vlo[i][1],vlo[i][2],vlo[i][3],vhi[i][0],vhi[i][1],vhi[i][2],vhi[i][3]}
  #define PIN(x) asm volatile("":"+v"(x))
  #define MX3(a,b,c) __builtin_fmaxf(__builtin_fmaxf((a),(b)),(c))
  #define GAPA(MF,A0,A1,A2,A3,W0,W1,PW) do{ MF; sacc+=A0; sacc+=A1; sacc+=A2; sacc+=A3; PIN(sacc); W0; W1; PIN(PW); SBAR(); }while(0)
  #define EX(v) __builtin_amdgcn_exp2f(v)
  #define GAPB(MF,X,B) do{ MF; X[B]=EX(X[B]); X[B+1]=EX(X[B+1]); X[B+2]=EX(X[B+2]); X[B+3]=EX(X[B+3]); PIN(X); SBAR(); }while(0)
  #define VRD(i) do{ vlo[i]=vtr(vp_+(((i)>>2)*4096+((i)&3)*1024)); vhi[i]=vtr(vp_+(((i)>>2)*4096+((i)&3)*1024+512)); }while(0)
  #define KRD(G,j) do{ if(G){ kload2(kf,kp0+sl_next,j); SBAR(); } }while(0)
  #define STEP(C0,C1,P0,P1,t,GK,GV,GL) do{ SBAR(); CINIT(C0,C1,t); PIN(C0); PIN(C1); SBAR(); \
    const lds_cptr vp_=vp0+sl_prev; \
    VRD(0); SBAR(); float sacc=(P0[0]+P0[1]); \
    GAPA(C0=__builtin_amdgcn_mfma_f32_32x32x16_bf16(kf[0],qr[0],C0,0,0,0), P0[2],P0[3],P0[4],P0[5],     pw0[0]=PKW(P0,0), pw0[1]=PKW(P0,2), pw0); \
    VRD(4); SBAR(); GAPA(C1=__builtin_amdgcn_mfma_f32_32x32x16_bf16(kf[1],qr[0],C1,0,0,0), P0[6],P0[7],P0[8],P0[9],     pw0[2]=PKW(P0,4), pw0[3]=PKW(P0,6), pw0); \
    VRD(1); SBAR(); GAPA(C0=__builtin_amdgcn_mfma_f32_32x32x16_bf16(kf[2],qr[1],C0,0,0,0),   P0[10],P0[11],P0[12],P0[13], pw1[0]=PKW(P0,8), pw1[1]=PKW(P0,10), pw1); \
    VRD(5); SBAR(); GAPA(C1=__builtin_amdgcn_mfma_f32_32x32x16_bf16(kf[3],qr[1],C1,0,0,0),   P0[14],P0[15],P1[0],P1[1],   pw1[2]=PKW(P0,12),pw1[3]=PKW(P0,14), pw1); \
    VRD(2); SBAR(); GAPA(C0=__builtin_amdgcn_mfma_f32_32x32x16_bf16(kf[4],qr[2],C0,0,0,0),   P1[2],P1[3],P1[4],P1[5],     pw2[0]=PKW(P1,0), pw2[1]=PKW(P1,2), pw2); \
    VRD(6); SBAR(); GAPA(C1=__builtin_amdgcn_mfma_f32_32x32x16_bf16(kf[5],qr[2],C1,0,0,0),   P1[6],P1[7],P1[8],P1[9],     pw2[2]=PKW(P1,4), pw2[3]=PKW(P1,6), pw2); \
    VRD(3); SBAR(); GAPA(C0=__builtin_amdgcn_mfma_f32_32x32x16_bf16(kf[6],qr[3],C0,0,0,0),   P1[10],P1[11],P1[12],P1[13], pw3[0]=PKW(P1,8), pw3[1]=PKW(P1,10), pw3); \
    VRD(7); SBAR(); GAPA(C1=__builtin_amdgcn_mfma_f32_32x32x16_bf16(kf[7],qr[3],C1,0,0,0),   P1[14],P1[15],0.f,0.f,       pw3[2]=PKW(P1,12),pw3[3]=PKW(P1,14), pw3); \
    l_reg+=sacc; \
    if(GK){DMA_K((t)+3,sl_cur);} if(GV){DMA_V((t)+1,sl_next);} \
    CMASK(C0,C1,t); \
    { float a=MX3(C0[0],C0[1],C1[0]),b=MX3(C0[2],C0[3],C1[1]); a=MX3(a,C1[2],C1[3]); \
      _Pragma("unroll") for(int r=4;r<16;r+=4){a=MX3(a,C0[r],C0[r+1]);b=MX3(b,C0[r+2],C0[r+3]);a=MX3(a,C1[r],C1[r+1]);b=MX3(b,C1[r+2],C1[r+3]);} \
      float rm=__builtin_fmaxf(a,b); { auto rr=__builtin_amdgcn_permlane32_swap(__float_as_uint(rm),__float_as_uint(rm),false,false); rm=__builtin_fmaxf(__uint_as_float(rr[0]),__uint_as_float(rr[1])); } \
      resc=false; \
      if(__builtin_expect(__any(rm>(float)THRL),0)){ const float dl=__builtin_fmaxf(rm,0.f); mhat+=dl; \
        _Pragma("unroll") for(int r=0;r<16;++r){C0[r]-=dl;C1[r]-=dl;} \
        const float f=__builtin_amdgcn_exp2f(-dl); l_reg*=f; if(hi==0)wsf[r32]=f; resc=true; } } \
    SBAR(); \
    GAPB(o[0]=__builtin_amdgcn_mfma_f32_32x32x16_bf16(PAF(0),VFR(0),o[0],0,0,0), C0,0); \
    GAPB(o[1]=__builtin_amdgcn_mfma_f32_32x32x16_bf16(PAF(0),VFR(4),o[1],0,0,0), C0,4); \
    KRD(GL,0); GAPB(o[0]=__builtin_amdgcn_mfma_f32_32x32x16_bf16(PAF(1),VFR(1),o[0],0,0,0), C0,8); \
    KRD(GL,1); GAPB(o[1]=__builtin_amdgcn_mfma_f32_32x32x16_bf16(PAF(1),VFR(5),o[1],0,0,0), C0,12); \
    KRD(GL,2); GAPB(o[0]=__builtin_amdgcn_mfma_f32_32x32x16_bf16(PAF(2),VFR(2),o[0],0,0,0), C1,0); \
    KRD(GL,3); GAPB(o[1]=__builtin_amdgcn_mfma_f32_32x32x16_bf16(PAF(2),VFR(6),o[1],0,0,0), C1,4); \
    GAPB(o[0]=__builtin_amdgcn_mfma_f32_32x32x16_bf16(PAF(3),VFR(3),o[0],0,0,0), C1,8); \
    GAPB(o[1]=__builtin_amdgcn_mfma_f32_32x32x16_bf16(PAF(3),VFR(7),o[1],0,0,0), C1,12); \
    }while(0)
  int t=1;
  #define ENDW(tt) do{ if((tt)+3<NT){WAIT_BAR(2);} else if((tt)+2<NT){WAIT_BAR(1);} else {WAIT_BAR(0);} }while(0)
  for(;t<5&&t+1<NT;t+=2){
    STEP(pB0,pB1,pA0,pA1,t,(t+3<NT),(t+1<NT),(t+1<NT));       ENDW(t);   RESC(); ROT();
    STEP(pA0,pA1,pB0,pB1,t+1,(t+4<NT),(t+2<NT),(t+2<NT));     ENDW(t+1); RESC(); ROT();
  }
  #undef CMASK
  #define CMASK(P0,P1,t) do{}while(0)
  for(;t+5<NT;t+=2){
    STEP(pB0,pB1,pA0,pA1,t,true,true,true);     WAIT_BAR(2); RESC(); ROT();
    STEP(pA0,pA1,pB0,pB1,t+1,true,true,true);   WAIT_BAR(2); RESC(); ROT();
  }
  for(;t+1<NT;t+=2){
    STEP(pB0,pB1,pA0,pA1,t,(t+3<NT),(t+1<NT),(t+1<NT));       ENDW(t);   RESC(); ROT();
    STEP(pA0,pA1,pB0,pB1,t+1,(t+4<NT),(t+2<NT),(t+2<NT));     ENDW(t+1); RESC(); ROT();
  }
  #undef CMASK
  #define CMASK(P0,P1,t) do{ if((t)<4)cmask(P0,P1,(t),qrel,hi);}while(0)
  STEP(pB0,pB1,pA0,pA1,NT-1,false,false,false); RESC();
  { float sacc=pB0[0]+pB0[1]; _Pragma("unroll") for(int r=2;r<16;++r)sacc+=pB0[r]; _Pragma("unroll") for(int r=0;r<16;++r)sacc+=pB1[r]; l_reg+=sacc;
    pw0=(u32x4){PKW(pB0,0),PKW(pB0,2),PKW(pB0,4),PKW(pB0,6)};pw1=(u32x4){PKW(pB0,8),PKW(pB0,10),PKW(pB0,12),PKW(pB0,14)};pw2=(u32x4){PKW(pB1,0),PKW(pB1,2),PKW(pB1,4),PKW(pB1,6)};pw3=(u32x4){PKW(pB1,8),PKW(pB1,10),PKW(pB1,12),PKW(pB1,14)};
    SBAR(); pv(o,vb0+sl_cur,PAF(0),PAF(1),PAF(2),PAF(3)); }
  #undef PKW
  #undef PAF
  #undef VFR
  #undef PIN
  #undef MX3
  #undef GAPA
  #undef GAPB
  #undef EX
  #undef VRD
  #undef KRD
  #undef STEP
  #undef ENDW
  {auto rr=__builtin_amdgcn_permlane32_swap(__float_as_uint(l_reg),__float_as_uint(l_reg),false,false);l_reg=__uint_as_float(rr[0])+__uint_as_float(rr[1]);}
  if(hi==0)wsf[32+r32]=l_reg;asm volatile("s_waitcnt lgkmcnt(0)":::"memory");
  float rli[16];
  #pragma unroll
  for(int r=0;r<16;++r)rli[r]=__builtin_amdgcn_rcpf(wsf[32+crow(r,hi)]);
  bf16*Ow=O+(rowbase+q0+wid*QBLK)*OPITCH+h*D; const __amdgpu_buffer_rsrc_t orsrc_=__builtin_amdgcn_make_buffer_rsrc((void*)O,0,0x7fffffff,0x00020000);
  { bf16*stg=(bf16*)(shm+LDS_OST)+wid*2048;
    #pragma unroll
    for(int r=0;r<16;++r){const int orow=crow(r,hi);
      #pragma unroll
      for(int d0=0;d0<2;++d0)stg[orow*64+d0*32+r32]=__float2bfloat16(o[d0][r]*rli[r]);}
    asm volatile("s_waitcnt lgkmcnt(0)":::"memory");
    #pragma unroll
    for(int i=0;i<4;++i){const int row=i*8+(lane>>3),ch=lane&7; const u32x4 v=*(const u32x4*)(stg+row*64+ch*8); ATTN_STORE16(Ow+(long)row*OPITCH+ch*8,v);} }
  asm volatile("s_waitcnt lgkmcnt(0)\n\ts_barrier":::"memory");
  #undef DMA_K
  #undef DMA_V
  #undef POS
  #undef CINIT
  #undef CMASK
  #undef START
  #undef RESC
  #undef ROT
}
constexpr int ATTN_LDS_BYTES=LDS_BYTES;
struct AttnTensors { const bf16* Q; const bf16* K; const bf16* V; bf16* O; const float* kmean; };
struct AttnUnit { int bh; int qb; };
struct StaticOrder {
  int vcu,grid;
  __device__ __forceinline__ explicit StaticOrder(int grid_,int block):vcu((grid_%8==0)?((block%8)*(grid_/8)+block/8):block),grid(grid_){}
  __device__ __forceinline__ bool next(int i,AttnUnit&u)const{ const int item=(i>>1)*grid+vcu; if(item>=BATCH*NHEAD*8)return false; const int s=item&7; u.bh=item>>3; u.qb=(i&1)?15-s:s; return true; }
  __device__ __forceinline__ void a_ready(const AttnUnit&)const{}
  __device__ __forceinline__ void done(const AttnUnit&)const{}
};
template<class Sched,int THRL=8> __device__ __forceinline__ void attn_phase(char*lds,const AttnTensors&T,const Sched&S){
  AttnUnit u;
  for(int i=0;S.next(i,u);++i){ S.a_ready(u); attn_unit<THRL>(u.bh/NHEAD,u.bh%NHEAD,u.qb,T.Q,T.K,T.V,T.O,T.kmean,lds); S.done(u); }
}
#undef SBAR
#undef WAIT_BAR
}

constexpr int NWAVES = 8;
#ifndef MK_N_LAUNCHES
#define MK_N_LAUNCHES 1
#endif
constexpr int N_LAUNCHES = MK_N_LAUNCHES;
constexpr int PER_PHASE = 8;

constexpr int BATCH = 8, SEQ = 4096, DM = 1024, TOK = BATCH * SEQ;
constexpr int CONV_CH = 512, CONV_W = 31, ATT_W = 512, IN_COLS = 4608;
constexpr int P_HEADS = 8, P_NK = 128, P_TOPK = 16, P_E = P_HEADS * P_TOPK  , N_EXP = P_NK * P_NK;
constexpr float NORM_EPS = 1e-6f;

constexpr size_t MiB = 1u << 20;
constexpr size_t WS_CTL = 0, CTL_ZERO_BYTES = 65536;
constexpr size_t WS_KMEAN = 1 * MiB;
constexpr size_t WS_SS = 2 * MiB;
constexpr size_t WS_WIN = 4 * MiB;
constexpr size_t WS_WPW = 13 * MiB, WS_WAO = 14 * MiB;
constexpr size_t WS_WOUT = 15 * MiB;
constexpr size_t WS_WQ = 17 * MiB;
constexpr size_t WS_KEYS = 21 * MiB;
constexpr size_t WS_USC = 22 * MiB, WS_VSC = 22 * MiB + 65536;
constexpr size_t WS_UB = 24 * MiB, WS_VB = 56 * MiB;
constexpr size_t WS_H = 88 * MiB;
constexpr size_t WS_CACT = 88 * MiB;
constexpr size_t WS_EIDX = 104 * MiB, WS_GW = 120 * MiB, WS_GA = 136 * MiB;
constexpr size_t WS_ZGLU = 152 * MiB, WS_QO = 184 * MiB, WS_K = 216 * MiB, WS_V = 248 * MiB;
constexpr size_t WS_MIX = 216 * MiB;
constexpr size_t WS_QP = 152 * MiB;
constexpr size_t WS_COEF = 152 * MiB, WS_SS2 = 168 * MiB;
constexpr size_t WS_GC = 280 * MiB, WS_GATE_A = 344 * MiB;
constexpr size_t WS_X1B = 280 * MiB;
constexpr size_t WS_X8 = 344 * MiB, WS_XS = 377 * MiB;
constexpr size_t WS_END = 408 * MiB;
constexpr int CW_TMO = 0, CW_CODE = 1, CW_CONVQ = 64, CW_BAR = 4096;

constexpr int RING_OFF = 0, RING_BYTES = 131072;
constexpr int LDSCTL_OFF = RING_BYTES, MISC_OFF = LDSCTL_OFF + 320;
constexpr int LDS_BYTES = 155648;
constexpr int VT_PITCH = 144, VT_BYTES = 128 * VT_PITCH, VT_LAST_OFF = LDSCTL_OFF + 1024, P7_CNT_OFF = LDSCTL_OFF + 512;
static_assert(7 * VT_BYTES <= RING_BYTES && VT_LAST_OFF + VT_BYTES <= LDS_BYTES && MISC_OFF + 128 <= P7_CNT_OFF, "PEER v tiles");
constexpr float C8_SCALE = 4096.f;
static_assert(MISC_OFF + 128 <= LDS_BYTES, "LDS map");

#define GAS __attribute__((address_space(1)))
#define LAS __attribute__((address_space(3)))
typedef unsigned short bf16;
typedef unsigned v4u __attribute__((ext_vector_type(4)));
typedef float f32x4 __attribute__((ext_vector_type(4)));
typedef float f32x16 __attribute__((ext_vector_type(16)));
typedef short bf16x8 __attribute__((ext_vector_type(8)));
typedef __bf16 bf16x2_t __attribute__((ext_vector_type(2)));
typedef GAS unsigned gu32;
#define RLX_AGENT __ATOMIC_RELAXED, __HIP_MEMORY_SCOPE_AGENT
#define LDS_WAIT() asm volatile("s_waitcnt lgkmcnt(0)" ::: "memory")
#define VM_WAIT() asm volatile("s_waitcnt vmcnt(0)" ::: "memory")
__device__ __forceinline__ unsigned f2bf(float f) { unsigned u = __builtin_bit_cast(unsigned, f); return (u + 0x7fffu + ((u >> 16) & 1u)) >> 16; }
__device__ __forceinline__ unsigned pk2(float lo, float hi) { return f2bf(lo) | (f2bf(hi) << 16); }
__device__ __forceinline__ float bflo(unsigned u) { return __uint_as_float(u << 16); }
__device__ __forceinline__ float bfhi(unsigned u) { return __uint_as_float(u & 0xffff0000u); }

#define XB_TMO      128
#define XB_XCNT(j)  (256  + 64 * (j))
#define XB_XSUB(j)  (1280 + 64 * (j))
#define XB_XGEN(j)  (2304 + 64 * (j))
#define XB_TOP      3328
#define XB_TOPGEN   3392
#define XCD_BAR_WORDS 3456
#define XB_SPIN_CAP (1u << 18)

__device__ __forceinline__ unsigned xb_ld(unsigned* p)              { return __hip_atomic_load(p, __ATOMIC_RELAXED, __HIP_MEMORY_SCOPE_AGENT); }
__device__ __forceinline__ unsigned xb_add(unsigned* p, unsigned v) { return __hip_atomic_fetch_add(p, v, __ATOMIC_RELAXED, __HIP_MEMORY_SCOPE_AGENT); }
__device__ __forceinline__ unsigned xb_xcc_id() { return (unsigned)__builtin_amdgcn_s_getreg((3 << 11) | 20) & 0xFu; }
#define XB_SPIN(cond, bar) do { unsigned _sp = 0; while (cond) { __builtin_amdgcn_s_sleep(1); \
    if ((++_sp & 255u) == 0u) { if (xb_ld(&(bar)[XB_TMO])) break; if (_sp > XB_SPIN_CAP) { atomicAdd(&(bar)[XB_TMO], 1u); break; } } } } while (0)

struct XcdBarrier {
    unsigned* bar; unsigned x;
    volatile LAS unsigned* st;
};

__device__ __forceinline__ XcdBarrier xcd_barrier_post(unsigned* bar, volatile LAS unsigned* st) {
    XcdBarrier b; b.bar = bar; b.x = xb_xcc_id(); b.st = st;
    if (threadIdx.x == 0) (void)xb_add(&bar[XB_XCNT(b.x)], 1u);
    return b;
}
__device__ __forceinline__ void xcd_barrier_complete(unsigned* bar, unsigned x, unsigned& nloc, unsigned& nx) {
    const unsigned G = gridDim.x * gridDim.y * gridDim.z;
    unsigned sum, cnt, mine, sp = 0u;
    for (;;) {
        sum = 0u; cnt = 0u; mine = 0u;
#pragma unroll
        for (unsigned j = 0; j < 16; ++j) { const unsigned c = xb_ld(&bar[XB_XCNT(j)]); sum += c; cnt += (c > 0u) ? 1u : 0u; mine = (j == x) ? c : mine; }
        if (sum == G) break;
        __builtin_amdgcn_s_sleep(1);
        if ((++sp & 255u) == 0u) { if (xb_ld(&bar[XB_TMO])) break; if (sp > XB_SPIN_CAP) { atomicAdd(&bar[XB_TMO], 1u); break; } }
    }
    nloc = mine > 0u ? mine : 1u; nx = cnt > 0u ? cnt : 1u;
}

__device__ __forceinline__ void xcd_barrier(const XcdBarrier& b) {
    asm volatile("s_waitcnt vmcnt(0)" ::: "memory");
    __syncthreads();
    if (threadIdx.x == 0) {
        unsigned* bar = b.bar;
        __builtin_amdgcn_s_waitcnt(0);
        unsigned nloc = b.st[0], nx = b.st[1];
        if (nloc == 0u) { xcd_barrier_complete(bar, b.x, nloc, nx); b.st[0] = nloc; b.st[1] = nx; }
        const unsigned old = xb_add(&bar[XB_XSUB(b.x)], 1u);
        const unsigned gen = old / nloc;
        if (old + 1u == (gen + 1u) * nloc) {
            __builtin_amdgcn_fence(__ATOMIC_RELEASE, "agent");
            asm volatile("s_waitcnt vmcnt(0)" ::: "memory");
            const unsigned og = xb_add(&bar[XB_TOP], 1u);
            const unsigned tg = og / nx;
            if (og + 1u == (tg + 1u) * nx) xb_add(&bar[XB_TOPGEN], 1u);
            else XB_SPIN(xb_ld(&bar[XB_TOPGEN]) == tg, bar);
            __builtin_amdgcn_fence(__ATOMIC_ACQUIRE, "agent");
            xb_add(&bar[XB_XGEN(b.x)], 1u);
            asm volatile("s_waitcnt vmcnt(0)" ::: "memory");
        } else {
            XB_SPIN(xb_ld(&bar[XB_XGEN(b.x)]) == gen, bar);
            __builtin_amdgcn_fence(__ATOMIC_ACQUIRE, "agent");
            asm volatile("s_waitcnt vmcnt(0)" ::: "memory");
        }
    }
    __syncthreads();
}

struct Frame {
    LAS unsigned char* lds;
    volatile LAS unsigned* MISC;
    gu32* ctl;
    int tid, lane, wave;
    int vcu, G;
};
__device__ __forceinline__ float wave_sum(float v) {
#pragma unroll
    for (int o = 1; o < 64; o <<= 1) v += __shfl_xor(v, o);
    return v;
}

__device__ __forceinline__ float wave_sum_hi(float v) {
    v += __builtin_bit_cast(float, __builtin_amdgcn_update_dpp(0, __builtin_bit_cast(int, v), 0xB1, 0xf, 0xf, false));
    v += __builtin_bit_cast(float, __builtin_amdgcn_update_dpp(0, __builtin_bit_cast(int, v), 0x4E, 0xf, 0xf, false));
    v += __builtin_bit_cast(float, __builtin_amdgcn_update_dpp(0, __builtin_bit_cast(int, v), 0x141, 0xf, 0xf, false));
    v += __builtin_bit_cast(float, __builtin_amdgcn_update_dpp(0, __builtin_bit_cast(int, v), 0x140, 0xf, 0xf, false));
    v += __builtin_bit_cast(float, __builtin_amdgcn_update_dpp(0, __builtin_bit_cast(int, v), 0x142, 0xA, 0xF, false));
    v += __builtin_bit_cast(float, __builtin_amdgcn_update_dpp(0, __builtin_bit_cast(int, v), 0x143, 0xC, 0xF, false));
    return v;
}

__device__ __forceinline__ void p0_transpose_item(const float* W, int K, int N, bf16* WT, int k0, int n0, int dst_row0, const float* kscale, LAS float* scr, int lane, int dpitch = 0, int koff = 0) {
    if (dpitch == 0) dpitch = K;
#pragma unroll 8
    for (int i = 0; i < 32; ++i) { const int kk = 2 * i + (lane >> 5); float v = W[(size_t)(k0 + kk) * N + n0 + (lane & 31)]; if (kscale) v *= kscale[k0 + kk]; scr[kk * 33 + (lane & 31)] = v; }
    LDS_WAIT(); asm volatile("" ::: "memory");
    const int c = lane & 7;
#pragma unroll
    for (int j = 0; j < 4; ++j) { const int n = (lane >> 3) + 8 * j; const LAS float* s = scr + (8 * c) * 33 + n;
        v4u o; o.x = pk2(s[0 * 33], s[1 * 33]); o.y = pk2(s[2 * 33], s[3 * 33]); o.z = pk2(s[4 * 33], s[5 * 33]); o.w = pk2(s[6 * 33], s[7 * 33]);
        *(GAS v4u*)(WT + (size_t)(dst_row0 + n) * dpitch + koff + k0 + 8 * c) = o; }
    LDS_WAIT(); asm volatile("" ::: "memory");
}
__device__ __forceinline__ int perm_in(int s) { if (s < 512) return 256 * (s >> 7) + (s & 127); if (s < 1024) { const int s2 = s - 512; return 256 * (s2 >> 7) + 128 + (s2 & 127); } return s; }
__device__ __forceinline__ float wave_max(float v) {
#pragma unroll
    for (int o = 1; o < 64; o <<= 1) v = fmaxf(v, __shfl_xor(v, o));
    return v;
}
template <bool NORM, int NR> __device__ __forceinline__ void rows_to_bf16(int lane, const float* xrow, size_t rstride, const float* g, bf16* orow) {
    f32x4 v[NR][4]; float s2[NR];
#pragma unroll
    for (int q = 0; q < NR; ++q) { const GAS f32x4* xr = (const GAS f32x4*)(xrow + q * rstride) + lane;
#pragma unroll
        for (int j = 0; j < 4; ++j) v[q][j] = xr[64 * j]; }
#pragma unroll
    for (int q = 0; q < NR; ++q) { s2[q] = 0.f;
#pragma unroll
        for (int j = 0; j < 4; ++j) s2[q] += (v[q][j].x * v[q][j].x + v[q][j].y * v[q][j].y) + (v[q][j].z * v[q][j].z + v[q][j].w * v[q][j].w); }
    float rstd[NR];
#pragma unroll
    for (int q = 0; q < NR; ++q) rstd[q] = NORM ? 1.f / sqrtf(wave_sum(s2[q]) * (1.f / 1024.f) + NORM_EPS) : 1.f;
#pragma unroll
    for (int j = 0; j < 4; ++j) { f32x4 gv = (f32x4){1.f, 1.f, 1.f, 1.f}; if (g) gv = *((const GAS f32x4*)g + lane + 64 * j);
#pragma unroll
        for (int q = 0; q < NR; ++q) { const f32x4 w = v[q][j] * rstd[q] * gv;
            ((GAS unsigned long long*)(orow + q * rstride) + lane)[64 * j] = (unsigned long long)pk2(w.x, w.y) | ((unsigned long long)pk2(w.z, w.w) << 32); } }
}
template <bool NORM> __device__ __forceinline__ void row_to_bf16(int lane, const float* xrow, const float* g, bf16* orow) { rows_to_bf16<NORM, 1>(lane, xrow, 1024, g, orow); }
template <bool SLICED> __device__ __forceinline__ void row_to_fp8(int lane, const float* xrow, const float* g, unsigned char* base, int row, float* isc) {
    const GAS f32x4* xr = (const GAS f32x4*)xrow + lane;
    f32x4 v[4]; float am = 0.f;
#pragma unroll
    for (int j = 0; j < 4; ++j) { v[j] = xr[64 * j]; if (g) v[j] = v[j] * *((const GAS f32x4*)g + lane + 64 * j);
        am = fmaxf(am, fmaxf(fmaxf(fabsf(v[j].x), fabsf(v[j].y)), fmaxf(fabsf(v[j].z), fabsf(v[j].w)))); }
#pragma unroll
    for (int o = 1; o < 64; o <<= 1) am = fmaxf(am, __shfl_xor(am, o));
    const float sc = am > 0.f ? 240.f / am : 1.f;
    if (lane == 0) isc[row] = am > 0.f ? am * (1.f / 240.f) : 1.f;
#pragma unroll
    for (int j = 0; j < 4; ++j) { int w = 0; w = __builtin_amdgcn_cvt_pk_fp8_f32(v[j].x * sc, v[j].y * sc, w, false); w = __builtin_amdgcn_cvt_pk_fp8_f32(v[j].z * sc, v[j].w * sc, w, true);
        if (SLICED) *(GAS int*)(base + (size_t)(2 * j + (lane >> 5)) * ((size_t)N_EXP * 128) + (size_t)row * 128 + 4 * (lane & 31)) = w;
        else *(GAS int*)(base + (size_t)row * 1024 + 4 * (lane + 64 * j)) = w; }
}
__device__ __forceinline__ void rows_to_fp8_uv(int lane, const float* urow, const float* vrow, const float* g, unsigned char* ub8, unsigned char* vb8, int row, float* usc, float* vsc) {
    f32x4 u[4], v[4]; float au = 0.f, av = 0.f;
#pragma unroll
    for (int j = 0; j < 4; ++j) { u[j] = ((const GAS f32x4*)urow + lane)[64 * j]; v[j] = ((const GAS f32x4*)vrow + lane)[64 * j]; }
#pragma unroll
    for (int j = 0; j < 4; ++j) { u[j] = u[j] * *((const GAS f32x4*)g + lane + 64 * j);
        au = fmaxf(au, fmaxf(fmaxf(fabsf(u[j].x), fabsf(u[j].y)), fmaxf(fabsf(u[j].z), fabsf(u[j].w))));
        av = fmaxf(av, fmaxf(fmaxf(fabsf(v[j].x), fabsf(v[j].y)), fmaxf(fabsf(v[j].z), fabsf(v[j].w)))); }
#pragma unroll
    for (int o = 1; o < 64; o <<= 1) { au = fmaxf(au, __shfl_xor(au, o)); av = fmaxf(av, __shfl_xor(av, o)); }
    const float su = au > 0.f ? 6.f / au : 1.f, sv = av > 0.f ? 6.f / av : 1.f;
    if (lane == 0) { usc[row] = au > 0.f ? au * (1.f / 6.f) : 1.f; vsc[row] = av > 0.f ? av * (1.f / 6.f) : 1.f; }
#pragma unroll
    for (int j = 0; j < 4; ++j) {
        { unsigned pk = 0;
          pk = __builtin_amdgcn_cvt_scalef32_pk_fp4_f32(pk, u[j].x * su, u[j].y * su, 1.0f, 0); pk = __builtin_amdgcn_cvt_scalef32_pk_fp4_f32(pk, u[j].z * su, u[j].w * su, 1.0f, 1);
          *(GAS unsigned short*)(ub8 + (size_t)row * 512 + 2 * (lane + 64 * j)) = (unsigned short)pk; }
        { unsigned pk = 0;
          pk = __builtin_amdgcn_cvt_scalef32_pk_fp4_f32(pk, v[j].x * sv, v[j].y * sv, 1.0f, 0); pk = __builtin_amdgcn_cvt_scalef32_pk_fp4_f32(pk, v[j].z * sv, v[j].w * sv, 1.0f, 1);
          const int c = 4 * lane + 256 * j;
          *(GAS unsigned short*)(vb8 + (size_t)(c >> 8) * ((size_t)N_EXP * 128) + (size_t)row * 128 + ((c & 255) >> 1)) = (unsigned short)pk; } }
}
struct P0Args { const float *x, *g1, *w_in, *w_pw, *w_ao, *w_out, *g2, *w_q, *k1, *k2, *pu, *pv; bf16 *H, *Win, *Wpw, *Wao, *Wout, *Wq, *keys; unsigned char *ub8, *vb8; float *usc, *vsc; };
__device__ __forceinline__ void p0_prologue(Frame& F, const P0Args& a) {
    LAS float* scr = (LAS float*)(F.lds + RING_OFF + F.wave * 16384);
    const int gw = F.vcu * NWAVES + F.wave, NGW = F.G * NWAVES;
    constexpr int I_IN = 16 * (IN_COLS / 32), I_PW = 8 * 32, I_AO = 8 * 32, I_OUT = 16 * 32, I_Q = 16 * 64;
    constexpr int NITEMS = I_IN + I_PW + I_AO + I_OUT + I_Q;
    for (int it = gw; it < NITEMS; it += NGW) {
        int r = it;
        if (r < I_IN) { const int nb = IN_COLS / 32, kb = r / nb, n0 = 32 * (r % nb); p0_transpose_item(a.w_in, 1024, IN_COLS, a.Win, 64 * kb, n0, perm_in(n0), nullptr, scr, F.lane); continue; } r -= I_IN;
        if (r < I_PW) { const int kb = r / 32, n0 = 32 * (r % 32); p0_transpose_item(a.w_pw, 512, 1024, a.Wpw, 64 * kb, n0, n0, nullptr, scr, F.lane, 1024, 0); continue; } r -= I_PW;
        if (r < I_AO) { const int kb = r / 32, n0 = 32 * (r % 32); p0_transpose_item(a.w_ao, 512, 1024, a.Wpw, 64 * kb, n0, n0, nullptr, scr, F.lane, 1024, 512); continue; }   r -= I_AO;
        if (r < I_OUT) { const int kb = r / 32, n0 = 32 * (r % 32); p0_transpose_item(a.w_out, 1024, 1024, a.Wout, 64 * kb, n0, n0, nullptr, scr, F.lane); continue; } r -= I_OUT;
        { const int kb = r / 64, n0 = 32 * (r % 64); p0_transpose_item(a.w_q, 1024, 2048, a.Wq, 64 * kb, n0, n0, a.g2, scr, F.lane); }
    }
    for (int m = 4 * gw; m < TOK; m += 4 * NGW) rows_to_bf16<true, 4>(F.lane, a.x + (size_t)m * 1024, 1024, a.g1, a.H + (size_t)m * 1024);
    for (int m = gw; m < N_EXP; m += NGW) rows_to_fp8_uv(F.lane, a.pu + (size_t)m * 1024, a.pv + (size_t)m * 1024, a.g2, a.ub8, a.vb8, m, a.usc, a.vsc);
    for (int m = gw; m < 32; m += NGW) { const float* src = (m < 16 ? a.k1 : a.k2) + (size_t)(m & 15) * 1024; row_to_bf16<false>(F.lane, src, nullptr, a.keys + (size_t)m * 1024); }
}

struct ConvArgs { const bf16* zglu; const float *cw, *cb, *lg, *lb; bf16* cact; };
__device__ __forceinline__ void conv_phase(Frame& F, const ConvArgs& a) {
    LAS unsigned char* zs = F.lds + RING_OFF;
    LAS float* part = (LAS float*)(F.lds + RING_OFF + 98304);
    int tid_ = F.tid; asm volatile("" : "+v"(tid_));
    const int cp = tid_ & 255, half = tid_ >> 8, c0 = 2 * cp;
    float w0[CONV_W], w1[CONV_W];
    { const GAS float* p = (const GAS float*)(a.cw + c0);
#pragma unroll
      for (int w = 0; w < CONV_W; ++w) { w0[w] = p[0]; w1[w] = p[1]; p += 512; asm volatile("" : "+v"(p)); } }
    const float b0 = a.cb[c0], b1 = a.cb[c0 + 1], lg0 = a.lg[c0], lg1 = a.lg[c0 + 1], lb0 = a.lb[c0], lb1 = a.lb[c0 + 1];
    for (int tile = F.vcu; tile < TOK / 64; tile += F.G) {
        const int t0 = tile * 64, tb = t0 & (SEQ - 1);
#pragma unroll
        for (int hb = 0; hb < 2; ++hb) { v4u zv[6];
#pragma unroll
          for (int q = 0; q < 6; ++q) { const int i = tid_ + 512 * (6 * hb + q), r = i >> 6, ch = i & 63; zv[q] = (v4u){0u, 0u, 0u, 0u};
              if (i < 94 * 64 && tb - 30 + r >= 0) zv[q] = *(const GAS v4u*)(a.zglu + (size_t)(t0 - 30 + r) * 512 + ch * 8); }
#pragma unroll
          for (int q = 0; q < 6; ++q) { const int i = tid_ + 512 * (6 * hb + q), r = i >> 6, ch = i & 63; if (i < 94 * 64) *(LAS v4u*)(zs + r * 1024 + ch * 16) = zv[q]; } }
        __syncthreads();
        for (int ch8 = 0; ch8 < 4; ++ch8) {
            const int tl = half * 32 + ch8 * 8;
            float z0[38], z1[38];
#pragma unroll
            for (int i = 0; i < 38; ++i) { const unsigned u = *(const LAS unsigned*)(zs + (tl + i) * 1024 + cp * 4); z0[i] = bflo(u); z1[i] = bfhi(u); }
            float a0[8], a1[8];
#pragma unroll
            for (int k = 0; k < 8; ++k) { float s0 = b0, s1 = b1;
#pragma unroll
                for (int w = 0; w < CONV_W; ++w) { s0 += w0[w] * z0[k + w]; s1 += w1[w] * z1[k + w]; }
                a0[k] = s0; a1[k] = s1; }
#pragma unroll
            for (int k = 0; k < 8; ++k) { const float s1 = wave_sum_hi(a0[k] + a1[k]), s2 = wave_sum_hi(a0[k] * a0[k] + a1[k] * a1[k]);
                if (F.lane == 63) { part[((half * 8 + k) * 4 + (F.wave & 3)) * 2] = s1; part[((half * 8 + k) * 4 + (F.wave & 3)) * 2 + 1] = s2; } }
            __syncthreads();
            bf16* op = a.cact + (size_t)(t0 + tl) * 1024 + c0;
#pragma unroll
            for (int k = 0; k < 8; ++k) { const LAS float* p = part + (half * 8 + k) * 8;
                const float S1 = (p[0] + p[2]) + (p[4] + p[6]), S2 = (p[1] + p[3]) + (p[5] + p[7]);
                const float mean = S1 * (1.f / 512.f), var = S2 * (1.f / 512.f) - mean * mean, rstd = __builtin_amdgcn_rsqf(var + NORM_EPS);
                const float y0 = (a0[k] - mean) * rstd * lg0 + lb0, y1 = (a1[k] - mean) * rstd * lg1 + lb1;
                const float o0 = y0 * __builtin_amdgcn_rcpf(1.f + __builtin_amdgcn_exp2f(-1.4426950408889634f * y0)), o1 = y1 * __builtin_amdgcn_rcpf(1.f + __builtin_amdgcn_exp2f(-1.4426950408889634f * y1));
                *(GAS unsigned*)(op + k * 1024) = pk2(o0, o1); }
            __syncthreads();
        }
    }
}

__device__ __forceinline__ int tokey(float v) { const int b = __float_as_int(v); return b ^ ((b >> 31) & 0x7fffffff); }
__device__ __forceinline__ float unkey(int k, int mask) { const int t = k & ~mask; return __int_as_float(t ^ ((t >> 31) & 0x7fffffff)); }
__device__ __forceinline__ void ce_desc(int& a, int& b) { const int hi = a > b ? a : b, lo = a > b ? b : a; a = hi; b = lo; }
template <int N> __device__ __forceinline__ void sort_desc(int (&v)[N]) {
#pragma unroll
    for (int k = 2; k <= N; k <<= 1)
#pragma unroll
        for (int j = k >> 1; j > 0; j >>= 1)
#pragma unroll
            for (int i = 0; i < N; ++i) { const int l = i ^ j; if (l > i) { if ((i & k) == 0) ce_desc(v[i], v[l]); else ce_desc(v[l], v[i]); } }
}
__device__ __forceinline__ void bitonic_merge16_desc(int (&v)[16]) {
#pragma unroll
    for (int j = 8; j > 0; j >>= 1)
#pragma unroll
        for (int i = 0; i < 16; ++i) { const int l = i ^ j; if (l > i) ce_desc(v[i], v[l]); }
}
__device__ __forceinline__ void merge_top16(int (&a)[16], const int (&b)[16]) {
#pragma unroll
    for (int i = 0; i < 16; ++i) a[i] = a[i] > b[15 - i] ? a[i] : b[15 - i];
    bitonic_merge16_desc(a);
}
__device__ __forceinline__ void top16_of_64(const int (&x)[64], int (&out)[16]) {
    int g[16];
#pragma unroll
    for (int i = 0; i < 16; ++i) out[i] = x[i];
    sort_desc<16>(out);
#pragma unroll
    for (int q = 1; q < 4; ++q) {
#pragma unroll
        for (int i = 0; i < 16; ++i) g[i] = x[16 * q + i];
        sort_desc<16>(g); merge_top16(out, g); }
}
__device__ __forceinline__ int crow_(int r, int hi) { return (r & 3) + 8 * (r >> 2) + 4 * hi; }
struct SelArgs { const bf16* qp; const bf16* keys; const float* ss; const float* usc; const float* vsc; int* eidx; float* ga; float* gb; const bf16* x1b; unsigned char* x8; float* xs; };
__device__ __forceinline__ void peer_select_phase(Frame& F, const SelArgs& a) {
    for (int i = F.tid; i < 2 * 128 * 16; i += 512) { const int which = i >> 11, rem = i & 2047, row = rem >> 4, ch = rem & 15;
        const v4u v = *(const GAS v4u*)(a.keys + (size_t)which * 16384 + row * 128 + ch * 8);
        *(LAS v4u*)(F.lds + RING_OFF + which * 32768 + row * 256 + ((ch ^ (row & 15)) << 4)) = v; }
    __syncthreads();
    LAS int* scr = (LAS int*)(F.lds + RING_OFF + 65536 + F.wave * 4096);
    const int lane = F.lane, tl = lane & 31, hi = lane >> 5;
    const int gw = F.vcu * NWAVES + F.wave, NGW = F.G * NWAVES;
    constexpr int NUNITS = (TOK / 32) * P_HEADS;
    constexpr int PA[50] = {0,0,0,0,0,0,0,0,0,0,0,0,0,0,0,0, 1,1,1,1,1,1,1,1, 2,2,2,2,2, 3,3,3,3, 4,4,4, 5,5, 6,6, 7,7, 8,9,10,11,12,13,14,15};
    constexpr int PB[50] = {0,1,2,3,4,5,6,7,8,9,10,11,12,13,14,15, 0,1,2,3,4,5,6,7, 0,1,2,3,4, 0,1,2,3, 0,1,2, 0,1, 0,1, 0,1, 0,0,0,0,0,0,0,0};
    for (int unit = gw; unit < NUNITS; unit += NGW) {
        const int tt = unit >> 3, hh = unit & 7, t = tt * 32 + tl;
        int vk[2][16];
#pragma unroll
        for (int half = 0; half < 2; ++half) {
            const bf16* qrow = a.qp + (size_t)t * 2048 + hh * 256 + half * 128 + hi * 8;
            bf16x8 bq[8];
#pragma unroll
            for (int ks = 0; ks < 8; ++ks) bq[ks] = *(const GAS bf16x8*)(qrow + ks * 16);
            f32x16 acc[4];
#pragma unroll
            for (int nb = 0; nb < 4; ++nb) { acc[nb] = (f32x16){};
#pragma unroll
                for (int ks = 0; ks < 8; ++ks) { const int row = nb * 32 + tl, ch = 2 * ks + hi;
                    const bf16x8 ka = *(const LAS bf16x8*)(F.lds + RING_OFF + half * 32768 + row * 256 + ((ch ^ (row & 15)) << 4));
                    acc[nb] = __builtin_amdgcn_mfma_f32_32x32x16_bf16(ka, bq[ks], acc[nb], 0, 0, 0); } }
            int keys[64];
#pragma unroll
            for (int nb = 0; nb < 4; ++nb)
#pragma unroll
                for (int r = 0; r < 16; ++r) keys[nb * 16 + r] = (tokey(acc[nb][r]) & ~127) | (nb * 32 + crow_(r, hi));
            int top[16]; top16_of_64(keys, top);
            int oth[16];
#pragma unroll
            for (int i = 0; i < 16; ++i) oth[i] = __shfl_xor(top[i], 32);
            merge_top16(top, oth);
#pragma unroll
            for (int i = 0; i < 16; ++i) vk[half][i] = top[i];
        }
        float f1[16], f2[16];
#pragma unroll
        for (int i = 0; i < 16; ++i) { f1[i] = unkey(vk[0][i], 127); f2[i] = unkey(vk[1][i], 127); }
        int ck[64];
#pragma unroll
        for (int i = 0; i < 50; ++i) ck[i] = (tokey(f1[PA[i]] + f2[PB[i]]) & ~255) | (PA[i] * 16 + PB[i]);
#pragma unroll
        for (int i = 50; i < 64; ++i) ck[i] = (int)0x80000000;
        int c[16]; top16_of_64(ck, c);
        if (hi == 0) {
#pragma unroll
            for (int i = 0; i < 16; ++i) { scr[tl * 32 + i] = vk[0][i] & 127; scr[tl * 32 + 16 + i] = vk[1][i] & 127; } }
        float ssum = 0.f;
        { const GAS f32x4* sp = (const GAS f32x4*)(a.ss + (size_t)t * 16);
#pragma unroll
          for (int i = 0; i < 4; ++i) { const f32x4 v = sp[i]; ssum += (v.x + v.y) + (v.z + v.w); } }
        const float rstd = 1.f / sqrtf(ssum * (1.f / 1024.f) + NORM_EPS);
        const float smax = unkey(c[0], 255);
        float e[16], esum = 0.f;
#pragma unroll
        for (int i = 0; i < 16; ++i) { e[i] = __expf((unkey(c[i], 255) - smax) * rstd); esum += e[i]; }
        const float inv = 1.f / esum;
        LDS_WAIT(); asm volatile("" ::: "memory");
        int eo[8]; float go[8];
#pragma unroll
        for (int i = 0; i < 8; ++i) { const int ci = hi ? c[i + 8] : c[i]; const float ei = hi ? e[i + 8] : e[i];
            const int id = ci & 255, i1 = scr[tl * 32 + (id >> 4)], i2 = scr[tl * 32 + 16 + (id & 15)];
            eo[i] = i1 * P_NK + i2; go[i] = ei * inv; }
        float ua[8];
#pragma unroll
        for (int i = 0; i < 8; ++i) { ua[i] = a.usc[eo[i]]; go[i] *= a.vsc[eo[i]]; }
        int* ep = a.eidx + (size_t)t * P_E + hh * 16 + hi * 8; float* gp = a.gb + (size_t)t * P_E + hh * 16 + hi * 8; float* up_ = a.ga + (size_t)t * P_E + hh * 16 + hi * 8;
        *(GAS f32x4*)(up_) = (f32x4){ua[0], ua[1], ua[2], ua[3]}; *(GAS f32x4*)(up_ + 4) = (f32x4){ua[4], ua[5], ua[6], ua[7]};
        *(GAS v4u*)(ep) = (v4u){(unsigned)eo[0], (unsigned)eo[1], (unsigned)eo[2], (unsigned)eo[3]}; *(GAS v4u*)(ep + 4) = (v4u){(unsigned)eo[4], (unsigned)eo[5], (unsigned)eo[6], (unsigned)eo[7]};
        *(GAS f32x4*)(gp) = (f32x4){go[0], go[1], go[2], go[3]}; *(GAS f32x4*)(gp + 4) = (f32x4){go[4], go[5], go[6], go[7]};
        LDS_WAIT(); asm volatile("" ::: "memory");
    }
}

__device__ __forceinline__ void peer_rows_fp8(Frame& F, const SelArgs& a) {
    const int gw = F.vcu * NWAVES + F.wave, NGW = F.G * NWAVES, lane = F.lane;
    for (int t = gw; t < TOK; t += NGW) {
        const GAS v4u* xp = (const GAS v4u*)(a.x1b + (size_t)t * 1024 + 16 * lane); const v4u xa = xp[0], xb = xp[1];
        const float xf[16] = {bflo(xa.x), bfhi(xa.x), bflo(xa.y), bfhi(xa.y), bflo(xa.z), bfhi(xa.z), bflo(xa.w), bfhi(xa.w), bflo(xb.x), bfhi(xb.x), bflo(xb.y), bfhi(xb.y), bflo(xb.z), bfhi(xb.z), bflo(xb.w), bfhi(xb.w)};
        float am = 0.f;
#pragma unroll
        for (int i = 0; i < 16; ++i) am = fmaxf(am, fabsf(xf[i]));
#pragma unroll
        for (int o = 1; o < 64; o <<= 1) am = fmaxf(am, __shfl_xor(am, o));
        const float xsc = am > 0.f ? 240.f / am : 1.f, xinv = am > 0.f ? am * (1.f / 240.f) : 1.f;
        v4u o;
        { int w = 0; w = __builtin_amdgcn_cvt_pk_fp8_f32(xf[0] * xsc, xf[1] * xsc, w, false); w = __builtin_amdgcn_cvt_pk_fp8_f32(xf[2] * xsc, xf[3] * xsc, w, true); o.x = (unsigned)w; }
        { int w = 0; w = __builtin_amdgcn_cvt_pk_fp8_f32(xf[4] * xsc, xf[5] * xsc, w, false); w = __builtin_amdgcn_cvt_pk_fp8_f32(xf[6] * xsc, xf[7] * xsc, w, true); o.y = (unsigned)w; }
        { int w = 0; w = __builtin_amdgcn_cvt_pk_fp8_f32(xf[8] * xsc, xf[9] * xsc, w, false); w = __builtin_amdgcn_cvt_pk_fp8_f32(xf[10] * xsc, xf[11] * xsc, w, true); o.z = (unsigned)w; }
        { int w = 0; w = __builtin_amdgcn_cvt_pk_fp8_f32(xf[12] * xsc, xf[13] * xsc, w, false); w = __builtin_amdgcn_cvt_pk_fp8_f32(xf[14] * xsc, xf[15] * xsc, w, true); o.w = (unsigned)w; }
        *(GAS v4u*)(a.x8 + (size_t)t * 1024 + 16 * lane) = o;
        const float ssum = wave_sum(lane < 16 ? a.ss[(size_t)t * 16 + lane] : 0.f);
        if (lane == 0) a.xs[t] = xinv / sqrtf(ssum * (1.f / 1024.f) + NORM_EPS);
    }
}

typedef float f32x2_t __attribute__((ext_vector_type(2)));
struct ExpA { const unsigned char* x8; const float* xs; const unsigned char* ub8; const int* eidx; const float* ga; const float* gb; unsigned char* coef8; };
__device__ __forceinline__ float row_sum16(float v) {
    v += __builtin_bit_cast(float, __builtin_amdgcn_update_dpp(0, __builtin_bit_cast(int, v), 0xB1, 0xf, 0xf, false));
    v += __builtin_bit_cast(float, __builtin_amdgcn_update_dpp(0, __builtin_bit_cast(int, v), 0x4E, 0xf, 0xf, false));
    v += __builtin_bit_cast(float, __builtin_amdgcn_update_dpp(0, __builtin_bit_cast(int, v), 0x141, 0xf, 0xf, false));
    v += __builtin_bit_cast(float, __builtin_amdgcn_update_dpp(0, __builtin_bit_cast(int, v), 0x140, 0xf, 0xf, false));
    return v;
}
__device__ __forceinline__ float gelu_as(float v) {
    const float av = fabsf(v), t = __builtin_amdgcn_rcpf(av * 0.2316418882f + 1.0f);
    float q = t * 0.5307027145f + (-0.7265760135f); q = q * t + 0.7107068705f; q = q * t + (-0.142248368f); q = q * t + 0.127414796f; q = q * t;
    const float m = v * (q * __builtin_amdgcn_exp2f((v * v) * (-0.72134752044f)));
    return v < 0.f ? m : v - m;
}
__device__ __forceinline__ float wave_sum_diag(float v) {
    v = row_sum16(v);
    v += __builtin_bit_cast(float, __builtin_amdgcn_update_dpp(0, __builtin_bit_cast(int, v), 0x142, 0xA, 0xF, false));
    v += __builtin_bit_cast(float, __builtin_amdgcn_update_dpp(0, __builtin_bit_cast(int, v), 0x143, 0xC, 0xF, false));
    return v;
}
__device__ __forceinline__ int wg_grab(LAS int* c, const int lane) {
    int v = 0; if (lane == 0) v = __hip_atomic_fetch_add(c, 1, __ATOMIC_RELAXED, __HIP_MEMORY_SCOPE_WORKGROUP);
    return __builtin_amdgcn_readfirstlane(v);
}
typedef int v2i_t __attribute__((ext_vector_type(2)));
typedef int v8i_t __attribute__((ext_vector_type(8)));
__device__ __forceinline__ void peer_u_phase(Frame& F, const ExpA& a, const int s, const int tfirst, const int step, LAS int* cnt) {
    const int lane = F.lane, q = lane >> 4, jn = lane & 15, half = lane >> 5, c32 = lane & 31;
    if (tfirst >= TOK) return;
    constexpr int UP = 528;
    LAS unsigned char* wb = F.lds + (F.wave < 7 ? F.wave * VT_BYTES : VT_LAST_OFF);
    static_assert(16 * UP + 2 * 1024 + 2 * 1536 <= VT_BYTES, "u-side LDS");
    LAS unsigned char* twr = wb + half * UP + 16 * c32;
    LAS unsigned char* tra = wb + jn * UP + 16 * q;
    const GAS unsigned char* ubase = (const GAS unsigned char*)a.ub8; const unsigned lane16c = 16u * (unsigned)c32;
    const int padent = s << 21;
#define UX(P) (wb + 16 * UP + 1024 * (P))
#define UL(P) ((LAS int*)(wb + 16 * UP + 2048 + 1536 * (P)))
    struct Raw { v4u x; int e0, e1; float fa0, fa1, fb0, fb1, xs; };
#define PU_RAW(R, T) do { const int tt_ = (T) < TOK ? (T) : tfirst; R.x = *(const GAS v4u*)(a.x8 + (size_t)tt_ * 1024 + 16 * lane); \
        R.e0 = a.eidx[(size_t)tt_ * P_E + lane]; R.e1 = a.eidx[(size_t)tt_ * P_E + 64 + lane]; R.fa0 = a.ga[(size_t)tt_ * P_E + lane]; R.fa1 = a.ga[(size_t)tt_ * P_E + 64 + lane]; \
        R.fb0 = a.gb[(size_t)tt_ * P_E + lane]; R.fb1 = a.gb[(size_t)tt_ * P_E + 64 + lane]; R.xs = a.xs[tt_]; } while (0)
#define PU_PREP(R, P, N, VALID) do { LAS int* LST = UL(P); \
        const bool in0_ = (VALID) && (R.e0 >> 11) == s, in1_ = (VALID) && (R.e1 >> 11) == s; \
        const unsigned long long m0_ = __ballot(in0_), m1_ = __ballot(in1_), lt_ = (1ull << lane) - 1ull; \
        const int n0_ = __popcll(m0_); N = n0_ + __popcll(m1_); \
        LAS float* lsa_ = (LAS float*)(LST + 128); LAS float* lsb_ = (LAS float*)(LST + 256); \
        if (N + lane < 128) LST[N + lane] = padent; if (N + 64 + lane < 128) LST[N + 64 + lane] = padent; \
        if (in0_) { const int p = __popcll(m0_ & lt_); LST[p] = lane | (R.e0 << 10); lsa_[p] = R.fa0 * R.xs; lsb_[p] = R.fb0; } \
        if (in1_) { const int p = n0_ + __popcll(m1_ & lt_); LST[p] = (64 + lane) | (R.e1 << 10); lsa_[p] = R.fa1 * R.xs; lsb_[p] = R.fb1; } \
        *(LAS v4u*)(UX(P) + 16 * lane) = R.x; } while (0)
#define PU_ISSUE(W, P, B) do { _Pragma("unroll") for (int u = 0; u < 8; ++u) { const unsigned ent_ = (unsigned)UL(P)[16 * (B) + 2 * u + half]; \
        W[u] = *(const GAS v4u*)(ubase + (((ent_ >> 1) & 0xFFFFFE00u) | lane16c)); } } while (0)
#define PU_COMP_REAL(W, P, B, N, T) do { \
        const int ku = 16 * (B) + 4 * q + (jn & 3); const int ent_e = UL(P)[ku]; const float fa_e = ((LAS float*)(UL(P) + 128))[ku], fb_e = ((LAS float*)(UL(P) + 256))[ku];     \
        _Pragma("unroll") for (int u = 0; u < 8; ++u) *(LAS v4u*)(twr + u * (2 * UP)) = W[u]; \
          \
        f32x4 acc0_ = {0.f, 0.f, 0.f, 0.f}, acc1_ = {0.f, 0.f, 0.f, 0.f}; v4u ar_[4], xl_[4], xh_[4]; \
        _Pragma("unroll") for (int kk = 0; kk < 2; ++kk) { ar_[kk] = *(const LAS v4u*)(tra + 64 * kk); xl_[kk] = *(const LAS v4u*)(UX(P) + 128 * kk + 16 * q); xh_[kk] = *(const LAS v4u*)(UX(P) + 128 * kk + 64 + 16 * q); } \
        _Pragma("unroll") for (int kk = 0; kk < 8; kk += 2) { \
            if (kk + 2 < 8) { _Pragma("unroll") for (int d = 2; d < 4; ++d) { const int k2 = kk + d; ar_[k2 & 3] = *(const LAS v4u*)(tra + 64 * k2); xl_[k2 & 3] = *(const LAS v4u*)(UX(P) + 128 * k2 + 16 * q); xh_[k2 & 3] = *(const LAS v4u*)(UX(P) + 128 * k2 + 64 + 16 * q); } } \
            { const v4u ar = ar_[kk & 3], xl = xl_[kk & 3], xh = xh_[kk & 3]; const v8i_t av = {(int)ar.x, (int)ar.y, (int)ar.z, (int)ar.w, 0, 0, 0, 0}, bv = {(int)xl.x, (int)xl.y, (int)xl.z, (int)xl.w, (int)xh.x, (int)xh.y, (int)xh.z, (int)xh.w}; \
              acc0_ = __builtin_amdgcn_mfma_scale_f32_16x16x128_f8f6f4(av, bv, acc0_, 4, 0, 0, 0, 0, 0); } \
            { const v4u ar = ar_[(kk + 1) & 3], xl = xl_[(kk + 1) & 3], xh = xh_[(kk + 1) & 3]; const v8i_t av = {(int)ar.x, (int)ar.y, (int)ar.z, (int)ar.w, 0, 0, 0, 0}, bv = {(int)xl.x, (int)xl.y, (int)xl.z, (int)xl.w, (int)xh.x, (int)xh.y, (int)xh.z, (int)xh.w}; \
              acc1_ = __builtin_amdgcn_mfma_scale_f32_16x16x128_f8f6f4(av, bv, acc1_, 4, 0, 0, 0, 0, 0); } } \
        const f32x4 acc = acc0_ + acc1_; \
        const float du = (jn & 2) ? ((jn & 1) ? acc[3] : acc[2]) : ((jn & 1) ? acc[1] : acc[0]); \
        if (jn < 4 && ku < N) { const int slot = ent_e & 127; \
            const float cf_ = C8_SCALE * fb_e * gelu_as(du * fa_e); \
            a.coef8[(size_t)(T) * P_E + slot] = (unsigned char)__builtin_amdgcn_cvt_pk_fp8_f32(fminf(fmaxf(cf_, -448.f), 448.f), 0.f, 0, false); } } while (0)
#if defined(ABL_UNOCOMP)
#define PU_COMP(W, P, B, N, T) do { unsigned x_ = 0; _Pragma("unroll") for (int u = 0; u < 8; ++u) x_ |= W[u].x ^ W[u].w; const int ku = 16 * (B) + 4 * q + (jn & 3); if (jn < 4 && ku < N) { const int slot = UL(P)[ku] & 127; a.coef8[(size_t)(T) * P_E + slot] = (unsigned char)(x_ == 0x12345u ? 1 : 0); } } while (0)
#else
#define PU_COMP(W, P, B, N, T) PU_COMP_REAL(W, P, B, N, T)
#endif
    const int ntok = (TOK - tfirst + step - 1) / step;
#define PU_TOK(i) ((i) < ntok ? tfirst + (i) * step : TOK)
    Raw raw; int nA = 0, nB = 0;
    v4u wA0[8], wA1[8], wB0[8], wB1[8];
    int iA = wg_grab(cnt, lane), iB = wg_grab(cnt, lane), iC = wg_grab(cnt, lane);
    if (iA >= ntok) return;
    PU_RAW(raw, PU_TOK(iA)); PU_PREP(raw, 0, nA, true);
    PU_RAW(raw, PU_TOK(iB));
    PU_ISSUE(wA0, 0, 0); if (nA > 16) PU_ISSUE(wA1, 0, 1);
    PU_PREP(raw, 1, nB, iB < ntok);
    PU_RAW(raw, PU_TOK(iC));
    for (;;) {
        const int iD = wg_grab(cnt, lane);
        PU_ISSUE(wB0, 1, 0); if (nB > 16) PU_ISSUE(wB1, 1, 1);
        { const int tA = PU_TOK(iA);
          PU_COMP(wA0, 0, 0, nA, tA);
          if (nA > 16) PU_COMP(wA1, 0, 1, nA, tA);
          for (int b = 2; 16 * b < nA; ++b) { PU_ISSUE(wA0, 0, b); PU_COMP(wA0, 0, b, nA, tA); } }
        if (iB >= ntok) break;
        PU_PREP(raw, 0, nA, iC < ntok);
        PU_RAW(raw, PU_TOK(iD));
        const int iE = wg_grab(cnt, lane);
        PU_ISSUE(wA0, 0, 0); if (nA > 16) PU_ISSUE(wA1, 0, 1);
        { const int tB = PU_TOK(iB);
          PU_COMP(wB0, 1, 0, nB, tB);
          if (nB > 16) PU_COMP(wB1, 1, 1, nB, tB);
          for (int b = 2; 16 * b < nB; ++b) { PU_ISSUE(wB0, 1, b); PU_COMP(wB0, 1, b, nB, tB); } }
        if (iC >= ntok) break;
        PU_PREP(raw, 1, nB, iD < ntok);
        PU_RAW(raw, PU_TOK(iE));
        iA = iC; iB = iD; iC = iE;
    }
#undef PU_TOK
#undef PU_RAW
#undef PU_PREP
#undef PU_ISSUE
#undef PU_COMP
#undef PU_COMP_REAL
#undef UX
#undef UL
}
struct ExpB { float* xio; const bf16* x1b; const unsigned char* vb8; const int* eidx; const unsigned char* coef8; float* ss2; };
constexpr int V_SLICES = 4;
__device__ __forceinline__ void peer_v_phase(Frame& F, const ExpB& a, const int s, const int t0, const int step, LAS int* cnt) {
    const int lane = F.lane, g = lane >> 3, j = lane & 7, q = lane >> 4, jn = lane & 15;
    const GAS unsigned char* vs = (const GAS unsigned char*)a.vb8 + (size_t)s * ((size_t)N_EXP * 128); const unsigned j16 = 16u * (unsigned)j;
    if (t0 >= TOK) return;
    LAS unsigned char* tile = F.lds + (F.wave < 7 ? F.wave * VT_BYTES : VT_LAST_OFF);
    LAS unsigned char* wbase = tile + g * (16 * VT_PITCH) + 16 * j;
    LAS unsigned char* rbase = tile + (32 * q + jn) * VT_PITCH;
    const int chA = 256 * s + 64 * q + jn;
#define PV_LDE(E, T) do { const int tt_ = (T) < TOK ? (T) : t0; const GAS v4u* ep_ = (const GAS v4u*)(a.eidx + (size_t)tt_ * P_E + 16 * g); \
        _Pragma("unroll") for (int k4 = 0; k4 < 4; ++k4) { const v4u ev = ep_[k4]; E[4 * k4] = (int)ev.x; E[4 * k4 + 1] = (int)ev.y; E[4 * k4 + 2] = (int)ev.z; E[4 * k4 + 3] = (int)ev.w; } } while (0)
#define PV_ROWS(W, E, C8, X, T) do { const int tt_ = (T) < TOK ? (T) : t0; _Pragma("unroll") for (int k = 0; k < 16; ++k) W[k] = *(const GAS v4u*)(vs + (((unsigned)E[k] << 7) | j16)); \
        { const GAS v4u* cp_ = (const GAS v4u*)(a.coef8 + (size_t)tt_ * P_E + 16 * q); C8[0] = cp_[0]; C8[1] = cp_[4]; }   \
        { const GAS bf16* xp_ = (const GAS bf16*)(a.x1b + (size_t)tt_ * 1024 + chA); _Pragma("unroll") for (int i = 0; i < 4; ++i) X[i] = xp_[16 * i]; } } while (0)
#define PV_COMP(W, C8, X, T) do { \
        _Pragma("unroll") for (int k = 0; k < 16; ++k) *(LAS v4u*)(wbase + k * VT_PITCH) = W[k]; \
        const v8i_t av = {(int)C8[0].x, (int)C8[0].y, (int)C8[0].z, (int)C8[0].w, (int)C8[1].x, (int)C8[1].y, (int)C8[1].z, (int)C8[1].w}; \
        float y[4] = {0.f, 0.f, 0.f, 0.f}; \
        _Pragma("unroll") for (int ct = 0; ct < 16; ++ct) { \
            const v2i_t b0 = __builtin_amdgcn_ds_read_tr4_b64_v2i32((LAS v2i_t*)(rbase + 8 * ct)), b1 = __builtin_amdgcn_ds_read_tr4_b64_v2i32((LAS v2i_t*)(rbase + 16 * VT_PITCH + 8 * ct)); \
            const v8i_t bv = {b0.x, b0.y, b1.x, b1.y, 0, 0, 0, 0}; \
            const f32x4 d_ = __builtin_amdgcn_mfma_scale_f32_16x16x128_f8f6f4(av, bv, (f32x4){0.f, 0.f, 0.f, 0.f}, 0, 4, 0, 0, 0, 0); \
            y[ct & 3] = (q == (ct >> 2)) ? d_[0] : y[ct & 3]; } \
        float sq = 0.f; \
        _Pragma("unroll") for (int i = 0; i < 4; ++i) { const float o_ = bflo((unsigned)X[i]) + y[i] * (1.f / C8_SCALE); a.xio[(size_t)(T) * 1024 + chA + 16 * i] = o_; sq += o_ * o_; } \
        sq = row_sum16(sq); \
        sq += __shfl_xor(sq, 16); sq += __shfl_xor(sq, 32); \
        if (lane == 0) a.ss2[(size_t)(T) * V_SLICES + s] = sq; } while (0)
    int e1[16], e2[16]; v4u wA[16], wB[16], c8A[2], c8B[2]; bf16 xA[4], xB[4];
    const int ntok = (TOK - t0 + step - 1) / step;
#define PV_TOK(i) ((i) < ntok ? t0 + (i) * step : TOK)
    int iA = wg_grab(cnt, lane), iB = wg_grab(cnt, lane);
    if (iA >= ntok) return;
    PV_LDE(e1, PV_TOK(iA));
    PV_LDE(e2, PV_TOK(iB));
    PV_ROWS(wA, e1, c8A, xA, PV_TOK(iA));
    for (;;) {
        const int iC = wg_grab(cnt, lane);
        PV_LDE(e1, PV_TOK(iC));
        PV_ROWS(wB, e2, c8B, xB, PV_TOK(iB));
        PV_COMP(wA, c8A, xA, PV_TOK(iA));
        if (iB >= ntok) break;
        const int iD = wg_grab(cnt, lane);
        PV_LDE(e2, PV_TOK(iD));
        PV_ROWS(wA, e1, c8A, xA, PV_TOK(iC));
        PV_COMP(wB, c8B, xB, PV_TOK(iB));
        if (iC >= ntok) break;
        iA = iC; iB = iD;
    }
#undef PV_TOK
#undef PV_LDE
#undef PV_ROWS
#undef PV_COMP
}
__device__ __forceinline__ void final_norm_phase(Frame& F, float* xio, const float* ss2, const float* gfinal, const int gw, const int NGW) {
    const int lane = F.lane;
    for (int t = gw; t < TOK; t += NGW) {
        const f32x4 s0 = *(const GAS f32x4*)(ss2 + (size_t)t * V_SLICES); static_assert(V_SLICES == 4, "ss2 row");
        const float rstd = 1.f / sqrtf(((s0.x + s0.y) + (s0.z + s0.w)) * (1.f / 1024.f) + NORM_EPS);
        GAS f32x4* xr = (GAS f32x4*)(xio + (size_t)t * 1024) + lane; const GAS f32x4* gf = (const GAS f32x4*)gfinal + lane;
#pragma unroll
        for (int q = 0; q < 4; ++q) xr[64 * q] = xr[64 * q] * rstd * gf[64 * q];
    }
}

struct Args { const float* in[18]; float* out; unsigned char* ws; int ph_lo, ph_hi, li, pad; };
__global__ void __launch_bounds__(NWAVES * 64, 2) fwd_kernel(Args args) {
    extern __shared__ __attribute__((aligned(16))) unsigned char lds[];
    Frame F;
    F.lds = (LAS unsigned char*)lds;
    F.MISC = (volatile LAS unsigned*)(F.lds + MISC_OFF);
    F.tid = threadIdx.x; F.lane = F.tid & 63; F.wave = __builtin_amdgcn_readfirstlane(F.tid >> 6);
    F.G = gridDim.x; { const int bx = blockIdx.x; F.vcu = (F.G % 8 == 0) ? (bx % 8) * (F.G / 8) + bx / 8 : bx; }
    unsigned char* ws = args.ws;
    F.ctl = (gu32*)(ws + WS_CTL);
#define GRID_BAR(seam) do { if (N_LAUNCHES == PER_PHASE) { if (F.tid == 0) __hip_atomic_store(F.ctl + CW_TMO, 0xBADBA0u | (unsigned)(seam), RLX_AGENT); } else { xcd_barrier(bar); } } while (0)
    const float* x = args.in[0];
    bf16* H = (bf16*)(ws + WS_H); bf16* Win = (bf16*)(ws + WS_WIN); bf16* Wpw = (bf16*)(ws + WS_WPW); bf16* Wao = (bf16*)(ws + WS_WAO); bf16* Wout = (bf16*)(ws + WS_WOUT); bf16* Wq = (bf16*)(ws + WS_WQ);
    bf16* KEYS = (bf16*)(ws + WS_KEYS); unsigned char* UB = ws + WS_UB; unsigned char* VB = ws + WS_VB; float* USC = (float*)(ws + WS_USC); float* VSC = (float*)(ws + WS_VSC);
    bf16* ZGLU = (bf16*)(ws + WS_ZGLU); bf16* QO = (bf16*)(ws + WS_QO); bf16* KB = (bf16*)(ws + WS_K); bf16* VBUF = (bf16*)(ws + WS_V); bf16* GC = (bf16*)(ws + WS_GC); bf16* GA = (bf16*)(ws + WS_GATE_A);
    bf16* CACT = (bf16*)(ws + WS_CACT); bf16* MIX = (bf16*)(ws + WS_MIX); bf16* X1B = (bf16*)(ws + WS_X1B); bf16* QP = (bf16*)(ws + WS_QP);
    float* KMEAN = (float*)(ws + WS_KMEAN); float* SS = (float*)(ws + WS_SS); int* EIDX = (int*)(ws + WS_EIDX); float* GW = (float*)(ws + WS_GW);
    for (int u = F.tid; u < (LDS_BYTES - LDSCTL_OFF) / 4; u += NWAVES * 64) ((LAS unsigned*)(F.lds + LDSCTL_OFF))[u] = 0u;
    __syncthreads();
    XcdBarrier bar; bar.bar = (unsigned*)(F.ctl + CW_BAR); bar.x = 0; bar.st = nullptr;
    if (N_LAUNCHES != PER_PHASE) bar = xcd_barrier_post((unsigned*)(F.ctl + CW_BAR), F.MISC + 8);
    const int lo = args.ph_lo, hi = args.ph_hi;
#ifdef TIME_PHASE
    unsigned long long ts_[PER_PHASE + 1]; ts_[0] = __builtin_amdgcn_s_memrealtime();
#define STAMP(k) ts_[(k) + 1] = __builtin_amdgcn_s_memrealtime()
#else
#define STAMP(k) do {} while (0)
#endif
#ifndef PHASE_MASK
#define PHASE_MASK 0xff
#endif
#define IN(k) (((PHASE_MASK >> (k)) & 1) && lo <= (k) && (k) < hi)
#define BOTH(k) (IN(k) && IN((k) + 1))

    if (IN(0)) {
        P0Args a{x, args.in[1], args.in[2], args.in[7], args.in[9], args.in[10], args.in[11], args.in[12], args.in[13], args.in[14], args.in[15], args.in[16], H, Win, Wpw, Wao, Wout, Wq, KEYS, UB, VB, USC, VSC};
        p0_prologue(F, a);
        if (BOTH(0)) GRID_BAR(0);
        STAMP(0);
    }
#ifdef DEBUG_P1_PLAIN
    if (IN(1)) {
        pg8::Gemm g{H, Wq, TOK, 2048, 1024}; pg8::StaticOrder S; S.init(TOK, 2048, F.G, (int)blockIdx.x);
        pg8::EpiStore E{QP, 2048};
        pg8::gemm_phase<pg8::EpiStore, pg8::StaticOrder, true, true>(F.lds + RING_OFF, g, S, E);
    }
#else
    if (IN(1)) {
        pg8::Gemm g{H, Win, TOK, IN_COLS, 1024}; pg8::StaticOrder S; S.init(TOK, IN_COLS, F.G, (int)blockIdx.x);
        pg8::EpiIn E{ZGLU, QO, GC, KMEAN, attn_body::C2, (size_t)(WS_K - WS_QO) / 2, (size_t)(WS_GATE_A - WS_GC) / 2};
        static_assert(WS_V - WS_K == WS_K - WS_QO, "Q|K|V equally spaced");
        pg8::gemm_phase<pg8::EpiIn, pg8::StaticOrder, true, true>(F.lds + RING_OFF, g, S, E);
        if (BOTH(1)) GRID_BAR(1);
        STAMP(1);
    }
#endif
    if (IN(2)) {
        static_assert(attn_body::ATTN_LDS_BYTES <= RING_BYTES && attn_body::ATTN_PITCH == ATT_W, "attention body geometry vs frame");
#ifdef CONV_FIRST
        { const ConvArgs ca{ZGLU, args.in[3], args.in[4], args.in[5], args.in[6], CACT};
          conv_phase(F, ca); }
        __syncthreads();
#ifdef TIME_SPLIT2
        ts_[3] = __builtin_amdgcn_s_memrealtime();
#endif
#endif
        const attn_body::AttnTensors AT{(const attn_body::bf16*)QO, (const attn_body::bf16*)KB, (const attn_body::bf16*)VBUF, (attn_body::bf16*)(CACT + 512), KMEAN};
        const attn_body::StaticOrder S((int)F.G, (int)blockIdx.x);
        attn_body::attn_phase<attn_body::StaticOrder>((char*)lds + RING_OFF, AT, S);
        __syncthreads();
#ifndef CONV_FIRST
        { const ConvArgs ca{ZGLU, args.in[3], args.in[4], args.in[5], args.in[6], CACT};
          conv_phase(F, ca); }
#endif
        if (BOTH(2)) GRID_BAR(2);
#if !(defined(TIME_SPLIT2) && defined(CONV_FIRST))
        STAMP(2);
#endif
    }
    if (IN(3)) {
        { pg8::Gemm g{CACT, Wpw, TOK, 1024, 1024}; pg8::StaticOrder S; S.init(TOK, 1024, F.G, (int)blockIdx.x);
          pg8::EpiMixF E{GC, GA, args.in[8], MIX};
          pg8::gemm_phase<pg8::EpiMixF, pg8::StaticOrder, true, true>(F.lds + RING_OFF, g, S, E); }
        if (BOTH(3)) GRID_BAR(3);
        STAMP(3);
    }
    if (IN(4)) {
        pg8::Gemm g{MIX, Wout, TOK, 1024, 1024}; pg8::StaticOrder S; S.init(TOK, 1024, F.G, (int)blockIdx.x);
        pg8::EpiX1 E{x, args.out, X1B, SS};
        pg8::gemm_phase<pg8::EpiX1, pg8::StaticOrder, true, true>(F.lds + RING_OFF, g, S, E);
        if (BOTH(4)) GRID_BAR(4);
        STAMP(4);
    }
    if (IN(5)) {
        pg8::Gemm g{X1B, Wq, TOK, 2048, 1024}; pg8::StaticOrder S; S.init(TOK, 2048, F.G, (int)blockIdx.x);
        pg8::EpiStore E{QP, 2048};
        pg8::gemm_phase<pg8::EpiStore, pg8::StaticOrder, true, true>(F.lds + RING_OFF, g, S, E);
        if (BOTH(5)) GRID_BAR(5);
        STAMP(5);
    }
    if (IN(6)) {
        const SelArgs sa{QP, KEYS, SS, USC, VSC, EIDX, (float*)(ws + WS_GA), GW, X1B, ws + WS_X8, (float*)(ws + WS_XS)};
        peer_select_phase(F, sa);
        peer_rows_fp8(F, sa);
        if (BOTH(6)) GRID_BAR(6);
        STAMP(6);
    }
    if (IN(7)) {
#ifdef TIME_U
        const unsigned long long tu0_ = __builtin_amdgcn_s_memrealtime();
#endif
        LAS int* cnt = (LAS int*)(F.lds + P7_CNT_OFF);
        if (F.tid < 16) cnt[F.tid] = 0;
        __syncthreads();
        const ExpA ea{ws + WS_X8, (const float*)(ws + WS_XS), UB, EIDX, (const float*)(ws + WS_GA), GW, ws + WS_COEF};
        for (int s = 0; s < 8; ++s) peer_u_phase(F, ea, s, F.vcu, F.G, cnt + s);
        VM_WAIT(); __syncthreads();
#ifdef TIME_V
        const unsigned long long tv0_ = __builtin_amdgcn_s_memrealtime();
#endif
        const ExpB eb{args.out, X1B, VB, EIDX, ws + WS_COEF, (float*)(ws + WS_SS2)};
        for (int s = 0; s < V_SLICES; ++s) peer_v_phase(F, eb, s, F.vcu, F.G, cnt + 8 + s);
        VM_WAIT(); __syncthreads();
#ifdef TIME_V
#ifdef TIME_U
        const float tvv_ = (float)(tv0_ - tu0_) * (0.01f / TIME_V);
#else
        const float tvv_ = (float)(__builtin_amdgcn_s_memrealtime() - tv0_) * (0.01f / TIME_V);
#endif
#endif
        final_norm_phase(F, args.out, (const float*)(ws + WS_SS2), args.in[17], F.vcu + F.G * F.wave, F.G * NWAVES);
#ifdef UNIT_MFMA4
        __syncthreads();
        if (blockIdx.x == 0 && F.wave == 0) {
            typedef int v8i_ __attribute__((ext_vector_type(8)));
            const int lane = F.lane, qq = lane >> 4;
            const v8i_ av = {0x38383838, 0x38383838, 0x38383838, 0x38383838, 0x38383838, 0x38383838, 0x38383838, 0x38383838};
            v8i_ bv = {0x22222222, 0x22222222, 0x22222222, 0x22222222, 0, 0, 0, 0};
            if (UNIT_MFMA4 == 2) bv = (v8i_){0x11111111, 0, 0, 0, 0, 0, 0, 0};
            v8i_ av2 = av;
            if (UNIT_MFMA4 == 3) { const bool on = qq == 1; av2 = (v8i_){0, on ? 0x00005800 : 0, 0, 0, 0, 0, 0, 0}; bv = (v8i_){on ? 0x00700000 : 0, 0, 0, 0, 0, 0, 0, 0}; }
            if (UNIT_MFMA4 == 4) { const bool on = qq == 2; av2 = (v8i_){0, 0, 0, 0, 0, on ? 0x58000000 : 0, 0, 0}; bv = (v8i_){0, 0, on ? 0x70000000 : 0, 0, 0, 0, 0, 0}; }
            const f32x4 d = __builtin_amdgcn_mfma_scale_f32_16x16x128_f8f6f4(av2, bv, (f32x4){0.f, 0.f, 0.f, 0.f}, 0, 4, 0, 0, 0, 0);
            if (UNIT_MFMA4 >= 100) {
                const int eb = UNIT_MFMA4 - 100; int found = 98;
                v8i_ bs = {0, 0, 0, 0, 0, 0, 0, 0}; if (qq == 2) bs[eb >> 3] = 7 << (4 * (eb & 7));
#pragma nounroll
                for (int qe = 0; qe < 128; ++qe) { int qa = qe >> 5, ea = qe & 31; asm volatile("" : "+s"(qa), "+s"(ea)); v8i_ as = {0, 0, 0, 0, 0, 0, 0, 0};
#pragma unroll
                    for (int w = 0; w < 8; ++w) as[w] = (qq == qa && (ea >> 2) == w) ? (0x58 << (8 * (ea & 3))) : 0;
                    const f32x4 dd = __builtin_amdgcn_mfma_scale_f32_16x16x128_f8f6f4(as, bs, (f32x4){0.f, 0.f, 0.f, 0.f}, 0, 4, 0, 0, 0, 0);
                    if (dd[0] > 1.f) found = (qa == UNIT_QA ? 3 * ea + 4 : 99); }
                if (lane == 0) { VM_WAIT(); args.out[0] = (float)found; }
            } else
            if (lane == 0) { VM_WAIT(); args.out[0] = 200.f + d[0]; }
        }
#endif
#ifdef UNIT_TR4
        __syncthreads();
        if (blockIdx.x == 0 && F.wave == 0) {
            typedef int v2i_ __attribute__((ext_vector_type(2)));
            const int lane = F.lane, g4 = lane >> 4, jj = lane & 15;
            LAS unsigned char* tb = F.lds + RING_OFF + g4 * 2048 + jj * 80;
            int okmask = 0;
            for (int hyp = 0; hyp < 4; ++hyp) { const int st = hyp & 1, ot = hyp >> 1;
                unsigned long long rowbits = 0;
                for (int n = 0; n < 16; ++n) { const unsigned v = (unsigned)(3 * jj + 5 * n + g4) & 15u; const int nib = st ? (n ^ 1) : n; rowbits |= (unsigned long long)v << (4 * nib); }
                *(LAS unsigned*)tb = (unsigned)rowbits; *(LAS unsigned*)(tb + 4) = (unsigned)(rowbits >> 32);
                LDS_WAIT(); asm volatile("" ::: "memory");
                const v2i_ rd = __builtin_amdgcn_ds_read_tr4_b64_v2i32((LAS v2i_*)tb);
                unsigned long long ex = 0;
                for (int k = 0; k < 16; ++k) { const unsigned v = (unsigned)(3 * k + 5 * jj + g4) & 15u; const int nib = ot ? (k ^ 1) : k; ex |= (unsigned long long)v << (4 * nib); }
                const bool bad = ((unsigned)rd.x != (unsigned)ex) || ((unsigned)rd.y != (unsigned)(ex >> 32));
                if (__ballot(bad) == 0ull) okmask |= 1 << hyp;
                LDS_WAIT(); asm volatile("" ::: "memory"); }
            if (lane == 0) { VM_WAIT(); args.out[0] = 200.f + 20.f * (float)okmask; }
        }
#endif
#ifdef TIME_V
        __syncthreads();
        if (blockIdx.x == TIME_V_BLOCK && F.tid == 0) { VM_WAIT(); args.out[0] = tvv_; }
#endif
        STAMP(7);
#ifdef TIME_P7_SPREAD
        __syncthreads();
        ts_[8] = __builtin_amdgcn_s_memrealtime();
        if (F.tid == 0) { __hip_atomic_fetch_max((unsigned long long*)(ws + 800), ts_[8] - ts_[7], __ATOMIC_RELAXED, __HIP_MEMORY_SCOPE_AGENT); __hip_atomic_fetch_add((unsigned*)(ws + 840), 1u, __ATOMIC_RELAXED, __HIP_MEMORY_SCOPE_AGENT); }
        if (blockIdx.x == 0 && F.tid == 0) { while (__hip_atomic_load((unsigned*)(ws + 840), __ATOMIC_RELAXED, __HIP_MEMORY_SCOPE_AGENT) < gridDim.x) __builtin_amdgcn_s_sleep(8);
            ts_[8] = ts_[7] + __hip_atomic_load((unsigned long long*)(ws + 800), __ATOMIC_RELAXED, __HIP_MEMORY_SCOPE_AGENT); }
#endif
#ifdef TIME_PHASE
#ifdef TIME_TOTAL
        if (blockIdx.x == 0 && F.tid == 0) { VM_WAIT(); args.out[0] = (float)(ts_[PER_PHASE] - ts_[0]) * (0.01f / TIME_UNIT_US); }
#else
        if (blockIdx.x == 0 && F.tid == 0) { VM_WAIT(); args.out[0] = (float)(ts_[TIME_PHASE + 1] - ts_[TIME_PHASE]) * (0.01f / TIME_UNIT_US); }
#endif
#endif
    }
#undef IN
#undef BOTH
}

#ifdef DEBUG_DUMP
__global__ void dump_kernel(const unsigned char* ws, float* out, float wsmib) {
    const size_t i = (size_t)blockIdx.x * 256 + threadIdx.x; if (i >= (size_t)TOK * 1024) return;
    const size_t t = i >> 10, c = i & 1023; float v = 0.f;
    auto B = [&](size_t off, size_t idx) { return bflo((unsigned)((const bf16*)(ws + off))[idx]); };
#if DEBUG_DUMP == 0
    v = B(WS_H, i) + B(WS_WIN, i % (4608u * 1024u)) + B(WS_WPW, i % (512u * 1024u)) + B(WS_WAO, i % (512u * 1024u)) + B(WS_WOUT, i % (1024u * 1024u)) + B(WS_WQ, i % (2048u * 1024u)) + B(WS_KEYS, i % 32768u) + B(WS_UB, i % (16384u * 1024u)) + B(WS_VB, i % (16384u * 1024u));
#elif DEBUG_DUMP == 1
    v = B(WS_ZGLU, t * 512 + (c & 511)) + 2.f * B(WS_QO, t * 512 + (c & 511)) + 3.f * B(WS_K, t * 512 + (c & 511)) + 4.f * B(WS_V, t * 512 + (c & 511)) + 5.f * B(WS_GC, i) + 6.f * B(WS_GATE_A, i) + ((const float*)(ws + WS_KMEAN))[(t >> 8) * 1024 + (c & 1023)];
#elif DEBUG_DUMP == 2
    v = B(WS_QO, t * 512 + (c & 511)) + 2.f * B(WS_CACT, t * 512 + (c & 511));
#elif DEBUG_DUMP == 20
    v = B(WS_QO, t * 512 + (c & 511));
#elif DEBUG_DUMP == 21
    v = B(WS_CACT, t * 512 + (c & 511));
#elif DEBUG_DUMP == 3
    v = B(WS_MIX, i);
#elif DEBUG_DUMP == 5
    v = B(WS_QP, t * 2048 + c) + 2.f * B(WS_QP, t * 2048 + 1024 + c);
#elif DEBUG_DUMP == 10
    v = B(WS_ZGLU, t * 512 + (c & 511));
#elif DEBUG_DUMP == 11
    v = 2.f * B(WS_QO, t * 512 + (c & 511)) + 3.f * B(WS_K, t * 512 + (c & 511)) + 4.f * B(WS_V, t * 512 + (c & 511));
#elif DEBUG_DUMP == 12
    v = 5.f * B(WS_GC, i) + 6.f * B(WS_GATE_A, i);
#elif DEBUG_DUMP == 13
    v = ((const float*)(ws + WS_KMEAN))[(t >> 8) * 1024 + (c & 1023)];
#elif DEBUG_DUMP == 98
    v = wsmib;
#elif DEBUG_DUMP == 99
    v = 1.0f + (float)(c & 7);
#endif
    out[i] = v;
}
#endif
extern "C" void kernel_launch(void* const* d_in, const int* in_sizes, int n_in, void* d_out, int out_size, void* d_ws, size_t ws_size, hipStream_t stream) {
    static int grid = 0;
    if (grid == 0) {
        if (n_in != 18 || in_sizes[0] != TOK * DM || out_size != TOK * DM || ws_size < WS_END) { fprintf(stderr, "kernel_launch: unexpected shapes (n_in %d, in0 %d, out %d, ws %zu); nothing launched\n", n_in, n_in > 0 ? in_sizes[0] : -1, out_size, ws_size); grid = -1; return; }
        int dev = 0, cus = 0, per_cu = 0;
        if (hipGetDevice(&dev) != hipSuccess || hipDeviceGetAttribute(&cus, hipDeviceAttributeMultiprocessorCount, dev) != hipSuccess) { grid = -1; return; }
        if (hipFuncSetAttribute((const void*)fwd_kernel, hipFuncAttributeMaxDynamicSharedMemorySize, LDS_BYTES) != hipSuccess) { fprintf(stderr, "kernel_launch: hipFuncSetAttribute failed\n"); grid = -1; return; }
        if (hipOccupancyMaxActiveBlocksPerMultiprocessor(&per_cu, (const void*)fwd_kernel, NWAVES * 64, LDS_BYTES) != hipSuccess || per_cu < 1) fprintf(stderr, "kernel_launch: occupancy query reports %d\n", per_cu);
        (void)hipGetLastError();
        grid = cus;
    }
    if (grid < 0) return;
    (void)hipMemsetAsync((char*)d_ws + WS_CTL, 0, CTL_ZERO_BYTES, stream);
    Args a{};
    for (int i = 0; i < 18; ++i) a.in[i] = (const float*)d_in[i];
    a.out = (float*)d_out; a.ws = (unsigned char*)d_ws;
#ifndef NPH_RUN
#define NPH_RUN N_LAUNCHES
#endif
    for (int li = 0; li < NPH_RUN; ++li) {
        a.ph_lo = (N_LAUNCHES == PER_PHASE) ? li : 0; a.ph_hi = (N_LAUNCHES == PER_PHASE) ? li + 1 : PER_PHASE; a.li = li;
        hipLaunchKernelGGL(fwd_kernel, dim3(grid), dim3(NWAVES * 64), LDS_BYTES, stream, a);
    }
#ifdef DEBUG_DUMP
    hipLaunchKernelGGL(dump_kernel, dim3(TOK * 1024 / 256), dim3(256), 0, stream, (const unsigned char*)d_ws, (float*)d_out, (float)(ws_size >> 20));
#endif
}
```

```cpp
#define MK_N_LAUNCHES 1
#ifndef PG8_EPI_DRAIN
#define PG8_EPI_DRAIN 0
#endif
#include <hip/hip_runtime.h>
#include <hip/hip_bf16.h>
#include <cstdio>
#include <cstdint>
#include <cmath>
namespace pg8 {
#define PG8_LAS __attribute__((address_space(3)))
typedef unsigned short bf16_t;
typedef short bf16x8 __attribute__((ext_vector_type(8)));
typedef float f32x4 __attribute__((ext_vector_type(4)));
typedef unsigned u32x4 __attribute__((ext_vector_type(4)));
constexpr int BM = 256, BK = 64, HALF = 128, HTB = HALF * BK * 2  , STAGE_BYTES = 8 * HTB, NXCD = 8, WGM = 4;

__host__ __device__ __forceinline__ int lds_byte(int r, int c) { const int st = (r >> 4) * 2 + (c >> 5), rr = r & 15, cc = c & 31, ob = rr * 64 + cc * 2; return st * 1024 + (ob ^ (((ob >> 9) & 1) << 5)); }
__host__ __device__ __forceinline__ void stage_rc(int b, int& R, int& C) { const int st = b / 1024, sb = b % 1024, swz = sb ^ (((sb >> 9) & 1) << 5); R = (st >> 1) * 16 + swz / 64; C = (st & 1) * 32 + (swz % 64) / 2; }
__host__ __device__ __forceinline__ int perm32(int rho) { const int n = rho >> 4, i = rho & 15; return 8 * (i >> 2) + 4 * n + (i & 3); }

struct Unit { int pm, pn; };
struct Gemm { const bf16_t* A; const bf16_t* Bt; int M, N, K; };

struct StaticOrder {
    int nM, nN, nwg, G, c;
    __host__ __device__ void init(int M, int N, int G_, int c_) { nM = M / BM; nN = N / BM; nwg = nM * nN; G = G_; c = c_; }
    __host__ __device__ bool next(int i, Unit& u) const {
        const long L = (long)i * G + c; if (L >= nwg) return false;
        int wgid = (int)L; { const int q = nwg / NXCD, r = nwg % NXCD, xcd = wgid % NXCD, off = wgid / NXCD; wgid = (xcd < r ? xcd * (q + 1) : r * (q + 1) + (xcd - r) * q) + off; }
        const int nig = WGM * nN, gid = wgid / nig, fm = gid * WGM, gsz = (nM - fm) < WGM ? (nM - fm) : WGM;
        u.pm = fm + ((wgid % nig) % gsz); u.pn = (wgid % nig) / gsz; return true;
    }
    __device__ __forceinline__ void a_ready(const Unit&) const {}
    __device__ __forceinline__ void done(const Unit&) const {}
};

typedef float f32x2c_t __attribute__((ext_vector_type(2))); typedef __bf16 bf16x2c_t __attribute__((ext_vector_type(2)));
__device__ __forceinline__ unsigned cvt_pk_bf16(float lo, float hi) { const f32x2c_t v = {lo, hi}; const bf16x2c_t b = __builtin_convertvector(v, bf16x2c_t); return __builtin_bit_cast(unsigned, b); }
typedef float f32x2 __attribute__((ext_vector_type(2)));
__device__ __forceinline__ float sigm(float v) { return __builtin_amdgcn_rcpf(1.0f + __builtin_amdgcn_exp2f(-1.4426950408889634f * v)); }
__device__ __forceinline__ float bf_lo(unsigned u) { return __uint_as_float(u << 16); }
__device__ __forceinline__ float bf_hi(unsigned u) { return __uint_as_float(u & 0xffff0000u); }
__device__ __forceinline__ u32x4 pack8(const f32x4 a, const f32x4 b) { u32x4 w; w.x = cvt_pk_bf16(a[0], a[1]); w.y = cvt_pk_bf16(a[2], a[3]); w.z = cvt_pk_bf16(b[0], b[1]); w.w = cvt_pk_bf16(b[2], b[3]); return w; }
typedef unsigned u32x2g __attribute__((ext_vector_type(2)));
__device__ __forceinline__ void unpack8u(const u32x2g w, f32x4& a, f32x4& b) { a = (f32x4){(float)(w.x & 255u), (float)((w.x >> 8) & 255u), (float)((w.x >> 16) & 255u), (float)(w.x >> 24)}; b = (f32x4){(float)(w.y & 255u), (float)((w.y >> 8) & 255u), (float)((w.y >> 16) & 255u), (float)(w.y >> 24)}; }
__device__ __forceinline__ void unpack8(const u32x4 w, f32x4& a, f32x4& b) { a = (f32x4){bf_lo(w.x), bf_hi(w.x), bf_lo(w.y), bf_hi(w.y)}; b = (f32x4){bf_lo(w.z), bf_hi(w.z), bf_lo(w.w), bf_hi(w.w)}; }

#ifndef PG8_WT
#define PG8_WT 1
#endif
__device__ __forceinline__ __amdgpu_buffer_rsrc_t wt_rsrc(const void* p) { return __builtin_amdgcn_make_buffer_rsrc((void*)p, 0, 0x7fffffff, 0x00020000); }
__device__ __forceinline__ void st16(bf16_t* base, const __amdgpu_buffer_rsrc_t r, size_t elem_off, const u32x4 v) {
#if PG8_WT
    __builtin_amdgcn_raw_buffer_store_b128(v, r, (unsigned)(elem_off * 2), 0, 16);
#else
    *(u32x4*)(base + elem_off) = v;
#endif
}
struct EpiIn {
    static constexpr bool PERM = true, AFTER_DRAIN = false, HAS_MID = false;
    bf16_t *zglu, *Q, *gc; float* kmean; float qscale; size_t qkv_stride, gate_stride;
    __device__ __forceinline__ void operator()(const f32x4 (&acc)[2][2][4][2], const Unit& u, int wr, int wc, int fr, int fq) const {
        const int row0 = u.pm * BM + wr * 64 + fr, cw = wc * 32 + 8 * fq, pn = u.pn;
        const __amdgpu_buffer_rsrc_t rz = wt_rsrc(zglu), rq = wt_rsrc(Q), rg = wt_rsrc(gc);
        if (pn < 4) {
#pragma unroll
            for (int ai = 0; ai < 2; ++ai)
#pragma unroll
                for (int m = 0; m < 4; ++m) { const size_t row = (size_t)(row0 + ai * HALF + m * 16);
                    f32x4 z0, z1;
#pragma unroll
                    for (int j = 0; j < 4; ++j) { z0[j] = acc[ai][0][m][0][j] * sigm(acc[ai][1][m][0][j]); z1[j] = acc[ai][0][m][1][j] * sigm(acc[ai][1][m][1][j]); }
                    st16(zglu, rz, row * 512 + pn * 128 + cw, pack8(z0, z1)); }
        } else if (pn < 10) {
            const size_t boff = (size_t)((pn - 4) >> 1) * qkv_stride; const int ct = (pn & 1) * 256; const float sc = pn < 6 ? qscale : 1.0f;
#pragma unroll
            for (int ai = 0; ai < 2; ++ai)
#pragma unroll
                for (int m = 0; m < 4; ++m) { const size_t row = (size_t)(row0 + ai * HALF + m * 16);
#pragma unroll
                    for (int bj = 0; bj < 2; ++bj) st16(Q, rq, boff + row * 512 + ct + bj * HALF + cw, pack8(acc[ai][bj][m][0] * sc, acc[ai][bj][m][1] * sc)); }
            if (pn == 6 || pn == 7) {
#pragma unroll
                for (int bj = 0; bj < 2; ++bj)
#pragma unroll
                    for (int n = 0; n < 2; ++n)
#pragma unroll
                        for (int j = 0; j < 4; ++j) { float s = 0.f;
#pragma unroll
                            for (int ai = 0; ai < 2; ++ai)
#pragma unroll
                                for (int m = 0; m < 4; ++m) s += acc[ai][bj][m][n][j];
                            s += __shfl_xor(s, 1); s += __shfl_xor(s, 2); s += __shfl_xor(s, 4); s += __shfl_xor(s, 8);
                            if (fr == 0) kmean[((size_t)u.pm * 2 + wr) * 512 + ct + bj * HALF + cw + 4 * n + j] = s * (1.0f / 256.0f); }
            }
        } else {
            const size_t boff = (size_t)((pn - 10) >> 2) * gate_stride; const int ct = ((pn - 10) & 3) * 256;
#pragma unroll
            for (int ai = 0; ai < 2; ++ai)
#pragma unroll
                for (int m = 0; m < 4; ++m) { const size_t row = (size_t)(row0 + ai * HALF + m * 16);
#pragma unroll
                    for (int bj = 0; bj < 2; ++bj) { unsigned w0 = 0, w1 = 0;
#pragma unroll
                        for (int j = 0; j < 4; ++j) { w0 = __builtin_amdgcn_cvt_pk_u8_f32(255.f * sigm(acc[ai][bj][m][0][j]), j, w0); w1 = __builtin_amdgcn_cvt_pk_u8_f32(255.f * sigm(acc[ai][bj][m][1][j]), j, w1); }
                        *(u32x2g*)((unsigned char*)gc + boff + row * 1024 + ct + bj * HALF + cw) = (u32x2g){w0, w1}; } }
        }
    }
};
template <bool ADD> struct EpiMix {
    static constexpr bool PERM = true, AFTER_DRAIN = false, HAS_MID = false;
    const bf16_t* gate; const float* bias; bf16_t* mix;
    __device__ __forceinline__ void operator()(const f32x4 (&acc)[2][2][4][2], const Unit& u, int wr, int wc, int fr, int fq) const {
        const int row0 = u.pm * BM + wr * 64 + fr, col0 = u.pn * BM + wc * 32 + 8 * fq;
        f32x4 b0[2], b1[2];
#pragma unroll
        for (int bj = 0; bj < 2; ++bj) { b0[bj] = (f32x4){0.f, 0.f, 0.f, 0.f}; b1[bj] = b0[bj]; if (!ADD) { b0[bj] = *(const f32x4*)(bias + col0 + bj * HALF); b1[bj] = *(const f32x4*)(bias + col0 + bj * HALF + 4); } }
#pragma unroll
        for (int ai = 0; ai < 2; ++ai) {
            u32x4 gq[4][2], mq[4][2];
#pragma unroll
            for (int m = 0; m < 4; ++m)
#pragma unroll
                for (int bj = 0; bj < 2; ++bj) { const size_t off = (size_t)(row0 + ai * HALF + m * 16) * 1024 + col0 + bj * HALF; gq[m][bj] = *(const u32x4*)(gate + off); if (ADD) mq[m][bj] = *(const u32x4*)(mix + off); }
#pragma unroll
            for (int m = 0; m < 4; ++m)
#pragma unroll
                for (int bj = 0; bj < 2; ++bj) { const size_t off = (size_t)(row0 + ai * HALF + m * 16) * 1024 + col0 + bj * HALF;
                    f32x4 g0, g1; unpack8(gq[m][bj], g0, g1);
                    f32x4 v0 = acc[ai][bj][m][0], v1 = acc[ai][bj][m][1];
                    if (!ADD) { v0 = (v0 + b0[bj]) * g0; v1 = (v1 + b1[bj]) * g1; }
                    else { f32x4 p0, p1; unpack8(mq[m][bj], p0, p1); v0 = p0 + v0 * g0; v1 = p1 + v1 * g1; }
                    *(u32x4*)(mix + off) = pack8(v0, v1); }
        }
    }
};
struct EpiMixF {
    static constexpr bool PERM = true, AFTER_DRAIN = false, HAS_MID = true;
    const unsigned char* gc; const unsigned char* ga; const float* bias; bf16_t* mix;
    __device__ __forceinline__ void mid(f32x4 (&acc)[2][2][4][2], const Unit& u, int wr, int wc, int fr, int fq) const {
        const int row0 = u.pm * BM + wr * 64 + fr, col0 = u.pn * BM + wc * 32 + 8 * fq;
#pragma unroll
        for (int ai = 0; ai < 2; ++ai)
#pragma unroll
            for (int m = 0; m < 4; ++m) { u32x2g cq[2], aq[2];
#pragma unroll
                for (int bj = 0; bj < 2; ++bj) { const size_t off = (size_t)(row0 + ai * HALF + m * 16) * 1024 + col0 + bj * HALF; cq[bj] = __builtin_nontemporal_load((const u32x2g*)(gc + off)); aq[bj] = *(const u32x2g*)(ga + off); }
#pragma unroll
                for (int bj = 0; bj < 2; ++bj) { f32x4 c0, c1, a0, a1; unpack8u(cq[bj], c0, c1); unpack8u(aq[bj], a0, a1);
                    const f32x4 b0 = *(const f32x4*)(bias + col0 + bj * HALF), b1 = *(const f32x4*)(bias + col0 + bj * HALF + 4);
#pragma unroll
                    for (int j = 0; j < 4; ++j) { acc[ai][bj][m][0][j] = (acc[ai][bj][m][0][j] + b0[j]) * c0[j] * __builtin_amdgcn_rcpf(fmaxf(a0[j], 1e-30f));
                                                  acc[ai][bj][m][1][j] = (acc[ai][bj][m][1][j] + b1[j]) * c1[j] * __builtin_amdgcn_rcpf(fmaxf(a1[j], 1e-30f)); } }
                if (m & 1) asm volatile("" ::: "memory"); }
    }
    __device__ __forceinline__ void operator()(const f32x4 (&acc)[2][2][4][2], const Unit& u, int wr, int wc, int fr, int fq) const {
        const int row0 = u.pm * BM + wr * 64 + fr, col0 = u.pn * BM + wc * 32 + 8 * fq;
        const __amdgpu_buffer_rsrc_t rm = wt_rsrc(mix);
#pragma unroll
        for (int ai = 0; ai < 2; ++ai) { u32x2g aq[4][2];
#pragma unroll
            for (int m = 0; m < 4; ++m)
#pragma unroll
                for (int bj = 0; bj < 2; ++bj) aq[m][bj] = *(const u32x2g*)(ga + (size_t)(row0 + ai * HALF + m * 16) * 1024 + col0 + bj * HALF);
#pragma unroll
            for (int m = 0; m < 4; ++m)
#pragma unroll
                for (int bj = 0; bj < 2; ++bj) { f32x4 a0, a1; unpack8u(aq[m][bj], a0, a1); f32x4 v0 = acc[ai][bj][m][0], v1 = acc[ai][bj][m][1];
#pragma unroll
                    for (int j = 0; j < 4; ++j) { v0[j] *= fmaxf(a0[j], 1e-30f) * (1.f / 255.f); v1[j] *= fmaxf(a1[j], 1e-30f) * (1.f / 255.f); }
                    st16(mix, rm, (size_t)(row0 + ai * HALF + m * 16) * 1024 + col0 + bj * HALF, pack8(v0, v1)); } }
    }
};
struct EpiX1 {
    static constexpr bool PERM = true, AFTER_DRAIN = false, HAS_MID = false;
    const float* x; float* x1; bf16_t* x1b; float* ss;
    __device__ __forceinline__ void operator()(const f32x4 (&acc)[2][2][4][2], const Unit& u, int wr, int wc, int fr, int fq) const {
        const int row0 = u.pm * BM + wr * 64 + fr, col0 = u.pn * BM + wc * 32 + 8 * fq;
        const __amdgpu_buffer_rsrc_t rx = wt_rsrc(x1b);
#pragma unroll
        for (int ai = 0; ai < 2; ++ai) {
            f32x4 xq[4][2][2];
#pragma unroll
            for (int m = 0; m < 4; ++m)
#pragma unroll
                for (int bj = 0; bj < 2; ++bj) { const size_t off = (size_t)(row0 + ai * HALF + m * 16) * 1024 + col0 + bj * HALF; xq[m][bj][0] = __builtin_nontemporal_load((const f32x4*)(x + off)); xq[m][bj][1] = __builtin_nontemporal_load((const f32x4*)(x + off + 4)); }
#pragma unroll
            for (int m = 0; m < 4; ++m) { const size_t row = (size_t)(row0 + ai * HALF + m * 16); float sq = 0.f;
#pragma unroll
                for (int bj = 0; bj < 2; ++bj) { const size_t off = row * 1024 + col0 + bj * HALF;
                    const f32x4 r0 = xq[m][bj][0] + acc[ai][bj][m][0], r1 = xq[m][bj][1] + acc[ai][bj][m][1];
                    st16(x1b, rx, off, pack8(r0, r1));
                    sq += (r0[0] * r0[0] + r0[1] * r0[1]) + (r0[2] * r0[2] + r0[3] * r0[3]) + (r1[0] * r1[0] + r1[1] * r1[1]) + (r1[2] * r1[2] + r1[3] * r1[3]); }
                sq += __shfl_xor(sq, 16); sq += __shfl_xor(sq, 32);
                if (fq == 0) ss[row * 16 + u.pn * 4 + wc] = sq; }
        }
    }
};
struct EpiStore {
    static constexpr bool PERM = true, AFTER_DRAIN = false, HAS_MID = false;
    bf16_t* O; int ldc;
    __device__ __forceinline__ void operator()(const f32x4 (&acc)[2][2][4][2], const Unit& u, int wr, int wc, int fr, int fq) const {
        const int row0 = u.pm * BM + wr * 64 + fr, col0 = u.pn * BM + wc * 32 + 8 * fq;
        const __amdgpu_buffer_rsrc_t ro = wt_rsrc(O);
#pragma unroll
        for (int ai = 0; ai < 2; ++ai)
#pragma unroll
            for (int m = 0; m < 4; ++m) { const size_t row = (size_t)(row0 + ai * HALF + m * 16);
#pragma unroll
                for (int bj = 0; bj < 2; ++bj) st16(O, ro, row * ldc + col0 + bj * HALF, pack8(acc[ai][bj][m][0], acc[ai][bj][m][1])); }
    }
};


template <class Epi, class Sched, bool ALIGN_EPI = false, bool SP2 = false>
__device__ __forceinline__ void gemm_phase(PG8_LAS unsigned char* lds, const Gemm g, const Sched& S, const Epi& E) {
    const int tid = threadIdx.x, wid = __builtin_amdgcn_readfirstlane(tid >> 6), lane = tid & 63, wr = wid >> 2, wc = wid & 3, fr = lane & 15, fq = lane >> 4;
    const int K = g.K, nt = K / BK;
    unsigned voffA[2], voffB[2];
#pragma unroll
    for (int i = 0; i < 2; ++i) { int R, C; stage_rc(tid * 16 + i * 8192, R, C); const int Rb = Epi::PERM ? ((R & ~31) + perm32(R & 31)) : R;
        voffA[i] = (unsigned)(R * K + C) * 2u; voffB[i] = (unsigned)(Rb * K + C) * 2u; }
    const size_t kstep = (size_t)(BK * 2);
    const size_t hstep = (size_t)HALF * K * 2;
    const size_t tstep = 2 * hstep;
    const unsigned ldsw = (unsigned)wid * 1024u;
    const int aoff = lds_byte(wr * 64 + fr, fq * 8), boff = lds_byte(wc * 32 + fr, fq * 8);
#define PG8_SA(b, h) (((b) * 2 + (h)) * HTB)
#define PG8_SB(b, h) ((4 + (b) * 2 + (h)) * HTB)
#define PG8_STAGE(bufoff, gbase, voff) do { _Pragma("unroll") for (int _i = 0; _i < 2; ++_i) \
        __builtin_amdgcn_global_load_lds((const unsigned*)((const char*)(gbase) + (voff)[_i]), (PG8_LAS unsigned*)(lds + (bufoff) + ldsw + _i * 8192), 16, 0, 0); } while (0)
#define PG8_LDA(dst, b, h) do { _Pragma("unroll") for (int m = 0; m < 4; ++m) _Pragma("unroll") for (int k = 0; k < 2; ++k) dst[m][k] = *(const PG8_LAS bf16x8*)(lds + PG8_SA(b, h) + aoff + m * 2048 + k * 1024); } while (0)
#define PG8_LDB(dst, b, h) do { _Pragma("unroll") for (int n = 0; n < 2; ++n) _Pragma("unroll") for (int k = 0; k < 2; ++k) dst[n][k] = *(const PG8_LAS bf16x8*)(lds + PG8_SB(b, h) + boff + n * 2048 + k * 1024); } while (0)
#define PG8_MMA(ai, bj, At, Bt) do { __builtin_amdgcn_s_setprio(1); _Pragma("unroll") for (int m = 0; m < 4; ++m) _Pragma("unroll") for (int n = 0; n < 2; ++n) _Pragma("unroll") for (int k = 0; k < 2; ++k) \
        acc[ai][bj][m][n] = __builtin_amdgcn_mfma_f32_16x16x32_bf16(Bt[n][k], At[m][k], acc[ai][bj][m][n], 0, 0, 0); __builtin_amdgcn_s_setprio(0); } while (0)
#define PG8_WAIT_V(n) asm volatile("s_waitcnt vmcnt(" #n ")" ::: "memory")
#define PG8_WAIT_L(n) asm volatile("s_waitcnt lgkmcnt(" #n ")" ::: "memory")
#define PG8_BAR __builtin_amdgcn_s_barrier()
#define PG8_SCHED __builtin_amdgcn_sched_barrier(0)
    Unit cur, nxt; int ui = 0;
    if (!S.next(0, cur)) return;
    f32x4 acc[2][2][4][2];
#pragma unroll
    for (int a = 0; a < 2; ++a)
#pragma unroll
        for (int b = 0; b < 2; ++b)
#pragma unroll
            for (int m = 0; m < 4; ++m)
#pragma unroll
                for (int n = 0; n < 2; ++n) acc[a][b][m][n] = (f32x4){0.f, 0.f, 0.f, 0.f};
    bf16x8 At[4][2], B0[2][2], B1[2][2];
    const char* cA = (const char*)g.A + (size_t)cur.pm * tstep; const char* cB = (const char*)g.Bt + (size_t)cur.pn * tstep;
    S.a_ready(cur);
    if constexpr (SP2) {
        PG8_STAGE(PG8_SB(0, 0), cB, voffB); PG8_STAGE(PG8_SB(0, 1), cB + hstep, voffB); PG8_STAGE(PG8_SA(0, 0), cA, voffA); PG8_STAGE(PG8_SA(0, 1), cA + hstep, voffA);
        if (wr == 1) PG8_BAR;
        PG8_WAIT_V(2); PG8_BAR;
        PG8_STAGE(PG8_SB(1, 0), cB + kstep, voffB); PG8_STAGE(PG8_SA(1, 0), cA + kstep, voffA); PG8_STAGE(PG8_SB(1, 1), cB + hstep + kstep, voffB);
        PG8_WAIT_V(6); PG8_BAR;
    } else {
        PG8_STAGE(PG8_SB(0, 0), cB, voffB); PG8_STAGE(PG8_SA(0, 0), cA, voffA); PG8_STAGE(PG8_SB(0, 1), cB + hstep, voffB); PG8_STAGE(PG8_SA(0, 1), cA + hstep, voffA);
        if (wr == 1) PG8_BAR;
        PG8_WAIT_V(4); PG8_BAR;
        PG8_STAGE(PG8_SB(1, 0), cB + kstep, voffB); PG8_STAGE(PG8_SA(1, 0), cA + kstep, voffA); PG8_STAGE(PG8_SB(1, 1), cB + hstep + kstep, voffB);
        PG8_WAIT_V(6); PG8_BAR;
    }
    for (;;) {
        const bool has_next = S.next(ui + 1, nxt);
        const char* nA = has_next ? (const char*)g.A + (size_t)nxt.pm * tstep : cA; const char* nB = has_next ? (const char*)g.Bt + (size_t)nxt.pn * tstep : cB;
        if constexpr (Epi::HAS_MID) {
        for (int t = 0; t < nt / 2; t += 2) {
            const bool last = (t == nt - 2);
            const char* a1 = cA + (size_t)(t + 1) * kstep;
            const char* a2 = last ? nA : cA + (size_t)(t + 2) * kstep; const char* b2 = last ? nB : cB + (size_t)(t + 2) * kstep;
            const char* a3 = a2 + kstep; const char* b3 = b2 + kstep;
            if (last && has_next) S.a_ready(nxt);
            if constexpr (SP2) {
            PG8_LDB(B0, 0, 0); PG8_LDB(B1, 0, 1); PG8_SCHED; PG8_LDA(At, 0, 0); PG8_STAGE(PG8_SA(1, 1), a1 + hstep, voffA);
            PG8_WAIT_V(8); PG8_WAIT_L(0); PG8_BAR; PG8_MMA(0, 0, At, B0); PG8_MMA(0, 1, At, B1); PG8_BAR; PG8_SCHED;
            PG8_LDA(At, 0, 1); PG8_STAGE(PG8_SB(0, 0), b2, voffB); PG8_STAGE(PG8_SB(0, 1), b2 + hstep, voffB); PG8_STAGE(PG8_SA(0, 0), a2, voffA);
            PG8_WAIT_V(8); PG8_WAIT_L(0); PG8_BAR; PG8_MMA(1, 0, At, B0); PG8_MMA(1, 1, At, B1); PG8_BAR; PG8_SCHED;
            PG8_LDB(B0, 1, 0); PG8_LDB(B1, 1, 1); PG8_SCHED; PG8_LDA(At, 1, 0); PG8_STAGE(PG8_SA(0, 1), a2 + hstep, voffA);
            PG8_WAIT_V(8); PG8_WAIT_L(0); PG8_BAR; PG8_MMA(0, 0, At, B0); PG8_MMA(0, 1, At, B1); PG8_BAR; PG8_SCHED;
            PG8_LDA(At, 1, 1); PG8_STAGE(PG8_SB(1, 0), b3, voffB); PG8_STAGE(PG8_SB(1, 1), b3 + hstep, voffB); PG8_STAGE(PG8_SA(1, 0), a3, voffA);
            PG8_WAIT_V(8); PG8_WAIT_L(0); PG8_BAR; PG8_MMA(1, 0, At, B0); PG8_MMA(1, 1, At, B1); PG8_BAR; PG8_SCHED;
            } else {
            PG8_LDB(B0, 0, 0); PG8_SCHED; PG8_LDA(At, 0, 0); PG8_STAGE(PG8_SA(1, 1), a1 + hstep, voffA);
            PG8_WAIT_L(8); PG8_BAR; PG8_WAIT_L(0); PG8_MMA(0, 0, At, B0); PG8_BAR; PG8_SCHED;
            PG8_LDB(B1, 0, 1); PG8_STAGE(PG8_SB(0, 0), b2, voffB);
            PG8_BAR; PG8_WAIT_L(0); PG8_MMA(0, 1, At, B1); PG8_BAR;
            PG8_LDA(At, 0, 1); PG8_STAGE(PG8_SA(0, 0), a2, voffA);
            PG8_BAR; PG8_WAIT_L(0); PG8_MMA(1, 0, At, B0); PG8_BAR; PG8_SCHED;
            PG8_STAGE(PG8_SB(0, 1), b2 + hstep, voffB);
            PG8_WAIT_V(6); PG8_BAR; PG8_MMA(1, 1, At, B1); PG8_BAR;
            PG8_LDB(B0, 1, 0); PG8_SCHED; PG8_LDA(At, 1, 0); PG8_STAGE(PG8_SA(0, 1), a2 + hstep, voffA);
            PG8_WAIT_L(8); PG8_BAR; PG8_WAIT_L(0); PG8_MMA(0, 0, At, B0); PG8_BAR; PG8_SCHED;
            PG8_LDB(B1, 1, 1); PG8_STAGE(PG8_SB(1, 0), b3, voffB);
            PG8_BAR; PG8_WAIT_L(0); PG8_MMA(0, 1, At, B1); PG8_BAR;
            PG8_LDA(At, 1, 1); PG8_STAGE(PG8_SA(1, 0), a3, voffA);
            PG8_BAR; PG8_WAIT_L(0); PG8_MMA(1, 0, At, B0); PG8_BAR; PG8_SCHED;
            PG8_STAGE(PG8_SB(1, 1), b3 + hstep, voffB);
            PG8_WAIT_V(6); PG8_BAR; PG8_MMA(1, 1, At, B1); PG8_BAR;
            }
        }
        E.mid(acc, cur, wr, wc, fr, fq);
        for (int t = nt / 2; t < nt; t += 2) {
            const bool last = (t == nt - 2);
            const char* a1 = cA + (size_t)(t + 1) * kstep;
            const char* a2 = last ? nA : cA + (size_t)(t + 2) * kstep; const char* b2 = last ? nB : cB + (size_t)(t + 2) * kstep;
            const char* a3 = a2 + kstep; const char* b3 = b2 + kstep;
            if (last && has_next) S.a_ready(nxt);
            if constexpr (SP2) {
            PG8_LDB(B0, 0, 0); PG8_LDB(B1, 0, 1); PG8_SCHED; PG8_LDA(At, 0, 0); PG8_STAGE(PG8_SA(1, 1), a1 + hstep, voffA);
            PG8_WAIT_V(8); PG8_WAIT_L(0); PG8_BAR; PG8_MMA(0, 0, At, B0); PG8_MMA(0, 1, At, B1); PG8_BAR; PG8_SCHED;
            PG8_LDA(At, 0, 1); PG8_STAGE(PG8_SB(0, 0), b2, voffB); PG8_STAGE(PG8_SB(0, 1), b2 + hstep, voffB); PG8_STAGE(PG8_SA(0, 0), a2, voffA);
            PG8_WAIT_V(8); PG8_WAIT_L(0); PG8_BAR; PG8_MMA(1, 0, At, B0); PG8_MMA(1, 1, At, B1); PG8_BAR; PG8_SCHED;
            PG8_LDB(B0, 1, 0); PG8_LDB(B1, 1, 1); PG8_SCHED; PG8_LDA(At, 1, 0); PG8_STAGE(PG8_SA(0, 1), a2 + hstep, voffA);
            PG8_WAIT_V(8); PG8_WAIT_L(0); PG8_BAR; PG8_MMA(0, 0, At, B0); PG8_MMA(0, 1, At, B1); PG8_BAR; PG8_SCHED;
            PG8_LDA(At, 1, 1); PG8_STAGE(PG8_SB(1, 0), b3, voffB); PG8_STAGE(PG8_SB(1, 1), b3 + hstep, voffB); PG8_STAGE(PG8_SA(1, 0), a3, voffA);
            PG8_WAIT_V(8); PG8_WAIT_L(0); PG8_BAR; PG8_MMA(1, 0, At, B0); PG8_MMA(1, 1, At, B1); PG8_BAR; PG8_SCHED;
            } else {
            PG8_LDB(B0, 0, 0); PG8_SCHED; PG8_LDA(At, 0, 0); PG8_STAGE(PG8_SA(1, 1), a1 + hstep, voffA);
            PG8_WAIT_L(8); PG8_BAR; PG8_WAIT_L(0); PG8_MMA(0, 0, At, B0); PG8_BAR; PG8_SCHED;
            PG8_LDB(B1, 0, 1); PG8_STAGE(PG8_SB(0, 0), b2, voffB);
            PG8_BAR; PG8_WAIT_L(0); PG8_MMA(0, 1, At, B1); PG8_BAR;
            PG8_LDA(At, 0, 1); PG8_STAGE(PG8_SA(0, 0), a2, voffA);
            PG8_BAR; PG8_WAIT_L(0); PG8_MMA(1, 0, At, B0); PG8_BAR; PG8_SCHED;
            PG8_STAGE(PG8_SB(0, 1), b2 + hstep, voffB);
            PG8_WAIT_V(6); PG8_BAR; PG8_MMA(1, 1, At, B1); PG8_BAR;
            PG8_LDB(B0, 1, 0); PG8_SCHED; PG8_LDA(At, 1, 0); PG8_STAGE(PG8_SA(0, 1), a2 + hstep, voffA);
            PG8_WAIT_L(8); PG8_BAR; PG8_WAIT_L(0); PG8_MMA(0, 0, At, B0); PG8_BAR; PG8_SCHED;
            PG8_LDB(B1, 1, 1); PG8_STAGE(PG8_SB(1, 0), b3, voffB);
            PG8_BAR; PG8_WAIT_L(0); PG8_MMA(0, 1, At, B1); PG8_BAR;
            PG8_LDA(At, 1, 1); PG8_STAGE(PG8_SA(1, 0), a3, voffA);
            PG8_BAR; PG8_WAIT_L(0); PG8_MMA(1, 0, At, B0); PG8_BAR; PG8_SCHED;
            PG8_STAGE(PG8_SB(1, 1), b3 + hstep, voffB);
            PG8_WAIT_V(6); PG8_BAR; PG8_MMA(1, 1, At, B1); PG8_BAR;
            }
        }
        } else {
        for (int t = 0; t < nt; t += 2) {
            const bool last = (t == nt - 2);
            const char* a1 = cA + (size_t)(t + 1) * kstep;
            const char* a2 = last ? nA : cA + (size_t)(t + 2) * kstep; const char* b2 = last ? nB : cB + (size_t)(t + 2) * kstep;
            const char* a3 = a2 + kstep; const char* b3 = b2 + kstep;
            if (last && has_next) S.a_ready(nxt);
            if constexpr (SP2) {
            PG8_LDB(B0, 0, 0); PG8_LDB(B1, 0, 1); PG8_SCHED; PG8_LDA(At, 0, 0); PG8_STAGE(PG8_SA(1, 1), a1 + hstep, voffA);
            PG8_WAIT_V(8); PG8_WAIT_L(0); PG8_BAR; PG8_MMA(0, 0, At, B0); PG8_MMA(0, 1, At, B1); PG8_BAR; PG8_SCHED;
            PG8_LDA(At, 0, 1); PG8_STAGE(PG8_SB(0, 0), b2, voffB); PG8_STAGE(PG8_SB(0, 1), b2 + hstep, voffB); PG8_STAGE(PG8_SA(0, 0), a2, voffA);
            PG8_WAIT_V(8); PG8_WAIT_L(0); PG8_BAR; PG8_MMA(1, 0, At, B0); PG8_MMA(1, 1, At, B1); PG8_BAR; PG8_SCHED;
            PG8_LDB(B0, 1, 0); PG8_LDB(B1, 1, 1); PG8_SCHED; PG8_LDA(At, 1, 0); PG8_STAGE(PG8_SA(0, 1), a2 + hstep, voffA);
            PG8_WAIT_V(8); PG8_WAIT_L(0); PG8_BAR; PG8_MMA(0, 0, At, B0); PG8_MMA(0, 1, At, B1); PG8_BAR; PG8_SCHED;
            PG8_LDA(At, 1, 1); PG8_STAGE(PG8_SB(1, 0), b3, voffB); PG8_STAGE(PG8_SB(1, 1), b3 + hstep, voffB); PG8_STAGE(PG8_SA(1, 0), a3, voffA);
            PG8_WAIT_V(8); PG8_WAIT_L(0); PG8_BAR; PG8_MMA(1, 0, At, B0); PG8_MMA(1, 1, At, B1); PG8_BAR; PG8_SCHED;
            } else {
            PG8_LDB(B0, 0, 0); PG8_SCHED; PG8_LDA(At, 0, 0); PG8_STAGE(PG8_SA(1, 1), a1 + hstep, voffA);
            PG8_WAIT_L(8); PG8_BAR; PG8_WAIT_L(0); PG8_MMA(0, 0, At, B0); PG8_BAR; PG8_SCHED;
            PG8_LDB(B1, 0, 1); PG8_STAGE(PG8_SB(0, 0), b2, voffB);
            PG8_BAR; PG8_WAIT_L(0); PG8_MMA(0, 1, At, B1); PG8_BAR;
            PG8_LDA(At, 0, 1); PG8_STAGE(PG8_SA(0, 0), a2, voffA);
            PG8_BAR; PG8_WAIT_L(0); PG8_MMA(1, 0, At, B0); PG8_BAR; PG8_SCHED;
            PG8_STAGE(PG8_SB(0, 1), b2 + hstep, voffB);
            PG8_WAIT_V(6); PG8_BAR; PG8_MMA(1, 1, At, B1); PG8_BAR;
            PG8_LDB(B0, 1, 0); PG8_SCHED; PG8_LDA(At, 1, 0); PG8_STAGE(PG8_SA(0, 1), a2 + hstep, voffA);
            PG8_WAIT_L(8); PG8_BAR; PG8_WAIT_L(0); PG8_MMA(0, 0, At, B0); PG8_BAR; PG8_SCHED;
            PG8_LDB(B1, 1, 1); PG8_STAGE(PG8_SB(1, 0), b3, voffB);
            PG8_BAR; PG8_WAIT_L(0); PG8_MMA(0, 1, At, B1); PG8_BAR;
            PG8_LDA(At, 1, 1); PG8_STAGE(PG8_SA(1, 0), a3, voffA);
            PG8_BAR; PG8_WAIT_L(0); PG8_MMA(1, 0, At, B0); PG8_BAR; PG8_SCHED;
            PG8_STAGE(PG8_SB(1, 1), b3 + hstep, voffB);
            PG8_WAIT_V(6); PG8_BAR; PG8_MMA(1, 1, At, B1); PG8_BAR;
            }
        }
        }
        if constexpr (ALIGN_EPI) { if (wr == 0) PG8_BAR; }
        if constexpr (!Epi::AFTER_DRAIN) { E(acc, cur, wr, wc, fr, fq); S.done(cur);
#if PG8_EPI_DRAIN
            PG8_WAIT_V(0);
#endif
        }
        if (!has_next) break;
#pragma unroll
        for (int a = 0; a < 2; ++a)
#pragma unroll
            for (int b = 0; b < 2; ++b)
#pragma unroll
                for (int m = 0; m < 4; ++m)
#pragma unroll
                    for (int n = 0; n < 2; ++n) acc[a][b][m][n] = (f32x4){0.f, 0.f, 0.f, 0.f};
        cur = nxt; cA = nA; cB = nB; ++ui;
        if constexpr (ALIGN_EPI) { if (wr == 1) PG8_BAR; }
    }
    PG8_WAIT_V(0);
    if constexpr (!ALIGN_EPI) { if (wr == 0) PG8_BAR; }
    PG8_BAR;
    if constexpr (Epi::AFTER_DRAIN) { E.fused(acc, cur, wr, wc, fr, fq, lds, wid, lane); S.done(cur); }
#undef PG8_SA
#undef PG8_SB
#undef PG8_STAGE
#undef PG8_LDA
#undef PG8_LDB
#undef PG8_MMA
#undef PG8_WAIT_V
#undef PG8_WAIT_L
#undef PG8_BAR
#undef PG8_SCHED
}
}

#include <hip/hip_bf16.h>
#include <cmath>
namespace attn_body {
using bf16=__hip_bfloat16;
using bf16x8=__attribute__((ext_vector_type(8)))short;
using s16x4=__attribute__((ext_vector_type(4)))short;
using f32x16=__attribute__((ext_vector_type(16)))float;
using u32x4=__attribute__((ext_vector_type(4)))unsigned;
typedef float f32x4_t __attribute__((ext_vector_type(4)));
constexpr int BATCH=8,NHEAD=8,SEQ=4096,D=64,DM=NHEAD*D;
constexpr int NW=8,QBLK=32,QB=QBLK*NW,KVBLK=64,NQB=SEQ/QB;
constexpr int ATTN_PITCH=DM, ATTN_UNIT_ROWS=QB, OPITCH=1024;
__device__ __forceinline__ int crow(int r,int hi){return (r&3)+8*(r>>2)+4*hi;}
#define SBAR() __builtin_amdgcn_sched_barrier(0)
__device__ __forceinline__ void cmask(f32x16&p0,f32x16&p1,int jb,int qrel,int hi){
  const float NEG=-INFINITY; int kb=64*jb+4*hi;
  #pragma unroll
  for(int r=0;r<16;++r){int kv=kb+(r&3)+8*(r>>2); if(kv>qrel)p0[r]=NEG; if(kv+32>qrel)p1[r]=NEG;}
}

constexpr int NSLOT=3, SLOTB=8192;
constexpr int LDS_K=0, LDS_V=NSLOT*SLOTB, LDS_WS=2*NSLOT*SLOTB, LDS_OST=LDS_WS+NW*64*4, LDS_KM=LDS_OST+NW*4096, LDS_BYTES=LDS_KM+4096;
constexpr float C2=0.125f*1.4426950408889634f;
__device__ __forceinline__ void glds16(const void*gsrc,unsigned lds_dst){unsigned keep;
  asm volatile("s_mov_b32 %0, m0\n\ts_mov_b32 m0, %2\n\ts_nop 0\n\tglobal_load_lds_dwordx4 %1, off\n\ts_mov_b32 m0, %0":"=&s"(keep):"v"(gsrc),"s"(lds_dst):"memory");}
__device__ __forceinline__ float max3f(float a,float b,float c){float r;asm("v_max3_f32 %0, %1, %2, %3":"=v"(r):"v"(a),"v"(b),"v"(c));return r;}
__device__ __forceinline__ float max2f(float a,float b){float r;asm("v_max_f32_e32 %0, %1, %2":"=v"(r):"v"(a),"v"(b));return r;}
__device__ __forceinline__ float fadd_s(float a,float b){float r;asm("v_add_f32_e32 %0, %1, %2":"=v"(r):"v"(a),"v"(b));return r;}
__device__ __forceinline__ float fsub_s(float a,float b){float r;asm("v_sub_f32_e32 %0, %1, %2":"=v"(r):"v"(a),"v"(b));return r;}
typedef float f32x2_t __attribute__((ext_vector_type(2))); typedef __bf16 bf16x2_t __attribute__((ext_vector_type(2)));
__device__ __forceinline__ unsigned cvtpk_s(float lo,float hi){f32x2_t v={lo,hi};bf16x2_t b=__builtin_convertvector(v,bf16x2_t);return __builtin_bit_cast(unsigned,b);}
#define WAIT_BAR(N) asm volatile("s_waitcnt vmcnt(" #N ") lgkmcnt(0)\n\ts_barrier":::"memory")

__device__ __forceinline__ void qkt(f32x16&p0,f32x16&p1,const char*Kslot,const bf16x8*qr,int r32,int hi){
  const char*kb=Kslot+hi*1024+r32*16;
  #pragma unroll
  for(int d0=0;d0<4;++d0){
    const bf16x8 b0=*reinterpret_cast<const bf16x8*>(kb+d0*2048);
    const bf16x8 b1=*reinterpret_cast<const bf16x8*>(kb+d0*2048+512);
    p0=__builtin_amdgcn_mfma_f32_32x32x16_bf16(b0,qr[d0],p0,0,0,0);p1=__builtin_amdgcn_mfma_f32_32x32x16_bf16(b1,qr[d0],p1,0,0,0);}
}
typedef __attribute__((address_space(3))) const char* lds_cptr;
typedef short v4i16_t __attribute__((ext_vector_type(4)));
__device__ __forceinline__ void kload8(bf16x8*kf,lds_cptr kp){
  kf[0]=*(const __attribute__((address_space(3))) bf16x8*)(kp);      kf[1]=*(const __attribute__((address_space(3))) bf16x8*)(kp+512);
  kf[2]=*(const __attribute__((address_space(3))) bf16x8*)(kp+2048); kf[3]=*(const __attribute__((address_space(3))) bf16x8*)(kp+2560);
  kf[4]=*(const __attribute__((address_space(3))) bf16x8*)(kp+4096); kf[5]=*(const __attribute__((address_space(3))) bf16x8*)(kp+4608);
  kf[6]=*(const __attribute__((address_space(3))) bf16x8*)(kp+6144); kf[7]=*(const __attribute__((address_space(3))) bf16x8*)(kp+6656);
}
__device__ __forceinline__ void kload2(bf16x8*kf,lds_cptr kp,int j){ kf[2*j]=*(const __attribute__((address_space(3))) bf16x8*)(kp+j*2048); kf[2*j+1]=*(const __attribute__((address_space(3))) bf16x8*)(kp+j*2048+512); }
__device__ __forceinline__ s16x4 vtr(lds_cptr p){ return __builtin_bit_cast(s16x4,__builtin_amdgcn_ds_read_tr16_b64_v4i16((__attribute__((address_space(3))) v4i16_t*)p)); }
__device__ __forceinline__ float rowmax(const f32x16&p0,const f32x16&p1){
  float a=max3f(p0[0],p0[1],p1[0]),b=max3f(p0[2],p0[3],p1[1]);a=max3f(a,p1[2],p1[3]);
  #pragma unroll
  for(int r=4;r<16;r+=4){a=max3f(a,p0[r],p0[r+1]);b=max3f(b,p0[r+2],p0[r+3]);a=max3f(a,p1[r],p1[r+1]);b=max3f(b,p1[r+2],p1[r+3]);}
  const float m=max2f(a,b);
  auto rr=__builtin_amdgcn_permlane32_swap(__float_as_uint(m),__float_as_uint(m),false,false);
  return max2f(__uint_as_float(rr[0]),__uint_as_float(rr[1]));
}
__device__ __forceinline__ void pv(f32x16*o,int vb,bf16x8 pa0,bf16x8 pa1,bf16x8 pa2,bf16x8 pa3){
  #pragma unroll
  for(int d0=0;d0<2;++d0){s16x4 lo[4],hi[4];
    #pragma unroll
    for(int ks=0;ks<4;++ks){
      asm volatile("ds_read_b64_tr_b16 %0,%1 offset:%c2":"=&v"(lo[ks]):"v"(vb),"i"(d0*4096+ks*1024):"memory");
      asm volatile("ds_read_b64_tr_b16 %0,%1 offset:%c2":"=&v"(hi[ks]):"v"(vb),"i"(d0*4096+ks*1024+512):"memory");}
    asm volatile("s_waitcnt lgkmcnt(0)":::"memory");SBAR();
    #define PK(k) (bf16x8){lo[k][0],lo[k][1],lo[k][2],lo[k][3],hi[k][0],hi[k][1],hi[k][2],hi[k][3]}
    o[d0]=__builtin_amdgcn_mfma_f32_32x32x16_bf16(pa0,PK(0),o[d0],0,0,0);
    o[d0]=__builtin_amdgcn_mfma_f32_32x32x16_bf16(pa1,PK(1),o[d0],0,0,0);
    o[d0]=__builtin_amdgcn_mfma_f32_32x32x16_bf16(pa2,PK(2),o[d0],0,0,0);
    o[d0]=__builtin_amdgcn_mfma_f32_32x32x16_bf16(pa3,PK(3),o[d0],0,0,0);
    #undef PK
  }
}

#ifndef ATTN_STORE16
#define ATTN_STORE16(p,v) __builtin_amdgcn_raw_buffer_store_b128((v),orsrc_,(unsigned)((const char*)(p)-(const char*)O),0,16)
#endif
template<int THRL> __device__ __forceinline__ void attn_unit(int b,int h,int qb,const bf16*Q,const bf16*__restrict__ K,const bf16*__restrict__ V,bf16*O,const float*kmean,char*shm){
  const int tid=threadIdx.x,lane=tid&63,r32=lane&31,hi=lane>>5; const int wid=__builtin_amdgcn_readfirstlane(tid>>6);
  const long rowbase=(long)b*SEQ; const int q0=qb*QB;
  const bf16*Qw=Q+(rowbase+q0+wid*QBLK)*DM+h*D;
  const bf16*Kh=K+rowbase*DM+h*D,*Vh=V+rowbase*DM+h*D;
  const unsigned lds0=(unsigned)(uintptr_t)shm;
  float*wsf=(float*)(shm+LDS_WS)+wid*64;
  const bf16*ksrc=Kh+(long)lane*DM+wid*8;
  const bf16*vsrc=Vh+(long)(16*(wid&3)+(lane>>2))*DM+(wid>>2)*32+(lane&3)*8;
  const unsigned kdst=lds0+LDS_K+wid*1024, vdst=lds0+LDS_V+wid*1024;
  #define POS(t) (((t)<4)?(NT-4+(t)):((t)-4))
  #define DMA_K(t,slot) glds16(ksrc+(long)POS(t)*KVBLK*DM,(unsigned)__builtin_amdgcn_readfirstlane(kdst+(slot)))
  #define DMA_V(t,slot) glds16(vsrc+(long)POS(t)*KVBLK*DM,(unsigned)__builtin_amdgcn_readfirstlane(vdst+(slot)))
  const int vb0=(int)(lds0+LDS_V)+((lane>>4)&1)*32+(lane&3)*8+(4*hi+((lane&15)>>2))*64;
  const char*Kbase=shm+LDS_K; bf16x8 kf[8];
  const lds_cptr shm3=(lds_cptr)shm; const lds_cptr kp0=shm3+LDS_K+hi*1024+r32*16; const lds_cptr vp0=shm3+LDS_V+((lane>>4)&1)*32+(lane&3)*8+(4*hi+((lane&15)>>2))*64;
  const int NT=(q0+QB)/KVBLK;
  DMA_K(0,0);DMA_V(0,0);DMA_K(1,SLOTB);
  bf16x8 qr[4];
  #pragma unroll
  for(int d0=0;d0<4;++d0)qr[d0]=*reinterpret_cast<const bf16x8*>(&Qw[(long)r32*DM+d0*16+hi*8]);
  float mhat=0.f,l_reg=0.f;f32x16 o[2];o[0]=f32x16{};o[1]=f32x16{};
  const float slope2=ldexpf(1.4426950408889634f,-(h+1));
  unsigned selmask=0u;
  { typedef __attribute__((address_space(3))) float* lds_fptr; typedef __attribute__((address_space(3))) const f32x4_t* lds_f4ptr;
    lds_fptr kml=(lds_fptr)((lds_cptr)shm+LDS_KM);
    { const float*src=kmean+((long)b*16)*2*DM+h*D;
      #pragma unroll
      for(int i=0;i<2;++i){const int e=tid+512*i; kml[e]=src[(e>>6)*2*DM+(e&63)]+src[(e>>6)*2*DM+DM+(e&63)];} }
    asm volatile("s_waitcnt vmcnt(0) lgkmcnt(0)\n\ts_barrier":::"memory");
    float qf[32];
    #pragma unroll
    for(int d0=0;d0<4;++d0){
      #pragma unroll
      for(int j=0;j<8;++j)qf[d0*8+j]=__uint_as_float(((unsigned)(unsigned short)qr[d0][j])<<16);}
    float sc[16];
    #pragma unroll
    for(int j=0;j<16;++j){ sc[j]=-INFINITY;
      if(j<qb){ lds_f4ptr kr=(lds_f4ptr)(kml+j*64+hi*8); float a=0.f;
        #pragma unroll
        for(int d0=0;d0<4;++d0){ const f32x4_t k0=kr[d0*4],k1=kr[d0*4+1];
          a+=qf[d0*8+0]*k0[0]+qf[d0*8+1]*k0[1]+qf[d0*8+2]*k0[2]+qf[d0*8+3]*k0[3]+qf[d0*8+4]*k1[0]+qf[d0*8+5]*k1[1]+qf[d0*8+6]*k1[2]+qf[d0*8+7]*k1[3]; }
        a+=__shfl_xor(a,32); sc[j]=a; } }
    #pragma unroll
    for(int j=0;j<15;++j){ int cnt=0;
      #pragma unroll
      for(int k=0;k<15;++k){ if(k!=j) cnt+=((sc[k]>sc[j])||((sc[k]==sc[j])&&(k<j)))?1:0; }
      if(j<qb&&cnt<3) selmask|=(1u<<j); } }
  #define CINIT(C0,C1,t) do{ const int pt_=POS(t); float x_=slope2*(float)(64*pt_-q0+4*hi)-mhat; \
    if((t)>=4){ x_+=((selmask>>(pt_>>2))&1u)?0.f:-30000.f; } const float y_=x_+32.f*slope2; \
    _Pragma("unroll") for(int r=0;r<16;++r){ const float cr_=(float)((r&3)+8*(r>>2)); C0[r]=__builtin_fmaf(slope2,cr_,x_); C1[r]=__builtin_fmaf(slope2,cr_,y_); } }while(0)

  const int qrel=wid*QBLK+r32;
  #define CMASK(P0,P1,t) do{ if((t)<4)cmask(P0,P1,(t),qrel,hi);}while(0)
  bool resc=false;
  #define START(P0,P1) do{ const float rm=rowmax(P0,P1); resc=false; \
    { const float dl=rm; mhat=fadd_s(mhat,dl); \
      _Pragma("unroll") for(int r=0;r<16;++r){P0[r]=fsub_s(P0[r],dl);P1[r]=fsub_s(P1[r],dl);} } \
    _Pragma("unroll") for(int r=0;r<16;++r)P0[r]=__builtin_amdgcn_exp2f(P0[r]); }while(0)
  #define RESC() do{ if(resc){ asm volatile("s_waitcnt lgkmcnt(0)":::"memory"); \
      _Pragma("unroll") for(int d_=0;d_<2;++d_) _Pragma("unroll") for(int r=0;r<16;++r)o[d_][r]*=wsf[crow(r,hi)]; } }while(0)
  f32x16 pA0,pA1,pB0,pB1;
  int sl_prev=0,sl_cur=0,sl_next=SLOTB;
  #define ROT() do{sl_prev=sl_cur;sl_cur=sl_next;sl_next=(sl_next==(NSLOT-1)*SLOTB)?0:sl_next+SLOTB;}while(0)
  DMA_K(2,2*SLOTB);
  WAIT_BAR(3);
  CINIT(pA0,pA1,0); qkt(pA0,pA1,Kbase,qr,r32,hi);asm volatile("s_nop 15\n\ts_nop 7":"+v"(pA0),"+v"(pA1));CMASK(pA0,pA1,0);
  START(pA0,pA1);
  _Pragma("unroll") for(int r=0;r<16;++r)pA1[r]=__builtin_amdgcn_exp2f(pA1[r]);
  WAIT_BAR(0);
  DMA_K(3,0);DMA_V(1,SLOTB);
  ROT();
  kload8(kf,kp0+sl_cur);
  WAIT_BAR(2);
  s16x4 vlo[8],vhi[8]; u32x4 pw0,pw1,pw2,pw3;
  #define PKW(P,B) cvtpk_s(P[B],P[B+1])
  #define PAF(k) __builtin_bit_cast(bf16x8,pw##k)
  #define VFR(i) (bf16x8){vlo[i][0],vlo[i][1],vlo[i][2],vlo[i][3],vhi[i][0],vhi[i][1],vhi[i][2],vhi[i][3]}
  #define PIN(x) asm volatile("":"+v"(x))
  #define MX3(a,b,c) __builtin_fmaxf(__builtin_fmaxf((a),(b)),(c))
  #define GAPA(MF,A0,A1,A2,A3,W0,W1,PW) do{ MF; sacc+=A0; sacc+=A1; sacc+=A2; sacc+=A3; PIN(sacc); W0; W1; PIN(PW); SBAR(); }while(0)
  #define EX(v) __builtin_amdgcn_exp2f(v)
  #define GAPB(MF,X,B) do{ MF; X[B]=EX(X[B]); X[B+1]=EX(X[B+1]); X[B+2]=EX(X[B+2]); X[B+3]=EX(X[B+3]); PIN(X); SBAR(); }while(0)
  #define VRD(i) do{ vlo[i]=vtr(vp_+(((i)>>2)*4096+((i)&3)*1024)); vhi[i]=vtr(vp_+(((i)>>2)*4096+((i)&3)*1024+512)); }while(0)
  #define KRD(G,j) do{ if(G){ kload2(kf,kp0+sl_next,j); SBAR(); } }while(0)
  #define STEP(C0,C1,P0,P1,t,GK,GV,GL) do{ SBAR(); CINIT(C0,C1,t); PIN(C0); PIN(C1); SBAR(); \
    const lds_cptr vp_=vp0+sl_prev; \
    VRD(0); SBAR(); float sacc=(P0[0]+P0[1]); \
    GAPA(C0=__builtin_amdgcn_mfma_f32_32x32x16_bf16(kf[0],qr[0],C0,0,0,0), P0[2],P0[3],P0[4],P0[5],     pw0[0]=PKW(P0,0), pw0[1]=PKW(P0,2), pw0); \
    VRD(4); SBAR(); GAPA(C1=__builtin_amdgcn_mfma_f32_32x32x16_bf16(kf[1],qr[0],C1,0,0,0), P0[6],P0[7],P0[8],P0[9],     pw0[2]=PKW(P0,4), pw0[3]=PKW(P0,6), pw0); \
    VRD(1); SBAR(); GAPA(C0=__builtin_amdgcn_mfma_f32_32x32x16_bf16(kf[2],qr[1],C0,0,0,0),   P0[10],P0[11],P0[12],P0[13], pw1[0]=PKW(P0,8), pw1[1]=PKW(P0,10), pw1); \
    VRD(5); SBAR(); GAPA(C1=__builtin_amdgcn_mfma_f32_32x32x16_bf16(kf[3],qr[1],C1,0,0,0),   P0[14],P0[15],P1[0],P1[1],   pw1[2]=PKW(P0,12),pw1[3]=PKW(P0,14), pw1); \
    VRD(2); SBAR(); GAPA(C0=__builtin_amdgcn_mfma_f32_32x32x16_bf16(kf[4],qr[2],C0,0,0,0),   P1[2],P1[3],P1[4],P1[5],     pw2[0]=PKW(P1,0), pw2[1]=PKW(P1,2), pw2); \
    VRD(6); SBAR(); GAPA(C1=__builtin_amdgcn_mfma_f32_32x32x16_bf16(kf[5],qr[2],C1,0,0,0),   P1[6],P1[7],P1[8],P1[9],     pw2[2]=PKW(P1,4), pw2[3]=PKW(P1,6), pw2); \
    VRD(3); SBAR(); GAPA(C0=__builtin_amdgcn_mfma_f32_32x32x16_bf16(kf[6],qr[3],C0,0,0,0),   P1[10],P1[11],P1[12],P1[13], pw3[0]=PKW(P1,8), pw3[1]=PKW(P1,10), pw3); \
    VRD(7); SBAR(); GAPA(C1=__builtin_amdgcn_mfma_f32_32x32x16_bf16(kf[7],qr[3],C1,0,0,0),   P1[14],P1[15],0.f,0.f,       pw3[2]=PKW(P1,12),pw3[3]=PKW(P1,14), pw3); \
    l_reg+=sacc; \
    if(GK){DMA_K((t)+3,sl_cur);} if(GV){DMA_V((t)+1,sl_next);} \
    CMASK(C0,C1,t); \
    { float a=MX3(C0[0],C0[1],C1[0]),b=MX3(C0[2],C0[3],C1[1]); a=MX3(a,C1[2],C1[3]); \
      _Pragma("unroll") for(int r=4;r<16;r+=4){a=MX3(a,C0[r],C0[r+1]);b=MX3(b,C0[r+2],C0[r+3]);a=MX3(a,C1[r],C1[r+1]);b=MX3(b,C1[r+2],C1[r+3]);} \
      float rm=__builtin_fmaxf(a,b); { auto rr=__builtin_amdgcn_permlane32_swap(__float_as_uint(rm),__float_as_uint(rm),false,false); rm=__builtin_fmaxf(__uint_as_float(rr[0]),__uint_as_float(rr[1])); } \
      resc=false; \
      if(__builtin_expect(__any(rm>(float)THRL),0)){ const float dl=__builtin_fmaxf(rm,0.f); mhat+=dl; \
        _Pragma("unroll") for(int r=0;r<16;++r){C0[r]-=dl;C1[r]-=dl;} \
        const float f=__builtin_amdgcn_exp2f(-dl); l_reg*=f; if(hi==0)wsf[r32]=f; resc=true; } } \
    SBAR(); \
    GAPB(o[0]=__builtin_amdgcn_mfma_f32_32x32x16_bf16(PAF(0),VFR(0),o[0],0,0,0), C0,0); \
    GAPB(o[1]=__builtin_amdgcn_mfma_f32_32x32x16_bf16(PAF(0),VFR(4),o[1],0,0,0), C0,4); \
    KRD(GL,0); GAPB(o[0]=__builtin_amdgcn_mfma_f32_32x32x16_bf16(PAF(1),VFR(1),o[0],0,0,0), C0,8); \
    KRD(GL,1); GAPB(o[1]=__builtin_amdgcn_mfma_f32_32x32x16_bf16(PAF(1),VFR(5),o[1],0,0,0), C0,12); \
    KRD(GL,2); GAPB(o[0]=__builtin_amdgcn_mfma_f32_32x32x16_bf16(PAF(2),VFR(2),o[0],0,0,0), C1,0); \
    KRD(GL,3); GAPB(o[1]=__builtin_amdgcn_mfma_f32_32x32x16_bf16(PAF(2),VFR(6),o[1],0,0,0), C1,4); \
    GAPB(o[0]=__builtin_amdgcn_mfma_f32_32x32x16_bf16(PAF(3),VFR(3),o[0],0,0,0), C1,8); \
    GAPB(o[1]=__builtin_amdgcn_mfma_f32_32x32x16_bf16(PAF(3),VFR(7),o[1],0,0,0), C1,12); \
    }while(0)
  int t=1;
  #define ENDW(tt) do{ if((tt)+3<NT){WAIT_BAR(2);} else if((tt)+2<NT){WAIT_BAR(1);} else {WAIT_BAR(0);} }while(0)
  for(;t<5&&t+1<NT;t+=2){
    STEP(pB0,pB1,pA0,pA1,t,(t+3<NT),(t+1<NT),(t+1<NT));       ENDW(t);   RESC(); ROT();
    STEP(pA0,pA1,pB0,pB1,t+1,(t+4<NT),(t+2<NT),(t+2<NT));     ENDW(t+1); RESC(); ROT();
  }
  #undef CMASK
  #define CMASK(P0,P1,t) do{}while(0)
  for(;t+5<NT;t+=2){
    STEP(pB0,pB1,pA0,pA1,t,true,true,true);     WAIT_BAR(2); RESC(); ROT();
    STEP(pA0,pA1,pB0,pB1,t+1,true,true,true);   WAIT_BAR(2); RESC(); ROT();
  }
  for(;t+1<NT;t+=2){
    STEP(pB0,pB1,pA0,pA1,t,(t+3<NT),(t+1<NT),(t+1<NT));       ENDW(t);   RESC(); ROT();
    STEP(pA0,pA1,pB0,pB1,t+1,(t+4<NT),(t+2<NT),(t+2<NT));     ENDW(t+1); RESC(); ROT();
  }
  #undef CMASK
  #define CMASK(P0,P1,t) do{ if((t)<4)cmask(P0,P1,(t),qrel,hi);}while(0)
  STEP(pB0,pB1,pA0,pA1,NT-1,false,false,false); RESC();
  { float sacc=pB0[0]+pB0[1]; _Pragma("unroll") for(int r=2;r<16;++r)sacc+=pB0[r]; _Pragma("unroll") for(int r=0;r<16;++r)sacc+=pB1[r]; l_reg+=sacc;
    pw0=(u32x4){PKW(pB0,0),PKW(pB0,2),PKW(pB0,4),PKW(pB0,6)};pw1=(u32x4){PKW(pB0,8),PKW(pB0,10),PKW(pB0,12),PKW(pB0,14)};pw2=(u32x4){PKW(pB1,0),PKW(pB1,2),PKW(pB1,4),PKW(pB1,6)};pw3=(u32x4){PKW(pB1,8),PKW(pB1,10),PKW(pB1,12),PKW(pB1,14)};
    SBAR(); pv(o,vb0+sl_cur,PAF(0),PAF(1),PAF(2),PAF(3)); }
  #undef PKW
  #undef PAF
  #undef VFR
  #undef PIN
  #undef MX3
  #undef GAPA
  #undef GAPB
  #undef EX
  #undef VRD
  #undef KRD
  #undef STEP
  #undef ENDW
  {auto rr=__builtin_amdgcn_permlane32_swap(__float_as_uint(l_reg),__float_as_uint(l_reg),false,false);l_reg=__uint_as_float(rr[0])+__uint_as_float(rr[1]);}
  if(hi==0)wsf[32+r32]=l_reg;asm volatile("s_waitcnt lgkmcnt(0)":::"memory");
  float rli[16];
  #pragma unroll
  for(int r=0;r<16;++r)rli[r]=__builtin_amdgcn_rcpf(wsf[32+crow(r,hi)]);
  bf16*Ow=O+(rowbase+q0+wid*QBLK)*OPITCH+h*D; const __amdgpu_buffer_rsrc_t orsrc_=__builtin_amdgcn_make_buffer_rsrc((void*)O,0,0x7fffffff,0x00020000);
  { bf16*stg=(bf16*)(shm+LDS_OST)+wid*2048;
    #pragma unroll
    for(int r=0;r<16;++r){const int orow=crow(r,hi);
      #pragma unroll
      for(int d0=0;d0<2;++d0)stg[orow*64+d0*32+r32]=__float2bfloat16(o[d0][r]*rli[r]);}
    asm volatile("s_waitcnt lgkmcnt(0)":::"memory");
    #pragma unroll
    for(int i=0;i<4;++i){const int row=i*8+(lane>>3),ch=lane&7; const u32x4 v=*(const u32x4*)(stg+row*64+ch*8); ATTN_STORE16(Ow+(long)row*OPITCH+ch*8,v);} }
  asm volatile("s_waitcnt lgkmcnt(0)\n\ts_barrier":::"memory");
  #undef DMA_K
  #undef DMA_V
  #undef POS
  #undef CINIT
  #undef CMASK
  #undef START
  #undef RESC
  #undef ROT
}
constexpr int ATTN_LDS_BYTES=LDS_BYTES;
struct AttnTensors { const bf16* Q; const bf16* K; const bf16* V; bf16* O; const float* kmean; };
struct AttnUnit { int bh; int qb; };
struct StaticOrder {
  int vcu,grid;
  __device__ __forceinline__ explicit StaticOrder(int grid_,int block):vcu((grid_%8==0)?((block%8)*(grid_/8)+block/8):block),grid(grid_){}
  __device__ __forceinline__ bool next(int i,AttnUnit&u)const{ const int item=(i>>1)*grid+vcu; if(item>=BATCH*NHEAD*8)return false; const int s=item&7; u.bh=item>>3; u.qb=(i&1)?15-s:s; return true; }
  __device__ __forceinline__ void a_ready(const AttnUnit&)const{}
  __device__ __forceinline__ void done(const AttnUnit&)const{}
};
template<class Sched,int THRL=8> __device__ __forceinline__ void attn_phase(char*lds,const AttnTensors&T,const Sched&S){
  AttnUnit u;
  for(int i=0;S.next(i,u);++i){ S.a_ready(u); attn_unit<THRL>(u.bh/NHEAD,u.bh%NHEAD,u.qb,T.Q,T.K,T.V,T.O,T.kmean,lds); S.done(u); }
}
#undef SBAR
#undef WAIT_BAR
}

constexpr int NWAVES = 8;
#ifndef MK_N_LAUNCHES
#define MK_N_LAUNCHES 1
#endif
constexpr int N_LAUNCHES = MK_N_LAUNCHES;
constexpr int PER_PHASE = 8;

constexpr int BATCH = 8, SEQ = 4096, DM = 1024, TOK = BATCH * SEQ;
constexpr int CONV_CH = 512, CONV_W = 31, ATT_W = 512, IN_COLS = 4608;
constexpr int P_HEADS = 8, P_NK = 128, P_TOPK = 16, P_E = P_HEADS * P_TOPK  , N_EXP = P_NK * P_NK;
constexpr float NORM_EPS = 1e-6f;

constexpr size_t MiB = 1u << 20;
constexpr size_t WS_CTL = 0, CTL_ZERO_BYTES = 65536;
constexpr size_t WS_KMEAN = 1 * MiB;
constexpr size_t WS_SS = 2 * MiB;
constexpr size_t WS_WIN = 4 * MiB;
constexpr size_t WS_WPW = 13 * MiB, WS_WAO = 14 * MiB;
constexpr size_t WS_WOUT = 15 * MiB;
constexpr size_t WS_WQ = 17 * MiB;
constexpr size_t WS_KEYS = 21 * MiB;
constexpr size_t WS_USC = 22 * MiB, WS_VSC = 22 * MiB + 65536;
constexpr size_t WS_UB = 24 * MiB, WS_VB = 56 * MiB;
constexpr size_t WS_H = 88 * MiB;
constexpr size_t WS_CACT = 88 * MiB;
constexpr size_t WS_EIDX = 104 * MiB, WS_GW = 120 * MiB, WS_GA = 136 * MiB;
constexpr size_t WS_ZGLU = 152 * MiB, WS_QO = 184 * MiB, WS_K = 216 * MiB, WS_V = 248 * MiB;
constexpr size_t WS_MIX = 216 * MiB;
constexpr size_t WS_QP = 152 * MiB;
constexpr size_t WS_X2B = 184 * MiB;
constexpr size_t WS_COEF = 152 * MiB, WS_SS2 = 168 * MiB;
constexpr size_t WS_GC = 280 * MiB, WS_GATE_A = 344 * MiB;
constexpr size_t WS_X1B = 280 * MiB;
constexpr size_t WS_X8 = 344 * MiB, WS_XS = 377 * MiB;
constexpr size_t WS_END = 408 * MiB;
constexpr int CW_TMO = 0, CW_CODE = 1, CW_CONVQ = 64, CW_BAR = 4096;

constexpr int RING_OFF = 0, RING_BYTES = 131072;
constexpr int LDSCTL_OFF = RING_BYTES, MISC_OFF = LDSCTL_OFF + 320;
constexpr int LDS_BYTES = 155648;
constexpr int VT_PITCH = 144, VT_BYTES = 128 * VT_PITCH, VT_LAST_OFF = LDSCTL_OFF + 1024, P7_CNT_OFF = LDSCTL_OFF + 512;
static_assert(7 * VT_BYTES <= RING_BYTES && VT_LAST_OFF + VT_BYTES <= LDS_BYTES && MISC_OFF + 128 <= P7_CNT_OFF, "PEER v tiles");
constexpr float C8_SCALE = 4096.f;
static_assert(MISC_OFF + 128 <= LDS_BYTES, "LDS map");

#define GAS __attribute__((address_space(1)))
#define LAS __attribute__((address_space(3)))
typedef unsigned short bf16;
typedef unsigned v4u __attribute__((ext_vector_type(4)));
typedef float f32x4 __attribute__((ext_vector_type(4)));
typedef float f32x16 __attribute__((ext_vector_type(16)));
typedef short bf16x8 __attribute__((ext_vector_type(8)));
typedef __bf16 bf16x2_t __attribute__((ext_vector_type(2)));
typedef GAS unsigned gu32;
#define RLX_AGENT __ATOMIC_RELAXED, __HIP_MEMORY_SCOPE_AGENT
#define LDS_WAIT() asm volatile("s_waitcnt lgkmcnt(0)" ::: "memory")
#define VM_WAIT() asm volatile("s_waitcnt vmcnt(0)" ::: "memory")
__device__ __forceinline__ unsigned f2bf(float f) { unsigned u = __builtin_bit_cast(unsigned, f); return (u + 0x7fffu + ((u >> 16) & 1u)) >> 16; }
__device__ __forceinline__ unsigned pk2(float lo, float hi) { return f2bf(lo) | (f2bf(hi) << 16); }
__device__ __forceinline__ float bflo(unsigned u) { return __uint_as_float(u << 16); }
__device__ __forceinline__ float bfhi(unsigned u) { return __uint_as_float(u & 0xffff0000u); }

#define XB_TMO      128
#define XB_XCNT(j)  (256  + 64 * (j))
#define XB_XSUB(j)  (1280 + 64 * (j))
#define XB_XGEN(j)  (2304 + 64 * (j))
#define XB_TOP      3328
#define XB_TOPGEN   3392
#define XCD_BAR_WORDS 3456
#define XB_SPIN_CAP (1u << 18)

__device__ __forceinline__ unsigned xb_ld(unsigned* p)              { return __hip_atomic_load(p, __ATOMIC_RELAXED, __HIP_MEMORY_SCOPE_AGENT); }
__device__ __forceinline__ unsigned xb_add(unsigned* p, unsigned v) { return __hip_atomic_fetch_add(p, v, __ATOMIC_RELAXED, __HIP_MEMORY_SCOPE_AGENT); }
__device__ __forceinline__ unsigned xb_xcc_id() { return (unsigned)__builtin_amdgcn_s_getreg((3 << 11) | 20) & 0xFu; }
#define XB_SPIN(cond, bar) do { unsigned _sp = 0; while (cond) { __builtin_amdgcn_s_sleep(1); \
    if ((++_sp & 255u) == 0u) { if (xb_ld(&(bar)[XB_TMO])) break; if (_sp > XB_SPIN_CAP) { atomicAdd(&(bar)[XB_TMO], 1u); break; } } } } while (0)

struct XcdBarrier {
    unsigned* bar; unsigned x;
    volatile LAS unsigned* st;
};

__device__ __forceinline__ XcdBarrier xcd_barrier_post(unsigned* bar, volatile LAS unsigned* st) {
    XcdBarrier b; b.bar = bar; b.x = xb_xcc_id(); b.st = st;
    if (threadIdx.x == 0) (void)xb_add(&bar[XB_XCNT(b.x)], 1u);
    return b;
}
__device__ __forceinline__ void xcd_barrier_complete(unsigned* bar, unsigned x, unsigned& nloc, unsigned& nx) {
    const unsigned G = gridDim.x * gridDim.y * gridDim.z;
    unsigned sum, cnt, mine, sp = 0u;
    for (;;) {
        sum = 0u; cnt = 0u; mine = 0u;
#pragma unroll
        for (unsigned j = 0; j < 16; ++j) { const unsigned c = xb_ld(&bar[XB_XCNT(j)]); sum += c; cnt += (c > 0u) ? 1u : 0u; mine = (j == x) ? c : mine; }
        if (sum == G) break;
        __builtin_amdgcn_s_sleep(1);
        if ((++sp & 255u) == 0u) { if (xb_ld(&bar[XB_TMO])) break; if (sp > XB_SPIN_CAP) { atomicAdd(&bar[XB_TMO], 1u); break; } }
    }
    nloc = mine > 0u ? mine : 1u; nx = cnt > 0u ? cnt : 1u;
}

__device__ __forceinline__ void xcd_barrier(const XcdBarrier& b) {
    asm volatile("s_waitcnt vmcnt(0)" ::: "memory");
    __syncthreads();
    if (threadIdx.x == 0) {
        unsigned* bar = b.bar;
        __builtin_amdgcn_s_waitcnt(0);
        unsigned nloc = b.st[0], nx = b.st[1];
        if (nloc == 0u) { xcd_barrier_complete(bar, b.x, nloc, nx); b.st[0] = nloc; b.st[1] = nx; }
        const unsigned old = xb_add(&bar[XB_XSUB(b.x)], 1u);
        const unsigned gen = old / nloc;
        if (old + 1u == (gen + 1u) * nloc) {
            __builtin_amdgcn_fence(__ATOMIC_RELEASE, "agent");
            asm volatile("s_waitcnt vmcnt(0)" ::: "memory");
            const unsigned og = xb_add(&bar[XB_TOP], 1u);
            const unsigned tg = og / nx;
            if (og + 1u == (tg + 1u) * nx) xb_add(&bar[XB_TOPGEN], 1u);
            else XB_SPIN(xb_ld(&bar[XB_TOPGEN]) == tg, bar);
            __builtin_amdgcn_fence(__ATOMIC_ACQUIRE, "agent");
            xb_add(&bar[XB_XGEN(b.x)], 1u);
            asm volatile("s_waitcnt vmcnt(0)" ::: "memory");
        } else {
            XB_SPIN(xb_ld(&bar[XB_XGEN(b.x)]) == gen, bar);
            __builtin_amdgcn_fence(__ATOMIC_ACQUIRE, "agent");
            asm volatile("s_waitcnt vmcnt(0)" ::: "memory");
        }
    }
    __syncthreads();
}

struct Frame {
    LAS unsigned char* lds;
    volatile LAS unsigned* MISC;
    gu32* ctl;
    int tid, lane, wave;
    int vcu, G;
};
__device__ __forceinline__ float wave_sum(float v) {
#pragma unroll
    for (int o = 1; o < 64; o <<= 1) v += __shfl_xor(v, o);
    return v;
}

__device__ __forceinline__ float wave_sum_hi(float v) {
    v += __builtin_bit_cast(float, __builtin_amdgcn_update_dpp(0, __builtin_bit_cast(int, v), 0xB1, 0xf, 0xf, false));
    v += __builtin_bit_cast(float, __builtin_amdgcn_update_dpp(0, __builtin_bit_cast(int, v), 0x4E, 0xf, 0xf, false));
    v += __builtin_bit_cast(float, __builtin_amdgcn_update_dpp(0, __builtin_bit_cast(int, v), 0x141, 0xf, 0xf, false));
    v += __builtin_bit_cast(float, __builtin_amdgcn_update_dpp(0, __builtin_bit_cast(int, v), 0x140, 0xf, 0xf, false));
    v += __builtin_bit_cast(float, __builtin_amdgcn_update_dpp(0, __builtin_bit_cast(int, v), 0x142, 0xA, 0xF, false));
    v += __builtin_bit_cast(float, __builtin_amdgcn_update_dpp(0, __builtin_bit_cast(int, v), 0x143, 0xC, 0xF, false));
    return v;
}

struct P0Item { const float* W; int N; bf16* WT; int k0, n0, drow; const float* kscale; int dpitch, koff; };
__device__ __forceinline__ void p0_item_fetch(const P0Item& t, int lane, float (&v)[32]) {
#pragma unroll
    for (int i = 0; i < 32; ++i) { const int kk = 2 * i + (lane >> 5); v[i] = __builtin_nontemporal_load((const GAS float*)t.W + (size_t)(t.k0 + kk) * t.N + t.n0 + (lane & 31)); }
}
__device__ __forceinline__ void p0_item_store(const P0Item& t, int lane, const float (&v)[32], LAS float* scr) {
#pragma unroll
    for (int i = 0; i < 32; ++i) { const int kk = 2 * i + (lane >> 5); float x = v[i]; if (t.kscale) x *= t.kscale[t.k0 + kk]; scr[kk * 33 + (lane & 31)] = x; }
    LDS_WAIT(); asm volatile("" ::: "memory");
    const int c = lane & 7;
#pragma unroll
    for (int j = 0; j < 4; ++j) { const int n = (lane >> 3) + 8 * j; const LAS float* s = scr + (8 * c) * 33 + n;
        v4u o; o.x = pk2(s[0 * 33], s[1 * 33]); o.y = pk2(s[2 * 33], s[3 * 33]); o.z = pk2(s[4 * 33], s[5 * 33]); o.w = pk2(s[6 * 33], s[7 * 33]);
        *(GAS v4u*)(t.WT + (size_t)(t.drow + n) * t.dpitch + t.koff + t.k0 + 8 * c) = o; }
    LDS_WAIT(); asm volatile("" ::: "memory");
}
__device__ __forceinline__ int perm_in(int s) { if (s < 512) return 256 * (s >> 7) + (s & 127); if (s < 1024) { const int s2 = s - 512; return 256 * (s2 >> 7) + 128 + (s2 & 127); } return s; }
__device__ __forceinline__ float wave_max(float v) {
#pragma unroll
    for (int o = 1; o < 64; o <<= 1) v = fmaxf(v, __shfl_xor(v, o));
    return v;
}
template <bool NORM, int NR> __device__ __forceinline__ void rows_to_bf16(int lane, const float* xrow, size_t rstride, const float* g, bf16* orow) {
    f32x4 v[NR][4]; float s2[NR];
#pragma unroll
    for (int q = 0; q < NR; ++q) { const GAS f32x4* xr = (const GAS f32x4*)(xrow + q * rstride) + lane;
#pragma unroll
        for (int j = 0; j < 4; ++j) v[q][j] = __builtin_nontemporal_load(&xr[64 * j]); }
#pragma unroll
    for (int q = 0; q < NR; ++q) { s2[q] = 0.f;
#pragma unroll
        for (int j = 0; j < 4; ++j) s2[q] += (v[q][j].x * v[q][j].x + v[q][j].y * v[q][j].y) + (v[q][j].z * v[q][j].z + v[q][j].w * v[q][j].w); }
    float rstd[NR];
#pragma unroll
    for (int q = 0; q < NR; ++q) rstd[q] = NORM ? 1.f / sqrtf(wave_sum(s2[q]) * (1.f / 1024.f) + NORM_EPS) : 1.f;
#pragma unroll
    for (int j = 0; j < 4; ++j) { f32x4 gv = (f32x4){1.f, 1.f, 1.f, 1.f}; if (g) gv = *((const GAS f32x4*)g + lane + 64 * j);
#pragma unroll
        for (int q = 0; q < NR; ++q) { const f32x4 w = v[q][j] * rstd[q] * gv;
            ((GAS unsigned long long*)(orow + q * rstride) + lane)[64 * j] = (unsigned long long)pk2(w.x, w.y) | ((unsigned long long)pk2(w.z, w.w) << 32); } }
}
template <bool NORM> __device__ __forceinline__ void row_to_bf16(int lane, const float* xrow, const float* g, bf16* orow) { rows_to_bf16<NORM, 1>(lane, xrow, 1024, g, orow); }
template <bool SLICED> __device__ __forceinline__ void row_to_fp8(int lane, const float* xrow, const float* g, unsigned char* base, int row, float* isc) {
    const GAS f32x4* xr = (const GAS f32x4*)xrow + lane;
    f32x4 v[4]; float am = 0.f;
#pragma unroll
    for (int j = 0; j < 4; ++j) { v[j] = xr[64 * j]; if (g) v[j] = v[j] * *((const GAS f32x4*)g + lane + 64 * j);
        am = fmaxf(am, fmaxf(fmaxf(fabsf(v[j].x), fabsf(v[j].y)), fmaxf(fabsf(v[j].z), fabsf(v[j].w)))); }
#pragma unroll
    for (int o = 1; o < 64; o <<= 1) am = fmaxf(am, __shfl_xor(am, o));
    const float sc = am > 0.f ? 240.f / am : 1.f;
    if (lane == 0) isc[row] = am > 0.f ? am * (1.f / 240.f) : 1.f;
#pragma unroll
    for (int j = 0; j < 4; ++j) { int w = 0; w = __builtin_amdgcn_cvt_pk_fp8_f32(v[j].x * sc, v[j].y * sc, w, false); w = __builtin_amdgcn_cvt_pk_fp8_f32(v[j].z * sc, v[j].w * sc, w, true);
        if (SLICED) *(GAS int*)(base + (size_t)(2 * j + (lane >> 5)) * ((size_t)N_EXP * 128) + (size_t)row * 128 + 4 * (lane & 31)) = w;
        else *(GAS int*)(base + (size_t)row * 1024 + 4 * (lane + 64 * j)) = w; }
}
__device__ __forceinline__ void rows_uv_fetch(int lane, const float* urow, const float* vrow, f32x4 (&u)[4], f32x4 (&v)[4]) {
#pragma unroll
    for (int j = 0; j < 4; ++j) { u[j] = __builtin_nontemporal_load((const GAS f32x4*)urow + lane + 64 * j); v[j] = __builtin_nontemporal_load((const GAS f32x4*)vrow + lane + 64 * j); }
}
__device__ __forceinline__ void rows_to_fp8_uv(int lane, f32x4 (&u)[4], f32x4 (&v)[4], const float* g, unsigned char* ub8, unsigned char* vb8, int row, float* usc, float* vsc) {
    float au = 0.f, av = 0.f;
#pragma unroll
    for (int j = 0; j < 4; ++j) { u[j] = u[j] * *((const GAS f32x4*)g + lane + 64 * j);
        au = fmaxf(au, fmaxf(fmaxf(fabsf(u[j].x), fabsf(u[j].y)), fmaxf(fabsf(u[j].z), fabsf(u[j].w))));
        av = fmaxf(av, fmaxf(fmaxf(fabsf(v[j].x), fabsf(v[j].y)), fmaxf(fabsf(v[j].z), fabsf(v[j].w)))); }
#pragma unroll
    for (int o = 1; o < 64; o <<= 1) { au = fmaxf(au, __shfl_xor(au, o)); av = fmaxf(av, __shfl_xor(av, o)); }
    const float su = au > 0.f ? 6.f / au : 1.f, sv = av > 0.f ? 6.f / av : 1.f;
    if (lane == 0) { usc[row] = au > 0.f ? au * (1.f / 6.f) : 1.f; vsc[row] = av > 0.f ? av * (1.f / 6.f) : 1.f; }
#pragma unroll
    for (int j = 0; j < 4; ++j) {
        { unsigned pk = 0;
          pk = __builtin_amdgcn_cvt_scalef32_pk_fp4_f32(pk, u[j].x * su, u[j].y * su, 1.0f, 0); pk = __builtin_amdgcn_cvt_scalef32_pk_fp4_f32(pk, u[j].z * su, u[j].w * su, 1.0f, 1);
          *(GAS unsigned short*)(ub8 + (size_t)row * 512 + 2 * (lane + 64 * j)) = (unsigned short)pk; }
        { unsigned pk = 0;
          pk = __builtin_amdgcn_cvt_scalef32_pk_fp4_f32(pk, v[j].x * sv, v[j].y * sv, 1.0f, 0); pk = __builtin_amdgcn_cvt_scalef32_pk_fp4_f32(pk, v[j].z * sv, v[j].w * sv, 1.0f, 1);
          const unsigned po = (unsigned)__shfl_xor((int)pk, 1);
          const unsigned lo = (lane & 1) ? po : pk, hi = (lane & 1) ? pk : po;
          GAS unsigned char* vrow_ = (GAS unsigned char*)vb8 + (size_t)j * ((size_t)N_EXP * 128) + (size_t)row * 128 + 32 * (lane >> 4) + ((lane & 15) >> 1);
          const int i0 = (lane & 1) * 2;
          vrow_[8 * i0] = (unsigned char)(((lo >> (4 * i0)) & 15u) | (((hi >> (4 * i0)) & 15u) << 4));
          vrow_[8 * (i0 + 1)] = (unsigned char)(((lo >> (4 * i0 + 4)) & 15u) | (((hi >> (4 * i0 + 4)) & 15u) << 4)); } }
}
struct P0Args { const float *x, *g1, *w_in, *w_pw, *w_ao, *w_out, *g2, *w_q, *k1, *k2, *pu, *pv; bf16 *H, *Win, *Wpw, *Wao, *Wout, *Wq, *keys; unsigned char *ub8, *vb8; float *usc, *vsc; };
__device__ __forceinline__ void p0_prologue(Frame& F, const P0Args& a) {
    LAS float* scr = (LAS float*)(F.lds + RING_OFF + F.wave * 16384);
    const int gw = F.vcu * NWAVES + F.wave, NGW = F.G * NWAVES;
    constexpr int I_IN = 16 * (IN_COLS / 32), I_PW = 8 * 32, I_AO = 8 * 32, I_OUT = 16 * 32, I_Q = 16 * 64;
    constexpr int NITEMS = I_IN + I_PW + I_AO + I_OUT + I_Q;
    auto item_of = [&](int r) -> P0Item {
        if (r < I_IN) { const int nb = IN_COLS / 32, kb = r / nb, n0 = 32 * (r % nb); return P0Item{a.w_in, IN_COLS, a.Win, 64 * kb, n0, perm_in(n0), nullptr, 1024, 0}; } r -= I_IN;
        if (r < I_PW) { const int kb = r / 32, n0 = 32 * (r % 32); return P0Item{a.w_pw, 1024, a.Wpw, 64 * kb, n0, n0, nullptr, 1024, 0}; } r -= I_PW;
        if (r < I_AO) { const int kb = r / 32, n0 = 32 * (r % 32); return P0Item{a.w_ao, 1024, a.Wpw, 64 * kb, n0, n0, nullptr, 1024, 512}; }   r -= I_AO;
        if (r < I_OUT) { const int kb = r / 32, n0 = 32 * (r % 32); return P0Item{a.w_out, 1024, a.Wout, 64 * kb, n0, n0, nullptr, 1024, 0}; } r -= I_OUT;
        { const int kb = r / 64, n0 = 32 * (r % 64); return P0Item{a.w_q, 2048, a.Wq, 64 * kb, n0, n0, a.g2, 1024, 0}; } };
    { float wn[32]; P0Item tn = item_of(gw < NITEMS ? gw : 0);
      if (gw < NITEMS) p0_item_fetch(tn, F.lane, wn);
      for (int it = gw; it < NITEMS; it += NGW) { const P0Item tc = tn; float wc[32];
#pragma unroll
          for (int i = 0; i < 32; ++i) wc[i] = wn[i];
          const int itn = it + NGW;
          if (itn < NITEMS) { tn = item_of(itn); p0_item_fetch(tn, F.lane, wn); }
          p0_item_store(tc, F.lane, wc, scr); } }
    for (int m = 4 * gw; m < TOK; m += 4 * NGW) rows_to_bf16<true, 4>(F.lane, a.x + (size_t)m * 1024, 1024, a.g1, a.H + (size_t)m * 1024);
    { f32x4 un[4], vn[4];
      if (gw < N_EXP) rows_uv_fetch(F.lane, a.pu + (size_t)gw * 1024, a.pv + (size_t)gw * 1024, un, vn);
      for (int m = gw; m < N_EXP; m += NGW) { f32x4 u[4], v[4];
#pragma unroll
          for (int j = 0; j < 4; ++j) { u[j] = un[j]; v[j] = vn[j]; }
          const int mn = m + NGW;
          if (mn < N_EXP) rows_uv_fetch(F.lane, a.pu + (size_t)mn * 1024, a.pv + (size_t)mn * 1024, un, vn);
          rows_to_fp8_uv(F.lane, u, v, a.g2, a.ub8, a.vb8, m, a.usc, a.vsc); } }
    for (int m = gw; m < 32; m += NGW) { const float* src = (m < 16 ? a.k1 : a.k2) + (size_t)(m & 15) * 1024; row_to_bf16<false>(F.lane, src, nullptr, a.keys + (size_t)m * 1024); }
}

typedef float cv_f2 __attribute__((ext_vector_type(2)));
struct ConvArgs { const bf16* zglu; const float *cw, *cb, *lg, *lb; bf16* cact; };
__device__ __forceinline__ void conv_phase(Frame& F, const ConvArgs& a) {
    LAS unsigned char* zs = F.lds + RING_OFF;
    LAS float* part = (LAS float*)(F.lds + RING_OFF + 98304);
    int tid_ = F.tid; asm volatile("" : "+v"(tid_));
    const int cp = tid_ & 255, half = tid_ >> 8, c0 = 2 * cp;
    cv_f2 wv[CONV_W];
    { const GAS float* p = (const GAS float*)(a.cw + c0);
#pragma unroll
      for (int w = 0; w < CONV_W; ++w) { wv[w] = *(const GAS cv_f2*)p; p += 512; asm volatile("" : "+v"(p)); } }
    const float b0 = a.cb[c0], b1 = a.cb[c0 + 1], lg0 = a.lg[c0], lg1 = a.lg[c0 + 1], lb0 = a.lb[c0], lb1 = a.lb[c0 + 1];
    v4u zn[12];
#define CONV_FETCH(TILE) do { const int t0_ = (TILE) * 64, tb_ = t0_ & (SEQ - 1); _Pragma("unroll") for (int q = 0; q < 12; ++q) { const int i = tid_ + 512 * q, r = i >> 6, ch = i & 63; zn[q] = (v4u){0u, 0u, 0u, 0u}; \
        if (i < 94 * 64 && tb_ - 30 + r >= 0) zn[q] = *(const GAS v4u*)(a.zglu + (size_t)(t0_ - 30 + r) * 512 + ch * 8); } } while (0)
    if (F.vcu < TOK / 64) CONV_FETCH(F.vcu);
    for (int tile = F.vcu; tile < TOK / 64; tile += F.G) {
        const int t0 = tile * 64;
#pragma unroll
        for (int q = 0; q < 12; ++q) { const int i = tid_ + 512 * q, r = i >> 6, ch = i & 63; if (i < 94 * 64) *(LAS v4u*)(zs + r * 1024 + ch * 16) = zn[q]; }
        __syncthreads();
        if (tile + F.G < TOK / 64) CONV_FETCH(tile + F.G);
        for (int ch8 = 0; ch8 < 4; ++ch8) {
            const int tl = half * 32 + ch8 * 8;
            cv_f2 zz[38];
#pragma unroll
            for (int i = 0; i < 38; ++i) { const unsigned u = *(const LAS unsigned*)(zs + (tl + i) * 1024 + cp * 4); zz[i] = (cv_f2){bflo(u), bfhi(u)}; }
            float a0[8], a1[8];
#pragma unroll
            for (int k = 0; k < 8; ++k) { cv_f2 sv = (cv_f2){b0, b1};
#pragma unroll
                for (int w = 0; w < CONV_W; ++w) sv = __builtin_elementwise_fma(wv[w], zz[k + w], sv);
                a0[k] = sv.x; a1[k] = sv.y; }
#pragma unroll
            for (int k = 0; k < 8; ++k) { const float s1 = wave_sum_hi(a0[k] + a1[k]), s2 = wave_sum_hi(a0[k] * a0[k] + a1[k] * a1[k]);
                if (F.lane == 63) { part[((half * 8 + k) * 4 + (F.wave & 3)) * 2] = s1; part[((half * 8 + k) * 4 + (F.wave & 3)) * 2 + 1] = s2; } }
            __syncthreads();
            bf16* op = a.cact + (size_t)(t0 + tl) * 1024 + c0;
#pragma unroll
            for (int k = 0; k < 8; ++k) { const LAS float* p = part + (half * 8 + k) * 8;
                const float S1 = (p[0] + p[2]) + (p[4] + p[6]), S2 = (p[1] + p[3]) + (p[5] + p[7]);
                const float mean = S1 * (1.f / 512.f), var = S2 * (1.f / 512.f) - mean * mean, rstd = __builtin_amdgcn_rsqf(var + NORM_EPS);
                const float y0 = (a0[k] - mean) * rstd * lg0 + lb0, y1 = (a1[k] - mean) * rstd * lg1 + lb1;
                const float o0 = y0 * __builtin_amdgcn_rcpf(1.f + __builtin_amdgcn_exp2f(-1.4426950408889634f * y0)), o1 = y1 * __builtin_amdgcn_rcpf(1.f + __builtin_amdgcn_exp2f(-1.4426950408889634f * y1));
                *(GAS unsigned*)(op + k * 1024) = pk2(o0, o1); }
            __syncthreads();
        }
    }
#undef CONV_FETCH
}

__device__ __forceinline__ float mkkey(float v, int mask, int payload) { return __int_as_float((__float_as_int(v) & ~mask) | payload); }
__device__ __forceinline__ int keypay(float k, int mask) { return __float_as_int(k) & mask; }
__device__ __forceinline__ float unkey(float k, int mask) { return __int_as_float(__float_as_int(k) & ~mask); }
__device__ __forceinline__ void ce_desc(float& a, float& b) { const float hi = __builtin_fmaxf(a, b), lo = __builtin_fminf(a, b); a = hi; b = lo; }
template <int N> __device__ __forceinline__ void sort_desc(float (&v)[N]) {
#pragma unroll
    for (int k = 2; k <= N; k <<= 1)
#pragma unroll
        for (int j = k >> 1; j > 0; j >>= 1)
#pragma unroll
            for (int i = 0; i < N; ++i) { const int l = i ^ j; if (l > i) { if ((i & k) == 0) ce_desc(v[i], v[l]); else ce_desc(v[l], v[i]); } }
}
template <> __device__ __forceinline__ void sort_desc<16>(float (&v)[16]) {
    ce_desc(v[0], v[1]); ce_desc(v[2], v[3]); ce_desc(v[0], v[2]); ce_desc(v[1], v[3]); ce_desc(v[1], v[2]); ce_desc(v[4], v[5]); ce_desc(v[6], v[7]); ce_desc(v[4], v[6]);
    ce_desc(v[5], v[7]); ce_desc(v[5], v[6]); ce_desc(v[0], v[4]); ce_desc(v[2], v[6]); ce_desc(v[2], v[4]); ce_desc(v[1], v[5]); ce_desc(v[3], v[7]); ce_desc(v[3], v[5]);
    ce_desc(v[1], v[2]); ce_desc(v[3], v[4]); ce_desc(v[5], v[6]); ce_desc(v[8], v[9]); ce_desc(v[10], v[11]); ce_desc(v[8], v[10]); ce_desc(v[9], v[11]); ce_desc(v[9], v[10]);
    ce_desc(v[12], v[13]); ce_desc(v[14], v[15]); ce_desc(v[12], v[14]); ce_desc(v[13], v[15]); ce_desc(v[13], v[14]); ce_desc(v[8], v[12]); ce_desc(v[10], v[14]); ce_desc(v[10], v[12]);
    ce_desc(v[9], v[13]); ce_desc(v[11], v[15]); ce_desc(v[11], v[13]); ce_desc(v[9], v[10]); ce_desc(v[11], v[12]); ce_desc(v[13], v[14]); ce_desc(v[0], v[8]); ce_desc(v[4], v[12]);
    ce_desc(v[4], v[8]); ce_desc(v[2], v[10]); ce_desc(v[6], v[14]); ce_desc(v[6], v[10]); ce_desc(v[2], v[4]); ce_desc(v[6], v[8]); ce_desc(v[10], v[12]); ce_desc(v[1], v[9]);
    ce_desc(v[5], v[13]); ce_desc(v[5], v[9]); ce_desc(v[3], v[11]); ce_desc(v[7], v[15]); ce_desc(v[7], v[11]); ce_desc(v[3], v[5]); ce_desc(v[7], v[9]); ce_desc(v[11], v[13]);
    ce_desc(v[1], v[2]); ce_desc(v[3], v[4]); ce_desc(v[5], v[6]); ce_desc(v[7], v[8]); ce_desc(v[9], v[10]); ce_desc(v[11], v[12]); ce_desc(v[13], v[14]);
}
__device__ __forceinline__ void bitonic_merge16_desc(float (&v)[16]) {
#pragma unroll
    for (int j = 8; j > 0; j >>= 1)
#pragma unroll
        for (int i = 0; i < 16; ++i) { const int l = i ^ j; if (l > i) ce_desc(v[i], v[l]); }
}
__device__ __forceinline__ void merge_top16(float (&a)[16], const float (&b)[16]) {
#pragma unroll
    for (int i = 0; i < 16; ++i) a[i] = __builtin_fmaxf(a[i], b[15 - i]);
    bitonic_merge16_desc(a);
}
__device__ __forceinline__ void top16_of_64(const float (&x)[64], float (&out)[16]) {
    float g[16];
#pragma unroll
    for (int i = 0; i < 16; ++i) out[i] = x[i];
    sort_desc<16>(out);
#pragma unroll
    for (int q = 1; q < 4; ++q) {
#pragma unroll
        for (int i = 0; i < 16; ++i) g[i] = x[16 * q + i];
        sort_desc<16>(g); merge_top16(out, g); }
}
__device__ __forceinline__ void top16_of_50(const float (&x)[64], float (&out)[16]) {
    float g[16];
#pragma unroll
    for (int i = 0; i < 16; ++i) out[i] = x[i];
    sort_desc<16>(out);
#pragma unroll
    for (int q = 1; q < 3; ++q) {
#pragma unroll
        for (int i = 0; i < 16; ++i) g[i] = x[16 * q + i];
        sort_desc<16>(g); merge_top16(out, g); }
#pragma unroll
    for (int i = 0; i < 16; ++i) g[i] = x[48 + i];
    ce_desc(g[0], g[1]);
    merge_top16(out, g);
}
__device__ __forceinline__ int crow_(int r, int hi) { return (r & 3) + 8 * (r >> 2) + 4 * hi; }
struct SelArgs { const bf16* qp; const bf16* keys; const float* ss; const float* usc; const float* vsc; int* eidx; float* ga; float* gb; const bf16* x1b; unsigned char* x8; float* xs; };
__device__ __forceinline__ void peer_select_phase(Frame& F, const SelArgs& a, const pg8::StaticOrder& S) {
    for (int i = F.tid; i < 2 * 128 * 16; i += 512) { const int which = i >> 11, rem = i & 2047, row = rem >> 4, ch = rem & 15;
        const v4u v = *(const GAS v4u*)(a.keys + (size_t)which * 16384 + row * 128 + ch * 8);
        *(LAS v4u*)(F.lds + RING_OFF + which * 32768 + row * 256 + ((ch ^ (row & 15)) << 4)) = v; }
    __syncthreads();
    LAS int* scr = (LAS int*)(F.lds + RING_OFF + 65536 + F.wave * 4096);
    const int lane = F.lane, tl = lane & 31, hi = lane >> 5;
    constexpr int QA[27] = {0,0,0,0,0,0,0,0,0,0,0,0,0,0,0, 1,1,1,1,1,1, 2,2, 0,1,2,3};
    constexpr int QB[27] = {1,2,3,4,5,6,7,8,9,10,11,12,13,14,15, 2,3,4,5,6,7, 3,4, 0,1,2,3};
    for (int ui = 0; ; ++ui) { pg8::Unit uu; if (!S.next(ui, uu)) break;
        const int tt = uu.pm * 8 + F.wave, hh = uu.pn, t = tt * 32 + tl;
        float vk[2][16];
#pragma unroll
        for (int half = 0; half < 2; ++half) {
            const bf16* qrow = a.qp + (size_t)t * 2048 + hh * 256 + half * 128 + hi * 8;
            bf16x8 bq[8];
#pragma unroll
            for (int ks = 0; ks < 8; ++ks) bq[ks] = *(const GAS bf16x8*)(qrow + ks * 16);
            f32x16 acc[4];
#pragma unroll
            for (int nb = 0; nb < 4; ++nb) { acc[nb] = (f32x16){};
#pragma unroll
                for (int ks = 0; ks < 8; ++ks) { const int row = nb * 32 + tl, ch = 2 * ks + hi;
                    const bf16x8 ka = *(const LAS bf16x8*)(F.lds + RING_OFF + half * 32768 + row * 256 + ((ch ^ (row & 15)) << 4));
                    acc[nb] = __builtin_amdgcn_mfma_f32_32x32x16_bf16(ka, bq[ks], acc[nb], 0, 0, 0); } }
            float keys[64];
#pragma unroll
            for (int nb = 0; nb < 4; ++nb)
#pragma unroll
                for (int r = 0; r < 16; ++r) keys[nb * 16 + r] = mkkey(acc[nb][r], 127, nb * 32 + crow_(r, hi));
            float top[16]; top16_of_64(keys, top);
#pragma unroll
            for (int i = 0; i < 16; ++i) vk[half][i] = top[i];
        }
        float mine[16];
        { float recv[16];
#pragma unroll
          for (int i = 0; i < 16; ++i) { const float snd = hi ? vk[1][i] : vk[0][i]; mine[i] = hi ? vk[0][i] : vk[1][i]; recv[i] = __shfl_xor(snd, 32); }
          merge_top16(mine, recv); }
        float F1[4], F2[16];
#pragma unroll
        for (int i = 0; i < 16; ++i) { F2[i] = unkey(mine[i], 127); if (i < 4) F1[i] = unkey(__shfl_xor(mine[i], 32), 127); }
        float c[16], g2[16];
        { const int hib = hi << 6;
#pragma unroll
          for (int i = 0; i < 27; ++i) { float k = mkkey(F1[QA[i]] + F2[QB[i]], 255, QA[i] | (QB[i] << 2)); k = __int_as_float(__float_as_int(k) | hib);
              if (i >= 23) k = hi ? -3.0e38f : k;
              if (i < 16) c[i] = k; else g2[i - 16] = k; }
#pragma unroll
          for (int i = 11; i < 16; ++i) g2[i] = -3.0e38f; }
        sort_desc<16>(c); sort_desc<16>(g2); merge_top16(c, g2);
#pragma unroll
        for (int i = 0; i < 16; ++i) scr[tl * 32 + (hi ? 0 : 16) + i] = keypay(mine[i], 127);
        float ssum = 0.f;
        { const GAS f32x4* sp = (const GAS f32x4*)(a.ss + (size_t)t * 16);
#pragma unroll
          for (int i = 0; i < 4; ++i) { const f32x4 v = sp[i]; ssum += (v.x + v.y) + (v.z + v.w); } }
        const float rstd = 1.f / sqrtf(ssum * (1.f / 1024.f) + NORM_EPS);
        const float smax = unkey(__builtin_fmaxf(c[0], __shfl_xor(c[0], 32)), 255);
#pragma unroll
        for (int i = 0; i < 8; ++i) c[i] = __builtin_fmaxf(c[i], __shfl_xor(c[15 - i], 32));
        float e[8], esum = 0.f;
#pragma unroll
        for (int i = 0; i < 8; ++i) { e[i] = __expf((unkey(c[i], 255) - smax) * rstd); esum += e[i]; }
        esum += __shfl_xor(esum, 32);
        const float inv = 1.f / esum;
        LDS_WAIT(); asm volatile("" ::: "memory");
        int eo[8]; float go[8];
#pragma unroll
        for (int i = 0; i < 8; ++i) { const int id = keypay(c[i], 255), pa = id & 3, pb = (id >> 2) & 15, o = id >> 6;
            const int i1 = scr[tl * 32 + (o ? pb : pa)], i2 = scr[tl * 32 + 16 + (o ? pa : pb)];
            eo[i] = i1 * P_NK + i2; go[i] = e[i] * inv; }
        float ua[8];
#pragma unroll
        for (int i = 0; i < 8; ++i) { ua[i] = a.usc[eo[i]]; go[i] *= a.vsc[eo[i]]; }
        unsigned short* ep = (unsigned short*)a.eidx + (size_t)t * P_E + hh * 16 + hi * 8; unsigned* gp = (unsigned*)a.ga + (size_t)t * P_E + hh * 16 + hi * 8;
        *(GAS v4u*)(ep) = (v4u){(unsigned)eo[0] | ((unsigned)eo[1] << 16), (unsigned)eo[2] | ((unsigned)eo[3] << 16), (unsigned)eo[4] | ((unsigned)eo[5] << 16), (unsigned)eo[6] | ((unsigned)eo[7] << 16)};
        *(GAS v4u*)(gp) = (v4u){pk2(ua[0], go[0]), pk2(ua[1], go[1]), pk2(ua[2], go[2]), pk2(ua[3], go[3])}; *(GAS v4u*)(gp + 4) = (v4u){pk2(ua[4], go[4]), pk2(ua[5], go[5]), pk2(ua[6], go[6]), pk2(ua[7], go[7])};
        LDS_WAIT(); asm volatile("" ::: "memory");
    }
}

__device__ __forceinline__ void peer_rows_fp8(Frame& F, const SelArgs& a) {
    const int gw = F.vcu * NWAVES + F.wave, NGW = F.G * NWAVES, lane = F.lane;
    for (int t = gw; t < TOK; t += NGW) {
        const GAS v4u* xp = (const GAS v4u*)(a.x1b + (size_t)t * 1024 + 16 * lane); const v4u xa = xp[0], xb = xp[1];
        const float xf[16] = {bflo(xa.x), bfhi(xa.x), bflo(xa.y), bfhi(xa.y), bflo(xa.z), bfhi(xa.z), bflo(xa.w), bfhi(xa.w), bflo(xb.x), bfhi(xb.x), bflo(xb.y), bfhi(xb.y), bflo(xb.z), bfhi(xb.z), bflo(xb.w), bfhi(xb.w)};
        float am = 0.f;
#pragma unroll
        for (int i = 0; i < 16; ++i) am = fmaxf(am, fabsf(xf[i]));
#pragma unroll
        for (int o = 1; o < 64; o <<= 1) am = fmaxf(am, __shfl_xor(am, o));
        const float xsc = am > 0.f ? 240.f / am : 1.f, xinv = am > 0.f ? am * (1.f / 240.f) : 1.f;
        v4u o;
        { int w = 0; w = __builtin_amdgcn_cvt_pk_fp8_f32(xf[0] * xsc, xf[1] * xsc, w, false); w = __builtin_amdgcn_cvt_pk_fp8_f32(xf[2] * xsc, xf[3] * xsc, w, true); o.x = (unsigned)w; }
        { int w = 0; w = __builtin_amdgcn_cvt_pk_fp8_f32(xf[4] * xsc, xf[5] * xsc, w, false); w = __builtin_amdgcn_cvt_pk_fp8_f32(xf[6] * xsc, xf[7] * xsc, w, true); o.y = (unsigned)w; }
        { int w = 0; w = __builtin_amdgcn_cvt_pk_fp8_f32(xf[8] * xsc, xf[9] * xsc, w, false); w = __builtin_amdgcn_cvt_pk_fp8_f32(xf[10] * xsc, xf[11] * xsc, w, true); o.z = (unsigned)w; }
        { int w = 0; w = __builtin_amdgcn_cvt_pk_fp8_f32(xf[12] * xsc, xf[13] * xsc, w, false); w = __builtin_amdgcn_cvt_pk_fp8_f32(xf[14] * xsc, xf[15] * xsc, w, true); o.w = (unsigned)w; }
        *(GAS v4u*)(a.x8 + (size_t)t * 1024 + 16 * lane) = o;
        const float ssum = wave_sum(lane < 16 ? a.ss[(size_t)t * 16 + lane] : 0.f);
        if (lane == 0) a.xs[t] = xinv / sqrtf(ssum * (1.f / 1024.f) + NORM_EPS);
    }
}

typedef float f32x2_t __attribute__((ext_vector_type(2)));
struct ExpA { const bf16* x1b; const float* ss; const unsigned char* ub8; const int* eidx; const float* ga; const float* gb; unsigned char* coef8; };
__device__ __forceinline__ float row_sum16(float v) {
    v += __builtin_bit_cast(float, __builtin_amdgcn_update_dpp(0, __builtin_bit_cast(int, v), 0xB1, 0xf, 0xf, false));
    v += __builtin_bit_cast(float, __builtin_amdgcn_update_dpp(0, __builtin_bit_cast(int, v), 0x4E, 0xf, 0xf, false));
    v += __builtin_bit_cast(float, __builtin_amdgcn_update_dpp(0, __builtin_bit_cast(int, v), 0x141, 0xf, 0xf, false));
    v += __builtin_bit_cast(float, __builtin_amdgcn_update_dpp(0, __builtin_bit_cast(int, v), 0x140, 0xf, 0xf, false));
    return v;
}
__device__ __forceinline__ float row_max16(float v) {
    v = fmaxf(v, __builtin_bit_cast(float, __builtin_amdgcn_update_dpp(0, __builtin_bit_cast(int, v), 0xB1, 0xf, 0xf, false)));
    v = fmaxf(v, __builtin_bit_cast(float, __builtin_amdgcn_update_dpp(0, __builtin_bit_cast(int, v), 0x4E, 0xf, 0xf, false)));
    v = fmaxf(v, __builtin_bit_cast(float, __builtin_amdgcn_update_dpp(0, __builtin_bit_cast(int, v), 0x141, 0xf, 0xf, false)));
    v = fmaxf(v, __builtin_bit_cast(float, __builtin_amdgcn_update_dpp(0, __builtin_bit_cast(int, v), 0x140, 0xf, 0xf, false)));
    return v;
}
__device__ __forceinline__ float gelu_as(float v) {
    const float av = fabsf(v), t = __builtin_amdgcn_rcpf(av * 0.2316418882f + 1.0f);
    float q = t * 0.5307027145f + (-0.7265760135f); q = q * t + 0.7107068705f; q = q * t + (-0.142248368f); q = q * t + 0.127414796f; q = q * t;
    const float m = v * (q * __builtin_amdgcn_exp2f((v * v) * (-0.72134752044f)));
    return v < 0.f ? m : v - m;
}
__device__ __forceinline__ float wave_sum_diag(float v) {
    v = row_sum16(v);
    v += __builtin_bit_cast(float, __builtin_amdgcn_update_dpp(0, __builtin_bit_cast(int, v), 0x142, 0xA, 0xF, false));
    v += __builtin_bit_cast(float, __builtin_amdgcn_update_dpp(0, __builtin_bit_cast(int, v), 0x143, 0xC, 0xF, false));
    return v;
}
__device__ __forceinline__ int wg_grab(LAS int* c, const int lane) {
    int v = 0; if (lane == 0) v = __hip_atomic_fetch_add(c, 1, __ATOMIC_RELAXED, __HIP_MEMORY_SCOPE_WORKGROUP);
    return __builtin_amdgcn_readfirstlane(v);
}
constexpr int U_SLICES = 1;
#define U_SLICE_OF(e) (0)
#define U_FIRST_OF(s) (0)
typedef unsigned v2u_t __attribute__((ext_vector_type(2)));
typedef int v2i_t __attribute__((ext_vector_type(2)));
typedef int v8i_t __attribute__((ext_vector_type(8)));
__device__ __forceinline__ void peer_u_phase(Frame& F, const ExpA& a, const int s, const int tfirst, const int step, LAS int* cnt) {
    const int lane = F.lane, q = lane >> 4, jn = lane & 15, half = lane >> 5, c32 = lane & 31;
    if (tfirst >= TOK) return;
    constexpr int UP = 528;
    LAS unsigned char* wb = F.lds + (F.wave < 7 ? F.wave * VT_BYTES : VT_LAST_OFF);
    static_assert(16 * UP + 2 * 1024 + 2 * 1536 <= VT_BYTES, "u-side LDS");
    LAS unsigned char* twr = wb + half * UP + 16 * c32;
    LAS unsigned char* tra = wb + jn * UP + 16 * q;
    const GAS unsigned char* ubase = (const GAS unsigned char*)a.ub8; const unsigned lane16c = 16u * (unsigned)c32;
    const int padent = U_FIRST_OF(s) << 10;
#define UX(P) (wb + 16 * UP + 1024 * (P))
#define UL(P) ((LAS int*)(wb + 16 * UP + 2048 + 1536 * (P)))
    struct Raw { v4u xa, xb; unsigned e01; v2u_t g01; float ssp; };
#define PU_RAW(R, T) do { const int tt_ = (T) < TOK ? (T) : tfirst; { const GAS v4u* xp_ = (const GAS v4u*)(a.x1b + (size_t)tt_ * 1024 + 16 * lane); R.xa = xp_[0]; R.xb = xp_[1]; } \
        R.e01 = ((const GAS unsigned*)a.eidx)[(size_t)tt_ * (P_E / 2) + lane]; R.g01 = *(const GAS v2u_t*)((const GAS unsigned*)a.ga + (size_t)tt_ * P_E + 2 * lane); R.ssp = a.ss[(size_t)tt_ * 16 + (lane & 15)]; } while (0)
#define PU_X8(R, XO, XS) do { \
        const float xf_[16] = {bflo(R.xa.x), bfhi(R.xa.x), bflo(R.xa.y), bfhi(R.xa.y), bflo(R.xa.z), bfhi(R.xa.z), bflo(R.xa.w), bfhi(R.xa.w), bflo(R.xb.x), bfhi(R.xb.x), bflo(R.xb.y), bfhi(R.xb.y), bflo(R.xb.z), bfhi(R.xb.z), bflo(R.xb.w), bfhi(R.xb.w)}; \
        float am_ = 0.f; _Pragma("unroll") for (int i = 0; i < 16; ++i) am_ = fmaxf(am_, fabsf(xf_[i])); \
        am_ = row_max16(am_); am_ = fmaxf(am_, __shfl_xor(am_, 16)); am_ = fmaxf(am_, __shfl_xor(am_, 32)); \
        const float xsc_ = am_ > 0.f ? 240.f / am_ : 1.f, xinv_ = am_ > 0.f ? am_ * (1.f / 240.f) : 1.f; \
        _Pragma("unroll") for (int w = 0; w < 4; ++w) { int p_ = 0; p_ = __builtin_amdgcn_cvt_pk_fp8_f32(xf_[4 * w] * xsc_, xf_[4 * w + 1] * xsc_, p_, false); p_ = __builtin_amdgcn_cvt_pk_fp8_f32(xf_[4 * w + 2] * xsc_, xf_[4 * w + 3] * xsc_, p_, true); XO[w] = (unsigned)p_; } \
        float ss_ = lane < 16 ? R.ssp : 0.f; ss_ = row_sum16(ss_); ss_ = __builtin_amdgcn_readfirstlane(ss_); \
        XS = xinv_ / sqrtf(ss_ * (1.f / 1024.f) + NORM_EPS); } while (0)
#define PU_PREP(R, P, N, VALID) do { LAS int* LST = UL(P); \
        v4u x8_; float xs_; PU_X8(R, x8_, xs_); \
        const int e0_ = (int)(R.e01 & 0xffffu), e1_ = (int)(R.e01 >> 16); \
        if (U_SLICES == 1) {        \
            N = (VALID) ? P_E : 0; \
            *(LAS v2u_t*)(LST + 2 * lane) = (VALID) ? (v2u_t){(unsigned)((2 * lane) | (e0_ << 10)), (unsigned)((2 * lane + 1) | (e1_ << 10))} : (v2u_t){(unsigned)padent, (unsigned)padent}; \
            *(LAS f32x2_t*)((LAS float*)(LST + 128) + 2 * lane) = (f32x2_t){bflo(R.g01.x) * xs_, bflo(R.g01.y) * xs_}; \
            *(LAS f32x2_t*)((LAS float*)(LST + 256) + 2 * lane) = (f32x2_t){bfhi(R.g01.x), bfhi(R.g01.y)}; \
            *(LAS v4u*)(UX(P) + 16 * lane) = x8_; break; } \
        const bool in0_ = (VALID) && U_SLICE_OF(e0_) == s, in1_ = (VALID) && U_SLICE_OF(e1_) == s; \
        const unsigned long long m0_ = __ballot(in0_), m1_ = __ballot(in1_), lt_ = (1ull << lane) - 1ull; \
        const int n0_ = __popcll(m0_); N = n0_ + __popcll(m1_); \
        LAS float* lsa_ = (LAS float*)(LST + 128); LAS float* lsb_ = (LAS float*)(LST + 256); \
        if (N + lane < 128) LST[N + lane] = padent; if (N + 64 + lane < 128) LST[N + 64 + lane] = padent; \
        if (in0_) { const int p = __popcll(m0_ & lt_); LST[p] = (2 * lane) | (e0_ << 10); lsa_[p] = bflo(R.g01.x) * xs_; lsb_[p] = bfhi(R.g01.x); } \
        if (in1_) { const int p = n0_ + __popcll(m1_ & lt_); LST[p] = (2 * lane + 1) | (e1_ << 10); lsa_[p] = bflo(R.g01.y) * xs_; lsb_[p] = bfhi(R.g01.y); } \
        *(LAS v4u*)(UX(P) + 16 * lane) = x8_; } while (0)
#define PU_ISSUE(W, P, B) do { _Pragma("unroll") for (int u = 0; u < 8; ++u) { const unsigned ent_ = (unsigned)UL(P)[16 * (B) + 2 * u + half]; \
        W[u] = *(const GAS v4u*)(ubase + (((ent_ >> 1) & 0xFFFFFE00u) | lane16c)); } } while (0)
#define PU_COMP_REAL(W, P, B, N, T) do { \
        const int ku = 16 * (B) + 4 * q + (jn & 3); const int ent_e = UL(P)[ku]; const float fa_e = ((LAS float*)(UL(P) + 128))[ku], fb_e = ((LAS float*)(UL(P) + 256))[ku];     \
        _Pragma("unroll") for (int u = 0; u < 8; ++u) *(LAS v4u*)(twr + u * (2 * UP)) = W[u]; \
          \
        f32x4 acc0_ = {0.f, 0.f, 0.f, 0.f}, acc1_ = {0.f, 0.f, 0.f, 0.f}; v4u ar_[8]; \
        _Pragma("unroll") for (int kk = 0; kk < 8; ++kk) ar_[kk] = *(const LAS v4u*)(tra + 64 * kk); \
        _Pragma("unroll") for (int kk = 0; kk < 8; kk += 2) { \
            { const v4u ar = ar_[kk], xl = XL[kk], xh = XH[kk]; const v8i_t av = {(int)ar.x, (int)ar.y, (int)ar.z, (int)ar.w, 0, 0, 0, 0}, bv = {(int)xl.x, (int)xl.y, (int)xl.z, (int)xl.w, (int)xh.x, (int)xh.y, (int)xh.z, (int)xh.w}; \
              acc0_ = __builtin_amdgcn_mfma_scale_f32_16x16x128_f8f6f4(av, bv, acc0_, 4, 0, 0, 0, 0, 0); } \
            { const v4u ar = ar_[kk + 1], xl = XL[kk + 1], xh = XH[kk + 1]; const v8i_t av = {(int)ar.x, (int)ar.y, (int)ar.z, (int)ar.w, 0, 0, 0, 0}, bv = {(int)xl.x, (int)xl.y, (int)xl.z, (int)xl.w, (int)xh.x, (int)xh.y, (int)xh.z, (int)xh.w}; \
              acc1_ = __builtin_amdgcn_mfma_scale_f32_16x16x128_f8f6f4(av, bv, acc1_, 4, 0, 0, 0, 0, 0); } } \
        const f32x4 acc = acc0_ + acc1_; \
        const float du = (jn & 2) ? ((jn & 1) ? acc[3] : acc[2]) : ((jn & 1) ? acc[1] : acc[0]); \
        if (jn < 4 && ku < N) { const int slot = ent_e & 127; \
            const float cf_ = C8_SCALE * fb_e * gelu_as(du * fa_e); \
            a.coef8[(size_t)(T) * P_E + slot] = (unsigned char)__builtin_amdgcn_cvt_pk_fp8_f32(fminf(fmaxf(cf_, -448.f), 448.f), 0.f, 0, false); } } while (0)
#if defined(ABL_UNOCOMP)
#define PU_COMP(W, P, B, N, T) do { unsigned x_ = 0; _Pragma("unroll") for (int u = 0; u < 8; ++u) x_ |= W[u].x ^ W[u].w; const int ku = 16 * (B) + 4 * q + (jn & 3); if (jn < 4 && ku < N) { const int slot = UL(P)[ku] & 127; a.coef8[(size_t)(T) * P_E + slot] = (unsigned char)(x_ == 0x12345u ? 1 : 0); } } while (0)
#else
#define PU_COMP(W, P, B, N, T) PU_COMP_REAL(W, P, B, N, T)
#endif
    const int ntok = (TOK - tfirst + step - 1) / step;
#define PU_TOK(i) ((i) < ntok ? tfirst + (i) * step : TOK)
    Raw raw; int nC = 0, nN = 0, par = 0;
    v4u w0[8], w1[8], w2[8], w3[8];
    int iA = wg_grab(cnt, lane), iB = wg_grab(cnt, lane), iC = wg_grab(cnt, lane);
    if (iA >= ntok) return;
    PU_RAW(raw, PU_TOK(iA)); PU_PREP(raw, 0, nC, true);
    PU_RAW(raw, PU_TOK(iB));
    PU_ISSUE(w0, 0, 0); if (nC > 16) PU_ISSUE(w1, 0, 1); if (nC > 32) PU_ISSUE(w2, 0, 2); if (nC > 48) PU_ISSUE(w3, 0, 3);
    PU_PREP(raw, 1, nN, iB < ntok);
    PU_RAW(raw, PU_TOK(iC));
#define PU_STEP(W, B) \
        if (16 * (B) < nC || (B) == 0) PU_COMP(W, par, B, nC, tC); \
        if ((B) < 4) { if (16 * ((B) + 4) < nC) PU_ISSUE(W, par, (B) + 4); } \
        else { if (16 * ((B) - 4) < nN || (B) == 4) PU_ISSUE(W, pn, (B) - 4); }
    for (;;) {
        const int iD = wg_grab(cnt, lane);
        const int tC = PU_TOK(iA), pn = par ^ 1;
        v4u XL[8], XH[8];
#pragma unroll
        for (int kk = 0; kk < 8; ++kk) { XL[kk] = *(const LAS v4u*)(UX(par) + 128 * kk + 16 * q); XH[kk] = *(const LAS v4u*)(UX(par) + 128 * kk + 64 + 16 * q); }
        PU_STEP(w0, 0) PU_STEP(w1, 1) PU_STEP(w2, 2) PU_STEP(w3, 3) PU_STEP(w0, 4) PU_STEP(w1, 5) PU_STEP(w2, 6) PU_STEP(w3, 7)
        if (iB >= ntok) break;
        int nNN; PU_PREP(raw, par, nNN, iC < ntok);
        PU_RAW(raw, PU_TOK(iD));
        iA = iB; iB = iC; iC = iD; nC = nN; nN = nNN; par = pn;
    }
#undef PU_STEP
#undef PU_TOK
#undef PU_RAW
#undef PU_X8
#undef PU_PREP
#undef PU_ISSUE
#undef PU_COMP
#undef PU_COMP_REAL
#undef UX
#undef UL
}
struct ExpB { bf16* x2b; const bf16* x1b; const unsigned char* vb8; const int* eidx; const unsigned char* coef8; float* ss2; float* out; const float* gfinal; };
constexpr int V_SLICES = 4;
template <bool LAST>
__device__ __forceinline__ void peer_v_phase(Frame& F, const ExpB& a, const int s, const int t0, const int step, LAS int* cnt) {
    const int lane = F.lane, g = lane >> 3, j = lane & 7, q = lane >> 4, jn = lane & 15;
    const GAS unsigned char* vs = (const GAS unsigned char*)a.vb8 + (size_t)s * ((size_t)N_EXP * 128); const unsigned j16 = 16u * (unsigned)j;
    if (t0 >= TOK) return;
    LAS unsigned char* tile = F.lds + (F.wave < 7 ? F.wave * VT_BYTES : VT_LAST_OFF);
    LAS unsigned char* wbase = tile + g * (16 * VT_PITCH) + 16 * j;
    LAS unsigned char* rbase = tile + (32 * q + jn) * VT_PITCH;
    f32x4 gfv[4];
    if constexpr (LAST) {
#pragma unroll
        for (int sp = 0; sp < 4; ++sp) gfv[sp] = *(const GAS f32x4*)(a.gfinal + 256 * sp + 64 * q + 4 * jn); }
    const int chA = 256 * s + 64 * q + 4 * jn;
#define PV_LDE(E, T) do { const int tt_ = (T) < TOK ? (T) : t0; const GAS v4u* ep_ = (const GAS v4u*)((const GAS unsigned short*)a.eidx + (size_t)tt_ * P_E + 16 * g); \
        _Pragma("unroll") for (int k4 = 0; k4 < 2; ++k4) { const v4u ev = ep_[k4]; const unsigned w_[4] = {ev.x, ev.y, ev.z, ev.w}; \
            _Pragma("unroll") for (int i = 0; i < 4; ++i) { E[8 * k4 + 2 * i] = (int)(w_[i] & 0xffffu); E[8 * k4 + 2 * i + 1] = (int)(w_[i] >> 16); } } } while (0)
#define PV_ROWS(W, E, C8, X, PS, PX, T) do { const int tt_ = (T) < TOK ? (T) : t0; _Pragma("unroll") for (int k = 0; k < 16; ++k) W[k] = *(const GAS v4u*)(vs + (((unsigned)E[k] << 7) | j16)); \
        { const GAS v4u* cp_ = (const GAS v4u*)(a.coef8 + (size_t)tt_ * P_E + 16 * q); C8[0] = cp_[0]; C8[1] = cp_[4]; }   \
        X = *(const GAS v2u_t*)(a.x1b + (size_t)tt_ * 1024 + chA); \
        if constexpr (LAST) { PS = *(const GAS f32x4*)(a.ss2 + (size_t)tt_ * V_SLICES); _Pragma("unroll") for (int sp = 0; sp < 3; ++sp) PX[sp] = *(const GAS v2u_t*)(a.x2b + (size_t)tt_ * 1024 + 256 * sp + 64 * q + 4 * jn); } } while (0)
#define PV_COMP(W, C8, X, PS, PX, T) do { \
        _Pragma("unroll") for (int k = 0; k < 16; ++k) *(LAS v4u*)(wbase + k * VT_PITCH) = W[k]; \
        const v8i_t av = {(int)C8[0].x, (int)C8[0].y, (int)C8[0].z, (int)C8[0].w, (int)C8[1].x, (int)C8[1].y, (int)C8[1].z, (int)C8[1].w}; \
        float y[4] = {0.f, 0.f, 0.f, 0.f}; \
        _Pragma("unroll") for (int ct = 0; ct < 16; ++ct) { \
            const v2i_t b0 = __builtin_amdgcn_ds_read_tr4_b64_v2i32((LAS v2i_t*)(rbase + 8 * ct)), b1 = __builtin_amdgcn_ds_read_tr4_b64_v2i32((LAS v2i_t*)(rbase + 16 * VT_PITCH + 8 * ct)); \
            const v8i_t bv = {b0.x, b0.y, b1.x, b1.y, 0, 0, 0, 0}; \
            const f32x4 d_ = __builtin_amdgcn_mfma_scale_f32_16x16x128_f8f6f4(av, bv, (f32x4){0.f, 0.f, 0.f, 0.f}, 0, 4, 0, 0, 0, 0); \
            y[ct & 3] = (q == (ct >> 2)) ? d_[0] : y[ct & 3]; } \
        const f32x4 o_ = {bflo(X.x) + y[0] * (1.f / C8_SCALE), bfhi(X.x) + y[1] * (1.f / C8_SCALE), bflo(X.y) + y[2] * (1.f / C8_SCALE), bfhi(X.y) + y[3] * (1.f / C8_SCALE)}; \
        float sq = (o_.x * o_.x + o_.y * o_.y) + (o_.z * o_.z + o_.w * o_.w); \
        sq = row_sum16(sq); \
        sq += __shfl_xor(sq, 16); sq += __shfl_xor(sq, 32); \
        if constexpr (LAST) { const float rstd_ = 1.f / sqrtf(((PS.x + PS.y) + (PS.z + sq)) * (1.f / 1024.f) + NORM_EPS); \
            GAS float* orow_ = (GAS float*)a.out + (size_t)(T) * 1024 + 64 * q + 4 * jn; \
            _Pragma("unroll") for (int sp = 0; sp < 3; ++sp) __builtin_nontemporal_store((f32x4){bflo(PX[sp].x), bfhi(PX[sp].x), bflo(PX[sp].y), bfhi(PX[sp].y)} * rstd_ * gfv[sp], (GAS f32x4*)(orow_ + 256 * sp)); \
            __builtin_nontemporal_store(o_ * rstd_ * gfv[3], (GAS f32x4*)(orow_ + 768)); } \
        else { *(GAS v2u_t*)(a.x2b + (size_t)(T) * 1024 + chA) = (v2u_t){pk2(o_.x, o_.y), pk2(o_.z, o_.w)}; \
            if (lane == 0) a.ss2[(size_t)(T) * V_SLICES + s] = sq; } } while (0)
    int e1[16], e2[16]; v4u wA[16], wB[16], c8A[2], c8B[2]; v2u_t xA, xB; f32x4 psA, psB; v2u_t pxA[3], pxB[3];
    const int ntok = (TOK - t0 + step - 1) / step;
#define PV_TOK(i) ((i) < ntok ? t0 + (i) * step : TOK)
    int iA = wg_grab(cnt, lane), iB = wg_grab(cnt, lane);
    if (iA >= ntok) return;
    PV_LDE(e1, PV_TOK(iA));
    PV_LDE(e2, PV_TOK(iB));
    PV_ROWS(wA, e1, c8A, xA, psA, pxA, PV_TOK(iA));
    for (;;) {
        const int iC = wg_grab(cnt, lane);
        PV_LDE(e1, PV_TOK(iC));
        PV_ROWS(wB, e2, c8B, xB, psB, pxB, PV_TOK(iB));
        PV_COMP(wA, c8A, xA, psA, pxA, PV_TOK(iA));
        if (iB >= ntok) break;
        const int iD = wg_grab(cnt, lane);
        PV_LDE(e2, PV_TOK(iD));
        PV_ROWS(wA, e1, c8A, xA, psA, pxA, PV_TOK(iC));
        PV_COMP(wB, c8B, xB, psB, pxB, PV_TOK(iB));
        if (iC >= ntok) break;
        iA = iC; iB = iD;
    }
#undef PV_TOK
#undef PV_LDE
#undef PV_ROWS
#undef PV_COMP
}
__device__ __forceinline__ void final_norm_phase(Frame& F, const bf16* x2b, float* out, const float* ss2, const float* gfinal, const int gw, const int NGW) {
    const int lane = F.lane;
    for (int t = gw; t < TOK; t += NGW) {
        const f32x4 s0 = *(const GAS f32x4*)(ss2 + (size_t)t * V_SLICES); static_assert(V_SLICES == 4, "ss2 row");
        const float rstd = 1.f / sqrtf(((s0.x + s0.y) + (s0.z + s0.w)) * (1.f / 1024.f) + NORM_EPS);
        typedef unsigned v2u_n __attribute__((ext_vector_type(2)));
        const GAS v2u_n* xr = (const GAS v2u_n*)(x2b + (size_t)t * 1024) + lane; GAS f32x4* orow = (GAS f32x4*)(out + (size_t)t * 1024) + lane; const GAS f32x4* gf = (const GAS f32x4*)gfinal + lane;
        v2u_n xv[4];
#pragma unroll
        for (int q = 0; q < 4; ++q) xv[q] = xr[64 * q];
#pragma unroll
        for (int q = 0; q < 4; ++q) orow[64 * q] = (f32x4){bflo(xv[q].x), bfhi(xv[q].x), bflo(xv[q].y), bfhi(xv[q].y)} * rstd * gf[64 * q];
    }
}

struct Args { const float* in[18]; float* out; unsigned char* ws; int ph_lo, ph_hi, li, pad; };
__global__ void __launch_bounds__(NWAVES * 64, 2) fwd_kernel(Args args) {
    extern __shared__ __attribute__((aligned(16))) unsigned char lds[];
    Frame F;
    F.lds = (LAS unsigned char*)lds;
    F.MISC = (volatile LAS unsigned*)(F.lds + MISC_OFF);
    F.tid = threadIdx.x; F.lane = F.tid & 63; F.wave = __builtin_amdgcn_readfirstlane(F.tid >> 6);
    F.G = gridDim.x; { const int bx = blockIdx.x; F.vcu = (F.G % 8 == 0) ? (bx % 8) * (F.G / 8) + bx / 8 : bx; }
    unsigned char* ws = args.ws;
    F.ctl = (gu32*)(ws + WS_CTL);
#define GRID_BAR(seam) do { if (N_LAUNCHES == PER_PHASE) { if (F.tid == 0) __hip_atomic_store(F.ctl + CW_TMO, 0xBADBA0u | (unsigned)(seam), RLX_AGENT); } else { xcd_barrier(bar); } } while (0)
    const float* x = args.in[0];
    bf16* H = (bf16*)(ws + WS_H); bf16* Win = (bf16*)(ws + WS_WIN); bf16* Wpw = (bf16*)(ws + WS_WPW); bf16* Wao = (bf16*)(ws + WS_WAO); bf16* Wout = (bf16*)(ws + WS_WOUT); bf16* Wq = (bf16*)(ws + WS_WQ);
    bf16* KEYS = (bf16*)(ws + WS_KEYS); unsigned char* UB = ws + WS_UB; unsigned char* VB = ws + WS_VB; float* USC = (float*)(ws + WS_USC); float* VSC = (float*)(ws + WS_VSC);
    bf16* ZGLU = (bf16*)(ws + WS_ZGLU); bf16* QO = (bf16*)(ws + WS_QO); bf16* KB = (bf16*)(ws + WS_K); bf16* VBUF = (bf16*)(ws + WS_V); bf16* GC = (bf16*)(ws + WS_GC); bf16* GA = (bf16*)(ws + WS_GATE_A);
    bf16* CACT = (bf16*)(ws + WS_CACT); bf16* MIX = (bf16*)(ws + WS_MIX); bf16* X1B = (bf16*)(ws + WS_X1B); bf16* QP = (bf16*)(ws + WS_QP);
    float* KMEAN = (float*)(ws + WS_KMEAN); float* SS = (float*)(ws + WS_SS); int* EIDX = (int*)(ws + WS_EIDX); float* GW = (float*)(ws + WS_GW);
    for (int u = F.tid; u < (LDS_BYTES - LDSCTL_OFF) / 4; u += NWAVES * 64) ((LAS unsigned*)(F.lds + LDSCTL_OFF))[u] = 0u;
    __syncthreads();
    XcdBarrier bar; bar.bar = (unsigned*)(F.ctl + CW_BAR); bar.x = 0; bar.st = nullptr;
    if (N_LAUNCHES != PER_PHASE) bar = xcd_barrier_post((unsigned*)(F.ctl + CW_BAR), F.MISC + 8);
    const int lo = args.ph_lo, hi = args.ph_hi;
#ifdef TIME_PHASE
    unsigned long long ts_[PER_PHASE + 1]; ts_[0] = __builtin_amdgcn_s_memrealtime();
#define STAMP(k) ts_[(k) + 1] = __builtin_amdgcn_s_memrealtime()
#else
#define STAMP(k) do {} while (0)
#endif
#ifndef PHASE_MASK
#define PHASE_MASK 0xff
#endif
#define IN(k) (((PHASE_MASK >> (k)) & 1) && lo <= (k) && (k) < hi)
#define BOTH(k) (IN(k) && IN((k) + 1))

    if (IN(0)) {
        P0Args a{x, args.in[1], args.in[2], args.in[7], args.in[9], args.in[10], args.in[11], args.in[12], args.in[13], args.in[14], args.in[15], args.in[16], H, Win, Wpw, Wao, Wout, Wq, KEYS, UB, VB, USC, VSC};
        p0_prologue(F, a);
        if (BOTH(0)) GRID_BAR(0);
        STAMP(0);
    }
#ifdef DEBUG_P1_PLAIN
    if (IN(1)) {
        pg8::Gemm g{H, Wq, TOK, 2048, 1024}; pg8::StaticOrder S; S.init(TOK, 2048, F.G, (int)blockIdx.x);
        pg8::EpiStore E{QP, 2048};
        pg8::gemm_phase<pg8::EpiStore, pg8::StaticOrder, true, true>(F.lds + RING_OFF, g, S, E);
    }
#else
    if (IN(1)) {
        pg8::Gemm g{H, Win, TOK, IN_COLS, 1024}; pg8::StaticOrder S; S.init(TOK, IN_COLS, F.G, (int)blockIdx.x);
        pg8::EpiIn E{ZGLU, QO, GC, KMEAN, attn_body::C2, (size_t)(WS_K - WS_QO) / 2, (size_t)(WS_GATE_A - WS_GC)};
        static_assert(WS_V - WS_K == WS_K - WS_QO, "Q|K|V equally spaced");
        pg8::gemm_phase<pg8::EpiIn, pg8::StaticOrder, true, true>(F.lds + RING_OFF, g, S, E);
        if (BOTH(1)) GRID_BAR(1);
        STAMP(1);
    }
#endif
    if (IN(2)) {
        static_assert(attn_body::ATTN_LDS_BYTES <= RING_BYTES && attn_body::ATTN_PITCH == ATT_W, "attention body geometry vs frame");
#ifdef CONV_FIRST
        { const ConvArgs ca{ZGLU, args.in[3], args.in[4], args.in[5], args.in[6], CACT};
          conv_phase(F, ca); }
        __syncthreads();
#ifdef TIME_SPLIT2
        ts_[3] = __builtin_amdgcn_s_memrealtime();
#endif
#endif
        const attn_body::AttnTensors AT{(const attn_body::bf16*)QO, (const attn_body::bf16*)KB, (const attn_body::bf16*)VBUF, (attn_body::bf16*)(CACT + 512), KMEAN};
        const attn_body::StaticOrder S((int)F.G, (int)blockIdx.x);
        attn_body::attn_phase<attn_body::StaticOrder>((char*)lds + RING_OFF, AT, S);
        __syncthreads();
#ifndef CONV_FIRST
        { const ConvArgs ca{ZGLU, args.in[3], args.in[4], args.in[5], args.in[6], CACT};
          conv_phase(F, ca); }
#endif
        if (BOTH(2)) GRID_BAR(2);
#if !(defined(TIME_SPLIT2) && defined(CONV_FIRST))
        STAMP(2);
#endif
    }
    if (IN(3)) {
        { pg8::Gemm g{CACT, Wpw, TOK, 1024, 1024}; pg8::StaticOrder S; S.init(TOK, 1024, F.G, (int)blockIdx.x);
          pg8::EpiMixF E{(const unsigned char*)GC, (const unsigned char*)GA, args.in[8], MIX};
          pg8::gemm_phase<pg8::EpiMixF, pg8::StaticOrder, true, true>(F.lds + RING_OFF, g, S, E); }
        if (BOTH(3)) GRID_BAR(3);
        STAMP(3);
    }
    if (IN(4)) {
        pg8::Gemm g{MIX, Wout, TOK, 1024, 1024}; pg8::StaticOrder S; S.init(TOK, 1024, F.G, (int)blockIdx.x);
        pg8::EpiX1 E{x, args.out, X1B, SS};
        pg8::gemm_phase<pg8::EpiX1, pg8::StaticOrder, true, true>(F.lds + RING_OFF, g, S, E);
        if (BOTH(4)) GRID_BAR(4);
        STAMP(4);
    }
    if (IN(5)) {
        pg8::Gemm g{X1B, Wq, TOK, 2048, 1024}; pg8::StaticOrder S; S.init(TOK, 2048, F.G, (int)blockIdx.x);
        pg8::EpiStore E{QP, 2048};
        pg8::gemm_phase<pg8::EpiStore, pg8::StaticOrder, true, true>(F.lds + RING_OFF, g, S, E);
        if (BOTH(5)) { VM_WAIT(); __syncthreads(); }
        STAMP(5);
    }
    if (IN(6)) {
        const SelArgs sa{QP, KEYS, SS, USC, VSC, EIDX, (float*)(ws + WS_GA), GW, X1B, ws + WS_X8, (float*)(ws + WS_XS)};
        { pg8::StaticOrder S; S.init(TOK, 2048, F.G, (int)blockIdx.x); peer_select_phase(F, sa, S); }
        if (BOTH(6)) GRID_BAR(6);
        STAMP(6);
    }
    if (IN(7)) {
#ifdef TIME_U
        const unsigned long long tu0_ = __builtin_amdgcn_s_memrealtime();
#endif
        LAS int* cnt = (LAS int*)(F.lds + P7_CNT_OFF);
        if (F.tid < 16) cnt[F.tid] = 0;
        __syncthreads();
        const ExpA ea{X1B, SS, UB, EIDX, (const float*)(ws + WS_GA), GW, ws + WS_COEF};
        for (int s = 0; s < U_SLICES; ++s) peer_u_phase(F, ea, s, F.vcu, F.G, cnt + s);
        VM_WAIT(); __syncthreads();
#ifdef TIME_V
        const unsigned long long tv0_ = __builtin_amdgcn_s_memrealtime();
#endif
        const ExpB eb{(bf16*)(ws + WS_X2B), X1B, VB, EIDX, ws + WS_COEF, (float*)(ws + WS_SS2), args.out, args.in[17]};
        for (int s = 0; s < V_SLICES - 1; ++s) peer_v_phase<false>(F, eb, s, F.vcu, F.G, cnt + 8 + s);
        VM_WAIT(); __syncthreads();
        peer_v_phase<true>(F, eb, V_SLICES - 1, F.vcu, F.G, cnt + 8 + V_SLICES - 1);
#ifdef TIME_V
#ifdef TIME_U
        const float tvv_ = (float)(tv0_ - tu0_) * (0.01f / TIME_V);
#else
        const float tvv_ = (float)(__builtin_amdgcn_s_memrealtime() - tv0_) * (0.01f / TIME_V);
#endif
#endif
#ifdef UNIT_MFMA4
        __syncthreads();
        if (blockIdx.x == 0 && F.wave == 0) {
            typedef int v8i_ __attribute__((ext_vector_type(8)));
            const int lane = F.lane, qq = lane >> 4;
            const v8i_ av = {0x38383838, 0x38383838, 0x38383838, 0x38383838, 0x38383838, 0x38383838, 0x38383838, 0x38383838};
            v8i_ bv = {0x22222222, 0x22222222, 0x22222222, 0x22222222, 0, 0, 0, 0};
            if (UNIT_MFMA4 == 2) bv = (v8i_){0x11111111, 0, 0, 0, 0, 0, 0, 0};
            v8i_ av2 = av;
            if (UNIT_MFMA4 == 3) { const bool on = qq == 1; av2 = (v8i_){0, on ? 0x00005800 : 0, 0, 0, 0, 0, 0, 0}; bv = (v8i_){on ? 0x00700000 : 0, 0, 0, 0, 0, 0, 0, 0}; }
            if (UNIT_MFMA4 == 4) { const bool on = qq == 2; av2 = (v8i_){0, 0, 0, 0, 0, on ? 0x58000000 : 0, 0, 0}; bv = (v8i_){0, 0, on ? 0x70000000 : 0, 0, 0, 0, 0, 0}; }
            const f32x4 d = __builtin_amdgcn_mfma_scale_f32_16x16x128_f8f6f4(av2, bv, (f32x4){0.f, 0.f, 0.f, 0.f}, 0, 4, 0, 0, 0, 0);
            if (UNIT_MFMA4 >= 100) {
                const int eb = UNIT_MFMA4 - 100; int found = 98;
                v8i_ bs = {0, 0, 0, 0, 0, 0, 0, 0}; if (qq == 2) bs[eb >> 3] = 7 << (4 * (eb & 7));
#pragma nounroll
                for (int qe = 0; qe < 128; ++qe) { int qa = qe >> 5, ea = qe & 31; asm volatile("" : "+s"(qa), "+s"(ea)); v8i_ as = {0, 0, 0, 0, 0, 0, 0, 0};
#pragma unroll
                    for (int w = 0; w < 8; ++w) as[w] = (qq == qa && (ea >> 2) == w) ? (0x58 << (8 * (ea & 3))) : 0;
                    const f32x4 dd = __builtin_amdgcn_mfma_scale_f32_16x16x128_f8f6f4(as, bs, (f32x4){0.f, 0.f, 0.f, 0.f}, 0, 4, 0, 0, 0, 0);
                    if (dd[0] > 1.f) found = (qa == UNIT_QA ? 3 * ea + 4 : 99); }
                if (lane == 0) { VM_WAIT(); args.out[0] = (float)found; }
            } else
            if (lane == 0) { VM_WAIT(); args.out[0] = 200.f + d[0]; }
        }
#endif
#ifdef UNIT_TR4
        __syncthreads();
        if (blockIdx.x == 0 && F.wave == 0) {
            typedef int v2i_ __attribute__((ext_vector_type(2)));
            const int lane = F.lane, g4 = lane >> 4, jj = lane & 15;
            LAS unsigned char* tb = F.lds + RING_OFF + g4 * 2048 + jj * 80;
            int okmask = 0;
            for (int hyp = 0; hyp < 4; ++hyp) { const int st = hyp & 1, ot = hyp >> 1;
                unsigned long long rowbits = 0;
                for (int n = 0; n < 16; ++n) { const unsigned v = (unsigned)(3 * jj + 5 * n + g4) & 15u; const int nib = st ? (n ^ 1) : n; rowbits |= (unsigned long long)v << (4 * nib); }
                *(LAS unsigned*)tb = (unsigned)rowbits; *(LAS unsigned*)(tb + 4) = (unsigned)(rowbits >> 32);
                LDS_WAIT(); asm volatile("" ::: "memory");
                const v2i_ rd = __builtin_amdgcn_ds_read_tr4_b64_v2i32((LAS v2i_*)tb);
                unsigned long long ex = 0;
                for (int k = 0; k < 16; ++k) { const unsigned v = (unsigned)(3 * k + 5 * jj + g4) & 15u; const int nib = ot ? (k ^ 1) : k; ex |= (unsigned long long)v << (4 * nib); }
                const bool bad = ((unsigned)rd.x != (unsigned)ex) || ((unsigned)rd.y != (unsigned)(ex >> 32));
                if (__ballot(bad) == 0ull) okmask |= 1 << hyp;
                LDS_WAIT(); asm volatile("" ::: "memory"); }
            if (lane == 0) { VM_WAIT(); args.out[0] = 200.f + 20.f * (float)okmask; }
        }
#endif
#ifdef TIME_V
        __syncthreads();
        if (blockIdx.x == TIME_V_BLOCK && F.tid == 0) { VM_WAIT(); args.out[0] = tvv_; }
#endif
#ifdef TIME_VSEG
        __syncthreads();
        if (blockIdx.x == 0 && F.tid == 0) { VM_WAIT(); args.out[0] = *(LAS float*)(F.lds + P7_CNT_OFF + 128); }
#endif
        STAMP(7);
#ifdef TIME_P7_SPREAD
        __syncthreads();
        ts_[8] = __builtin_amdgcn_s_memrealtime();
        if (F.tid == 0) { __hip_atomic_fetch_max((unsigned long long*)(ws + 800), ts_[8] - ts_[7], __ATOMIC_RELAXED, __HIP_MEMORY_SCOPE_AGENT); __hip_atomic_fetch_add((unsigned*)(ws + 840), 1u, __ATOMIC_RELAXED, __HIP_MEMORY_SCOPE_AGENT); }
        if (blockIdx.x == 0 && F.tid == 0) { while (__hip_atomic_load((unsigned*)(ws + 840), __ATOMIC_RELAXED, __HIP_MEMORY_SCOPE_AGENT) < gridDim.x) __builtin_amdgcn_s_sleep(8);
            ts_[8] = ts_[7] + __hip_atomic_load((unsigned long long*)(ws + 800), __ATOMIC_RELAXED, __HIP_MEMORY_SCOPE_AGENT); }
#endif
#ifdef TIME_PHASE
#ifdef TIME_TOTAL
        if (blockIdx.x == 0 && F.tid == 0) { VM_WAIT(); args.out[0] = (float)(ts_[PER_PHASE] - ts_[0]) * (0.01f / TIME_UNIT_US); }
#else
        if (blockIdx.x == 0 && F.tid == 0) { VM_WAIT(); args.out[0] = (float)(ts_[TIME_PHASE + 1] - ts_[TIME_PHASE]) * (0.01f / TIME_UNIT_US); }
#endif
#endif
    }
#undef IN
#undef BOTH
}

#ifdef DEBUG_DUMP
__global__ void dump_kernel(const unsigned char* ws, float* out, float wsmib) {
    const size_t i = (size_t)blockIdx.x * 256 + threadIdx.x; if (i >= (size_t)TOK * 1024) return;
    const size_t t = i >> 10, c = i & 1023; float v = 0.f;
    auto B = [&](size_t off, size_t idx) { return bflo((unsigned)((const bf16*)(ws + off))[idx]); };
#if DEBUG_DUMP == 0
    v = B(WS_H, i) + B(WS_WIN, i % (4608u * 1024u)) + B(WS_WPW, i % (512u * 1024u)) + B(WS_WAO, i % (512u * 1024u)) + B(WS_WOUT, i % (1024u * 1024u)) + B(WS_WQ, i % (2048u * 1024u)) + B(WS_KEYS, i % 32768u) + B(WS_UB, i % (16384u * 1024u)) + B(WS_VB, i % (16384u * 1024u));
#elif DEBUG_DUMP == 1
    v = B(WS_ZGLU, t * 512 + (c & 511)) + 2.f * B(WS_QO, t * 512 + (c & 511)) + 3.f * B(WS_K, t * 512 + (c & 511)) + 4.f * B(WS_V, t * 512 + (c & 511)) + 5.f * B(WS_GC, i) + 6.f * B(WS_GATE_A, i) + ((const float*)(ws + WS_KMEAN))[(t >> 8) * 1024 + (c & 1023)];
#elif DEBUG_DUMP == 2
    v = B(WS_QO, t * 512 + (c & 511)) + 2.f * B(WS_CACT, t * 512 + (c & 511));
#elif DEBUG_DUMP == 20
    v = B(WS_QO, t * 512 + (c & 511));
#elif DEBUG_DUMP == 21
    v = B(WS_CACT, t * 512 + (c & 511));
#elif DEBUG_DUMP == 3
    v = B(WS_MIX, i);
#elif DEBUG_DUMP == 5
    v = B(WS_QP, t * 2048 + c) + 2.f * B(WS_QP, t * 2048 + 1024 + c);
#elif DEBUG_DUMP == 10
    v = B(WS_ZGLU, t * 512 + (c & 511));
#elif DEBUG_DUMP == 11
    v = 2.f * B(WS_QO, t * 512 + (c & 511)) + 3.f * B(WS_K, t * 512 + (c & 511)) + 4.f * B(WS_V, t * 512 + (c & 511));
#elif DEBUG_DUMP == 12
    v = 5.f * B(WS_GC, i) + 6.f * B(WS_GATE_A, i);
#elif DEBUG_DUMP == 13
    v = ((const float*)(ws + WS_KMEAN))[(t >> 8) * 1024 + (c & 1023)];
#elif DEBUG_DUMP == 98
    v = wsmib;
#elif DEBUG_DUMP == 99
    v = 1.0f + (float)(c & 7);
#endif
    out[i] = v;
}
#endif
extern "C" void kernel_launch(void* const* d_in, const int* in_sizes, int n_in, void* d_out, int out_size, void* d_ws, size_t ws_size, hipStream_t stream) {
    static int grid = 0;
    if (grid == 0) {
        if (n_in != 18 || in_sizes[0] != TOK * DM || out_size != TOK * DM || ws_size < WS_END) { fprintf(stderr, "kernel_launch: unexpected shapes (n_in %d, in0 %d, out %d, ws %zu); nothing launched\n", n_in, n_in > 0 ? in_sizes[0] : -1, out_size, ws_size); grid = -1; return; }
        int dev = 0, cus = 0, per_cu = 0;
        if (hipGetDevice(&dev) != hipSuccess || hipDeviceGetAttribute(&cus, hipDeviceAttributeMultiprocessorCount, dev) != hipSuccess) { grid = -1; return; }
        if (hipFuncSetAttribute((const void*)fwd_kernel, hipFuncAttributeMaxDynamicSharedMemorySize, LDS_BYTES) != hipSuccess) { fprintf(stderr, "kernel_launch: hipFuncSetAttribute failed\n"); grid = -1; return; }
        if (hipOccupancyMaxActiveBlocksPerMultiprocessor(&per_cu, (const void*)fwd_kernel, NWAVES * 64, LDS_BYTES) != hipSuccess || per_cu < 1) fprintf(stderr, "kernel_launch: occupancy query reports %d\n", per_cu);
        (void)hipGetLastError();
        grid = cus;
    }
    if (grid < 0) return;
    (void)hipMemsetAsync((char*)d_ws + WS_CTL, 0, CTL_ZERO_BYTES, stream);
    Args a{};
    for (int i = 0; i < 18; ++i) a.in[i] = (const float*)d_in[i];
    a.out = (float*)d_out; a.ws = (unsigned char*)d_ws;
#ifndef NPH_RUN
#define NPH_RUN N_LAUNCHES
#endif
    for (int li = 0; li < NPH_RUN; ++li) {
        a.ph_lo = (N_LAUNCHES == PER_PHASE) ? li : 0; a.ph_hi = (N_LAUNCHES == PER_PHASE) ? li + 1 : PER_PHASE; a.li = li;
        hipLaunchKernelGGL(fwd_kernel, dim3(grid), dim3(NWAVES * 64), LDS_BYTES, stream, a);
    }
#ifdef DEBUG_DUMP
    hipLaunchKernelGGL(dump_kernel, dim3(TOK * 1024 / 256), dim3(256), 0, stream, (const unsigned char*)d_ws, (float*)d_out, (float)(ws_size >> 20));
#endif
}
```
